# Optimizing an MI355X kernel written in HIP

```python
import jax, jax.numpy as jnp
from jax import lax
import numpy as np

D_MODEL = 1024
BATCH = 32
SEQ = 2048
DEPTH = 1

HEAD_DIM = 64
N_HEADS_SWA = 8
N_KV_SWA = 2
GROUP_SWA = N_HEADS_SWA // N_KV_SWA
WINDOW = 128
N_HEADS_MOBA = 8
MOBA_BLOCK = 256
MOBA_TOPK = 3
MOBA_QCHUNK = 16
ROPE_THETA = 10000.0
N_EXPERTS = 32
TOP_K = 4
D_FF = D_MODEL
SWIGLU_LIMIT = 7.0
SWIGLU_ALPHA = 1.702
EXPERT_BLOCK = 256
LN_EPS = 1e-5
DEEPNORM_ALPHA = (2 * DEPTH) ** 0.25
DEEPNORM_BETA = (8 * DEPTH) ** -0.25

W_Q_SWA = N_HEADS_SWA * HEAD_DIM
W_KV_SWA = N_KV_SWA * HEAD_DIM
W_MOBA = N_HEADS_MOBA * HEAD_DIM
MIX_WIDTH = W_Q_SWA + W_MOBA
IN_WIDTH = W_Q_SWA + 2 * W_KV_SWA + 3 * W_MOBA
SPLITS = (W_Q_SWA, W_Q_SWA + W_KV_SWA, W_Q_SWA + 2 * W_KV_SWA,
          W_Q_SWA + 2 * W_KV_SWA + W_MOBA, W_Q_SWA + 2 * W_KV_SWA + 2 * W_MOBA)

kernel_name = 'hymba_style_swa_sink_moba_moe_deepnorm'


def layer_norm(x, g, b):
    xf = x.astype(jnp.float32)
    mu = jnp.mean(xf, axis=-1, keepdims=True)
    var = jnp.mean(jnp.square(xf - mu), axis=-1, keepdims=True)
    y = (xf - mu) * lax.rsqrt(var + LN_EPS) * g.astype(jnp.float32) + b.astype(jnp.float32)
    return y.astype(x.dtype)


def rope_tables(seq_len, dtype):
    inv_freq = 1.0 / (ROPE_THETA ** (jnp.arange(0, HEAD_DIM, 2, dtype=jnp.float32) / HEAD_DIM))
    ang = jnp.arange(seq_len, dtype=jnp.float32)[:, None] * inv_freq[None, :]
    return jnp.cos(ang)[None, :, None, :].astype(dtype), jnp.sin(ang)[None, :, None, :].astype(dtype)


def apply_rope(t, cos, sin):
    t1, t2 = jnp.split(t, 2, axis=-1)
    return jnp.concatenate([t1 * cos - t2 * sin, t2 * cos + t1 * sin], axis=-1)


def sliding_window_sink_attention(q, k, v, sinks):
    B, S = q.shape[0], q.shape[1]
    nb = S // WINDOW
    qb = q.reshape(B, nb, WINDOW, N_KV_SWA, GROUP_SWA, HEAD_DIM)

    def band(t):
        cur = t.reshape(B, nb, WINDOW, N_KV_SWA, HEAD_DIM)
        prev = jnp.pad(cur, ((0, 0), (1, 0), (0, 0), (0, 0), (0, 0)))[:, :-1]
        return jnp.concatenate([prev, cur], axis=2)

    kb, vb = band(k), band(v)
    scale = HEAD_DIM ** -0.5
    s = jnp.einsum('bnqkgd,bnckd->bkgnqc', qb, kb).astype(jnp.float32) * scale
    r = jnp.arange(WINDOW)[:, None]
    c = jnp.arange(2 * WINDOW)[None, :]
    rel = WINDOW + r - c
    band_mask = (rel >= 0) & (rel < WINDOW)
    key_pos = jnp.arange(nb)[:, None, None] * WINDOW + c[None] - WINDOW
    mask = band_mask[None] & (key_pos >= 0)
    s = jnp.where(mask, s, -jnp.inf)
    sink = sinks.astype(jnp.float32).reshape(1, N_KV_SWA, GROUP_SWA, 1, 1, 1)
    m = jnp.maximum(jnp.max(s, axis=-1, keepdims=True), sink)
    p = jnp.exp(s - m)
    denom = jnp.sum(p, axis=-1, keepdims=True) + jnp.exp(sink - m)
    p = (p / denom).astype(v.dtype)
    o = jnp.einsum('bkgnqc,bnckd->bnqkgd', p, vb)
    return o.reshape(B, S, W_Q_SWA)


def moba_attention(q, k, v):
    B, S = q.shape[0], q.shape[1]
    s_pad = -(-S // MOBA_BLOCK) * MOBA_BLOCK
    pad = ((0, 0), (0, s_pad - S), (0, 0), (0, 0))
    q, k, v = [jnp.pad(t, pad).transpose(0, 2, 1, 3) for t in (q, k, v)]
    nblk = s_pad // MOBA_BLOCK
    ksel = min(MOBA_TOPK, nblk)
    kblk = k.reshape(B, N_HEADS_MOBA, nblk, MOBA_BLOCK, HEAD_DIM)
    vblk = v.reshape(B, N_HEADS_MOBA, nblk, MOBA_BLOCK, HEAD_DIM)
    kmean = jnp.mean(kblk.astype(jnp.float32), axis=3)
    gate = jnp.einsum('bhsd,bhnd->bhsn', q.astype(jnp.float32), kmean)
    q_block = jnp.arange(s_pad) // MOBA_BLOCK
    fully_past = jnp.arange(nblk)[None, :] < q_block[:, None]
    gate = jnp.where(fully_past, gate, -jnp.inf)
    gate_vals, sel_idx = lax.top_k(gate, ksel)
    sel_valid = jnp.isfinite(gate_vals)

    nc = s_pad // MOBA_QCHUNK

    def chunked(t):
        return jnp.moveaxis(t.reshape(B, N_HEADS_MOBA, nc, MOBA_QCHUNK, *t.shape[3:]), 2, 0)

    bi = jnp.arange(B)[:, None, None, None]
    hi = jnp.arange(N_HEADS_MOBA)[None, :, None, None]
    scale = HEAD_DIM ** -0.5

    def chunk_attend(args):
        qc, ic, vc, cidx = args
        k_sel = kblk[bi, hi, ic]
        v_sel = vblk[bi, hi, ic]
        own = cidx * MOBA_QCHUNK // MOBA_BLOCK
        k_own = lax.dynamic_index_in_dim(kblk, own, axis=2, keepdims=False)
        v_own = lax.dynamic_index_in_dim(vblk, own, axis=2, keepdims=False)
        s_sel = jnp.einsum('bhqd,bhqnkd->bhqnk', qc, k_sel).astype(jnp.float32) * scale
        s_sel = jnp.where(vc[..., None], s_sel, -jnp.inf)
        s_own = jnp.einsum('bhqd,bhkd->bhqk', qc, k_own).astype(jnp.float32) * scale
        q_pos = cidx * MOBA_QCHUNK + jnp.arange(MOBA_QCHUNK)
        k_pos = own * MOBA_BLOCK + jnp.arange(MOBA_BLOCK)
        s_own = jnp.where(k_pos[None, :] <= q_pos[:, None], s_own, -jnp.inf)
        s_all = jnp.concatenate([s_sel.reshape(B, N_HEADS_MOBA, MOBA_QCHUNK, ksel * MOBA_BLOCK), s_own], axis=-1)
        p = jax.nn.softmax(s_all, axis=-1).astype(v.dtype)
        p_sel = p[..., :ksel * MOBA_BLOCK].reshape(B, N_HEADS_MOBA, MOBA_QCHUNK, ksel, MOBA_BLOCK)
        p_own = p[..., ksel * MOBA_BLOCK:]
        return (jnp.einsum('bhqnk,bhqnkd->bhqd', p_sel, v_sel)
                + jnp.einsum('bhqk,bhkd->bhqd', p_own, v_own))

    out = lax.map(chunk_attend, (chunked(q), chunked(sel_idx), chunked(sel_valid),
                                 jnp.arange(nc, dtype=jnp.int32)))
    out = jnp.moveaxis(out, 0, 2).reshape(B, N_HEADS_MOBA, s_pad, HEAD_DIM)
    return out.transpose(0, 2, 1, 3)[:, :S].reshape(B, S, W_MOBA)


def clamped_swiglu(h):
    glu = jnp.minimum(h[..., 0::2], SWIGLU_LIMIT)
    lin = jnp.clip(h[..., 1::2], -SWIGLU_LIMIT, SWIGLU_LIMIT)
    return glu * jax.nn.sigmoid(SWIGLU_ALPHA * glu) * (lin + 1.0)


def moe_ffn(h, w_router, b_router, w1, b1, w2, b2):
    T, D = h.shape
    logits = (h @ w_router + b_router).astype(jnp.float32)
    top_vals, top_idx = lax.top_k(logits, TOP_K)
    gates = jax.nn.softmax(top_vals, axis=-1)
    n_assign = T * TOP_K
    e_flat = top_idx.reshape(n_assign)
    order = jnp.argsort(e_flat)
    e_sorted = e_flat[order]
    tok_sorted = order // TOP_K
    gate_sorted = gates.reshape(n_assign)[order]
    counts = jnp.bincount(e_flat, length=N_EXPERTS)
    offsets = jnp.cumsum(counts) - counts
    padded = (counts + EXPERT_BLOCK - 1) // EXPERT_BLOCK * EXPERT_BLOCK
    padded_end = jnp.cumsum(padded)
    padded_off = padded_end - padded
    dest = padded_off[e_sorted] + (jnp.arange(n_assign) - offsets[e_sorted])
    n_blocks = -(-n_assign // EXPERT_BLOCK) + N_EXPERTS
    rows = n_blocks * EXPERT_BLOCK
    xbuf = jnp.zeros((rows, D), h.dtype).at[dest].set(h[tok_sorted])
    block_start = jnp.arange(n_blocks) * EXPERT_BLOCK
    block_expert = jnp.minimum(jnp.searchsorted(padded_end, block_start, side='right'), N_EXPERTS - 1)

    def expert_block(args):
        xb, e = args
        act = clamped_swiglu(xb @ w1[e] + b1[e])
        return act @ w2[e] + b2[e]

    ybuf = lax.map(expert_block, (xbuf.reshape(n_blocks, EXPERT_BLOCK, D), block_expert)).reshape(rows, D)
    contrib = gate_sorted.astype(h.dtype)[:, None] * ybuf[dest]
    return jnp.zeros((T, D), h.dtype).at[tok_sorted].add(contrib)


def setup_inputs(seed: int = 0) -> dict:
    key = jax.random.key(seed)
    ks = jax.random.split(key, 16)
    f32 = jnp.float32

    def nrm(k, shape, scale):
        return scale * jax.random.normal(k, shape, f32)

    x = jax.random.normal(ks[0], (BATCH, SEQ, D_MODEL), f32)
    col_scale = jnp.concatenate([
        jnp.ones((W_Q_SWA + W_KV_SWA,), f32), jnp.full((W_KV_SWA,), DEEPNORM_BETA, f32),
        jnp.ones((2 * W_MOBA,), f32), jnp.full((W_MOBA,), DEEPNORM_BETA, f32)])
    w_in = nrm(ks[1], (DEPTH, D_MODEL, IN_WIDTH), D_MODEL ** -0.5) * col_scale
    b_in = nrm(ks[2], (DEPTH, IN_WIDTH), 0.02)
    sinks = nrm(ks[3], (DEPTH, N_HEADS_SWA), 1.0)
    w_out = nrm(ks[4], (DEPTH, MIX_WIDTH, D_MODEL), MIX_WIDTH ** -0.5 * DEEPNORM_BETA)
    b_out = nrm(ks[5], (DEPTH, D_MODEL), 0.02)
    ln1_g = 1.0 + nrm(ks[6], (DEPTH, D_MODEL), 0.02)
    ln1_b = nrm(ks[7], (DEPTH, D_MODEL), 0.02)
    w_router = nrm(ks[8], (DEPTH, D_MODEL, N_EXPERTS), D_MODEL ** -0.5)
    b_router = nrm(ks[9], (DEPTH, N_EXPERTS), 0.01)
    w1 = nrm(ks[10], (DEPTH, N_EXPERTS, D_MODEL, 2 * D_FF), D_MODEL ** -0.5 * DEEPNORM_BETA)
    b1 = nrm(ks[11], (DEPTH, N_EXPERTS, 2 * D_FF), 0.02)
    w2 = nrm(ks[12], (DEPTH, N_EXPERTS, D_FF, D_MODEL), D_FF ** -0.5 * DEEPNORM_BETA)
    b2 = nrm(ks[13], (DEPTH, N_EXPERTS, D_MODEL), 0.02)
    ln2_g = 1.0 + nrm(ks[14], (DEPTH, D_MODEL), 0.02)
    ln2_b = nrm(ks[15], (DEPTH, D_MODEL), 0.02)
    return {'x': x, 'w_in': w_in, 'b_in': b_in, 'sinks': sinks, 'w_out': w_out, 'b_out': b_out,
            'ln1_g': ln1_g, 'ln1_b': ln1_b, 'w_router': w_router, 'b_router': b_router,
            'w1': w1, 'b1': b1, 'w2': w2, 'b2': b2, 'ln2_g': ln2_g, 'ln2_b': ln2_b}


def reference(x, w_in, b_in, sinks, w_out, b_out, ln1_g, ln1_b, w_router, b_router,
              w1, b1, w2, b2, ln2_g, ln2_b):
    B, S, D = x.shape
    cos, sin = rope_tables(S, x.dtype)
    for l in range(DEPTH):
        proj = x @ w_in[l] + b_in[l]
        q_a, k_a, v_a, q_b, k_b, v_b = jnp.split(proj, SPLITS, axis=-1)
        q_a = apply_rope(q_a.reshape(B, S, N_HEADS_SWA, HEAD_DIM), cos, sin)
        k_a = apply_rope(k_a.reshape(B, S, N_KV_SWA, HEAD_DIM), cos, sin)
        v_a = v_a.reshape(B, S, N_KV_SWA, HEAD_DIM)
        q_b = apply_rope(q_b.reshape(B, S, N_HEADS_MOBA, HEAD_DIM), cos, sin)
        k_b = apply_rope(k_b.reshape(B, S, N_HEADS_MOBA, HEAD_DIM), cos, sin)
        v_b = v_b.reshape(B, S, N_HEADS_MOBA, HEAD_DIM)
        o_a = sliding_window_sink_attention(q_a, k_a, v_a, sinks[l])
        o_b = moba_attention(q_b, k_b, v_b)
        mix = jnp.concatenate([o_a, o_b], axis=-1) @ w_out[l] + b_out[l]
        x = layer_norm(DEEPNORM_ALPHA * x + mix, ln1_g[l], ln1_b[l])
        moe = moe_ffn(x.reshape(B * S, D), w_router[l], b_router[l], w1[l], b1[l], w2[l], b2[l]).reshape(B, S, D)
        x = layer_norm(DEEPNORM_ALPHA * x + moe, ln2_g[l], ln2_b[l])
    return x
```

```cpp
#include <hip/hip_runtime.h>
#include <hip/hip_cooperative_groups.h>
#include <cstdio>
#include <cstdint>
namespace cg = cooperative_groups;

#define LAS __attribute__((address_space(3)))
typedef unsigned short bf16_t;
typedef short bf16x8 __attribute__((ext_vector_type(8)));
typedef short s16x4 __attribute__((ext_vector_type(4)));
typedef float f32x2 __attribute__((ext_vector_type(2)));
typedef float f32x4 __attribute__((ext_vector_type(4)));
typedef float f32x16 __attribute__((ext_vector_type(16)));
typedef unsigned u32x2 __attribute__((ext_vector_type(2)));
typedef unsigned u32x4 __attribute__((ext_vector_type(4)));
typedef __bf16 bf16x2_t __attribute__((ext_vector_type(2)));

constexpr int D = 1024, BATCH = 32, SEQ = 2048, T = BATCH * SEQ;
constexpr int INW = 2304, NE = 32;
constexpr float LN_EPS = 1e-5f;
constexpr float DN_ALPHA = 1.189207115002721f;
constexpr float LOG2E = 1.4426950408889634f;
constexpr float C2 = 0.18033688011112042f;
constexpr int NTHREADS = 512;
constexpr int LDS_BYTES = 147456;
constexpr int MAX_TILES = 1056;
#ifndef DUP_MASK
#define DUP_MASK 0
#endif
#define REP(k) for (int _rep = 0; _rep < (((DUP_MASK >> (k)) & 1) ? 2 : 1); ++_rep)

constexpr size_t MiB = 1u << 20;
constexpr size_t WS_CTL = 0, CTL_ZERO_BYTES = 2 * MiB;
constexpr size_t WS_KSUM = 1 * MiB;
constexpr size_t WS_ROPE = 2 * MiB;
constexpr size_t WS_WIN_T = 4 * MiB;
constexpr size_t WS_WOUT_T = 9 * MiB;
constexpr size_t WS_SMALL = 11 * MiB;
constexpr size_t WS_CNT = WS_SMALL, WS_TILE_E = WS_SMALL + 65536, WS_WR_HI = WS_SMALL + 131072, WS_WR_LO = WS_WR_HI + 65536;
constexpr size_t WS_TOK = 12 * MiB;
constexpr size_t WS_ASG_E = 14 * MiB, WS_ASG_G = 15 * MiB, WS_ASG_D = 16 * MiB;
constexpr size_t WS_W2_T = 24 * MiB;
constexpr size_t WS_X1B = 88 * MiB;
constexpr size_t WS_ACT2 = 216 * MiB;
constexpr size_t WS_XB = 216 * MiB;
constexpr size_t WS_X1LO = 344 * MiB;
constexpr size_t WS_YB = 488 * MiB;
constexpr size_t WS_W1_T = 488 * MiB;
constexpr size_t WS_QKV = 616 * MiB;
constexpr size_t WS_END = 1016 * MiB;
constexpr int ACT_SPLIT_TILES = 512;
constexpr int CW_NTILES = 16;

struct Params {
    const float *x, *w_in, *b_in, *sinks, *w_out, *b_out, *ln1_g, *ln1_b, *w_router, *b_router, *w1, *b1, *w2, *b2, *ln2_g, *ln2_b;
    float* out; unsigned char* ws;
};

__device__ __forceinline__ unsigned f2bf(float f) { unsigned u = __builtin_bit_cast(unsigned, f); return (u + 0x7fffu + ((u >> 16) & 1u)) >> 16; }
__device__ __forceinline__ float bf2f(unsigned h) { return __builtin_bit_cast(float, h << 16); }
__device__ __forceinline__ unsigned cvtpk(float lo, float hi) { f32x2 v = {lo, hi}; bf16x2_t b = __builtin_convertvector(v, bf16x2_t); return __builtin_bit_cast(unsigned, b); }
__device__ __forceinline__ float wave_sum(float v) {
#pragma unroll
    for (int o = 1; o < 64; o <<= 1) v += __shfl_xor(v, o);
    return v;
}
#define LDS_WAIT() asm volatile("s_waitcnt lgkmcnt(0)" ::: "memory")

namespace pg8 {
constexpr int BM = 256, BK = 64, HALF = 128, HTB = HALF * BK * 2, STAGE_BYTES = 8 * HTB, NXCD = 8, WGM = 8;
constexpr int KD = 1024;
__host__ __device__ __forceinline__ int lds_byte(int r, int c) { const int st = (r >> 4) * 2 + (c >> 5), rr = r & 15, cc = c & 31, ob = rr * 64 + cc * 2; return st * 1024 + (ob ^ (((ob >> 9) & 1) << 5)); }
__host__ __device__ __forceinline__ void stage_rc(int b, int& R, int& C) { const int st = b / 1024, sb = b % 1024, swz = sb ^ (((sb >> 9) & 1) << 5); R = (st >> 1) * 16 + swz / 64; C = (st & 1) * 32 + (swz % 64) / 2; }
__host__ __device__ __forceinline__ int perm32(int rho) { const int n = rho >> 4, i = rho & 15; return 8 * (i >> 2) + 4 * n + (i & 3); }

struct Unit { int pm, pn, e; const char* A; const char* B; const int* rows; };

template <class Epi, class Sched, bool GATHER, bool ALIGN_EPI>
__device__ __forceinline__ void gemm_phase(LAS unsigned char* lds, const Sched& S, const Epi& E) {
    int tid = threadIdx.x; asm volatile("" : "+v"(tid));
    const int wid = __builtin_amdgcn_readfirstlane(tid >> 6), lane = tid & 63, wr = wid >> 2, wc = wid & 3, fr = lane & 15, fq = lane >> 4;
    constexpr int K = KD, nt = K / BK;
    unsigned voffB[2], Vc[2][2], Vn[2][2]; int stR0, stC0;
    { int R, C; stage_rc(tid * 16, R, C); stR0 = R; stC0 = C; }
#pragma unroll
    for (int i = 0; i < 2; ++i) { voffB[i] = (unsigned)((stR0 + 64 * i) * K + stC0) * 2u; Vc[0][i] = voffB[i]; Vc[1][i] = voffB[i]; Vn[0][i] = voffB[i]; Vn[1][i] = voffB[i]; }
#define PG8_GATHER_LOAD(VV, rowsp) do { int _t = threadIdx.x; asm volatile("" : "+v"(_t)); int _R, _C; stage_rc(_t * 16, _R, _C);     \
        const int* _rp = (const int*)((const char*)(rowsp) + (unsigned)(_R * 4)); _Pragma("unroll") for (int _h = 0; _h < 2; ++_h) _Pragma("unroll") for (int _i = 0; _i < 2; ++_i) \
        VV[_h][_i] = ((unsigned)_rp[128 * _h + 64 * _i] * (unsigned)K + (unsigned)_C) * 2u; } while (0)
    constexpr size_t kstep = (size_t)(BK * 2);
    constexpr size_t hstep = (size_t)HALF * K * 2;
    const unsigned ldsw = (unsigned)wid * 1024u;
    const int aoff = lds_byte(wr * 64 + fr, fq * 8), boff = lds_byte(wc * 32 + fr, fq * 8);
#define PG8_SA(b, h) (((b) * 2 + (h)) * HTB)
#define PG8_SB(b, h) ((4 + (b) * 2 + (h)) * HTB)
#define PG8_STAGE(bufoff, gbase, voff) do { _Pragma("unroll") for (int _i = 0; _i < 2; ++_i) \
        __builtin_amdgcn_global_load_lds((const unsigned*)((const char*)(gbase) + (voff)[_i]), (LAS unsigned*)(lds + (bufoff) + ldsw + _i * 8192), 16, 0, 0); } while (0)
#define PG8_STAGE_A(bufoff, gbase, h, VV) do { if constexpr (GATHER) { PG8_STAGE(bufoff, gbase, VV[h]); } else { PG8_STAGE(bufoff, (gbase) + (h) * hstep, voffB); } } while (0)
#define PG8_LDA(dst, b, h) do { _Pragma("unroll") for (int m = 0; m < 4; ++m) _Pragma("unroll") for (int k = 0; k < 2; ++k) dst[m][k] = *(const LAS bf16x8*)(lds + PG8_SA(b, h) + aoff + m * 2048 + k * 1024); } while (0)
#define PG8_LDB(dst, b, h) do { _Pragma("unroll") for (int n = 0; n < 2; ++n) _Pragma("unroll") for (int k = 0; k < 2; ++k) dst[n][k] = *(const LAS bf16x8*)(lds + PG8_SB(b, h) + boff + n * 2048 + k * 1024); } while (0)
#define PG8_MMA(ai, bj, At, Bt) do { __builtin_amdgcn_s_setprio(1); _Pragma("unroll") for (int m = 0; m < 4; ++m) _Pragma("unroll") for (int n = 0; n < 2; ++n) _Pragma("unroll") for (int k = 0; k < 2; ++k) \
        acc[ai][bj][m][n] = __builtin_amdgcn_mfma_f32_16x16x32_bf16(Bt[n][k], At[m][k], acc[ai][bj][m][n], 0, 0, 0); __builtin_amdgcn_s_setprio(0); } while (0)
#define PG8_WAIT_V(n) asm volatile("s_waitcnt vmcnt(" #n ")" ::: "memory")
#define PG8_WAIT_L(n) asm volatile("s_waitcnt lgkmcnt(" #n ")" ::: "memory")
#define PG8_BAR __builtin_amdgcn_s_barrier()
#define PG8_SCHED __builtin_amdgcn_sched_barrier(0)
    Unit cur, nxt; int ui = 0;
    if (!S.next(0, cur)) return;
    if constexpr (GATHER) { PG8_GATHER_LOAD(Vc, cur.rows); }
    f32x4 acc[2][2][4][2];
#pragma unroll
    for (int a = 0; a < 2; ++a)
#pragma unroll
        for (int b = 0; b < 2; ++b)
#pragma unroll
            for (int m = 0; m < 4; ++m)
#pragma unroll
                for (int n = 0; n < 2; ++n) acc[a][b][m][n] = (f32x4){0.f, 0.f, 0.f, 0.f};
    bf16x8 At[4][2], B0[2][2], B1[2][2];
    const char* cA = cur.A; const char* cB = cur.B;
    PG8_STAGE(PG8_SB(0, 0), cB, voffB); PG8_STAGE(PG8_SB(0, 1), cB + hstep, voffB); PG8_STAGE_A(PG8_SA(0, 0), cA, 0, Vc); PG8_STAGE_A(PG8_SA(0, 1), cA, 1, Vc);
    if (wr == 1) PG8_BAR;
    PG8_WAIT_V(2); PG8_BAR;
    PG8_STAGE(PG8_SB(1, 0), cB + kstep, voffB); PG8_STAGE_A(PG8_SA(1, 0), cA + kstep, 0, Vc); PG8_STAGE(PG8_SB(1, 1), cB + hstep + kstep, voffB);
    PG8_WAIT_V(6); PG8_BAR;
    for (;;) {
        const bool has_next = S.next(ui + 1, nxt);
        const char* nA = has_next ? nxt.A : cA; const char* nB = has_next ? nxt.B : cB;
        if constexpr (GATHER) {
            if (has_next) { PG8_GATHER_LOAD(Vn, nxt.rows); }
            else {
#pragma unroll
                for (int i = 0; i < 2; ++i) { Vn[0][i] = Vc[0][i]; Vn[1][i] = Vc[1][i]; }
            }
        }
        for (int t = 0; t < nt; t += 2) {
            const bool last = (t == nt - 2);
            const char* a1 = cA + (size_t)(t + 1) * kstep;
            const char* a2 = last ? nA : cA + (size_t)(t + 2) * kstep; const char* b2 = last ? nB : cB + (size_t)(t + 2) * kstep;
            const char* a3 = a2 + kstep; const char* b3 = b2 + kstep;
            PG8_LDB(B0, 0, 0); PG8_LDB(B1, 0, 1); PG8_SCHED; PG8_LDA(At, 0, 0); PG8_STAGE_A(PG8_SA(1, 1), a1, 1, Vc);
            if constexpr (GATHER) { if (last) {
#pragma unroll
                for (int i = 0; i < 2; ++i) { Vc[0][i] = Vn[0][i]; Vc[1][i] = Vn[1][i]; } } }
            PG8_WAIT_V(8); PG8_WAIT_L(0); PG8_BAR; PG8_MMA(0, 0, At, B0); PG8_MMA(0, 1, At, B1); PG8_BAR; PG8_SCHED;
            PG8_LDA(At, 0, 1); PG8_STAGE(PG8_SB(0, 0), b2, voffB); PG8_STAGE(PG8_SB(0, 1), b2 + hstep, voffB); PG8_STAGE_A(PG8_SA(0, 0), a2, 0, Vc);
            PG8_WAIT_V(8); PG8_WAIT_L(0); PG8_BAR; PG8_MMA(1, 0, At, B0); PG8_MMA(1, 1, At, B1); PG8_BAR; PG8_SCHED;
            PG8_LDB(B0, 1, 0); PG8_LDB(B1, 1, 1); PG8_SCHED; PG8_LDA(At, 1, 0); PG8_STAGE_A(PG8_SA(0, 1), a2, 1, Vc);
            PG8_WAIT_V(8); PG8_WAIT_L(0); PG8_BAR; PG8_MMA(0, 0, At, B0); PG8_MMA(0, 1, At, B1); PG8_BAR; PG8_SCHED;
            PG8_LDA(At, 1, 1); PG8_STAGE(PG8_SB(1, 0), b3, voffB); PG8_STAGE(PG8_SB(1, 1), b3 + hstep, voffB); PG8_STAGE_A(PG8_SA(1, 0), a3, 0, Vc);
            PG8_WAIT_V(8); PG8_WAIT_L(0); PG8_BAR; PG8_MMA(1, 0, At, B0); PG8_MMA(1, 1, At, B1); PG8_BAR; PG8_SCHED;
        }
        if constexpr (ALIGN_EPI) { if (wr == 0) PG8_BAR; }
        E(acc, cur, wr, wc, fr, fq);
        if (!has_next) break;
#pragma unroll
        for (int a = 0; a < 2; ++a)
#pragma unroll
            for (int b = 0; b < 2; ++b)
#pragma unroll
                for (int m = 0; m < 4; ++m)
#pragma unroll
                    for (int n = 0; n < 2; ++n) acc[a][b][m][n] = (f32x4){0.f, 0.f, 0.f, 0.f};
        cur = nxt; cA = nA; cB = nB; ++ui;
        if constexpr (ALIGN_EPI) { if (wr == 1) PG8_BAR; }
    }
    PG8_WAIT_V(0);
    if constexpr (!ALIGN_EPI) { if (wr == 0) PG8_BAR; }
    PG8_BAR;
#undef PG8_SA
#undef PG8_SB
#undef PG8_STAGE
#undef PG8_STAGE_A
#undef PG8_GATHER_LOAD
#undef PG8_LDA
#undef PG8_LDB
#undef PG8_MMA
#undef PG8_WAIT_V
#undef PG8_WAIT_L
#undef PG8_BAR
#undef PG8_SCHED
}

struct SchedInProj {
    const char* A; const char* B; int G, c;
    __device__ __forceinline__ bool next(int i, Unit& u) const {
        constexpr int nM = T / BM, nN = INW / BM, nwg = nM * nN;
        const long L = (long)i * G + c; if (L >= nwg) return false;
        int wgid = (int)L; { const int q = nwg / NXCD, r = nwg % NXCD, xcd = wgid % NXCD, off = wgid / NXCD; wgid = (xcd < r ? xcd * (q + 1) : r * (q + 1) + (xcd - r) * q) + off; }
        const int nig = WGM * nN, gid = wgid / nig, fm = gid * WGM, gsz = (nM - fm) < WGM ? (nM - fm) : WGM;
        u.pm = fm + ((wgid % nig) % gsz); u.pn = (wgid % nig) / gsz; u.e = 0; u.rows = nullptr;
        u.A = A + (size_t)u.pm * (2 * HALF * KD * 2); u.B = B + (size_t)u.pn * (2 * HALF * KD * 2); return true;
    }
};
struct SchedPanel {
    const char* A; const char* B; int pm;
    __device__ __forceinline__ bool next(int i, Unit& u) const {
        if (i >= 4) return false;
        u.pm = pm; u.pn = i; u.e = 0; u.rows = nullptr; u.A = A + (size_t)pm * (256 * KD * 2); u.B = B + (size_t)i * (256 * KD * 2); return true;
    }
};
template <int NPN, bool G1>
struct SchedMoe {
    const char* A0; const char* A1; const char* B; const int* tile_e; const int* tok; int ntiles, G, c;
    __device__ __forceinline__ bool next(int i, Unit& u) const {
        const long L = (long)i * G + c; int t, pn;
        if ((G & 7) == 0) { const int x = (int)(L & 7); const long j = L >> 3; t = (int)(j / NPN) * 8 + x; pn = (int)(j % NPN); }
        else { t = (int)(L / NPN); pn = (int)(L % NPN); }
        if (t >= ntiles) return false;
        const int e = tile_e[t];
        u.pm = t; u.pn = pn; u.e = e;
        if (G1) { u.A = A0; u.rows = tok + (size_t)t * 256; u.B = B + ((size_t)e * 2048 + (size_t)pn * 256) * (KD * 2); }
        else { u.A = (t < ACT_SPLIT_TILES) ? A0 + (size_t)t * (256 * KD * 2) : A1 + (size_t)(t - ACT_SPLIT_TILES) * (256 * KD * 2); u.rows = nullptr; u.B = B + ((size_t)e * 1024 + (size_t)pn * 256) * (KD * 2); }
        return true;
    }
};

struct EpiInProj {
    bf16_t* qkv; const float* b_in; const float* rope; float* ksum;
    __device__ __forceinline__ void operator()(const f32x4 (&acc)[2][2][4][2], const Unit& u, int wr, int wc, int fr, int fq) const {
        const int pn = u.pn;
        const int colb = 256 * pn + 64 * wc + 8 * fq;
        const bool do_rope = !(pn >= 7 || (pn == 2 && wc >= 2));
        const bool is_q = (pn < 2) || (pn == 3) || (pn == 4);
        const bool is_kb = (pn == 5) || (pn == 6);
        const float sc = is_q ? C2 : 1.0f;
        f32x4 bv[2][2];
#pragma unroll
        for (int bj = 0; bj < 2; ++bj)
#pragma unroll
            for (int n = 0; n < 2; ++n) bv[bj][n] = *(const f32x4*)(b_in + colb + 32 * bj + 4 * n);
        f32x4 ks[2][2];
#pragma unroll
        for (int bj = 0; bj < 2; ++bj)
#pragma unroll
            for (int n = 0; n < 2; ++n) ks[bj][n] = (f32x4){0.f, 0.f, 0.f, 0.f};
#pragma unroll
        for (int ai = 0; ai < 2; ++ai)
#pragma unroll
            for (int m = 0; m < 4; ++m) {
                const int row = u.pm * 256 + ai * 128 + wr * 64 + m * 16 + fr;
                const int pos = row & (SEQ - 1);
                f32x4 o1[2], o2[2];
#pragma unroll
                for (int n = 0; n < 2; ++n) { o1[n] = acc[ai][0][m][n] + bv[0][n]; o2[n] = acc[ai][1][m][n] + bv[1][n]; }
                if (do_rope) {
                    const float* rp = rope + pos * 64 + 8 * fq;
#pragma unroll
                    for (int n = 0; n < 2; ++n) { const f32x4 c = *(const f32x4*)(rp + 4 * n), s = *(const f32x4*)(rp + 32 + 4 * n);
                        const f32x4 a = o1[n], b = o2[n]; o1[n] = a * c - b * s; o2[n] = b * c + a * s; }
                }
                if (is_kb) {
#pragma unroll
                    for (int n = 0; n < 2; ++n) { ks[0][n] += o1[n]; ks[1][n] += o2[n]; }
                }
                bf16_t* rowp = qkv + (size_t)row * INW + colb;
                u32x4 w1, w2;
                w1.x = cvtpk(o1[0][0] * sc, o1[0][1] * sc); w1.y = cvtpk(o1[0][2] * sc, o1[0][3] * sc); w1.z = cvtpk(o1[1][0] * sc, o1[1][1] * sc); w1.w = cvtpk(o1[1][2] * sc, o1[1][3] * sc);
                w2.x = cvtpk(o2[0][0] * sc, o2[0][1] * sc); w2.y = cvtpk(o2[0][2] * sc, o2[0][3] * sc); w2.z = cvtpk(o2[1][0] * sc, o2[1][1] * sc); w2.w = cvtpk(o2[1][2] * sc, o2[1][3] * sc);
                *(u32x4*)(rowp) = w1; *(u32x4*)(rowp + 32) = w2;
            }
        if (is_kb) {
            float* kd = ksum + (size_t)u.pm * 512 + 256 * (pn - 5) + 64 * wc + 8 * fq;
#pragma unroll
            for (int bj = 0; bj < 2; ++bj)
#pragma unroll
                for (int n = 0; n < 2; ++n)
#pragma unroll
                    for (int j = 0; j < 4; ++j) {
                        float v = ks[bj][n][j];
                        v += __shfl_xor(v, 1); v += __shfl_xor(v, 2); v += __shfl_xor(v, 4); v += __shfl_xor(v, 8);
                        if (fr == 0) atomicAdd(kd + 32 * bj + 4 * n + j, v);
                    }
        }
    }
};
struct EpiOutProj {
    float* y; const float* b_out; const float* x;
    __device__ __forceinline__ void operator()(const f32x4 (&acc)[2][2][4][2], const Unit& u, int wr, int wc, int fr, int fq) const {
        const int col0 = u.pn * 256 + wc * 32 + 8 * fq;
        f32x4 bv[2][2];
#pragma unroll
        for (int bj = 0; bj < 2; ++bj)
#pragma unroll
            for (int n = 0; n < 2; ++n) bv[bj][n] = *(const f32x4*)(b_out + col0 + 128 * bj + 4 * n);
#pragma unroll
        for (int ai = 0; ai < 2; ++ai)
#pragma unroll
            for (int m = 0; m < 4; ++m) {
                const size_t off = (size_t)(u.pm * 256 + ai * 128 + wr * 64 + m * 16 + fr) * D + col0;
#pragma unroll
                for (int bj = 0; bj < 2; ++bj)
#pragma unroll
                    for (int n = 0; n < 2; ++n) { const f32x4 xv = *(const f32x4*)(x + off + 128 * bj + 4 * n);
                        *(f32x4*)(y + off + 128 * bj + 4 * n) = acc[ai][bj][m][n] + bv[bj][n] + xv * DN_ALPHA; }
                if (m & 1) asm volatile("" ::: "memory");
            }
    }
};
struct EpiSwiglu {
    unsigned char* act0; unsigned char* act1; const float* b1;
    __device__ __forceinline__ void operator()(const f32x4 (&acc)[2][2][4][2], const Unit& u, int wr, int wc, int fr, int fq) const {
        const int a0 = 128 * u.pn + 32 * wc + 8 * fq;
        const float* bp = b1 + (size_t)u.e * 2048 + 2 * a0;
        f32x4 bb[4];
#pragma unroll
        for (int q = 0; q < 4; ++q) bb[q] = *(const f32x4*)(bp + 4 * q);
        unsigned char* tile = (u.pm < ACT_SPLIT_TILES) ? act0 + (size_t)u.pm * (256 * 2048) : act1 + (size_t)(u.pm - ACT_SPLIT_TILES) * (256 * 2048);
#pragma unroll
        for (int ai = 0; ai < 2; ++ai)
#pragma unroll
            for (int m = 0; m < 4; ++m) {
                const int row = ai * 128 + wr * 64 + m * 16 + fr;
                float r[8];
#pragma unroll
                for (int n = 0; n < 2; ++n)
#pragma unroll
                    for (int j = 0; j < 4; ++j) {
                        const int q = 4 * n + j;
                        float g = acc[ai][0][m][n][j] + bb[q >> 1][(2 * q) & 3];
                        float l = acc[ai][1][m][n][j] + bb[q >> 1][((2 * q) & 3) + 1];
                        g = fminf(g, 7.0f); l = fminf(fmaxf(l, -7.0f), 7.0f);
                        const float sg = __builtin_amdgcn_rcpf(1.0f + __builtin_amdgcn_exp2f(-1.702f * LOG2E * g));
                        r[q] = g * sg * (l + 1.0f);
                    }
                u32x4 w; w.x = cvtpk(r[0], r[1]); w.y = cvtpk(r[2], r[3]); w.z = cvtpk(r[4], r[5]); w.w = cvtpk(r[6], r[7]);
                *(u32x4*)(tile + (size_t)row * 2048 + (size_t)a0 * 2) = w;
            }
    }
};
struct EpiDown {
    bf16_t* yb; const float* b2;
    __device__ __forceinline__ void operator()(const f32x4 (&acc)[2][2][4][2], const Unit& u, int wr, int wc, int fr, int fq) const {
        const int col0 = u.pn * 256 + wc * 32 + 8 * fq;
        const float* bp = b2 + (size_t)u.e * 1024 + col0;
        f32x4 bv[2][2];
#pragma unroll
        for (int bj = 0; bj < 2; ++bj)
#pragma unroll
            for (int n = 0; n < 2; ++n) bv[bj][n] = *(const f32x4*)(bp + 128 * bj + 4 * n);
#pragma unroll
        for (int ai = 0; ai < 2; ++ai)
#pragma unroll
            for (int m = 0; m < 4; ++m) {
                bf16_t* rowp = yb + (size_t)(u.pm * 256 + ai * 128 + wr * 64 + m * 16 + fr) * 1024 + col0;
#pragma unroll
                for (int bj = 0; bj < 2; ++bj) { const f32x4 v0 = acc[ai][bj][m][0] + bv[bj][0], v1 = acc[ai][bj][m][1] + bv[bj][1];
                    u32x4 w; w.x = cvtpk(v0[0], v0[1]); w.y = cvtpk(v0[2], v0[3]); w.z = cvtpk(v1[0], v1[1]); w.w = cvtpk(v1[2], v1[3]);
                    *(u32x4*)(rowp + 128 * bj) = w; }
            }
    }
};
}

namespace att {
constexpr int PITCH = INW, SLOTB = 8192;
constexpr int L_K = 0, L_V = 2 * SLOTB, L_WS = 4 * SLOTB, L_KS = L_WS + 2048, L_OST = L_KS + 2048, L_END = L_OST + 8 * 4096;
constexpr float NEG = -1.0e30f, M0 = -1.0e20f;
typedef LAS const char* lds_cptr;
__device__ __forceinline__ int crow(int r, int hi) { return (r & 3) + 8 * (r >> 2) + 4 * hi; }
__device__ __forceinline__ void glds16(const void* gsrc, unsigned lds_dst) { unsigned keep;
    asm volatile("s_mov_b32 %0, m0\n\ts_mov_b32 m0, %2\n\ts_nop 0\n\tglobal_load_lds_dwordx4 %1, off\n\ts_mov_b32 m0, %0" : "=&s"(keep) : "v"(gsrc), "s"(lds_dst) : "memory"); }
#define ATT_WAIT_BAR0() asm volatile("s_waitcnt vmcnt(0) lgkmcnt(0)\n\ts_barrier" ::: "memory")
#define ATT_SBAR() __builtin_amdgcn_sched_barrier(0)

__device__ __forceinline__ void qkt(f32x16& p0, f32x16& p1, lds_cptr kb, const bf16x8* qr) {
    const f32x16 z = {};
#pragma unroll
    for (int d0 = 0; d0 < 4; ++d0) {
        const bf16x8 b0 = *(const LAS bf16x8*)(kb + d0 * 2048);
        const bf16x8 b1 = *(const LAS bf16x8*)(kb + d0 * 2048 + 512);
        if (d0 == 0) { p0 = __builtin_amdgcn_mfma_f32_32x32x16_bf16(b0, qr[0], z, 0, 0, 0); p1 = __builtin_amdgcn_mfma_f32_32x32x16_bf16(b1, qr[0], z, 0, 0, 0); }
        else { p0 = __builtin_amdgcn_mfma_f32_32x32x16_bf16(b0, qr[d0], p0, 0, 0, 0); p1 = __builtin_amdgcn_mfma_f32_32x32x16_bf16(b1, qr[d0], p1, 0, 0, 0); }
    }
}
__device__ __forceinline__ float rowmax32(const f32x16& p0, const f32x16& p1) {
    float a = fmaxf(p0[0], p1[0]);
#pragma unroll
    for (int r = 1; r < 16; ++r) a = fmaxf(a, fmaxf(p0[r], p1[r]));
    auto rr = __builtin_amdgcn_permlane32_swap(__float_as_uint(a), __float_as_uint(a), false, false);
    return fmaxf(__uint_as_float(rr[0]), __uint_as_float(rr[1]));
}
__device__ __forceinline__ void pv(f32x16* o, int vb, bf16x8 pa0, bf16x8 pa1, bf16x8 pa2, bf16x8 pa3) {
#pragma unroll
    for (int d0 = 0; d0 < 2; ++d0) { s16x4 lo[4], hi[4];
#pragma unroll
        for (int ks = 0; ks < 4; ++ks) {
            asm volatile("ds_read_b64_tr_b16 %0,%1 offset:%c2" : "=&v"(lo[ks]) : "v"(vb), "i"(d0 * 4096 + ks * 1024) : "memory");
            asm volatile("ds_read_b64_tr_b16 %0,%1 offset:%c2" : "=&v"(hi[ks]) : "v"(vb), "i"(d0 * 4096 + ks * 1024 + 512) : "memory"); }
        asm volatile("s_waitcnt lgkmcnt(0)" ::: "memory"); ATT_SBAR();
#define ATT_PK(k) (bf16x8){lo[k][0], lo[k][1], lo[k][2], lo[k][3], hi[k][0], hi[k][1], hi[k][2], hi[k][3]}
        o[d0] = __builtin_amdgcn_mfma_f32_32x32x16_bf16(pa0, ATT_PK(0), o[d0], 0, 0, 0);
        o[d0] = __builtin_amdgcn_mfma_f32_32x32x16_bf16(pa1, ATT_PK(1), o[d0], 0, 0, 0);
        o[d0] = __builtin_amdgcn_mfma_f32_32x32x16_bf16(pa2, ATT_PK(2), o[d0], 0, 0, 0);
        o[d0] = __builtin_amdgcn_mfma_f32_32x32x16_bf16(pa3, ATT_PK(3), o[d0], 0, 0, 0);
#undef ATT_PK
    }
}

template <bool MOBA>
__device__ __forceinline__ void attn_item(char* shm, const bf16_t* __restrict__ qkv, bf16_t* __restrict__ aout, int b, int hh, int qb, const float* __restrict__ sinks, const float* __restrict__ ksum) {
    int tid = threadIdx.x; asm volatile("" : "+v"(tid));
    const int lane = tid & 63, r32 = lane & 31, hi = lane >> 5; const int wid = __builtin_amdgcn_readfirstlane(tid >> 6);
    const long rowbase = (long)b * SEQ;
    int qa, qcol, kcol, vcol, ocol, kt0, kt1;
    if (MOBA) { qa = 256 * qb + 32 * wid; qcol = 768 + 64 * hh; kcol = 1280 + 64 * hh; vcol = 1792 + 64 * hh; ocol = 512 + 64 * hh; kt0 = 0; kt1 = 4 * qb + 4; }
    else { const int g = wid >> 1; qa = 64 * qb + 32 * (wid & 1); qcol = (4 * hh + g) * 64; kcol = 512 + 64 * hh; vcol = 640 + 64 * hh; ocol = qcol; kt0 = qb - 2 < 0 ? 0 : qb - 2; kt1 = qb + 1; }
    const bf16_t* Qw = qkv + (rowbase + qa) * PITCH + qcol;
    const bf16_t* Kh = qkv + rowbase * PITCH + kcol; const bf16_t* Vh = qkv + rowbase * PITCH + vcol;
    const unsigned lds0 = (unsigned)(uintptr_t)shm;
    float* wsf = (float*)(shm + L_WS) + wid * 64;
    const bf16_t* ksrc = Kh + (long)lane * PITCH + wid * 8;
    const bf16_t* vsrc = Vh + (long)(16 * (wid & 3) + (lane >> 2)) * PITCH + (wid >> 2) * 32 + (lane & 3) * 8;
    const unsigned kdst = lds0 + L_K + wid * 1024, vdst = lds0 + L_V + wid * 1024;
#define ATT_DMA_K(t, slot) glds16(ksrc + (long)(t) * 64 * PITCH, (unsigned)__builtin_amdgcn_readfirstlane(kdst + (slot)))
#define ATT_DMA_V(t, slot) glds16(vsrc + (long)(t) * 64 * PITCH, (unsigned)__builtin_amdgcn_readfirstlane(vdst + (slot)))
    const int vb0 = (int)(lds0 + L_V) + ((lane >> 4) & 1) * 32 + (lane & 3) * 8 + (4 * hi + ((lane & 15) >> 2)) * 64;
    const lds_cptr shm3 = (lds_cptr)shm; const lds_cptr kp0 = shm3 + L_K + hi * 1024 + r32 * 16;
    ATT_DMA_K(kt0, 0); ATT_DMA_V(kt0, 0);
    if (MOBA) { float* ksl = (float*)(shm + L_KS); ksl[tid] = ksum[((size_t)b * 8 + (tid >> 6)) * 512 + 64 * hh + (tid & 63)]; }
    bf16x8 qr[4];
#pragma unroll
    for (int d0 = 0; d0 < 4; ++d0) qr[d0] = *reinterpret_cast<const bf16x8*>(&Qw[(long)r32 * PITCH + d0 * 16 + hi * 8]);
    float m_run, l_run;
    if (MOBA) { m_run = M0; l_run = 0.f; }
    else { m_run = sinks[4 * hh + (wid >> 1)] * LOG2E; l_run = (hi == 0) ? 1.0f : 0.0f; }
    f32x16 o[2]; o[0] = f32x16{}; o[1] = f32x16{};
    ATT_WAIT_BAR0();
    unsigned sel = 0u;
    if (MOBA) {
        if (qb <= 3) sel = (1u << qb) - 1u;
        else {
            const float* ksl = (const float*)(shm + L_KS);
            float gv[7];
#pragma unroll
            for (int i = 0; i < 7; ++i) {
                float s = 0.f;
#pragma unroll
                for (int d0 = 0; d0 < 4; ++d0) {
                    const f32x4 k0 = *(const f32x4*)(ksl + i * 64 + 16 * d0 + 8 * hi), k1 = *(const f32x4*)(ksl + i * 64 + 16 * d0 + 8 * hi + 4);
#pragma unroll
                    for (int jj = 0; jj < 4; ++jj) { s += bf2f((unsigned short)qr[d0][jj]) * k0[jj]; s += bf2f((unsigned short)qr[d0][4 + jj]) * k1[jj]; }
                }
                auto rr = __builtin_amdgcn_permlane32_swap(__float_as_uint(s), __float_as_uint(s), false, false);
                s = __uint_as_float(rr[0]) + __uint_as_float(rr[1]);
                gv[i] = (i < qb) ? s : -INFINITY;
            }
#pragma unroll
            for (int rk = 0; rk < 3; ++rk) { float best = -INFINITY; int bi = 0;
#pragma unroll
                for (int i = 0; i < 7; ++i) { const bool c = (((sel >> i) & 1u) == 0u) && (gv[i] > best); best = c ? gv[i] : best; bi = c ? i : bi; }
                sel |= 1u << bi; }
        }
    }
    const int NT = kt1 - kt0;
    for (int it = 0; it < NT; ++it) {
        const int kt = kt0 + it; const int cur = (it & 1) * SLOTB;
        if (it + 1 < NT) { ATT_DMA_K(kt + 1, cur ^ SLOTB); ATT_DMA_V(kt + 1, cur ^ SLOTB); }
        bool need;
        if (MOBA) need = (kt < 4 * qb) ? true : (64 * kt <= qa + 31);
        else need = (64 * kt + 63 >= qa - 127) && (64 * kt <= qa + 31);
        if (need) {
            f32x16 p0, p1; qkt(p0, p1, kp0 + cur, qr);
            if (MOBA && kt < 4 * qb) {
                const bool on = ((sel >> (kt >> 2)) & 1u) != 0u;
#pragma unroll
                for (int r = 0; r < 16; ++r) { p0[r] = on ? p0[r] : NEG; p1[r] = on ? p1[r] : NEG; }
            } else {
                const int dq = qa + r32 - 64 * kt - 4 * hi;
#pragma unroll
                for (int r = 0; r < 16; ++r) { const int d0_ = dq - ((r & 3) + 8 * (r >> 2)), d1_ = d0_ - 32;
                    const bool v0 = MOBA ? (d0_ >= 0) : ((unsigned)d0_ < 128u), v1 = MOBA ? (d1_ >= 0) : ((unsigned)d1_ < 128u);
                    p0[r] = v0 ? p0[r] : NEG; p1[r] = v1 ? p1[r] : NEG; }
            }
            const float rm = rowmax32(p0, p1);
            const float mnew = fmaxf(m_run, rm);
            const float f = __builtin_amdgcn_exp2f(m_run - mnew);
            m_run = mnew; l_run *= f;
            if (hi == 0) wsf[r32] = f;
            LDS_WAIT();
#pragma unroll
            for (int r = 0; r < 16; ++r) { const float fr_ = wsf[crow(r, hi)]; o[0][r] *= fr_; o[1][r] *= fr_; }
            float sacc = 0.f;
#pragma unroll
            for (int r = 0; r < 16; ++r) { p0[r] = __builtin_amdgcn_exp2f(p0[r] - mnew); p1[r] = __builtin_amdgcn_exp2f(p1[r] - mnew); sacc += p0[r] + p1[r]; }
            l_run += sacc;
            u32x4 pw0, pw1, pw2, pw3;
            pw0 = (u32x4){cvtpk(p0[0], p0[1]), cvtpk(p0[2], p0[3]), cvtpk(p0[4], p0[5]), cvtpk(p0[6], p0[7])};
            pw1 = (u32x4){cvtpk(p0[8], p0[9]), cvtpk(p0[10], p0[11]), cvtpk(p0[12], p0[13]), cvtpk(p0[14], p0[15])};
            pw2 = (u32x4){cvtpk(p1[0], p1[1]), cvtpk(p1[2], p1[3]), cvtpk(p1[4], p1[5]), cvtpk(p1[6], p1[7])};
            pw3 = (u32x4){cvtpk(p1[8], p1[9]), cvtpk(p1[10], p1[11]), cvtpk(p1[12], p1[13]), cvtpk(p1[14], p1[15])};
            ATT_SBAR();
            pv(o, vb0 + cur, __builtin_bit_cast(bf16x8, pw0), __builtin_bit_cast(bf16x8, pw1), __builtin_bit_cast(bf16x8, pw2), __builtin_bit_cast(bf16x8, pw3));
        }
        if (it + 1 < NT) ATT_WAIT_BAR0();
    }
    { auto rr = __builtin_amdgcn_permlane32_swap(__float_as_uint(l_run), __float_as_uint(l_run), false, false); l_run = __uint_as_float(rr[0]) + __uint_as_float(rr[1]); }
    if (hi == 0) wsf[32 + r32] = l_run;
    LDS_WAIT();
    float rli[16];
#pragma unroll
    for (int r = 0; r < 16; ++r) rli[r] = __builtin_amdgcn_rcpf(wsf[32 + crow(r, hi)]);
    bf16_t* Ow = aout + (rowbase + qa) * D + ocol;
    { bf16_t* stg = (bf16_t*)(shm + L_OST) + wid * 2048;
#pragma unroll
        for (int r = 0; r < 16; ++r) { const int orow = crow(r, hi);
#pragma unroll
            for (int d0 = 0; d0 < 2; ++d0) stg[orow * 64 + d0 * 32 + r32] = (bf16_t)f2bf(o[d0][r] * rli[r]); }
        LDS_WAIT();
#pragma unroll
        for (int i = 0; i < 4; ++i) { const int row = i * 8 + (lane >> 3), ch = lane & 7; const u32x4 v = *(const u32x4*)(stg + row * 64 + ch * 8); *(u32x4*)(Ow + (long)row * D + ch * 8) = v; } }
    asm volatile("s_waitcnt lgkmcnt(0)\n\ts_barrier" ::: "memory");
#undef ATT_DMA_K
#undef ATT_DMA_V
}
}

__device__ __forceinline__ void sincos_d(double a, double& s, double& c) {
    const double q = __builtin_rint(a * 0.63661977236758134308);
    double r = __builtin_fma(-q, 1.57079632679489655800e+00, a);
    r = __builtin_fma(-q, 6.12323399573676603587e-17, r);
    const double r2 = r * r;
    double sp = -1.0 / 1307674368000.0;
    sp = sp * r2 + 1.0 / 6227020800.0; sp = sp * r2 - 1.0 / 39916800.0; sp = sp * r2 + 1.0 / 362880.0; sp = sp * r2 - 1.0 / 5040.0; sp = sp * r2 + 1.0 / 120.0; sp = sp * r2 - 1.0 / 6.0;
    const double sr = r + r * r2 * sp;
    double cp = 1.0 / 20922789888000.0;
    cp = cp * r2 - 1.0 / 87178291200.0; cp = cp * r2 + 1.0 / 479001600.0; cp = cp * r2 - 1.0 / 3628800.0; cp = cp * r2 + 1.0 / 40320.0; cp = cp * r2 - 1.0 / 720.0; cp = cp * r2 + 1.0 / 24.0; cp = cp * r2 - 0.5;
    const double cr = 1.0 + r2 * cp;
    const int n = ((int)q) & 3;
    s = (n == 0) ? sr : (n == 1) ? cr : (n == 2) ? -sr : -cr;
    c = (n == 0) ? cr : (n == 1) ? -sr : (n == 2) ? -cr : sr;
}
__device__ __forceinline__ int sigma_col(int p, int mode) {
    if (mode == 0) return (p & ~255) + 64 * ((p >> 5) & 3) + 32 * ((p >> 7) & 1) + pg8::perm32(p & 31);
    if (mode == 1) return (p & ~31) + pg8::perm32(p & 31);
    const int pn = p >> 8, q = p & 255; return 2 * (128 * pn + 32 * ((q >> 5) & 3) + pg8::perm32(q & 31)) + (q >> 7);
}
__device__ __forceinline__ void p0_transpose_item(const float* __restrict__ W, int N, bf16_t* __restrict__ WT, int mode, LAS float* scr, int item, int lane) {
    const int nblk = N / 32, kb = item / nblk, nb = item % nblk, k0 = 64 * kb, p0 = 32 * nb;
    const int sc = sigma_col(p0 + (lane & 31), mode);
#pragma unroll 8
    for (int i = 0; i < 32; ++i) { const int kk = 2 * i + (lane >> 5); scr[kk * 33 + (lane & 31)] = W[(size_t)(k0 + kk) * N + sc]; }
    LDS_WAIT(); asm volatile("" ::: "memory");
    const int c = lane & 7;
#pragma unroll
    for (int j = 0; j < 4; ++j) { const int n = (lane >> 3) + 8 * j; const LAS float* s = scr + (8 * c) * 33 + n;
        u32x4 o; o.x = cvtpk(s[0 * 33], s[1 * 33]); o.y = cvtpk(s[2 * 33], s[3 * 33]); o.z = cvtpk(s[4 * 33], s[5 * 33]); o.w = cvtpk(s[6 * 33], s[7 * 33]);
        *(u32x4*)(WT + (size_t)(p0 + n) * 1024 + k0 + 8 * c) = o; }
    LDS_WAIT(); asm volatile("" ::: "memory");
}

__global__ void __launch_bounds__(NTHREADS, 2) fwd_megakernel(Params p) {
    extern __shared__ __attribute__((aligned(16))) unsigned char lds_raw[];
    LAS unsigned char* lds = (LAS unsigned char*)lds_raw;
    cg::grid_group grid = cg::this_grid();
#define PHASE_IDS() int tid = threadIdx.x; asm volatile("" : "+v"(tid)); const int lane = tid & 63, wave = __builtin_amdgcn_readfirstlane(tid >> 6); (void)lane; (void)wave
    const int G = gridDim.x, bx = blockIdx.x;
    unsigned char* ws = p.ws;
    unsigned* ctl = (unsigned*)(ws + WS_CTL);
    float* ksum = (float*)(ws + WS_KSUM);
    float* rope = (float*)(ws + WS_ROPE);
    bf16_t* w_in_t = (bf16_t*)(ws + WS_WIN_T); bf16_t* w_out_t = (bf16_t*)(ws + WS_WOUT_T);
    bf16_t* w1_t = (bf16_t*)(ws + WS_W1_T); bf16_t* w2_t = (bf16_t*)(ws + WS_W2_T);
    int* cnt_blk = (int*)(ws + WS_CNT); int* tile_e = (int*)(ws + WS_TILE_E);
    bf16_t* wr_hi = (bf16_t*)(ws + WS_WR_HI); bf16_t* wr_lo = (bf16_t*)(ws + WS_WR_LO);
    int* tok = (int*)(ws + WS_TOK);
    int* asg_e = (int*)(ws + WS_ASG_E); float* asg_g = (float*)(ws + WS_ASG_G); int* asg_d = (int*)(ws + WS_ASG_D);
    bf16_t* x1b = (bf16_t*)(ws + WS_X1B); bf16_t* x1lo = (bf16_t*)(ws + WS_X1LO);
    bf16_t* xb = (bf16_t*)(ws + WS_XB); bf16_t* attn_o = xb;
    bf16_t* qkv = (bf16_t*)(ws + WS_QKV);
    bf16_t* yb = (bf16_t*)(ws + WS_YB);

    REP(0) {
        PHASE_IDS();
        const long gt = (long)bx * NTHREADS + tid, gsz = (long)G * NTHREADS;
        for (long i = gt; i < 2048 * 32; i += gsz) {
            const int pos = (int)(i >> 5), k = (int)(i & 31);
            double inv = 1.0; for (int q = 0; q < k; ++q) inv *= 0.7498942093324559;
            double s, c; sincos_d((double)pos * inv, s, c);
            rope[pos * 64 + k] = (float)c; rope[pos * 64 + 32 + k] = (float)s;
        }
        for (long i = gt; i < 32 * 1024; i += gsz) {
            const int e = (int)(i >> 10), k = (int)(i & 1023); const float w = p.w_router[k * 32 + e];
            const unsigned h = f2bf(w); wr_hi[i] = (bf16_t)h; wr_lo[i] = (bf16_t)f2bf(w - bf2f(h));
        }
        LAS float* scr = (LAS float*)(lds + wave * 16384);
        const int gw = bx * 8 + wave, NGW = G * 8;
        constexpr int I_IN = 16 * (INW / 32), I_OUT = 16 * 32, I_W1 = 16 * 64, I_W2 = 16 * 32;
        constexpr int NITEMS = I_IN + I_OUT + NE * I_W1 + NE * I_W2;
        for (int it = gw; it < NITEMS; it += NGW) {
            int r = it;
            if (r < I_IN) { p0_transpose_item(p.w_in, INW, w_in_t, 0, scr, r, lane); continue; } r -= I_IN;
            if (r < I_OUT) { p0_transpose_item(p.w_out, 1024, w_out_t, 1, scr, r, lane); continue; } r -= I_OUT;
            if (r < NE * I_W1) { const int e = r / I_W1; p0_transpose_item(p.w1 + (size_t)e * 1024 * 2048, 2048, w1_t + (size_t)e * 2048 * 1024, 2, scr, r % I_W1, lane); continue; } r -= NE * I_W1;
            { const int e = r / I_W2; p0_transpose_item(p.w2 + (size_t)e * 1024 * 1024, 1024, w2_t + (size_t)e * 1024 * 1024, 1, scr, r % I_W2, lane); }
        }
        const f32x4* x4 = (const f32x4*)p.x; u32x4* xb4 = (u32x4*)xb;
        for (long i = gt; i < (long)T * D / 8; i += gsz) { const f32x4 a = x4[2 * i], b = x4[2 * i + 1];
            u32x4 o; o.x = cvtpk(a[0], a[1]); o.y = cvtpk(a[2], a[3]); o.z = cvtpk(b[0], b[1]); o.w = cvtpk(b[2], b[3]); xb4[i] = o; }
    }
    grid.sync();

    REP(1) {
        pg8::SchedInProj S{(const char*)xb, (const char*)w_in_t, G, bx};
        pg8::EpiInProj E{qkv, p.b_in, rope, ksum};
        pg8::gemm_phase<pg8::EpiInProj, pg8::SchedInProj, false, true>(lds, S, E);
    }
    grid.sync();

    REP(2) for (int u = bx; u < 256; u += G) {
        { const int b = u >> 3, h = u & 7;
            for (int j = 0; j < 8; ++j) att::attn_item<true>((char*)lds_raw, qkv, attn_o, b, h, j, p.sinks, ksum); }
        { const int b = u >> 3, kvh = (u >> 2) & 1, oct = u & 3;
            for (int i = 0; i < 8; ++i) att::attn_item<false>((char*)lds_raw, qkv, attn_o, b, kvh, oct * 8 + i, p.sinks, ksum); }
    }
    grid.sync();

    REP(3) for (int pm = bx; pm < T / 256; pm += G) {
        PHASE_IDS();
        {
            pg8::SchedPanel S{(const char*)attn_o, (const char*)w_out_t, pm};
            pg8::EpiOutProj E{p.out, p.b_out, p.x};
            pg8::gemm_phase<pg8::EpiOutProj, pg8::SchedPanel, false, true>(lds, S, E);
        }
        __syncthreads();
        {
#pragma unroll
            for (int i = 0; i < 16; ++i) { const int idx = tid + 512 * i, mat = idx >> 12, rw = (idx >> 7) & 31, ch = idx & 127;
                const u32x4 v = *(const u32x4*)((mat ? wr_lo : wr_hi) + rw * 1024 + ch * 8);
                *(LAS u32x4*)(lds + mat * 66048 + rw * 2064 + ch * 16) = v; }
        }
        {
            f32x4 gg[4], bb[4];
#pragma unroll
            for (int j = 0; j < 4; ++j) { gg[j] = *(const f32x4*)(p.ln1_g + 256 * j + 4 * lane); bb[j] = *(const f32x4*)(p.ln1_b + 256 * j + 4 * lane); }
            for (int rr = 0; rr < 32; rr += 4) {
                const size_t row0 = (size_t)pm * 256 + wave * 32 + rr;
                f32x4 v[4][4]; float sm[4], sq[4];
#pragma unroll
                for (int q = 0; q < 4; ++q) { const f32x4* yr = (const f32x4*)(p.out + (row0 + q) * D) + lane;
#pragma unroll
                    for (int j = 0; j < 4; ++j) v[q][j] = yr[64 * j]; }
#pragma unroll
                for (int q = 0; q < 4; ++q) { float s = 0.f;
#pragma unroll
                    for (int j = 0; j < 4; ++j) s += (v[q][j][0] + v[q][j][1]) + (v[q][j][2] + v[q][j][3]);
                    sm[q] = s; }
#pragma unroll
                for (int o = 1; o < 64; o <<= 1) {
#pragma unroll
                    for (int q = 0; q < 4; ++q) sm[q] += __shfl_xor(sm[q], o); }
#pragma unroll
                for (int q = 0; q < 4; ++q) { const float mean = sm[q] * (1.0f / D); float s2 = 0.f;
#pragma unroll
                    for (int j = 0; j < 4; ++j) { v[q][j] = v[q][j] - mean; s2 += (v[q][j][0] * v[q][j][0] + v[q][j][1] * v[q][j][1]) + (v[q][j][2] * v[q][j][2] + v[q][j][3] * v[q][j][3]); }
                    sq[q] = s2; }
#pragma unroll
                for (int o = 1; o < 64; o <<= 1) {
#pragma unroll
                    for (int q = 0; q < 4; ++q) sq[q] += __shfl_xor(sq[q], o); }
#pragma unroll
                for (int q = 0; q < 4; ++q) {
                    const float rstd = 1.0f / sqrtf(sq[q] * (1.0f / D) + LN_EPS);
#pragma unroll
                    for (int j = 0; j < 4; ++j) {
                        const f32x4 xv = v[q][j] * rstd * gg[j] + bb[j];
                        const unsigned h01 = cvtpk(xv[0], xv[1]), h23 = cvtpk(xv[2], xv[3]);
                        const float r0 = xv[0] - bf2f(h01 & 0xffffu), r1 = xv[1] - bf2f(h01 >> 16), r2 = xv[2] - bf2f(h23 & 0xffffu), r3 = xv[3] - bf2f(h23 >> 16);
                        u32x2 hv = {h01, h23}, lv = {cvtpk(r0, r1), cvtpk(r2, r3)};
                        *(u32x2*)(x1b + (row0 + q) * D + 256 * j + 4 * lane) = hv;
                        *(u32x2*)(x1lo + (row0 + q) * D + 256 * j + 4 * lane) = lv;
                    }
                }
            }
        }
        __syncthreads();
        {
            const int fr = lane & 15, fq = lane >> 4;
            f32x4 lacc[2][2];
#pragma unroll
            for (int m = 0; m < 2; ++m)
#pragma unroll
                for (int n = 0; n < 2; ++n) lacc[m][n] = (f32x4){0.f, 0.f, 0.f, 0.f};
            const size_t r0 = (size_t)pm * 256 + wave * 32;
            const bf16_t* ah = x1b + (r0 + fr) * D + 8 * fq; const bf16_t* al = x1lo + (r0 + fr) * D + 8 * fq;
            const LAS unsigned char* bh = lds + fr * 2064 + 16 * fq; const LAS unsigned char* bl = bh + 66048;
#pragma unroll 4
            for (int k0 = 0; k0 < 1024; k0 += 32) {
                bf16x8 a_hi[2], a_lo[2], b_hi[2], b_lo[2];
#pragma unroll
                for (int m = 0; m < 2; ++m) { a_hi[m] = *(const bf16x8*)(ah + (size_t)m * 16 * D + k0); a_lo[m] = *(const bf16x8*)(al + (size_t)m * 16 * D + k0); }
#pragma unroll
                for (int n = 0; n < 2; ++n) { b_hi[n] = *(const LAS bf16x8*)(bh + n * 16 * 2064 + k0 * 2); b_lo[n] = *(const LAS bf16x8*)(bl + n * 16 * 2064 + k0 * 2); }
#pragma unroll
                for (int m = 0; m < 2; ++m)
#pragma unroll
                    for (int n = 0; n < 2; ++n) {
                        lacc[m][n] = __builtin_amdgcn_mfma_f32_16x16x32_bf16(a_hi[m], b_hi[n], lacc[m][n], 0, 0, 0);
                        lacc[m][n] = __builtin_amdgcn_mfma_f32_16x16x32_bf16(a_lo[m], b_hi[n], lacc[m][n], 0, 0, 0);
                        lacc[m][n] = __builtin_amdgcn_mfma_f32_16x16x32_bf16(a_hi[m], b_lo[n], lacc[m][n], 0, 0, 0);
                    }
            }
            __syncthreads();
            LAS float* lg = (LAS float*)lds;
#pragma unroll
            for (int m = 0; m < 2; ++m)
#pragma unroll
                for (int n = 0; n < 2; ++n)
#pragma unroll
                    for (int rg = 0; rg < 4; ++rg) lg[(wave * 32 + 16 * m + 4 * fq + rg) * 33 + 16 * n + fr] = lacc[m][n][rg];
        }
        __syncthreads();
        {
            LAS float* lg = (LAS float*)lds;
            LAS int* wcnt = (LAS int*)(lds + 36864);
            float t0 = -INFINITY, t1 = -INFINITY, t2 = -INFINITY, t3 = -INFINITY; int i0 = 0, i1 = 0, i2 = 0, i3 = 0;
            int rk0 = 0, rk1 = 0, rk2 = 0, rk3 = 0;
            if (tid < 256) {
                for (int e = 0; e < NE; ++e) {
                    const float xv = lg[tid * 33 + e] + p.b_router[e];
                    if (xv > t3) {
                        if (xv > t2) { t3 = t2; i3 = i2;
                            if (xv > t1) { t2 = t1; i2 = i1;
                                if (xv > t0) { t1 = t0; i1 = i0; t0 = xv; i0 = e; } else { t1 = xv; i1 = e; }
                            } else { t2 = xv; i2 = e; }
                        } else { t3 = xv; i3 = e; }
                    }
                }
                const unsigned selm = (1u << i0) | (1u << i1) | (1u << i2) | (1u << i3);
                for (int e = 0; e < NE; ++e) {
                    const bool has = ((selm >> e) & 1u) != 0u;
                    const unsigned long long bal = __ballot(has);
                    const int pre = __popcll(bal & ((1ull << lane) - 1ull));
                    if (e == i0) rk0 = pre; if (e == i1) rk1 = pre; if (e == i2) rk2 = pre; if (e == i3) rk3 = pre;
                    if (lane == 0) wcnt[wave * 32 + e] = __popcll(bal);
                }
            }
            __syncthreads();
            if (tid < 256) {
                const float e1 = __expf(t1 - t0), e2 = __expf(t2 - t0), e3 = __expf(t3 - t0);
                const float inv = 1.0f / (1.0f + e1 + e2 + e3);
                int b0 = 0, b1 = 0, b2 = 0, b3 = 0;
                for (int w = 0; w < wave; ++w) { b0 += wcnt[w * 32 + i0]; b1 += wcnt[w * 32 + i1]; b2 += wcnt[w * 32 + i2]; b3 += wcnt[w * 32 + i3]; }
                const size_t a = ((size_t)pm * 256 + tid) * 4;
                *(int4*)(asg_e + a) = make_int4(i0, i1, i2, i3);
                *(float4*)(asg_g + a) = make_float4(inv, e1 * inv, e2 * inv, e3 * inv);
                *(int4*)(asg_d + a) = make_int4(b0 + rk0, b1 + rk1, b2 + rk2, b3 + rk3);
            }
            if (tid < 32) cnt_blk[pm * 32 + tid] = wcnt[tid] + wcnt[32 + tid] + wcnt[64 + tid] + wcnt[96 + tid];
            __syncthreads();
        }
    }
    grid.sync();

    for (int pm = bx; pm < T / 256; pm += G) {
        PHASE_IDS();
        LAS int* part_all = (LAS int*)lds; LAS int* part_pre = part_all + 512; LAS int* tot = part_pre + 512; LAS int* pre = tot + 32; LAS int* poff = pre + 32;
        { const int e = tid & 31, seg = tid >> 5; int sa = 0, sp = 0;
            for (int bb = seg * 16; bb < seg * 16 + 16; ++bb) { const int c = cnt_blk[bb * 32 + e]; sa += c; sp += (bb < pm) ? c : 0; }
            part_all[tid] = sa; part_pre[tid] = sp; }
        __syncthreads();
        if (tid < 32) { int sa = 0, sp = 0; for (int s = 0; s < 16; ++s) { sa += part_all[s * 32 + tid]; sp += part_pre[s * 32 + tid]; } tot[tid] = sa; pre[tid] = sp; }
        __syncthreads();
        if (tid == 0) { int off = 0; for (int e = 0; e < NE; ++e) { poff[e] = off; off += ((tot[e] + 255) >> 8) << 8; } poff[32] = off; }
        __syncthreads();
        if (tid < 256) {
            const int token = pm * 256 + tid; const size_t a = (size_t)token * 4;
            const int4 ee = *(const int4*)(asg_e + a); const int4 rk = *(const int4*)(asg_d + a);
            const int d0 = poff[ee.x] + pre[ee.x] + rk.x, d1 = poff[ee.y] + pre[ee.y] + rk.y, d2 = poff[ee.z] + pre[ee.z] + rk.z, d3 = poff[ee.w] + pre[ee.w] + rk.w;
            *(int4*)(asg_d + a) = make_int4(d0, d1, d2, d3);
            tok[d0] = token; tok[d1] = token; tok[d2] = token; tok[d3] = token;
        }
        if (pm < NE) {
            const int e = pm, n = tot[e], np = ((n + 255) >> 8) << 8, o = poff[e];
            for (int i = n + tid; i < np; i += NTHREADS) tok[o + i] = 0;
            for (int i = tid; i < (np >> 8); i += NTHREADS) tile_e[(o >> 8) + i] = e;
        }
        if (pm == 0 && tid == 0) ctl[CW_NTILES] = (unsigned)(poff[32] >> 8);
        __syncthreads();
    }
    grid.sync();

    const int ntiles = (int)ctl[CW_NTILES];
    REP(5) {
        pg8::SchedMoe<8, true> S{(const char*)x1b, nullptr, (const char*)w1_t, tile_e, tok, ntiles, G, bx};
        pg8::EpiSwiglu E{(unsigned char*)p.out, ws + WS_ACT2, p.b1};
        pg8::gemm_phase<pg8::EpiSwiglu, pg8::SchedMoe<8, true>, true, true>(lds, S, E);
    }
    grid.sync();

    REP(6) {
        pg8::SchedMoe<4, false> S{(const char*)p.out, (const char*)(ws + WS_ACT2), (const char*)w2_t, tile_e, tok, ntiles, G, bx};
        pg8::EpiDown E{yb, p.b2};
        pg8::gemm_phase<pg8::EpiDown, pg8::SchedMoe<4, false>, false, true>(lds, S, E);
    }
    grid.sync();

    REP(7) {
        PHASE_IDS();
        const int gw = bx * 8 + wave, NGW = G * 8;
        f32x4 gg[2][2], bb[2][2];
#pragma unroll
        for (int j = 0; j < 2; ++j)
#pragma unroll
            for (int h = 0; h < 2; ++h) { gg[j][h] = *(const f32x4*)(p.ln2_g + 512 * j + 8 * lane + 4 * h); bb[j][h] = *(const f32x4*)(p.ln2_b + 512 * j + 8 * lane + 4 * h); }
        for (int row = gw; row < T; row += NGW) {
            const size_t a = (size_t)row * 4;
            const int4 dd = *(const int4*)(asg_d + a); const float4 gt4 = *(const float4*)(asg_g + a);
            u32x4 xr[2], y0[2], y1[2], y2[2], y3[2];
#pragma unroll
            for (int j = 0; j < 2; ++j) {
                xr[j] = *(const u32x4*)(x1b + (size_t)row * D + 512 * j + 8 * lane);
                y0[j] = *(const u32x4*)(yb + (size_t)dd.x * D + 512 * j + 8 * lane);
                y1[j] = *(const u32x4*)(yb + (size_t)dd.y * D + 512 * j + 8 * lane);
                y2[j] = *(const u32x4*)(yb + (size_t)dd.z * D + 512 * j + 8 * lane);
                y3[j] = *(const u32x4*)(yb + (size_t)dd.w * D + 512 * j + 8 * lane);
            }
            float z[2][8]; float s = 0.f;
#pragma unroll
            for (int j = 0; j < 2; ++j)
#pragma unroll
                for (int q = 0; q < 4; ++q) {
                    const unsigned xw = xr[j][q], a0 = y0[j][q], a1 = y1[j][q], a2 = y2[j][q], a3 = y3[j][q];
                    const float lo = DN_ALPHA * bf2f(xw & 0xffffu) + gt4.x * bf2f(a0 & 0xffffu) + gt4.y * bf2f(a1 & 0xffffu) + gt4.z * bf2f(a2 & 0xffffu) + gt4.w * bf2f(a3 & 0xffffu);
                    const float hi = DN_ALPHA * bf2f(xw >> 16) + gt4.x * bf2f(a0 >> 16) + gt4.y * bf2f(a1 >> 16) + gt4.z * bf2f(a2 >> 16) + gt4.w * bf2f(a3 >> 16);
                    z[j][2 * q] = lo; z[j][2 * q + 1] = hi; s += lo + hi;
                }
            const float mean = wave_sum(s) * (1.0f / D); float s2 = 0.f;
#pragma unroll
            for (int j = 0; j < 2; ++j)
#pragma unroll
                for (int q = 0; q < 8; ++q) { z[j][q] -= mean; s2 += z[j][q] * z[j][q]; }
            const float rstd = 1.0f / sqrtf(wave_sum(s2) * (1.0f / D) + LN_EPS);
#pragma unroll
            for (int j = 0; j < 2; ++j)
#pragma unroll
                for (int h = 0; h < 2; ++h) {
                    f32x4 o;
#pragma unroll
                    for (int q = 0; q < 4; ++q) o[q] = z[j][4 * h + q] * rstd * gg[j][h][q] + bb[j][h][q];
                    *(f32x4*)(p.out + (size_t)row * D + 512 * j + 8 * lane + 4 * h) = o;
                }
        }
    }
}

extern "C" void kernel_launch(void* const* d_in, const int* in_sizes, int n_in, void* d_out, int out_size, void* d_ws, size_t ws_size, hipStream_t stream) {
    static int grid_blocks = 0;
    if (grid_blocks == 0) {
        if (n_in != 16 || in_sizes[0] != T * D || out_size != T * D || ws_size < WS_END) {
            fprintf(stderr, "kernel_launch: unexpected shapes: n_in %d in0 %d out %d ws %zu (need %zu)\n", n_in, n_in > 0 ? in_sizes[0] : -1, out_size, ws_size, (size_t)WS_END); grid_blocks = -1; return; }
        int dev = 0, cus = 0, per_cu = 0;
        (void)hipGetDevice(&dev);
        (void)hipDeviceGetAttribute(&cus, hipDeviceAttributeMultiprocessorCount, dev);
        (void)hipFuncSetAttribute((const void*)fwd_megakernel, hipFuncAttributeMaxDynamicSharedMemorySize, LDS_BYTES);
        (void)hipOccupancyMaxActiveBlocksPerMultiprocessor(&per_cu, (const void*)fwd_megakernel, NTHREADS, LDS_BYTES);
        if (per_cu < 1) { fprintf(stderr, "kernel_launch: occupancy query reports %d blocks per CU\n", per_cu); per_cu = 1; }
        grid_blocks = cus;
        fprintf(stderr, "kernel_launch: cus=%d per_cu=%d grid=%d ws=%zu\n", cus, per_cu, grid_blocks, ws_size);
    }
    if (grid_blocks < 0) return;
    (void)hipMemsetAsync((char*)d_ws + WS_CTL, 0, CTL_ZERO_BYTES, stream);
    Params p{};
    p.x = (const float*)d_in[0]; p.w_in = (const float*)d_in[1]; p.b_in = (const float*)d_in[2]; p.sinks = (const float*)d_in[3]; p.w_out = (const float*)d_in[4]; p.b_out = (const float*)d_in[5];
    p.ln1_g = (const float*)d_in[6]; p.ln1_b = (const float*)d_in[7]; p.w_router = (const float*)d_in[8]; p.b_router = (const float*)d_in[9];
    p.w1 = (const float*)d_in[10]; p.b1 = (const float*)d_in[11]; p.w2 = (const float*)d_in[12]; p.b2 = (const float*)d_in[13]; p.ln2_g = (const float*)d_in[14]; p.ln2_b = (const float*)d_in[15];
    p.out = (float*)d_out; p.ws = (unsigned char*)d_ws;
    void* args[] = {&p};
    hipError_t e = hipLaunchCooperativeKernel((void*)fwd_megakernel, dim3(grid_blocks), dim3(NTHREADS), args, LDS_BYTES, stream);
    if (e != hipSuccess) fprintf(stderr, "cooperative launch failed: %s (grid %d)\n", hipGetErrorString(e), grid_blocks);
}
```

```cpp
#include <hip/hip_runtime.h>
#include <hip/hip_cooperative_groups.h>
#include <cstdio>
#include <cstdint>
namespace cg = cooperative_groups;

#define LAS __attribute__((address_space(3)))
typedef unsigned short bf16_t;
typedef short bf16x8 __attribute__((ext_vector_type(8)));
typedef short s16x4 __attribute__((ext_vector_type(4)));
typedef float f32x2 __attribute__((ext_vector_type(2)));
typedef float f32x4 __attribute__((ext_vector_type(4)));
typedef float f32x16 __attribute__((ext_vector_type(16)));
typedef unsigned u32x2 __attribute__((ext_vector_type(2)));
typedef unsigned u32x4 __attribute__((ext_vector_type(4)));
typedef __bf16 bf16x2_t __attribute__((ext_vector_type(2)));

constexpr int D = 1024, BATCH = 32, SEQ = 2048, T = BATCH * SEQ;
constexpr int INW = 2304, NE = 32;
constexpr float LN_EPS = 1e-5f;
constexpr float DN_ALPHA = 1.189207115002721f;
constexpr float LOG2E = 1.4426950408889634f;
constexpr float C2 = 0.18033688011112042f;
constexpr int NTHREADS = 512;
constexpr int LDS_BYTES = 147456;
constexpr int MAX_TILES = 1056;
#ifndef DUP_MASK
#define DUP_MASK 0
#endif
#define REP(k) for (int _rep = 0; _rep < (((DUP_MASK >> (k)) & 1) ? 2 : 1); ++_rep)

constexpr size_t MiB = 1u << 20;
constexpr size_t WS_CTL = 0, CTL_ZERO_BYTES = 2 * MiB;
constexpr size_t WS_KSUM = 1 * MiB;
constexpr size_t WS_ROPE = 2 * MiB;
constexpr size_t WS_WIN_T = 4 * MiB;
constexpr size_t WS_WOUT_T = 9 * MiB;
constexpr size_t WS_SMALL = 11 * MiB;
constexpr size_t WS_CNT = WS_SMALL, WS_TILE_E = WS_SMALL + 65536, WS_WR_HI = WS_SMALL + 131072, WS_WR_LO = WS_WR_HI + 65536;
constexpr size_t WS_TOK = 12 * MiB;
constexpr size_t WS_ASG_E = 14 * MiB, WS_ASG_G = 15 * MiB, WS_ASG_D = 16 * MiB;
constexpr size_t WS_W2_8 = 24 * MiB;
constexpr size_t WS_X1B = 56 * MiB;
constexpr size_t WS_ACT8 = 184 * MiB;
constexpr size_t WS_XB = 184 * MiB;
constexpr size_t WS_X1LO = 312 * MiB;
constexpr size_t WS_YB = 488 * MiB;
constexpr size_t WS_W1_8 = 488 * MiB;
constexpr size_t WS_X1_8 = 552 * MiB;
constexpr size_t WS_QKV = 616 * MiB;
constexpr size_t WS_END = 1016 * MiB;
constexpr float W_SCALE = 64.0f, ACT_SCALE = 4.0f;
constexpr int CW_NTILES = 16;

struct Params {
    const float *x, *w_in, *b_in, *sinks, *w_out, *b_out, *ln1_g, *ln1_b, *w_router, *b_router, *w1, *b1, *w2, *b2, *ln2_g, *ln2_b;
    float* out; unsigned char* ws;
};

__device__ __forceinline__ unsigned f2bf(float f) { unsigned u = __builtin_bit_cast(unsigned, f); return (u + 0x7fffu + ((u >> 16) & 1u)) >> 16; }
__device__ __forceinline__ float bf2f(unsigned h) { return __builtin_bit_cast(float, h << 16); }
__device__ __forceinline__ unsigned cvtpk(float lo, float hi) { f32x2 v = {lo, hi}; bf16x2_t b = __builtin_convertvector(v, bf16x2_t); return __builtin_bit_cast(unsigned, b); }
__device__ __forceinline__ unsigned pk4_fp8(float a, float b, float c, float d) { int w = 0; w = __builtin_amdgcn_cvt_pk_fp8_f32(a, b, w, false); w = __builtin_amdgcn_cvt_pk_fp8_f32(c, d, w, true); return (unsigned)w; }
__device__ __forceinline__ float wave_sum(float v) {
#pragma unroll
    for (int o = 1; o < 64; o <<= 1) v += __shfl_xor(v, o);
    return v;
}
#define LDS_WAIT() asm volatile("s_waitcnt lgkmcnt(0)" ::: "memory")

namespace pg8 {
constexpr int BM = 256, BK = 64, HALF = 128, HTB = HALF * BK * 2, STAGE_BYTES = 8 * HTB, NXCD = 8, WGM = 8;
constexpr int KD = 1024;
__host__ __device__ __forceinline__ int lds_byte(int r, int c) { const int st = (r >> 4) * 2 + (c >> 5), rr = r & 15, cc = c & 31, ob = rr * 64 + cc * 2; return st * 1024 + (ob ^ (((ob >> 9) & 1) << 5)); }
__host__ __device__ __forceinline__ void stage_rc(int b, int& R, int& C) { const int st = b / 1024, sb = b % 1024, swz = sb ^ (((sb >> 9) & 1) << 5); R = (st >> 1) * 16 + swz / 64; C = (st & 1) * 32 + (swz % 64) / 2; }
__host__ __device__ __forceinline__ int perm32(int rho) { const int n = rho >> 4, i = rho & 15; return 8 * (i >> 2) + 4 * n + (i & 3); }

struct Unit { int pm, pn, e; unsigned ao, bo; const int* rows; };

typedef int v8i32_t __attribute__((ext_vector_type(8)));
typedef int v4i32_t __attribute__((ext_vector_type(4)));
__device__ __forceinline__ v8i32_t cat8(bf16x8 a, bf16x8 b) { const v4i32_t x = __builtin_bit_cast(v4i32_t, a), y = __builtin_bit_cast(v4i32_t, b); return __builtin_shufflevector(x, y, 0, 1, 2, 3, 4, 5, 6, 7); }
template <class Epi, class Sched, bool GATHER, bool ALIGN_EPI, int KP = 1024, bool FP8 = false>
__device__ __forceinline__ void gemm_phase(LAS unsigned char* lds, const Sched& S, const Epi& E) {
    int tid = threadIdx.x; asm volatile("" : "+v"(tid));
    const int wid = __builtin_amdgcn_readfirstlane(tid >> 6), lane = tid & 63, wr = wid >> 2, wc = wid & 3, fr = lane & 15, fq = lane >> 4;
    constexpr int K = KP, nt = K / BK;
    unsigned voffB[2], Vc[2][2], Vn[2][2]; int stR0, stC0;
    { int R, C; stage_rc(tid * 16, R, C); stR0 = R; stC0 = C; }
#pragma unroll
    for (int i = 0; i < 2; ++i) { voffB[i] = (unsigned)((stR0 + 64 * i) * K + stC0) * 2u; Vc[0][i] = voffB[i]; Vc[1][i] = voffB[i]; Vn[0][i] = voffB[i]; Vn[1][i] = voffB[i]; }
#define PG8_GATHER_LOAD(VV, rowsp) do { int _t = threadIdx.x; asm volatile("" : "+v"(_t)); int _R, _C; stage_rc(_t * 16, _R, _C);     \
        const int* _rp = (const int*)((const char*)(rowsp) + (unsigned)(_R * 4)); _Pragma("unroll") for (int _h = 0; _h < 2; ++_h) _Pragma("unroll") for (int _i = 0; _i < 2; ++_i) \
        VV[_h][_i] = ((unsigned)_rp[128 * _h + 64 * _i] * (unsigned)K + (unsigned)_C) * 2u; } while (0)
    constexpr unsigned kstep = (unsigned)(BK * 2);
    constexpr unsigned hstep = (unsigned)HALF * K * 2;
    const char* const Abase = S.A; const char* const Bbase = S.B;
    const unsigned ldsw = (unsigned)wid * 1024u;
    const int aoff = lds_byte(wr * 64 + fr, fq * 8), boff = lds_byte(wc * 32 + fr, fq * 8);
#define PG8_SA(b, h) (((b) * 2 + (h)) * HTB)
#define PG8_SB(b, h) ((4 + (b) * 2 + (h)) * HTB)
#define PG8_STAGE(bufoff, gbase, soff, voff) do { _Pragma("unroll") for (int _i = 0; _i < 2; ++_i) \
        __builtin_amdgcn_global_load_lds((const unsigned*)((gbase) + (unsigned)((voff)[_i] + (soff))), (LAS unsigned*)(lds + (bufoff) + ldsw + _i * 8192), 16, 0, 0); } while (0)
#define PG8_STAGE_B(bufoff, soff) PG8_STAGE(bufoff, Bbase, soff, voffB)
#define PG8_STAGE_A(bufoff, soff, h, VV) do { if constexpr (GATHER) { PG8_STAGE(bufoff, Abase, soff, VV[h]); } else { PG8_STAGE(bufoff, Abase, (soff) + (h) * hstep, voffB); } } while (0)
#define PG8_LDA(dst, b, h) do { _Pragma("unroll") for (int m = 0; m < 4; ++m) dst[m] = cat8(*(const LAS bf16x8*)(lds + PG8_SA(b, h) + aoff + m * 2048), *(const LAS bf16x8*)(lds + PG8_SA(b, h) + aoff + m * 2048 + 1024)); } while (0)
#define PG8_LDB(dst, b, h) do { _Pragma("unroll") for (int n = 0; n < 2; ++n) dst[n] = cat8(*(const LAS bf16x8*)(lds + PG8_SB(b, h) + boff + n * 2048), *(const LAS bf16x8*)(lds + PG8_SB(b, h) + boff + n * 2048 + 1024)); } while (0)
#define PG8_LO(v) __builtin_bit_cast(bf16x8, __builtin_shufflevector(v, v, 0, 1, 2, 3))
#define PG8_HI(v) __builtin_bit_cast(bf16x8, __builtin_shufflevector(v, v, 4, 5, 6, 7))
#define PG8_MMA(ai, bj, At, Bt) do { __builtin_amdgcn_s_setprio(1); _Pragma("unroll") for (int m = 0; m < 4; ++m) _Pragma("unroll") for (int n = 0; n < 2; ++n) { \
        if constexpr (FP8) { acc[ai][bj][m][n] = __builtin_amdgcn_mfma_scale_f32_16x16x128_f8f6f4(Bt[n], At[m], acc[ai][bj][m][n], 0, 0, 0, 0x7f7f7f7f, 0, 0x7f7f7f7f); } \
        else { acc[ai][bj][m][n] = __builtin_amdgcn_mfma_f32_16x16x32_bf16(PG8_LO(Bt[n]), PG8_LO(At[m]), acc[ai][bj][m][n], 0, 0, 0); \
               acc[ai][bj][m][n] = __builtin_amdgcn_mfma_f32_16x16x32_bf16(PG8_HI(Bt[n]), PG8_HI(At[m]), acc[ai][bj][m][n], 0, 0, 0); } } \
        __builtin_amdgcn_s_setprio(0); } while (0)
#define PG8_WAIT_V(n) asm volatile("s_waitcnt vmcnt(" #n ")" ::: "memory")
#define PG8_WAIT_L(n) asm volatile("s_waitcnt lgkmcnt(" #n ")" ::: "memory")
#define PG8_BAR __builtin_amdgcn_s_barrier()
#define PG8_SCHED __builtin_amdgcn_sched_barrier(0)
    Unit cur, nxt; int ui = 0;
    if (!S.next(0, cur)) return;
    if constexpr (GATHER) { PG8_GATHER_LOAD(Vc, cur.rows); }
    f32x4 acc[2][2][4][2];
#pragma unroll
    for (int a = 0; a < 2; ++a)
#pragma unroll
        for (int b = 0; b < 2; ++b)
#pragma unroll
            for (int m = 0; m < 4; ++m)
#pragma unroll
                for (int n = 0; n < 2; ++n) acc[a][b][m][n] = (f32x4){0.f, 0.f, 0.f, 0.f};
    v8i32_t At[4], B0[2], B1[2];
    unsigned cA = cur.ao, cB = cur.bo;
    PG8_STAGE_B(PG8_SB(0, 0), cB); PG8_STAGE_B(PG8_SB(0, 1), cB + hstep); PG8_STAGE_A(PG8_SA(0, 0), cA, 0, Vc); PG8_STAGE_A(PG8_SA(0, 1), cA, 1, Vc);
    if (wr == 1) PG8_BAR;
    PG8_WAIT_V(2); PG8_BAR;
    PG8_STAGE_B(PG8_SB(1, 0), cB + kstep); PG8_STAGE_A(PG8_SA(1, 0), cA + kstep, 0, Vc); PG8_STAGE_B(PG8_SB(1, 1), cB + hstep + kstep);
    PG8_WAIT_V(6); PG8_BAR;
    for (;;) {
        const bool has_next = S.next(ui + 1, nxt);
        const unsigned nA = has_next ? nxt.ao : cA; const unsigned nB = has_next ? nxt.bo : cB;
        if constexpr (GATHER) {
            if (has_next) { PG8_GATHER_LOAD(Vn, nxt.rows); }
            else {
#pragma unroll
                for (int i = 0; i < 2; ++i) { Vn[0][i] = Vc[0][i]; Vn[1][i] = Vc[1][i]; }
            }
        }
#pragma unroll 1
        for (int t = 0; t < nt; t += 2) {
            const bool last = (t == nt - 2);
            const unsigned a1 = cA + (unsigned)(t + 1) * kstep;
            const unsigned a2 = last ? nA : cA + (unsigned)(t + 2) * kstep; const unsigned b2 = last ? nB : cB + (unsigned)(t + 2) * kstep;
            const unsigned a3 = a2 + kstep; const unsigned b3 = b2 + kstep;
            PG8_LDB(B0, 0, 0); PG8_LDB(B1, 0, 1); PG8_SCHED; PG8_LDA(At, 0, 0); PG8_STAGE_A(PG8_SA(1, 1), a1, 1, Vc);
            if constexpr (GATHER) { if (last) {
#pragma unroll
                for (int i = 0; i < 2; ++i) { Vc[0][i] = Vn[0][i]; Vc[1][i] = Vn[1][i]; } } }
            PG8_WAIT_V(8); PG8_WAIT_L(0); PG8_BAR; PG8_MMA(0, 0, At, B0); PG8_MMA(0, 1, At, B1); PG8_BAR; PG8_SCHED;
            PG8_LDA(At, 0, 1); PG8_STAGE_B(PG8_SB(0, 0), b2); PG8_STAGE_B(PG8_SB(0, 1), b2 + hstep); PG8_STAGE_A(PG8_SA(0, 0), a2, 0, Vc);
            PG8_WAIT_V(8); PG8_WAIT_L(0); PG8_BAR; PG8_MMA(1, 0, At, B0); PG8_MMA(1, 1, At, B1); PG8_BAR; PG8_SCHED;
            PG8_LDB(B0, 1, 0); PG8_LDB(B1, 1, 1); PG8_SCHED; PG8_LDA(At, 1, 0); PG8_STAGE_A(PG8_SA(0, 1), a2, 1, Vc);
            PG8_WAIT_V(8); PG8_WAIT_L(0); PG8_BAR; PG8_MMA(0, 0, At, B0); PG8_MMA(0, 1, At, B1); PG8_BAR; PG8_SCHED;
            PG8_LDA(At, 1, 1); PG8_STAGE_B(PG8_SB(1, 0), b3); PG8_STAGE_B(PG8_SB(1, 1), b3 + hstep); PG8_STAGE_A(PG8_SA(1, 0), a3, 0, Vc);
            PG8_WAIT_V(8); PG8_WAIT_L(0); PG8_BAR; PG8_MMA(1, 0, At, B0); PG8_MMA(1, 1, At, B1); PG8_BAR; PG8_SCHED;
        }
        if constexpr (ALIGN_EPI) { if (wr == 0) PG8_BAR; }
        E(acc, cur, wr, wc, fr, fq);
        if (!has_next) break;
#pragma unroll
        for (int a = 0; a < 2; ++a)
#pragma unroll
            for (int b = 0; b < 2; ++b)
#pragma unroll
                for (int m = 0; m < 4; ++m)
#pragma unroll
                    for (int n = 0; n < 2; ++n) acc[a][b][m][n] = (f32x4){0.f, 0.f, 0.f, 0.f};
        cur = nxt; cA = nA; cB = nB; ++ui;
        if constexpr (ALIGN_EPI) { if (wr == 1) PG8_BAR; }
    }
    PG8_WAIT_V(0);
    if constexpr (!ALIGN_EPI) { if (wr == 0) PG8_BAR; }
    PG8_BAR;
#undef PG8_SA
#undef PG8_SB
#undef PG8_STAGE
#undef PG8_STAGE_A
#undef PG8_STAGE_B
#undef PG8_GATHER_LOAD
#undef PG8_LDA
#undef PG8_LDB
#undef PG8_LO
#undef PG8_HI
#undef PG8_MMA
#undef PG8_WAIT_V
#undef PG8_WAIT_L
#undef PG8_BAR
#undef PG8_SCHED
}

struct SchedInProj {
    const char* A; const char* B; int G, c;
    __device__ __forceinline__ bool next(int i, Unit& u) const {
        constexpr int nM = T / BM, nN = INW / BM, nwg = nM * nN;
        const long L = (long)i * G + c; if (L >= nwg) return false;
        int wgid = (int)L; { const int q = nwg / NXCD, r = nwg % NXCD, xcd = wgid % NXCD, off = wgid / NXCD; wgid = (xcd < r ? xcd * (q + 1) : r * (q + 1) + (xcd - r) * q) + off; }
        const int nig = WGM * nN, gid = wgid / nig, fm = gid * WGM, gsz = (nM - fm) < WGM ? (nM - fm) : WGM;
        u.pm = fm + ((wgid % nig) % gsz); u.pn = (wgid % nig) / gsz; u.e = 0; u.rows = nullptr;
        u.ao = (unsigned)u.pm * (unsigned)(2 * HALF * KD * 2); u.bo = (unsigned)u.pn * (unsigned)(2 * HALF * KD * 2); return true;
    }
};
struct SchedPanel {
    const char* A; const char* B; int pm;
    __device__ __forceinline__ bool next(int i, Unit& u) const {
        if (i >= 4) return false;
        u.pm = pm; u.pn = i; u.e = 0; u.rows = nullptr; u.ao = (unsigned)pm * (unsigned)(256 * KD * 2); u.bo = (unsigned)i * (unsigned)(256 * KD * 2); return true;
    }
};
template <int NPN, bool G1>
struct SchedMoe {
    const char* A; const char* B; const int* tile_e; const int* tok; int ntiles, G, c;
    __device__ __forceinline__ bool next(int i, Unit& u) const {
        const long L = (long)i * G + c; int t, pn;
        if ((G & 7) == 0) { const int x = (int)(L & 7); const long j = L >> 3; t = (int)(j / NPN) * 8 + x; pn = (int)(j % NPN); }
        else { t = (int)(L / NPN); pn = (int)(L % NPN); }
        if (t >= ntiles) return false;
        const int e = tile_e[t];
        u.pm = t; u.pn = pn; u.e = e;
        if (G1) { u.ao = 0u; u.rows = tok + (size_t)t * 256; u.bo = ((unsigned)e * 2048u + (unsigned)pn * 256u) * 1024u; }
        else { u.ao = (unsigned)t * (256u * 1024u); u.rows = nullptr; u.bo = ((unsigned)e * 1024u + (unsigned)pn * 256u) * 1024u; }
        return true;
    }
};

struct EpiInProj {
    bf16_t* qkv; const float* b_in; const float* rope; float* ksum;
    __device__ __forceinline__ void operator()(const f32x4 (&acc)[2][2][4][2], const Unit& u, int wr, int wc, int fr, int fq) const {
        const int pn = u.pn;
        const int colb = 256 * pn + 64 * wc + 8 * fq;
        const bool do_rope = !(pn >= 7 || (pn == 2 && wc >= 2));
        const bool is_q = (pn < 2) || (pn == 3) || (pn == 4);
        const bool is_kb = (pn == 5) || (pn == 6);
        const float sc = is_q ? C2 : 1.0f;
        f32x4 bv[2][2];
#pragma unroll
        for (int bj = 0; bj < 2; ++bj)
#pragma unroll
            for (int n = 0; n < 2; ++n) bv[bj][n] = *(const f32x4*)(b_in + colb + 32 * bj + 4 * n);
        f32x4 ks[2][2];
#pragma unroll
        for (int bj = 0; bj < 2; ++bj)
#pragma unroll
            for (int n = 0; n < 2; ++n) ks[bj][n] = (f32x4){0.f, 0.f, 0.f, 0.f};
#pragma unroll
        for (int ai = 0; ai < 2; ++ai)
#pragma unroll
            for (int m = 0; m < 4; ++m) {
                const int row = u.pm * 256 + ai * 128 + wr * 64 + m * 16 + fr;
                const int pos = row & (SEQ - 1);
                f32x4 o1[2], o2[2];
#pragma unroll
                for (int n = 0; n < 2; ++n) { o1[n] = acc[ai][0][m][n] + bv[0][n]; o2[n] = acc[ai][1][m][n] + bv[1][n]; }
                if (do_rope) {
                    const float* rp = rope + pos * 64 + 8 * fq;
#pragma unroll
                    for (int n = 0; n < 2; ++n) { const f32x4 c = *(const f32x4*)(rp + 4 * n), s = *(const f32x4*)(rp + 32 + 4 * n);
                        const f32x4 a = o1[n], b = o2[n]; o1[n] = a * c - b * s; o2[n] = b * c + a * s; }
                }
                if (is_kb) {
#pragma unroll
                    for (int n = 0; n < 2; ++n) { ks[0][n] += o1[n]; ks[1][n] += o2[n]; }
                }
                bf16_t* rowp = qkv + (size_t)row * INW + colb;
                u32x4 w1, w2;
                w1.x = cvtpk(o1[0][0] * sc, o1[0][1] * sc); w1.y = cvtpk(o1[0][2] * sc, o1[0][3] * sc); w1.z = cvtpk(o1[1][0] * sc, o1[1][1] * sc); w1.w = cvtpk(o1[1][2] * sc, o1[1][3] * sc);
                w2.x = cvtpk(o2[0][0] * sc, o2[0][1] * sc); w2.y = cvtpk(o2[0][2] * sc, o2[0][3] * sc); w2.z = cvtpk(o2[1][0] * sc, o2[1][1] * sc); w2.w = cvtpk(o2[1][2] * sc, o2[1][3] * sc);
                *(u32x4*)(rowp) = w1; *(u32x4*)(rowp + 32) = w2;
            }
        if (is_kb) {
            float* kd = ksum + (size_t)u.pm * 512 + 256 * (pn - 5) + 64 * wc + 8 * fq;
#pragma unroll
            for (int bj = 0; bj < 2; ++bj)
#pragma unroll
                for (int n = 0; n < 2; ++n)
#pragma unroll
                    for (int j = 0; j < 4; ++j) {
                        float v = ks[bj][n][j];
                        v += __shfl_xor(v, 1); v += __shfl_xor(v, 2); v += __shfl_xor(v, 4); v += __shfl_xor(v, 8);
                        if (fr == 0) atomicAdd(kd + 32 * bj + 4 * n + j, v);
                    }
        }
    }
};
struct EpiOutProj {
    float* y; const float* b_out; const float* x;
    __device__ __forceinline__ void operator()(const f32x4 (&acc)[2][2][4][2], const Unit& u, int wr, int wc, int fr, int fq) const {
        const int col0 = u.pn * 256 + wc * 32 + 8 * fq;
        f32x4 bv[2][2];
#pragma unroll
        for (int bj = 0; bj < 2; ++bj)
#pragma unroll
            for (int n = 0; n < 2; ++n) bv[bj][n] = *(const f32x4*)(b_out + col0 + 128 * bj + 4 * n);
#pragma unroll
        for (int ai = 0; ai < 2; ++ai)
#pragma unroll
            for (int m = 0; m < 4; ++m) {
                const size_t off = (size_t)(u.pm * 256 + ai * 128 + wr * 64 + m * 16 + fr) * D + col0;
#pragma unroll
                for (int bj = 0; bj < 2; ++bj)
#pragma unroll
                    for (int n = 0; n < 2; ++n) { const f32x4 xv = *(const f32x4*)(x + off + 128 * bj + 4 * n);
                        *(f32x4*)(y + off + 128 * bj + 4 * n) = acc[ai][bj][m][n] + bv[bj][n] + xv * DN_ALPHA; }
                if (m & 1) asm volatile("" ::: "memory");
            }
    }
};
struct EpiSwiglu {
    unsigned char* act8; const float* b1;
    __device__ __forceinline__ void operator()(const f32x4 (&acc)[2][2][4][2], const Unit& u, int wr, int wc, int fr, int fq) const {
        const int a0 = 128 * u.pn + 32 * wc + 8 * fq;
        const float* bp = b1 + (size_t)u.e * 2048 + 2 * a0;
        f32x4 bb[4];
#pragma unroll
        for (int q = 0; q < 4; ++q) bb[q] = *(const f32x4*)(bp + 4 * q);
        unsigned char* tile = act8 + (size_t)u.pm * (256 * 1024);
#pragma unroll
        for (int ai = 0; ai < 2; ++ai)
#pragma unroll
            for (int m = 0; m < 4; ++m) {
                const int row = ai * 128 + wr * 64 + m * 16 + fr;
                float r[8];
#pragma unroll
                for (int n = 0; n < 2; ++n)
#pragma unroll
                    for (int j = 0; j < 4; ++j) {
                        const int q = 4 * n + j;
                        float g = acc[ai][0][m][n][j] * (1.0f / W_SCALE) + bb[q >> 1][(2 * q) & 3];
                        float l = acc[ai][1][m][n][j] * (1.0f / W_SCALE) + bb[q >> 1][((2 * q) & 3) + 1];
                        g = fminf(g, 7.0f); l = fminf(fmaxf(l, -7.0f), 7.0f);
                        const float sg = __builtin_amdgcn_rcpf(1.0f + __builtin_amdgcn_exp2f(-1.702f * LOG2E * g));
                        r[q] = g * sg * (l + 1.0f) * ACT_SCALE;
                    }
                u32x2 w; w.x = pk4_fp8(r[0], r[1], r[2], r[3]); w.y = pk4_fp8(r[4], r[5], r[6], r[7]);
                *(u32x2*)(tile + (size_t)row * 1024 + (size_t)a0) = w;
            }
    }
};
struct EpiDown {
    bf16_t* yb; const float* b2;
    __device__ __forceinline__ void operator()(const f32x4 (&acc)[2][2][4][2], const Unit& u, int wr, int wc, int fr, int fq) const {
        const int col0 = u.pn * 256 + wc * 32 + 8 * fq;
        const float* bp = b2 + (size_t)u.e * 1024 + col0;
        f32x4 bv[2][2];
#pragma unroll
        for (int bj = 0; bj < 2; ++bj)
#pragma unroll
            for (int n = 0; n < 2; ++n) bv[bj][n] = *(const f32x4*)(bp + 128 * bj + 4 * n);
#pragma unroll
        for (int ai = 0; ai < 2; ++ai)
#pragma unroll
            for (int m = 0; m < 4; ++m) {
                bf16_t* rowp = yb + (size_t)(u.pm * 256 + ai * 128 + wr * 64 + m * 16 + fr) * 1024 + col0;
#pragma unroll
                for (int bj = 0; bj < 2; ++bj) { const f32x4 v0 = acc[ai][bj][m][0] * (1.0f / (W_SCALE * ACT_SCALE)) + bv[bj][0], v1 = acc[ai][bj][m][1] * (1.0f / (W_SCALE * ACT_SCALE)) + bv[bj][1];
                    u32x4 w; w.x = cvtpk(v0[0], v0[1]); w.y = cvtpk(v0[2], v0[3]); w.z = cvtpk(v1[0], v1[1]); w.w = cvtpk(v1[2], v1[3]);
                    *(u32x4*)(rowp + 128 * bj) = w; }
            }
    }
};
}

namespace att {
constexpr int PITCH = INW, SLOTB = 8192;
constexpr int L_K = 0, L_V = 2 * SLOTB, L_WS = 4 * SLOTB, L_KS = L_WS + 2048, L_OST = L_KS + 2048, L_END = L_OST + 8 * 4096;
constexpr float NEG = -1.0e30f, M0 = -1.0e20f;
typedef LAS const char* lds_cptr;
__device__ __forceinline__ int crow(int r, int hi) { return (r & 3) + 8 * (r >> 2) + 4 * hi; }
__device__ __forceinline__ void glds16(const void* gsrc, unsigned lds_dst) { unsigned keep;
    asm volatile("s_mov_b32 %0, m0\n\ts_mov_b32 m0, %2\n\ts_nop 0\n\tglobal_load_lds_dwordx4 %1, off\n\ts_mov_b32 m0, %0" : "=&s"(keep) : "v"(gsrc), "s"(lds_dst) : "memory"); }
#define ATT_WAIT_BAR0() asm volatile("s_waitcnt vmcnt(0) lgkmcnt(0)\n\ts_barrier" ::: "memory")
#define ATT_SBAR() __builtin_amdgcn_sched_barrier(0)

__device__ __forceinline__ void qkt(f32x16& p0, f32x16& p1, lds_cptr kb, const bf16x8* qr) {
    const f32x16 z = {};
#pragma unroll
    for (int d0 = 0; d0 < 4; ++d0) {
        const bf16x8 b0 = *(const LAS bf16x8*)(kb + d0 * 2048);
        const bf16x8 b1 = *(const LAS bf16x8*)(kb + d0 * 2048 + 512);
        if (d0 == 0) { p0 = __builtin_amdgcn_mfma_f32_32x32x16_bf16(b0, qr[0], z, 0, 0, 0); p1 = __builtin_amdgcn_mfma_f32_32x32x16_bf16(b1, qr[0], z, 0, 0, 0); }
        else { p0 = __builtin_amdgcn_mfma_f32_32x32x16_bf16(b0, qr[d0], p0, 0, 0, 0); p1 = __builtin_amdgcn_mfma_f32_32x32x16_bf16(b1, qr[d0], p1, 0, 0, 0); }
    }
}
__device__ __forceinline__ float rowmax32(const f32x16& p0, const f32x16& p1) {
    float a = fmaxf(p0[0], p1[0]);
#pragma unroll
    for (int r = 1; r < 16; ++r) a = fmaxf(a, fmaxf(p0[r], p1[r]));
    auto rr = __builtin_amdgcn_permlane32_swap(__float_as_uint(a), __float_as_uint(a), false, false);
    return fmaxf(__uint_as_float(rr[0]), __uint_as_float(rr[1]));
}
__device__ __forceinline__ void pv(f32x16* o, int vb, bf16x8 pa0, bf16x8 pa1, bf16x8 pa2, bf16x8 pa3) {
#pragma unroll
    for (int d0 = 0; d0 < 2; ++d0) { s16x4 lo[4], hi[4];
#pragma unroll
        for (int ks = 0; ks < 4; ++ks) {
            asm volatile("ds_read_b64_tr_b16 %0,%1 offset:%c2" : "=&v"(lo[ks]) : "v"(vb), "i"(d0 * 4096 + ks * 1024) : "memory");
            asm volatile("ds_read_b64_tr_b16 %0,%1 offset:%c2" : "=&v"(hi[ks]) : "v"(vb), "i"(d0 * 4096 + ks * 1024 + 512) : "memory"); }
        asm volatile("s_waitcnt lgkmcnt(0)" ::: "memory"); ATT_SBAR();
#define ATT_PK(k) (bf16x8){lo[k][0], lo[k][1], lo[k][2], lo[k][3], hi[k][0], hi[k][1], hi[k][2], hi[k][3]}
        o[d0] = __builtin_amdgcn_mfma_f32_32x32x16_bf16(pa0, ATT_PK(0), o[d0], 0, 0, 0);
        o[d0] = __builtin_amdgcn_mfma_f32_32x32x16_bf16(pa1, ATT_PK(1), o[d0], 0, 0, 0);
        o[d0] = __builtin_amdgcn_mfma_f32_32x32x16_bf16(pa2, ATT_PK(2), o[d0], 0, 0, 0);
        o[d0] = __builtin_amdgcn_mfma_f32_32x32x16_bf16(pa3, ATT_PK(3), o[d0], 0, 0, 0);
#undef ATT_PK
    }
}

template <bool MOBA>
__device__ __forceinline__ void attn_item(char* shm, const bf16_t* __restrict__ qkv, bf16_t* __restrict__ aout, int b, int hh, int qb, const float* __restrict__ sinks, const float* __restrict__ ksum) {
    int tid = threadIdx.x; asm volatile("" : "+v"(tid));
    const int lane = tid & 63, r32 = lane & 31, hi = lane >> 5; const int wid = __builtin_amdgcn_readfirstlane(tid >> 6);
    const long rowbase = (long)b * SEQ;
    int qa, qcol, kcol, vcol, ocol, kt0, kt1;
    if (MOBA) { qa = 256 * qb + 32 * wid; qcol = 768 + 64 * hh; kcol = 1280 + 64 * hh; vcol = 1792 + 64 * hh; ocol = 512 + 64 * hh; kt0 = 0; kt1 = 4 * qb + 4; }
    else { const int g = wid >> 1; qa = 64 * qb + 32 * (wid & 1); qcol = (4 * hh + g) * 64; kcol = 512 + 64 * hh; vcol = 640 + 64 * hh; ocol = qcol; kt0 = qb - 2 < 0 ? 0 : qb - 2; kt1 = qb + 1; }
    const bf16_t* Qw = qkv + (rowbase + qa) * PITCH + qcol;
    const bf16_t* Kh = qkv + rowbase * PITCH + kcol; const bf16_t* Vh = qkv + rowbase * PITCH + vcol;
    const unsigned lds0 = (unsigned)(uintptr_t)shm;
    float* wsf = (float*)(shm + L_WS) + wid * 64;
    const bf16_t* ksrc = Kh + (long)lane * PITCH + wid * 8;
    const bf16_t* vsrc = Vh + (long)(16 * (wid & 3) + (lane >> 2)) * PITCH + (wid >> 2) * 32 + (lane & 3) * 8;
    const unsigned kdst = lds0 + L_K + wid * 1024, vdst = lds0 + L_V + wid * 1024;
#define ATT_DMA_K(t, slot) glds16(ksrc + (long)(t) * 64 * PITCH, (unsigned)__builtin_amdgcn_readfirstlane(kdst + (slot)))
#define ATT_DMA_V(t, slot) glds16(vsrc + (long)(t) * 64 * PITCH, (unsigned)__builtin_amdgcn_readfirstlane(vdst + (slot)))
    const int vb0 = (int)(lds0 + L_V) + ((lane >> 4) & 1) * 32 + (lane & 3) * 8 + (4 * hi + ((lane & 15) >> 2)) * 64;
    const lds_cptr shm3 = (lds_cptr)shm; const lds_cptr kp0 = shm3 + L_K + hi * 1024 + r32 * 16;
    ATT_DMA_K(kt0, 0); ATT_DMA_V(kt0, 0);
    if (MOBA) { float* ksl = (float*)(shm + L_KS); ksl[tid] = ksum[((size_t)b * 8 + (tid >> 6)) * 512 + 64 * hh + (tid & 63)]; }
    bf16x8 qr[4];
#pragma unroll
    for (int d0 = 0; d0 < 4; ++d0) qr[d0] = *reinterpret_cast<const bf16x8*>(&Qw[(long)r32 * PITCH + d0 * 16 + hi * 8]);
    float m_run, l_run;
    if (MOBA) { m_run = M0; l_run = 0.f; }
    else { m_run = sinks[4 * hh + (wid >> 1)] * LOG2E; l_run = (hi == 0) ? 1.0f : 0.0f; }
    f32x16 o[2]; o[0] = f32x16{}; o[1] = f32x16{};
    ATT_WAIT_BAR0();
    unsigned sel = 0u;
    if (MOBA) {
        if (qb <= 3) sel = (1u << qb) - 1u;
        else {
            const float* ksl = (const float*)(shm + L_KS);
            float gv[7];
#pragma unroll
            for (int i = 0; i < 7; ++i) {
                float s = 0.f;
#pragma unroll
                for (int d0 = 0; d0 < 4; ++d0) {
                    const f32x4 k0 = *(const f32x4*)(ksl + i * 64 + 16 * d0 + 8 * hi), k1 = *(const f32x4*)(ksl + i * 64 + 16 * d0 + 8 * hi + 4);
#pragma unroll
                    for (int jj = 0; jj < 4; ++jj) { s += bf2f((unsigned short)qr[d0][jj]) * k0[jj]; s += bf2f((unsigned short)qr[d0][4 + jj]) * k1[jj]; }
                }
                auto rr = __builtin_amdgcn_permlane32_swap(__float_as_uint(s), __float_as_uint(s), false, false);
                s = __uint_as_float(rr[0]) + __uint_as_float(rr[1]);
                gv[i] = (i < qb) ? s : -INFINITY;
            }
#pragma unroll
            for (int rk = 0; rk < 3; ++rk) { float best = -INFINITY; int bi = 0;
#pragma unroll
                for (int i = 0; i < 7; ++i) { const bool c = (((sel >> i) & 1u) == 0u) && (gv[i] > best); best = c ? gv[i] : best; bi = c ? i : bi; }
                sel |= 1u << bi; }
        }
    }
    const int NT = kt1 - kt0;
    for (int it = 0; it < NT; ++it) {
        const int kt = kt0 + it; const int cur = (it & 1) * SLOTB;
        if (it + 1 < NT) { ATT_DMA_K(kt + 1, cur ^ SLOTB); ATT_DMA_V(kt + 1, cur ^ SLOTB); }
        bool need;
        if (MOBA) need = (kt < 4 * qb) ? true : (64 * kt <= qa + 31);
        else need = (64 * kt + 63 >= qa - 127) && (64 * kt <= qa + 31);
        if (need) {
            f32x16 p0, p1; qkt(p0, p1, kp0 + cur, qr);
            if (MOBA && kt < 4 * qb) {
                const bool on = ((sel >> (kt >> 2)) & 1u) != 0u;
#pragma unroll
                for (int r = 0; r < 16; ++r) { p0[r] = on ? p0[r] : NEG; p1[r] = on ? p1[r] : NEG; }
            } else {
                const int dq = qa + r32 - 64 * kt - 4 * hi;
#pragma unroll
                for (int r = 0; r < 16; ++r) { const int d0_ = dq - ((r & 3) + 8 * (r >> 2)), d1_ = d0_ - 32;
                    const bool v0 = MOBA ? (d0_ >= 0) : ((unsigned)d0_ < 128u), v1 = MOBA ? (d1_ >= 0) : ((unsigned)d1_ < 128u);
                    p0[r] = v0 ? p0[r] : NEG; p1[r] = v1 ? p1[r] : NEG; }
            }
            const float rm = rowmax32(p0, p1);
            const float mnew = fmaxf(m_run, rm);
            const float f = __builtin_amdgcn_exp2f(m_run - mnew);
            m_run = mnew; l_run *= f;
            if (hi == 0) wsf[r32] = f;
            LDS_WAIT();
#pragma unroll
            for (int r = 0; r < 16; ++r) { const float fr_ = wsf[crow(r, hi)]; o[0][r] *= fr_; o[1][r] *= fr_; }
            float sacc = 0.f;
#pragma unroll
            for (int r = 0; r < 16; ++r) { p0[r] = __builtin_amdgcn_exp2f(p0[r] - mnew); p1[r] = __builtin_amdgcn_exp2f(p1[r] - mnew); sacc += p0[r] + p1[r]; }
            l_run += sacc;
            u32x4 pw0, pw1, pw2, pw3;
            pw0 = (u32x4){cvtpk(p0[0], p0[1]), cvtpk(p0[2], p0[3]), cvtpk(p0[4], p0[5]), cvtpk(p0[6], p0[7])};
            pw1 = (u32x4){cvtpk(p0[8], p0[9]), cvtpk(p0[10], p0[11]), cvtpk(p0[12], p0[13]), cvtpk(p0[14], p0[15])};
            pw2 = (u32x4){cvtpk(p1[0], p1[1]), cvtpk(p1[2], p1[3]), cvtpk(p1[4], p1[5]), cvtpk(p1[6], p1[7])};
            pw3 = (u32x4){cvtpk(p1[8], p1[9]), cvtpk(p1[10], p1[11]), cvtpk(p1[12], p1[13]), cvtpk(p1[14], p1[15])};
            ATT_SBAR();
            pv(o, vb0 + cur, __builtin_bit_cast(bf16x8, pw0), __builtin_bit_cast(bf16x8, pw1), __builtin_bit_cast(bf16x8, pw2), __builtin_bit_cast(bf16x8, pw3));
        }
        if (it + 1 < NT) ATT_WAIT_BAR0();
    }
    { auto rr = __builtin_amdgcn_permlane32_swap(__float_as_uint(l_run), __float_as_uint(l_run), false, false); l_run = __uint_as_float(rr[0]) + __uint_as_float(rr[1]); }
    if (hi == 0) wsf[32 + r32] = l_run;
    LDS_WAIT();
    float rli[16];
#pragma unroll
    for (int r = 0; r < 16; ++r) rli[r] = __builtin_amdgcn_rcpf(wsf[32 + crow(r, hi)]);
    bf16_t* Ow = aout + (rowbase + qa) * D + ocol;
    { bf16_t* stg = (bf16_t*)(shm + L_OST) + wid * 2048;
#pragma unroll
        for (int r = 0; r < 16; ++r) { const int orow = crow(r, hi);
#pragma unroll
            for (int d0 = 0; d0 < 2; ++d0) stg[orow * 64 + d0 * 32 + r32] = (bf16_t)f2bf(o[d0][r] * rli[r]); }
        LDS_WAIT();
#pragma unroll
        for (int i = 0; i < 4; ++i) { const int row = i * 8 + (lane >> 3), ch = lane & 7; const u32x4 v = *(const u32x4*)(stg + row * 64 + ch * 8); *(u32x4*)(Ow + (long)row * D + ch * 8) = v; } }
    asm volatile("s_waitcnt lgkmcnt(0)\n\ts_barrier" ::: "memory");
#undef ATT_DMA_K
#undef ATT_DMA_V
}
}

__device__ __forceinline__ void sincos_d(double a, double& s, double& c) {
    const double q = __builtin_rint(a * 0.63661977236758134308);
    double r = __builtin_fma(-q, 1.57079632679489655800e+00, a);
    r = __builtin_fma(-q, 6.12323399573676603587e-17, r);
    const double r2 = r * r;
    double sp = -1.0 / 1307674368000.0;
    sp = sp * r2 + 1.0 / 6227020800.0; sp = sp * r2 - 1.0 / 39916800.0; sp = sp * r2 + 1.0 / 362880.0; sp = sp * r2 - 1.0 / 5040.0; sp = sp * r2 + 1.0 / 120.0; sp = sp * r2 - 1.0 / 6.0;
    const double sr = r + r * r2 * sp;
    double cp = 1.0 / 20922789888000.0;
    cp = cp * r2 - 1.0 / 87178291200.0; cp = cp * r2 + 1.0 / 479001600.0; cp = cp * r2 - 1.0 / 3628800.0; cp = cp * r2 + 1.0 / 40320.0; cp = cp * r2 - 1.0 / 720.0; cp = cp * r2 + 1.0 / 24.0; cp = cp * r2 - 0.5;
    const double cr = 1.0 + r2 * cp;
    const int n = ((int)q) & 3;
    s = (n == 0) ? sr : (n == 1) ? cr : (n == 2) ? -sr : -cr;
    c = (n == 0) ? cr : (n == 1) ? -sr : (n == 2) ? -cr : sr;
}
__device__ __forceinline__ int sigma_col(int p, int mode) {
    if (mode == 0) return (p & ~255) + 64 * ((p >> 5) & 3) + 32 * ((p >> 7) & 1) + pg8::perm32(p & 31);
    if (mode == 1) return (p & ~31) + pg8::perm32(p & 31);
    const int pn = p >> 8, q = p & 255; return 2 * (128 * pn + 32 * ((q >> 5) & 3) + pg8::perm32(q & 31)) + (q >> 7);
}
__device__ __forceinline__ void p0_transpose_item(const float* __restrict__ W, int N, bf16_t* __restrict__ WT, int mode, LAS float* scr, int item, int lane) {
    const int nblk = N / 32, kb = item / nblk, nb = item % nblk, k0 = 64 * kb, p0 = 32 * nb;
    const int sc = sigma_col(p0 + (lane & 31), mode);
#pragma unroll 8
    for (int i = 0; i < 32; ++i) { const int kk = 2 * i + (lane >> 5); scr[kk * 33 + (lane & 31)] = W[(size_t)(k0 + kk) * N + sc]; }
    LDS_WAIT(); asm volatile("" ::: "memory");
    const int c = lane & 7;
#pragma unroll
    for (int j = 0; j < 4; ++j) { const int n = (lane >> 3) + 8 * j; const LAS float* s = scr + (8 * c) * 33 + n;
        u32x4 o; o.x = cvtpk(s[0 * 33], s[1 * 33]); o.y = cvtpk(s[2 * 33], s[3 * 33]); o.z = cvtpk(s[4 * 33], s[5 * 33]); o.w = cvtpk(s[6 * 33], s[7 * 33]);
        *(u32x4*)(WT + (size_t)(p0 + n) * 1024 + k0 + 8 * c) = o; }
    LDS_WAIT(); asm volatile("" ::: "memory");
}

__device__ __forceinline__ void p0_transpose_item_fp8(const float* __restrict__ W, int N, unsigned char* __restrict__ WT, int mode, float scale, LAS float* scr, int item, int lane) {
    const int nblk = N / 32, kb = item / nblk, nb = item % nblk, k0 = 64 * kb, p0 = 32 * nb;
    const int sc = sigma_col(p0 + (lane & 31), mode);
#pragma unroll 8
    for (int i = 0; i < 32; ++i) { const int kk = 2 * i + (lane >> 5); scr[kk * 33 + (lane & 31)] = W[(size_t)(k0 + kk) * N + sc] * scale; }
    LDS_WAIT(); asm volatile("" ::: "memory");
    const int c = lane & 7;
#pragma unroll
    for (int j = 0; j < 4; ++j) { const int n = (lane >> 3) + 8 * j; const LAS float* s = scr + (8 * c) * 33 + n;
        u32x2 o; o.x = pk4_fp8(s[0 * 33], s[1 * 33], s[2 * 33], s[3 * 33]); o.y = pk4_fp8(s[4 * 33], s[5 * 33], s[6 * 33], s[7 * 33]);
        *(u32x2*)(WT + (size_t)(p0 + n) * 1024 + k0 + 8 * c) = o; }
    LDS_WAIT(); asm volatile("" ::: "memory");
}

__global__ void __launch_bounds__(NTHREADS, 2) fwd_megakernel(Params p) {
    extern __shared__ __attribute__((aligned(16))) unsigned char lds_raw[];
    LAS unsigned char* lds = (LAS unsigned char*)lds_raw;
    cg::grid_group grid = cg::this_grid();
#define PHASE_IDS() int tid = threadIdx.x; asm volatile("" : "+v"(tid)); const int lane = tid & 63, wave = __builtin_amdgcn_readfirstlane(tid >> 6); (void)lane; (void)wave
    const int G = gridDim.x, bx = blockIdx.x;
    unsigned char* ws = p.ws;
    unsigned* ctl = (unsigned*)(ws + WS_CTL);
    float* ksum = (float*)(ws + WS_KSUM);
    float* rope = (float*)(ws + WS_ROPE);
    bf16_t* w_in_t = (bf16_t*)(ws + WS_WIN_T); bf16_t* w_out_t = (bf16_t*)(ws + WS_WOUT_T);
    unsigned char* w1_8 = ws + WS_W1_8; unsigned char* w2_8 = ws + WS_W2_8; unsigned char* x1_8 = ws + WS_X1_8; unsigned char* act8 = ws + WS_ACT8;
    int* cnt_blk = (int*)(ws + WS_CNT); int* tile_e = (int*)(ws + WS_TILE_E);
    bf16_t* wr_hi = (bf16_t*)(ws + WS_WR_HI); bf16_t* wr_lo = (bf16_t*)(ws + WS_WR_LO);
    int* tok = (int*)(ws + WS_TOK);
    int* asg_e = (int*)(ws + WS_ASG_E); float* asg_g = (float*)(ws + WS_ASG_G); int* asg_d = (int*)(ws + WS_ASG_D);
    bf16_t* x1b = (bf16_t*)(ws + WS_X1B); bf16_t* x1lo = (bf16_t*)(ws + WS_X1LO);
    bf16_t* xb = (bf16_t*)(ws + WS_XB); bf16_t* attn_o = xb;
    bf16_t* qkv = (bf16_t*)(ws + WS_QKV);
    bf16_t* yb = (bf16_t*)(ws + WS_YB);

    REP(0) {
        PHASE_IDS();
        const long gt = (long)bx * NTHREADS + tid, gsz = (long)G * NTHREADS;
        for (long i = gt; i < 2048 * 32; i += gsz) {
            const int pos = (int)(i >> 5), k = (int)(i & 31);
            double inv = 1.0; for (int q = 0; q < k; ++q) inv *= 0.7498942093324559;
            double s, c; sincos_d((double)pos * inv, s, c);
            rope[pos * 64 + k] = (float)c; rope[pos * 64 + 32 + k] = (float)s;
        }
        for (long i = gt; i < 32 * 1024; i += gsz) {
            const int e = (int)(i >> 10), k = (int)(i & 1023); const float w = p.w_router[k * 32 + e];
            const unsigned h = f2bf(w); wr_hi[i] = (bf16_t)h; wr_lo[i] = (bf16_t)f2bf(w - bf2f(h));
        }
        LAS float* scr = (LAS float*)(lds + wave * 16384);
        const int gw = bx * 8 + wave, NGW = G * 8;
        constexpr int I_IN = 16 * (INW / 32), I_OUT = 16 * 32, I_W1 = 16 * 64, I_W2 = 16 * 32;
        constexpr int NITEMS = I_IN + I_OUT + NE * I_W1 + NE * I_W2;
        for (int it = gw; it < NITEMS; it += NGW) {
            int r = it;
            if (r < I_IN) { p0_transpose_item(p.w_in, INW, w_in_t, 0, scr, r, lane); continue; } r -= I_IN;
            if (r < I_OUT) { p0_transpose_item(p.w_out, 1024, w_out_t, 1, scr, r, lane); continue; } r -= I_OUT;
            if (r < NE * I_W1) { const int e = r / I_W1; p0_transpose_item_fp8(p.w1 + (size_t)e * 1024 * 2048, 2048, w1_8 + (size_t)e * 2048 * 1024, 2, W_SCALE, scr, r % I_W1, lane); continue; } r -= NE * I_W1;
            { const int e = r / I_W2; p0_transpose_item_fp8(p.w2 + (size_t)e * 1024 * 1024, 1024, w2_8 + (size_t)e * 1024 * 1024, 1, W_SCALE, scr, r % I_W2, lane); }
        }
        const f32x4* x4 = (const f32x4*)p.x; u32x4* xb4 = (u32x4*)xb;
        for (long i = gt; i < (long)T * D / 8; i += gsz) { const f32x4 a = x4[2 * i], b = x4[2 * i + 1];
            u32x4 o; o.x = cvtpk(a[0], a[1]); o.y = cvtpk(a[2], a[3]); o.z = cvtpk(b[0], b[1]); o.w = cvtpk(b[2], b[3]); xb4[i] = o; }
    }
    grid.sync();

    REP(1) {
        pg8::SchedInProj S{(const char*)xb, (const char*)w_in_t, G, bx};
        pg8::EpiInProj E{qkv, p.b_in, rope, ksum};
        pg8::gemm_phase<pg8::EpiInProj, pg8::SchedInProj, false, true>(lds, S, E);
    }
    grid.sync();

    REP(2) for (int u = bx; u < 256; u += G) {
        { const int b = u >> 3, h = u & 7;
            for (int j = 0; j < 8; ++j) att::attn_item<true>((char*)lds_raw, qkv, attn_o, b, h, j, p.sinks, ksum); }
        { const int b = u >> 3, kvh = (u >> 2) & 1, oct = u & 3;
            for (int i = 0; i < 8; ++i) att::attn_item<false>((char*)lds_raw, qkv, attn_o, b, kvh, oct * 8 + i, p.sinks, ksum); }
    }
    grid.sync();

    REP(3) for (int pm = bx; pm < T / 256; pm += G) {
        PHASE_IDS();
        {
            pg8::SchedPanel S{(const char*)attn_o, (const char*)w_out_t, pm};
            pg8::EpiOutProj E{p.out, p.b_out, p.x};
            pg8::gemm_phase<pg8::EpiOutProj, pg8::SchedPanel, false, true>(lds, S, E);
        }
        __syncthreads();
        {
#pragma unroll
            for (int i = 0; i < 16; ++i) { const int idx = tid + 512 * i, mat = idx >> 12, rw = (idx >> 7) & 31, ch = idx & 127;
                const u32x4 v = *(const u32x4*)((mat ? wr_lo : wr_hi) + rw * 1024 + ch * 8);
                *(LAS u32x4*)(lds + mat * 66048 + rw * 2064 + ch * 16) = v; }
        }
        {
            f32x4 gg[4], bb[4];
#pragma unroll
            for (int j = 0; j < 4; ++j) { gg[j] = *(const f32x4*)(p.ln1_g + 256 * j + 4 * lane); bb[j] = *(const f32x4*)(p.ln1_b + 256 * j + 4 * lane); }
            for (int rr = 0; rr < 32; rr += 4) {
                const size_t row0 = (size_t)pm * 256 + wave * 32 + rr;
                f32x4 v[4][4]; float sm[4], sq[4];
#pragma unroll
                for (int q = 0; q < 4; ++q) { const f32x4* yr = (const f32x4*)(p.out + (row0 + q) * D) + lane;
#pragma unroll
                    for (int j = 0; j < 4; ++j) v[q][j] = yr[64 * j]; }
#pragma unroll
                for (int q = 0; q < 4; ++q) { float s = 0.f;
#pragma unroll
                    for (int j = 0; j < 4; ++j) s += (v[q][j][0] + v[q][j][1]) + (v[q][j][2] + v[q][j][3]);
                    sm[q] = s; }
#pragma unroll
                for (int o = 1; o < 64; o <<= 1) {
#pragma unroll
                    for (int q = 0; q < 4; ++q) sm[q] += __shfl_xor(sm[q], o); }
#pragma unroll
                for (int q = 0; q < 4; ++q) { const float mean = sm[q] * (1.0f / D); float s2 = 0.f;
#pragma unroll
                    for (int j = 0; j < 4; ++j) { v[q][j] = v[q][j] - mean; s2 += (v[q][j][0] * v[q][j][0] + v[q][j][1] * v[q][j][1]) + (v[q][j][2] * v[q][j][2] + v[q][j][3] * v[q][j][3]); }
                    sq[q] = s2; }
#pragma unroll
                for (int o = 1; o < 64; o <<= 1) {
#pragma unroll
                    for (int q = 0; q < 4; ++q) sq[q] += __shfl_xor(sq[q], o); }
#pragma unroll
                for (int q = 0; q < 4; ++q) {
                    const float rstd = 1.0f / sqrtf(sq[q] * (1.0f / D) + LN_EPS);
#pragma unroll
                    for (int j = 0; j < 4; ++j) {
                        const f32x4 xv = v[q][j] * rstd * gg[j] + bb[j];
                        const unsigned h01 = cvtpk(xv[0], xv[1]), h23 = cvtpk(xv[2], xv[3]);
                        const float r0 = xv[0] - bf2f(h01 & 0xffffu), r1 = xv[1] - bf2f(h01 >> 16), r2 = xv[2] - bf2f(h23 & 0xffffu), r3 = xv[3] - bf2f(h23 >> 16);
                        u32x2 hv = {h01, h23}, lv = {cvtpk(r0, r1), cvtpk(r2, r3)};
                        *(u32x2*)(x1b + (row0 + q) * D + 256 * j + 4 * lane) = hv;
                        *(u32x2*)(x1lo + (row0 + q) * D + 256 * j + 4 * lane) = lv;
                        *(unsigned*)(x1_8 + (row0 + q) * D + 256 * j + 4 * lane) = pk4_fp8(xv[0], xv[1], xv[2], xv[3]);
                    }
                }
            }
        }
        __syncthreads();
        {
            const int fr = lane & 15, fq = lane >> 4;
            f32x4 lacc[2][2];
#pragma unroll
            for (int m = 0; m < 2; ++m)
#pragma unroll
                for (int n = 0; n < 2; ++n) lacc[m][n] = (f32x4){0.f, 0.f, 0.f, 0.f};
            const size_t r0 = (size_t)pm * 256 + wave * 32;
            const bf16_t* ah = x1b + (r0 + fr) * D + 8 * fq; const bf16_t* al = x1lo + (r0 + fr) * D + 8 * fq;
            const LAS unsigned char* bh = lds + fr * 2064 + 16 * fq; const LAS unsigned char* bl = bh + 66048;
#pragma unroll 4
            for (int k0 = 0; k0 < 1024; k0 += 32) {
                bf16x8 a_hi[2], a_lo[2], b_hi[2], b_lo[2];
#pragma unroll
                for (int m = 0; m < 2; ++m) { a_hi[m] = *(const bf16x8*)(ah + (size_t)m * 16 * D + k0); a_lo[m] = *(const bf16x8*)(al + (size_t)m * 16 * D + k0); }
#pragma unroll
                for (int n = 0; n < 2; ++n) { b_hi[n] = *(const LAS bf16x8*)(bh + n * 16 * 2064 + k0 * 2); b_lo[n] = *(const LAS bf16x8*)(bl + n * 16 * 2064 + k0 * 2); }
#pragma unroll
                for (int m = 0; m < 2; ++m)
#pragma unroll
                    for (int n = 0; n < 2; ++n) {
                        lacc[m][n] = __builtin_amdgcn_mfma_f32_16x16x32_bf16(a_hi[m], b_hi[n], lacc[m][n], 0, 0, 0);
                        lacc[m][n] = __builtin_amdgcn_mfma_f32_16x16x32_bf16(a_lo[m], b_hi[n], lacc[m][n], 0, 0, 0);
                        lacc[m][n] = __builtin_amdgcn_mfma_f32_16x16x32_bf16(a_hi[m], b_lo[n], lacc[m][n], 0, 0, 0);
                    }
            }
            __syncthreads();
            LAS float* lg = (LAS float*)lds;
#pragma unroll
            for (int m = 0; m < 2; ++m)
#pragma unroll
                for (int n = 0; n < 2; ++n)
#pragma unroll
                    for (int rg = 0; rg < 4; ++rg) lg[(wave * 32 + 16 * m + 4 * fq + rg) * 33 + 16 * n + fr] = lacc[m][n][rg];
        }
        __syncthreads();
        {
            LAS float* lg = (LAS float*)lds;
            LAS int* wcnt = (LAS int*)(lds + 36864);
            float t0 = -INFINITY, t1 = -INFINITY, t2 = -INFINITY, t3 = -INFINITY; int i0 = 0, i1 = 0, i2 = 0, i3 = 0;
            int rk0 = 0, rk1 = 0, rk2 = 0, rk3 = 0;
            if (tid < 256) {
                for (int e = 0; e < NE; ++e) {
                    const float xv = lg[tid * 33 + e] + p.b_router[e];
                    if (xv > t3) {
                        if (xv > t2) { t3 = t2; i3 = i2;
                            if (xv > t1) { t2 = t1; i2 = i1;
                                if (xv > t0) { t1 = t0; i1 = i0; t0 = xv; i0 = e; } else { t1 = xv; i1 = e; }
                            } else { t2 = xv; i2 = e; }
                        } else { t3 = xv; i3 = e; }
                    }
                }
                const unsigned selm = (1u << i0) | (1u << i1) | (1u << i2) | (1u << i3);
                for (int e = 0; e < NE; ++e) {
                    const bool has = ((selm >> e) & 1u) != 0u;
                    const unsigned long long bal = __ballot(has);
                    const int pre = __popcll(bal & ((1ull << lane) - 1ull));
                    if (e == i0) rk0 = pre; if (e == i1) rk1 = pre; if (e == i2) rk2 = pre; if (e == i3) rk3 = pre;
                    if (lane == 0) wcnt[wave * 32 + e] = __popcll(bal);
                }
            }
            __syncthreads();
            if (tid < 256) {
                const float e1 = __expf(t1 - t0), e2 = __expf(t2 - t0), e3 = __expf(t3 - t0);
                const float inv = 1.0f / (1.0f + e1 + e2 + e3);
                int b0 = 0, b1 = 0, b2 = 0, b3 = 0;
                for (int w = 0; w < wave; ++w) { b0 += wcnt[w * 32 + i0]; b1 += wcnt[w * 32 + i1]; b2 += wcnt[w * 32 + i2]; b3 += wcnt[w * 32 + i3]; }
                const size_t a = ((size_t)pm * 256 + tid) * 4;
                *(int4*)(asg_e + a) = make_int4(i0, i1, i2, i3);
                *(float4*)(asg_g + a) = make_float4(inv, e1 * inv, e2 * inv, e3 * inv);
                *(int4*)(asg_d + a) = make_int4(b0 + rk0, b1 + rk1, b2 + rk2, b3 + rk3);
            }
            if (tid < 32) cnt_blk[pm * 32 + tid] = wcnt[tid] + wcnt[32 + tid] + wcnt[64 + tid] + wcnt[96 + tid];
            __syncthreads();
        }
    }
    grid.sync();

    for (int pm = bx; pm < T / 256; pm += G) {
        PHASE_IDS();
        LAS int* part_all = (LAS int*)lds; LAS int* part_pre = part_all + 512; LAS int* tot = part_pre + 512; LAS int* pre = tot + 32; LAS int* poff = pre + 32;
        { const int e = tid & 31, seg = tid >> 5; int sa = 0, sp = 0;
            for (int bb = seg * 16; bb < seg * 16 + 16; ++bb) { const int c = cnt_blk[bb * 32 + e]; sa += c; sp += (bb < pm) ? c : 0; }
            part_all[tid] = sa; part_pre[tid] = sp; }
        __syncthreads();
        if (tid < 32) { int sa = 0, sp = 0; for (int s = 0; s < 16; ++s) { sa += part_all[s * 32 + tid]; sp += part_pre[s * 32 + tid]; } tot[tid] = sa; pre[tid] = sp; }
        __syncthreads();
        if (tid == 0) { int off = 0; for (int e = 0; e < NE; ++e) { poff[e] = off; off += ((tot[e] + 255) >> 8) << 8; } poff[32] = off; }
        __syncthreads();
        if (tid < 256) {
            const int token = pm * 256 + tid; const size_t a = (size_t)token * 4;
            const int4 ee = *(const int4*)(asg_e + a); const int4 rk = *(const int4*)(asg_d + a);
            const int d0 = poff[ee.x] + pre[ee.x] + rk.x, d1 = poff[ee.y] + pre[ee.y] + rk.y, d2 = poff[ee.z] + pre[ee.z] + rk.z, d3 = poff[ee.w] + pre[ee.w] + rk.w;
            *(int4*)(asg_d + a) = make_int4(d0, d1, d2, d3);
            tok[d0] = token; tok[d1] = token; tok[d2] = token; tok[d3] = token;
        }
        if (pm < NE) {
            const int e = pm, n = tot[e], np = ((n + 255) >> 8) << 8, o = poff[e];
            for (int i = n + tid; i < np; i += NTHREADS) tok[o + i] = 0;
            for (int i = tid; i < (np >> 8); i += NTHREADS) tile_e[(o >> 8) + i] = e;
        }
        if (pm == 0 && tid == 0) ctl[CW_NTILES] = (unsigned)(poff[32] >> 8);
        __syncthreads();
    }
    grid.sync();

    const int ntiles = (int)ctl[CW_NTILES];
    REP(5) {
        pg8::SchedMoe<8, true> S{(const char*)x1_8, (const char*)w1_8, tile_e, tok, ntiles, G, bx};
        pg8::EpiSwiglu E{act8, p.b1};
        pg8::gemm_phase<pg8::EpiSwiglu, pg8::SchedMoe<8, true>, true, true, 512, true>(lds, S, E);
    }
    grid.sync();

    REP(6) {
        pg8::SchedMoe<4, false> S{(const char*)act8, (const char*)w2_8, tile_e, tok, ntiles, G, bx};
        pg8::EpiDown E{yb, p.b2};
        pg8::gemm_phase<pg8::EpiDown, pg8::SchedMoe<4, false>, false, true, 512, true>(lds, S, E);
    }
    grid.sync();

    REP(7) {
        PHASE_IDS();
        const int gw = bx * 8 + wave, NGW = G * 8;
        f32x4 gg[2][2], bb[2][2];
#pragma unroll
        for (int j = 0; j < 2; ++j)
#pragma unroll
            for (int h = 0; h < 2; ++h) { gg[j][h] = *(const f32x4*)(p.ln2_g + 512 * j + 8 * lane + 4 * h); bb[j][h] = *(const f32x4*)(p.ln2_b + 512 * j + 8 * lane + 4 * h); }
        for (int row = gw; row < T; row += NGW) {
            const size_t a = (size_t)row * 4;
            const int4 dd = *(const int4*)(asg_d + a); const float4 gt4 = *(const float4*)(asg_g + a);
            u32x4 xr[2], y0[2], y1[2], y2[2], y3[2];
#pragma unroll
            for (int j = 0; j < 2; ++j) {
                xr[j] = *(const u32x4*)(x1b + (size_t)row * D + 512 * j + 8 * lane);
                y0[j] = *(const u32x4*)(yb + (size_t)dd.x * D + 512 * j + 8 * lane);
                y1[j] = *(const u32x4*)(yb + (size_t)dd.y * D + 512 * j + 8 * lane);
                y2[j] = *(const u32x4*)(yb + (size_t)dd.z * D + 512 * j + 8 * lane);
                y3[j] = *(const u32x4*)(yb + (size_t)dd.w * D + 512 * j + 8 * lane);
            }
            float z[2][8]; float s = 0.f;
#pragma unroll
            for (int j = 0; j < 2; ++j)
#pragma unroll
                for (int q = 0; q < 4; ++q) {
                    const unsigned xw = xr[j][q], a0 = y0[j][q], a1 = y1[j][q], a2 = y2[j][q], a3 = y3[j][q];
                    const float lo = DN_ALPHA * bf2f(xw & 0xffffu) + gt4.x * bf2f(a0 & 0xffffu) + gt4.y * bf2f(a1 & 0xffffu) + gt4.z * bf2f(a2 & 0xffffu) + gt4.w * bf2f(a3 & 0xffffu);
                    const float hi = DN_ALPHA * bf2f(xw >> 16) + gt4.x * bf2f(a0 >> 16) + gt4.y * bf2f(a1 >> 16) + gt4.z * bf2f(a2 >> 16) + gt4.w * bf2f(a3 >> 16);
                    z[j][2 * q] = lo; z[j][2 * q + 1] = hi; s += lo + hi;
                }
            const float mean = wave_sum(s) * (1.0f / D); float s2 = 0.f;
#pragma unroll
            for (int j = 0; j < 2; ++j)
#pragma unroll
                for (int q = 0; q < 8; ++q) { z[j][q] -= mean; s2 += z[j][q] * z[j][q]; }
            const float rstd = 1.0f / sqrtf(wave_sum(s2) * (1.0f / D) + LN_EPS);
#pragma unroll
            for (int j = 0; j < 2; ++j)
#pragma unroll
                for (int h = 0; h < 2; ++h) {
                    f32x4 o;
#pragma unroll
                    for (int q = 0; q < 4; ++q) o[q] = z[j][4 * h + q] * rstd * gg[j][h][q] + bb[j][h][q];
                    *(f32x4*)(p.out + (size_t)row * D + 512 * j + 8 * lane + 4 * h) = o;
                }
        }
    }
}

extern "C" void kernel_launch(void* const* d_in, const int* in_sizes, int n_in, void* d_out, int out_size, void* d_ws, size_t ws_size, hipStream_t stream) {
    static int grid_blocks = 0;
    if (grid_blocks == 0) {
        if (n_in != 16 || in_sizes[0] != T * D || out_size != T * D || ws_size < WS_END) {
            fprintf(stderr, "kernel_launch: unexpected shapes: n_in %d in0 %d out %d ws %zu (need %zu)\n", n_in, n_in > 0 ? in_sizes[0] : -1, out_size, ws_size, (size_t)WS_END); grid_blocks = -1; return; }
        int dev = 0, cus = 0, per_cu = 0;
        (void)hipGetDevice(&dev);
        (void)hipDeviceGetAttribute(&cus, hipDeviceAttributeMultiprocessorCount, dev);
        (void)hipFuncSetAttribute((const void*)fwd_megakernel, hipFuncAttributeMaxDynamicSharedMemorySize, LDS_BYTES);
        (void)hipOccupancyMaxActiveBlocksPerMultiprocessor(&per_cu, (const void*)fwd_megakernel, NTHREADS, LDS_BYTES);
        if (per_cu < 1) { fprintf(stderr, "kernel_launch: occupancy query reports %d blocks per CU\n", per_cu); per_cu = 1; }
        grid_blocks = cus;
        fprintf(stderr, "kernel_launch: cus=%d per_cu=%d grid=%d ws=%zu\n", cus, per_cu, grid_blocks, ws_size);
    }
    if (grid_blocks < 0) return;
    (void)hipMemsetAsync((char*)d_ws + WS_CTL, 0, CTL_ZERO_BYTES, stream);
    Params p{};
    p.x = (const float*)d_in[0]; p.w_in = (const float*)d_in[1]; p.b_in = (const float*)d_in[2]; p.sinks = (const float*)d_in[3]; p.w_out = (const float*)d_in[4]; p.b_out = (const float*)d_in[5];
    p.ln1_g = (const float*)d_in[6]; p.ln1_b = (const float*)d_in[7]; p.w_router = (const float*)d_in[8]; p.b_router = (const float*)d_in[9];
    p.w1 = (const float*)d_in[10]; p.b1 = (const float*)d_in[11]; p.w2 = (const float*)d_in[12]; p.b2 = (const float*)d_in[13]; p.ln2_g = (const float*)d_in[14]; p.ln2_b = (const float*)d_in[15];
    p.out = (float*)d_out; p.ws = (unsigned char*)d_ws;
    void* args[] = {&p};
    hipError_t e = hipLaunchCooperativeKernel((void*)fwd_megakernel, dim3(grid_blocks), dim3(NTHREADS), args, LDS_BYTES, stream);
    if (e != hipSuccess) fprintf(stderr, "cooperative launch failed: %s (grid %d)\n", hipGetErrorString(e), grid_blocks);
}
```

```cpp
#include <hip/hip_runtime.h>
#include <hip/hip_cooperative_groups.h>
#include <cstdio>
#include <cstdint>
namespace cg = cooperative_groups;

#define LAS __attribute__((address_space(3)))
typedef unsigned short bf16_t;
typedef short bf16x8 __attribute__((ext_vector_type(8)));
typedef short s16x4 __attribute__((ext_vector_type(4)));
typedef float f32x2 __attribute__((ext_vector_type(2)));
typedef float f32x4 __attribute__((ext_vector_type(4)));
typedef float f32x16 __attribute__((ext_vector_type(16)));
typedef unsigned u32x2 __attribute__((ext_vector_type(2)));
typedef unsigned u32x4 __attribute__((ext_vector_type(4)));
typedef __bf16 bf16x2_t __attribute__((ext_vector_type(2)));

constexpr int D = 1024, BATCH = 32, SEQ = 2048, T = BATCH * SEQ;
constexpr int INW = 2304, NE = 32;
constexpr float LN_EPS = 1e-5f;
constexpr float DN_ALPHA = 1.189207115002721f;
constexpr float LOG2E = 1.4426950408889634f;
constexpr float C2 = 0.18033688011112042f;
constexpr int NTHREADS = 512;
constexpr int LDS_BYTES = 147456;
constexpr int MAX_TILES = 1056;
#ifndef DUP_MASK
#define DUP_MASK 0
#endif
#define REP(k) for (int _rep = 0; _rep < (((DUP_MASK >> (k)) & 1) ? 2 : 1); ++_rep)

constexpr size_t MiB = 1u << 20;
constexpr size_t WS_CTL = 0, CTL_ZERO_BYTES = 2 * MiB;
constexpr size_t WS_KSUM = 1 * MiB;
constexpr size_t WS_ROPE = 2 * MiB;
constexpr size_t WS_WIN_T = 4 * MiB;
constexpr size_t WS_WOUT_T = 9 * MiB;
constexpr size_t WS_SMALL = 11 * MiB;
constexpr size_t WS_CNT = WS_SMALL, WS_TILE_E = WS_SMALL + 65536, WS_WR_HI = WS_SMALL + 131072, WS_WR_LO = WS_WR_HI + 65536;
constexpr size_t WS_TOK = 12 * MiB;
constexpr size_t WS_ASG_E = 14 * MiB, WS_ASG_G = 15 * MiB, WS_ASG_D = 16 * MiB;
constexpr size_t WS_W2_8 = 24 * MiB;
constexpr size_t WS_X1B = 56 * MiB;
constexpr size_t WS_ACT8 = 184 * MiB;
constexpr size_t WS_XB = 184 * MiB;
constexpr size_t WS_X1LO = 312 * MiB;
constexpr size_t WS_YB = 488 * MiB;
constexpr size_t WS_W1_8 = 488 * MiB;
constexpr size_t WS_X1_8 = 552 * MiB;
constexpr size_t WS_QKV = 616 * MiB;
constexpr size_t WS_END = 1016 * MiB;
constexpr float W_SCALE = 64.0f, ACT_SCALE = 4.0f;
constexpr int CW_NTILES = 16, CW_BAR = 4096;
constexpr int LDS_BARST = LDS_BYTES - 256;

struct Params {
    const float *x, *w_in, *b_in, *sinks, *w_out, *b_out, *ln1_g, *ln1_b, *w_router, *b_router, *w1, *b1, *w2, *b2, *ln2_g, *ln2_b;
    float* out; unsigned char* ws;
};

__device__ __forceinline__ unsigned f2bf(float f) { unsigned u = __builtin_bit_cast(unsigned, f); return (u + 0x7fffu + ((u >> 16) & 1u)) >> 16; }
__device__ __forceinline__ float bf2f(unsigned h) { return __builtin_bit_cast(float, h << 16); }
__device__ __forceinline__ unsigned cvtpk(float lo, float hi) { f32x2 v = {lo, hi}; bf16x2_t b = __builtin_convertvector(v, bf16x2_t); return __builtin_bit_cast(unsigned, b); }
__device__ __forceinline__ unsigned pk4_fp8(float a, float b, float c, float d) { int w = 0; w = __builtin_amdgcn_cvt_pk_fp8_f32(a, b, w, false); w = __builtin_amdgcn_cvt_pk_fp8_f32(c, d, w, true); return (unsigned)w; }
__device__ __forceinline__ float wave_sum(float v) {
#pragma unroll
    for (int o = 1; o < 64; o <<= 1) v += __shfl_xor(v, o);
    return v;
}
#define LDS_WAIT() asm volatile("s_waitcnt lgkmcnt(0)" ::: "memory")

namespace pg8 {
constexpr int BM = 256, BK = 64, HALF = 128, HTB = HALF * BK * 2, STAGE_BYTES = 8 * HTB, NXCD = 8, WGM = 8;
constexpr int KD = 1024;
__host__ __device__ __forceinline__ int lds_byte(int r, int c) { const int st = (r >> 4) * 2 + (c >> 5), rr = r & 15, cc = c & 31, ob = rr * 64 + cc * 2; return st * 1024 + (ob ^ (((ob >> 9) & 1) << 5)); }
__host__ __device__ __forceinline__ void stage_rc(int b, int& R, int& C) { const int st = b / 1024, sb = b % 1024, swz = sb ^ (((sb >> 9) & 1) << 5); R = (st >> 1) * 16 + swz / 64; C = (st & 1) * 32 + (swz % 64) / 2; }
__host__ __device__ __forceinline__ int perm32(int rho) { const int n = rho >> 4, i = rho & 15; return 8 * (i >> 2) + 4 * n + (i & 3); }

struct Unit { int pm, pn, e; unsigned ao, bo; const int* rows; };

typedef int v8i32_t __attribute__((ext_vector_type(8)));
typedef int v4i32_t __attribute__((ext_vector_type(4)));
__device__ __forceinline__ v8i32_t cat8(bf16x8 a, bf16x8 b) { const v4i32_t x = __builtin_bit_cast(v4i32_t, a), y = __builtin_bit_cast(v4i32_t, b); return __builtin_shufflevector(x, y, 0, 1, 2, 3, 4, 5, 6, 7); }
template <class Epi, class Sched, bool GATHER, bool ALIGN_EPI, int KP = 1024, bool FP8 = false>
__device__ __forceinline__ void gemm_phase(LAS unsigned char* lds, const Sched& S, const Epi& E) {
    int tid = threadIdx.x; asm volatile("" : "+v"(tid));
    const int wid = __builtin_amdgcn_readfirstlane(tid >> 6), lane = tid & 63, wr = wid >> 2, wc = wid & 3, fr = lane & 15, fq = lane >> 4;
    constexpr int K = KP, nt = K / BK;
    unsigned voffB[2], Vc[2][2], Vn[2][2]; int stR0, stC0;
    { int R, C; stage_rc(tid * 16, R, C); stR0 = R; stC0 = C; }
#pragma unroll
    for (int i = 0; i < 2; ++i) { voffB[i] = (unsigned)((stR0 + 64 * i) * K + stC0) * 2u; Vc[0][i] = voffB[i]; Vc[1][i] = voffB[i]; Vn[0][i] = voffB[i]; Vn[1][i] = voffB[i]; }
#define PG8_GATHER_LOAD(VV, rowsp) do { int _t = threadIdx.x; asm volatile("" : "+v"(_t)); int _R, _C; stage_rc(_t * 16, _R, _C);     \
        const int* _rp = (const int*)((const char*)(rowsp) + (unsigned)(_R * 4)); _Pragma("unroll") for (int _h = 0; _h < 2; ++_h) _Pragma("unroll") for (int _i = 0; _i < 2; ++_i) \
        VV[_h][_i] = ((unsigned)_rp[128 * _h + 64 * _i] * (unsigned)K + (unsigned)_C) * 2u; } while (0)
    constexpr unsigned kstep = (unsigned)(BK * 2);
    constexpr unsigned hstep = (unsigned)HALF * K * 2;
    const char* const Abase = S.A; const char* const Bbase = S.B;
    const unsigned ldsw = (unsigned)wid * 1024u;
    const int aoff = lds_byte(wr * 64 + fr, fq * 8), boff = lds_byte(wc * 32 + fr, fq * 8);
#define PG8_SA(b, h) (((b) * 2 + (h)) * HTB)
#define PG8_SB(b, h) ((4 + (b) * 2 + (h)) * HTB)
#define PG8_STAGE(bufoff, gbase, soff, voff) do { _Pragma("unroll") for (int _i = 0; _i < 2; ++_i) \
        __builtin_amdgcn_global_load_lds((const unsigned*)((gbase) + (unsigned)((voff)[_i] + (soff))), (LAS unsigned*)(lds + (bufoff) + ldsw + _i * 8192), 16, 0, 0); } while (0)
#define PG8_STAGE_B(bufoff, soff) PG8_STAGE(bufoff, Bbase, soff, voffB)
#define PG8_STAGE_A(bufoff, soff, h, VV) do { if constexpr (GATHER) { PG8_STAGE(bufoff, Abase, soff, VV[h]); } else { PG8_STAGE(bufoff, Abase, (soff) + (h) * hstep, voffB); } } while (0)
#define PG8_LDA(dst, b, h) do { _Pragma("unroll") for (int m = 0; m < 4; ++m) dst[m] = cat8(*(const LAS bf16x8*)(lds + PG8_SA(b, h) + aoff + m * 2048), *(const LAS bf16x8*)(lds + PG8_SA(b, h) + aoff + m * 2048 + 1024)); } while (0)
#define PG8_LDB(dst, b, h) do { _Pragma("unroll") for (int n = 0; n < 2; ++n) dst[n] = cat8(*(const LAS bf16x8*)(lds + PG8_SB(b, h) + boff + n * 2048), *(const LAS bf16x8*)(lds + PG8_SB(b, h) + boff + n * 2048 + 1024)); } while (0)
#define PG8_LO(v) __builtin_bit_cast(bf16x8, __builtin_shufflevector(v, v, 0, 1, 2, 3))
#define PG8_HI(v) __builtin_bit_cast(bf16x8, __builtin_shufflevector(v, v, 4, 5, 6, 7))
#define PG8_MMA(ai, bj, At, Bt) do { __builtin_amdgcn_s_setprio(1); _Pragma("unroll") for (int m = 0; m < 4; ++m) _Pragma("unroll") for (int n = 0; n < 2; ++n) { \
        if constexpr (FP8) { acc[ai][bj][m][n] = __builtin_amdgcn_mfma_scale_f32_16x16x128_f8f6f4(Bt[n], At[m], acc[ai][bj][m][n], 0, 0, 0, 0x7f7f7f7f, 0, 0x7f7f7f7f); } \
        else { acc[ai][bj][m][n] = __builtin_amdgcn_mfma_f32_16x16x32_bf16(PG8_LO(Bt[n]), PG8_LO(At[m]), acc[ai][bj][m][n], 0, 0, 0); \
               acc[ai][bj][m][n] = __builtin_amdgcn_mfma_f32_16x16x32_bf16(PG8_HI(Bt[n]), PG8_HI(At[m]), acc[ai][bj][m][n], 0, 0, 0); } } \
        __builtin_amdgcn_s_setprio(0); } while (0)
#define PG8_WAIT_V(n) asm volatile("s_waitcnt vmcnt(" #n ")" ::: "memory")
#define PG8_WAIT_L(n) asm volatile("s_waitcnt lgkmcnt(" #n ")" ::: "memory")
#define PG8_BAR __builtin_amdgcn_s_barrier()
#define PG8_SCHED __builtin_amdgcn_sched_barrier(0)
    Unit cur, nxt; int ui = 0;
    if (!S.next(0, cur)) return;
    if constexpr (GATHER) { PG8_GATHER_LOAD(Vc, cur.rows); }
    f32x4 acc[2][2][4][2];
#pragma unroll
    for (int a = 0; a < 2; ++a)
#pragma unroll
        for (int b = 0; b < 2; ++b)
#pragma unroll
            for (int m = 0; m < 4; ++m)
#pragma unroll
                for (int n = 0; n < 2; ++n) acc[a][b][m][n] = (f32x4){0.f, 0.f, 0.f, 0.f};
    v8i32_t At[4], B0[2], B1[2];
    unsigned cA = cur.ao, cB = cur.bo;
    PG8_STAGE_B(PG8_SB(0, 0), cB); PG8_STAGE_B(PG8_SB(0, 1), cB + hstep); PG8_STAGE_A(PG8_SA(0, 0), cA, 0, Vc); PG8_STAGE_A(PG8_SA(0, 1), cA, 1, Vc);
    if (wr == 1) PG8_BAR;
    PG8_WAIT_V(2); PG8_BAR;
    PG8_STAGE_B(PG8_SB(1, 0), cB + kstep); PG8_STAGE_A(PG8_SA(1, 0), cA + kstep, 0, Vc); PG8_STAGE_B(PG8_SB(1, 1), cB + hstep + kstep);
    PG8_WAIT_V(6); PG8_BAR;
    for (;;) {
        const bool has_next = S.next(ui + 1, nxt);
        const unsigned nA = has_next ? nxt.ao : cA; const unsigned nB = has_next ? nxt.bo : cB;
        if constexpr (GATHER) {
            if (has_next) { PG8_GATHER_LOAD(Vn, nxt.rows); }
            else {
#pragma unroll
                for (int i = 0; i < 2; ++i) { Vn[0][i] = Vc[0][i]; Vn[1][i] = Vc[1][i]; }
            }
        }
#pragma unroll 1
        for (int t = 0; t < nt; t += 2) {
            const bool last = (t == nt - 2);
            const unsigned a1 = cA + (unsigned)(t + 1) * kstep;
            const unsigned a2 = last ? nA : cA + (unsigned)(t + 2) * kstep; const unsigned b2 = last ? nB : cB + (unsigned)(t + 2) * kstep;
            const unsigned a3 = a2 + kstep; const unsigned b3 = b2 + kstep;
            PG8_LDB(B0, 0, 0); PG8_LDB(B1, 0, 1); PG8_SCHED; PG8_LDA(At, 0, 0); PG8_STAGE_A(PG8_SA(1, 1), a1, 1, Vc);
            if constexpr (GATHER) { if (last) {
#pragma unroll
                for (int i = 0; i < 2; ++i) { Vc[0][i] = Vn[0][i]; Vc[1][i] = Vn[1][i]; } } }
            PG8_WAIT_V(8); PG8_WAIT_L(0); PG8_BAR; PG8_MMA(0, 0, At, B0); PG8_MMA(0, 1, At, B1); PG8_BAR; PG8_SCHED;
            PG8_LDA(At, 0, 1); PG8_STAGE_B(PG8_SB(0, 0), b2); PG8_STAGE_B(PG8_SB(0, 1), b2 + hstep); PG8_STAGE_A(PG8_SA(0, 0), a2, 0, Vc);
            PG8_WAIT_V(8); PG8_WAIT_L(0); PG8_BAR; PG8_MMA(1, 0, At, B0); PG8_MMA(1, 1, At, B1); PG8_BAR; PG8_SCHED;
            PG8_LDB(B0, 1, 0); PG8_LDB(B1, 1, 1); PG8_SCHED; PG8_LDA(At, 1, 0); PG8_STAGE_A(PG8_SA(0, 1), a2, 1, Vc);
            PG8_WAIT_V(8); PG8_WAIT_L(0); PG8_BAR; PG8_MMA(0, 0, At, B0); PG8_MMA(0, 1, At, B1); PG8_BAR; PG8_SCHED;
            PG8_LDA(At, 1, 1); PG8_STAGE_B(PG8_SB(1, 0), b3); PG8_STAGE_B(PG8_SB(1, 1), b3 + hstep); PG8_STAGE_A(PG8_SA(1, 0), a3, 0, Vc);
            PG8_WAIT_V(8); PG8_WAIT_L(0); PG8_BAR; PG8_MMA(1, 0, At, B0); PG8_MMA(1, 1, At, B1); PG8_BAR; PG8_SCHED;
        }
        if constexpr (ALIGN_EPI) { if (wr == 0) PG8_BAR; }
        E(acc, cur, wr, wc, fr, fq);
        if (!has_next) break;
#pragma unroll
        for (int a = 0; a < 2; ++a)
#pragma unroll
            for (int b = 0; b < 2; ++b)
#pragma unroll
                for (int m = 0; m < 4; ++m)
#pragma unroll
                    for (int n = 0; n < 2; ++n) acc[a][b][m][n] = (f32x4){0.f, 0.f, 0.f, 0.f};
        cur = nxt; cA = nA; cB = nB; ++ui;
        if constexpr (ALIGN_EPI) { if (wr == 1) PG8_BAR; }
    }
    PG8_WAIT_V(0);
    if constexpr (!ALIGN_EPI) { if (wr == 0) PG8_BAR; }
    PG8_BAR;
#undef PG8_SA
#undef PG8_SB
#undef PG8_STAGE
#undef PG8_STAGE_A
#undef PG8_STAGE_B
#undef PG8_GATHER_LOAD
#undef PG8_LDA
#undef PG8_LDB
#undef PG8_LO
#undef PG8_HI
#undef PG8_MMA
#undef PG8_WAIT_V
#undef PG8_WAIT_L
#undef PG8_BAR
#undef PG8_SCHED
}

struct SchedInProj {
    const char* A; const char* B; int G, c;
    __device__ __forceinline__ bool next(int i, Unit& u) const {
        constexpr int nM = T / BM, nN = INW / BM, nwg = nM * nN;
        const long L = (long)i * G + c; if (L >= nwg) return false;
        int wgid = (int)L; { const int q = nwg / NXCD, r = nwg % NXCD, xcd = wgid % NXCD, off = wgid / NXCD; wgid = (xcd < r ? xcd * (q + 1) : r * (q + 1) + (xcd - r) * q) + off; }
        const int nig = WGM * nN, gid = wgid / nig, fm = gid * WGM, gsz = (nM - fm) < WGM ? (nM - fm) : WGM;
        u.pm = fm + ((wgid % nig) % gsz); u.pn = (wgid % nig) / gsz; u.e = 0; u.rows = nullptr;
        u.ao = (unsigned)u.pm * (unsigned)(2 * HALF * KD * 2); u.bo = (unsigned)u.pn * (unsigned)(2 * HALF * KD * 2); return true;
    }
};
struct SchedPanel {
    const char* A; const char* B; int pm;
    __device__ __forceinline__ bool next(int i, Unit& u) const {
        if (i >= 4) return false;
        u.pm = pm; u.pn = i; u.e = 0; u.rows = nullptr; u.ao = (unsigned)pm * (unsigned)(256 * KD * 2); u.bo = (unsigned)i * (unsigned)(256 * KD * 2); return true;
    }
};
template <int NPN, bool G1>
struct SchedMoe {
    const char* A; const char* B; const int* tile_e; const int* tok; int ntiles, G, c;
    __device__ __forceinline__ bool next(int i, Unit& u) const {
        const long L = (long)i * G + c; int t, pn;
        if ((G & 7) == 0) { const int x = (int)(L & 7); const long j = L >> 3; t = (int)(j / NPN) * 8 + x; pn = (int)(j % NPN); }
        else { t = (int)(L / NPN); pn = (int)(L % NPN); }
        if (t >= ntiles) return false;
        const int e = tile_e[t];
        u.pm = t; u.pn = pn; u.e = e;
        if (G1) { u.ao = 0u; u.rows = tok + (size_t)t * 256; u.bo = ((unsigned)e * 2048u + (unsigned)pn * 256u) * 1024u; }
        else { u.ao = (unsigned)t * (256u * 1024u); u.rows = nullptr; u.bo = ((unsigned)e * 1024u + (unsigned)pn * 256u) * 1024u; }
        return true;
    }
};

struct EpiInProj {
    bf16_t* qkv; const float* b_in; const float* rope; float* ksum;
    __device__ __forceinline__ void operator()(const f32x4 (&acc)[2][2][4][2], const Unit& u, int wr, int wc, int fr, int fq) const {
        const int pn = u.pn;
        const int colb = 256 * pn + 64 * wc + 8 * fq;
        const bool do_rope = !(pn >= 7 || (pn == 2 && wc >= 2));
        const bool is_q = (pn < 2) || (pn == 3) || (pn == 4);
        const bool is_kb = (pn == 5) || (pn == 6);
        const float sc = is_q ? C2 : 1.0f;
        f32x4 bv[2][2];
#pragma unroll
        for (int bj = 0; bj < 2; ++bj)
#pragma unroll
            for (int n = 0; n < 2; ++n) bv[bj][n] = *(const f32x4*)(b_in + colb + 32 * bj + 4 * n);
        f32x4 ks[2][2];
#pragma unroll
        for (int bj = 0; bj < 2; ++bj)
#pragma unroll
            for (int n = 0; n < 2; ++n) ks[bj][n] = (f32x4){0.f, 0.f, 0.f, 0.f};
#pragma unroll
        for (int ai = 0; ai < 2; ++ai)
#pragma unroll
            for (int m = 0; m < 4; ++m) {
                const int row = u.pm * 256 + ai * 128 + wr * 64 + m * 16 + fr;
                const int pos = row & (SEQ - 1);
                f32x4 o1[2], o2[2];
#pragma unroll
                for (int n = 0; n < 2; ++n) { o1[n] = acc[ai][0][m][n] + bv[0][n]; o2[n] = acc[ai][1][m][n] + bv[1][n]; }
                if (do_rope) {
                    const float* rp = rope + pos * 64 + 8 * fq;
#pragma unroll
                    for (int n = 0; n < 2; ++n) { const f32x4 c = *(const f32x4*)(rp + 4 * n), s = *(const f32x4*)(rp + 32 + 4 * n);
                        const f32x4 a = o1[n], b = o2[n]; o1[n] = a * c - b * s; o2[n] = b * c + a * s; }
                }
                if (is_kb) {
#pragma unroll
                    for (int n = 0; n < 2; ++n) { ks[0][n] += o1[n]; ks[1][n] += o2[n]; }
                }
                bf16_t* rowp = qkv + (size_t)row * INW + colb;
                u32x4 w1, w2;
                w1.x = cvtpk(o1[0][0] * sc, o1[0][1] * sc); w1.y = cvtpk(o1[0][2] * sc, o1[0][3] * sc); w1.z = cvtpk(o1[1][0] * sc, o1[1][1] * sc); w1.w = cvtpk(o1[1][2] * sc, o1[1][3] * sc);
                w2.x = cvtpk(o2[0][0] * sc, o2[0][1] * sc); w2.y = cvtpk(o2[0][2] * sc, o2[0][3] * sc); w2.z = cvtpk(o2[1][0] * sc, o2[1][1] * sc); w2.w = cvtpk(o2[1][2] * sc, o2[1][3] * sc);
                *(u32x4*)(rowp) = w1; *(u32x4*)(rowp + 32) = w2;
            }
        if (is_kb) {
            float* kd = ksum + (size_t)u.pm * 512 + 256 * (pn - 5) + 64 * wc + 8 * fq;
#pragma unroll
            for (int bj = 0; bj < 2; ++bj)
#pragma unroll
                for (int n = 0; n < 2; ++n)
#pragma unroll
                    for (int j = 0; j < 4; ++j) {
                        float v = ks[bj][n][j];
                        v += __shfl_xor(v, 1); v += __shfl_xor(v, 2); v += __shfl_xor(v, 4); v += __shfl_xor(v, 8);
                        if (fr == 0) atomicAdd(kd + 32 * bj + 4 * n + j, v);
                    }
        }
    }
};
struct EpiOutProj {
    float* y; const float* b_out; const float* x;
    __device__ __forceinline__ void operator()(const f32x4 (&acc)[2][2][4][2], const Unit& u, int wr, int wc, int fr, int fq) const {
        const int col0 = u.pn * 256 + wc * 32 + 8 * fq;
        f32x4 bv[2][2];
#pragma unroll
        for (int bj = 0; bj < 2; ++bj)
#pragma unroll
            for (int n = 0; n < 2; ++n) bv[bj][n] = *(const f32x4*)(b_out + col0 + 128 * bj + 4 * n);
#pragma unroll
        for (int ai = 0; ai < 2; ++ai)
#pragma unroll
            for (int m = 0; m < 4; ++m) {
                const size_t off = (size_t)(u.pm * 256 + ai * 128 + wr * 64 + m * 16 + fr) * D + col0;
#pragma unroll
                for (int bj = 0; bj < 2; ++bj)
#pragma unroll
                    for (int n = 0; n < 2; ++n) { const f32x4 xv = *(const f32x4*)(x + off + 128 * bj + 4 * n);
                        *(f32x4*)(y + off + 128 * bj + 4 * n) = acc[ai][bj][m][n] + bv[bj][n] + xv * DN_ALPHA; }
                if (m & 1) asm volatile("" ::: "memory");
            }
    }
};
struct EpiSwiglu {
    unsigned char* act8; const float* b1;
    __device__ __forceinline__ void operator()(const f32x4 (&acc)[2][2][4][2], const Unit& u, int wr, int wc, int fr, int fq) const {
        const int a0 = 128 * u.pn + 32 * wc + 8 * fq;
        const float* bp = b1 + (size_t)u.e * 2048 + 2 * a0;
        f32x4 bb[4];
#pragma unroll
        for (int q = 0; q < 4; ++q) bb[q] = *(const f32x4*)(bp + 4 * q);
        unsigned char* tile = act8 + (size_t)u.pm * (256 * 1024);
#pragma unroll
        for (int ai = 0; ai < 2; ++ai)
#pragma unroll
            for (int m = 0; m < 4; ++m) {
                const int row = ai * 128 + wr * 64 + m * 16 + fr;
                float r[8];
#pragma unroll
                for (int n = 0; n < 2; ++n)
#pragma unroll
                    for (int j = 0; j < 4; ++j) {
                        const int q = 4 * n + j;
                        float g = acc[ai][0][m][n][j] * (1.0f / W_SCALE) + bb[q >> 1][(2 * q) & 3];
                        float l = acc[ai][1][m][n][j] * (1.0f / W_SCALE) + bb[q >> 1][((2 * q) & 3) + 1];
                        g = fminf(g, 7.0f); l = fminf(fmaxf(l, -7.0f), 7.0f);
                        const float sg = __builtin_amdgcn_rcpf(1.0f + __builtin_amdgcn_exp2f(-1.702f * LOG2E * g));
                        r[q] = g * sg * (l + 1.0f) * ACT_SCALE;
                    }
                u32x2 w; w.x = pk4_fp8(r[0], r[1], r[2], r[3]); w.y = pk4_fp8(r[4], r[5], r[6], r[7]);
                *(u32x2*)(tile + (size_t)row * 1024 + (size_t)a0) = w;
            }
    }
};
struct EpiDown {
    bf16_t* yb; const float* b2;
    __device__ __forceinline__ void operator()(const f32x4 (&acc)[2][2][4][2], const Unit& u, int wr, int wc, int fr, int fq) const {
        const int col0 = u.pn * 256 + wc * 32 + 8 * fq;
        const float* bp = b2 + (size_t)u.e * 1024 + col0;
        f32x4 bv[2][2];
#pragma unroll
        for (int bj = 0; bj < 2; ++bj)
#pragma unroll
            for (int n = 0; n < 2; ++n) bv[bj][n] = *(const f32x4*)(bp + 128 * bj + 4 * n);
#pragma unroll
        for (int ai = 0; ai < 2; ++ai)
#pragma unroll
            for (int m = 0; m < 4; ++m) {
                bf16_t* rowp = yb + (size_t)(u.pm * 256 + ai * 128 + wr * 64 + m * 16 + fr) * 1024 + col0;
#pragma unroll
                for (int bj = 0; bj < 2; ++bj) { const f32x4 v0 = acc[ai][bj][m][0] * (1.0f / (W_SCALE * ACT_SCALE)) + bv[bj][0], v1 = acc[ai][bj][m][1] * (1.0f / (W_SCALE * ACT_SCALE)) + bv[bj][1];
                    u32x4 w; w.x = cvtpk(v0[0], v0[1]); w.y = cvtpk(v0[2], v0[3]); w.z = cvtpk(v1[0], v1[1]); w.w = cvtpk(v1[2], v1[3]);
                    *(u32x4*)(rowp + 128 * bj) = w; }
            }
    }
};
}

namespace att {
constexpr int PITCH = INW, SLOTB = 8192;
constexpr int L_K = 0, L_V = 2 * SLOTB, L_WS = 4 * SLOTB, L_KS = L_WS + 2048, L_OST = L_KS + 2048, L_END = L_OST + 8 * 4096;
constexpr float NEG = -1.0e30f, M0 = -1.0e20f;
typedef LAS const char* lds_cptr;
__device__ __forceinline__ int crow(int r, int hi) { return (r & 3) + 8 * (r >> 2) + 4 * hi; }
__device__ __forceinline__ void glds16(const void* gsrc, unsigned lds_dst) { unsigned keep;
    asm volatile("s_mov_b32 %0, m0\n\ts_mov_b32 m0, %2\n\ts_nop 0\n\tglobal_load_lds_dwordx4 %1, off\n\ts_mov_b32 m0, %0" : "=&s"(keep) : "v"(gsrc), "s"(lds_dst) : "memory"); }
#define ATT_WAIT_BAR0() asm volatile("s_waitcnt vmcnt(0) lgkmcnt(0)\n\ts_barrier" ::: "memory")
#define ATT_SBAR() __builtin_amdgcn_sched_barrier(0)

__device__ __forceinline__ void qkt(f32x16& p0, f32x16& p1, lds_cptr kb, const bf16x8* qr) {
    const f32x16 z = {};
#pragma unroll
    for (int d0 = 0; d0 < 4; ++d0) {
        const bf16x8 b0 = *(const LAS bf16x8*)(kb + d0 * 2048);
        const bf16x8 b1 = *(const LAS bf16x8*)(kb + d0 * 2048 + 512);
        if (d0 == 0) { p0 = __builtin_amdgcn_mfma_f32_32x32x16_bf16(b0, qr[0], z, 0, 0, 0); p1 = __builtin_amdgcn_mfma_f32_32x32x16_bf16(b1, qr[0], z, 0, 0, 0); }
        else { p0 = __builtin_amdgcn_mfma_f32_32x32x16_bf16(b0, qr[d0], p0, 0, 0, 0); p1 = __builtin_amdgcn_mfma_f32_32x32x16_bf16(b1, qr[d0], p1, 0, 0, 0); }
    }
}
__device__ __forceinline__ float rowmax32(const f32x16& p0, const f32x16& p1) {
    float a = fmaxf(p0[0], p1[0]);
#pragma unroll
    for (int r = 1; r < 16; ++r) a = fmaxf(a, fmaxf(p0[r], p1[r]));
    auto rr = __builtin_amdgcn_permlane32_swap(__float_as_uint(a), __float_as_uint(a), false, false);
    return fmaxf(__uint_as_float(rr[0]), __uint_as_float(rr[1]));
}
__device__ __forceinline__ void pv(f32x16* o, int vb, bf16x8 pa0, bf16x8 pa1, bf16x8 pa2, bf16x8 pa3) {
#pragma unroll
    for (int d0 = 0; d0 < 2; ++d0) { s16x4 lo[4], hi[4];
#pragma unroll
        for (int ks = 0; ks < 4; ++ks) {
            asm volatile("ds_read_b64_tr_b16 %0,%1 offset:%c2" : "=&v"(lo[ks]) : "v"(vb), "i"(d0 * 4096 + ks * 1024) : "memory");
            asm volatile("ds_read_b64_tr_b16 %0,%1 offset:%c2" : "=&v"(hi[ks]) : "v"(vb), "i"(d0 * 4096 + ks * 1024 + 512) : "memory"); }
        asm volatile("s_waitcnt lgkmcnt(0)" ::: "memory"); ATT_SBAR();
#define ATT_PK(k) (bf16x8){lo[k][0], lo[k][1], lo[k][2], lo[k][3], hi[k][0], hi[k][1], hi[k][2], hi[k][3]}
        o[d0] = __builtin_amdgcn_mfma_f32_32x32x16_bf16(pa0, ATT_PK(0), o[d0], 0, 0, 0);
        o[d0] = __builtin_amdgcn_mfma_f32_32x32x16_bf16(pa1, ATT_PK(1), o[d0], 0, 0, 0);
        o[d0] = __builtin_amdgcn_mfma_f32_32x32x16_bf16(pa2, ATT_PK(2), o[d0], 0, 0, 0);
        o[d0] = __builtin_amdgcn_mfma_f32_32x32x16_bf16(pa3, ATT_PK(3), o[d0], 0, 0, 0);
#undef ATT_PK
    }
}

template <bool MOBA>
__device__ __forceinline__ void attn_item(char* shm, const bf16_t* __restrict__ qkv, bf16_t* __restrict__ aout, int b, int hh, int qb, const float* __restrict__ sinks, const float* __restrict__ ksum) {
    int tid = threadIdx.x; asm volatile("" : "+v"(tid));
    const int lane = tid & 63, r32 = lane & 31, hi = lane >> 5; const int wid = __builtin_amdgcn_readfirstlane(tid >> 6);
    const long rowbase = (long)b * SEQ;
    int qa, qcol, kcol, vcol, ocol, kt0, kt1;
    if (MOBA) { qa = 256 * qb + 32 * wid; qcol = 768 + 64 * hh; kcol = 1280 + 64 * hh; vcol = 1792 + 64 * hh; ocol = 512 + 64 * hh; kt0 = 0; kt1 = 4 * qb + 4; }
    else { const int g = wid >> 1; qa = 64 * qb + 32 * (wid & 1); qcol = (4 * hh + g) * 64; kcol = 512 + 64 * hh; vcol = 640 + 64 * hh; ocol = qcol; kt0 = qb - 2 < 0 ? 0 : qb - 2; kt1 = qb + 1; }
    const bf16_t* Qw = qkv + (rowbase + qa) * PITCH + qcol;
    const bf16_t* Kh = qkv + rowbase * PITCH + kcol; const bf16_t* Vh = qkv + rowbase * PITCH + vcol;
    const unsigned lds0 = (unsigned)(uintptr_t)shm;
    float* wsf = (float*)(shm + L_WS) + wid * 64;
    const bf16_t* ksrc = Kh + (long)lane * PITCH + wid * 8;
    const bf16_t* vsrc = Vh + (long)(16 * (wid & 3) + (lane >> 2)) * PITCH + (wid >> 2) * 32 + (lane & 3) * 8;
    const unsigned kdst = lds0 + L_K + wid * 1024, vdst = lds0 + L_V + wid * 1024;
#define ATT_DMA_K(t, slot) glds16(ksrc + (long)(t) * 64 * PITCH, (unsigned)__builtin_amdgcn_readfirstlane(kdst + (slot)))
#define ATT_DMA_V(t, slot) glds16(vsrc + (long)(t) * 64 * PITCH, (unsigned)__builtin_amdgcn_readfirstlane(vdst + (slot)))
    const int vb0 = (int)(lds0 + L_V) + ((lane >> 4) & 1) * 32 + (lane & 3) * 8 + (4 * hi + ((lane & 15) >> 2)) * 64;
    const lds_cptr shm3 = (lds_cptr)shm; const lds_cptr kp0 = shm3 + L_K + hi * 1024 + r32 * 16;
    ATT_DMA_K(kt0, 0); ATT_DMA_V(kt0, 0);
    if (MOBA) { float* ksl = (float*)(shm + L_KS); ksl[tid] = ksum[((size_t)b * 8 + (tid >> 6)) * 512 + 64 * hh + (tid & 63)]; }
    bf16x8 qr[4];
#pragma unroll
    for (int d0 = 0; d0 < 4; ++d0) qr[d0] = *reinterpret_cast<const bf16x8*>(&Qw[(long)r32 * PITCH + d0 * 16 + hi * 8]);
    float m_run, l_run;
    if (MOBA) { m_run = M0; l_run = 0.f; }
    else { m_run = sinks[4 * hh + (wid >> 1)] * LOG2E; l_run = (hi == 0) ? 1.0f : 0.0f; }
    f32x16 o[2]; o[0] = f32x16{}; o[1] = f32x16{};
    ATT_WAIT_BAR0();
    unsigned sel = 0u;
    if (MOBA) {
        if (qb <= 3) sel = (1u << qb) - 1u;
        else {
            const float* ksl = (const float*)(shm + L_KS);
            float gv[7];
#pragma unroll
            for (int i = 0; i < 7; ++i) {
                float s = 0.f;
#pragma unroll
                for (int d0 = 0; d0 < 4; ++d0) {
                    const f32x4 k0 = *(const f32x4*)(ksl + i * 64 + 16 * d0 + 8 * hi), k1 = *(const f32x4*)(ksl + i * 64 + 16 * d0 + 8 * hi + 4);
#pragma unroll
                    for (int jj = 0; jj < 4; ++jj) { s += bf2f((unsigned short)qr[d0][jj]) * k0[jj]; s += bf2f((unsigned short)qr[d0][4 + jj]) * k1[jj]; }
                }
                auto rr = __builtin_amdgcn_permlane32_swap(__float_as_uint(s), __float_as_uint(s), false, false);
                s = __uint_as_float(rr[0]) + __uint_as_float(rr[1]);
                gv[i] = (i < qb) ? s : -INFINITY;
            }
#pragma unroll
            for (int rk = 0; rk < 3; ++rk) { float best = -INFINITY; int bi = 0;
#pragma unroll
                for (int i = 0; i < 7; ++i) { const bool c = (((sel >> i) & 1u) == 0u) && (gv[i] > best); best = c ? gv[i] : best; bi = c ? i : bi; }
                sel |= 1u << bi; }
        }
    }
    const int NT = kt1 - kt0;
    for (int it = 0; it < NT; ++it) {
        const int kt = kt0 + it; const int cur = (it & 1) * SLOTB;
        if (it + 1 < NT) { ATT_DMA_K(kt + 1, cur ^ SLOTB); ATT_DMA_V(kt + 1, cur ^ SLOTB); }
        bool need;
        if (MOBA) need = (kt < 4 * qb) ? true : (64 * kt <= qa + 31);
        else need = (64 * kt + 63 >= qa - 127) && (64 * kt <= qa + 31);
        if (need) {
            f32x16 p0, p1; qkt(p0, p1, kp0 + cur, qr);
            if (MOBA && kt < 4 * qb) {
                const bool on = ((sel >> (kt >> 2)) & 1u) != 0u;
#pragma unroll
                for (int r = 0; r < 16; ++r) { p0[r] = on ? p0[r] : NEG; p1[r] = on ? p1[r] : NEG; }
            } else {
                const int dq = qa + r32 - 64 * kt - 4 * hi;
#pragma unroll
                for (int r = 0; r < 16; ++r) { const int d0_ = dq - ((r & 3) + 8 * (r >> 2)), d1_ = d0_ - 32;
                    const bool v0 = MOBA ? (d0_ >= 0) : ((unsigned)d0_ < 128u), v1 = MOBA ? (d1_ >= 0) : ((unsigned)d1_ < 128u);
                    p0[r] = v0 ? p0[r] : NEG; p1[r] = v1 ? p1[r] : NEG; }
            }
            const float rm = rowmax32(p0, p1);
            const float mnew = fmaxf(m_run, rm);
            const float f = __builtin_amdgcn_exp2f(m_run - mnew);
            m_run = mnew; l_run *= f;
            if (hi == 0) wsf[r32] = f;
            LDS_WAIT();
#pragma unroll
            for (int r = 0; r < 16; ++r) { const float fr_ = wsf[crow(r, hi)]; o[0][r] *= fr_; o[1][r] *= fr_; }
            float sacc = 0.f;
#pragma unroll
            for (int r = 0; r < 16; ++r) { p0[r] = __builtin_amdgcn_exp2f(p0[r] - mnew); p1[r] = __builtin_amdgcn_exp2f(p1[r] - mnew); sacc += p0[r] + p1[r]; }
            l_run += sacc;
            u32x4 pw0, pw1, pw2, pw3;
            pw0 = (u32x4){cvtpk(p0[0], p0[1]), cvtpk(p0[2], p0[3]), cvtpk(p0[4], p0[5]), cvtpk(p0[6], p0[7])};
            pw1 = (u32x4){cvtpk(p0[8], p0[9]), cvtpk(p0[10], p0[11]), cvtpk(p0[12], p0[13]), cvtpk(p0[14], p0[15])};
            pw2 = (u32x4){cvtpk(p1[0], p1[1]), cvtpk(p1[2], p1[3]), cvtpk(p1[4], p1[5]), cvtpk(p1[6], p1[7])};
            pw3 = (u32x4){cvtpk(p1[8], p1[9]), cvtpk(p1[10], p1[11]), cvtpk(p1[12], p1[13]), cvtpk(p1[14], p1[15])};
            ATT_SBAR();
            pv(o, vb0 + cur, __builtin_bit_cast(bf16x8, pw0), __builtin_bit_cast(bf16x8, pw1), __builtin_bit_cast(bf16x8, pw2), __builtin_bit_cast(bf16x8, pw3));
        }
        if (it + 1 < NT) ATT_WAIT_BAR0();
    }
    { auto rr = __builtin_amdgcn_permlane32_swap(__float_as_uint(l_run), __float_as_uint(l_run), false, false); l_run = __uint_as_float(rr[0]) + __uint_as_float(rr[1]); }
    if (hi == 0) wsf[32 + r32] = l_run;
    LDS_WAIT();
    float rli[16];
#pragma unroll
    for (int r = 0; r < 16; ++r) rli[r] = __builtin_amdgcn_rcpf(wsf[32 + crow(r, hi)]);
    bf16_t* Ow = aout + (rowbase + qa) * D + ocol;
    { bf16_t* stg = (bf16_t*)(shm + L_OST) + wid * 2048;
#pragma unroll
        for (int r = 0; r < 16; ++r) { const int orow = crow(r, hi);
#pragma unroll
            for (int d0 = 0; d0 < 2; ++d0) stg[orow * 64 + d0 * 32 + r32] = (bf16_t)f2bf(o[d0][r] * rli[r]); }
        LDS_WAIT();
#pragma unroll
        for (int i = 0; i < 4; ++i) { const int row = i * 8 + (lane >> 3), ch = lane & 7; const u32x4 v = *(const u32x4*)(stg + row * 64 + ch * 8); *(u32x4*)(Ow + (long)row * D + ch * 8) = v; } }
    asm volatile("s_waitcnt lgkmcnt(0)\n\ts_barrier" ::: "memory");
#undef ATT_DMA_K
#undef ATT_DMA_V
}
}

__device__ __forceinline__ void sincos_d(double a, double& s, double& c) {
    const double q = __builtin_rint(a * 0.63661977236758134308);
    double r = __builtin_fma(-q, 1.57079632679489655800e+00, a);
    r = __builtin_fma(-q, 6.12323399573676603587e-17, r);
    const double r2 = r * r;
    double sp = -1.0 / 1307674368000.0;
    sp = sp * r2 + 1.0 / 6227020800.0; sp = sp * r2 - 1.0 / 39916800.0; sp = sp * r2 + 1.0 / 362880.0; sp = sp * r2 - 1.0 / 5040.0; sp = sp * r2 + 1.0 / 120.0; sp = sp * r2 - 1.0 / 6.0;
    const double sr = r + r * r2 * sp;
    double cp = 1.0 / 20922789888000.0;
    cp = cp * r2 - 1.0 / 87178291200.0; cp = cp * r2 + 1.0 / 479001600.0; cp = cp * r2 - 1.0 / 3628800.0; cp = cp * r2 + 1.0 / 40320.0; cp = cp * r2 - 1.0 / 720.0; cp = cp * r2 + 1.0 / 24.0; cp = cp * r2 - 0.5;
    const double cr = 1.0 + r2 * cp;
    const int n = ((int)q) & 3;
    s = (n == 0) ? sr : (n == 1) ? cr : (n == 2) ? -sr : -cr;
    c = (n == 0) ? cr : (n == 1) ? -sr : (n == 2) ? -cr : sr;
}
__device__ __forceinline__ int sigma_col(int p, int mode) {
    if (mode == 0) return (p & ~255) + 64 * ((p >> 5) & 3) + 32 * ((p >> 7) & 1) + pg8::perm32(p & 31);
    if (mode == 1) return (p & ~31) + pg8::perm32(p & 31);
    const int pn = p >> 8, q = p & 255; return 2 * (128 * pn + 32 * ((q >> 5) & 3) + pg8::perm32(q & 31)) + (q >> 7);
}
__device__ __forceinline__ void p0_transpose_item(const float* __restrict__ W, int N, bf16_t* __restrict__ WT, int mode, LAS float* scr, int item, int lane) {
    const int nblk = N / 32, kb = item / nblk, nb = item % nblk, k0 = 64 * kb, p0 = 32 * nb;
    const int sc = sigma_col(p0 + (lane & 31), mode);
#pragma unroll 8
    for (int i = 0; i < 32; ++i) { const int kk = 2 * i + (lane >> 5); scr[kk * 33 + (lane & 31)] = W[(size_t)(k0 + kk) * N + sc]; }
    LDS_WAIT(); asm volatile("" ::: "memory");
    const int c = lane & 7;
#pragma unroll
    for (int j = 0; j < 4; ++j) { const int n = (lane >> 3) + 8 * j; const LAS float* s = scr + (8 * c) * 33 + n;
        u32x4 o; o.x = cvtpk(s[0 * 33], s[1 * 33]); o.y = cvtpk(s[2 * 33], s[3 * 33]); o.z = cvtpk(s[4 * 33], s[5 * 33]); o.w = cvtpk(s[6 * 33], s[7 * 33]);
        *(u32x4*)(WT + (size_t)(p0 + n) * 1024 + k0 + 8 * c) = o; }
    LDS_WAIT(); asm volatile("" ::: "memory");
}

__device__ __forceinline__ void p0_transpose_item_fp8(const float* __restrict__ W, int N, unsigned char* __restrict__ WT, int mode, float scale, LAS float* scr, int item, int lane) {
    const int nblk = N / 32, kb = item / nblk, nb = item % nblk, k0 = 64 * kb, p0 = 32 * nb;
    const int sc = sigma_col(p0 + (lane & 31), mode);
#pragma unroll 8
    for (int i = 0; i < 32; ++i) { const int kk = 2 * i + (lane >> 5); scr[kk * 33 + (lane & 31)] = W[(size_t)(k0 + kk) * N + sc] * scale; }
    LDS_WAIT(); asm volatile("" ::: "memory");
    const int c = lane & 7;
#pragma unroll
    for (int j = 0; j < 4; ++j) { const int n = (lane >> 3) + 8 * j; const LAS float* s = scr + (8 * c) * 33 + n;
        u32x2 o; o.x = pk4_fp8(s[0 * 33], s[1 * 33], s[2 * 33], s[3 * 33]); o.y = pk4_fp8(s[4 * 33], s[5 * 33], s[6 * 33], s[7 * 33]);
        *(u32x2*)(WT + (size_t)(p0 + n) * 1024 + k0 + 8 * c) = o; }
    LDS_WAIT(); asm volatile("" ::: "memory");
}


#define XB_TMO      128
#define XB_XCNT(j)  (256  + 64 * (j))
#define XB_XSUB(j)  (1280 + 64 * (j))
#define XB_XGEN(j)  (2304 + 64 * (j))
#define XB_TOP      3328
#define XB_TOPGEN   3392
#define XCD_BAR_WORDS 3456
#define XB_SPIN_CAP (1u << 18)
__device__ __forceinline__ unsigned xb_ld(unsigned* p)              { return __hip_atomic_load(p, __ATOMIC_RELAXED, __HIP_MEMORY_SCOPE_AGENT); }
__device__ __forceinline__ unsigned xb_add(unsigned* p, unsigned v) { return __hip_atomic_fetch_add(p, v, __ATOMIC_RELAXED, __HIP_MEMORY_SCOPE_AGENT); }
__device__ __forceinline__ unsigned xb_xcc_id() { return (unsigned)__builtin_amdgcn_s_getreg((3 << 11) | 20) & 0xFu; }
#define XB_SPIN(cond, bar) do { unsigned _sp = 0; while (cond) { __builtin_amdgcn_s_sleep(1); \
    if ((++_sp & 255u) == 0u) { if (xb_ld(&(bar)[XB_TMO])) break; if (_sp > XB_SPIN_CAP) { atomicAdd(&(bar)[XB_TMO], 1u); break; } } } } while (0)
struct XcdBarrier { unsigned* bar; unsigned x; volatile LAS unsigned* st; };
__device__ __forceinline__ XcdBarrier xcd_barrier_post(unsigned* bar, volatile LAS unsigned* st) {
    XcdBarrier b; b.bar = bar; b.x = xb_xcc_id(); b.st = st;
    if (threadIdx.x == 0) (void)xb_add(&bar[XB_XCNT(b.x)], 1u);
    return b;
}
__device__ __forceinline__ void xcd_barrier_complete(unsigned* bar, unsigned x, unsigned& nloc, unsigned& nx) {
    const unsigned G = gridDim.x * gridDim.y * gridDim.z;
    unsigned sum, cnt, mine, sp = 0u;
    for (;;) {
        sum = 0u; cnt = 0u; mine = 0u;
#pragma unroll
        for (unsigned j = 0; j < 16; ++j) { const unsigned c = xb_ld(&bar[XB_XCNT(j)]); sum += c; cnt += (c > 0u) ? 1u : 0u; mine = (j == x) ? c : mine; }
        if (sum == G) break;
        __builtin_amdgcn_s_sleep(1);
        if ((++sp & 255u) == 0u) { if (xb_ld(&bar[XB_TMO])) break; if (sp > XB_SPIN_CAP) { atomicAdd(&bar[XB_TMO], 1u); break; } }
    }
    nloc = mine > 0u ? mine : 1u; nx = cnt > 0u ? cnt : 1u;
}
__device__ __forceinline__ void xcd_barrier(const XcdBarrier& b) {
    asm volatile("s_waitcnt vmcnt(0)" ::: "memory");
    __syncthreads();
    if (threadIdx.x == 0) {
        unsigned* bar = b.bar;
        __builtin_amdgcn_s_waitcnt(0);
        unsigned nloc = b.st[0], nx = b.st[1];
        if (nloc == 0u) { xcd_barrier_complete(bar, b.x, nloc, nx); b.st[0] = nloc; b.st[1] = nx; }
        const unsigned old = xb_add(&bar[XB_XSUB(b.x)], 1u);
        const unsigned gen = old / nloc;
        if (old + 1u == (gen + 1u) * nloc) {
            __builtin_amdgcn_fence(__ATOMIC_RELEASE, "agent");
            asm volatile("s_waitcnt vmcnt(0)" ::: "memory");
            const unsigned og = xb_add(&bar[XB_TOP], 1u);
            const unsigned tg = og / nx;
            if (og + 1u == (tg + 1u) * nx) xb_add(&bar[XB_TOPGEN], 1u);
            else XB_SPIN(xb_ld(&bar[XB_TOPGEN]) == tg, bar);
            __builtin_amdgcn_fence(__ATOMIC_ACQUIRE, "agent");
            xb_add(&bar[XB_XGEN(b.x)], 1u);
            asm volatile("s_waitcnt vmcnt(0)" ::: "memory");
        } else {
            XB_SPIN(xb_ld(&bar[XB_XGEN(b.x)]) == gen, bar);
            __builtin_amdgcn_fence(__ATOMIC_ACQUIRE, "agent");
            asm volatile("s_waitcnt vmcnt(0)" ::: "memory");
        }
    }
    __syncthreads();
}

__global__ void __launch_bounds__(NTHREADS, 2) fwd_megakernel(Params p) {
    extern __shared__ __attribute__((aligned(16))) unsigned char lds_raw[];
    LAS unsigned char* lds = (LAS unsigned char*)lds_raw;
    cg::grid_group grid = cg::this_grid();
#define PHASE_IDS() int tid = threadIdx.x; asm volatile("" : "+v"(tid)); const int lane = tid & 63, wave = __builtin_amdgcn_readfirstlane(tid >> 6); (void)lane; (void)wave
    const int G = gridDim.x, bx = blockIdx.x;
    unsigned char* ws = p.ws;
    unsigned* ctl = (unsigned*)(ws + WS_CTL);
    if (threadIdx.x < 2) ((LAS unsigned*)(lds + LDS_BARST))[threadIdx.x] = 0u;
    __syncthreads();
    const XcdBarrier xbar = xcd_barrier_post(ctl + CW_BAR, (volatile LAS unsigned*)(lds + LDS_BARST));
    float* ksum = (float*)(ws + WS_KSUM);
    float* rope = (float*)(ws + WS_ROPE);
    bf16_t* w_in_t = (bf16_t*)(ws + WS_WIN_T); bf16_t* w_out_t = (bf16_t*)(ws + WS_WOUT_T);
    unsigned char* w1_8 = ws + WS_W1_8; unsigned char* w2_8 = ws + WS_W2_8; unsigned char* x1_8 = ws + WS_X1_8; unsigned char* act8 = ws + WS_ACT8;
    int* cnt_blk = (int*)(ws + WS_CNT); int* tile_e = (int*)(ws + WS_TILE_E);
    bf16_t* wr_hi = (bf16_t*)(ws + WS_WR_HI); bf16_t* wr_lo = (bf16_t*)(ws + WS_WR_LO);
    int* tok = (int*)(ws + WS_TOK);
    int* asg_e = (int*)(ws + WS_ASG_E); float* asg_g = (float*)(ws + WS_ASG_G); int* asg_d = (int*)(ws + WS_ASG_D);
    bf16_t* x1b = (bf16_t*)(ws + WS_X1B); bf16_t* x1lo = (bf16_t*)(ws + WS_X1LO);
    bf16_t* xb = (bf16_t*)(ws + WS_XB); bf16_t* attn_o = xb;
    bf16_t* qkv = (bf16_t*)(ws + WS_QKV);
    bf16_t* yb = (bf16_t*)(ws + WS_YB);

    REP(0) {
        PHASE_IDS();
        const long gt = (long)bx * NTHREADS + tid, gsz = (long)G * NTHREADS;
        for (long i = gt; i < 2048 * 32; i += gsz) {
            const int pos = (int)(i >> 5), k = (int)(i & 31);
            double inv = 1.0; for (int q = 0; q < k; ++q) inv *= 0.7498942093324559;
            double s, c; sincos_d((double)pos * inv, s, c);
            rope[pos * 64 + k] = (float)c; rope[pos * 64 + 32 + k] = (float)s;
        }
        for (long i = gt; i < 32 * 1024; i += gsz) {
            const int e = (int)(i >> 10), k = (int)(i & 1023); const float w = p.w_router[k * 32 + e];
            const unsigned h = f2bf(w); wr_hi[i] = (bf16_t)h; wr_lo[i] = (bf16_t)f2bf(w - bf2f(h));
        }
        LAS float* scr = (LAS float*)(lds + wave * 16384);
        const int gw = bx * 8 + wave, NGW = G * 8;
        constexpr int I_IN = 16 * (INW / 32), I_OUT = 16 * 32, I_W1 = 16 * 64, I_W2 = 16 * 32;
        constexpr int NITEMS = I_IN + I_OUT + NE * I_W1 + NE * I_W2;
        for (int it = gw; it < NITEMS; it += NGW) {
            int r = it;
            if (r < I_IN) { p0_transpose_item(p.w_in, INW, w_in_t, 0, scr, r, lane); continue; } r -= I_IN;
            if (r < I_OUT) { p0_transpose_item(p.w_out, 1024, w_out_t, 1, scr, r, lane); continue; } r -= I_OUT;
            if (r < NE * I_W1) { const int e = r / I_W1; p0_transpose_item_fp8(p.w1 + (size_t)e * 1024 * 2048, 2048, w1_8 + (size_t)e * 2048 * 1024, 2, W_SCALE, scr, r % I_W1, lane); continue; } r -= NE * I_W1;
            { const int e = r / I_W2; p0_transpose_item_fp8(p.w2 + (size_t)e * 1024 * 1024, 1024, w2_8 + (size_t)e * 1024 * 1024, 1, W_SCALE, scr, r % I_W2, lane); }
        }
        const f32x4* x4 = (const f32x4*)p.x; u32x4* xb4 = (u32x4*)xb;
        for (long i = gt; i < (long)T * D / 8; i += gsz) { const f32x4 a = x4[2 * i], b = x4[2 * i + 1];
            u32x4 o; o.x = cvtpk(a[0], a[1]); o.y = cvtpk(a[2], a[3]); o.z = cvtpk(b[0], b[1]); o.w = cvtpk(b[2], b[3]); xb4[i] = o; }
    }
    grid.sync();

    REP(1) {
        pg8::SchedInProj S{(const char*)xb, (const char*)w_in_t, G, bx};
        pg8::EpiInProj E{qkv, p.b_in, rope, ksum};
        pg8::gemm_phase<pg8::EpiInProj, pg8::SchedInProj, false, true>(lds, S, E);
    }
    xcd_barrier(xbar);

    REP(2) for (int u = bx; u < 256; u += G) {
        { const int b = u >> 3, h = u & 7;
            for (int j = 0; j < 8; ++j) att::attn_item<true>((char*)lds_raw, qkv, attn_o, b, h, j, p.sinks, ksum); }
        { const int b = u >> 3, kvh = (u >> 2) & 1, oct = u & 3;
            for (int i = 0; i < 8; ++i) att::attn_item<false>((char*)lds_raw, qkv, attn_o, b, kvh, oct * 8 + i, p.sinks, ksum); }
    }
    xcd_barrier(xbar);

    REP(3) for (int pm = bx; pm < T / 256; pm += G) {
        PHASE_IDS();
        {
            pg8::SchedPanel S{(const char*)attn_o, (const char*)w_out_t, pm};
            pg8::EpiOutProj E{p.out, p.b_out, p.x};
            pg8::gemm_phase<pg8::EpiOutProj, pg8::SchedPanel, false, true>(lds, S, E);
        }
        __syncthreads();
        {
#pragma unroll
            for (int i = 0; i < 16; ++i) { const int idx = tid + 512 * i, mat = idx >> 12, rw = (idx >> 7) & 31, ch = idx & 127;
                const u32x4 v = *(const u32x4*)((mat ? wr_lo : wr_hi) + rw * 1024 + ch * 8);
                *(LAS u32x4*)(lds + mat * 66048 + rw * 2064 + ch * 16) = v; }
        }
        {
            f32x4 gg[4], bb[4];
#pragma unroll
            for (int j = 0; j < 4; ++j) { gg[j] = *(const f32x4*)(p.ln1_g + 256 * j + 4 * lane); bb[j] = *(const f32x4*)(p.ln1_b + 256 * j + 4 * lane); }
            for (int rr = 0; rr < 32; rr += 4) {
                const size_t row0 = (size_t)pm * 256 + wave * 32 + rr;
                f32x4 v[4][4]; float sm[4], sq[4];
#pragma unroll
                for (int q = 0; q < 4; ++q) { const f32x4* yr = (const f32x4*)(p.out + (row0 + q) * D) + lane;
#pragma unroll
                    for (int j = 0; j < 4; ++j) v[q][j] = yr[64 * j]; }
#pragma unroll
                for (int q = 0; q < 4; ++q) { float s = 0.f;
#pragma unroll
                    for (int j = 0; j < 4; ++j) s += (v[q][j][0] + v[q][j][1]) + (v[q][j][2] + v[q][j][3]);
                    sm[q] = s; }
#pragma unroll
                for (int o = 1; o < 64; o <<= 1) {
#pragma unroll
                    for (int q = 0; q < 4; ++q) sm[q] += __shfl_xor(sm[q], o); }
#pragma unroll
                for (int q = 0; q < 4; ++q) { const float mean = sm[q] * (1.0f / D); float s2 = 0.f;
#pragma unroll
                    for (int j = 0; j < 4; ++j) { v[q][j] = v[q][j] - mean; s2 += (v[q][j][0] * v[q][j][0] + v[q][j][1] * v[q][j][1]) + (v[q][j][2] * v[q][j][2] + v[q][j][3] * v[q][j][3]); }
                    sq[q] = s2; }
#pragma unroll
                for (int o = 1; o < 64; o <<= 1) {
#pragma unroll
                    for (int q = 0; q < 4; ++q) sq[q] += __shfl_xor(sq[q], o); }
#pragma unroll
                for (int q = 0; q < 4; ++q) {
                    const float rstd = 1.0f / sqrtf(sq[q] * (1.0f / D) + LN_EPS);
#pragma unroll
                    for (int j = 0; j < 4; ++j) {
                        const f32x4 xv = v[q][j] * rstd * gg[j] + bb[j];
                        const unsigned h01 = cvtpk(xv[0], xv[1]), h23 = cvtpk(xv[2], xv[3]);
                        const float r0 = xv[0] - bf2f(h01 & 0xffffu), r1 = xv[1] - bf2f(h01 >> 16), r2 = xv[2] - bf2f(h23 & 0xffffu), r3 = xv[3] - bf2f(h23 >> 16);
                        u32x2 hv = {h01, h23}, lv = {cvtpk(r0, r1), cvtpk(r2, r3)};
                        *(u32x2*)(x1b + (row0 + q) * D + 256 * j + 4 * lane) = hv;
                        *(u32x2*)(x1lo + (row0 + q) * D + 256 * j + 4 * lane) = lv;
                        *(unsigned*)(x1_8 + (row0 + q) * D + 256 * j + 4 * lane) = pk4_fp8(xv[0], xv[1], xv[2], xv[3]);
                    }
                }
            }
        }
        __syncthreads();
        {
            const int fr = lane & 15, fq = lane >> 4;
            f32x4 lacc[2][2];
#pragma unroll
            for (int m = 0; m < 2; ++m)
#pragma unroll
                for (int n = 0; n < 2; ++n) lacc[m][n] = (f32x4){0.f, 0.f, 0.f, 0.f};
            const size_t r0 = (size_t)pm * 256 + wave * 32;
            const bf16_t* ah = x1b + (r0 + fr) * D + 8 * fq; const bf16_t* al = x1lo + (r0 + fr) * D + 8 * fq;
            const LAS unsigned char* bh = lds + fr * 2064 + 16 * fq; const LAS unsigned char* bl = bh + 66048;
#pragma unroll 4
            for (int k0 = 0; k0 < 1024; k0 += 32) {
                bf16x8 a_hi[2], a_lo[2], b_hi[2], b_lo[2];
#pragma unroll
                for (int m = 0; m < 2; ++m) { a_hi[m] = *(const bf16x8*)(ah + (size_t)m * 16 * D + k0); a_lo[m] = *(const bf16x8*)(al + (size_t)m * 16 * D + k0); }
#pragma unroll
                for (int n = 0; n < 2; ++n) { b_hi[n] = *(const LAS bf16x8*)(bh + n * 16 * 2064 + k0 * 2); b_lo[n] = *(const LAS bf16x8*)(bl + n * 16 * 2064 + k0 * 2); }
#pragma unroll
                for (int m = 0; m < 2; ++m)
#pragma unroll
                    for (int n = 0; n < 2; ++n) {
                        lacc[m][n] = __builtin_amdgcn_mfma_f32_16x16x32_bf16(a_hi[m], b_hi[n], lacc[m][n], 0, 0, 0);
                        lacc[m][n] = __builtin_amdgcn_mfma_f32_16x16x32_bf16(a_lo[m], b_hi[n], lacc[m][n], 0, 0, 0);
                        lacc[m][n] = __builtin_amdgcn_mfma_f32_16x16x32_bf16(a_hi[m], b_lo[n], lacc[m][n], 0, 0, 0);
                    }
            }
            __syncthreads();
            LAS float* lg = (LAS float*)lds;
#pragma unroll
            for (int m = 0; m < 2; ++m)
#pragma unroll
                for (int n = 0; n < 2; ++n)
#pragma unroll
                    for (int rg = 0; rg < 4; ++rg) lg[(wave * 32 + 16 * m + 4 * fq + rg) * 33 + 16 * n + fr] = lacc[m][n][rg];
        }
        __syncthreads();
        {
            LAS float* lg = (LAS float*)lds;
            LAS int* wcnt = (LAS int*)(lds + 36864);
            float t0 = -INFINITY, t1 = -INFINITY, t2 = -INFINITY, t3 = -INFINITY; int i0 = 0, i1 = 0, i2 = 0, i3 = 0;
            int rk0 = 0, rk1 = 0, rk2 = 0, rk3 = 0;
            if (tid < 256) {
                for (int e = 0; e < NE; ++e) {
                    const float xv = lg[tid * 33 + e] + p.b_router[e];
                    if (xv > t3) {
                        if (xv > t2) { t3 = t2; i3 = i2;
                            if (xv > t1) { t2 = t1; i2 = i1;
                                if (xv > t0) { t1 = t0; i1 = i0; t0 = xv; i0 = e; } else { t1 = xv; i1 = e; }
                            } else { t2 = xv; i2 = e; }
                        } else { t3 = xv; i3 = e; }
                    }
                }
                const unsigned selm = (1u << i0) | (1u << i1) | (1u << i2) | (1u << i3);
                for (int e = 0; e < NE; ++e) {
                    const bool has = ((selm >> e) & 1u) != 0u;
                    const unsigned long long bal = __ballot(has);
                    const int pre = __popcll(bal & ((1ull << lane) - 1ull));
                    if (e == i0) rk0 = pre; if (e == i1) rk1 = pre; if (e == i2) rk2 = pre; if (e == i3) rk3 = pre;
                    if (lane == 0) wcnt[wave * 32 + e] = __popcll(bal);
                }
            }
            __syncthreads();
            if (tid < 256) {
                const float e1 = __expf(t1 - t0), e2 = __expf(t2 - t0), e3 = __expf(t3 - t0);
                const float inv = 1.0f / (1.0f + e1 + e2 + e3);
                int b0 = 0, b1 = 0, b2 = 0, b3 = 0;
                for (int w = 0; w < wave; ++w) { b0 += wcnt[w * 32 + i0]; b1 += wcnt[w * 32 + i1]; b2 += wcnt[w * 32 + i2]; b3 += wcnt[w * 32 + i3]; }
                const size_t a = ((size_t)pm * 256 + tid) * 4;
                *(int4*)(asg_e + a) = make_int4(i0, i1, i2, i3);
                *(float4*)(asg_g + a) = make_float4(inv, e1 * inv, e2 * inv, e3 * inv);
                *(int4*)(asg_d + a) = make_int4(b0 + rk0, b1 + rk1, b2 + rk2, b3 + rk3);
            }
            if (tid < 32) cnt_blk[pm * 32 + tid] = wcnt[tid] + wcnt[32 + tid] + wcnt[64 + tid] + wcnt[96 + tid];
            __syncthreads();
        }
    }
    xcd_barrier(xbar);

    for (int pm = bx; pm < T / 256; pm += G) {
        PHASE_IDS();
        LAS int* part_all = (LAS int*)lds; LAS int* part_pre = part_all + 512; LAS int* tot = part_pre + 512; LAS int* pre = tot + 32; LAS int* poff = pre + 32;
        { const int e = tid & 31, seg = tid >> 5; int sa = 0, sp = 0;
            for (int bb = seg * 16; bb < seg * 16 + 16; ++bb) { const int c = cnt_blk[bb * 32 + e]; sa += c; sp += (bb < pm) ? c : 0; }
            part_all[tid] = sa; part_pre[tid] = sp; }
        __syncthreads();
        if (tid < 32) { int sa = 0, sp = 0; for (int s = 0; s < 16; ++s) { sa += part_all[s * 32 + tid]; sp += part_pre[s * 32 + tid]; } tot[tid] = sa; pre[tid] = sp; }
        __syncthreads();
        if (tid == 0) { int off = 0; for (int e = 0; e < NE; ++e) { poff[e] = off; off += ((tot[e] + 255) >> 8) << 8; } poff[32] = off; }
        __syncthreads();
        if (tid < 256) {
            const int token = pm * 256 + tid; const size_t a = (size_t)token * 4;
            const int4 ee = *(const int4*)(asg_e + a); const int4 rk = *(const int4*)(asg_d + a);
            const int d0 = poff[ee.x] + pre[ee.x] + rk.x, d1 = poff[ee.y] + pre[ee.y] + rk.y, d2 = poff[ee.z] + pre[ee.z] + rk.z, d3 = poff[ee.w] + pre[ee.w] + rk.w;
            *(int4*)(asg_d + a) = make_int4(d0, d1, d2, d3);
            tok[d0] = token; tok[d1] = token; tok[d2] = token; tok[d3] = token;
        }
        if (pm < NE) {
            const int e = pm, n = tot[e], np = ((n + 255) >> 8) << 8, o = poff[e];
            for (int i = n + tid; i < np; i += NTHREADS) tok[o + i] = 0;
            for (int i = tid; i < (np >> 8); i += NTHREADS) tile_e[(o >> 8) + i] = e;
        }
        if (pm == 0 && tid == 0) ctl[CW_NTILES] = (unsigned)(poff[32] >> 8);
        __syncthreads();
    }
    xcd_barrier(xbar);

    const int ntiles = (int)ctl[CW_NTILES];
    REP(5) {
        pg8::SchedMoe<8, true> S{(const char*)x1_8, (const char*)w1_8, tile_e, tok, ntiles, G, bx};
        pg8::EpiSwiglu E{act8, p.b1};
        pg8::gemm_phase<pg8::EpiSwiglu, pg8::SchedMoe<8, true>, true, true, 512, true>(lds, S, E);
    }
    xcd_barrier(xbar);

    REP(6) {
        pg8::SchedMoe<4, false> S{(const char*)act8, (const char*)w2_8, tile_e, tok, ntiles, G, bx};
        pg8::EpiDown E{yb, p.b2};
        pg8::gemm_phase<pg8::EpiDown, pg8::SchedMoe<4, false>, false, true, 512, true>(lds, S, E);
    }
    xcd_barrier(xbar);

    REP(7) {
        PHASE_IDS();
        const int gw = bx * 8 + wave, NGW = G * 8;
        f32x4 gg[2][2], bb[2][2];
#pragma unroll
        for (int j = 0; j < 2; ++j)
#pragma unroll
            for (int h = 0; h < 2; ++h) { gg[j][h] = *(const f32x4*)(p.ln2_g + 512 * j + 8 * lane + 4 * h); bb[j][h] = *(const f32x4*)(p.ln2_b + 512 * j + 8 * lane + 4 * h); }
        for (int row = gw; row < T; row += NGW) {
            const size_t a = (size_t)row * 4;
            const int4 dd = *(const int4*)(asg_d + a); const float4 gt4 = *(const float4*)(asg_g + a);
            u32x4 xr[2], y0[2], y1[2], y2[2], y3[2];
#pragma unroll
            for (int j = 0; j < 2; ++j) {
                xr[j] = *(const u32x4*)(x1b + (size_t)row * D + 512 * j + 8 * lane);
                y0[j] = *(const u32x4*)(yb + (size_t)dd.x * D + 512 * j + 8 * lane);
                y1[j] = *(const u32x4*)(yb + (size_t)dd.y * D + 512 * j + 8 * lane);
                y2[j] = *(const u32x4*)(yb + (size_t)dd.z * D + 512 * j + 8 * lane);
                y3[j] = *(const u32x4*)(yb + (size_t)dd.w * D + 512 * j + 8 * lane);
            }
            float z[2][8]; float s = 0.f;
#pragma unroll
            for (int j = 0; j < 2; ++j)
#pragma unroll
                for (int q = 0; q < 4; ++q) {
                    const unsigned xw = xr[j][q], a0 = y0[j][q], a1 = y1[j][q], a2 = y2[j][q], a3 = y3[j][q];
                    const float lo = DN_ALPHA * bf2f(xw & 0xffffu) + gt4.x * bf2f(a0 & 0xffffu) + gt4.y * bf2f(a1 & 0xffffu) + gt4.z * bf2f(a2 & 0xffffu) + gt4.w * bf2f(a3 & 0xffffu);
                    const float hi = DN_ALPHA * bf2f(xw >> 16) + gt4.x * bf2f(a0 >> 16) + gt4.y * bf2f(a1 >> 16) + gt4.z * bf2f(a2 >> 16) + gt4.w * bf2f(a3 >> 16);
                    z[j][2 * q] = lo; z[j][2 * q + 1] = hi; s += lo + hi;
                }
            const float mean = wave_sum(s) * (1.0f / D); float s2 = 0.f;
#pragma unroll
            for (int j = 0; j < 2; ++j)
#pragma unroll
                for (int q = 0; q < 8; ++q) { z[j][q] -= mean; s2 += z[j][q] * z[j][q]; }
            const float rstd = 1.0f / sqrtf(wave_sum(s2) * (1.0f / D) + LN_EPS);
#pragma unroll
            for (int j = 0; j < 2; ++j)
#pragma unroll
                for (int h = 0; h < 2; ++h) {
                    f32x4 o;
#pragma unroll
                    for (int q = 0; q < 4; ++q) o[q] = z[j][4 * h + q] * rstd * gg[j][h][q] + bb[j][h][q];
                    *(f32x4*)(p.out + (size_t)row * D + 512 * j + 8 * lane + 4 * h) = o;
                }
        }
    }
}

extern "C" void kernel_launch(void* const* d_in, const int* in_sizes, int n_in, void* d_out, int out_size, void* d_ws, size_t ws_size, hipStream_t stream) {
    static int grid_blocks = 0;
    if (grid_blocks == 0) {
        if (n_in != 16 || in_sizes[0] != T * D || out_size != T * D || ws_size < WS_END) {
            fprintf(stderr, "kernel_launch: unexpected shapes: n_in %d in0 %d out %d ws %zu (need %zu)\n", n_in, n_in > 0 ? in_sizes[0] : -1, out_size, ws_size, (size_t)WS_END); grid_blocks = -1; return; }
        int dev = 0, cus = 0, per_cu = 0;
        (void)hipGetDevice(&dev);
        (void)hipDeviceGetAttribute(&cus, hipDeviceAttributeMultiprocessorCount, dev);
        (void)hipFuncSetAttribute((const void*)fwd_megakernel, hipFuncAttributeMaxDynamicSharedMemorySize, LDS_BYTES);
        (void)hipOccupancyMaxActiveBlocksPerMultiprocessor(&per_cu, (const void*)fwd_megakernel, NTHREADS, LDS_BYTES);
        if (per_cu < 1) { fprintf(stderr, "kernel_launch: occupancy query reports %d blocks per CU\n", per_cu); per_cu = 1; }
        grid_blocks = cus;
        fprintf(stderr, "kernel_launch: cus=%d per_cu=%d grid=%d ws=%zu\n", cus, per_cu, grid_blocks, ws_size);
    }
    if (grid_blocks < 0) return;
    (void)hipMemsetAsync((char*)d_ws + WS_CTL, 0, CTL_ZERO_BYTES, stream);
    Params p{};
    p.x = (const float*)d_in[0]; p.w_in = (const float*)d_in[1]; p.b_in = (const float*)d_in[2]; p.sinks = (const float*)d_in[3]; p.w_out = (const float*)d_in[4]; p.b_out = (const float*)d_in[5];
    p.ln1_g = (const float*)d_in[6]; p.ln1_b = (const float*)d_in[7]; p.w_router = (const float*)d_in[8]; p.b_router = (const float*)d_in[9];
    p.w1 = (const float*)d_in[10]; p.b1 = (const float*)d_in[11]; p.w2 = (const float*)d_in[12]; p.b2 = (const float*)d_in[13]; p.ln2_g = (const float*)d_in[14]; p.ln2_b = (const float*)d_in[15];
    p.out = (float*)d_out; p.ws = (unsigned char*)d_ws;
    void* args[] = {&p};
    hipError_t e = hipLaunchCooperativeKernel((void*)fwd_megakernel, dim3(grid_blocks), dim3(NTHREADS), args, LDS_BYTES, stream);
    if (e != hipSuccess) fprintf(stderr, "cooperative launch failed: %s (grid %d)\n", hipGetErrorString(e), grid_blocks);
}
```

```cpp
#include <hip/hip_runtime.h>
#include <hip/hip_cooperative_groups.h>
#include <cstdio>
#include <cstdint>
namespace cg = cooperative_groups;

#define LAS __attribute__((address_space(3)))
typedef unsigned short bf16_t;
typedef short bf16x8 __attribute__((ext_vector_type(8)));
typedef short s16x4 __attribute__((ext_vector_type(4)));
typedef float f32x2 __attribute__((ext_vector_type(2)));
typedef float f32x4 __attribute__((ext_vector_type(4)));
typedef float f32x16 __attribute__((ext_vector_type(16)));
typedef unsigned u32x2 __attribute__((ext_vector_type(2)));
typedef unsigned u32x4 __attribute__((ext_vector_type(4)));
typedef __bf16 bf16x2_t __attribute__((ext_vector_type(2)));

constexpr int D = 1024, BATCH = 32, SEQ = 2048, T = BATCH * SEQ;
constexpr int INW = 2304, NE = 32;
constexpr float LN_EPS = 1e-5f;
constexpr float DN_ALPHA = 1.189207115002721f;
constexpr float LOG2E = 1.4426950408889634f;
constexpr float C2 = 0.18033688011112042f;
constexpr int NTHREADS = 512;
constexpr int LDS_BYTES = 147456;
constexpr int MAX_TILES = 1056;
#ifndef DUP_MASK
#define DUP_MASK 0
#endif
#define REP(k) for (int _rep = 0; _rep < (((DUP_MASK >> (k)) & 1) ? 2 : 1); ++_rep)

constexpr size_t MiB = 1u << 20;
constexpr size_t WS_CTL = 0, CTL_ZERO_BYTES = 2 * MiB;
constexpr size_t WS_KSUM = 1 * MiB;
constexpr size_t WS_ROPE = 2 * MiB;
constexpr size_t WS_WIN_T = 4 * MiB;
constexpr size_t WS_WOUT_T = 9 * MiB;
constexpr size_t WS_SMALL = 11 * MiB;
constexpr size_t WS_CNT = WS_SMALL, WS_TILE_E = WS_SMALL + 65536, WS_WR_HI = WS_SMALL + 131072, WS_WR_LO = WS_WR_HI + 65536;
constexpr size_t WS_TOK = 12 * MiB;
constexpr size_t WS_ASG_E = 14 * MiB, WS_ASG_G = 15 * MiB, WS_ASG_D = 16 * MiB;
constexpr size_t WS_W2_8 = 24 * MiB;
constexpr size_t WS_X1B = 56 * MiB;
constexpr size_t WS_ACT8 = 184 * MiB;
constexpr size_t WS_XB = 184 * MiB;
constexpr size_t WS_X1LO = 312 * MiB;
constexpr size_t WS_YB = 488 * MiB;
constexpr size_t WS_W1_8 = 488 * MiB;
constexpr size_t WS_X1_8 = 552 * MiB;
constexpr size_t WS_QKV = 616 * MiB;
constexpr size_t WS_END = 1016 * MiB;
constexpr float W_SCALE = 64.0f, ACT_SCALE = 4.0f;
constexpr int CW_NTILES = 16, CW_BAR = 4096;
constexpr int LDS_BARST = LDS_BYTES - 256;

struct Params {
    const float *x, *w_in, *b_in, *sinks, *w_out, *b_out, *ln1_g, *ln1_b, *w_router, *b_router, *w1, *b1, *w2, *b2, *ln2_g, *ln2_b;
    float* out; unsigned char* ws;
};

__device__ __forceinline__ unsigned f2bf(float f) { unsigned u = __builtin_bit_cast(unsigned, f); return (u + 0x7fffu + ((u >> 16) & 1u)) >> 16; }
__device__ __forceinline__ float bf2f(unsigned h) { return __builtin_bit_cast(float, h << 16); }
__device__ __forceinline__ unsigned cvtpk(float lo, float hi) { f32x2 v = {lo, hi}; bf16x2_t b = __builtin_convertvector(v, bf16x2_t); return __builtin_bit_cast(unsigned, b); }
__device__ __forceinline__ unsigned pk4_fp8(float a, float b, float c, float d) { int w = 0; w = __builtin_amdgcn_cvt_pk_fp8_f32(a, b, w, false); w = __builtin_amdgcn_cvt_pk_fp8_f32(c, d, w, true); return (unsigned)w; }
__device__ __forceinline__ float wave_sum(float v) {
#pragma unroll
    for (int o = 1; o < 64; o <<= 1) v += __shfl_xor(v, o);
    return v;
}
#define LDS_WAIT() asm volatile("s_waitcnt lgkmcnt(0)" ::: "memory")

namespace pg8 {
constexpr int BM = 256, BK = 64, HALF = 128, HTB = HALF * BK * 2, STAGE_BYTES = 8 * HTB, NXCD = 8, WGM = 8;
constexpr int KD = 1024;
__host__ __device__ __forceinline__ int lds_byte(int r, int c) { const int st = (r >> 4) * 2 + (c >> 5), rr = r & 15, cc = c & 31, ob = rr * 64 + cc * 2; return st * 1024 + (ob ^ (((ob >> 9) & 1) << 5)); }
__host__ __device__ __forceinline__ void stage_rc(int b, int& R, int& C) { const int st = b / 1024, sb = b % 1024, swz = sb ^ (((sb >> 9) & 1) << 5); R = (st >> 1) * 16 + swz / 64; C = (st & 1) * 32 + (swz % 64) / 2; }
__host__ __device__ __forceinline__ int perm32(int rho) { const int n = rho >> 4, i = rho & 15; return 8 * (i >> 2) + 4 * n + (i & 3); }

struct Unit { int pm, pn, e; unsigned ao, bo; const int* rows; };

typedef int v8i32_t __attribute__((ext_vector_type(8)));
typedef int v4i32_t __attribute__((ext_vector_type(4)));
__device__ __forceinline__ v8i32_t cat8(bf16x8 a, bf16x8 b) { const v4i32_t x = __builtin_bit_cast(v4i32_t, a), y = __builtin_bit_cast(v4i32_t, b); return __builtin_shufflevector(x, y, 0, 1, 2, 3, 4, 5, 6, 7); }
template <class Epi, class Sched, bool GATHER, bool ALIGN_EPI, int KP = 1024, bool FP8 = false>
__device__ __forceinline__ void gemm_phase(LAS unsigned char* lds, const Sched& S, const Epi& E) {
    int tid = threadIdx.x; asm volatile("" : "+v"(tid));
    const int wid = __builtin_amdgcn_readfirstlane(tid >> 6), lane = tid & 63, wr = wid >> 2, wc = wid & 3, fr = lane & 15, fq = lane >> 4;
    constexpr int K = KP, nt = K / BK;
    unsigned voffB[2], Vc[2][2], Vn[2][2]; int stR0, stC0;
    { int R, C; stage_rc(tid * 16, R, C); stR0 = R; stC0 = C; }
#pragma unroll
    for (int i = 0; i < 2; ++i) { voffB[i] = (unsigned)((stR0 + 64 * i) * K + stC0) * 2u; Vc[0][i] = voffB[i]; Vc[1][i] = voffB[i]; Vn[0][i] = voffB[i]; Vn[1][i] = voffB[i]; }
#define PG8_GATHER_LOAD(VV, rowsp) do { int _t = threadIdx.x; asm volatile("" : "+v"(_t)); int _R, _C; stage_rc(_t * 16, _R, _C);     \
        const int* _rp = (const int*)((const char*)(rowsp) + (unsigned)(_R * 4)); _Pragma("unroll") for (int _h = 0; _h < 2; ++_h) _Pragma("unroll") for (int _i = 0; _i < 2; ++_i) \
        VV[_h][_i] = ((unsigned)_rp[128 * _h + 64 * _i] * (unsigned)K + (unsigned)_C) * 2u; } while (0)
    constexpr unsigned kstep = (unsigned)(BK * 2);
    constexpr unsigned hstep = (unsigned)HALF * K * 2;
    const char* const Abase = S.A; const char* const Bbase = S.B;
    const unsigned ldsw = (unsigned)wid * 1024u;
    const int aoff = lds_byte(wr * 64 + fr, fq * 8), boff = lds_byte(wc * 32 + fr, fq * 8);
#define PG8_SA(b, h) (((b) * 2 + (h)) * HTB)
#define PG8_SB(b, h) ((4 + (b) * 2 + (h)) * HTB)
#define PG8_STAGE(bufoff, gbase, soff, voff) do { _Pragma("unroll") for (int _i = 0; _i < 2; ++_i) \
        __builtin_amdgcn_global_load_lds((const unsigned*)((gbase) + (unsigned)((voff)[_i] + (soff))), (LAS unsigned*)(lds + (bufoff) + ldsw + _i * 8192), 16, 0, 0); } while (0)
#define PG8_STAGE_B(bufoff, soff) PG8_STAGE(bufoff, Bbase, soff, voffB)
#define PG8_STAGE_A(bufoff, soff, h, VV) do { if constexpr (GATHER) { PG8_STAGE(bufoff, Abase, soff, VV[h]); } else { PG8_STAGE(bufoff, Abase, (soff) + (h) * hstep, voffB); } } while (0)
#define PG8_LDA(dst, b, h) do { _Pragma("unroll") for (int m = 0; m < 4; ++m) dst[m] = cat8(*(const LAS bf16x8*)(lds + PG8_SA(b, h) + aoff + m * 2048), *(const LAS bf16x8*)(lds + PG8_SA(b, h) + aoff + m * 2048 + 1024)); } while (0)
#define PG8_LDB(dst, b, h) do { _Pragma("unroll") for (int n = 0; n < 2; ++n) dst[n] = cat8(*(const LAS bf16x8*)(lds + PG8_SB(b, h) + boff + n * 2048), *(const LAS bf16x8*)(lds + PG8_SB(b, h) + boff + n * 2048 + 1024)); } while (0)
#define PG8_LO(v) __builtin_bit_cast(bf16x8, __builtin_shufflevector(v, v, 0, 1, 2, 3))
#define PG8_HI(v) __builtin_bit_cast(bf16x8, __builtin_shufflevector(v, v, 4, 5, 6, 7))
#define PG8_MMA(ai, bj, At, Bt) do { __builtin_amdgcn_s_setprio(1); _Pragma("unroll") for (int m = 0; m < 4; ++m) _Pragma("unroll") for (int n = 0; n < 2; ++n) { \
        if constexpr (FP8) { acc[ai][bj][m][n] = __builtin_amdgcn_mfma_scale_f32_16x16x128_f8f6f4(Bt[n], At[m], acc[ai][bj][m][n], 0, 0, 0, 0x7f7f7f7f, 0, 0x7f7f7f7f); } \
        else { acc[ai][bj][m][n] = __builtin_amdgcn_mfma_f32_16x16x32_bf16(PG8_LO(Bt[n]), PG8_LO(At[m]), acc[ai][bj][m][n], 0, 0, 0); \
               acc[ai][bj][m][n] = __builtin_amdgcn_mfma_f32_16x16x32_bf16(PG8_HI(Bt[n]), PG8_HI(At[m]), acc[ai][bj][m][n], 0, 0, 0); } } \
        __builtin_amdgcn_s_setprio(0); } while (0)
#define PG8_WAIT_V(n) asm volatile("s_waitcnt vmcnt(" #n ")" ::: "memory")
#define PG8_WAIT_L(n) asm volatile("s_waitcnt lgkmcnt(" #n ")" ::: "memory")
#define PG8_BAR __builtin_amdgcn_s_barrier()
#define PG8_SCHED __builtin_amdgcn_sched_barrier(0)
    Unit cur, nxt; int ui = 0;
    if (!S.next(0, cur)) return;
    if constexpr (GATHER) { PG8_GATHER_LOAD(Vc, cur.rows); }
    f32x4 acc[2][2][4][2];
#pragma unroll
    for (int a = 0; a < 2; ++a)
#pragma unroll
        for (int b = 0; b < 2; ++b)
#pragma unroll
            for (int m = 0; m < 4; ++m)
#pragma unroll
                for (int n = 0; n < 2; ++n) acc[a][b][m][n] = (f32x4){0.f, 0.f, 0.f, 0.f};
    v8i32_t At[4], B0[2], B1[2];
    unsigned cA = cur.ao, cB = cur.bo;
    PG8_STAGE_B(PG8_SB(0, 0), cB); PG8_STAGE_B(PG8_SB(0, 1), cB + hstep); PG8_STAGE_A(PG8_SA(0, 0), cA, 0, Vc); PG8_STAGE_A(PG8_SA(0, 1), cA, 1, Vc);
    if (wr == 1) PG8_BAR;
    PG8_WAIT_V(2); PG8_BAR;
    PG8_STAGE_B(PG8_SB(1, 0), cB + kstep); PG8_STAGE_A(PG8_SA(1, 0), cA + kstep, 0, Vc); PG8_STAGE_B(PG8_SB(1, 1), cB + hstep + kstep);
    PG8_WAIT_V(6); PG8_BAR;
    for (;;) {
        const bool has_next = S.next(ui + 1, nxt);
        const unsigned nA = has_next ? nxt.ao : cA; const unsigned nB = has_next ? nxt.bo : cB;
        if constexpr (GATHER) {
            if (has_next) { PG8_GATHER_LOAD(Vn, nxt.rows); }
            else {
#pragma unroll
                for (int i = 0; i < 2; ++i) { Vn[0][i] = Vc[0][i]; Vn[1][i] = Vc[1][i]; }
            }
        }
#pragma unroll 1
        for (int t = 0; t < nt; t += 2) {
            const bool last = (t == nt - 2);
            const unsigned a1 = cA + (unsigned)(t + 1) * kstep;
            const unsigned a2 = last ? nA : cA + (unsigned)(t + 2) * kstep; const unsigned b2 = last ? nB : cB + (unsigned)(t + 2) * kstep;
            const unsigned a3 = a2 + kstep; const unsigned b3 = b2 + kstep;
            PG8_LDB(B0, 0, 0); PG8_LDB(B1, 0, 1); PG8_SCHED; PG8_LDA(At, 0, 0); PG8_STAGE_A(PG8_SA(1, 1), a1, 1, Vc);
            if constexpr (GATHER) { if (last) {
#pragma unroll
                for (int i = 0; i < 2; ++i) { Vc[0][i] = Vn[0][i]; Vc[1][i] = Vn[1][i]; } } }
            PG8_WAIT_V(8); PG8_WAIT_L(0); PG8_BAR; PG8_MMA(0, 0, At, B0); PG8_MMA(0, 1, At, B1); PG8_BAR; PG8_SCHED;
            PG8_LDA(At, 0, 1); PG8_STAGE_B(PG8_SB(0, 0), b2); PG8_STAGE_B(PG8_SB(0, 1), b2 + hstep); PG8_STAGE_A(PG8_SA(0, 0), a2, 0, Vc);
            PG8_WAIT_V(8); PG8_WAIT_L(0); PG8_BAR; PG8_MMA(1, 0, At, B0); PG8_MMA(1, 1, At, B1); PG8_BAR; PG8_SCHED;
            PG8_LDB(B0, 1, 0); PG8_LDB(B1, 1, 1); PG8_SCHED; PG8_LDA(At, 1, 0); PG8_STAGE_A(PG8_SA(0, 1), a2, 1, Vc);
            PG8_WAIT_V(8); PG8_WAIT_L(0); PG8_BAR; PG8_MMA(0, 0, At, B0); PG8_MMA(0, 1, At, B1); PG8_BAR; PG8_SCHED;
            PG8_LDA(At, 1, 1); PG8_STAGE_B(PG8_SB(1, 0), b3); PG8_STAGE_B(PG8_SB(1, 1), b3 + hstep); PG8_STAGE_A(PG8_SA(1, 0), a3, 0, Vc);
            PG8_WAIT_V(8); PG8_WAIT_L(0); PG8_BAR; PG8_MMA(1, 0, At, B0); PG8_MMA(1, 1, At, B1); PG8_BAR; PG8_SCHED;
        }
        if constexpr (ALIGN_EPI) { if (wr == 0) PG8_BAR; }
        E(acc, cur, wr, wc, fr, fq);
        if (!has_next) break;
#pragma unroll
        for (int a = 0; a < 2; ++a)
#pragma unroll
            for (int b = 0; b < 2; ++b)
#pragma unroll
                for (int m = 0; m < 4; ++m)
#pragma unroll
                    for (int n = 0; n < 2; ++n) acc[a][b][m][n] = (f32x4){0.f, 0.f, 0.f, 0.f};
        cur = nxt; cA = nA; cB = nB; ++ui;
        if constexpr (ALIGN_EPI) { if (wr == 1) PG8_BAR; }
    }
    PG8_WAIT_V(0);
    if constexpr (!ALIGN_EPI) { if (wr == 0) PG8_BAR; }
    PG8_BAR;
#undef PG8_SA
#undef PG8_SB
#undef PG8_STAGE
#undef PG8_STAGE_A
#undef PG8_STAGE_B
#undef PG8_GATHER_LOAD
#undef PG8_LDA
#undef PG8_LDB
#undef PG8_LO
#undef PG8_HI
#undef PG8_MMA
#undef PG8_WAIT_V
#undef PG8_WAIT_L
#undef PG8_BAR
#undef PG8_SCHED
}

struct SchedInProj {
    const char* A; const char* B; int G, c;
    __device__ __forceinline__ bool next(int i, Unit& u) const {
        constexpr int nM = T / BM, nN = INW / BM, nwg = nM * nN;
        const long L = (long)i * G + c; if (L >= nwg) return false;
        int wgid = (int)L; { const int q = nwg / NXCD, r = nwg % NXCD, xcd = wgid % NXCD, off = wgid / NXCD; wgid = (xcd < r ? xcd * (q + 1) : r * (q + 1) + (xcd - r) * q) + off; }
        const int nig = WGM * nN, gid = wgid / nig, fm = gid * WGM, gsz = (nM - fm) < WGM ? (nM - fm) : WGM;
        u.pm = fm + ((wgid % nig) % gsz); u.pn = (wgid % nig) / gsz; u.e = 0; u.rows = nullptr;
        u.ao = (unsigned)u.pm * (unsigned)(2 * HALF * KD * 2); u.bo = (unsigned)u.pn * (unsigned)(2 * HALF * KD * 2); return true;
    }
};
struct SchedPanel {
    const char* A; const char* B; int pm;
    __device__ __forceinline__ bool next(int i, Unit& u) const {
        if (i >= 4) return false;
        u.pm = pm; u.pn = i; u.e = 0; u.rows = nullptr; u.ao = (unsigned)pm * (unsigned)(256 * KD * 2); u.bo = (unsigned)i * (unsigned)(256 * KD * 2); return true;
    }
};
template <int NPN, bool G1>
struct SchedMoe {
    const char* A; const char* B; const int* tile_e; const int* tok; int ntiles, G, c;
    __device__ __forceinline__ bool next(int i, Unit& u) const {
        const long L = (long)i * G + c; int t, pn;
        if ((G & 7) == 0) { const int x = (int)(L & 7); const long j = L >> 3; t = (int)(j / NPN) * 8 + x; pn = (int)(j % NPN); }
        else { t = (int)(L / NPN); pn = (int)(L % NPN); }
        if (t >= ntiles) return false;
        const int e = tile_e[t];
        u.pm = t; u.pn = pn; u.e = e;
        if (G1) { u.ao = 0u; u.rows = tok + (size_t)t * 256; u.bo = ((unsigned)e * 2048u + (unsigned)pn * 256u) * 1024u; }
        else { u.ao = (unsigned)t * (256u * 1024u); u.rows = nullptr; u.bo = ((unsigned)e * 1024u + (unsigned)pn * 256u) * 1024u; }
        return true;
    }
};

struct EpiInProj {
    bf16_t* qkv; const float* b_in; const float* rope; float* ksum;
    __device__ __forceinline__ void operator()(const f32x4 (&acc)[2][2][4][2], const Unit& u, int wr, int wc, int fr, int fq) const {
        const int pn = u.pn;
        const int colb = 256 * pn + 64 * wc + 8 * fq;
        const bool do_rope = !(pn >= 7 || (pn == 2 && wc >= 2));
        const bool is_q = (pn < 2) || (pn == 3) || (pn == 4);
        const bool is_kb = (pn == 5) || (pn == 6);
        const float sc = is_q ? C2 : 1.0f;
        f32x4 bv[2][2];
#pragma unroll
        for (int bj = 0; bj < 2; ++bj)
#pragma unroll
            for (int n = 0; n < 2; ++n) bv[bj][n] = *(const f32x4*)(b_in + colb + 32 * bj + 4 * n);
        f32x4 ks[2][2];
#pragma unroll
        for (int bj = 0; bj < 2; ++bj)
#pragma unroll
            for (int n = 0; n < 2; ++n) ks[bj][n] = (f32x4){0.f, 0.f, 0.f, 0.f};
#pragma unroll
        for (int ai = 0; ai < 2; ++ai)
#pragma unroll
            for (int m = 0; m < 4; ++m) {
                const int row = u.pm * 256 + ai * 128 + wr * 64 + m * 16 + fr;
                const int pos = row & (SEQ - 1);
                f32x4 o1[2], o2[2];
#pragma unroll
                for (int n = 0; n < 2; ++n) { o1[n] = acc[ai][0][m][n] + bv[0][n]; o2[n] = acc[ai][1][m][n] + bv[1][n]; }
                if (do_rope) {
                    const float* rp = rope + pos * 64 + 8 * fq;
#pragma unroll
                    for (int n = 0; n < 2; ++n) { const f32x4 c = *(const f32x4*)(rp + 4 * n), s = *(const f32x4*)(rp + 32 + 4 * n);
                        const f32x4 a = o1[n], b = o2[n]; o1[n] = a * c - b * s; o2[n] = b * c + a * s; }
                }
                if (is_kb) {
#pragma unroll
                    for (int n = 0; n < 2; ++n) { ks[0][n] += o1[n]; ks[1][n] += o2[n]; }
                }
                bf16_t* rowp = qkv + (size_t)row * INW + colb;
                u32x4 w1, w2;
                w1.x = cvtpk(o1[0][0] * sc, o1[0][1] * sc); w1.y = cvtpk(o1[0][2] * sc, o1[0][3] * sc); w1.z = cvtpk(o1[1][0] * sc, o1[1][1] * sc); w1.w = cvtpk(o1[1][2] * sc, o1[1][3] * sc);
                w2.x = cvtpk(o2[0][0] * sc, o2[0][1] * sc); w2.y = cvtpk(o2[0][2] * sc, o2[0][3] * sc); w2.z = cvtpk(o2[1][0] * sc, o2[1][1] * sc); w2.w = cvtpk(o2[1][2] * sc, o2[1][3] * sc);
                *(u32x4*)(rowp) = w1; *(u32x4*)(rowp + 32) = w2;
            }
        if (is_kb) {
            float* kd = ksum + (size_t)u.pm * 512 + 256 * (pn - 5) + 64 * wc + 8 * fq;
#pragma unroll
            for (int bj = 0; bj < 2; ++bj)
#pragma unroll
                for (int n = 0; n < 2; ++n)
#pragma unroll
                    for (int j = 0; j < 4; ++j) {
                        float v = ks[bj][n][j];
                        v += __shfl_xor(v, 1); v += __shfl_xor(v, 2); v += __shfl_xor(v, 4); v += __shfl_xor(v, 8);
                        if (fr == 0) atomicAdd(kd + 32 * bj + 4 * n + j, v);
                    }
        }
    }
};
struct EpiOutProj {
    bf16_t* y; const float* b_out; const float* x;
    __device__ __forceinline__ void operator()(const f32x4 (&acc)[2][2][4][2], const Unit& u, int wr, int wc, int fr, int fq) const {
        const int col0 = u.pn * 256 + wc * 32 + 8 * fq;
        f32x4 bv[2][2];
#pragma unroll
        for (int bj = 0; bj < 2; ++bj)
#pragma unroll
            for (int n = 0; n < 2; ++n) bv[bj][n] = *(const f32x4*)(b_out + col0 + 128 * bj + 4 * n);
#pragma unroll
        for (int ai = 0; ai < 2; ++ai)
#pragma unroll
            for (int m = 0; m < 4; ++m) {
                const size_t off = (size_t)(u.pm * 256 + ai * 128 + wr * 64 + m * 16 + fr) * D + col0;
#pragma unroll
                for (int bj = 0; bj < 2; ++bj) {
                    const f32x4 x0 = *(const f32x4*)(x + off + 128 * bj), x1 = *(const f32x4*)(x + off + 128 * bj + 4);
                    const f32x4 v0 = acc[ai][bj][m][0] + bv[bj][0] + x0 * DN_ALPHA, v1 = acc[ai][bj][m][1] + bv[bj][1] + x1 * DN_ALPHA;
                    u32x4 w; w.x = cvtpk(v0[0], v0[1]); w.y = cvtpk(v0[2], v0[3]); w.z = cvtpk(v1[0], v1[1]); w.w = cvtpk(v1[2], v1[3]);
                    *(u32x4*)(y + off + 128 * bj) = w; }
                if (m & 1) asm volatile("" ::: "memory");
            }
    }
};
struct EpiSwiglu {
    unsigned char* act8; const float* b1;
    __device__ __forceinline__ void operator()(const f32x4 (&acc)[2][2][4][2], const Unit& u, int wr, int wc, int fr, int fq) const {
        const int a0 = 128 * u.pn + 32 * wc + 8 * fq;
        const float* bp = b1 + (size_t)u.e * 2048 + 2 * a0;
        f32x4 bb[4];
#pragma unroll
        for (int q = 0; q < 4; ++q) bb[q] = *(const f32x4*)(bp + 4 * q);
        unsigned char* tile = act8 + (size_t)u.pm * (256 * 1024);
#pragma unroll
        for (int ai = 0; ai < 2; ++ai)
#pragma unroll
            for (int m = 0; m < 4; ++m) {
                const int row = ai * 128 + wr * 64 + m * 16 + fr;
                float r[8];
#pragma unroll
                for (int n = 0; n < 2; ++n)
#pragma unroll
                    for (int j = 0; j < 4; ++j) {
                        const int q = 4 * n + j;
                        float g = acc[ai][0][m][n][j] * (1.0f / W_SCALE) + bb[q >> 1][(2 * q) & 3];
                        float l = acc[ai][1][m][n][j] * (1.0f / W_SCALE) + bb[q >> 1][((2 * q) & 3) + 1];
                        g = fminf(g, 7.0f); l = fminf(fmaxf(l, -7.0f), 7.0f);
                        const float sg = __builtin_amdgcn_rcpf(1.0f + __builtin_amdgcn_exp2f(-1.702f * LOG2E * g));
                        r[q] = g * sg * (l + 1.0f) * ACT_SCALE;
                    }
                u32x2 w; w.x = pk4_fp8(r[0], r[1], r[2], r[3]); w.y = pk4_fp8(r[4], r[5], r[6], r[7]);
                *(u32x2*)(tile + (size_t)row * 1024 + (size_t)a0) = w;
            }
    }
};
struct EpiDown {
    bf16_t* yb; const float* b2;
    __device__ __forceinline__ void operator()(const f32x4 (&acc)[2][2][4][2], const Unit& u, int wr, int wc, int fr, int fq) const {
        const int col0 = u.pn * 256 + wc * 32 + 8 * fq;
        const float* bp = b2 + (size_t)u.e * 1024 + col0;
        f32x4 bv[2][2];
#pragma unroll
        for (int bj = 0; bj < 2; ++bj)
#pragma unroll
            for (int n = 0; n < 2; ++n) bv[bj][n] = *(const f32x4*)(bp + 128 * bj + 4 * n);
#pragma unroll
        for (int ai = 0; ai < 2; ++ai)
#pragma unroll
            for (int m = 0; m < 4; ++m) {
                bf16_t* rowp = yb + (size_t)(u.pm * 256 + ai * 128 + wr * 64 + m * 16 + fr) * 1024 + col0;
#pragma unroll
                for (int bj = 0; bj < 2; ++bj) { const f32x4 v0 = acc[ai][bj][m][0] * (1.0f / (W_SCALE * ACT_SCALE)) + bv[bj][0], v1 = acc[ai][bj][m][1] * (1.0f / (W_SCALE * ACT_SCALE)) + bv[bj][1];
                    u32x4 w; w.x = cvtpk(v0[0], v0[1]); w.y = cvtpk(v0[2], v0[3]); w.z = cvtpk(v1[0], v1[1]); w.w = cvtpk(v1[2], v1[3]);
                    *(u32x4*)(rowp + 128 * bj) = w; }
            }
    }
};
}

namespace att {
constexpr int PITCH = INW, SLOTB = 8192;
constexpr int L_K = 0, L_V = 2 * SLOTB, L_WS = 4 * SLOTB, L_KS = L_WS + 2048, L_OST = L_KS + 2048, L_END = L_OST + 8 * 4096;
constexpr float NEG = -1.0e30f, M0 = -1.0e20f;
typedef LAS const char* lds_cptr;
__device__ __forceinline__ int crow(int r, int hi) { return (r & 3) + 8 * (r >> 2) + 4 * hi; }
__device__ __forceinline__ void glds16(const void* gsrc, unsigned lds_dst) { unsigned keep;
    asm volatile("s_mov_b32 %0, m0\n\ts_mov_b32 m0, %2\n\ts_nop 0\n\tglobal_load_lds_dwordx4 %1, off\n\ts_mov_b32 m0, %0" : "=&s"(keep) : "v"(gsrc), "s"(lds_dst) : "memory"); }
#define ATT_WAIT_BAR0() asm volatile("s_waitcnt vmcnt(0) lgkmcnt(0)\n\ts_barrier" ::: "memory")
#define ATT_SBAR() __builtin_amdgcn_sched_barrier(0)

__device__ __forceinline__ void qkt(f32x16& p0, f32x16& p1, lds_cptr kb, const bf16x8* qr) {
    const f32x16 z = {};
#pragma unroll
    for (int d0 = 0; d0 < 4; ++d0) {
        const bf16x8 b0 = *(const LAS bf16x8*)(kb + d0 * 2048);
        const bf16x8 b1 = *(const LAS bf16x8*)(kb + d0 * 2048 + 512);
        if (d0 == 0) { p0 = __builtin_amdgcn_mfma_f32_32x32x16_bf16(b0, qr[0], z, 0, 0, 0); p1 = __builtin_amdgcn_mfma_f32_32x32x16_bf16(b1, qr[0], z, 0, 0, 0); }
        else { p0 = __builtin_amdgcn_mfma_f32_32x32x16_bf16(b0, qr[d0], p0, 0, 0, 0); p1 = __builtin_amdgcn_mfma_f32_32x32x16_bf16(b1, qr[d0], p1, 0, 0, 0); }
    }
}
__device__ __forceinline__ float rowmax32(const f32x16& p0, const f32x16& p1) {
    float a = fmaxf(p0[0], p1[0]);
#pragma unroll
    for (int r = 1; r < 16; ++r) a = fmaxf(a, fmaxf(p0[r], p1[r]));
    auto rr = __builtin_amdgcn_permlane32_swap(__float_as_uint(a), __float_as_uint(a), false, false);
    return fmaxf(__uint_as_float(rr[0]), __uint_as_float(rr[1]));
}
__device__ __forceinline__ void pv(f32x16* o, int vb, bf16x8 pa0, bf16x8 pa1, bf16x8 pa2, bf16x8 pa3) {
#pragma unroll
    for (int d0 = 0; d0 < 2; ++d0) { s16x4 lo[4], hi[4];
#pragma unroll
        for (int ks = 0; ks < 4; ++ks) {
            asm volatile("ds_read_b64_tr_b16 %0,%1 offset:%c2" : "=&v"(lo[ks]) : "v"(vb), "i"(d0 * 4096 + ks * 1024) : "memory");
            asm volatile("ds_read_b64_tr_b16 %0,%1 offset:%c2" : "=&v"(hi[ks]) : "v"(vb), "i"(d0 * 4096 + ks * 1024 + 512) : "memory"); }
        asm volatile("s_waitcnt lgkmcnt(0)" ::: "memory"); ATT_SBAR();
#define ATT_PK(k) (bf16x8){lo[k][0], lo[k][1], lo[k][2], lo[k][3], hi[k][0], hi[k][1], hi[k][2], hi[k][3]}
        o[d0] = __builtin_amdgcn_mfma_f32_32x32x16_bf16(pa0, ATT_PK(0), o[d0], 0, 0, 0);
        o[d0] = __builtin_amdgcn_mfma_f32_32x32x16_bf16(pa1, ATT_PK(1), o[d0], 0, 0, 0);
        o[d0] = __builtin_amdgcn_mfma_f32_32x32x16_bf16(pa2, ATT_PK(2), o[d0], 0, 0, 0);
        o[d0] = __builtin_amdgcn_mfma_f32_32x32x16_bf16(pa3, ATT_PK(3), o[d0], 0, 0, 0);
#undef ATT_PK
    }
}

template <bool MOBA>
__device__ __forceinline__ void attn_item(char* shm, const bf16_t* __restrict__ qkv, bf16_t* __restrict__ aout, int b, int hh, int qb, const float* __restrict__ sinks, const float* __restrict__ ksum) {
    int tid = threadIdx.x; asm volatile("" : "+v"(tid));
    const int lane = tid & 63, r32 = lane & 31, hi = lane >> 5; const int wid = __builtin_amdgcn_readfirstlane(tid >> 6);
    const long rowbase = (long)b * SEQ;
    int qa, qcol, kcol, vcol, ocol, kt0, kt1;
    if (MOBA) { qa = 256 * qb + 32 * wid; qcol = 768 + 64 * hh; kcol = 1280 + 64 * hh; vcol = 1792 + 64 * hh; ocol = 512 + 64 * hh; kt0 = 0; kt1 = 4 * qb + 4; }
    else { const int g = wid >> 1; qa = 64 * qb + 32 * (wid & 1); qcol = (4 * hh + g) * 64; kcol = 512 + 64 * hh; vcol = 640 + 64 * hh; ocol = qcol; kt0 = qb - 2 < 0 ? 0 : qb - 2; kt1 = qb + 1; }
    const bf16_t* Qw = qkv + (rowbase + qa) * PITCH + qcol;
    const bf16_t* Kh = qkv + rowbase * PITCH + kcol; const bf16_t* Vh = qkv + rowbase * PITCH + vcol;
    const unsigned lds0 = (unsigned)(uintptr_t)shm;
    float* wsf = (float*)(shm + L_WS) + wid * 64;
    const bf16_t* ksrc = Kh + (long)lane * PITCH + wid * 8;
    const bf16_t* vsrc = Vh + (long)(16 * (wid & 3) + (lane >> 2)) * PITCH + (wid >> 2) * 32 + (lane & 3) * 8;
    const unsigned kdst = lds0 + L_K + wid * 1024, vdst = lds0 + L_V + wid * 1024;
#define ATT_DMA_K(t, slot) glds16(ksrc + (long)(t) * 64 * PITCH, (unsigned)__builtin_amdgcn_readfirstlane(kdst + (slot)))
#define ATT_DMA_V(t, slot) glds16(vsrc + (long)(t) * 64 * PITCH, (unsigned)__builtin_amdgcn_readfirstlane(vdst + (slot)))
    const int vb0 = (int)(lds0 + L_V) + ((lane >> 4) & 1) * 32 + (lane & 3) * 8 + (4 * hi + ((lane & 15) >> 2)) * 64;
    const lds_cptr shm3 = (lds_cptr)shm; const lds_cptr kp0 = shm3 + L_K + hi * 1024 + r32 * 16;
    ATT_DMA_K(kt0, 0); ATT_DMA_V(kt0, 0);
    if (MOBA) { float* ksl = (float*)(shm + L_KS); ksl[tid] = ksum[((size_t)b * 8 + (tid >> 6)) * 512 + 64 * hh + (tid & 63)]; }
    bf16x8 qr[4];
#pragma unroll
    for (int d0 = 0; d0 < 4; ++d0) qr[d0] = *reinterpret_cast<const bf16x8*>(&Qw[(long)r32 * PITCH + d0 * 16 + hi * 8]);
    float m_run, l_run;
    if (MOBA) { m_run = M0; l_run = 0.f; }
    else { m_run = sinks[4 * hh + (wid >> 1)] * LOG2E; l_run = (hi == 0) ? 1.0f : 0.0f; }
    f32x16 o[2]; o[0] = f32x16{}; o[1] = f32x16{};
    ATT_WAIT_BAR0();
    unsigned sel = 0u;
    if (MOBA) {
        if (qb <= 3) sel = (1u << qb) - 1u;
        else {
            const float* ksl = (const float*)(shm + L_KS);
            float gv[7];
#pragma unroll
            for (int i = 0; i < 7; ++i) {
                float s = 0.f;
#pragma unroll
                for (int d0 = 0; d0 < 4; ++d0) {
                    const f32x4 k0 = *(const f32x4*)(ksl + i * 64 + 16 * d0 + 8 * hi), k1 = *(const f32x4*)(ksl + i * 64 + 16 * d0 + 8 * hi + 4);
#pragma unroll
                    for (int jj = 0; jj < 4; ++jj) { s += bf2f((unsigned short)qr[d0][jj]) * k0[jj]; s += bf2f((unsigned short)qr[d0][4 + jj]) * k1[jj]; }
                }
                auto rr = __builtin_amdgcn_permlane32_swap(__float_as_uint(s), __float_as_uint(s), false, false);
                s = __uint_as_float(rr[0]) + __uint_as_float(rr[1]);
                gv[i] = (i < qb) ? s : -INFINITY;
            }
#pragma unroll
            for (int rk = 0; rk < 3; ++rk) { float best = -INFINITY; int bi = 0;
#pragma unroll
                for (int i = 0; i < 7; ++i) { const bool c = (((sel >> i) & 1u) == 0u) && (gv[i] > best); best = c ? gv[i] : best; bi = c ? i : bi; }
                sel |= 1u << bi; }
        }
    }
    const int NT = kt1 - kt0;
    for (int it = 0; it < NT; ++it) {
        const int kt = kt0 + it; const int cur = (it & 1) * SLOTB;
        if (it + 1 < NT) { ATT_DMA_K(kt + 1, cur ^ SLOTB); ATT_DMA_V(kt + 1, cur ^ SLOTB); }
        bool need;
        if (MOBA) need = (kt < 4 * qb) ? true : (64 * kt <= qa + 31);
        else need = (64 * kt + 63 >= qa - 127) && (64 * kt <= qa + 31);
        if (need) {
            f32x16 p0, p1; qkt(p0, p1, kp0 + cur, qr);
            if (MOBA && kt < 4 * qb) {
                const bool on = ((sel >> (kt >> 2)) & 1u) != 0u;
#pragma unroll
                for (int r = 0; r < 16; ++r) { p0[r] = on ? p0[r] : NEG; p1[r] = on ? p1[r] : NEG; }
            } else {
                const int dq = qa + r32 - 64 * kt - 4 * hi;
#pragma unroll
                for (int r = 0; r < 16; ++r) { const int d0_ = dq - ((r & 3) + 8 * (r >> 2)), d1_ = d0_ - 32;
                    const bool v0 = MOBA ? (d0_ >= 0) : ((unsigned)d0_ < 128u), v1 = MOBA ? (d1_ >= 0) : ((unsigned)d1_ < 128u);
                    p0[r] = v0 ? p0[r] : NEG; p1[r] = v1 ? p1[r] : NEG; }
            }
            const float rm = rowmax32(p0, p1);
            const float mnew = fmaxf(m_run, rm);
            const float f = __builtin_amdgcn_exp2f(m_run - mnew);
            m_run = mnew; l_run *= f;
            if (hi == 0) wsf[r32] = f;
            LDS_WAIT();
#pragma unroll
            for (int r = 0; r < 16; ++r) { const float fr_ = wsf[crow(r, hi)]; o[0][r] *= fr_; o[1][r] *= fr_; }
            float sacc = 0.f;
#pragma unroll
            for (int r = 0; r < 16; ++r) { p0[r] = __builtin_amdgcn_exp2f(p0[r] - mnew); p1[r] = __builtin_amdgcn_exp2f(p1[r] - mnew); sacc += p0[r] + p1[r]; }
            l_run += sacc;
            u32x4 pw0, pw1, pw2, pw3;
            pw0 = (u32x4){cvtpk(p0[0], p0[1]), cvtpk(p0[2], p0[3]), cvtpk(p0[4], p0[5]), cvtpk(p0[6], p0[7])};
            pw1 = (u32x4){cvtpk(p0[8], p0[9]), cvtpk(p0[10], p0[11]), cvtpk(p0[12], p0[13]), cvtpk(p0[14], p0[15])};
            pw2 = (u32x4){cvtpk(p1[0], p1[1]), cvtpk(p1[2], p1[3]), cvtpk(p1[4], p1[5]), cvtpk(p1[6], p1[7])};
            pw3 = (u32x4){cvtpk(p1[8], p1[9]), cvtpk(p1[10], p1[11]), cvtpk(p1[12], p1[13]), cvtpk(p1[14], p1[15])};
            ATT_SBAR();
            pv(o, vb0 + cur, __builtin_bit_cast(bf16x8, pw0), __builtin_bit_cast(bf16x8, pw1), __builtin_bit_cast(bf16x8, pw2), __builtin_bit_cast(bf16x8, pw3));
        }
        if (it + 1 < NT) ATT_WAIT_BAR0();
    }
    { auto rr = __builtin_amdgcn_permlane32_swap(__float_as_uint(l_run), __float_as_uint(l_run), false, false); l_run = __uint_as_float(rr[0]) + __uint_as_float(rr[1]); }
    if (hi == 0) wsf[32 + r32] = l_run;
    LDS_WAIT();
    float rli[16];
#pragma unroll
    for (int r = 0; r < 16; ++r) rli[r] = __builtin_amdgcn_rcpf(wsf[32 + crow(r, hi)]);
    bf16_t* Ow = aout + (rowbase + qa) * D + ocol;
    { bf16_t* stg = (bf16_t*)(shm + L_OST) + wid * 2048;
#pragma unroll
        for (int r = 0; r < 16; ++r) { const int orow = crow(r, hi);
#pragma unroll
            for (int d0 = 0; d0 < 2; ++d0) stg[orow * 64 + d0 * 32 + r32] = (bf16_t)f2bf(o[d0][r] * rli[r]); }
        LDS_WAIT();
#pragma unroll
        for (int i = 0; i < 4; ++i) { const int row = i * 8 + (lane >> 3), ch = lane & 7; const u32x4 v = *(const u32x4*)(stg + row * 64 + ch * 8); *(u32x4*)(Ow + (long)row * D + ch * 8) = v; } }
    asm volatile("s_waitcnt lgkmcnt(0)\n\ts_barrier" ::: "memory");
#undef ATT_DMA_K
#undef ATT_DMA_V
}
}

__device__ __forceinline__ void sincos_d(double a, double& s, double& c) {
    const double q = __builtin_rint(a * 0.63661977236758134308);
    double r = __builtin_fma(-q, 1.57079632679489655800e+00, a);
    r = __builtin_fma(-q, 6.12323399573676603587e-17, r);
    const double r2 = r * r;
    double sp = -1.0 / 1307674368000.0;
    sp = sp * r2 + 1.0 / 6227020800.0; sp = sp * r2 - 1.0 / 39916800.0; sp = sp * r2 + 1.0 / 362880.0; sp = sp * r2 - 1.0 / 5040.0; sp = sp * r2 + 1.0 / 120.0; sp = sp * r2 - 1.0 / 6.0;
    const double sr = r + r * r2 * sp;
    double cp = 1.0 / 20922789888000.0;
    cp = cp * r2 - 1.0 / 87178291200.0; cp = cp * r2 + 1.0 / 479001600.0; cp = cp * r2 - 1.0 / 3628800.0; cp = cp * r2 + 1.0 / 40320.0; cp = cp * r2 - 1.0 / 720.0; cp = cp * r2 + 1.0 / 24.0; cp = cp * r2 - 0.5;
    const double cr = 1.0 + r2 * cp;
    const int n = ((int)q) & 3;
    s = (n == 0) ? sr : (n == 1) ? cr : (n == 2) ? -sr : -cr;
    c = (n == 0) ? cr : (n == 1) ? -sr : (n == 2) ? -cr : sr;
}
__device__ __forceinline__ int sigma_col(int p, int mode) {
    if (mode == 0) return (p & ~255) + 64 * ((p >> 5) & 3) + 32 * ((p >> 7) & 1) + pg8::perm32(p & 31);
    if (mode == 1) return (p & ~31) + pg8::perm32(p & 31);
    const int pn = p >> 8, q = p & 255; return 2 * (128 * pn + 32 * ((q >> 5) & 3) + pg8::perm32(q & 31)) + (q >> 7);
}
__device__ __forceinline__ void p0_transpose_item(const float* __restrict__ W, int N, bf16_t* __restrict__ WT, int mode, LAS float* scr, int item, int lane) {
    const int nblk = N / 32, kb = item / nblk, nb = item % nblk, k0 = 64 * kb, p0 = 32 * nb;
    const int sc = sigma_col(p0 + (lane & 31), mode);
#pragma unroll 8
    for (int i = 0; i < 32; ++i) { const int kk = 2 * i + (lane >> 5); scr[kk * 33 + (lane & 31)] = W[(size_t)(k0 + kk) * N + sc]; }
    LDS_WAIT(); asm volatile("" ::: "memory");
    const int c = lane & 7;
#pragma unroll
    for (int j = 0; j < 4; ++j) { const int n = (lane >> 3) + 8 * j; const LAS float* s = scr + (8 * c) * 33 + n;
        u32x4 o; o.x = cvtpk(s[0 * 33], s[1 * 33]); o.y = cvtpk(s[2 * 33], s[3 * 33]); o.z = cvtpk(s[4 * 33], s[5 * 33]); o.w = cvtpk(s[6 * 33], s[7 * 33]);
        *(u32x4*)(WT + (size_t)(p0 + n) * 1024 + k0 + 8 * c) = o; }
    LDS_WAIT(); asm volatile("" ::: "memory");
}

__device__ __forceinline__ void p0_transpose_item_fp8(const float* __restrict__ W, int N, unsigned char* __restrict__ WT, int mode, float scale, LAS float* scr, int item, int lane) {
    const int nblk = N / 32, kb = item / nblk, nb = item % nblk, k0 = 64 * kb, p0 = 32 * nb;
    const int sc = sigma_col(p0 + (lane & 31), mode);
#pragma unroll 8
    for (int i = 0; i < 32; ++i) { const int kk = 2 * i + (lane >> 5); scr[kk * 33 + (lane & 31)] = W[(size_t)(k0 + kk) * N + sc] * scale; }
    LDS_WAIT(); asm volatile("" ::: "memory");
    const int c = lane & 7;
#pragma unroll
    for (int j = 0; j < 4; ++j) { const int n = (lane >> 3) + 8 * j; const LAS float* s = scr + (8 * c) * 33 + n;
        u32x2 o; o.x = pk4_fp8(s[0 * 33], s[1 * 33], s[2 * 33], s[3 * 33]); o.y = pk4_fp8(s[4 * 33], s[5 * 33], s[6 * 33], s[7 * 33]);
        *(u32x2*)(WT + (size_t)(p0 + n) * 1024 + k0 + 8 * c) = o; }
    LDS_WAIT(); asm volatile("" ::: "memory");
}


#define XB_TMO      128
#define XB_XCNT(j)  (256  + 64 * (j))
#define XB_XSUB(j)  (1280 + 64 * (j))
#define XB_XGEN(j)  (2304 + 64 * (j))
#define XB_TOP      3328
#define XB_TOPGEN   3392
#define XCD_BAR_WORDS 3456
#define XB_SPIN_CAP (1u << 18)
__device__ __forceinline__ unsigned xb_ld(unsigned* p)              { return __hip_atomic_load(p, __ATOMIC_RELAXED, __HIP_MEMORY_SCOPE_AGENT); }
__device__ __forceinline__ unsigned xb_add(unsigned* p, unsigned v) { return __hip_atomic_fetch_add(p, v, __ATOMIC_RELAXED, __HIP_MEMORY_SCOPE_AGENT); }
__device__ __forceinline__ unsigned xb_xcc_id() { return (unsigned)__builtin_amdgcn_s_getreg((3 << 11) | 20) & 0xFu; }
#define XB_SPIN(cond, bar) do { unsigned _sp = 0; while (cond) { __builtin_amdgcn_s_sleep(1); \
    if ((++_sp & 255u) == 0u) { if (xb_ld(&(bar)[XB_TMO])) break; if (_sp > XB_SPIN_CAP) { atomicAdd(&(bar)[XB_TMO], 1u); break; } } } } while (0)
struct XcdBarrier { unsigned* bar; unsigned x; volatile LAS unsigned* st; };
__device__ __forceinline__ XcdBarrier xcd_barrier_post(unsigned* bar, volatile LAS unsigned* st) {
    XcdBarrier b; b.bar = bar; b.x = xb_xcc_id(); b.st = st;
    if (threadIdx.x == 0) (void)xb_add(&bar[XB_XCNT(b.x)], 1u);
    return b;
}
__device__ __forceinline__ void xcd_barrier_complete(unsigned* bar, unsigned x, unsigned& nloc, unsigned& nx) {
    const unsigned G = gridDim.x * gridDim.y * gridDim.z;
    unsigned sum, cnt, mine, sp = 0u;
    for (;;) {
        sum = 0u; cnt = 0u; mine = 0u;
#pragma unroll
        for (unsigned j = 0; j < 16; ++j) { const unsigned c = xb_ld(&bar[XB_XCNT(j)]); sum += c; cnt += (c > 0u) ? 1u : 0u; mine = (j == x) ? c : mine; }
        if (sum == G) break;
        __builtin_amdgcn_s_sleep(1);
        if ((++sp & 255u) == 0u) { if (xb_ld(&bar[XB_TMO])) break; if (sp > XB_SPIN_CAP) { atomicAdd(&bar[XB_TMO], 1u); break; } }
    }
    nloc = mine > 0u ? mine : 1u; nx = cnt > 0u ? cnt : 1u;
}
__device__ __forceinline__ void xcd_barrier(const XcdBarrier& b) {
    asm volatile("s_waitcnt vmcnt(0)" ::: "memory");
    __syncthreads();
    if (threadIdx.x == 0) {
        unsigned* bar = b.bar;
        __builtin_amdgcn_s_waitcnt(0);
        unsigned nloc = b.st[0], nx = b.st[1];
        if (nloc == 0u) { xcd_barrier_complete(bar, b.x, nloc, nx); b.st[0] = nloc; b.st[1] = nx; }
        const unsigned old = xb_add(&bar[XB_XSUB(b.x)], 1u);
        const unsigned gen = old / nloc;
        if (old + 1u == (gen + 1u) * nloc) {
            __builtin_amdgcn_fence(__ATOMIC_RELEASE, "agent");
            asm volatile("s_waitcnt vmcnt(0)" ::: "memory");
            const unsigned og = xb_add(&bar[XB_TOP], 1u);
            const unsigned tg = og / nx;
            if (og + 1u == (tg + 1u) * nx) xb_add(&bar[XB_TOPGEN], 1u);
            else XB_SPIN(xb_ld(&bar[XB_TOPGEN]) == tg, bar);
            __builtin_amdgcn_fence(__ATOMIC_ACQUIRE, "agent");
            xb_add(&bar[XB_XGEN(b.x)], 1u);
            asm volatile("s_waitcnt vmcnt(0)" ::: "memory");
        } else {
            XB_SPIN(xb_ld(&bar[XB_XGEN(b.x)]) == gen, bar);
            __builtin_amdgcn_fence(__ATOMIC_ACQUIRE, "agent");
            asm volatile("s_waitcnt vmcnt(0)" ::: "memory");
        }
    }
    __syncthreads();
}

__global__ void __launch_bounds__(NTHREADS, 2) fwd_megakernel(Params p) {
    extern __shared__ __attribute__((aligned(16))) unsigned char lds_raw[];
    LAS unsigned char* lds = (LAS unsigned char*)lds_raw;
    cg::grid_group grid = cg::this_grid();
#define PHASE_IDS() int tid = threadIdx.x; asm volatile("" : "+v"(tid)); const int lane = tid & 63, wave = __builtin_amdgcn_readfirstlane(tid >> 6); (void)lane; (void)wave
    const int G = gridDim.x, bx = blockIdx.x;
    unsigned char* ws = p.ws;
    unsigned* ctl = (unsigned*)(ws + WS_CTL);
    if (threadIdx.x < 2) ((LAS unsigned*)(lds + LDS_BARST))[threadIdx.x] = 0u;
    __syncthreads();
    const XcdBarrier xbar = xcd_barrier_post(ctl + CW_BAR, (volatile LAS unsigned*)(lds + LDS_BARST));
    float* ksum = (float*)(ws + WS_KSUM);
    float* rope = (float*)(ws + WS_ROPE);
    bf16_t* w_in_t = (bf16_t*)(ws + WS_WIN_T); bf16_t* w_out_t = (bf16_t*)(ws + WS_WOUT_T);
    unsigned char* w1_8 = ws + WS_W1_8; unsigned char* w2_8 = ws + WS_W2_8; unsigned char* x1_8 = ws + WS_X1_8; unsigned char* act8 = ws + WS_ACT8;
    int* cnt_blk = (int*)(ws + WS_CNT); int* tile_e = (int*)(ws + WS_TILE_E);
    bf16_t* wr_hi = (bf16_t*)(ws + WS_WR_HI); bf16_t* wr_lo = (bf16_t*)(ws + WS_WR_LO);
    int* tok = (int*)(ws + WS_TOK);
    int* asg_e = (int*)(ws + WS_ASG_E); float* asg_g = (float*)(ws + WS_ASG_G); int* asg_d = (int*)(ws + WS_ASG_D);
    bf16_t* x1b = (bf16_t*)(ws + WS_X1B); bf16_t* x1lo = (bf16_t*)(ws + WS_X1LO);
    bf16_t* xb = (bf16_t*)(ws + WS_XB); bf16_t* attn_o = xb;
    bf16_t* qkv = (bf16_t*)(ws + WS_QKV);
    bf16_t* yb = (bf16_t*)(ws + WS_YB);

    REP(0) {
        PHASE_IDS();
        const long gt = (long)bx * NTHREADS + tid, gsz = (long)G * NTHREADS;
        for (long i = gt; i < 2048 * 32; i += gsz) {
            const int pos = (int)(i >> 5), k = (int)(i & 31);
            double inv = 1.0; for (int q = 0; q < k; ++q) inv *= 0.7498942093324559;
            double s, c; sincos_d((double)pos * inv, s, c);
            rope[pos * 64 + k] = (float)c; rope[pos * 64 + 32 + k] = (float)s;
        }
        for (long i = gt; i < 32 * 1024; i += gsz) {
            const int e = (int)(i >> 10), k = (int)(i & 1023); const float w = p.w_router[k * 32 + e];
            const unsigned h = f2bf(w); wr_hi[i] = (bf16_t)h; wr_lo[i] = (bf16_t)f2bf(w - bf2f(h));
        }
        LAS float* scr = (LAS float*)(lds + wave * 16384);
        const int gw = bx * 8 + wave, NGW = G * 8;
        constexpr int I_IN = 16 * (INW / 32), I_OUT = 16 * 32, I_W1 = 16 * 64, I_W2 = 16 * 32;
        constexpr int NITEMS = I_IN + I_OUT + NE * I_W1 + NE * I_W2;
        for (int it = gw; it < NITEMS; it += NGW) {
            int r = it;
            if (r < I_IN) { p0_transpose_item(p.w_in, INW, w_in_t, 0, scr, r, lane); continue; } r -= I_IN;
            if (r < I_OUT) { p0_transpose_item(p.w_out, 1024, w_out_t, 1, scr, r, lane); continue; } r -= I_OUT;
            if (r < NE * I_W1) { const int e = r / I_W1; p0_transpose_item_fp8(p.w1 + (size_t)e * 1024 * 2048, 2048, w1_8 + (size_t)e * 2048 * 1024, 2, W_SCALE, scr, r % I_W1, lane); continue; } r -= NE * I_W1;
            { const int e = r / I_W2; p0_transpose_item_fp8(p.w2 + (size_t)e * 1024 * 1024, 1024, w2_8 + (size_t)e * 1024 * 1024, 1, W_SCALE, scr, r % I_W2, lane); }
        }
        const f32x4* x4 = (const f32x4*)p.x; u32x4* xb4 = (u32x4*)xb;
        for (long i = gt; i < (long)T * D / 8; i += gsz) { const f32x4 a = x4[2 * i], b = x4[2 * i + 1];
            u32x4 o; o.x = cvtpk(a[0], a[1]); o.y = cvtpk(a[2], a[3]); o.z = cvtpk(b[0], b[1]); o.w = cvtpk(b[2], b[3]); xb4[i] = o; }
    }
    grid.sync();

    REP(1) {
        pg8::SchedInProj S{(const char*)xb, (const char*)w_in_t, G, bx};
        pg8::EpiInProj E{qkv, p.b_in, rope, ksum};
        pg8::gemm_phase<pg8::EpiInProj, pg8::SchedInProj, false, true>(lds, S, E);
    }
    xcd_barrier(xbar);

    REP(2) for (int u = bx; u < 256; u += G) {
        { const int b = u >> 3, h = u & 7;
            for (int j = 0; j < 8; ++j) att::attn_item<true>((char*)lds_raw, qkv, attn_o, b, h, j, p.sinks, ksum); }
        { const int b = u >> 3, kvh = (u >> 2) & 1, oct = u & 3;
            for (int i = 0; i < 8; ++i) att::attn_item<false>((char*)lds_raw, qkv, attn_o, b, kvh, oct * 8 + i, p.sinks, ksum); }
    }
    xcd_barrier(xbar);

    REP(3) for (int pm = bx; pm < T / 256; pm += G) {
        PHASE_IDS();
        {
            pg8::SchedPanel S{(const char*)attn_o, (const char*)w_out_t, pm};
            pg8::EpiOutProj E{(bf16_t*)p.out, p.b_out, p.x};
            pg8::gemm_phase<pg8::EpiOutProj, pg8::SchedPanel, false, true>(lds, S, E);
        }
        __syncthreads();
        {
#pragma unroll
            for (int i = 0; i < 16; ++i) { const int idx = tid + 512 * i, mat = idx >> 12, rw = (idx >> 7) & 31, ch = idx & 127;
                const u32x4 v = *(const u32x4*)((mat ? wr_lo : wr_hi) + rw * 1024 + ch * 8);
                *(LAS u32x4*)(lds + mat * 66048 + rw * 2064 + ch * 16) = v; }
        }
        {
            const bf16_t* ytmp = (const bf16_t*)p.out;
            f32x4 gg[2][2], bb[2][2];
#pragma unroll
            for (int j = 0; j < 2; ++j)
#pragma unroll
                for (int h = 0; h < 2; ++h) { gg[j][h] = *(const f32x4*)(p.ln1_g + 512 * j + 8 * lane + 4 * h); bb[j][h] = *(const f32x4*)(p.ln1_b + 512 * j + 8 * lane + 4 * h); }
            for (int rr = 0; rr < 32; rr += 4) {
                const size_t row0 = (size_t)pm * 256 + wave * 32 + rr;
                u32x4 raw[4][2]; float v[4][2][8]; float sm[4], sq[4];
#pragma unroll
                for (int q = 0; q < 4; ++q)
#pragma unroll
                    for (int j = 0; j < 2; ++j) raw[q][j] = *(const u32x4*)(ytmp + (row0 + q) * D + 512 * j + 8 * lane);
#pragma unroll
                for (int q = 0; q < 4; ++q) { float s_ = 0.f;
#pragma unroll
                    for (int j = 0; j < 2; ++j)
#pragma unroll
                        for (int c = 0; c < 4; ++c) { const unsigned w = raw[q][j][c]; v[q][j][2 * c] = bf2f(w & 0xffffu); v[q][j][2 * c + 1] = bf2f(w >> 16); s_ += v[q][j][2 * c] + v[q][j][2 * c + 1]; }
                    sm[q] = s_; }
#pragma unroll
                for (int o = 1; o < 64; o <<= 1) {
#pragma unroll
                    for (int q = 0; q < 4; ++q) sm[q] += __shfl_xor(sm[q], o); }
#pragma unroll
                for (int q = 0; q < 4; ++q) { const float mean = sm[q] * (1.0f / D); float s2 = 0.f;
#pragma unroll
                    for (int j = 0; j < 2; ++j)
#pragma unroll
                        for (int c = 0; c < 8; ++c) { v[q][j][c] -= mean; s2 += v[q][j][c] * v[q][j][c]; }
                    sq[q] = s2; }
#pragma unroll
                for (int o = 1; o < 64; o <<= 1) {
#pragma unroll
                    for (int q = 0; q < 4; ++q) sq[q] += __shfl_xor(sq[q], o); }
#pragma unroll
                for (int q = 0; q < 4; ++q) {
                    const float rstd = 1.0f / sqrtf(sq[q] * (1.0f / D) + LN_EPS);
#pragma unroll
                    for (int j = 0; j < 2; ++j) {
                        float xv[8];
#pragma unroll
                        for (int c = 0; c < 8; ++c) xv[c] = v[q][j][c] * rstd * gg[j][c >> 2][c & 3] + bb[j][c >> 2][c & 3];
                        u32x4 hv; hv.x = cvtpk(xv[0], xv[1]); hv.y = cvtpk(xv[2], xv[3]); hv.z = cvtpk(xv[4], xv[5]); hv.w = cvtpk(xv[6], xv[7]);
                        u32x2 fv; fv.x = pk4_fp8(xv[0], xv[1], xv[2], xv[3]); fv.y = pk4_fp8(xv[4], xv[5], xv[6], xv[7]);
                        *(u32x4*)(x1b + (row0 + q) * D + 512 * j + 8 * lane) = hv;
                        *(u32x2*)(x1_8 + (row0 + q) * D + 512 * j + 8 * lane) = fv;
                    }
                }
            }
        }
        __syncthreads();
        {
            const int fr = lane & 15, fq = lane >> 4;
            f32x4 lacc[2][2];
#pragma unroll
            for (int m = 0; m < 2; ++m)
#pragma unroll
                for (int n = 0; n < 2; ++n) lacc[m][n] = (f32x4){0.f, 0.f, 0.f, 0.f};
            const size_t r0 = (size_t)pm * 256 + wave * 32;
            const bf16_t* ah = x1b + (r0 + fr) * D + 8 * fq;
            const LAS unsigned char* bh = lds + fr * 2064 + 16 * fq; const LAS unsigned char* bl = bh + 66048;
#pragma unroll 4
            for (int k0 = 0; k0 < 1024; k0 += 32) {
                bf16x8 a_hi[2], b_hi[2], b_lo[2];
#pragma unroll
                for (int m = 0; m < 2; ++m) a_hi[m] = *(const bf16x8*)(ah + (size_t)m * 16 * D + k0);
#pragma unroll
                for (int n = 0; n < 2; ++n) { b_hi[n] = *(const LAS bf16x8*)(bh + n * 16 * 2064 + k0 * 2); b_lo[n] = *(const LAS bf16x8*)(bl + n * 16 * 2064 + k0 * 2); }
#pragma unroll
                for (int m = 0; m < 2; ++m)
#pragma unroll
                    for (int n = 0; n < 2; ++n) {
                        lacc[m][n] = __builtin_amdgcn_mfma_f32_16x16x32_bf16(a_hi[m], b_hi[n], lacc[m][n], 0, 0, 0);
                        lacc[m][n] = __builtin_amdgcn_mfma_f32_16x16x32_bf16(a_hi[m], b_lo[n], lacc[m][n], 0, 0, 0);
                    }
            }
            __syncthreads();
            LAS float* lg = (LAS float*)lds;
#pragma unroll
            for (int m = 0; m < 2; ++m)
#pragma unroll
                for (int n = 0; n < 2; ++n)
#pragma unroll
                    for (int rg = 0; rg < 4; ++rg) lg[(wave * 32 + 16 * m + 4 * fq + rg) * 33 + 16 * n + fr] = lacc[m][n][rg];
        }
        __syncthreads();
        {
            LAS float* lg = (LAS float*)lds;
            LAS int* wcnt = (LAS int*)(lds + 36864);
            float t0 = -INFINITY, t1 = -INFINITY, t2 = -INFINITY, t3 = -INFINITY; int i0 = 0, i1 = 0, i2 = 0, i3 = 0;
            int rk0 = 0, rk1 = 0, rk2 = 0, rk3 = 0;
            if (tid < 256) {
                for (int e = 0; e < NE; ++e) {
                    const float xv = lg[tid * 33 + e] + p.b_router[e];
                    if (xv > t3) {
                        if (xv > t2) { t3 = t2; i3 = i2;
                            if (xv > t1) { t2 = t1; i2 = i1;
                                if (xv > t0) { t1 = t0; i1 = i0; t0 = xv; i0 = e; } else { t1 = xv; i1 = e; }
                            } else { t2 = xv; i2 = e; }
                        } else { t3 = xv; i3 = e; }
                    }
                }
                const unsigned selm = (1u << i0) | (1u << i1) | (1u << i2) | (1u << i3);
                for (int e = 0; e < NE; ++e) {
                    const bool has = ((selm >> e) & 1u) != 0u;
                    const unsigned long long bal = __ballot(has);
                    const int pre = __popcll(bal & ((1ull << lane) - 1ull));
                    if (e == i0) rk0 = pre; if (e == i1) rk1 = pre; if (e == i2) rk2 = pre; if (e == i3) rk3 = pre;
                    if (lane == 0) wcnt[wave * 32 + e] = __popcll(bal);
                }
            }
            __syncthreads();
            if (tid < 256) {
                const float e1 = __expf(t1 - t0), e2 = __expf(t2 - t0), e3 = __expf(t3 - t0);
                const float inv = 1.0f / (1.0f + e1 + e2 + e3);
                int b0 = 0, b1 = 0, b2 = 0, b3 = 0;
                for (int w = 0; w < wave; ++w) { b0 += wcnt[w * 32 + i0]; b1 += wcnt[w * 32 + i1]; b2 += wcnt[w * 32 + i2]; b3 += wcnt[w * 32 + i3]; }
                const size_t a = ((size_t)pm * 256 + tid) * 4;
                *(int4*)(asg_e + a) = make_int4(i0, i1, i2, i3);
                *(float4*)(asg_g + a) = make_float4(inv, e1 * inv, e2 * inv, e3 * inv);
                *(int4*)(asg_d + a) = make_int4(b0 + rk0, b1 + rk1, b2 + rk2, b3 + rk3);
            }
            if (tid < 32) cnt_blk[pm * 32 + tid] = wcnt[tid] + wcnt[32 + tid] + wcnt[64 + tid] + wcnt[96 + tid];
            __syncthreads();
        }
    }
    xcd_barrier(xbar);

    for (int pm = bx; pm < T / 256; pm += G) {
        PHASE_IDS();
        LAS int* part_all = (LAS int*)lds; LAS int* part_pre = part_all + 512; LAS int* tot = part_pre + 512; LAS int* pre = tot + 32; LAS int* poff = pre + 32;
        { const int e = tid & 31, seg = tid >> 5; int sa = 0, sp = 0;
            for (int bb = seg * 16; bb < seg * 16 + 16; ++bb) { const int c = cnt_blk[bb * 32 + e]; sa += c; sp += (bb < pm) ? c : 0; }
            part_all[tid] = sa; part_pre[tid] = sp; }
        __syncthreads();
        if (tid < 32) { int sa = 0, sp = 0; for (int s = 0; s < 16; ++s) { sa += part_all[s * 32 + tid]; sp += part_pre[s * 32 + tid]; } tot[tid] = sa; pre[tid] = sp; }
        __syncthreads();
        if (tid == 0) { int off = 0; for (int e = 0; e < NE; ++e) { poff[e] = off; off += ((tot[e] + 255) >> 8) << 8; } poff[32] = off; }
        __syncthreads();
        if (tid < 256) {
            const int token = pm * 256 + tid; const size_t a = (size_t)token * 4;
            const int4 ee = *(const int4*)(asg_e + a); const int4 rk = *(const int4*)(asg_d + a);
            const int d0 = poff[ee.x] + pre[ee.x] + rk.x, d1 = poff[ee.y] + pre[ee.y] + rk.y, d2 = poff[ee.z] + pre[ee.z] + rk.z, d3 = poff[ee.w] + pre[ee.w] + rk.w;
            *(int4*)(asg_d + a) = make_int4(d0, d1, d2, d3);
            tok[d0] = token; tok[d1] = token; tok[d2] = token; tok[d3] = token;
        }
        if (pm < NE) {
            const int e = pm, n = tot[e], np = ((n + 255) >> 8) << 8, o = poff[e];
            for (int i = n + tid; i < np; i += NTHREADS) tok[o + i] = 0;
            for (int i = tid; i < (np >> 8); i += NTHREADS) tile_e[(o >> 8) + i] = e;
        }
        if (pm == 0 && tid == 0) ctl[CW_NTILES] = (unsigned)(poff[32] >> 8);
        __syncthreads();
    }
    xcd_barrier(xbar);

    const int ntiles = (int)ctl[CW_NTILES];
    REP(5) {
        pg8::SchedMoe<8, true> S{(const char*)x1_8, (const char*)w1_8, tile_e, tok, ntiles, G, bx};
        pg8::EpiSwiglu E{act8, p.b1};
        pg8::gemm_phase<pg8::EpiSwiglu, pg8::SchedMoe<8, true>, true, true, 512, true>(lds, S, E);
    }
    xcd_barrier(xbar);

    REP(6) {
        pg8::SchedMoe<4, false> S{(const char*)act8, (const char*)w2_8, tile_e, tok, ntiles, G, bx};
        pg8::EpiDown E{yb, p.b2};
        pg8::gemm_phase<pg8::EpiDown, pg8::SchedMoe<4, false>, false, true, 512, true>(lds, S, E);
    }
    xcd_barrier(xbar);

    REP(7) {
        PHASE_IDS();
        const int gw = bx * 8 + wave, NGW = G * 8;
        f32x4 gg[2][2], bb[2][2];
#pragma unroll
        for (int j = 0; j < 2; ++j)
#pragma unroll
            for (int h = 0; h < 2; ++h) { gg[j][h] = *(const f32x4*)(p.ln2_g + 512 * j + 8 * lane + 4 * h); bb[j][h] = *(const f32x4*)(p.ln2_b + 512 * j + 8 * lane + 4 * h); }
        for (int row = gw; row < T; row += NGW) {
            const size_t a = (size_t)row * 4;
            const int4 dd = *(const int4*)(asg_d + a); const float4 gt4 = *(const float4*)(asg_g + a);
            u32x4 xr[2], y0[2], y1[2], y2[2], y3[2];
#pragma unroll
            for (int j = 0; j < 2; ++j) {
                xr[j] = *(const u32x4*)(x1b + (size_t)row * D + 512 * j + 8 * lane);
                y0[j] = *(const u32x4*)(yb + (size_t)dd.x * D + 512 * j + 8 * lane);
                y1[j] = *(const u32x4*)(yb + (size_t)dd.y * D + 512 * j + 8 * lane);
                y2[j] = *(const u32x4*)(yb + (size_t)dd.z * D + 512 * j + 8 * lane);
                y3[j] = *(const u32x4*)(yb + (size_t)dd.w * D + 512 * j + 8 * lane);
            }
            float z[2][8]; float s = 0.f;
#pragma unroll
            for (int j = 0; j < 2; ++j)
#pragma unroll
                for (int q = 0; q < 4; ++q) {
                    const unsigned xw = xr[j][q], a0 = y0[j][q], a1 = y1[j][q], a2 = y2[j][q], a3 = y3[j][q];
                    const float lo = DN_ALPHA * bf2f(xw & 0xffffu) + gt4.x * bf2f(a0 & 0xffffu) + gt4.y * bf2f(a1 & 0xffffu) + gt4.z * bf2f(a2 & 0xffffu) + gt4.w * bf2f(a3 & 0xffffu);
                    const float hi = DN_ALPHA * bf2f(xw >> 16) + gt4.x * bf2f(a0 >> 16) + gt4.y * bf2f(a1 >> 16) + gt4.z * bf2f(a2 >> 16) + gt4.w * bf2f(a3 >> 16);
                    z[j][2 * q] = lo; z[j][2 * q + 1] = hi; s += lo + hi;
                }
            const float mean = wave_sum(s) * (1.0f / D); float s2 = 0.f;
#pragma unroll
            for (int j = 0; j < 2; ++j)
#pragma unroll
                for (int q = 0; q < 8; ++q) { z[j][q] -= mean; s2 += z[j][q] * z[j][q]; }
            const float rstd = 1.0f / sqrtf(wave_sum(s2) * (1.0f / D) + LN_EPS);
#pragma unroll
            for (int j = 0; j < 2; ++j)
#pragma unroll
                for (int h = 0; h < 2; ++h) {
                    f32x4 o;
#pragma unroll
                    for (int q = 0; q < 4; ++q) o[q] = z[j][4 * h + q] * rstd * gg[j][h][q] + bb[j][h][q];
                    *(f32x4*)(p.out + (size_t)row * D + 512 * j + 8 * lane + 4 * h) = o;
                }
        }
    }
}

extern "C" void kernel_launch(void* const* d_in, const int* in_sizes, int n_in, void* d_out, int out_size, void* d_ws, size_t ws_size, hipStream_t stream) {
    static int grid_blocks = 0;
    if (grid_blocks == 0) {
        if (n_in != 16 || in_sizes[0] != T * D || out_size != T * D || ws_size < WS_END) {
            fprintf(stderr, "kernel_launch: unexpected shapes: n_in %d in0 %d out %d ws %zu (need %zu)\n", n_in, n_in > 0 ? in_sizes[0] : -1, out_size, ws_size, (size_t)WS_END); grid_blocks = -1; return; }
        int dev = 0, cus = 0, per_cu = 0;
        (void)hipGetDevice(&dev);
        (void)hipDeviceGetAttribute(&cus, hipDeviceAttributeMultiprocessorCount, dev);
        (void)hipFuncSetAttribute((const void*)fwd_megakernel, hipFuncAttributeMaxDynamicSharedMemorySize, LDS_BYTES);
        (void)hipOccupancyMaxActiveBlocksPerMultiprocessor(&per_cu, (const void*)fwd_megakernel, NTHREADS, LDS_BYTES);
        if (per_cu < 1) { fprintf(stderr, "kernel_launch: occupancy query reports %d blocks per CU\n", per_cu); per_cu = 1; }
        grid_blocks = cus;
        fprintf(stderr, "kernel_launch: cus=%d per_cu=%d grid=%d ws=%zu\n", cus, per_cu, grid_blocks, ws_size);
    }
    if (grid_blocks < 0) return;
    (void)hipMemsetAsync((char*)d_ws + WS_CTL, 0, CTL_ZERO_BYTES, stream);
    Params p{};
    p.x = (const float*)d_in[0]; p.w_in = (const float*)d_in[1]; p.b_in = (const float*)d_in[2]; p.sinks = (const float*)d_in[3]; p.w_out = (const float*)d_in[4]; p.b_out = (const float*)d_in[5];
    p.ln1_g = (const float*)d_in[6]; p.ln1_b = (const float*)d_in[7]; p.w_router = (const float*)d_in[8]; p.b_router = (const float*)d_in[9];
    p.w1 = (const float*)d_in[10]; p.b1 = (const float*)d_in[11]; p.w2 = (const float*)d_in[12]; p.b2 = (const float*)d_in[13]; p.ln2_g = (const float*)d_in[14]; p.ln2_b = (const float*)d_in[15];
    p.out = (float*)d_out; p.ws = (unsigned char*)d_ws;
    void* args[] = {&p};
    hipError_t e = hipLaunchCooperativeKernel((void*)fwd_megakernel, dim3(grid_blocks), dim3(NTHREADS), args, LDS_BYTES, stream);
    if (e != hipSuccess) fprintf(stderr, "cooperative launch failed: %s (grid %d)\n", hipGetErrorString(e), grid_blocks);
}
```

```cpp
#include <hip/hip_runtime.h>
#include <hip/hip_cooperative_groups.h>
#include <cstdio>
#include <cstdint>
namespace cg = cooperative_groups;

#define LAS __attribute__((address_space(3)))
typedef unsigned short bf16_t;
typedef short bf16x8 __attribute__((ext_vector_type(8)));
typedef short s16x4 __attribute__((ext_vector_type(4)));
typedef float f32x2 __attribute__((ext_vector_type(2)));
typedef float f32x4 __attribute__((ext_vector_type(4)));
typedef float f32x16 __attribute__((ext_vector_type(16)));
typedef unsigned u32x2 __attribute__((ext_vector_type(2)));
typedef unsigned u32x4 __attribute__((ext_vector_type(4)));
typedef __bf16 bf16x2_t __attribute__((ext_vector_type(2)));

constexpr int D = 1024, BATCH = 32, SEQ = 2048, T = BATCH * SEQ;
constexpr int INW = 2304, NE = 32;
constexpr float LN_EPS = 1e-5f;
constexpr float DN_ALPHA = 1.189207115002721f;
constexpr float LOG2E = 1.4426950408889634f;
constexpr float C2 = 0.18033688011112042f;
constexpr int NTHREADS = 512;
constexpr int LDS_BYTES = 147456;
constexpr int MAX_TILES = 1056;
#ifndef DUP_MASK
#define DUP_MASK 0
#endif
#define REP(k) for (int _rep = 0; _rep < (((DUP_MASK >> (k)) & 1) ? 2 : 1); ++_rep)

constexpr size_t MiB = 1u << 20;
constexpr size_t WS_CTL = 0, CTL_ZERO_BYTES = 2 * MiB;
constexpr size_t WS_KSUM = 1 * MiB;
constexpr size_t WS_ROPE = 2 * MiB;
constexpr size_t WS_WIN_T = 4 * MiB;
constexpr size_t WS_WOUT_T = 9 * MiB;
constexpr size_t WS_SMALL = 11 * MiB;
constexpr size_t WS_CNT = WS_SMALL, WS_TILE_E = WS_SMALL + 65536, WS_WR_HI = WS_SMALL + 131072, WS_WR_LO = WS_WR_HI + 65536;
constexpr size_t WS_TOK = 12 * MiB;
constexpr size_t WS_ASG_E = 14 * MiB, WS_ASG_G = 15 * MiB, WS_ASG_D = 16 * MiB;
constexpr size_t WS_W2_8 = 24 * MiB;
constexpr size_t WS_X1B = 56 * MiB;
constexpr size_t WS_ACT8 = 184 * MiB;
constexpr size_t WS_XB = 184 * MiB;
constexpr size_t WS_X1LO = 312 * MiB;
constexpr size_t WS_YB = 488 * MiB;
constexpr size_t WS_W1_8 = 488 * MiB;
constexpr size_t WS_X1_8 = 552 * MiB;
constexpr size_t WS_QKV = 616 * MiB;
constexpr size_t WS_END = 1016 * MiB;
constexpr float W_SCALE = 64.0f, ACT_SCALE = 4.0f;
constexpr int CW_NTILES = 16, CW_BAR = 4096;
constexpr int LDS_BARST = LDS_BYTES - 256;

struct Params {
    const float *x, *w_in, *b_in, *sinks, *w_out, *b_out, *ln1_g, *ln1_b, *w_router, *b_router, *w1, *b1, *w2, *b2, *ln2_g, *ln2_b;
    float* out; unsigned char* ws;
};

__device__ __forceinline__ unsigned f2bf(float f) { unsigned u = __builtin_bit_cast(unsigned, f); return (u + 0x7fffu + ((u >> 16) & 1u)) >> 16; }
__device__ __forceinline__ float bf2f(unsigned h) { return __builtin_bit_cast(float, h << 16); }
__device__ __forceinline__ unsigned cvtpk(float lo, float hi) { f32x2 v = {lo, hi}; bf16x2_t b = __builtin_convertvector(v, bf16x2_t); return __builtin_bit_cast(unsigned, b); }
__device__ __forceinline__ unsigned pk4_fp8(float a, float b, float c, float d) { int w = 0; w = __builtin_amdgcn_cvt_pk_fp8_f32(a, b, w, false); w = __builtin_amdgcn_cvt_pk_fp8_f32(c, d, w, true); return (unsigned)w; }
__device__ __forceinline__ float wave_sum(float v) {
#pragma unroll
    for (int o = 1; o < 64; o <<= 1) v += __shfl_xor(v, o);
    return v;
}
#define LDS_WAIT() asm volatile("s_waitcnt lgkmcnt(0)" ::: "memory")

namespace pg8 {
constexpr int BM = 256, BK = 64, HALF = 128, HTB = HALF * BK * 2, STAGE_BYTES = 8 * HTB, NXCD = 8, WGM = 8;
constexpr int KD = 1024;
__host__ __device__ __forceinline__ int lds_byte(int r, int c) { const int st = (r >> 4) * 2 + (c >> 5), rr = r & 15, cc = c & 31, ob = rr * 64 + cc * 2; return st * 1024 + (ob ^ (((ob >> 9) & 1) << 5)); }
__host__ __device__ __forceinline__ void stage_rc(int b, int& R, int& C) { const int st = b / 1024, sb = b % 1024, swz = sb ^ (((sb >> 9) & 1) << 5); R = (st >> 1) * 16 + swz / 64; C = (st & 1) * 32 + (swz % 64) / 2; }
__host__ __device__ __forceinline__ int perm32(int rho) { const int n = rho >> 4, i = rho & 15; return 8 * (i >> 2) + 4 * n + (i & 3); }

struct Unit { int pm, pn, e; unsigned ao, bo; const int* rows; };

typedef int v8i32_t __attribute__((ext_vector_type(8)));
typedef int v4i32_t __attribute__((ext_vector_type(4)));
__device__ __forceinline__ v8i32_t cat8(bf16x8 a, bf16x8 b) { const v4i32_t x = __builtin_bit_cast(v4i32_t, a), y = __builtin_bit_cast(v4i32_t, b); return __builtin_shufflevector(x, y, 0, 1, 2, 3, 4, 5, 6, 7); }
template <class Epi, class Sched, bool GATHER, bool ALIGN_EPI, int KP = 1024, bool FP8 = false>
__device__ __forceinline__ void gemm_phase(LAS unsigned char* lds, const Sched& S, const Epi& E) {
    int tid = threadIdx.x; asm volatile("" : "+v"(tid));
    const int wid = __builtin_amdgcn_readfirstlane(tid >> 6), lane = tid & 63, wr = wid >> 2, wc = wid & 3, fr = lane & 15, fq = lane >> 4;
    constexpr int K = KP, nt = K / BK;
    unsigned voffB[2], Vc[2][2], Vn[2][2]; int stR0, stC0;
    { int R, C; stage_rc(tid * 16, R, C); stR0 = R; stC0 = C; }
#pragma unroll
    for (int i = 0; i < 2; ++i) { voffB[i] = (unsigned)((stR0 + 64 * i) * K + stC0) * 2u; Vc[0][i] = voffB[i]; Vc[1][i] = voffB[i]; Vn[0][i] = voffB[i]; Vn[1][i] = voffB[i]; }
#define PG8_GATHER_LOAD(VV, rowsp) do { int _t = threadIdx.x; asm volatile("" : "+v"(_t)); int _R, _C; stage_rc(_t * 16, _R, _C);     \
        const int* _rp = (const int*)((const char*)(rowsp) + (unsigned)(_R * 4)); _Pragma("unroll") for (int _h = 0; _h < 2; ++_h) _Pragma("unroll") for (int _i = 0; _i < 2; ++_i) \
        VV[_h][_i] = ((unsigned)_rp[128 * _h + 64 * _i] * (unsigned)K + (unsigned)_C) * 2u; } while (0)
    constexpr unsigned kstep = (unsigned)(BK * 2);
    constexpr unsigned hstep = (unsigned)HALF * K * 2;
    const char* const Abase = S.A; const char* const Bbase = S.B;
    const unsigned ldsw = (unsigned)wid * 1024u;
    const int aoff = lds_byte(wr * 64 + fr, fq * 8), boff = lds_byte(wc * 32 + fr, fq * 8);
#define PG8_SA(b, h) (((b) * 2 + (h)) * HTB)
#define PG8_SB(b, h) ((4 + (b) * 2 + (h)) * HTB)
#define PG8_STAGE(bufoff, gbase, soff, voff) do { _Pragma("unroll") for (int _i = 0; _i < 2; ++_i) \
        __builtin_amdgcn_global_load_lds((const unsigned*)((gbase) + (unsigned)((voff)[_i] + (soff))), (LAS unsigned*)(lds + (bufoff) + ldsw + _i * 8192), 16, 0, 0); } while (0)
#define PG8_STAGE_B(bufoff, soff) PG8_STAGE(bufoff, Bbase, soff, voffB)
#define PG8_STAGE_A(bufoff, soff, h, VV) do { if constexpr (GATHER) { PG8_STAGE(bufoff, Abase, soff, VV[h]); } else { PG8_STAGE(bufoff, Abase, (soff) + (h) * hstep, voffB); } } while (0)
#define PG8_LDA(dst, b, h) do { _Pragma("unroll") for (int m = 0; m < 4; ++m) dst[m] = cat8(*(const LAS bf16x8*)(lds + PG8_SA(b, h) + aoff + m * 2048), *(const LAS bf16x8*)(lds + PG8_SA(b, h) + aoff + m * 2048 + 1024)); } while (0)
#define PG8_LDB(dst, b, h) do { _Pragma("unroll") for (int n = 0; n < 2; ++n) dst[n] = cat8(*(const LAS bf16x8*)(lds + PG8_SB(b, h) + boff + n * 2048), *(const LAS bf16x8*)(lds + PG8_SB(b, h) + boff + n * 2048 + 1024)); } while (0)
#define PG8_LO(v) __builtin_bit_cast(bf16x8, __builtin_shufflevector(v, v, 0, 1, 2, 3))
#define PG8_HI(v) __builtin_bit_cast(bf16x8, __builtin_shufflevector(v, v, 4, 5, 6, 7))
#define PG8_MMA(ai, bj, At, Bt) do { __builtin_amdgcn_s_setprio(1); _Pragma("unroll") for (int m = 0; m < 4; ++m) _Pragma("unroll") for (int n = 0; n < 2; ++n) { \
        if constexpr (FP8) { acc[ai][bj][m][n] = __builtin_amdgcn_mfma_scale_f32_16x16x128_f8f6f4(Bt[n], At[m], acc[ai][bj][m][n], 0, 0, 0, 0x7f7f7f7f, 0, 0x7f7f7f7f); } \
        else { acc[ai][bj][m][n] = __builtin_amdgcn_mfma_f32_16x16x32_bf16(PG8_LO(Bt[n]), PG8_LO(At[m]), acc[ai][bj][m][n], 0, 0, 0); \
               acc[ai][bj][m][n] = __builtin_amdgcn_mfma_f32_16x16x32_bf16(PG8_HI(Bt[n]), PG8_HI(At[m]), acc[ai][bj][m][n], 0, 0, 0); } } \
        __builtin_amdgcn_s_setprio(0); } while (0)
#define PG8_WAIT_V(n) asm volatile("s_waitcnt vmcnt(" #n ")" ::: "memory")
#define PG8_WAIT_L(n) asm volatile("s_waitcnt lgkmcnt(" #n ")" ::: "memory")
#define PG8_BAR __builtin_amdgcn_s_barrier()
#define PG8_SCHED __builtin_amdgcn_sched_barrier(0)
    Unit cur, nxt; int ui = 0;
    if (!S.next(0, cur)) return;
    if constexpr (GATHER) { PG8_GATHER_LOAD(Vc, cur.rows); }
    f32x4 acc[2][2][4][2];
#pragma unroll
    for (int a = 0; a < 2; ++a)
#pragma unroll
        for (int b = 0; b < 2; ++b)
#pragma unroll
            for (int m = 0; m < 4; ++m)
#pragma unroll
                for (int n = 0; n < 2; ++n) acc[a][b][m][n] = (f32x4){0.f, 0.f, 0.f, 0.f};
    v8i32_t At[4], B0[2], B1[2];
    unsigned cA = cur.ao, cB = cur.bo;
    PG8_STAGE_B(PG8_SB(0, 0), cB); PG8_STAGE_B(PG8_SB(0, 1), cB + hstep); PG8_STAGE_A(PG8_SA(0, 0), cA, 0, Vc); PG8_STAGE_A(PG8_SA(0, 1), cA, 1, Vc);
    if (wr == 1) PG8_BAR;
    PG8_WAIT_V(2); PG8_BAR;
    PG8_STAGE_B(PG8_SB(1, 0), cB + kstep); PG8_STAGE_A(PG8_SA(1, 0), cA + kstep, 0, Vc); PG8_STAGE_B(PG8_SB(1, 1), cB + hstep + kstep);
    PG8_WAIT_V(6); PG8_BAR;
    for (;;) {
        const bool has_next = S.next(ui + 1, nxt);
        const unsigned nA = has_next ? nxt.ao : cA; const unsigned nB = has_next ? nxt.bo : cB;
        if constexpr (GATHER) {
            if (has_next) { PG8_GATHER_LOAD(Vn, nxt.rows); }
            else {
#pragma unroll
                for (int i = 0; i < 2; ++i) { Vn[0][i] = Vc[0][i]; Vn[1][i] = Vc[1][i]; }
            }
        }
#pragma unroll 1
        for (int t = 0; t < nt; t += 2) {
            const bool last = (t == nt - 2);
            const unsigned a1 = cA + (unsigned)(t + 1) * kstep;
            const unsigned a2 = last ? nA : cA + (unsigned)(t + 2) * kstep; const unsigned b2 = last ? nB : cB + (unsigned)(t + 2) * kstep;
            const unsigned a3 = a2 + kstep; const unsigned b3 = b2 + kstep;
            PG8_LDB(B0, 0, 0); PG8_LDB(B1, 0, 1); PG8_SCHED; PG8_LDA(At, 0, 0); PG8_STAGE_A(PG8_SA(1, 1), a1, 1, Vc);
            if constexpr (GATHER) { if (last) {
#pragma unroll
                for (int i = 0; i < 2; ++i) { Vc[0][i] = Vn[0][i]; Vc[1][i] = Vn[1][i]; } } }
            PG8_WAIT_V(8); PG8_WAIT_L(0); PG8_BAR; PG8_MMA(0, 0, At, B0); PG8_MMA(0, 1, At, B1); PG8_BAR; PG8_SCHED;
            PG8_LDA(At, 0, 1); PG8_STAGE_B(PG8_SB(0, 0), b2); PG8_STAGE_B(PG8_SB(0, 1), b2 + hstep); PG8_STAGE_A(PG8_SA(0, 0), a2, 0, Vc);
            PG8_WAIT_V(8); PG8_WAIT_L(0); PG8_BAR; PG8_MMA(1, 0, At, B0); PG8_MMA(1, 1, At, B1); PG8_BAR; PG8_SCHED;
            PG8_LDB(B0, 1, 0); PG8_LDB(B1, 1, 1); PG8_SCHED; PG8_LDA(At, 1, 0); PG8_STAGE_A(PG8_SA(0, 1), a2, 1, Vc);
            PG8_WAIT_V(8); PG8_WAIT_L(0); PG8_BAR; PG8_MMA(0, 0, At, B0); PG8_MMA(0, 1, At, B1); PG8_BAR; PG8_SCHED;
            PG8_LDA(At, 1, 1); PG8_STAGE_B(PG8_SB(1, 0), b3); PG8_STAGE_B(PG8_SB(1, 1), b3 + hstep); PG8_STAGE_A(PG8_SA(1, 0), a3, 0, Vc);
            PG8_WAIT_V(8); PG8_WAIT_L(0); PG8_BAR; PG8_MMA(1, 0, At, B0); PG8_MMA(1, 1, At, B1); PG8_BAR; PG8_SCHED;
        }
        if constexpr (ALIGN_EPI) { if (wr == 0) PG8_BAR; }
        E(acc, cur, wr, wc, fr, fq);
        if (!has_next) break;
#pragma unroll
        for (int a = 0; a < 2; ++a)
#pragma unroll
            for (int b = 0; b < 2; ++b)
#pragma unroll
                for (int m = 0; m < 4; ++m)
#pragma unroll
                    for (int n = 0; n < 2; ++n) acc[a][b][m][n] = (f32x4){0.f, 0.f, 0.f, 0.f};
        cur = nxt; cA = nA; cB = nB; ++ui;
        if constexpr (ALIGN_EPI) { if (wr == 1) PG8_BAR; }
    }
    PG8_WAIT_V(0);
    if constexpr (!ALIGN_EPI) { if (wr == 0) PG8_BAR; }
    PG8_BAR;
#undef PG8_SA
#undef PG8_SB
#undef PG8_STAGE
#undef PG8_STAGE_A
#undef PG8_STAGE_B
#undef PG8_GATHER_LOAD
#undef PG8_LDA
#undef PG8_LDB
#undef PG8_LO
#undef PG8_HI
#undef PG8_MMA
#undef PG8_WAIT_V
#undef PG8_WAIT_L
#undef PG8_BAR
#undef PG8_SCHED
}

struct SchedInProj {
    const char* A; const char* B; int G, c;
    __device__ __forceinline__ bool next(int i, Unit& u) const {
        constexpr int nM = T / BM, nN = INW / BM, nwg = nM * nN;
        const long L = (long)i * G + c; if (L >= nwg) return false;
        int wgid = (int)L; { const int q = nwg / NXCD, r = nwg % NXCD, xcd = wgid % NXCD, off = wgid / NXCD; wgid = (xcd < r ? xcd * (q + 1) : r * (q + 1) + (xcd - r) * q) + off; }
        const int nig = WGM * nN, gid = wgid / nig, fm = gid * WGM, gsz = (nM - fm) < WGM ? (nM - fm) : WGM;
        u.pm = fm + ((wgid % nig) % gsz); u.pn = (wgid % nig) / gsz; u.e = 0; u.rows = nullptr;
        u.ao = (unsigned)u.pm * (unsigned)(2 * HALF * KD * 2); u.bo = (unsigned)u.pn * (unsigned)(2 * HALF * KD * 2); return true;
    }
};
struct SchedPanel {
    const char* A; const char* B; int pm;
    __device__ __forceinline__ bool next(int i, Unit& u) const {
        if (i >= 4) return false;
        u.pm = pm; u.pn = i; u.e = 0; u.rows = nullptr; u.ao = (unsigned)pm * (unsigned)(256 * KD * 2); u.bo = (unsigned)i * (unsigned)(256 * KD * 2); return true;
    }
};
template <int NPN, bool G1>
struct SchedMoe {
    const char* A; const char* B; const int* tile_e; const int* tok; int ntiles, G, c;
    __device__ __forceinline__ bool next(int i, Unit& u) const {
        const long L = (long)i * G + c; int t, pn;
        if ((G & 7) == 0) { const int x = (int)(L & 7); const long j = L >> 3; t = (int)(j / NPN) * 8 + x; pn = (int)(j % NPN); }
        else { t = (int)(L / NPN); pn = (int)(L % NPN); }
        if (t >= ntiles) return false;
        const int e = tile_e[t];
        u.pm = t; u.pn = pn; u.e = e;
        if (G1) { u.ao = 0u; u.rows = tok + (size_t)t * 256; u.bo = ((unsigned)e * 2048u + (unsigned)pn * 256u) * 1024u; }
        else { u.ao = (unsigned)t * (256u * 1024u); u.rows = nullptr; u.bo = ((unsigned)e * 1024u + (unsigned)pn * 256u) * 1024u; }
        return true;
    }
};

struct EpiInProj {
    bf16_t* qkv; const float* b_in; const float* rope; float* ksum;
    __device__ __forceinline__ void operator()(const f32x4 (&acc)[2][2][4][2], const Unit& u, int wr, int wc, int fr, int fq) const {
        const int pn = u.pn;
        const int colb = 256 * pn + 64 * wc + 8 * fq;
        const bool do_rope = !(pn >= 7 || (pn == 2 && wc >= 2));
        const bool is_q = (pn < 2) || (pn == 3) || (pn == 4);
        const bool is_kb = (pn == 5) || (pn == 6);
        const float sc = is_q ? C2 : 1.0f;
        f32x4 bv[2][2];
#pragma unroll
        for (int bj = 0; bj < 2; ++bj)
#pragma unroll
            for (int n = 0; n < 2; ++n) bv[bj][n] = *(const f32x4*)(b_in + colb + 32 * bj + 4 * n);
        f32x4 ks[2][2];
#pragma unroll
        for (int bj = 0; bj < 2; ++bj)
#pragma unroll
            for (int n = 0; n < 2; ++n) ks[bj][n] = (f32x4){0.f, 0.f, 0.f, 0.f};
#pragma unroll
        for (int ai = 0; ai < 2; ++ai)
#pragma unroll
            for (int m = 0; m < 4; ++m) {
                const int row = u.pm * 256 + ai * 128 + wr * 64 + m * 16 + fr;
                const int pos = row & (SEQ - 1);
                f32x4 o1[2], o2[2];
#pragma unroll
                for (int n = 0; n < 2; ++n) { o1[n] = acc[ai][0][m][n] + bv[0][n]; o2[n] = acc[ai][1][m][n] + bv[1][n]; }
                if (do_rope) {
                    const float* rp = rope + pos * 64 + 8 * fq;
#pragma unroll
                    for (int n = 0; n < 2; ++n) { const f32x4 c = *(const f32x4*)(rp + 4 * n), s = *(const f32x4*)(rp + 32 + 4 * n);
                        const f32x4 a = o1[n], b = o2[n]; o1[n] = a * c - b * s; o2[n] = b * c + a * s; }
                }
                if (is_kb) {
#pragma unroll
                    for (int n = 0; n < 2; ++n) { ks[0][n] += o1[n]; ks[1][n] += o2[n]; }
                }
                bf16_t* rowp = qkv + (size_t)row * INW + colb;
                u32x4 w1, w2;
                w1.x = cvtpk(o1[0][0] * sc, o1[0][1] * sc); w1.y = cvtpk(o1[0][2] * sc, o1[0][3] * sc); w1.z = cvtpk(o1[1][0] * sc, o1[1][1] * sc); w1.w = cvtpk(o1[1][2] * sc, o1[1][3] * sc);
                w2.x = cvtpk(o2[0][0] * sc, o2[0][1] * sc); w2.y = cvtpk(o2[0][2] * sc, o2[0][3] * sc); w2.z = cvtpk(o2[1][0] * sc, o2[1][1] * sc); w2.w = cvtpk(o2[1][2] * sc, o2[1][3] * sc);
                *(u32x4*)(rowp) = w1; *(u32x4*)(rowp + 32) = w2;
            }
        if (is_kb) {
            float* kd = ksum + (size_t)u.pm * 512 + 256 * (pn - 5) + 64 * wc + 8 * fq;
#pragma unroll
            for (int bj = 0; bj < 2; ++bj)
#pragma unroll
                for (int n = 0; n < 2; ++n)
#pragma unroll
                    for (int j = 0; j < 4; ++j) {
                        float v = ks[bj][n][j];
                        v += __shfl_xor(v, 1); v += __shfl_xor(v, 2); v += __shfl_xor(v, 4); v += __shfl_xor(v, 8);
                        if (fr == 0) atomicAdd(kd + 32 * bj + 4 * n + j, v);
                    }
        }
    }
};
struct EpiOutProj {
    bf16_t* y; const float* b_out; const float* x;
    __device__ __forceinline__ void operator()(const f32x4 (&acc)[2][2][4][2], const Unit& u, int wr, int wc, int fr, int fq) const {
        const int col0 = u.pn * 256 + wc * 32 + 8 * fq;
        f32x4 bv[2][2];
#pragma unroll
        for (int bj = 0; bj < 2; ++bj)
#pragma unroll
            for (int n = 0; n < 2; ++n) bv[bj][n] = *(const f32x4*)(b_out + col0 + 128 * bj + 4 * n);
#pragma unroll
        for (int ai = 0; ai < 2; ++ai)
#pragma unroll
            for (int m = 0; m < 4; ++m) {
                const size_t off = (size_t)(u.pm * 256 + ai * 128 + wr * 64 + m * 16 + fr) * D + col0;
#pragma unroll
                for (int bj = 0; bj < 2; ++bj) {
                    const f32x4 x0 = *(const f32x4*)(x + off + 128 * bj), x1 = *(const f32x4*)(x + off + 128 * bj + 4);
                    const f32x4 v0 = acc[ai][bj][m][0] + bv[bj][0] + x0 * DN_ALPHA, v1 = acc[ai][bj][m][1] + bv[bj][1] + x1 * DN_ALPHA;
                    u32x4 w; w.x = cvtpk(v0[0], v0[1]); w.y = cvtpk(v0[2], v0[3]); w.z = cvtpk(v1[0], v1[1]); w.w = cvtpk(v1[2], v1[3]);
                    *(u32x4*)(y + off + 128 * bj) = w; }
                if (m & 1) asm volatile("" ::: "memory");
            }
    }
};
struct EpiSwiglu {
    unsigned char* act8; const float* b1;
    __device__ __forceinline__ void operator()(const f32x4 (&acc)[2][2][4][2], const Unit& u, int wr, int wc, int fr, int fq) const {
        const int a0 = 128 * u.pn + 32 * wc + 8 * fq;
        const float* bp = b1 + (size_t)u.e * 2048 + 2 * a0;
        f32x4 bb[4];
#pragma unroll
        for (int q = 0; q < 4; ++q) bb[q] = *(const f32x4*)(bp + 4 * q);
        unsigned char* tile = act8 + (size_t)u.pm * (256 * 1024);
#pragma unroll
        for (int ai = 0; ai < 2; ++ai)
#pragma unroll
            for (int m = 0; m < 4; ++m) {
                const int row = ai * 128 + wr * 64 + m * 16 + fr;
                float r[8];
#pragma unroll
                for (int n = 0; n < 2; ++n)
#pragma unroll
                    for (int j = 0; j < 4; ++j) {
                        const int q = 4 * n + j;
                        float g = acc[ai][0][m][n][j] * (1.0f / W_SCALE) + bb[q >> 1][(2 * q) & 3];
                        float l = acc[ai][1][m][n][j] * (1.0f / W_SCALE) + bb[q >> 1][((2 * q) & 3) + 1];
                        g = fminf(g, 7.0f); l = fminf(fmaxf(l, -7.0f), 7.0f);
                        const float sg = __builtin_amdgcn_rcpf(1.0f + __builtin_amdgcn_exp2f(-1.702f * LOG2E * g));
                        r[q] = g * sg * (l + 1.0f) * ACT_SCALE;
                    }
                u32x2 w; w.x = pk4_fp8(r[0], r[1], r[2], r[3]); w.y = pk4_fp8(r[4], r[5], r[6], r[7]);
                *(u32x2*)(tile + (size_t)row * 1024 + (size_t)a0) = w;
            }
    }
};
struct EpiDown {
    bf16_t* yb; const float* b2;
    __device__ __forceinline__ void operator()(const f32x4 (&acc)[2][2][4][2], const Unit& u, int wr, int wc, int fr, int fq) const {
        const int col0 = u.pn * 256 + wc * 32 + 8 * fq;
        const float* bp = b2 + (size_t)u.e * 1024 + col0;
        f32x4 bv[2][2];
#pragma unroll
        for (int bj = 0; bj < 2; ++bj)
#pragma unroll
            for (int n = 0; n < 2; ++n) bv[bj][n] = *(const f32x4*)(bp + 128 * bj + 4 * n);
#pragma unroll
        for (int ai = 0; ai < 2; ++ai)
#pragma unroll
            for (int m = 0; m < 4; ++m) {
                bf16_t* rowp = yb + (size_t)(u.pm * 256 + ai * 128 + wr * 64 + m * 16 + fr) * 1024 + col0;
#pragma unroll
                for (int bj = 0; bj < 2; ++bj) { const f32x4 v0 = acc[ai][bj][m][0] * (1.0f / (W_SCALE * ACT_SCALE)) + bv[bj][0], v1 = acc[ai][bj][m][1] * (1.0f / (W_SCALE * ACT_SCALE)) + bv[bj][1];
                    u32x4 w; w.x = cvtpk(v0[0], v0[1]); w.y = cvtpk(v0[2], v0[3]); w.z = cvtpk(v1[0], v1[1]); w.w = cvtpk(v1[2], v1[3]);
                    *(u32x4*)(rowp + 128 * bj) = w; }
            }
    }
};
}

namespace att {
constexpr int PITCH = INW, SLOTB = 8192;
constexpr int L_K = 0, L_V = 2 * SLOTB, L_WS = 4 * SLOTB, L_KS = L_WS + 2048, L_OST = L_KS + 2048, L_END = L_OST + 8 * 4096;
constexpr float NEG = -1.0e30f, M0 = -1.0e20f, THR = 8.0f;
typedef LAS const char* lds_cptr;
__device__ __forceinline__ int crow(int r, int hi) { return (r & 3) + 8 * (r >> 2) + 4 * hi; }
__device__ __forceinline__ void glds16(const void* gsrc, unsigned lds_dst) { unsigned keep;
    asm volatile("s_mov_b32 %0, m0\n\ts_mov_b32 m0, %2\n\ts_nop 0\n\tglobal_load_lds_dwordx4 %1, off\n\ts_mov_b32 m0, %0" : "=&s"(keep) : "v"(gsrc), "s"(lds_dst) : "memory"); }
#define ATT_WAIT_BAR0() asm volatile("s_waitcnt vmcnt(0) lgkmcnt(0)\n\ts_barrier" ::: "memory")
#define ATT_SBAR() __builtin_amdgcn_sched_barrier(0)

__device__ __forceinline__ void qkt(f32x16& p0, f32x16& p1, lds_cptr kb, const bf16x8* qr, const f32x16& negm) {
#pragma unroll
    for (int d0 = 0; d0 < 4; ++d0) {
        const bf16x8 b0 = *(const LAS bf16x8*)(kb + d0 * 2048);
        const bf16x8 b1 = *(const LAS bf16x8*)(kb + d0 * 2048 + 512);
        if (d0 == 0) { p0 = __builtin_amdgcn_mfma_f32_32x32x16_bf16(b0, qr[0], negm, 0, 0, 0); p1 = __builtin_amdgcn_mfma_f32_32x32x16_bf16(b1, qr[0], negm, 0, 0, 0); }
        else { p0 = __builtin_amdgcn_mfma_f32_32x32x16_bf16(b0, qr[d0], p0, 0, 0, 0); p1 = __builtin_amdgcn_mfma_f32_32x32x16_bf16(b1, qr[d0], p1, 0, 0, 0); }
    }
}
__device__ __forceinline__ float rowmax32(const f32x16& p0, const f32x16& p1) {
    float a = fmaxf(p0[0], p1[0]);
#pragma unroll
    for (int r = 1; r < 16; ++r) a = fmaxf(a, fmaxf(p0[r], p1[r]));
    auto rr = __builtin_amdgcn_permlane32_swap(__float_as_uint(a), __float_as_uint(a), false, false);
    return fmaxf(__uint_as_float(rr[0]), __uint_as_float(rr[1]));
}
__device__ __forceinline__ void pv(f32x16* o, int vb, bf16x8 pa0, bf16x8 pa1, bf16x8 pa2, bf16x8 pa3) {
#pragma unroll
    for (int d0 = 0; d0 < 2; ++d0) { s16x4 lo[4], hi[4];
#pragma unroll
        for (int ks = 0; ks < 4; ++ks) {
            asm volatile("ds_read_b64_tr_b16 %0,%1 offset:%c2" : "=&v"(lo[ks]) : "v"(vb), "i"(d0 * 4096 + ks * 1024) : "memory");
            asm volatile("ds_read_b64_tr_b16 %0,%1 offset:%c2" : "=&v"(hi[ks]) : "v"(vb), "i"(d0 * 4096 + ks * 1024 + 512) : "memory"); }
        asm volatile("s_waitcnt lgkmcnt(0)" ::: "memory"); ATT_SBAR();
#define ATT_PK(k) (bf16x8){lo[k][0], lo[k][1], lo[k][2], lo[k][3], hi[k][0], hi[k][1], hi[k][2], hi[k][3]}
        o[d0] = __builtin_amdgcn_mfma_f32_32x32x16_bf16(pa0, ATT_PK(0), o[d0], 0, 0, 0);
        o[d0] = __builtin_amdgcn_mfma_f32_32x32x16_bf16(pa1, ATT_PK(1), o[d0], 0, 0, 0);
        o[d0] = __builtin_amdgcn_mfma_f32_32x32x16_bf16(pa2, ATT_PK(2), o[d0], 0, 0, 0);
        o[d0] = __builtin_amdgcn_mfma_f32_32x32x16_bf16(pa3, ATT_PK(3), o[d0], 0, 0, 0);
#undef ATT_PK
    }
}

template <bool MOBA>
__device__ __forceinline__ void attn_item(char* shm, const bf16_t* __restrict__ qkv, bf16_t* __restrict__ aout, int b, int hh, int qb, const float* __restrict__ sinks, const float* __restrict__ ksum) {
    int tid = threadIdx.x; asm volatile("" : "+v"(tid));
    const int lane = tid & 63, r32 = lane & 31, hi = lane >> 5; const int wid = __builtin_amdgcn_readfirstlane(tid >> 6);
    const long rowbase = (long)b * SEQ;
    int qa, qcol, kcol, vcol, ocol, kt0, kt1;
    if (MOBA) { qa = 256 * qb + 32 * wid; qcol = 768 + 64 * hh; kcol = 1280 + 64 * hh; vcol = 1792 + 64 * hh; ocol = 512 + 64 * hh; kt0 = 0; kt1 = 4 * qb + 4; }
    else { const int g = wid >> 1; qa = 64 * qb + 32 * (wid & 1); qcol = (4 * hh + g) * 64; kcol = 512 + 64 * hh; vcol = 640 + 64 * hh; ocol = qcol; kt0 = qb - 2 < 0 ? 0 : qb - 2; kt1 = qb + 1; }
    const bf16_t* Qw = qkv + (rowbase + qa) * PITCH + qcol;
    const bf16_t* Kh = qkv + rowbase * PITCH + kcol; const bf16_t* Vh = qkv + rowbase * PITCH + vcol;
    const unsigned lds0 = (unsigned)(uintptr_t)shm;
    float* wsf = (float*)(shm + L_WS) + wid * 64;
    const bf16_t* ksrc = Kh + (long)lane * PITCH + wid * 8;
    const bf16_t* vsrc = Vh + (long)(16 * (wid & 3) + (lane >> 2)) * PITCH + (wid >> 2) * 32 + (lane & 3) * 8;
    const unsigned kdst = lds0 + L_K + wid * 1024, vdst = lds0 + L_V + wid * 1024;
#define ATT_DMA_K(t, slot) glds16(ksrc + (long)(t) * 64 * PITCH, (unsigned)__builtin_amdgcn_readfirstlane(kdst + (slot)))
#define ATT_DMA_V(t, slot) glds16(vsrc + (long)(t) * 64 * PITCH, (unsigned)__builtin_amdgcn_readfirstlane(vdst + (slot)))
    const int vb0 = (int)(lds0 + L_V) + ((lane >> 4) & 1) * 32 + (lane & 3) * 8 + (4 * hi + ((lane & 15) >> 2)) * 64;
    const lds_cptr shm3 = (lds_cptr)shm; const lds_cptr kp0 = shm3 + L_K + hi * 1024 + r32 * 16;
    ATT_DMA_K(kt0, 0); ATT_DMA_V(kt0, 0);
    if (MOBA) { float* ksl = (float*)(shm + L_KS); ksl[tid] = ksum[((size_t)b * 8 + (tid >> 6)) * 512 + 64 * hh + (tid & 63)]; }
    bf16x8 qr[4];
#pragma unroll
    for (int d0 = 0; d0 < 4; ++d0) qr[d0] = *reinterpret_cast<const bf16x8*>(&Qw[(long)r32 * PITCH + d0 * 16 + hi * 8]);
    float m_run, l_run;
    if (MOBA) { m_run = M0; l_run = 0.f; }
    else { m_run = sinks[4 * hh + (wid >> 1)] * LOG2E; l_run = (hi == 0) ? 1.0f : 0.0f; }
    f32x16 negm;
#pragma unroll
    for (int r = 0; r < 16; ++r) negm[r] = MOBA ? 0.f : -m_run;
    f32x16 o[2]; o[0] = f32x16{}; o[1] = f32x16{};
    ATT_WAIT_BAR0();
    unsigned sel = 0u;
    if (MOBA) {
        if (qb <= 3) sel = (1u << qb) - 1u;
        else {
            const float* ksl = (const float*)(shm + L_KS);
            float gv[7];
#pragma unroll
            for (int i = 0; i < 7; ++i) {
                float s = 0.f;
#pragma unroll
                for (int d0 = 0; d0 < 4; ++d0) {
                    const f32x4 k0 = *(const f32x4*)(ksl + i * 64 + 16 * d0 + 8 * hi), k1 = *(const f32x4*)(ksl + i * 64 + 16 * d0 + 8 * hi + 4);
#pragma unroll
                    for (int jj = 0; jj < 4; ++jj) { s += bf2f((unsigned short)qr[d0][jj]) * k0[jj]; s += bf2f((unsigned short)qr[d0][4 + jj]) * k1[jj]; }
                }
                auto rr = __builtin_amdgcn_permlane32_swap(__float_as_uint(s), __float_as_uint(s), false, false);
                s = __uint_as_float(rr[0]) + __uint_as_float(rr[1]);
                gv[i] = (i < qb) ? s : -INFINITY;
            }
#pragma unroll
            for (int rk = 0; rk < 3; ++rk) { float best = -INFINITY; int bi = 0;
#pragma unroll
                for (int i = 0; i < 7; ++i) { const bool c = (((sel >> i) & 1u) == 0u) && (gv[i] > best); best = c ? gv[i] : best; bi = c ? i : bi; }
                sel |= 1u << bi; }
        }
    }
    const int NT = kt1 - kt0;
    for (int it = 0; it < NT; ++it) {
        const int kt = kt0 + it; const int cur = (it & 1) * SLOTB;
        if (it + 1 < NT) { ATT_DMA_K(kt + 1, cur ^ SLOTB); ATT_DMA_V(kt + 1, cur ^ SLOTB); }
        bool need; bool on = true;
        if (MOBA) { if (kt < 4 * qb) { on = ((sel >> (kt >> 2)) & 1u) != 0u; need = __any(on) != 0; } else need = (64 * kt <= qa + 31); }
        else need = (64 * kt + 63 >= qa - 127) && (64 * kt <= qa + 31);
        if (need) {
            f32x16 p0, p1; qkt(p0, p1, kp0 + cur, qr, negm);
            if (MOBA && kt < 4 * qb) {
                if (!__all(on)) {
#pragma unroll
                    for (int r = 0; r < 16; ++r) { p0[r] = on ? p0[r] : NEG; p1[r] = on ? p1[r] : NEG; }
                }
            } else {
                const bool edge = MOBA ? (64 * kt + 63 > qa) : !((64 * kt + 63 <= qa) && (qa + 31 - 64 * kt <= 127));
                if (edge) {
                    const int dq = qa + r32 - 64 * kt - 4 * hi;
#pragma unroll
                    for (int r = 0; r < 16; ++r) { const int d0_ = dq - ((r & 3) + 8 * (r >> 2)), d1_ = d0_ - 32;
                        const bool v0 = MOBA ? (d0_ >= 0) : ((unsigned)d0_ < 128u), v1 = MOBA ? (d1_ >= 0) : ((unsigned)d1_ < 128u);
                        p0[r] = v0 ? p0[r] : NEG; p1[r] = v1 ? p1[r] : NEG; }
                }
            }
            const float rm = rowmax32(p0, p1);
            const bool sent = (m_run <= M0), live = (rm > 0.5f * NEG);
            const bool upd = sent ? live : (rm > THR);
            if (__any(upd)) {
                const float dl = sent ? (live ? rm : 0.f) : fmaxf(rm, 0.f);
                const float f = sent ? 1.0f : __builtin_amdgcn_exp2f(-dl);
                m_run = sent ? (live ? rm : m_run) : (m_run + dl);
                const float nm = (m_run <= M0) ? 0.f : -m_run;
#pragma unroll
                for (int r = 0; r < 16; ++r) { p0[r] -= dl; p1[r] -= dl; negm[r] = nm; }
                l_run *= f;
                if (hi == 0) wsf[r32] = f;
                LDS_WAIT();
#pragma unroll
                for (int r = 0; r < 16; ++r) { const float fr_ = wsf[crow(r, hi)]; o[0][r] *= fr_; o[1][r] *= fr_; }
            }
            float sacc = 0.f;
#pragma unroll
            for (int r = 0; r < 16; ++r) { p0[r] = __builtin_amdgcn_exp2f(p0[r]); p1[r] = __builtin_amdgcn_exp2f(p1[r]); sacc += p0[r] + p1[r]; }
            l_run += sacc;
            u32x4 pw0, pw1, pw2, pw3;
            pw0 = (u32x4){cvtpk(p0[0], p0[1]), cvtpk(p0[2], p0[3]), cvtpk(p0[4], p0[5]), cvtpk(p0[6], p0[7])};
            pw1 = (u32x4){cvtpk(p0[8], p0[9]), cvtpk(p0[10], p0[11]), cvtpk(p0[12], p0[13]), cvtpk(p0[14], p0[15])};
            pw2 = (u32x4){cvtpk(p1[0], p1[1]), cvtpk(p1[2], p1[3]), cvtpk(p1[4], p1[5]), cvtpk(p1[6], p1[7])};
            pw3 = (u32x4){cvtpk(p1[8], p1[9]), cvtpk(p1[10], p1[11]), cvtpk(p1[12], p1[13]), cvtpk(p1[14], p1[15])};
            ATT_SBAR();
            pv(o, vb0 + cur, __builtin_bit_cast(bf16x8, pw0), __builtin_bit_cast(bf16x8, pw1), __builtin_bit_cast(bf16x8, pw2), __builtin_bit_cast(bf16x8, pw3));
        }
        if (it + 1 < NT) ATT_WAIT_BAR0();
    }
    { auto rr = __builtin_amdgcn_permlane32_swap(__float_as_uint(l_run), __float_as_uint(l_run), false, false); l_run = __uint_as_float(rr[0]) + __uint_as_float(rr[1]); }
    if (hi == 0) wsf[32 + r32] = l_run;
    LDS_WAIT();
    float rli[16];
#pragma unroll
    for (int r = 0; r < 16; ++r) rli[r] = __builtin_amdgcn_rcpf(wsf[32 + crow(r, hi)]);
    bf16_t* Ow = aout + (rowbase + qa) * D + ocol;
    { bf16_t* stg = (bf16_t*)(shm + L_OST) + wid * 2048;
#pragma unroll
        for (int r = 0; r < 16; ++r) { const int orow = crow(r, hi);
#pragma unroll
            for (int d0 = 0; d0 < 2; ++d0) stg[orow * 64 + d0 * 32 + r32] = (bf16_t)f2bf(o[d0][r] * rli[r]); }
        LDS_WAIT();
#pragma unroll
        for (int i = 0; i < 4; ++i) { const int row = i * 8 + (lane >> 3), ch = lane & 7; const u32x4 v = *(const u32x4*)(stg + row * 64 + ch * 8); *(u32x4*)(Ow + (long)row * D + ch * 8) = v; } }
    asm volatile("s_waitcnt lgkmcnt(0)\n\ts_barrier" ::: "memory");
#undef ATT_DMA_K
#undef ATT_DMA_V
}
}

__device__ __forceinline__ void sincos_d(double a, double& s, double& c) {
    const double q = __builtin_rint(a * 0.63661977236758134308);
    double r = __builtin_fma(-q, 1.57079632679489655800e+00, a);
    r = __builtin_fma(-q, 6.12323399573676603587e-17, r);
    const double r2 = r * r;
    double sp = -1.0 / 1307674368000.0;
    sp = sp * r2 + 1.0 / 6227020800.0; sp = sp * r2 - 1.0 / 39916800.0; sp = sp * r2 + 1.0 / 362880.0; sp = sp * r2 - 1.0 / 5040.0; sp = sp * r2 + 1.0 / 120.0; sp = sp * r2 - 1.0 / 6.0;
    const double sr = r + r * r2 * sp;
    double cp = 1.0 / 20922789888000.0;
    cp = cp * r2 - 1.0 / 87178291200.0; cp = cp * r2 + 1.0 / 479001600.0; cp = cp * r2 - 1.0 / 3628800.0; cp = cp * r2 + 1.0 / 40320.0; cp = cp * r2 - 1.0 / 720.0; cp = cp * r2 + 1.0 / 24.0; cp = cp * r2 - 0.5;
    const double cr = 1.0 + r2 * cp;
    const int n = ((int)q) & 3;
    s = (n == 0) ? sr : (n == 1) ? cr : (n == 2) ? -sr : -cr;
    c = (n == 0) ? cr : (n == 1) ? -sr : (n == 2) ? -cr : sr;
}
__device__ __forceinline__ int sigma_col(int p, int mode) {
    if (mode == 0) return (p & ~255) + 64 * ((p >> 5) & 3) + 32 * ((p >> 7) & 1) + pg8::perm32(p & 31);
    if (mode == 1) return (p & ~31) + pg8::perm32(p & 31);
    const int pn = p >> 8, q = p & 255; return 2 * (128 * pn + 32 * ((q >> 5) & 3) + pg8::perm32(q & 31)) + (q >> 7);
}
__device__ __forceinline__ void p0_transpose_item(const float* __restrict__ W, int N, bf16_t* __restrict__ WT, int mode, LAS float* scr, int item, int lane) {
    const int nblk = N / 32, kb = item / nblk, nb = item % nblk, k0 = 64 * kb, p0 = 32 * nb;
    const int sc = sigma_col(p0 + (lane & 31), mode);
#pragma unroll 8
    for (int i = 0; i < 32; ++i) { const int kk = 2 * i + (lane >> 5); scr[kk * 33 + (lane & 31)] = W[(size_t)(k0 + kk) * N + sc]; }
    LDS_WAIT(); asm volatile("" ::: "memory");
    const int c = lane & 7;
#pragma unroll
    for (int j = 0; j < 4; ++j) { const int n = (lane >> 3) + 8 * j; const LAS float* s = scr + (8 * c) * 33 + n;
        u32x4 o; o.x = cvtpk(s[0 * 33], s[1 * 33]); o.y = cvtpk(s[2 * 33], s[3 * 33]); o.z = cvtpk(s[4 * 33], s[5 * 33]); o.w = cvtpk(s[6 * 33], s[7 * 33]);
        *(u32x4*)(WT + (size_t)(p0 + n) * 1024 + k0 + 8 * c) = o; }
    LDS_WAIT(); asm volatile("" ::: "memory");
}

__device__ __forceinline__ void p0_transpose_item_fp8(const float* __restrict__ W, int N, unsigned char* __restrict__ WT, int mode, float scale, LAS float* scr, int item, int lane) {
    const int nblk = N / 32, kb = item / nblk, nb = item % nblk, k0 = 64 * kb, p0 = 32 * nb;
    const int sc = sigma_col(p0 + (lane & 31), mode);
#pragma unroll 8
    for (int i = 0; i < 32; ++i) { const int kk = 2 * i + (lane >> 5); scr[kk * 33 + (lane & 31)] = W[(size_t)(k0 + kk) * N + sc] * scale; }
    LDS_WAIT(); asm volatile("" ::: "memory");
    const int c = lane & 7;
#pragma unroll
    for (int j = 0; j < 4; ++j) { const int n = (lane >> 3) + 8 * j; const LAS float* s = scr + (8 * c) * 33 + n;
        u32x2 o; o.x = pk4_fp8(s[0 * 33], s[1 * 33], s[2 * 33], s[3 * 33]); o.y = pk4_fp8(s[4 * 33], s[5 * 33], s[6 * 33], s[7 * 33]);
        *(u32x2*)(WT + (size_t)(p0 + n) * 1024 + k0 + 8 * c) = o; }
    LDS_WAIT(); asm volatile("" ::: "memory");
}


#define XB_TMO      128
#define XB_XCNT(j)  (256  + 64 * (j))
#define XB_XSUB(j)  (1280 + 64 * (j))
#define XB_XGEN(j)  (2304 + 64 * (j))
#define XB_TOP      3328
#define XB_TOPGEN   3392
#define XCD_BAR_WORDS 3456
#define XB_SPIN_CAP (1u << 18)
__device__ __forceinline__ unsigned xb_ld(unsigned* p)              { return __hip_atomic_load(p, __ATOMIC_RELAXED, __HIP_MEMORY_SCOPE_AGENT); }
__device__ __forceinline__ unsigned xb_add(unsigned* p, unsigned v) { return __hip_atomic_fetch_add(p, v, __ATOMIC_RELAXED, __HIP_MEMORY_SCOPE_AGENT); }
__device__ __forceinline__ unsigned xb_xcc_id() { return (unsigned)__builtin_amdgcn_s_getreg((3 << 11) | 20) & 0xFu; }
#define XB_SPIN(cond, bar) do { unsigned _sp = 0; while (cond) { __builtin_amdgcn_s_sleep(1); \
    if ((++_sp & 255u) == 0u) { if (xb_ld(&(bar)[XB_TMO])) break; if (_sp > XB_SPIN_CAP) { atomicAdd(&(bar)[XB_TMO], 1u); break; } } } } while (0)
struct XcdBarrier { unsigned* bar; unsigned x; volatile LAS unsigned* st; };
__device__ __forceinline__ XcdBarrier xcd_barrier_post(unsigned* bar, volatile LAS unsigned* st) {
    XcdBarrier b; b.bar = bar; b.x = xb_xcc_id(); b.st = st;
    if (threadIdx.x == 0) (void)xb_add(&bar[XB_XCNT(b.x)], 1u);
    return b;
}
__device__ __forceinline__ void xcd_barrier_complete(unsigned* bar, unsigned x, unsigned& nloc, unsigned& nx) {
    const unsigned G = gridDim.x * gridDim.y * gridDim.z;
    unsigned sum, cnt, mine, sp = 0u;
    for (;;) {
        sum = 0u; cnt = 0u; mine = 0u;
#pragma unroll
        for (unsigned j = 0; j < 16; ++j) { const unsigned c = xb_ld(&bar[XB_XCNT(j)]); sum += c; cnt += (c > 0u) ? 1u : 0u; mine = (j == x) ? c : mine; }
        if (sum == G) break;
        __builtin_amdgcn_s_sleep(1);
        if ((++sp & 255u) == 0u) { if (xb_ld(&bar[XB_TMO])) break; if (sp > XB_SPIN_CAP) { atomicAdd(&bar[XB_TMO], 1u); break; } }
    }
    nloc = mine > 0u ? mine : 1u; nx = cnt > 0u ? cnt : 1u;
}
__device__ __forceinline__ void xcd_barrier(const XcdBarrier& b) {
    asm volatile("s_waitcnt vmcnt(0)" ::: "memory");
    __syncthreads();
    if (threadIdx.x == 0) {
        unsigned* bar = b.bar;
        __builtin_amdgcn_s_waitcnt(0);
        unsigned nloc = b.st[0], nx = b.st[1];
        if (nloc == 0u) { xcd_barrier_complete(bar, b.x, nloc, nx); b.st[0] = nloc; b.st[1] = nx; }
        const unsigned old = xb_add(&bar[XB_XSUB(b.x)], 1u);
        const unsigned gen = old / nloc;
        if (old + 1u == (gen + 1u) * nloc) {
            __builtin_amdgcn_fence(__ATOMIC_RELEASE, "agent");
            asm volatile("s_waitcnt vmcnt(0)" ::: "memory");
            const unsigned og = xb_add(&bar[XB_TOP], 1u);
            const unsigned tg = og / nx;
            if (og + 1u == (tg + 1u) * nx) xb_add(&bar[XB_TOPGEN], 1u);
            else XB_SPIN(xb_ld(&bar[XB_TOPGEN]) == tg, bar);
            __builtin_amdgcn_fence(__ATOMIC_ACQUIRE, "agent");
            xb_add(&bar[XB_XGEN(b.x)], 1u);
            asm volatile("s_waitcnt vmcnt(0)" ::: "memory");
        } else {
            XB_SPIN(xb_ld(&bar[XB_XGEN(b.x)]) == gen, bar);
            __builtin_amdgcn_fence(__ATOMIC_ACQUIRE, "agent");
            asm volatile("s_waitcnt vmcnt(0)" ::: "memory");
        }
    }
    __syncthreads();
}

__global__ void __launch_bounds__(NTHREADS, 2) fwd_megakernel(Params p) {
    extern __shared__ __attribute__((aligned(16))) unsigned char lds_raw[];
    LAS unsigned char* lds = (LAS unsigned char*)lds_raw;
    cg::grid_group grid = cg::this_grid();
#define PHASE_IDS() int tid = threadIdx.x; asm volatile("" : "+v"(tid)); const int lane = tid & 63, wave = __builtin_amdgcn_readfirstlane(tid >> 6); (void)lane; (void)wave
    const int G = gridDim.x, bx = blockIdx.x;
    unsigned char* ws = p.ws;
    unsigned* ctl = (unsigned*)(ws + WS_CTL);
    if (threadIdx.x < 2) ((LAS unsigned*)(lds + LDS_BARST))[threadIdx.x] = 0u;
    __syncthreads();
    const XcdBarrier xbar = xcd_barrier_post(ctl + CW_BAR, (volatile LAS unsigned*)(lds + LDS_BARST));
    float* ksum = (float*)(ws + WS_KSUM);
    float* rope = (float*)(ws + WS_ROPE);
    bf16_t* w_in_t = (bf16_t*)(ws + WS_WIN_T); bf16_t* w_out_t = (bf16_t*)(ws + WS_WOUT_T);
    unsigned char* w1_8 = ws + WS_W1_8; unsigned char* w2_8 = ws + WS_W2_8; unsigned char* x1_8 = ws + WS_X1_8; unsigned char* act8 = ws + WS_ACT8;
    int* cnt_blk = (int*)(ws + WS_CNT); int* tile_e = (int*)(ws + WS_TILE_E);
    bf16_t* wr_hi = (bf16_t*)(ws + WS_WR_HI); bf16_t* wr_lo = (bf16_t*)(ws + WS_WR_LO);
    int* tok = (int*)(ws + WS_TOK);
    int* asg_e = (int*)(ws + WS_ASG_E); float* asg_g = (float*)(ws + WS_ASG_G); int* asg_d = (int*)(ws + WS_ASG_D);
    bf16_t* x1b = (bf16_t*)(ws + WS_X1B); bf16_t* x1lo = (bf16_t*)(ws + WS_X1LO);
    bf16_t* xb = (bf16_t*)(ws + WS_XB); bf16_t* attn_o = xb;
    bf16_t* qkv = (bf16_t*)(ws + WS_QKV);
    bf16_t* yb = (bf16_t*)(ws + WS_YB);

    REP(0) {
        PHASE_IDS();
        const long gt = (long)bx * NTHREADS + tid, gsz = (long)G * NTHREADS;
        for (long i = gt; i < 2048 * 32; i += gsz) {
            const int pos = (int)(i >> 5), k = (int)(i & 31);
            double inv = 1.0; for (int q = 0; q < k; ++q) inv *= 0.7498942093324559;
            double s, c; sincos_d((double)pos * inv, s, c);
            rope[pos * 64 + k] = (float)c; rope[pos * 64 + 32 + k] = (float)s;
        }
        for (long i = gt; i < 32 * 1024; i += gsz) {
            const int e = (int)(i >> 10), k = (int)(i & 1023); const float w = p.w_router[k * 32 + e];
            const unsigned h = f2bf(w); wr_hi[i] = (bf16_t)h; wr_lo[i] = (bf16_t)f2bf(w - bf2f(h));
        }
        LAS float* scr = (LAS float*)(lds + wave * 16384);
        const int gw = bx * 8 + wave, NGW = G * 8;
        constexpr int I_IN = 16 * (INW / 32), I_OUT = 16 * 32, I_W1 = 16 * 64, I_W2 = 16 * 32;
        constexpr int NITEMS = I_IN + I_OUT + NE * I_W1 + NE * I_W2;
        for (int it = gw; it < NITEMS; it += NGW) {
            int r = it;
            if (r < I_IN) { p0_transpose_item(p.w_in, INW, w_in_t, 0, scr, r, lane); continue; } r -= I_IN;
            if (r < I_OUT) { p0_transpose_item(p.w_out, 1024, w_out_t, 1, scr, r, lane); continue; } r -= I_OUT;
            if (r < NE * I_W1) { const int e = r / I_W1; p0_transpose_item_fp8(p.w1 + (size_t)e * 1024 * 2048, 2048, w1_8 + (size_t)e * 2048 * 1024, 2, W_SCALE, scr, r % I_W1, lane); continue; } r -= NE * I_W1;
            { const int e = r / I_W2; p0_transpose_item_fp8(p.w2 + (size_t)e * 1024 * 1024, 1024, w2_8 + (size_t)e * 1024 * 1024, 1, W_SCALE, scr, r % I_W2, lane); }
        }
        const f32x4* x4 = (const f32x4*)p.x; u32x4* xb4 = (u32x4*)xb;
        for (long i = gt; i < (long)T * D / 8; i += gsz) { const f32x4 a = x4[2 * i], b = x4[2 * i + 1];
            u32x4 o; o.x = cvtpk(a[0], a[1]); o.y = cvtpk(a[2], a[3]); o.z = cvtpk(b[0], b[1]); o.w = cvtpk(b[2], b[3]); xb4[i] = o; }
    }
    grid.sync();

    REP(1) {
        pg8::SchedInProj S{(const char*)xb, (const char*)w_in_t, G, bx};
        pg8::EpiInProj E{qkv, p.b_in, rope, ksum};
        pg8::gemm_phase<pg8::EpiInProj, pg8::SchedInProj, false, true>(lds, S, E);
    }
    xcd_barrier(xbar);

    REP(2) for (int u = bx; u < 256; u += G) {
        { const int b = u >> 3, h = u & 7;
            for (int j = 0; j < 8; ++j) att::attn_item<true>((char*)lds_raw, qkv, attn_o, b, h, j, p.sinks, ksum); }
        { const int b = u >> 3, kvh = (u >> 2) & 1, oct = u & 3;
            for (int i = 0; i < 8; ++i) att::attn_item<false>((char*)lds_raw, qkv, attn_o, b, kvh, oct * 8 + i, p.sinks, ksum); }
    }
    xcd_barrier(xbar);

    REP(3) for (int pm = bx; pm < T / 256; pm += G) {
        PHASE_IDS();
        {
            pg8::SchedPanel S{(const char*)attn_o, (const char*)w_out_t, pm};
            pg8::EpiOutProj E{(bf16_t*)p.out, p.b_out, p.x};
            pg8::gemm_phase<pg8::EpiOutProj, pg8::SchedPanel, false, true>(lds, S, E);
        }
        __syncthreads();
        {
#pragma unroll
            for (int i = 0; i < 16; ++i) { const int idx = tid + 512 * i, mat = idx >> 12, rw = (idx >> 7) & 31, ch = idx & 127;
                const u32x4 v = *(const u32x4*)((mat ? wr_lo : wr_hi) + rw * 1024 + ch * 8);
                *(LAS u32x4*)(lds + mat * 66048 + rw * 2064 + ch * 16) = v; }
        }
        {
            const bf16_t* ytmp = (const bf16_t*)p.out;
            f32x4 gg[2][2], bb[2][2];
#pragma unroll
            for (int j = 0; j < 2; ++j)
#pragma unroll
                for (int h = 0; h < 2; ++h) { gg[j][h] = *(const f32x4*)(p.ln1_g + 512 * j + 8 * lane + 4 * h); bb[j][h] = *(const f32x4*)(p.ln1_b + 512 * j + 8 * lane + 4 * h); }
            for (int rr = 0; rr < 32; rr += 4) {
                const size_t row0 = (size_t)pm * 256 + wave * 32 + rr;
                u32x4 raw[4][2]; float v[4][2][8]; float sm[4], sq[4];
#pragma unroll
                for (int q = 0; q < 4; ++q)
#pragma unroll
                    for (int j = 0; j < 2; ++j) raw[q][j] = *(const u32x4*)(ytmp + (row0 + q) * D + 512 * j + 8 * lane);
#pragma unroll
                for (int q = 0; q < 4; ++q) { float s_ = 0.f;
#pragma unroll
                    for (int j = 0; j < 2; ++j)
#pragma unroll
                        for (int c = 0; c < 4; ++c) { const unsigned w = raw[q][j][c]; v[q][j][2 * c] = bf2f(w & 0xffffu); v[q][j][2 * c + 1] = bf2f(w >> 16); s_ += v[q][j][2 * c] + v[q][j][2 * c + 1]; }
                    sm[q] = s_; }
#pragma unroll
                for (int o = 1; o < 64; o <<= 1) {
#pragma unroll
                    for (int q = 0; q < 4; ++q) sm[q] += __shfl_xor(sm[q], o); }
#pragma unroll
                for (int q = 0; q < 4; ++q) { const float mean = sm[q] * (1.0f / D); float s2 = 0.f;
#pragma unroll
                    for (int j = 0; j < 2; ++j)
#pragma unroll
                        for (int c = 0; c < 8; ++c) { v[q][j][c] -= mean; s2 += v[q][j][c] * v[q][j][c]; }
                    sq[q] = s2; }
#pragma unroll
                for (int o = 1; o < 64; o <<= 1) {
#pragma unroll
                    for (int q = 0; q < 4; ++q) sq[q] += __shfl_xor(sq[q], o); }
#pragma unroll
                for (int q = 0; q < 4; ++q) {
                    const float rstd = 1.0f / sqrtf(sq[q] * (1.0f / D) + LN_EPS);
#pragma unroll
                    for (int j = 0; j < 2; ++j) {
                        float xv[8];
#pragma unroll
                        for (int c = 0; c < 8; ++c) xv[c] = v[q][j][c] * rstd * gg[j][c >> 2][c & 3] + bb[j][c >> 2][c & 3];
                        u32x4 hv; hv.x = cvtpk(xv[0], xv[1]); hv.y = cvtpk(xv[2], xv[3]); hv.z = cvtpk(xv[4], xv[5]); hv.w = cvtpk(xv[6], xv[7]);
                        u32x2 fv; fv.x = pk4_fp8(xv[0], xv[1], xv[2], xv[3]); fv.y = pk4_fp8(xv[4], xv[5], xv[6], xv[7]);
                        *(u32x4*)(x1b + (row0 + q) * D + 512 * j + 8 * lane) = hv;
                        *(u32x2*)(x1_8 + (row0 + q) * D + 512 * j + 8 * lane) = fv;
                    }
                }
            }
        }
        __syncthreads();
        {
            const int fr = lane & 15, fq = lane >> 4;
            f32x4 lacc[2][2];
#pragma unroll
            for (int m = 0; m < 2; ++m)
#pragma unroll
                for (int n = 0; n < 2; ++n) lacc[m][n] = (f32x4){0.f, 0.f, 0.f, 0.f};
            const size_t r0 = (size_t)pm * 256 + wave * 32;
            const bf16_t* ah = x1b + (r0 + fr) * D + 8 * fq;
            const LAS unsigned char* bh = lds + fr * 2064 + 16 * fq; const LAS unsigned char* bl = bh + 66048;
#pragma unroll 4
            for (int k0 = 0; k0 < 1024; k0 += 32) {
                bf16x8 a_hi[2], b_hi[2], b_lo[2];
#pragma unroll
                for (int m = 0; m < 2; ++m) a_hi[m] = *(const bf16x8*)(ah + (size_t)m * 16 * D + k0);
#pragma unroll
                for (int n = 0; n < 2; ++n) { b_hi[n] = *(const LAS bf16x8*)(bh + n * 16 * 2064 + k0 * 2); b_lo[n] = *(const LAS bf16x8*)(bl + n * 16 * 2064 + k0 * 2); }
#pragma unroll
                for (int m = 0; m < 2; ++m)
#pragma unroll
                    for (int n = 0; n < 2; ++n) {
                        lacc[m][n] = __builtin_amdgcn_mfma_f32_16x16x32_bf16(a_hi[m], b_hi[n], lacc[m][n], 0, 0, 0);
                        lacc[m][n] = __builtin_amdgcn_mfma_f32_16x16x32_bf16(a_hi[m], b_lo[n], lacc[m][n], 0, 0, 0);
                    }
            }
            __syncthreads();
            LAS float* lg = (LAS float*)lds;
#pragma unroll
            for (int m = 0; m < 2; ++m)
#pragma unroll
                for (int n = 0; n < 2; ++n)
#pragma unroll
                    for (int rg = 0; rg < 4; ++rg) lg[(wave * 32 + 16 * m + 4 * fq + rg) * 33 + 16 * n + fr] = lacc[m][n][rg];
        }
        __syncthreads();
        {
            LAS float* lg = (LAS float*)lds;
            LAS int* wcnt = (LAS int*)(lds + 36864);
            float t0 = -INFINITY, t1 = -INFINITY, t2 = -INFINITY, t3 = -INFINITY; int i0 = 0, i1 = 0, i2 = 0, i3 = 0;
            int rk0 = 0, rk1 = 0, rk2 = 0, rk3 = 0;
            if (tid < 256) {
                for (int e = 0; e < NE; ++e) {
                    const float xv = lg[tid * 33 + e] + p.b_router[e];
                    if (xv > t3) {
                        if (xv > t2) { t3 = t2; i3 = i2;
                            if (xv > t1) { t2 = t1; i2 = i1;
                                if (xv > t0) { t1 = t0; i1 = i0; t0 = xv; i0 = e; } else { t1 = xv; i1 = e; }
                            } else { t2 = xv; i2 = e; }
                        } else { t3 = xv; i3 = e; }
                    }
                }
                const unsigned selm = (1u << i0) | (1u << i1) | (1u << i2) | (1u << i3);
                for (int e = 0; e < NE; ++e) {
                    const bool has = ((selm >> e) & 1u) != 0u;
                    const unsigned long long bal = __ballot(has);
                    const int pre = __popcll(bal & ((1ull << lane) - 1ull));
                    if (e == i0) rk0 = pre; if (e == i1) rk1 = pre; if (e == i2) rk2 = pre; if (e == i3) rk3 = pre;
                    if (lane == 0) wcnt[wave * 32 + e] = __popcll(bal);
                }
            }
            __syncthreads();
            if (tid < 256) {
                const float e1 = __expf(t1 - t0), e2 = __expf(t2 - t0), e3 = __expf(t3 - t0);
                const float inv = 1.0f / (1.0f + e1 + e2 + e3);
                int b0 = 0, b1 = 0, b2 = 0, b3 = 0;
                for (int w = 0; w < wave; ++w) { b0 += wcnt[w * 32 + i0]; b1 += wcnt[w * 32 + i1]; b2 += wcnt[w * 32 + i2]; b3 += wcnt[w * 32 + i3]; }
                const size_t a = ((size_t)pm * 256 + tid) * 4;
                *(int4*)(asg_e + a) = make_int4(i0, i1, i2, i3);
                *(float4*)(asg_g + a) = make_float4(inv, e1 * inv, e2 * inv, e3 * inv);
                *(int4*)(asg_d + a) = make_int4(b0 + rk0, b1 + rk1, b2 + rk2, b3 + rk3);
            }
            if (tid < 32) cnt_blk[pm * 32 + tid] = wcnt[tid] + wcnt[32 + tid] + wcnt[64 + tid] + wcnt[96 + tid];
            __syncthreads();
        }
    }
    xcd_barrier(xbar);

    for (int pm = bx; pm < T / 256; pm += G) {
        PHASE_IDS();
        LAS int* part_all = (LAS int*)lds; LAS int* part_pre = part_all + 512; LAS int* tot = part_pre + 512; LAS int* pre = tot + 32; LAS int* poff = pre + 32;
        { const int e = tid & 31, seg = tid >> 5; int sa = 0, sp = 0;
            for (int bb = seg * 16; bb < seg * 16 + 16; ++bb) { const int c = cnt_blk[bb * 32 + e]; sa += c; sp += (bb < pm) ? c : 0; }
            part_all[tid] = sa; part_pre[tid] = sp; }
        __syncthreads();
        if (tid < 32) { int sa = 0, sp = 0; for (int s = 0; s < 16; ++s) { sa += part_all[s * 32 + tid]; sp += part_pre[s * 32 + tid]; } tot[tid] = sa; pre[tid] = sp; }
        __syncthreads();
        if (tid == 0) { int off = 0; for (int e = 0; e < NE; ++e) { poff[e] = off; off += ((tot[e] + 255) >> 8) << 8; } poff[32] = off; }
        __syncthreads();
        if (tid < 256) {
            const int token = pm * 256 + tid; const size_t a = (size_t)token * 4;
            const int4 ee = *(const int4*)(asg_e + a); const int4 rk = *(const int4*)(asg_d + a);
            const int d0 = poff[ee.x] + pre[ee.x] + rk.x, d1 = poff[ee.y] + pre[ee.y] + rk.y, d2 = poff[ee.z] + pre[ee.z] + rk.z, d3 = poff[ee.w] + pre[ee.w] + rk.w;
            *(int4*)(asg_d + a) = make_int4(d0, d1, d2, d3);
            tok[d0] = token; tok[d1] = token; tok[d2] = token; tok[d3] = token;
        }
        if (pm < NE) {
            const int e = pm, n = tot[e], np = ((n + 255) >> 8) << 8, o = poff[e];
            for (int i = n + tid; i < np; i += NTHREADS) tok[o + i] = 0;
            for (int i = tid; i < (np >> 8); i += NTHREADS) tile_e[(o >> 8) + i] = e;
        }
        if (pm == 0 && tid == 0) ctl[CW_NTILES] = (unsigned)(poff[32] >> 8);
        __syncthreads();
    }
    xcd_barrier(xbar);

    const int ntiles = (int)ctl[CW_NTILES];
    REP(5) {
        pg8::SchedMoe<8, true> S{(const char*)x1_8, (const char*)w1_8, tile_e, tok, ntiles, G, bx};
        pg8::EpiSwiglu E{act8, p.b1};
        pg8::gemm_phase<pg8::EpiSwiglu, pg8::SchedMoe<8, true>, true, true, 512, true>(lds, S, E);
    }
    xcd_barrier(xbar);

    REP(6) {
        pg8::SchedMoe<4, false> S{(const char*)act8, (const char*)w2_8, tile_e, tok, ntiles, G, bx};
        pg8::EpiDown E{yb, p.b2};
        pg8::gemm_phase<pg8::EpiDown, pg8::SchedMoe<4, false>, false, true, 512, true>(lds, S, E);
    }
    xcd_barrier(xbar);

    REP(7) {
        PHASE_IDS();
        const int gw = bx * 8 + wave, NGW = G * 8;
        f32x4 gg[2][2], bb[2][2];
#pragma unroll
        for (int j = 0; j < 2; ++j)
#pragma unroll
            for (int h = 0; h < 2; ++h) { gg[j][h] = *(const f32x4*)(p.ln2_g + 512 * j + 8 * lane + 4 * h); bb[j][h] = *(const f32x4*)(p.ln2_b + 512 * j + 8 * lane + 4 * h); }
        for (int row = gw; row < T; row += NGW) {
            const size_t a = (size_t)row * 4;
            const int4 dd = *(const int4*)(asg_d + a); const float4 gt4 = *(const float4*)(asg_g + a);
            u32x4 xr[2], y0[2], y1[2], y2[2], y3[2];
#pragma unroll
            for (int j = 0; j < 2; ++j) {
                xr[j] = *(const u32x4*)(x1b + (size_t)row * D + 512 * j + 8 * lane);
                y0[j] = *(const u32x4*)(yb + (size_t)dd.x * D + 512 * j + 8 * lane);
                y1[j] = *(const u32x4*)(yb + (size_t)dd.y * D + 512 * j + 8 * lane);
                y2[j] = *(const u32x4*)(yb + (size_t)dd.z * D + 512 * j + 8 * lane);
                y3[j] = *(const u32x4*)(yb + (size_t)dd.w * D + 512 * j + 8 * lane);
            }
            float z[2][8]; float s = 0.f;
#pragma unroll
            for (int j = 0; j < 2; ++j)
#pragma unroll
                for (int q = 0; q < 4; ++q) {
                    const unsigned xw = xr[j][q], a0 = y0[j][q], a1 = y1[j][q], a2 = y2[j][q], a3 = y3[j][q];
                    const float lo = DN_ALPHA * bf2f(xw & 0xffffu) + gt4.x * bf2f(a0 & 0xffffu) + gt4.y * bf2f(a1 & 0xffffu) + gt4.z * bf2f(a2 & 0xffffu) + gt4.w * bf2f(a3 & 0xffffu);
                    const float hi = DN_ALPHA * bf2f(xw >> 16) + gt4.x * bf2f(a0 >> 16) + gt4.y * bf2f(a1 >> 16) + gt4.z * bf2f(a2 >> 16) + gt4.w * bf2f(a3 >> 16);
                    z[j][2 * q] = lo; z[j][2 * q + 1] = hi; s += lo + hi;
                }
            const float mean = wave_sum(s) * (1.0f / D); float s2 = 0.f;
#pragma unroll
            for (int j = 0; j < 2; ++j)
#pragma unroll
                for (int q = 0; q < 8; ++q) { z[j][q] -= mean; s2 += z[j][q] * z[j][q]; }
            const float rstd = 1.0f / sqrtf(wave_sum(s2) * (1.0f / D) + LN_EPS);
#pragma unroll
            for (int j = 0; j < 2; ++j)
#pragma unroll
                for (int h = 0; h < 2; ++h) {
                    f32x4 o;
#pragma unroll
                    for (int q = 0; q < 4; ++q) o[q] = z[j][4 * h + q] * rstd * gg[j][h][q] + bb[j][h][q];
                    *(f32x4*)(p.out + (size_t)row * D + 512 * j + 8 * lane + 4 * h) = o;
                }
        }
    }
}

extern "C" void kernel_launch(void* const* d_in, const int* in_sizes, int n_in, void* d_out, int out_size, void* d_ws, size_t ws_size, hipStream_t stream) {
    static int grid_blocks = 0;
    if (grid_blocks == 0) {
        if (n_in != 16 || in_sizes[0] != T * D || out_size != T * D || ws_size < WS_END) {
            fprintf(stderr, "kernel_launch: unexpected shapes: n_in %d in0 %d out %d ws %zu (need %zu)\n", n_in, n_in > 0 ? in_sizes[0] : -1, out_size, ws_size, (size_t)WS_END); grid_blocks = -1; return; }
        int dev = 0, cus = 0, per_cu = 0;
        (void)hipGetDevice(&dev);
        (void)hipDeviceGetAttribute(&cus, hipDeviceAttributeMultiprocessorCount, dev);
        (void)hipFuncSetAttribute((const void*)fwd_megakernel, hipFuncAttributeMaxDynamicSharedMemorySize, LDS_BYTES);
        (void)hipOccupancyMaxActiveBlocksPerMultiprocessor(&per_cu, (const void*)fwd_megakernel, NTHREADS, LDS_BYTES);
        if (per_cu < 1) { fprintf(stderr, "kernel_launch: occupancy query reports %d blocks per CU\n", per_cu); per_cu = 1; }
        grid_blocks = cus;
        fprintf(stderr, "kernel_launch: cus=%d per_cu=%d grid=%d ws=%zu\n", cus, per_cu, grid_blocks, ws_size);
    }
    if (grid_blocks < 0) return;
    (void)hipMemsetAsync((char*)d_ws + WS_CTL, 0, CTL_ZERO_BYTES, stream);
    Params p{};
    p.x = (const float*)d_in[0]; p.w_in = (const float*)d_in[1]; p.b_in = (const float*)d_in[2]; p.sinks = (const float*)d_in[3]; p.w_out = (const float*)d_in[4]; p.b_out = (const float*)d_in[5];
    p.ln1_g = (const float*)d_in[6]; p.ln1_b = (const float*)d_in[7]; p.w_router = (const float*)d_in[8]; p.b_router = (const float*)d_in[9];
    p.w1 = (const float*)d_in[10]; p.b1 = (const float*)d_in[11]; p.w2 = (const float*)d_in[12]; p.b2 = (const float*)d_in[13]; p.ln2_g = (const float*)d_in[14]; p.ln2_b = (const float*)d_in[15];
    p.out = (float*)d_out; p.ws = (unsigned char*)d_ws;
    void* args[] = {&p};
    hipError_t e = hipLaunchCooperativeKernel((void*)fwd_megakernel, dim3(grid_blocks), dim3(NTHREADS), args, LDS_BYTES, stream);
    if (e != hipSuccess) fprintf(stderr, "cooperative launch failed: %s (grid %d)\n", hipGetErrorString(e), grid_blocks);
}
```

```cpp
#include <hip/hip_runtime.h>
#include <hip/hip_cooperative_groups.h>
#include <cstdio>
#include <cstdint>
namespace cg = cooperative_groups;

#define LAS __attribute__((address_space(3)))
typedef unsigned short bf16_t;
typedef short bf16x8 __attribute__((ext_vector_type(8)));
typedef short s16x4 __attribute__((ext_vector_type(4)));
typedef float f32x2 __attribute__((ext_vector_type(2)));
typedef float f32x4 __attribute__((ext_vector_type(4)));
typedef float f32x16 __attribute__((ext_vector_type(16)));
typedef unsigned u32x2 __attribute__((ext_vector_type(2)));
typedef unsigned u32x4 __attribute__((ext_vector_type(4)));
typedef __bf16 bf16x2_t __attribute__((ext_vector_type(2)));

constexpr int D = 1024, BATCH = 32, SEQ = 2048, T = BATCH * SEQ;
constexpr int INW = 2304, NE = 32;
constexpr float LN_EPS = 1e-5f;
constexpr float DN_ALPHA = 1.189207115002721f;
constexpr float LOG2E = 1.4426950408889634f;
constexpr float C2 = 0.18033688011112042f;
constexpr int NTHREADS = 512;
constexpr int LDS_BYTES = 147456;
constexpr int MAX_TILES = 1056;
#ifndef DUP_MASK
#define DUP_MASK 0
#endif
#define REP(k) for (int _rep = 0; _rep < (((DUP_MASK >> (k)) & 1) ? 2 : 1); ++_rep)

constexpr size_t MiB = 1u << 20;
constexpr size_t WS_CTL = 0, CTL_ZERO_BYTES = 2 * MiB;
constexpr size_t WS_KSUM = 1 * MiB;
constexpr size_t WS_ROPE = 2 * MiB;
constexpr size_t WS_WIN_T = 4 * MiB;
constexpr size_t WS_WOUT_T = 9 * MiB;
constexpr size_t WS_SMALL = 11 * MiB;
constexpr size_t WS_CNT = WS_SMALL, WS_TILE_E = WS_SMALL + 65536, WS_WR_HI = WS_SMALL + 131072, WS_WR_LO = WS_WR_HI + 65536;
constexpr size_t WS_TOK = 12 * MiB;
constexpr size_t WS_ASG_E = 14 * MiB, WS_ASG_G = 15 * MiB, WS_ASG_D = 16 * MiB;
constexpr size_t WS_W2_8 = 24 * MiB;
constexpr size_t WS_X1B = 56 * MiB;
constexpr size_t WS_ACT8 = 184 * MiB;
constexpr size_t WS_XB = 184 * MiB;
constexpr size_t WS_X1LO = 312 * MiB;
constexpr size_t WS_YB = 488 * MiB;
constexpr size_t WS_W1_8 = 488 * MiB;
constexpr size_t WS_X1_8 = 552 * MiB;
constexpr size_t WS_QKV = 616 * MiB;
constexpr size_t WS_END = 1016 * MiB;
constexpr float W_SCALE = 64.0f, ACT_SCALE = 4.0f;
constexpr int CW_NTILES = 16, CW_BAR = 4096;
constexpr int LDS_BARST = LDS_BYTES - 256;

struct Params {
    const float *x, *w_in, *b_in, *sinks, *w_out, *b_out, *ln1_g, *ln1_b, *w_router, *b_router, *w1, *b1, *w2, *b2, *ln2_g, *ln2_b;
    float* out; unsigned char* ws;
};

__device__ __forceinline__ unsigned f2bf(float f) { unsigned u = __builtin_bit_cast(unsigned, f); return (u + 0x7fffu + ((u >> 16) & 1u)) >> 16; }
__device__ __forceinline__ float bf2f(unsigned h) { return __builtin_bit_cast(float, h << 16); }
__device__ __forceinline__ unsigned cvtpk(float lo, float hi) { f32x2 v = {lo, hi}; bf16x2_t b = __builtin_convertvector(v, bf16x2_t); return __builtin_bit_cast(unsigned, b); }
__device__ __forceinline__ unsigned pk4_fp8(float a, float b, float c, float d) { int w = 0; w = __builtin_amdgcn_cvt_pk_fp8_f32(a, b, w, false); w = __builtin_amdgcn_cvt_pk_fp8_f32(c, d, w, true); return (unsigned)w; }
__device__ __forceinline__ float wave_sum(float v) {
#pragma unroll
    for (int o = 1; o < 64; o <<= 1) v += __shfl_xor(v, o);
    return v;
}
#define LDS_WAIT() asm volatile("s_waitcnt lgkmcnt(0)" ::: "memory")

namespace pg8 {
constexpr int BM = 256, BK = 64, HALF = 128, HTB = HALF * BK * 2, STAGE_BYTES = 8 * HTB, NXCD = 8, WGM = 8;
constexpr int KD = 1024;
__host__ __device__ __forceinline__ int lds_byte(int r, int c) { const int st = (r >> 4) * 2 + (c >> 5), rr = r & 15, cc = c & 31, ob = rr * 64 + cc * 2; return st * 1024 + (ob ^ (((ob >> 9) & 1) << 5)); }
__host__ __device__ __forceinline__ void stage_rc(int b, int& R, int& C) { const int st = b / 1024, sb = b % 1024, swz = sb ^ (((sb >> 9) & 1) << 5); R = (st >> 1) * 16 + swz / 64; C = (st & 1) * 32 + (swz % 64) / 2; }
__host__ __device__ __forceinline__ int perm32(int rho) { const int n = rho >> 4, i = rho & 15; return 8 * (i >> 2) + 4 * n + (i & 3); }

struct Unit { int pm, pn, e; unsigned ao, bo; const int* rows; };

typedef int v8i32_t __attribute__((ext_vector_type(8)));
typedef int v4i32_t __attribute__((ext_vector_type(4)));
__device__ __forceinline__ v8i32_t cat8(bf16x8 a, bf16x8 b) { const v4i32_t x = __builtin_bit_cast(v4i32_t, a), y = __builtin_bit_cast(v4i32_t, b); return __builtin_shufflevector(x, y, 0, 1, 2, 3, 4, 5, 6, 7); }
template <class Epi, class Sched, bool GATHER, bool ALIGN_EPI, int KP = 1024, bool FP8 = false>
__device__ __forceinline__ void gemm_phase(LAS unsigned char* lds, const Sched& S, const Epi& E) {
    int tid = threadIdx.x; asm volatile("" : "+v"(tid));
    const int wid = __builtin_amdgcn_readfirstlane(tid >> 6), lane = tid & 63, wr = wid >> 2, wc = wid & 3, fr = lane & 15, fq = lane >> 4;
    constexpr int K = KP, nt = K / BK;
    unsigned voffB[2], Vc[2][2], Vn[2][2]; int stR0, stC0;
    { int R, C; stage_rc(tid * 16, R, C); stR0 = R; stC0 = C; }
#pragma unroll
    for (int i = 0; i < 2; ++i) { voffB[i] = (unsigned)((stR0 + 64 * i) * K + stC0) * 2u; Vc[0][i] = voffB[i]; Vc[1][i] = voffB[i]; Vn[0][i] = voffB[i]; Vn[1][i] = voffB[i]; }
#define PG8_GATHER_LOAD(VV, rowsp) do { int _t = threadIdx.x; asm volatile("" : "+v"(_t)); int _R, _C; stage_rc(_t * 16, _R, _C);     \
        const int* _rp = (const int*)((const char*)(rowsp) + (unsigned)(_R * 4)); _Pragma("unroll") for (int _h = 0; _h < 2; ++_h) _Pragma("unroll") for (int _i = 0; _i < 2; ++_i) \
        VV[_h][_i] = ((unsigned)_rp[128 * _h + 64 * _i] * (unsigned)K + (unsigned)_C) * 2u; } while (0)
    constexpr unsigned kstep = (unsigned)(BK * 2);
    constexpr unsigned hstep = (unsigned)HALF * K * 2;
    const char* const Abase = S.A; const char* const Bbase = S.B;
    const unsigned ldsw = (unsigned)wid * 1024u;
    const int aoff = lds_byte(wr * 64 + fr, fq * 8), boff = lds_byte(wc * 32 + fr, fq * 8);
#define PG8_SA(b, h) (((b) * 2 + (h)) * HTB)
#define PG8_SB(b, h) ((4 + (b) * 2 + (h)) * HTB)
#define PG8_STAGE(bufoff, gbase, soff, voff) do { _Pragma("unroll") for (int _i = 0; _i < 2; ++_i) \
        __builtin_amdgcn_global_load_lds((const unsigned*)((gbase) + (unsigned)((voff)[_i] + (soff))), (LAS unsigned*)(lds + (bufoff) + ldsw + _i * 8192), 16, 0, 0); } while (0)
#define PG8_STAGE_B(bufoff, soff) PG8_STAGE(bufoff, Bbase, soff, voffB)
#define PG8_STAGE_A(bufoff, soff, h, VV) do { if constexpr (GATHER) { PG8_STAGE(bufoff, Abase, soff, VV[h]); } else { PG8_STAGE(bufoff, Abase, (soff) + (h) * hstep, voffB); } } while (0)
#define PG8_LDA(dst, b, h) do { _Pragma("unroll") for (int m = 0; m < 4; ++m) dst[m] = cat8(*(const LAS bf16x8*)(lds + PG8_SA(b, h) + aoff + m * 2048), *(const LAS bf16x8*)(lds + PG8_SA(b, h) + aoff + m * 2048 + 1024)); } while (0)
#define PG8_LDB(dst, b, h) do { _Pragma("unroll") for (int n = 0; n < 2; ++n) dst[n] = cat8(*(const LAS bf16x8*)(lds + PG8_SB(b, h) + boff + n * 2048), *(const LAS bf16x8*)(lds + PG8_SB(b, h) + boff + n * 2048 + 1024)); } while (0)
#define PG8_LO(v) __builtin_bit_cast(bf16x8, __builtin_shufflevector(v, v, 0, 1, 2, 3))
#define PG8_HI(v) __builtin_bit_cast(bf16x8, __builtin_shufflevector(v, v, 4, 5, 6, 7))
#define PG8_MMA(ai, bj, At, Bt) do { __builtin_amdgcn_s_setprio(1); _Pragma("unroll") for (int m = 0; m < 4; ++m) _Pragma("unroll") for (int n = 0; n < 2; ++n) { \
        if constexpr (FP8) { acc[ai][bj][m][n] = __builtin_amdgcn_mfma_scale_f32_16x16x128_f8f6f4(Bt[n], At[m], acc[ai][bj][m][n], 0, 0, 0, 0x7f7f7f7f, 0, 0x7f7f7f7f); } \
        else { acc[ai][bj][m][n] = __builtin_amdgcn_mfma_f32_16x16x32_bf16(PG8_LO(Bt[n]), PG8_LO(At[m]), acc[ai][bj][m][n], 0, 0, 0); \
               acc[ai][bj][m][n] = __builtin_amdgcn_mfma_f32_16x16x32_bf16(PG8_HI(Bt[n]), PG8_HI(At[m]), acc[ai][bj][m][n], 0, 0, 0); } } \
        __builtin_amdgcn_s_setprio(0); } while (0)
#define PG8_WAIT_V(n) asm volatile("s_waitcnt vmcnt(" #n ")" ::: "memory")
#define PG8_WAIT_L(n) asm volatile("s_waitcnt lgkmcnt(" #n ")" ::: "memory")
#define PG8_BAR __builtin_amdgcn_s_barrier()
#define PG8_SCHED __builtin_amdgcn_sched_barrier(0)
    Unit cur, nxt; int ui = 0;
    if (!S.next(0, cur)) return;
    if constexpr (GATHER) { PG8_GATHER_LOAD(Vc, cur.rows); }
    f32x4 acc[2][2][4][2];
#pragma unroll
    for (int a = 0; a < 2; ++a)
#pragma unroll
        for (int b = 0; b < 2; ++b)
#pragma unroll
            for (int m = 0; m < 4; ++m)
#pragma unroll
                for (int n = 0; n < 2; ++n) acc[a][b][m][n] = (f32x4){0.f, 0.f, 0.f, 0.f};
    v8i32_t At[4], B0[2], B1[2];
    unsigned cA = cur.ao, cB = cur.bo;
    PG8_STAGE_B(PG8_SB(0, 0), cB); PG8_STAGE_B(PG8_SB(0, 1), cB + hstep); PG8_STAGE_A(PG8_SA(0, 0), cA, 0, Vc); PG8_STAGE_A(PG8_SA(0, 1), cA, 1, Vc);
    if (wr == 1) PG8_BAR;
    PG8_WAIT_V(2); PG8_BAR;
    PG8_STAGE_B(PG8_SB(1, 0), cB + kstep); PG8_STAGE_A(PG8_SA(1, 0), cA + kstep, 0, Vc); PG8_STAGE_B(PG8_SB(1, 1), cB + hstep + kstep);
    PG8_WAIT_V(6); PG8_BAR;
    for (;;) {
        const bool has_next = S.next(ui + 1, nxt);
        const unsigned nA = has_next ? nxt.ao : cA; const unsigned nB = has_next ? nxt.bo : cB;
        if constexpr (GATHER) {
            if (has_next) { PG8_GATHER_LOAD(Vn, nxt.rows); }
            else {
#pragma unroll
                for (int i = 0; i < 2; ++i) { Vn[0][i] = Vc[0][i]; Vn[1][i] = Vc[1][i]; }
            }
        }
#pragma unroll 1
        for (int t = 0; t < nt; t += 2) {
            const bool last = (t == nt - 2);
            const unsigned a1 = cA + (unsigned)(t + 1) * kstep;
            const unsigned a2 = last ? nA : cA + (unsigned)(t + 2) * kstep; const unsigned b2 = last ? nB : cB + (unsigned)(t + 2) * kstep;
            const unsigned a3 = a2 + kstep; const unsigned b3 = b2 + kstep;
            PG8_LDB(B0, 0, 0); PG8_LDB(B1, 0, 1); PG8_SCHED; PG8_LDA(At, 0, 0); PG8_STAGE_A(PG8_SA(1, 1), a1, 1, Vc);
            if constexpr (GATHER) { if (last) {
#pragma unroll
                for (int i = 0; i < 2; ++i) { Vc[0][i] = Vn[0][i]; Vc[1][i] = Vn[1][i]; } } }
            PG8_WAIT_V(8); PG8_WAIT_L(0); PG8_BAR; PG8_MMA(0, 0, At, B0); PG8_MMA(0, 1, At, B1); PG8_BAR; PG8_SCHED;
            PG8_LDA(At, 0, 1); PG8_STAGE_B(PG8_SB(0, 0), b2); PG8_STAGE_B(PG8_SB(0, 1), b2 + hstep); PG8_STAGE_A(PG8_SA(0, 0), a2, 0, Vc);
            PG8_WAIT_V(8); PG8_WAIT_L(0); PG8_BAR; PG8_MMA(1, 0, At, B0); PG8_MMA(1, 1, At, B1); PG8_BAR; PG8_SCHED;
            PG8_LDB(B0, 1, 0); PG8_LDB(B1, 1, 1); PG8_SCHED; PG8_LDA(At, 1, 0); PG8_STAGE_A(PG8_SA(0, 1), a2, 1, Vc);
            PG8_WAIT_V(8); PG8_WAIT_L(0); PG8_BAR; PG8_MMA(0, 0, At, B0); PG8_MMA(0, 1, At, B1); PG8_BAR; PG8_SCHED;
            PG8_LDA(At, 1, 1); PG8_STAGE_B(PG8_SB(1, 0), b3); PG8_STAGE_B(PG8_SB(1, 1), b3 + hstep); PG8_STAGE_A(PG8_SA(1, 0), a3, 0, Vc);
            PG8_WAIT_V(8); PG8_WAIT_L(0); PG8_BAR; PG8_MMA(1, 0, At, B0); PG8_MMA(1, 1, At, B1); PG8_BAR; PG8_SCHED;
        }
        if constexpr (ALIGN_EPI) { if (wr == 0) PG8_BAR; }
        E(acc, cur, wr, wc, fr, fq);
        if (!has_next) break;
#pragma unroll
        for (int a = 0; a < 2; ++a)
#pragma unroll
            for (int b = 0; b < 2; ++b)
#pragma unroll
                for (int m = 0; m < 4; ++m)
#pragma unroll
                    for (int n = 0; n < 2; ++n) acc[a][b][m][n] = (f32x4){0.f, 0.f, 0.f, 0.f};
        cur = nxt; cA = nA; cB = nB; ++ui;
        if constexpr (ALIGN_EPI) { if (wr == 1) PG8_BAR; }
    }
    PG8_WAIT_V(0);
    if constexpr (!ALIGN_EPI) { if (wr == 0) PG8_BAR; }
    PG8_BAR;
#undef PG8_SA
#undef PG8_SB
#undef PG8_STAGE
#undef PG8_STAGE_A
#undef PG8_STAGE_B
#undef PG8_GATHER_LOAD
#undef PG8_LDA
#undef PG8_LDB
#undef PG8_LO
#undef PG8_HI
#undef PG8_MMA
#undef PG8_WAIT_V
#undef PG8_WAIT_L
#undef PG8_BAR
#undef PG8_SCHED
}

struct SchedInProj {
    const char* A; const char* B; int G, c;
    __device__ __forceinline__ bool next(int i, Unit& u) const {
        constexpr int nM = T / BM, nN = INW / BM, nwg = nM * nN;
        const long L = (long)i * G + c; if (L >= nwg) return false;
        int wgid = (int)L; { const int q = nwg / NXCD, r = nwg % NXCD, xcd = wgid % NXCD, off = wgid / NXCD; wgid = (xcd < r ? xcd * (q + 1) : r * (q + 1) + (xcd - r) * q) + off; }
        const int nig = WGM * nN, gid = wgid / nig, fm = gid * WGM, gsz = (nM - fm) < WGM ? (nM - fm) : WGM;
        u.pm = fm + ((wgid % nig) % gsz); u.pn = (wgid % nig) / gsz; u.e = 0; u.rows = nullptr;
        u.ao = (unsigned)u.pm * (unsigned)(2 * HALF * KD * 2); u.bo = (unsigned)u.pn * (unsigned)(2 * HALF * KD * 2); return true;
    }
};
struct SchedPanel {
    const char* A; const char* B; int pm;
    __device__ __forceinline__ bool next(int i, Unit& u) const {
        if (i >= 4) return false;
        u.pm = pm; u.pn = i; u.e = 0; u.rows = nullptr; u.ao = (unsigned)pm * (unsigned)(256 * KD * 2); u.bo = (unsigned)i * (unsigned)(256 * KD * 2); return true;
    }
};
template <int NPN, bool G1>
struct SchedMoe {
    const char* A; const char* B; const int* tile_e; const int* tok; int ntiles, G, c;
    __device__ __forceinline__ bool next(int i, Unit& u) const {
        const long L = (long)i * G + c; int t, pn;
        if ((G & 7) == 0) { const int x = (int)(L & 7); const long j = L >> 3; t = (int)(j / NPN) * 8 + x; pn = (int)(j % NPN); }
        else { t = (int)(L / NPN); pn = (int)(L % NPN); }
        if (t >= ntiles) return false;
        const int e = tile_e[t];
        u.pm = t; u.pn = pn; u.e = e;
        if (G1) { u.ao = 0u; u.rows = tok + (size_t)t * 256; u.bo = ((unsigned)e * 2048u + (unsigned)pn * 256u) * 1024u; }
        else { u.ao = (unsigned)t * (256u * 1024u); u.rows = nullptr; u.bo = ((unsigned)e * 1024u + (unsigned)pn * 256u) * 1024u; }
        return true;
    }
};

struct EpiInProj {
    bf16_t* qkv; const float* b_in; const float* rope; float* ksum;
    __device__ __forceinline__ void operator()(const f32x4 (&acc)[2][2][4][2], const Unit& u, int wr, int wc, int fr, int fq) const {
        const int pn = u.pn;
        const int colb = 256 * pn + 64 * wc + 8 * fq;
        const bool do_rope = !(pn >= 7 || (pn == 2 && wc >= 2));
        const bool is_q = (pn < 2) || (pn == 3) || (pn == 4);
        const bool is_kb = (pn == 5) || (pn == 6);
        const float sc = is_q ? C2 : 1.0f;
        f32x4 bv[2][2];
#pragma unroll
        for (int bj = 0; bj < 2; ++bj)
#pragma unroll
            for (int n = 0; n < 2; ++n) bv[bj][n] = *(const f32x4*)(b_in + colb + 32 * bj + 4 * n);
        f32x4 ks[2][2];
#pragma unroll
        for (int bj = 0; bj < 2; ++bj)
#pragma unroll
            for (int n = 0; n < 2; ++n) ks[bj][n] = (f32x4){0.f, 0.f, 0.f, 0.f};
#pragma unroll
        for (int ai = 0; ai < 2; ++ai)
#pragma unroll
            for (int m = 0; m < 4; ++m) {
                const int row = u.pm * 256 + ai * 128 + wr * 64 + m * 16 + fr;
                const int pos = row & (SEQ - 1);
                f32x4 o1[2], o2[2];
#pragma unroll
                for (int n = 0; n < 2; ++n) { o1[n] = acc[ai][0][m][n] + bv[0][n]; o2[n] = acc[ai][1][m][n] + bv[1][n]; }
                if (do_rope) {
                    const float* rp = rope + pos * 64 + 8 * fq;
#pragma unroll
                    for (int n = 0; n < 2; ++n) { const f32x4 c = *(const f32x4*)(rp + 4 * n), s = *(const f32x4*)(rp + 32 + 4 * n);
                        const f32x4 a = o1[n], b = o2[n]; o1[n] = a * c - b * s; o2[n] = b * c + a * s; }
                }
                if (is_kb) {
#pragma unroll
                    for (int n = 0; n < 2; ++n) { ks[0][n] += o1[n]; ks[1][n] += o2[n]; }
                }
                bf16_t* rowp = qkv + (size_t)row * INW + colb;
                u32x4 w1, w2;
                w1.x = cvtpk(o1[0][0] * sc, o1[0][1] * sc); w1.y = cvtpk(o1[0][2] * sc, o1[0][3] * sc); w1.z = cvtpk(o1[1][0] * sc, o1[1][1] * sc); w1.w = cvtpk(o1[1][2] * sc, o1[1][3] * sc);
                w2.x = cvtpk(o2[0][0] * sc, o2[0][1] * sc); w2.y = cvtpk(o2[0][2] * sc, o2[0][3] * sc); w2.z = cvtpk(o2[1][0] * sc, o2[1][1] * sc); w2.w = cvtpk(o2[1][2] * sc, o2[1][3] * sc);
                *(u32x4*)(rowp) = w1; *(u32x4*)(rowp + 32) = w2;
            }
        if (is_kb) {
            float* kd = ksum + (size_t)u.pm * 512 + 256 * (pn - 5) + 64 * wc + 8 * fq;
#pragma unroll
            for (int bj = 0; bj < 2; ++bj)
#pragma unroll
                for (int n = 0; n < 2; ++n)
#pragma unroll
                    for (int j = 0; j < 4; ++j) {
                        float v = ks[bj][n][j];
                        v += __shfl_xor(v, 1); v += __shfl_xor(v, 2); v += __shfl_xor(v, 4); v += __shfl_xor(v, 8);
                        if (fr == 0) atomicAdd(kd + 32 * bj + 4 * n + j, v);
                    }
        }
    }
};
struct EpiOutProj {
    bf16_t* y; const float* b_out; const float* x;
    __device__ __forceinline__ void operator()(const f32x4 (&acc)[2][2][4][2], const Unit& u, int wr, int wc, int fr, int fq) const {
        const int col0 = u.pn * 256 + wc * 32 + 8 * fq;
        f32x4 bv[2][2];
#pragma unroll
        for (int bj = 0; bj < 2; ++bj)
#pragma unroll
            for (int n = 0; n < 2; ++n) bv[bj][n] = *(const f32x4*)(b_out + col0 + 128 * bj + 4 * n);
#pragma unroll
        for (int ai = 0; ai < 2; ++ai)
#pragma unroll
            for (int m = 0; m < 4; ++m) {
                const size_t off = (size_t)(u.pm * 256 + ai * 128 + wr * 64 + m * 16 + fr) * D + col0;
#pragma unroll
                for (int bj = 0; bj < 2; ++bj) {
                    const f32x4 x0 = *(const f32x4*)(x + off + 128 * bj), x1 = *(const f32x4*)(x + off + 128 * bj + 4);
                    const f32x4 v0 = acc[ai][bj][m][0] + bv[bj][0] + x0 * DN_ALPHA, v1 = acc[ai][bj][m][1] + bv[bj][1] + x1 * DN_ALPHA;
                    u32x4 w; w.x = cvtpk(v0[0], v0[1]); w.y = cvtpk(v0[2], v0[3]); w.z = cvtpk(v1[0], v1[1]); w.w = cvtpk(v1[2], v1[3]);
                    *(u32x4*)(y + off + 128 * bj) = w; }
                if (m & 1) asm volatile("" ::: "memory");
            }
    }
};
struct EpiSwiglu {
    unsigned char* act8; const float* b1;
    __device__ __forceinline__ void operator()(const f32x4 (&acc)[2][2][4][2], const Unit& u, int wr, int wc, int fr, int fq) const {
        const int a0 = 128 * u.pn + 32 * wc + 8 * fq;
        const float* bp = b1 + (size_t)u.e * 2048 + 2 * a0;
        f32x4 bb[4];
#pragma unroll
        for (int q = 0; q < 4; ++q) bb[q] = *(const f32x4*)(bp + 4 * q);
        unsigned char* tile = act8 + (size_t)u.pm * (256 * 1024);
#pragma unroll
        for (int ai = 0; ai < 2; ++ai)
#pragma unroll
            for (int m = 0; m < 4; ++m) {
                const int row = ai * 128 + wr * 64 + m * 16 + fr;
                float r[8];
#pragma unroll
                for (int n = 0; n < 2; ++n)
#pragma unroll
                    for (int j = 0; j < 4; ++j) {
                        const int q = 4 * n + j;
                        float g = acc[ai][0][m][n][j] * (1.0f / W_SCALE) + bb[q >> 1][(2 * q) & 3];
                        float l = acc[ai][1][m][n][j] * (1.0f / W_SCALE) + bb[q >> 1][((2 * q) & 3) + 1];
                        g = fminf(g, 7.0f); l = fminf(fmaxf(l, -7.0f), 7.0f);
                        const float sg = __builtin_amdgcn_rcpf(1.0f + __builtin_amdgcn_exp2f(-1.702f * LOG2E * g));
                        r[q] = g * sg * (l + 1.0f) * ACT_SCALE;
                    }
                u32x2 w; w.x = pk4_fp8(r[0], r[1], r[2], r[3]); w.y = pk4_fp8(r[4], r[5], r[6], r[7]);
                *(u32x2*)(tile + (size_t)row * 1024 + (size_t)a0) = w;
            }
    }
};
struct EpiDown {
    bf16_t* yb; const float* b2;
    __device__ __forceinline__ void operator()(const f32x4 (&acc)[2][2][4][2], const Unit& u, int wr, int wc, int fr, int fq) const {
        const int col0 = u.pn * 256 + wc * 32 + 8 * fq;
        const float* bp = b2 + (size_t)u.e * 1024 + col0;
        f32x4 bv[2][2];
#pragma unroll
        for (int bj = 0; bj < 2; ++bj)
#pragma unroll
            for (int n = 0; n < 2; ++n) bv[bj][n] = *(const f32x4*)(bp + 128 * bj + 4 * n);
#pragma unroll
        for (int ai = 0; ai < 2; ++ai)
#pragma unroll
            for (int m = 0; m < 4; ++m) {
                bf16_t* rowp = yb + (size_t)(u.pm * 256 + ai * 128 + wr * 64 + m * 16 + fr) * 1024 + col0;
#pragma unroll
                for (int bj = 0; bj < 2; ++bj) { const f32x4 v0 = acc[ai][bj][m][0] * (1.0f / (W_SCALE * ACT_SCALE)) + bv[bj][0], v1 = acc[ai][bj][m][1] * (1.0f / (W_SCALE * ACT_SCALE)) + bv[bj][1];
                    u32x4 w; w.x = cvtpk(v0[0], v0[1]); w.y = cvtpk(v0[2], v0[3]); w.z = cvtpk(v1[0], v1[1]); w.w = cvtpk(v1[2], v1[3]);
                    *(u32x4*)(rowp + 128 * bj) = w; }
            }
    }
};
}

namespace att {
constexpr int PITCH = INW, SLOTB = 8192;
constexpr int NSLOT = 4;
constexpr int L_K = 0, L_V = NSLOT * SLOTB, L_WS = 2 * NSLOT * SLOTB, L_KS = L_WS + 2048, L_OST = L_KS + 2048, L_END = L_OST + 8 * 4096;
static_assert(NSLOT == 4 && L_END <= 131072, "attention LDS map");
constexpr float NEG = -1.0e30f, M0 = -1.0e20f, THR = 8.0f;
typedef LAS const char* lds_cptr;
__device__ __forceinline__ int crow(int r, int hi) { return (r & 3) + 8 * (r >> 2) + 4 * hi; }
__device__ __forceinline__ void glds16(const void* gsrc, unsigned lds_dst) { unsigned keep;
    asm volatile("s_mov_b32 %0, m0\n\ts_mov_b32 m0, %2\n\ts_nop 0\n\tglobal_load_lds_dwordx4 %1, off\n\ts_mov_b32 m0, %0" : "=&s"(keep) : "v"(gsrc), "s"(lds_dst) : "memory"); }
#define ATT_WAIT_BAR0() asm volatile("s_waitcnt vmcnt(0) lgkmcnt(0)\n\ts_barrier" ::: "memory")
#define ATT_WAIT_BARN(N) asm volatile("s_waitcnt vmcnt(" #N ") lgkmcnt(0)\n\ts_barrier" ::: "memory")
#define ATT_SBAR() __builtin_amdgcn_sched_barrier(0)

__device__ __forceinline__ void qkt(f32x16& p0, f32x16& p1, lds_cptr kb, const bf16x8* qr, const f32x16& negm) {
#pragma unroll
    for (int d0 = 0; d0 < 4; ++d0) {
        const bf16x8 b0 = *(const LAS bf16x8*)(kb + d0 * 2048);
        const bf16x8 b1 = *(const LAS bf16x8*)(kb + d0 * 2048 + 512);
        if (d0 == 0) { p0 = __builtin_amdgcn_mfma_f32_32x32x16_bf16(b0, qr[0], negm, 0, 0, 0); p1 = __builtin_amdgcn_mfma_f32_32x32x16_bf16(b1, qr[0], negm, 0, 0, 0); }
        else { p0 = __builtin_amdgcn_mfma_f32_32x32x16_bf16(b0, qr[d0], p0, 0, 0, 0); p1 = __builtin_amdgcn_mfma_f32_32x32x16_bf16(b1, qr[d0], p1, 0, 0, 0); }
    }
}
__device__ __forceinline__ float rowmax32(const f32x16& p0, const f32x16& p1) {
    float a = fmaxf(p0[0], p1[0]);
#pragma unroll
    for (int r = 1; r < 16; ++r) a = fmaxf(a, fmaxf(p0[r], p1[r]));
    auto rr = __builtin_amdgcn_permlane32_swap(__float_as_uint(a), __float_as_uint(a), false, false);
    return fmaxf(__uint_as_float(rr[0]), __uint_as_float(rr[1]));
}
__device__ __forceinline__ void pv(f32x16* o, int vb, bf16x8 pa0, bf16x8 pa1, bf16x8 pa2, bf16x8 pa3) {
#pragma unroll
    for (int d0 = 0; d0 < 2; ++d0) { s16x4 lo[4], hi[4];
#pragma unroll
        for (int ks = 0; ks < 4; ++ks) {
            asm volatile("ds_read_b64_tr_b16 %0,%1 offset:%c2" : "=&v"(lo[ks]) : "v"(vb), "i"(d0 * 4096 + ks * 1024) : "memory");
            asm volatile("ds_read_b64_tr_b16 %0,%1 offset:%c2" : "=&v"(hi[ks]) : "v"(vb), "i"(d0 * 4096 + ks * 1024 + 512) : "memory"); }
        asm volatile("s_waitcnt lgkmcnt(0)" ::: "memory"); ATT_SBAR();
#define ATT_PK(k) (bf16x8){lo[k][0], lo[k][1], lo[k][2], lo[k][3], hi[k][0], hi[k][1], hi[k][2], hi[k][3]}
        o[d0] = __builtin_amdgcn_mfma_f32_32x32x16_bf16(pa0, ATT_PK(0), o[d0], 0, 0, 0);
        o[d0] = __builtin_amdgcn_mfma_f32_32x32x16_bf16(pa1, ATT_PK(1), o[d0], 0, 0, 0);
        o[d0] = __builtin_amdgcn_mfma_f32_32x32x16_bf16(pa2, ATT_PK(2), o[d0], 0, 0, 0);
        o[d0] = __builtin_amdgcn_mfma_f32_32x32x16_bf16(pa3, ATT_PK(3), o[d0], 0, 0, 0);
#undef ATT_PK
    }
}

template <bool MOBA>
__device__ __forceinline__ void attn_item(char* shm, const bf16_t* __restrict__ qkv, bf16_t* __restrict__ aout, int b, int hh, int qb, const float* __restrict__ sinks, const float* __restrict__ ksum) {
    int tid = threadIdx.x; asm volatile("" : "+v"(tid));
    const int lane = tid & 63, r32 = lane & 31, hi = lane >> 5; const int wid = __builtin_amdgcn_readfirstlane(tid >> 6);
    const long rowbase = (long)b * SEQ;
    int qa, qcol, kcol, vcol, ocol, kt0, kt1;
    if (MOBA) { qa = 256 * qb + 32 * wid; qcol = 768 + 64 * hh; kcol = 1280 + 64 * hh; vcol = 1792 + 64 * hh; ocol = 512 + 64 * hh; kt0 = 0; kt1 = 4 * qb + 4; }
    else { const int g = wid >> 1; qa = 64 * qb + 32 * (wid & 1); qcol = (4 * hh + g) * 64; kcol = 512 + 64 * hh; vcol = 640 + 64 * hh; ocol = qcol; kt0 = qb - 2 < 0 ? 0 : qb - 2; kt1 = qb + 1; }
    const bf16_t* Qw = qkv + (rowbase + qa) * PITCH + qcol;
    const bf16_t* Kh = qkv + rowbase * PITCH + kcol; const bf16_t* Vh = qkv + rowbase * PITCH + vcol;
    const unsigned lds0 = (unsigned)(uintptr_t)shm;
    float* wsf = (float*)(shm + L_WS) + wid * 64;
    const bf16_t* ksrc = Kh + (long)lane * PITCH + wid * 8;
    const bf16_t* vsrc = Vh + (long)(16 * (wid & 3) + (lane >> 2)) * PITCH + (wid >> 2) * 32 + (lane & 3) * 8;
    const unsigned kdst = lds0 + L_K + wid * 1024, vdst = lds0 + L_V + wid * 1024;
#define ATT_DMA_K(t, slot) glds16(ksrc + (long)(t) * 64 * PITCH, (unsigned)__builtin_amdgcn_readfirstlane(kdst + (slot)))
#define ATT_DMA_V(t, slot) glds16(vsrc + (long)(t) * 64 * PITCH, (unsigned)__builtin_amdgcn_readfirstlane(vdst + (slot)))
    const int vb0 = (int)(lds0 + L_V) + ((lane >> 4) & 1) * 32 + (lane & 3) * 8 + (4 * hi + ((lane & 15) >> 2)) * 64;
    const lds_cptr shm3 = (lds_cptr)shm; const lds_cptr kp0 = shm3 + L_K + hi * 1024 + r32 * 16;
    const int NT = kt1 - kt0;
    ATT_DMA_K(kt0, 0); ATT_DMA_V(kt0, 0);
    if (NT > 1) { ATT_DMA_K(kt0 + 1, SLOTB); ATT_DMA_V(kt0 + 1, SLOTB); }
    if (NT > 2) { ATT_DMA_K(kt0 + 2, 2 * SLOTB); ATT_DMA_V(kt0 + 2, 2 * SLOTB); }
    if (MOBA) { float* ksl = (float*)(shm + L_KS); ksl[tid] = ksum[((size_t)b * 8 + (tid >> 6)) * 512 + 64 * hh + (tid & 63)]; }
    bf16x8 qr[4];
#pragma unroll
    for (int d0 = 0; d0 < 4; ++d0) qr[d0] = *reinterpret_cast<const bf16x8*>(&Qw[(long)r32 * PITCH + d0 * 16 + hi * 8]);
    float m_run, l_run;
    if (MOBA) { m_run = M0; l_run = 0.f; }
    else { m_run = sinks[4 * hh + (wid >> 1)] * LOG2E; l_run = (hi == 0) ? 1.0f : 0.0f; }
    f32x16 negm;
#pragma unroll
    for (int r = 0; r < 16; ++r) negm[r] = MOBA ? 0.f : -m_run;
    f32x16 o[2]; o[0] = f32x16{}; o[1] = f32x16{};
    ATT_WAIT_BAR0();
    unsigned sel = 0u;
    if (MOBA) {
        if (qb <= 3) sel = (1u << qb) - 1u;
        else {
            const float* ksl = (const float*)(shm + L_KS);
            float gv[7];
#pragma unroll
            for (int i = 0; i < 7; ++i) {
                float s = 0.f;
#pragma unroll
                for (int d0 = 0; d0 < 4; ++d0) {
                    const f32x4 k0 = *(const f32x4*)(ksl + i * 64 + 16 * d0 + 8 * hi), k1 = *(const f32x4*)(ksl + i * 64 + 16 * d0 + 8 * hi + 4);
#pragma unroll
                    for (int jj = 0; jj < 4; ++jj) { s += bf2f((unsigned short)qr[d0][jj]) * k0[jj]; s += bf2f((unsigned short)qr[d0][4 + jj]) * k1[jj]; }
                }
                auto rr = __builtin_amdgcn_permlane32_swap(__float_as_uint(s), __float_as_uint(s), false, false);
                s = __uint_as_float(rr[0]) + __uint_as_float(rr[1]);
                gv[i] = (i < qb) ? s : -INFINITY;
            }
#pragma unroll
            for (int rk = 0; rk < 3; ++rk) { float best = -INFINITY; int bi = 0;
#pragma unroll
                for (int i = 0; i < 7; ++i) { const bool c = (((sel >> i) & 1u) == 0u) && (gv[i] > best); best = c ? gv[i] : best; bi = c ? i : bi; }
                sel |= 1u << bi; }
        }
    }
    for (int it = 0; it < NT; ++it) {
        const int kt = kt0 + it; const int cur = (it & (NSLOT - 1)) * SLOTB;
        if (it + 3 < NT) { const int sl = ((it + 3) & (NSLOT - 1)) * SLOTB; ATT_DMA_K(kt + 3, sl); ATT_DMA_V(kt + 3, sl); }
        bool need; bool on = true;
        if (MOBA) { if (kt < 4 * qb) { on = ((sel >> (kt >> 2)) & 1u) != 0u; need = __any(on) != 0; } else need = (64 * kt <= qa + 31); }
        else need = (64 * kt + 63 >= qa - 127) && (64 * kt <= qa + 31);
        if (need) {
            f32x16 p0, p1; qkt(p0, p1, kp0 + cur, qr, negm);
            if (MOBA && kt < 4 * qb) {
                if (!__all(on)) {
#pragma unroll
                    for (int r = 0; r < 16; ++r) { p0[r] = on ? p0[r] : NEG; p1[r] = on ? p1[r] : NEG; }
                }
            } else {
                const bool edge = MOBA ? (64 * kt + 63 > qa) : !((64 * kt + 63 <= qa) && (qa + 31 - 64 * kt <= 127));
                if (edge) {
                    const int dq = qa + r32 - 64 * kt - 4 * hi;
#pragma unroll
                    for (int r = 0; r < 16; ++r) { const int d0_ = dq - ((r & 3) + 8 * (r >> 2)), d1_ = d0_ - 32;
                        const bool v0 = MOBA ? (d0_ >= 0) : ((unsigned)d0_ < 128u), v1 = MOBA ? (d1_ >= 0) : ((unsigned)d1_ < 128u);
                        p0[r] = v0 ? p0[r] : NEG; p1[r] = v1 ? p1[r] : NEG; }
                }
            }
            const float rm = rowmax32(p0, p1);
            const bool sent = (m_run <= M0), live = (rm > 0.5f * NEG);
            const bool upd = sent ? live : (rm > THR);
            if (__any(upd)) {
                const float dl = sent ? (live ? rm : 0.f) : fmaxf(rm, 0.f);
                const float f = sent ? 1.0f : __builtin_amdgcn_exp2f(-dl);
                m_run = sent ? (live ? rm : m_run) : (m_run + dl);
                const float nm = (m_run <= M0) ? 0.f : -m_run;
#pragma unroll
                for (int r = 0; r < 16; ++r) { p0[r] -= dl; p1[r] -= dl; negm[r] = nm; }
                l_run *= f;
                if (hi == 0) wsf[r32] = f;
                LDS_WAIT();
#pragma unroll
                for (int r = 0; r < 16; ++r) { const float fr_ = wsf[crow(r, hi)]; o[0][r] *= fr_; o[1][r] *= fr_; }
            }
            float sacc = 0.f;
#pragma unroll
            for (int r = 0; r < 16; ++r) { p0[r] = __builtin_amdgcn_exp2f(p0[r]); p1[r] = __builtin_amdgcn_exp2f(p1[r]); sacc += p0[r] + p1[r]; }
            l_run += sacc;
            u32x4 pw0, pw1, pw2, pw3;
            pw0 = (u32x4){cvtpk(p0[0], p0[1]), cvtpk(p0[2], p0[3]), cvtpk(p0[4], p0[5]), cvtpk(p0[6], p0[7])};
            pw1 = (u32x4){cvtpk(p0[8], p0[9]), cvtpk(p0[10], p0[11]), cvtpk(p0[12], p0[13]), cvtpk(p0[14], p0[15])};
            pw2 = (u32x4){cvtpk(p1[0], p1[1]), cvtpk(p1[2], p1[3]), cvtpk(p1[4], p1[5]), cvtpk(p1[6], p1[7])};
            pw3 = (u32x4){cvtpk(p1[8], p1[9]), cvtpk(p1[10], p1[11]), cvtpk(p1[12], p1[13]), cvtpk(p1[14], p1[15])};
            ATT_SBAR();
            pv(o, vb0 + cur, __builtin_bit_cast(bf16x8, pw0), __builtin_bit_cast(bf16x8, pw1), __builtin_bit_cast(bf16x8, pw2), __builtin_bit_cast(bf16x8, pw3));
        }
        if (it + 1 < NT) {
            if (it + 3 < NT) ATT_WAIT_BARN(4); else if (it + 2 < NT) ATT_WAIT_BARN(2); else ATT_WAIT_BAR0();
        }
    }
    { auto rr = __builtin_amdgcn_permlane32_swap(__float_as_uint(l_run), __float_as_uint(l_run), false, false); l_run = __uint_as_float(rr[0]) + __uint_as_float(rr[1]); }
    if (hi == 0) wsf[32 + r32] = l_run;
    LDS_WAIT();
    float rli[16];
#pragma unroll
    for (int r = 0; r < 16; ++r) rli[r] = __builtin_amdgcn_rcpf(wsf[32 + crow(r, hi)]);
    bf16_t* Ow = aout + (rowbase + qa) * D + ocol;
    { bf16_t* stg = (bf16_t*)(shm + L_OST) + wid * 2048;
#pragma unroll
        for (int r = 0; r < 16; ++r) { const int orow = crow(r, hi);
#pragma unroll
            for (int d0 = 0; d0 < 2; ++d0) stg[orow * 64 + d0 * 32 + r32] = (bf16_t)f2bf(o[d0][r] * rli[r]); }
        LDS_WAIT();
#pragma unroll
        for (int i = 0; i < 4; ++i) { const int row = i * 8 + (lane >> 3), ch = lane & 7; const u32x4 v = *(const u32x4*)(stg + row * 64 + ch * 8); *(u32x4*)(Ow + (long)row * D + ch * 8) = v; } }
    asm volatile("s_waitcnt lgkmcnt(0)\n\ts_barrier" ::: "memory");
#undef ATT_DMA_K
#undef ATT_DMA_V
}
}

__device__ __forceinline__ void sincos_d(double a, double& s, double& c) {
    const double q = __builtin_rint(a * 0.63661977236758134308);
    double r = __builtin_fma(-q, 1.57079632679489655800e+00, a);
    r = __builtin_fma(-q, 6.12323399573676603587e-17, r);
    const double r2 = r * r;
    double sp = -1.0 / 1307674368000.0;
    sp = sp * r2 + 1.0 / 6227020800.0; sp = sp * r2 - 1.0 / 39916800.0; sp = sp * r2 + 1.0 / 362880.0; sp = sp * r2 - 1.0 / 5040.0; sp = sp * r2 + 1.0 / 120.0; sp = sp * r2 - 1.0 / 6.0;
    const double sr = r + r * r2 * sp;
    double cp = 1.0 / 20922789888000.0;
    cp = cp * r2 - 1.0 / 87178291200.0; cp = cp * r2 + 1.0 / 479001600.0; cp = cp * r2 - 1.0 / 3628800.0; cp = cp * r2 + 1.0 / 40320.0; cp = cp * r2 - 1.0 / 720.0; cp = cp * r2 + 1.0 / 24.0; cp = cp * r2 - 0.5;
    const double cr = 1.0 + r2 * cp;
    const int n = ((int)q) & 3;
    s = (n == 0) ? sr : (n == 1) ? cr : (n == 2) ? -sr : -cr;
    c = (n == 0) ? cr : (n == 1) ? -sr : (n == 2) ? -cr : sr;
}
__device__ __forceinline__ int sigma_col(int p, int mode) {
    if (mode == 0) return (p & ~255) + 64 * ((p >> 5) & 3) + 32 * ((p >> 7) & 1) + pg8::perm32(p & 31);
    if (mode == 1) return (p & ~31) + pg8::perm32(p & 31);
    const int pn = p >> 8, q = p & 255; return 2 * (128 * pn + 32 * ((q >> 5) & 3) + pg8::perm32(q & 31)) + (q >> 7);
}
__device__ __forceinline__ void p0_transpose_item(const float* __restrict__ W, int N, bf16_t* __restrict__ WT, int mode, LAS float* scr, int item, int lane) {
    const int nblk = N / 32, kb = item / nblk, nb = item % nblk, k0 = 64 * kb, p0 = 32 * nb;
    const int sc = sigma_col(p0 + (lane & 31), mode);
#pragma unroll 8
    for (int i = 0; i < 32; ++i) { const int kk = 2 * i + (lane >> 5); scr[kk * 33 + (lane & 31)] = W[(size_t)(k0 + kk) * N + sc]; }
    LDS_WAIT(); asm volatile("" ::: "memory");
    const int c = lane & 7;
#pragma unroll
    for (int j = 0; j < 4; ++j) { const int n = (lane >> 3) + 8 * j; const LAS float* s = scr + (8 * c) * 33 + n;
        u32x4 o; o.x = cvtpk(s[0 * 33], s[1 * 33]); o.y = cvtpk(s[2 * 33], s[3 * 33]); o.z = cvtpk(s[4 * 33], s[5 * 33]); o.w = cvtpk(s[6 * 33], s[7 * 33]);
        *(u32x4*)(WT + (size_t)(p0 + n) * 1024 + k0 + 8 * c) = o; }
    LDS_WAIT(); asm volatile("" ::: "memory");
}

__device__ __forceinline__ void p0_transpose_item_fp8(const float* __restrict__ W, int N, unsigned char* __restrict__ WT, int mode, float scale, LAS float* scr, int item, int lane) {
    const int nblk = N / 32, kb = item / nblk, nb = item % nblk, k0 = 64 * kb, p0 = 32 * nb;
    const int sc = sigma_col(p0 + (lane & 31), mode);
#pragma unroll 8
    for (int i = 0; i < 32; ++i) { const int kk = 2 * i + (lane >> 5); scr[kk * 33 + (lane & 31)] = W[(size_t)(k0 + kk) * N + sc] * scale; }
    LDS_WAIT(); asm volatile("" ::: "memory");
    const int c = lane & 7;
#pragma unroll
    for (int j = 0; j < 4; ++j) { const int n = (lane >> 3) + 8 * j; const LAS float* s = scr + (8 * c) * 33 + n;
        u32x2 o; o.x = pk4_fp8(s[0 * 33], s[1 * 33], s[2 * 33], s[3 * 33]); o.y = pk4_fp8(s[4 * 33], s[5 * 33], s[6 * 33], s[7 * 33]);
        *(u32x2*)(WT + (size_t)(p0 + n) * 1024 + k0 + 8 * c) = o; }
    LDS_WAIT(); asm volatile("" ::: "memory");
}


#define XB_TMO      128
#define XB_XCNT(j)  (256  + 64 * (j))
#define XB_XSUB(j)  (1280 + 64 * (j))
#define XB_XGEN(j)  (2304 + 64 * (j))
#define XB_TOP      3328
#define XB_TOPGEN   3392
#define XCD_BAR_WORDS 3456
#define XB_SPIN_CAP (1u << 18)
__device__ __forceinline__ unsigned xb_ld(unsigned* p)              { return __hip_atomic_load(p, __ATOMIC_RELAXED, __HIP_MEMORY_SCOPE_AGENT); }
__device__ __forceinline__ unsigned xb_add(unsigned* p, unsigned v) { return __hip_atomic_fetch_add(p, v, __ATOMIC_RELAXED, __HIP_MEMORY_SCOPE_AGENT); }
__device__ __forceinline__ unsigned xb_xcc_id() { return (unsigned)__builtin_amdgcn_s_getreg((3 << 11) | 20) & 0xFu; }
#define XB_SPIN(cond, bar) do { unsigned _sp = 0; while (cond) { __builtin_amdgcn_s_sleep(1); \
    if ((++_sp & 255u) == 0u) { if (xb_ld(&(bar)[XB_TMO])) break; if (_sp > XB_SPIN_CAP) { atomicAdd(&(bar)[XB_TMO], 1u); break; } } } } while (0)
struct XcdBarrier { unsigned* bar; unsigned x; volatile LAS unsigned* st; };
__device__ __forceinline__ XcdBarrier xcd_barrier_post(unsigned* bar, volatile LAS unsigned* st) {
    XcdBarrier b; b.bar = bar; b.x = xb_xcc_id(); b.st = st;
    if (threadIdx.x == 0) (void)xb_add(&bar[XB_XCNT(b.x)], 1u);
    return b;
}
__device__ __forceinline__ void xcd_barrier_complete(unsigned* bar, unsigned x, unsigned& nloc, unsigned& nx) {
    const unsigned G = gridDim.x * gridDim.y * gridDim.z;
    unsigned sum, cnt, mine, sp = 0u;
    for (;;) {
        sum = 0u; cnt = 0u; mine = 0u;
#pragma unroll
        for (unsigned j = 0; j < 16; ++j) { const unsigned c = xb_ld(&bar[XB_XCNT(j)]); sum += c; cnt += (c > 0u) ? 1u : 0u; mine = (j == x) ? c : mine; }
        if (sum == G) break;
        __builtin_amdgcn_s_sleep(1);
        if ((++sp & 255u) == 0u) { if (xb_ld(&bar[XB_TMO])) break; if (sp > XB_SPIN_CAP) { atomicAdd(&bar[XB_TMO], 1u); break; } }
    }
    nloc = mine > 0u ? mine : 1u; nx = cnt > 0u ? cnt : 1u;
}
__device__ __forceinline__ void xcd_barrier(const XcdBarrier& b) {
    asm volatile("s_waitcnt vmcnt(0)" ::: "memory");
    __syncthreads();
    if (threadIdx.x == 0) {
        unsigned* bar = b.bar;
        __builtin_amdgcn_s_waitcnt(0);
        unsigned nloc = b.st[0], nx = b.st[1];
        if (nloc == 0u) { xcd_barrier_complete(bar, b.x, nloc, nx); b.st[0] = nloc; b.st[1] = nx; }
        const unsigned old = xb_add(&bar[XB_XSUB(b.x)], 1u);
        const unsigned gen = old / nloc;
        if (old + 1u == (gen + 1u) * nloc) {
            __builtin_amdgcn_fence(__ATOMIC_RELEASE, "agent");
            asm volatile("s_waitcnt vmcnt(0)" ::: "memory");
            const unsigned og = xb_add(&bar[XB_TOP], 1u);
            const unsigned tg = og / nx;
            if (og + 1u == (tg + 1u) * nx) xb_add(&bar[XB_TOPGEN], 1u);
            else XB_SPIN(xb_ld(&bar[XB_TOPGEN]) == tg, bar);
            __builtin_amdgcn_fence(__ATOMIC_ACQUIRE, "agent");
            xb_add(&bar[XB_XGEN(b.x)], 1u);
            asm volatile("s_waitcnt vmcnt(0)" ::: "memory");
        } else {
            XB_SPIN(xb_ld(&bar[XB_XGEN(b.x)]) == gen, bar);
            __builtin_amdgcn_fence(__ATOMIC_ACQUIRE, "agent");
            asm volatile("s_waitcnt vmcnt(0)" ::: "memory");
        }
    }
    __syncthreads();
}

__global__ void __launch_bounds__(NTHREADS, 2) fwd_megakernel(Params p) {
    extern __shared__ __attribute__((aligned(16))) unsigned char lds_raw[];
    LAS unsigned char* lds = (LAS unsigned char*)lds_raw;
    cg::grid_group grid = cg::this_grid();
#define PHASE_IDS() int tid = threadIdx.x; asm volatile("" : "+v"(tid)); const int lane = tid & 63, wave = __builtin_amdgcn_readfirstlane(tid >> 6); (void)lane; (void)wave
    const int G = gridDim.x, bx = blockIdx.x;
    unsigned char* ws = p.ws;
    unsigned* ctl = (unsigned*)(ws + WS_CTL);
    if (threadIdx.x < 2) ((LAS unsigned*)(lds + LDS_BARST))[threadIdx.x] = 0u;
    __syncthreads();
    const XcdBarrier xbar = xcd_barrier_post(ctl + CW_BAR, (volatile LAS unsigned*)(lds + LDS_BARST));
    float* ksum = (float*)(ws + WS_KSUM);
    float* rope = (float*)(ws + WS_ROPE);
    bf16_t* w_in_t = (bf16_t*)(ws + WS_WIN_T); bf16_t* w_out_t = (bf16_t*)(ws + WS_WOUT_T);
    unsigned char* w1_8 = ws + WS_W1_8; unsigned char* w2_8 = ws + WS_W2_8; unsigned char* x1_8 = ws + WS_X1_8; unsigned char* act8 = ws + WS_ACT8;
    int* cnt_blk = (int*)(ws + WS_CNT); int* tile_e = (int*)(ws + WS_TILE_E);
    bf16_t* wr_hi = (bf16_t*)(ws + WS_WR_HI); bf16_t* wr_lo = (bf16_t*)(ws + WS_WR_LO);
    int* tok = (int*)(ws + WS_TOK);
    int* asg_e = (int*)(ws + WS_ASG_E); float* asg_g = (float*)(ws + WS_ASG_G); int* asg_d = (int*)(ws + WS_ASG_D);
    bf16_t* x1b = (bf16_t*)(ws + WS_X1B); bf16_t* x1lo = (bf16_t*)(ws + WS_X1LO);
    bf16_t* xb = (bf16_t*)(ws + WS_XB); bf16_t* attn_o = xb;
    bf16_t* qkv = (bf16_t*)(ws + WS_QKV);
    bf16_t* yb = (bf16_t*)(ws + WS_YB);

    REP(0) {
        PHASE_IDS();
        const long gt = (long)bx * NTHREADS + tid, gsz = (long)G * NTHREADS;
        for (long i = gt; i < 2048 * 32; i += gsz) {
            const int pos = (int)(i >> 5), k = (int)(i & 31);
            double inv = 1.0; for (int q = 0; q < k; ++q) inv *= 0.7498942093324559;
            double s, c; sincos_d((double)pos * inv, s, c);
            rope[pos * 64 + k] = (float)c; rope[pos * 64 + 32 + k] = (float)s;
        }
        for (long i = gt; i < 32 * 1024; i += gsz) {
            const int e = (int)(i >> 10), k = (int)(i & 1023); const float w = p.w_router[k * 32 + e];
            const unsigned h = f2bf(w); wr_hi[i] = (bf16_t)h; wr_lo[i] = (bf16_t)f2bf(w - bf2f(h));
        }
        LAS float* scr = (LAS float*)(lds + wave * 16384);
        const int gw = bx * 8 + wave, NGW = G * 8;
        constexpr int I_IN = 16 * (INW / 32), I_OUT = 16 * 32, I_W1 = 16 * 64, I_W2 = 16 * 32;
        constexpr int NITEMS = I_IN + I_OUT + NE * I_W1 + NE * I_W2;
        for (int it = gw; it < NITEMS; it += NGW) {
            int r = it;
            if (r < I_IN) { p0_transpose_item(p.w_in, INW, w_in_t, 0, scr, r, lane); continue; } r -= I_IN;
            if (r < I_OUT) { p0_transpose_item(p.w_out, 1024, w_out_t, 1, scr, r, lane); continue; } r -= I_OUT;
            if (r < NE * I_W1) { const int e = r / I_W1; p0_transpose_item_fp8(p.w1 + (size_t)e * 1024 * 2048, 2048, w1_8 + (size_t)e * 2048 * 1024, 2, W_SCALE, scr, r % I_W1, lane); continue; } r -= NE * I_W1;
            { const int e = r / I_W2; p0_transpose_item_fp8(p.w2 + (size_t)e * 1024 * 1024, 1024, w2_8 + (size_t)e * 1024 * 1024, 1, W_SCALE, scr, r % I_W2, lane); }
        }
        const f32x4* x4 = (const f32x4*)p.x; u32x4* xb4 = (u32x4*)xb;
        for (long i = gt; i < (long)T * D / 8; i += gsz) { const f32x4 a = x4[2 * i], b = x4[2 * i + 1];
            u32x4 o; o.x = cvtpk(a[0], a[1]); o.y = cvtpk(a[2], a[3]); o.z = cvtpk(b[0], b[1]); o.w = cvtpk(b[2], b[3]); xb4[i] = o; }
    }
    grid.sync();

    REP(1) {
        pg8::SchedInProj S{(const char*)xb, (const char*)w_in_t, G, bx};
        pg8::EpiInProj E{qkv, p.b_in, rope, ksum};
        pg8::gemm_phase<pg8::EpiInProj, pg8::SchedInProj, false, true>(lds, S, E);
    }
    xcd_barrier(xbar);

    REP(2) for (int u = bx; u < 256; u += G) {
        { const int b = u >> 3, h = u & 7;
            for (int j = 0; j < 8; ++j) att::attn_item<true>((char*)lds_raw, qkv, attn_o, b, h, j, p.sinks, ksum); }
        { const int b = u >> 3, kvh = (u >> 2) & 1, oct = u & 3;
            for (int i = 0; i < 8; ++i) att::attn_item<false>((char*)lds_raw, qkv, attn_o, b, kvh, oct * 8 + i, p.sinks, ksum); }
    }
    xcd_barrier(xbar);

    REP(3) for (int pm = bx; pm < T / 256; pm += G) {
        PHASE_IDS();
        {
            pg8::SchedPanel S{(const char*)attn_o, (const char*)w_out_t, pm};
            pg8::EpiOutProj E{(bf16_t*)p.out, p.b_out, p.x};
            pg8::gemm_phase<pg8::EpiOutProj, pg8::SchedPanel, false, true>(lds, S, E);
        }
        __syncthreads();
        {
#pragma unroll
            for (int i = 0; i < 16; ++i) { const int idx = tid + 512 * i, mat = idx >> 12, rw = (idx >> 7) & 31, ch = idx & 127;
                const u32x4 v = *(const u32x4*)((mat ? wr_lo : wr_hi) + rw * 1024 + ch * 8);
                *(LAS u32x4*)(lds + mat * 66048 + rw * 2064 + ch * 16) = v; }
        }
        {
            const bf16_t* ytmp = (const bf16_t*)p.out;
            f32x4 gg[2][2], bb[2][2];
#pragma unroll
            for (int j = 0; j < 2; ++j)
#pragma unroll
                for (int h = 0; h < 2; ++h) { gg[j][h] = *(const f32x4*)(p.ln1_g + 512 * j + 8 * lane + 4 * h); bb[j][h] = *(const f32x4*)(p.ln1_b + 512 * j + 8 * lane + 4 * h); }
            for (int rr = 0; rr < 32; rr += 4) {
                const size_t row0 = (size_t)pm * 256 + wave * 32 + rr;
                u32x4 raw[4][2]; float v[4][2][8]; float sm[4], sq[4];
#pragma unroll
                for (int q = 0; q < 4; ++q)
#pragma unroll
                    for (int j = 0; j < 2; ++j) raw[q][j] = *(const u32x4*)(ytmp + (row0 + q) * D + 512 * j + 8 * lane);
#pragma unroll
                for (int q = 0; q < 4; ++q) { float s_ = 0.f;
#pragma unroll
                    for (int j = 0; j < 2; ++j)
#pragma unroll
                        for (int c = 0; c < 4; ++c) { const unsigned w = raw[q][j][c]; v[q][j][2 * c] = bf2f(w & 0xffffu); v[q][j][2 * c + 1] = bf2f(w >> 16); s_ += v[q][j][2 * c] + v[q][j][2 * c + 1]; }
                    sm[q] = s_; }
#pragma unroll
                for (int o = 1; o < 64; o <<= 1) {
#pragma unroll
                    for (int q = 0; q < 4; ++q) sm[q] += __shfl_xor(sm[q], o); }
#pragma unroll
                for (int q = 0; q < 4; ++q) { const float mean = sm[q] * (1.0f / D); float s2 = 0.f;
#pragma unroll
                    for (int j = 0; j < 2; ++j)
#pragma unroll
                        for (int c = 0; c < 8; ++c) { v[q][j][c] -= mean; s2 += v[q][j][c] * v[q][j][c]; }
                    sq[q] = s2; }
#pragma unroll
                for (int o = 1; o < 64; o <<= 1) {
#pragma unroll
                    for (int q = 0; q < 4; ++q) sq[q] += __shfl_xor(sq[q], o); }
#pragma unroll
                for (int q = 0; q < 4; ++q) {
                    const float rstd = 1.0f / sqrtf(sq[q] * (1.0f / D) + LN_EPS);
#pragma unroll
                    for (int j = 0; j < 2; ++j) {
                        float xv[8];
#pragma unroll
                        for (int c = 0; c < 8; ++c) xv[c] = v[q][j][c] * rstd * gg[j][c >> 2][c & 3] + bb[j][c >> 2][c & 3];
                        u32x4 hv; hv.x = cvtpk(xv[0], xv[1]); hv.y = cvtpk(xv[2], xv[3]); hv.z = cvtpk(xv[4], xv[5]); hv.w = cvtpk(xv[6], xv[7]);
                        u32x2 fv; fv.x = pk4_fp8(xv[0], xv[1], xv[2], xv[3]); fv.y = pk4_fp8(xv[4], xv[5], xv[6], xv[7]);
                        *(u32x4*)(x1b + (row0 + q) * D + 512 * j + 8 * lane) = hv;
                        *(u32x2*)(x1_8 + (row0 + q) * D + 512 * j + 8 * lane) = fv;
                    }
                }
            }
        }
        __syncthreads();
        {
            const int fr = lane & 15, fq = lane >> 4;
            f32x4 lacc[2][2];
#pragma unroll
            for (int m = 0; m < 2; ++m)
#pragma unroll
                for (int n = 0; n < 2; ++n) lacc[m][n] = (f32x4){0.f, 0.f, 0.f, 0.f};
            const size_t r0 = (size_t)pm * 256 + wave * 32;
            const bf16_t* ah = x1b + (r0 + fr) * D + 8 * fq;
            const LAS unsigned char* bh = lds + fr * 2064 + 16 * fq; const LAS unsigned char* bl = bh + 66048;
#pragma unroll 4
            for (int k0 = 0; k0 < 1024; k0 += 32) {
                bf16x8 a_hi[2], b_hi[2], b_lo[2];
#pragma unroll
                for (int m = 0; m < 2; ++m) a_hi[m] = *(const bf16x8*)(ah + (size_t)m * 16 * D + k0);
#pragma unroll
                for (int n = 0; n < 2; ++n) { b_hi[n] = *(const LAS bf16x8*)(bh + n * 16 * 2064 + k0 * 2); b_lo[n] = *(const LAS bf16x8*)(bl + n * 16 * 2064 + k0 * 2); }
#pragma unroll
                for (int m = 0; m < 2; ++m)
#pragma unroll
                    for (int n = 0; n < 2; ++n) {
                        lacc[m][n] = __builtin_amdgcn_mfma_f32_16x16x32_bf16(a_hi[m], b_hi[n], lacc[m][n], 0, 0, 0);
                        lacc[m][n] = __builtin_amdgcn_mfma_f32_16x16x32_bf16(a_hi[m], b_lo[n], lacc[m][n], 0, 0, 0);
                    }
            }
            __syncthreads();
            LAS float* lg = (LAS float*)lds;
#pragma unroll
            for (int m = 0; m < 2; ++m)
#pragma unroll
                for (int n = 0; n < 2; ++n)
#pragma unroll
                    for (int rg = 0; rg < 4; ++rg) lg[(wave * 32 + 16 * m + 4 * fq + rg) * 33 + 16 * n + fr] = lacc[m][n][rg];
        }
        __syncthreads();
        {
            LAS float* lg = (LAS float*)lds;
            LAS int* wcnt = (LAS int*)(lds + 36864);
            float t0 = -INFINITY, t1 = -INFINITY, t2 = -INFINITY, t3 = -INFINITY; int i0 = 0, i1 = 0, i2 = 0, i3 = 0;
            int rk0 = 0, rk1 = 0, rk2 = 0, rk3 = 0;
            if (tid < 256) {
                for (int e = 0; e < NE; ++e) {
                    const float xv = lg[tid * 33 + e] + p.b_router[e];
                    if (xv > t3) {
                        if (xv > t2) { t3 = t2; i3 = i2;
                            if (xv > t1) { t2 = t1; i2 = i1;
                                if (xv > t0) { t1 = t0; i1 = i0; t0 = xv; i0 = e; } else { t1 = xv; i1 = e; }
                            } else { t2 = xv; i2 = e; }
                        } else { t3 = xv; i3 = e; }
                    }
                }
                const unsigned selm = (1u << i0) | (1u << i1) | (1u << i2) | (1u << i3);
                for (int e = 0; e < NE; ++e) {
                    const bool has = ((selm >> e) & 1u) != 0u;
                    const unsigned long long bal = __ballot(has);
                    const int pre = __popcll(bal & ((1ull << lane) - 1ull));
                    if (e == i0) rk0 = pre; if (e == i1) rk1 = pre; if (e == i2) rk2 = pre; if (e == i3) rk3 = pre;
                    if (lane == 0) wcnt[wave * 32 + e] = __popcll(bal);
                }
            }
            __syncthreads();
            if (tid < 256) {
                const float e1 = __expf(t1 - t0), e2 = __expf(t2 - t0), e3 = __expf(t3 - t0);
                const float inv = 1.0f / (1.0f + e1 + e2 + e3);
                int b0 = 0, b1 = 0, b2 = 0, b3 = 0;
                for (int w = 0; w < wave; ++w) { b0 += wcnt[w * 32 + i0]; b1 += wcnt[w * 32 + i1]; b2 += wcnt[w * 32 + i2]; b3 += wcnt[w * 32 + i3]; }
                const size_t a = ((size_t)pm * 256 + tid) * 4;
                *(int4*)(asg_e + a) = make_int4(i0, i1, i2, i3);
                *(float4*)(asg_g + a) = make_float4(inv, e1 * inv, e2 * inv, e3 * inv);
                *(int4*)(asg_d + a) = make_int4(b0 + rk0, b1 + rk1, b2 + rk2, b3 + rk3);
            }
            if (tid < 32) cnt_blk[pm * 32 + tid] = wcnt[tid] + wcnt[32 + tid] + wcnt[64 + tid] + wcnt[96 + tid];
            __syncthreads();
        }
    }
    xcd_barrier(xbar);

    for (int pm = bx; pm < T / 256; pm += G) {
        PHASE_IDS();
        LAS int* part_all = (LAS int*)lds; LAS int* part_pre = part_all + 512; LAS int* tot = part_pre + 512; LAS int* pre = tot + 32; LAS int* poff = pre + 32;
        { const int e = tid & 31, seg = tid >> 5; int sa = 0, sp = 0;
            for (int bb = seg * 16; bb < seg * 16 + 16; ++bb) { const int c = cnt_blk[bb * 32 + e]; sa += c; sp += (bb < pm) ? c : 0; }
            part_all[tid] = sa; part_pre[tid] = sp; }
        __syncthreads();
        if (tid < 32) { int sa = 0, sp = 0; for (int s = 0; s < 16; ++s) { sa += part_all[s * 32 + tid]; sp += part_pre[s * 32 + tid]; } tot[tid] = sa; pre[tid] = sp; }
        __syncthreads();
        if (tid == 0) { int off = 0; for (int e = 0; e < NE; ++e) { poff[e] = off; off += ((tot[e] + 255) >> 8) << 8; } poff[32] = off; }
        __syncthreads();
        if (tid < 256) {
            const int token = pm * 256 + tid; const size_t a = (size_t)token * 4;
            const int4 ee = *(const int4*)(asg_e + a); const int4 rk = *(const int4*)(asg_d + a);
            const int d0 = poff[ee.x] + pre[ee.x] + rk.x, d1 = poff[ee.y] + pre[ee.y] + rk.y, d2 = poff[ee.z] + pre[ee.z] + rk.z, d3 = poff[ee.w] + pre[ee.w] + rk.w;
            *(int4*)(asg_d + a) = make_int4(d0, d1, d2, d3);
            tok[d0] = token; tok[d1] = token; tok[d2] = token; tok[d3] = token;
        }
        if (pm < NE) {
            const int e = pm, n = tot[e], np = ((n + 255) >> 8) << 8, o = poff[e];
            for (int i = n + tid; i < np; i += NTHREADS) tok[o + i] = 0;
            for (int i = tid; i < (np >> 8); i += NTHREADS) tile_e[(o >> 8) + i] = e;
        }
        if (pm == 0 && tid == 0) ctl[CW_NTILES] = (unsigned)(poff[32] >> 8);
        __syncthreads();
    }
    xcd_barrier(xbar);

    const int ntiles = (int)ctl[CW_NTILES];
    REP(5) {
        pg8::SchedMoe<8, true> S{(const char*)x1_8, (const char*)w1_8, tile_e, tok, ntiles, G, bx};
        pg8::EpiSwiglu E{act8, p.b1};
        pg8::gemm_phase<pg8::EpiSwiglu, pg8::SchedMoe<8, true>, true, true, 512, true>(lds, S, E);
    }
    xcd_barrier(xbar);

    REP(6) {
        pg8::SchedMoe<4, false> S{(const char*)act8, (const char*)w2_8, tile_e, tok, ntiles, G, bx};
        pg8::EpiDown E{yb, p.b2};
        pg8::gemm_phase<pg8::EpiDown, pg8::SchedMoe<4, false>, false, true, 512, true>(lds, S, E);
    }
    xcd_barrier(xbar);

    REP(7) {
        PHASE_IDS();
        const int gw = bx * 8 + wave, NGW = G * 8;
        f32x4 gg[2][2], bb[2][2];
#pragma unroll
        for (int j = 0; j < 2; ++j)
#pragma unroll
            for (int h = 0; h < 2; ++h) { gg[j][h] = *(const f32x4*)(p.ln2_g + 512 * j + 8 * lane + 4 * h); bb[j][h] = *(const f32x4*)(p.ln2_b + 512 * j + 8 * lane + 4 * h); }
        for (int row = gw; row < T; row += NGW) {
            const size_t a = (size_t)row * 4;
            const int4 dd = *(const int4*)(asg_d + a); const float4 gt4 = *(const float4*)(asg_g + a);
            u32x4 xr[2], y0[2], y1[2], y2[2], y3[2];
#pragma unroll
            for (int j = 0; j < 2; ++j) {
                xr[j] = *(const u32x4*)(x1b + (size_t)row * D + 512 * j + 8 * lane);
                y0[j] = *(const u32x4*)(yb + (size_t)dd.x * D + 512 * j + 8 * lane);
                y1[j] = *(const u32x4*)(yb + (size_t)dd.y * D + 512 * j + 8 * lane);
                y2[j] = *(const u32x4*)(yb + (size_t)dd.z * D + 512 * j + 8 * lane);
                y3[j] = *(const u32x4*)(yb + (size_t)dd.w * D + 512 * j + 8 * lane);
            }
            float z[2][8]; float s = 0.f;
#pragma unroll
            for (int j = 0; j < 2; ++j)
#pragma unroll
                for (int q = 0; q < 4; ++q) {
                    const unsigned xw = xr[j][q], a0 = y0[j][q], a1 = y1[j][q], a2 = y2[j][q], a3 = y3[j][q];
                    const float lo = DN_ALPHA * bf2f(xw & 0xffffu) + gt4.x * bf2f(a0 & 0xffffu) + gt4.y * bf2f(a1 & 0xffffu) + gt4.z * bf2f(a2 & 0xffffu) + gt4.w * bf2f(a3 & 0xffffu);
                    const float hi = DN_ALPHA * bf2f(xw >> 16) + gt4.x * bf2f(a0 >> 16) + gt4.y * bf2f(a1 >> 16) + gt4.z * bf2f(a2 >> 16) + gt4.w * bf2f(a3 >> 16);
                    z[j][2 * q] = lo; z[j][2 * q + 1] = hi; s += lo + hi;
                }
            const float mean = wave_sum(s) * (1.0f / D); float s2 = 0.f;
#pragma unroll
            for (int j = 0; j < 2; ++j)
#pragma unroll
                for (int q = 0; q < 8; ++q) { z[j][q] -= mean; s2 += z[j][q] * z[j][q]; }
            const float rstd = 1.0f / sqrtf(wave_sum(s2) * (1.0f / D) + LN_EPS);
#pragma unroll
            for (int j = 0; j < 2; ++j)
#pragma unroll
                for (int h = 0; h < 2; ++h) {
                    f32x4 o;
#pragma unroll
                    for (int q = 0; q < 4; ++q) o[q] = z[j][4 * h + q] * rstd * gg[j][h][q] + bb[j][h][q];
                    *(f32x4*)(p.out + (size_t)row * D + 512 * j + 8 * lane + 4 * h) = o;
                }
        }
    }
}

extern "C" void kernel_launch(void* const* d_in, const int* in_sizes, int n_in, void* d_out, int out_size, void* d_ws, size_t ws_size, hipStream_t stream) {
    static int grid_blocks = 0;
    if (grid_blocks == 0) {
        if (n_in != 16 || in_sizes[0] != T * D || out_size != T * D || ws_size < WS_END) {
            fprintf(stderr, "kernel_launch: unexpected shapes: n_in %d in0 %d out %d ws %zu (need %zu)\n", n_in, n_in > 0 ? in_sizes[0] : -1, out_size, ws_size, (size_t)WS_END); grid_blocks = -1; return; }
        int dev = 0, cus = 0, per_cu = 0;
        (void)hipGetDevice(&dev);
        (void)hipDeviceGetAttribute(&cus, hipDeviceAttributeMultiprocessorCount, dev);
        (void)hipFuncSetAttribute((const void*)fwd_megakernel, hipFuncAttributeMaxDynamicSharedMemorySize, LDS_BYTES);
        (void)hipOccupancyMaxActiveBlocksPerMultiprocessor(&per_cu, (const void*)fwd_megakernel, NTHREADS, LDS_BYTES);
        if (per_cu < 1) { fprintf(stderr, "kernel_launch: occupancy query reports %d blocks per CU\n", per_cu); per_cu = 1; }
        grid_blocks = cus;
        fprintf(stderr, "kernel_launch: cus=%d per_cu=%d grid=%d ws=%zu\n", cus, per_cu, grid_blocks, ws_size);
    }
    if (grid_blocks < 0) return;
    (void)hipMemsetAsync((char*)d_ws + WS_CTL, 0, CTL_ZERO_BYTES, stream);
    Params p{};
    p.x = (const float*)d_in[0]; p.w_in = (const float*)d_in[1]; p.b_in = (const float*)d_in[2]; p.sinks = (const float*)d_in[3]; p.w_out = (const float*)d_in[4]; p.b_out = (const float*)d_in[5];
    p.ln1_g = (const float*)d_in[6]; p.ln1_b = (const float*)d_in[7]; p.w_router = (const float*)d_in[8]; p.b_router = (const float*)d_in[9];
    p.w1 = (const float*)d_in[10]; p.b1 = (const float*)d_in[11]; p.w2 = (const float*)d_in[12]; p.b2 = (const float*)d_in[13]; p.ln2_g = (const float*)d_in[14]; p.ln2_b = (const float*)d_in[15];
    p.out = (float*)d_out; p.ws = (unsigned char*)d_ws;
    void* args[] = {&p};
    hipError_t e = hipLaunchCooperativeKernel((void*)fwd_megakernel, dim3(grid_blocks), dim3(NTHREADS), args, LDS_BYTES, stream);
    if (e != hipSuccess) fprintf(stderr, "cooperative launch failed: %s (grid %d)\n", hipGetErrorString(e), grid_blocks);
}
```

```cpp
#include <hip/hip_runtime.h>
#include <hip/hip_cooperative_groups.h>
#include <cstdio>
#include <cstdint>
namespace cg = cooperative_groups;

#define LAS __attribute__((address_space(3)))
typedef unsigned short bf16_t;
typedef short bf16x8 __attribute__((ext_vector_type(8)));
typedef short s16x4 __attribute__((ext_vector_type(4)));
typedef float f32x2 __attribute__((ext_vector_type(2)));
typedef float f32x4 __attribute__((ext_vector_type(4)));
typedef float f32x16 __attribute__((ext_vector_type(16)));
typedef unsigned u32x2 __attribute__((ext_vector_type(2)));
typedef unsigned u32x4 __attribute__((ext_vector_type(4)));
typedef __bf16 bf16x2_t __attribute__((ext_vector_type(2)));

constexpr int D = 1024, BATCH = 32, SEQ = 2048, T = BATCH * SEQ;
constexpr int INW = 2304, NE = 32;
constexpr float LN_EPS = 1e-5f;
constexpr float DN_ALPHA = 1.189207115002721f;
constexpr float LOG2E = 1.4426950408889634f;
constexpr float C2 = 0.18033688011112042f;
constexpr int NTHREADS = 512;
constexpr int LDS_BYTES = 147456;
constexpr int MAX_TILES = 1056;
#ifndef INPROJ_FP8
#define INPROJ_FP8 1
#endif
#ifndef DUP_MASK
#define DUP_MASK 0
#endif
#define REP(k) for (int _rep = 0; _rep < (((DUP_MASK >> (k)) & 1) ? 2 : 1); ++_rep)

constexpr size_t MiB = 1u << 20;
constexpr size_t WS_CTL = 0, CTL_ZERO_BYTES = 2 * MiB;
constexpr size_t WS_KSUM = 1 * MiB;
constexpr size_t WS_ROPE = 2 * MiB;
constexpr size_t WS_WIN_T = 4 * MiB;
constexpr size_t WS_WOUT_T = 9 * MiB;
constexpr size_t WS_SMALL = 11 * MiB;
constexpr size_t WS_CNT = WS_SMALL, WS_TILE_E = WS_SMALL + 65536, WS_WR_HI = WS_SMALL + 131072, WS_WR_LO = WS_WR_HI + 65536;
constexpr size_t WS_TOK = 12 * MiB;
constexpr size_t WS_ASG_E = 14 * MiB, WS_ASG_G = 15 * MiB, WS_ASG_D = 16 * MiB;
constexpr size_t WS_W2_8 = 24 * MiB;
constexpr size_t WS_X1B = 56 * MiB;
constexpr size_t WS_ACT8 = 184 * MiB;
constexpr size_t WS_XB = 184 * MiB;
constexpr size_t WS_X1LO = 312 * MiB;
constexpr size_t WS_YB = 488 * MiB;
constexpr size_t WS_W1_8 = 488 * MiB;
constexpr size_t WS_X1_8 = 552 * MiB;
constexpr size_t WS_QKV = 616 * MiB;
constexpr size_t WS_END = 1016 * MiB;
constexpr float W_SCALE = 64.0f, ACT_SCALE = 4.0f, WIN_SCALE = 32.0f;
constexpr int CW_NTILES = 16, CW_BAR = 4096;
constexpr int LDS_BARST = LDS_BYTES - 256;

struct Params {
    const float *x, *w_in, *b_in, *sinks, *w_out, *b_out, *ln1_g, *ln1_b, *w_router, *b_router, *w1, *b1, *w2, *b2, *ln2_g, *ln2_b;
    float* out; unsigned char* ws;
};

__device__ __forceinline__ unsigned f2bf(float f) { unsigned u = __builtin_bit_cast(unsigned, f); return (u + 0x7fffu + ((u >> 16) & 1u)) >> 16; }
__device__ __forceinline__ float bf2f(unsigned h) { return __builtin_bit_cast(float, h << 16); }
__device__ __forceinline__ unsigned cvtpk(float lo, float hi) { f32x2 v = {lo, hi}; bf16x2_t b = __builtin_convertvector(v, bf16x2_t); return __builtin_bit_cast(unsigned, b); }
__device__ __forceinline__ unsigned pk4_fp8(float a, float b, float c, float d) { int w = 0; w = __builtin_amdgcn_cvt_pk_fp8_f32(a, b, w, false); w = __builtin_amdgcn_cvt_pk_fp8_f32(c, d, w, true); return (unsigned)w; }
__device__ __forceinline__ float wave_sum(float v) {
#pragma unroll
    for (int o = 1; o < 64; o <<= 1) v += __shfl_xor(v, o);
    return v;
}
#define LDS_WAIT() asm volatile("s_waitcnt lgkmcnt(0)" ::: "memory")
template <int X> __device__ __forceinline__ float swz_xor(float v) { return __builtin_bit_cast(float, __builtin_amdgcn_ds_swizzle(__builtin_bit_cast(int, v), (X << 10) | 0x1f)); }

namespace pg8 {
constexpr int BM = 256, BK = 64, HALF = 128, HTB = HALF * BK * 2, STAGE_BYTES = 8 * HTB, NXCD = 8, WGM = 8;
constexpr int KD = 1024;
__host__ __device__ __forceinline__ int lds_byte(int r, int c) { const int st = (r >> 4) * 2 + (c >> 5), rr = r & 15, cc = c & 31, ob = rr * 64 + cc * 2; return st * 1024 + (ob ^ (((ob >> 9) & 1) << 5)); }
__host__ __device__ __forceinline__ void stage_rc(int b, int& R, int& C) { const int st = b / 1024, sb = b % 1024, swz = sb ^ (((sb >> 9) & 1) << 5); R = (st >> 1) * 16 + swz / 64; C = (st & 1) * 32 + (swz % 64) / 2; }
__host__ __device__ __forceinline__ int perm32(int rho) { const int n = rho >> 4, i = rho & 15; return 8 * (i >> 2) + 4 * n + (i & 3); }

struct Unit { int pm, pn, e; unsigned ao, bo; const int* rows; };

typedef int v8i32_t __attribute__((ext_vector_type(8)));
typedef int v4i32_t __attribute__((ext_vector_type(4)));
__device__ __forceinline__ v8i32_t cat8(bf16x8 a, bf16x8 b) { const v4i32_t x = __builtin_bit_cast(v4i32_t, a), y = __builtin_bit_cast(v4i32_t, b); return __builtin_shufflevector(x, y, 0, 1, 2, 3, 4, 5, 6, 7); }
template <class Epi, class Sched, bool GATHER, bool ALIGN_EPI, int KP = 1024, bool FP8 = false>
__device__ __forceinline__ void gemm_phase(LAS unsigned char* lds, const Sched& S, const Epi& E) {
    int tid = threadIdx.x; asm volatile("" : "+v"(tid));
    const int wid = __builtin_amdgcn_readfirstlane(tid >> 6), lane = tid & 63, wr = wid >> 2, wc = wid & 3, fr = lane & 15, fq = lane >> 4;
    constexpr int K = KP, nt = K / BK;
    unsigned voffB[2], Vc[2][2], Vn[2][2]; int stR0, stC0;
    { int R, C; stage_rc(tid * 16, R, C); stR0 = R; stC0 = C; }
#pragma unroll
    for (int i = 0; i < 2; ++i) { voffB[i] = (unsigned)((stR0 + 64 * i) * K + stC0) * 2u; Vc[0][i] = voffB[i]; Vc[1][i] = voffB[i]; Vn[0][i] = voffB[i]; Vn[1][i] = voffB[i]; }
#define PG8_GATHER_LOAD(VV, rowsp) do { int _t = threadIdx.x; asm volatile("" : "+v"(_t)); int _R, _C; stage_rc(_t * 16, _R, _C);     \
        const int* _rp = (const int*)((const char*)(rowsp) + (unsigned)(_R * 4)); _Pragma("unroll") for (int _h = 0; _h < 2; ++_h) _Pragma("unroll") for (int _i = 0; _i < 2; ++_i) \
        VV[_h][_i] = ((unsigned)_rp[128 * _h + 64 * _i] * (unsigned)K + (unsigned)_C) * 2u; } while (0)
    constexpr unsigned kstep = (unsigned)(BK * 2);
    constexpr unsigned hstep = (unsigned)HALF * K * 2;
    const char* const Abase = S.A; const char* const Bbase = S.B;
    const unsigned ldsw = (unsigned)wid * 1024u;
    const int aoff = lds_byte(wr * 64 + fr, fq * 8), boff = lds_byte(wc * 32 + fr, fq * 8);
#define PG8_SA(b, h) (((b) * 2 + (h)) * HTB)
#define PG8_SB(b, h) ((4 + (b) * 2 + (h)) * HTB)
#define PG8_STAGE(bufoff, gbase, soff, voff) do { _Pragma("unroll") for (int _i = 0; _i < 2; ++_i) \
        __builtin_amdgcn_global_load_lds((const unsigned*)((gbase) + (unsigned)((voff)[_i] + (soff))), (LAS unsigned*)(lds + (bufoff) + ldsw + _i * 8192), 16, 0, 0); } while (0)
#define PG8_STAGE_B(bufoff, soff) PG8_STAGE(bufoff, Bbase, soff, voffB)
#define PG8_STAGE_A(bufoff, soff, h, VV) do { if constexpr (GATHER) { PG8_STAGE(bufoff, Abase, soff, VV[h]); } else { PG8_STAGE(bufoff, Abase, (soff) + (h) * hstep, voffB); } } while (0)
#define PG8_LDA(dst, b, h) do { _Pragma("unroll") for (int m = 0; m < 4; ++m) dst[m] = cat8(*(const LAS bf16x8*)(lds + PG8_SA(b, h) + aoff + m * 2048), *(const LAS bf16x8*)(lds + PG8_SA(b, h) + aoff + m * 2048 + 1024)); } while (0)
#define PG8_LDB(dst, b, h) do { _Pragma("unroll") for (int n = 0; n < 2; ++n) dst[n] = cat8(*(const LAS bf16x8*)(lds + PG8_SB(b, h) + boff + n * 2048), *(const LAS bf16x8*)(lds + PG8_SB(b, h) + boff + n * 2048 + 1024)); } while (0)
#define PG8_LO(v) __builtin_bit_cast(bf16x8, __builtin_shufflevector(v, v, 0, 1, 2, 3))
#define PG8_HI(v) __builtin_bit_cast(bf16x8, __builtin_shufflevector(v, v, 4, 5, 6, 7))
#define PG8_MMA(ai, bj, At, Bt) do { __builtin_amdgcn_s_setprio(1); _Pragma("unroll") for (int m = 0; m < 4; ++m) _Pragma("unroll") for (int n = 0; n < 2; ++n) { \
        if constexpr (FP8) { acc[ai][bj][m][n] = __builtin_amdgcn_mfma_scale_f32_16x16x128_f8f6f4(Bt[n], At[m], acc[ai][bj][m][n], 0, 0, 0, 0x7f7f7f7f, 0, 0x7f7f7f7f); } \
        else { acc[ai][bj][m][n] = __builtin_amdgcn_mfma_f32_16x16x32_bf16(PG8_LO(Bt[n]), PG8_LO(At[m]), acc[ai][bj][m][n], 0, 0, 0); \
               acc[ai][bj][m][n] = __builtin_amdgcn_mfma_f32_16x16x32_bf16(PG8_HI(Bt[n]), PG8_HI(At[m]), acc[ai][bj][m][n], 0, 0, 0); } } \
        __builtin_amdgcn_s_setprio(0); } while (0)
#define PG8_WAIT_V(n) asm volatile("s_waitcnt vmcnt(" #n ")" ::: "memory")
#define PG8_WAIT_L(n) asm volatile("s_waitcnt lgkmcnt(" #n ")" ::: "memory")
#define PG8_BAR __builtin_amdgcn_s_barrier()
#define PG8_SCHED __builtin_amdgcn_sched_barrier(0)
    Unit cur, nxt; int ui = 0;
    if (!S.next(0, cur)) return;
    if constexpr (GATHER) { PG8_GATHER_LOAD(Vc, cur.rows); }
    f32x4 acc[2][2][4][2];
#pragma unroll
    for (int a = 0; a < 2; ++a)
#pragma unroll
        for (int b = 0; b < 2; ++b)
#pragma unroll
            for (int m = 0; m < 4; ++m)
#pragma unroll
                for (int n = 0; n < 2; ++n) acc[a][b][m][n] = (f32x4){0.f, 0.f, 0.f, 0.f};
    v8i32_t At[4], B0[2], B1[2];
    unsigned cA = cur.ao, cB = cur.bo;
    PG8_STAGE_B(PG8_SB(0, 0), cB); PG8_STAGE_B(PG8_SB(0, 1), cB + hstep); PG8_STAGE_A(PG8_SA(0, 0), cA, 0, Vc); PG8_STAGE_A(PG8_SA(0, 1), cA, 1, Vc);
    if (wr == 1) PG8_BAR;
    PG8_WAIT_V(2); PG8_BAR;
    PG8_STAGE_B(PG8_SB(1, 0), cB + kstep); PG8_STAGE_A(PG8_SA(1, 0), cA + kstep, 0, Vc); PG8_STAGE_B(PG8_SB(1, 1), cB + hstep + kstep);
    PG8_WAIT_V(6); PG8_BAR;
    for (;;) {
        const bool has_next = S.next(ui + 1, nxt);
        const unsigned nA = has_next ? nxt.ao : cA; const unsigned nB = has_next ? nxt.bo : cB;
        if constexpr (GATHER) {
            if (has_next) { PG8_GATHER_LOAD(Vn, nxt.rows); }
            else {
#pragma unroll
                for (int i = 0; i < 2; ++i) { Vn[0][i] = Vc[0][i]; Vn[1][i] = Vc[1][i]; }
            }
        }
#pragma unroll 1
        for (int t = 0; t < nt; t += 2) {
            const bool last = (t == nt - 2);
            const unsigned a1 = cA + (unsigned)(t + 1) * kstep;
            const unsigned a2 = last ? nA : cA + (unsigned)(t + 2) * kstep; const unsigned b2 = last ? nB : cB + (unsigned)(t + 2) * kstep;
            const unsigned a3 = a2 + kstep; const unsigned b3 = b2 + kstep;
            PG8_LDB(B0, 0, 0); PG8_LDB(B1, 0, 1); PG8_SCHED; PG8_LDA(At, 0, 0); PG8_STAGE_A(PG8_SA(1, 1), a1, 1, Vc);
            if constexpr (GATHER) { if (last) {
#pragma unroll
                for (int i = 0; i < 2; ++i) { Vc[0][i] = Vn[0][i]; Vc[1][i] = Vn[1][i]; } } }
            PG8_WAIT_V(8); PG8_WAIT_L(0); PG8_BAR; PG8_MMA(0, 0, At, B0); PG8_MMA(0, 1, At, B1); PG8_BAR; PG8_SCHED;
            PG8_LDA(At, 0, 1); PG8_STAGE_B(PG8_SB(0, 0), b2); PG8_STAGE_B(PG8_SB(0, 1), b2 + hstep); PG8_STAGE_A(PG8_SA(0, 0), a2, 0, Vc);
            PG8_WAIT_V(8); PG8_WAIT_L(0); PG8_BAR; PG8_MMA(1, 0, At, B0); PG8_MMA(1, 1, At, B1); PG8_BAR; PG8_SCHED;
            PG8_LDB(B0, 1, 0); PG8_LDB(B1, 1, 1); PG8_SCHED; PG8_LDA(At, 1, 0); PG8_STAGE_A(PG8_SA(0, 1), a2, 1, Vc);
            PG8_WAIT_V(8); PG8_WAIT_L(0); PG8_BAR; PG8_MMA(0, 0, At, B0); PG8_MMA(0, 1, At, B1); PG8_BAR; PG8_SCHED;
            PG8_LDA(At, 1, 1); PG8_STAGE_B(PG8_SB(1, 0), b3); PG8_STAGE_B(PG8_SB(1, 1), b3 + hstep); PG8_STAGE_A(PG8_SA(1, 0), a3, 0, Vc);
            PG8_WAIT_V(8); PG8_WAIT_L(0); PG8_BAR; PG8_MMA(1, 0, At, B0); PG8_MMA(1, 1, At, B1); PG8_BAR; PG8_SCHED;
        }
        if constexpr (ALIGN_EPI) { if (wr == 0) PG8_BAR; }
        { int t2 = threadIdx.x; asm volatile("" : "+v"(t2));
          E(acc, cur, wr, wc, t2 & 15, (t2 & 63) >> 4); }
        if (!has_next) break;
#pragma unroll
        for (int a = 0; a < 2; ++a)
#pragma unroll
            for (int b = 0; b < 2; ++b)
#pragma unroll
                for (int m = 0; m < 4; ++m)
#pragma unroll
                    for (int n = 0; n < 2; ++n) acc[a][b][m][n] = (f32x4){0.f, 0.f, 0.f, 0.f};
        cur = nxt; cA = nA; cB = nB; ++ui;
        if constexpr (ALIGN_EPI) { if (wr == 1) PG8_BAR; }
    }
    PG8_WAIT_V(0);
    if constexpr (!ALIGN_EPI) { if (wr == 0) PG8_BAR; }
    PG8_BAR;
#undef PG8_SA
#undef PG8_SB
#undef PG8_STAGE
#undef PG8_STAGE_A
#undef PG8_STAGE_B
#undef PG8_GATHER_LOAD
#undef PG8_LDA
#undef PG8_LDB
#undef PG8_LO
#undef PG8_HI
#undef PG8_MMA
#undef PG8_WAIT_V
#undef PG8_WAIT_L
#undef PG8_BAR
#undef PG8_SCHED
}

template <int ROWB>
struct SchedInProj {
    const char* A; const char* B; int G, c;
    __device__ __forceinline__ bool next(int i, Unit& u) const {
        constexpr int nM = T / BM, nN = INW / BM, nwg = nM * nN;
        const long L = (long)i * G + c; if (L >= nwg) return false;
        int wgid = (int)L; { const int q = nwg / NXCD, r = nwg % NXCD, xcd = wgid % NXCD, off = wgid / NXCD; wgid = (xcd < r ? xcd * (q + 1) : r * (q + 1) + (xcd - r) * q) + off; }
        const int nig = WGM * nN, gid = wgid / nig, fm = gid * WGM, gsz = (nM - fm) < WGM ? (nM - fm) : WGM;
        u.pm = fm + ((wgid % nig) % gsz); u.pn = (wgid % nig) / gsz; u.e = 0; u.rows = nullptr;
        u.ao = (unsigned)u.pm * (unsigned)(256 * ROWB); u.bo = (unsigned)u.pn * (unsigned)(256 * ROWB); return true;
    }
};
struct SchedPanel {
    const char* A; const char* B; int pm;
    __device__ __forceinline__ bool next(int i, Unit& u) const {
        if (i >= 4) return false;
        u.pm = pm; u.pn = i; u.e = 0; u.rows = nullptr; u.ao = (unsigned)pm * (unsigned)(256 * KD * 2); u.bo = (unsigned)i * (unsigned)(256 * KD * 2); return true;
    }
};
template <int NPN, bool G1>
struct SchedMoe {
    const char* A; const char* B; const int* tile_e; const int* tok; int ntiles, G, c;
    __device__ __forceinline__ bool next(int i, Unit& u) const {
        const long L = (long)i * G + c; int t, pn;
        if ((G & 7) == 0) { const int x = (int)(L & 7); const long j = L >> 3; t = (int)(j / NPN) * 8 + x; pn = (int)(j % NPN); }
        else { t = (int)(L / NPN); pn = (int)(L % NPN); }
        if (t >= ntiles) return false;
        const int e = tile_e[t];
        u.pm = t; u.pn = pn; u.e = e;
        if (G1) { u.ao = 0u; u.rows = tok + (size_t)t * 256; u.bo = ((unsigned)e * 2048u + (unsigned)pn * 256u) * 1024u; }
        else { u.ao = (unsigned)t * (256u * 1024u); u.rows = nullptr; u.bo = ((unsigned)e * 1024u + (unsigned)pn * 256u) * 1024u; }
        return true;
    }
};

struct EpiInProj {
    bf16_t* qkv; const float* b_in; const float* rope; float* ksum; float descale;
    __device__ __forceinline__ void operator()(const f32x4 (&acc)[2][2][4][2], const Unit& u, int wr, int wc, int fr, int fq) const {
        const int pn = u.pn;
        const int colb = 256 * pn + 64 * wc + 8 * fq;
        const bool do_rope = !(pn >= 7 || (pn == 2 && wc >= 2));
        const bool is_q = (pn < 2) || (pn == 3) || (pn == 4);
        const bool is_kb = (pn == 5) || (pn == 6);
        const float sc = is_q ? C2 : 1.0f;
        f32x4 bv[2][2];
#pragma unroll
        for (int bj = 0; bj < 2; ++bj)
#pragma unroll
            for (int n = 0; n < 2; ++n) bv[bj][n] = *(const f32x4*)(b_in + colb + 32 * bj + 4 * n);
        f32x4 ks[2][2];
#pragma unroll
        for (int bj = 0; bj < 2; ++bj)
#pragma unroll
            for (int n = 0; n < 2; ++n) ks[bj][n] = (f32x4){0.f, 0.f, 0.f, 0.f};
#pragma unroll
        for (int ai = 0; ai < 2; ++ai)
#pragma unroll
            for (int m = 0; m < 4; ++m) {
                const int row = u.pm * 256 + ai * 128 + wr * 64 + m * 16 + fr;
                const int pos = row & (SEQ - 1);
                f32x4 o1[2], o2[2];
#pragma unroll
                for (int n = 0; n < 2; ++n) { o1[n] = acc[ai][0][m][n] * descale + bv[0][n]; o2[n] = acc[ai][1][m][n] * descale + bv[1][n]; }
                if (do_rope) {
                    const float* rp = rope + pos * 64 + 8 * fq;
#pragma unroll
                    for (int n = 0; n < 2; ++n) { const f32x4 c = *(const f32x4*)(rp + 4 * n), s = *(const f32x4*)(rp + 32 + 4 * n);
                        const f32x4 a = o1[n], b = o2[n]; o1[n] = a * c - b * s; o2[n] = b * c + a * s; }
                }
                if (is_kb) {
#pragma unroll
                    for (int n = 0; n < 2; ++n) { ks[0][n] += o1[n]; ks[1][n] += o2[n]; }
                }
                bf16_t* rowp = qkv + (size_t)row * INW + colb;
                u32x4 w1, w2;
                w1.x = cvtpk(o1[0][0] * sc, o1[0][1] * sc); w1.y = cvtpk(o1[0][2] * sc, o1[0][3] * sc); w1.z = cvtpk(o1[1][0] * sc, o1[1][1] * sc); w1.w = cvtpk(o1[1][2] * sc, o1[1][3] * sc);
                w2.x = cvtpk(o2[0][0] * sc, o2[0][1] * sc); w2.y = cvtpk(o2[0][2] * sc, o2[0][3] * sc); w2.z = cvtpk(o2[1][0] * sc, o2[1][1] * sc); w2.w = cvtpk(o2[1][2] * sc, o2[1][3] * sc);
                *(u32x4*)(rowp) = w1; *(u32x4*)(rowp + 32) = w2;
            }
        if (is_kb) {
            float* kd = ksum + (size_t)u.pm * 512 + 256 * (pn - 5) + 64 * wc + 8 * fq;
#pragma unroll
            for (int bj = 0; bj < 2; ++bj)
#pragma unroll
                for (int n = 0; n < 2; ++n)
#pragma unroll
                    for (int j = 0; j < 4; ++j) {
                        float v = ks[bj][n][j];
                        v += swz_xor<1>(v); v += swz_xor<2>(v); v += swz_xor<4>(v); v += swz_xor<8>(v);
                        if (fr == 0) atomicAdd(kd + 32 * bj + 4 * n + j, v);
                    }
        }
    }
};
struct EpiOutProj {
    bf16_t* y; const float* b_out; const float* x;
    __device__ __forceinline__ void operator()(const f32x4 (&acc)[2][2][4][2], const Unit& u, int wr, int wc, int fr, int fq) const {
        const int col0 = u.pn * 256 + wc * 32 + 8 * fq;
        f32x4 bv[2][2];
#pragma unroll
        for (int bj = 0; bj < 2; ++bj)
#pragma unroll
            for (int n = 0; n < 2; ++n) bv[bj][n] = *(const f32x4*)(b_out + col0 + 128 * bj + 4 * n);
#pragma unroll
        for (int ai = 0; ai < 2; ++ai)
#pragma unroll
            for (int m = 0; m < 4; ++m) {
                const size_t off = (size_t)(u.pm * 256 + ai * 128 + wr * 64 + m * 16 + fr) * D + col0;
#pragma unroll
                for (int bj = 0; bj < 2; ++bj) {
                    const f32x4 x0 = *(const f32x4*)(x + off + 128 * bj), x1 = *(const f32x4*)(x + off + 128 * bj + 4);
                    const f32x4 v0 = acc[ai][bj][m][0] + bv[bj][0] + x0 * DN_ALPHA, v1 = acc[ai][bj][m][1] + bv[bj][1] + x1 * DN_ALPHA;
                    u32x4 w; w.x = cvtpk(v0[0], v0[1]); w.y = cvtpk(v0[2], v0[3]); w.z = cvtpk(v1[0], v1[1]); w.w = cvtpk(v1[2], v1[3]);
                    *(u32x4*)(y + off + 128 * bj) = w; }
                if (m & 1) asm volatile("" ::: "memory");
            }
    }
};
struct EpiSwiglu {
    unsigned char* act8; const float* b1;
    __device__ __forceinline__ void operator()(const f32x4 (&acc)[2][2][4][2], const Unit& u, int wr, int wc, int fr, int fq) const {
        const int a0 = 128 * u.pn + 32 * wc + 8 * fq;
        const float* bp = b1 + (size_t)u.e * 2048 + 2 * a0;
        f32x4 bb[4];
#pragma unroll
        for (int q = 0; q < 4; ++q) bb[q] = *(const f32x4*)(bp + 4 * q);
        unsigned char* tile = act8 + (size_t)u.pm * (256 * 1024);
#pragma unroll
        for (int ai = 0; ai < 2; ++ai)
#pragma unroll
            for (int m = 0; m < 4; ++m) {
                const int row = ai * 128 + wr * 64 + m * 16 + fr;
                float r[8];
#pragma unroll
                for (int n = 0; n < 2; ++n)
#pragma unroll
                    for (int j = 0; j < 4; ++j) {
                        const int q = 4 * n + j;
                        float g = acc[ai][0][m][n][j] * (1.0f / W_SCALE) + bb[q >> 1][(2 * q) & 3];
                        float l = acc[ai][1][m][n][j] * (1.0f / W_SCALE) + bb[q >> 1][((2 * q) & 3) + 1];
                        g = fminf(g, 7.0f); l = fminf(fmaxf(l, -7.0f), 7.0f);
                        const float sg = __builtin_amdgcn_rcpf(1.0f + __builtin_amdgcn_exp2f(-1.702f * LOG2E * g));
                        r[q] = g * sg * (l + 1.0f) * ACT_SCALE;
                    }
                u32x2 w; w.x = pk4_fp8(r[0], r[1], r[2], r[3]); w.y = pk4_fp8(r[4], r[5], r[6], r[7]);
                *(u32x2*)(tile + (size_t)row * 1024 + (size_t)a0) = w;
            }
    }
};
struct EpiDown {
    bf16_t* yb; const float* b2;
    __device__ __forceinline__ void operator()(const f32x4 (&acc)[2][2][4][2], const Unit& u, int wr, int wc, int fr, int fq) const {
        const int col0 = u.pn * 256 + wc * 32 + 8 * fq;
        const float* bp = b2 + (size_t)u.e * 1024 + col0;
        f32x4 bv[2][2];
#pragma unroll
        for (int bj = 0; bj < 2; ++bj)
#pragma unroll
            for (int n = 0; n < 2; ++n) bv[bj][n] = *(const f32x4*)(bp + 128 * bj + 4 * n);
#pragma unroll
        for (int ai = 0; ai < 2; ++ai)
#pragma unroll
            for (int m = 0; m < 4; ++m) {
                bf16_t* rowp = yb + (size_t)(u.pm * 256 + ai * 128 + wr * 64 + m * 16 + fr) * 1024 + col0;
#pragma unroll
                for (int bj = 0; bj < 2; ++bj) { const f32x4 v0 = acc[ai][bj][m][0] * (1.0f / (W_SCALE * ACT_SCALE)) + bv[bj][0], v1 = acc[ai][bj][m][1] * (1.0f / (W_SCALE * ACT_SCALE)) + bv[bj][1];
                    u32x4 w; w.x = cvtpk(v0[0], v0[1]); w.y = cvtpk(v0[2], v0[3]); w.z = cvtpk(v1[0], v1[1]); w.w = cvtpk(v1[2], v1[3]);
                    *(u32x4*)(rowp + 128 * bj) = w; }
            }
    }
};
}

namespace att {
constexpr int PITCH = INW, SLOTB = 8192;
constexpr int NSLOT = 4;
constexpr int L_K = 0, L_V = NSLOT * SLOTB, L_WS = 2 * NSLOT * SLOTB, L_KS = L_WS + 2048, L_OST = L_KS + 2048, L_END = L_OST + 8 * 4096;
static_assert(NSLOT == 4 && L_END <= 131072, "attention LDS map");
constexpr float NEG = -1.0e30f, M0 = -1.0e20f, THR = 8.0f;
typedef LAS const char* lds_cptr;
__device__ __forceinline__ int crow(int r, int hi) { return (r & 3) + 8 * (r >> 2) + 4 * hi; }
__device__ __forceinline__ void glds16(const void* gsrc, unsigned lds_dst) { unsigned keep;
    asm volatile("s_mov_b32 %0, m0\n\ts_mov_b32 m0, %2\n\ts_nop 0\n\tglobal_load_lds_dwordx4 %1, off\n\ts_mov_b32 m0, %0" : "=&s"(keep) : "v"(gsrc), "s"(lds_dst) : "memory"); }
#define ATT_WAIT_BAR0() asm volatile("s_waitcnt vmcnt(0) lgkmcnt(0)\n\ts_barrier" ::: "memory")
#define ATT_WAIT_BARN(N) asm volatile("s_waitcnt vmcnt(" #N ") lgkmcnt(0)\n\ts_barrier" ::: "memory")
#define ATT_SBAR() __builtin_amdgcn_sched_barrier(0)

__device__ __forceinline__ void qkt(f32x16& p0, f32x16& p1, lds_cptr kb, const bf16x8* qr, const f32x16& negm) {
#pragma unroll
    for (int d0 = 0; d0 < 4; ++d0) {
        const bf16x8 b0 = *(const LAS bf16x8*)(kb + d0 * 2048);
        const bf16x8 b1 = *(const LAS bf16x8*)(kb + d0 * 2048 + 512);
        if (d0 == 0) { p0 = __builtin_amdgcn_mfma_f32_32x32x16_bf16(b0, qr[0], negm, 0, 0, 0); p1 = __builtin_amdgcn_mfma_f32_32x32x16_bf16(b1, qr[0], negm, 0, 0, 0); }
        else { p0 = __builtin_amdgcn_mfma_f32_32x32x16_bf16(b0, qr[d0], p0, 0, 0, 0); p1 = __builtin_amdgcn_mfma_f32_32x32x16_bf16(b1, qr[d0], p1, 0, 0, 0); }
    }
}
__device__ __forceinline__ float rowmax32(const f32x16& p0, const f32x16& p1) {
    float a = fmaxf(p0[0], p1[0]);
#pragma unroll
    for (int r = 1; r < 16; ++r) a = fmaxf(a, fmaxf(p0[r], p1[r]));
    auto rr = __builtin_amdgcn_permlane32_swap(__float_as_uint(a), __float_as_uint(a), false, false);
    return fmaxf(__uint_as_float(rr[0]), __uint_as_float(rr[1]));
}
__device__ __forceinline__ void pv(f32x16* o, int vb, bf16x8 pa0, bf16x8 pa1, bf16x8 pa2, bf16x8 pa3) {
#pragma unroll
    for (int d0 = 0; d0 < 2; ++d0) { s16x4 lo[4], hi[4];
#pragma unroll
        for (int ks = 0; ks < 4; ++ks) {
            asm volatile("ds_read_b64_tr_b16 %0,%1 offset:%c2" : "=&v"(lo[ks]) : "v"(vb), "i"(d0 * 4096 + ks * 1024) : "memory");
            asm volatile("ds_read_b64_tr_b16 %0,%1 offset:%c2" : "=&v"(hi[ks]) : "v"(vb), "i"(d0 * 4096 + ks * 1024 + 512) : "memory"); }
        asm volatile("s_waitcnt lgkmcnt(0)" ::: "memory"); ATT_SBAR();
#define ATT_PK(k) (bf16x8){lo[k][0], lo[k][1], lo[k][2], lo[k][3], hi[k][0], hi[k][1], hi[k][2], hi[k][3]}
        o[d0] = __builtin_amdgcn_mfma_f32_32x32x16_bf16(pa0, ATT_PK(0), o[d0], 0, 0, 0);
        o[d0] = __builtin_amdgcn_mfma_f32_32x32x16_bf16(pa1, ATT_PK(1), o[d0], 0, 0, 0);
        o[d0] = __builtin_amdgcn_mfma_f32_32x32x16_bf16(pa2, ATT_PK(2), o[d0], 0, 0, 0);
        o[d0] = __builtin_amdgcn_mfma_f32_32x32x16_bf16(pa3, ATT_PK(3), o[d0], 0, 0, 0);
#undef ATT_PK
    }
}

template <bool MOBA>
__device__ __forceinline__ void attn_item(char* shm, const bf16_t* __restrict__ qkv, bf16_t* __restrict__ aout, int b, int hh, int qb, const float* __restrict__ sinks, const float* __restrict__ ksum) {
    int tid = threadIdx.x; asm volatile("" : "+v"(tid));
    const int lane = tid & 63, r32 = lane & 31, hi = lane >> 5; const int wid = __builtin_amdgcn_readfirstlane(tid >> 6);
    const long rowbase = (long)b * SEQ;
    int qa, qcol, kcol, vcol, ocol, kt0, kt1;
    if (MOBA) { qa = 256 * qb + 32 * wid; qcol = 768 + 64 * hh; kcol = 1280 + 64 * hh; vcol = 1792 + 64 * hh; ocol = 512 + 64 * hh; kt0 = 0; kt1 = 4 * qb + 4; }
    else { const int g = wid >> 1; qa = 64 * qb + 32 * (wid & 1); qcol = (4 * hh + g) * 64; kcol = 512 + 64 * hh; vcol = 640 + 64 * hh; ocol = qcol; kt0 = qb - 2 < 0 ? 0 : qb - 2; kt1 = qb + 1; }
    const bf16_t* Qw = qkv + (rowbase + qa) * PITCH + qcol;
    const bf16_t* Kh = qkv + rowbase * PITCH + kcol; const bf16_t* Vh = qkv + rowbase * PITCH + vcol;
    const unsigned lds0 = (unsigned)(uintptr_t)shm;
    float* wsf = (float*)(shm + L_WS) + wid * 64;
    const bf16_t* ksrc = Kh + (long)lane * PITCH + wid * 8;
    const bf16_t* vsrc = Vh + (long)(16 * (wid & 3) + (lane >> 2)) * PITCH + (wid >> 2) * 32 + (lane & 3) * 8;
    const unsigned kdst = lds0 + L_K + wid * 1024, vdst = lds0 + L_V + wid * 1024;
#define ATT_DMA_K(t, slot) glds16(ksrc + (long)(t) * 64 * PITCH, (unsigned)__builtin_amdgcn_readfirstlane(kdst + (slot)))
#define ATT_DMA_V(t, slot) glds16(vsrc + (long)(t) * 64 * PITCH, (unsigned)__builtin_amdgcn_readfirstlane(vdst + (slot)))
    const int vb0 = (int)(lds0 + L_V) + ((lane >> 4) & 1) * 32 + (lane & 3) * 8 + (4 * hi + ((lane & 15) >> 2)) * 64;
    const lds_cptr shm3 = (lds_cptr)shm; const lds_cptr kp0 = shm3 + L_K + hi * 1024 + r32 * 16;
    const int NT = kt1 - kt0;
    ATT_DMA_K(kt0, 0); ATT_DMA_V(kt0, 0);
    if (NT > 1) { ATT_DMA_K(kt0 + 1, SLOTB); ATT_DMA_V(kt0 + 1, SLOTB); }
    if (NT > 2) { ATT_DMA_K(kt0 + 2, 2 * SLOTB); ATT_DMA_V(kt0 + 2, 2 * SLOTB); }
    if (MOBA) { float* ksl = (float*)(shm + L_KS); ksl[tid] = ksum[((size_t)b * 8 + (tid >> 6)) * 512 + 64 * hh + (tid & 63)]; }
    bf16x8 qr[4];
#pragma unroll
    for (int d0 = 0; d0 < 4; ++d0) qr[d0] = *reinterpret_cast<const bf16x8*>(&Qw[(long)r32 * PITCH + d0 * 16 + hi * 8]);
    float m_run, l_run;
    if (MOBA) { m_run = M0; l_run = 0.f; }
    else { m_run = sinks[4 * hh + (wid >> 1)] * LOG2E; l_run = (hi == 0) ? 1.0f : 0.0f; }
    f32x16 negm;
#pragma unroll
    for (int r = 0; r < 16; ++r) negm[r] = MOBA ? 0.f : -m_run;
    f32x16 o[2]; o[0] = f32x16{}; o[1] = f32x16{};
    ATT_WAIT_BAR0();
    unsigned sel = 0u;
    if (MOBA) {
        if (qb <= 3) sel = (1u << qb) - 1u;
        else {
            const float* ksl = (const float*)(shm + L_KS);
            float gv[7];
#pragma unroll
            for (int i = 0; i < 7; ++i) {
                float s = 0.f;
#pragma unroll
                for (int d0 = 0; d0 < 4; ++d0) {
                    const f32x4 k0 = *(const f32x4*)(ksl + i * 64 + 16 * d0 + 8 * hi), k1 = *(const f32x4*)(ksl + i * 64 + 16 * d0 + 8 * hi + 4);
#pragma unroll
                    for (int jj = 0; jj < 4; ++jj) { s += bf2f((unsigned short)qr[d0][jj]) * k0[jj]; s += bf2f((unsigned short)qr[d0][4 + jj]) * k1[jj]; }
                }
                auto rr = __builtin_amdgcn_permlane32_swap(__float_as_uint(s), __float_as_uint(s), false, false);
                s = __uint_as_float(rr[0]) + __uint_as_float(rr[1]);
                gv[i] = (i < qb) ? s : -INFINITY;
            }
#pragma unroll
            for (int rk = 0; rk < 3; ++rk) { float best = -INFINITY; int bi = 0;
#pragma unroll
                for (int i = 0; i < 7; ++i) { const bool c = (((sel >> i) & 1u) == 0u) && (gv[i] > best); best = c ? gv[i] : best; bi = c ? i : bi; }
                sel |= 1u << bi; }
        }
    }
    for (int it = 0; it < NT; ++it) {
        const int kt = kt0 + it; const int cur = (it & (NSLOT - 1)) * SLOTB;
        if (it + 3 < NT) { const int sl = ((it + 3) & (NSLOT - 1)) * SLOTB; ATT_DMA_K(kt + 3, sl); ATT_DMA_V(kt + 3, sl); }
        bool need; bool on = true;
        if (MOBA) { if (kt < 4 * qb) { on = ((sel >> (kt >> 2)) & 1u) != 0u; need = __any(on) != 0; } else need = (64 * kt <= qa + 31); }
        else need = (64 * kt + 63 >= qa - 127) && (64 * kt <= qa + 31);
        if (need) {
            f32x16 p0, p1; qkt(p0, p1, kp0 + cur, qr, negm);
            if (MOBA && kt < 4 * qb) {
                if (!__all(on)) {
#pragma unroll
                    for (int r = 0; r < 16; ++r) { p0[r] = on ? p0[r] : NEG; p1[r] = on ? p1[r] : NEG; }
                }
            } else {
                const bool edge = MOBA ? (64 * kt + 63 > qa) : !((64 * kt + 63 <= qa) && (qa + 31 - 64 * kt <= 127));
                if (edge) {
                    const int dq = qa + r32 - 64 * kt - 4 * hi;
#pragma unroll
                    for (int r = 0; r < 16; ++r) { const int d0_ = dq - ((r & 3) + 8 * (r >> 2)), d1_ = d0_ - 32;
                        const bool v0 = MOBA ? (d0_ >= 0) : ((unsigned)d0_ < 128u), v1 = MOBA ? (d1_ >= 0) : ((unsigned)d1_ < 128u);
                        p0[r] = v0 ? p0[r] : NEG; p1[r] = v1 ? p1[r] : NEG; }
                }
            }
            const float rm = rowmax32(p0, p1);
            const bool sent = (m_run <= M0), live = (rm > 0.5f * NEG);
            const bool upd = sent ? live : (rm > THR);
            if (__any(upd)) {
                const float dl = sent ? (live ? rm : 0.f) : fmaxf(rm, 0.f);
                const float f = sent ? 1.0f : __builtin_amdgcn_exp2f(-dl);
                m_run = sent ? (live ? rm : m_run) : (m_run + dl);
                const float nm = (m_run <= M0) ? 0.f : -m_run;
#pragma unroll
                for (int r = 0; r < 16; ++r) { p0[r] -= dl; p1[r] -= dl; negm[r] = nm; }
                l_run *= f;
                if (hi == 0) wsf[r32] = f;
                LDS_WAIT();
#pragma unroll
                for (int r = 0; r < 16; ++r) { const float fr_ = wsf[crow(r, hi)]; o[0][r] *= fr_; o[1][r] *= fr_; }
            }
            float sacc = 0.f;
#pragma unroll
            for (int r = 0; r < 16; ++r) { p0[r] = __builtin_amdgcn_exp2f(p0[r]); p1[r] = __builtin_amdgcn_exp2f(p1[r]); sacc += p0[r] + p1[r]; }
            l_run += sacc;
            u32x4 pw0, pw1, pw2, pw3;
            pw0 = (u32x4){cvtpk(p0[0], p0[1]), cvtpk(p0[2], p0[3]), cvtpk(p0[4], p0[5]), cvtpk(p0[6], p0[7])};
            pw1 = (u32x4){cvtpk(p0[8], p0[9]), cvtpk(p0[10], p0[11]), cvtpk(p0[12], p0[13]), cvtpk(p0[14], p0[15])};
            pw2 = (u32x4){cvtpk(p1[0], p1[1]), cvtpk(p1[2], p1[3]), cvtpk(p1[4], p1[5]), cvtpk(p1[6], p1[7])};
            pw3 = (u32x4){cvtpk(p1[8], p1[9]), cvtpk(p1[10], p1[11]), cvtpk(p1[12], p1[13]), cvtpk(p1[14], p1[15])};
            ATT_SBAR();
            pv(o, vb0 + cur, __builtin_bit_cast(bf16x8, pw0), __builtin_bit_cast(bf16x8, pw1), __builtin_bit_cast(bf16x8, pw2), __builtin_bit_cast(bf16x8, pw3));
        }
        if (it + 1 < NT) {
            if (it + 3 < NT) ATT_WAIT_BARN(4); else if (it + 2 < NT) ATT_WAIT_BARN(2); else ATT_WAIT_BAR0();
        }
    }
    { auto rr = __builtin_amdgcn_permlane32_swap(__float_as_uint(l_run), __float_as_uint(l_run), false, false); l_run = __uint_as_float(rr[0]) + __uint_as_float(rr[1]); }
    if (hi == 0) wsf[32 + r32] = l_run;
    LDS_WAIT();
    float rli[16];
#pragma unroll
    for (int r = 0; r < 16; ++r) rli[r] = __builtin_amdgcn_rcpf(wsf[32 + crow(r, hi)]);
    bf16_t* Ow = aout + (rowbase + qa) * D + ocol;
    { bf16_t* stg = (bf16_t*)(shm + L_OST) + wid * 2048;
#pragma unroll
        for (int r = 0; r < 16; ++r) { const int orow = crow(r, hi);
#pragma unroll
            for (int d0 = 0; d0 < 2; ++d0) stg[orow * 64 + d0 * 32 + r32] = (bf16_t)f2bf(o[d0][r] * rli[r]); }
        LDS_WAIT();
#pragma unroll
        for (int i = 0; i < 4; ++i) { const int row = i * 8 + (lane >> 3), ch = lane & 7; const u32x4 v = *(const u32x4*)(stg + row * 64 + ch * 8); *(u32x4*)(Ow + (long)row * D + ch * 8) = v; } }
    asm volatile("s_waitcnt lgkmcnt(0)\n\ts_barrier" ::: "memory");
#undef ATT_DMA_K
#undef ATT_DMA_V
}
}

__device__ __forceinline__ void sincos_d(double a, double& s, double& c) {
    const double q = __builtin_rint(a * 0.63661977236758134308);
    double r = __builtin_fma(-q, 1.57079632679489655800e+00, a);
    r = __builtin_fma(-q, 6.12323399573676603587e-17, r);
    const double r2 = r * r;
    double sp = -1.0 / 1307674368000.0;
    sp = sp * r2 + 1.0 / 6227020800.0; sp = sp * r2 - 1.0 / 39916800.0; sp = sp * r2 + 1.0 / 362880.0; sp = sp * r2 - 1.0 / 5040.0; sp = sp * r2 + 1.0 / 120.0; sp = sp * r2 - 1.0 / 6.0;
    const double sr = r + r * r2 * sp;
    double cp = 1.0 / 20922789888000.0;
    cp = cp * r2 - 1.0 / 87178291200.0; cp = cp * r2 + 1.0 / 479001600.0; cp = cp * r2 - 1.0 / 3628800.0; cp = cp * r2 + 1.0 / 40320.0; cp = cp * r2 - 1.0 / 720.0; cp = cp * r2 + 1.0 / 24.0; cp = cp * r2 - 0.5;
    const double cr = 1.0 + r2 * cp;
    const int n = ((int)q) & 3;
    s = (n == 0) ? sr : (n == 1) ? cr : (n == 2) ? -sr : -cr;
    c = (n == 0) ? cr : (n == 1) ? -sr : (n == 2) ? -cr : sr;
}
__device__ __forceinline__ int sigma_col(int p, int mode) {
    if (mode == 0) return (p & ~255) + 64 * ((p >> 5) & 3) + 32 * ((p >> 7) & 1) + pg8::perm32(p & 31);
    if (mode == 1) return (p & ~31) + pg8::perm32(p & 31);
    const int pn = p >> 8, q = p & 255; return 2 * (128 * pn + 32 * ((q >> 5) & 3) + pg8::perm32(q & 31)) + (q >> 7);
}
__device__ __forceinline__ void p0_transpose_item(const float* __restrict__ W, int N, bf16_t* __restrict__ WT, int mode, LAS float* scr, int item, int lane) {
    const int nblk = N / 32, kb = item / nblk, nb = item % nblk, k0 = 64 * kb, p0 = 32 * nb;
    const int sc = sigma_col(p0 + (lane & 31), mode);
#pragma unroll 8
    for (int i = 0; i < 32; ++i) { const int kk = 2 * i + (lane >> 5); scr[kk * 33 + (lane & 31)] = W[(size_t)(k0 + kk) * N + sc]; }
    LDS_WAIT(); asm volatile("" ::: "memory");
    const int c = lane & 7;
#pragma unroll
    for (int j = 0; j < 4; ++j) { const int n = (lane >> 3) + 8 * j; const LAS float* s = scr + (8 * c) * 33 + n;
        u32x4 o; o.x = cvtpk(s[0 * 33], s[1 * 33]); o.y = cvtpk(s[2 * 33], s[3 * 33]); o.z = cvtpk(s[4 * 33], s[5 * 33]); o.w = cvtpk(s[6 * 33], s[7 * 33]);
        *(u32x4*)(WT + (size_t)(p0 + n) * 1024 + k0 + 8 * c) = o; }
    LDS_WAIT(); asm volatile("" ::: "memory");
}

__device__ __forceinline__ void p0_transpose_item_fp8(const float* __restrict__ W, int N, unsigned char* __restrict__ WT, int mode, float scale, LAS float* scr, int item, int lane) {
    const int nblk = N / 32, kb = item / nblk, nb = item % nblk, k0 = 64 * kb, p0 = 32 * nb;
    const int sc = sigma_col(p0 + (lane & 31), mode);
#pragma unroll 8
    for (int i = 0; i < 32; ++i) { const int kk = 2 * i + (lane >> 5); scr[kk * 33 + (lane & 31)] = W[(size_t)(k0 + kk) * N + sc] * scale; }
    LDS_WAIT(); asm volatile("" ::: "memory");
    const int c = lane & 7;
#pragma unroll
    for (int j = 0; j < 4; ++j) { const int n = (lane >> 3) + 8 * j; const LAS float* s = scr + (8 * c) * 33 + n;
        u32x2 o; o.x = pk4_fp8(s[0 * 33], s[1 * 33], s[2 * 33], s[3 * 33]); o.y = pk4_fp8(s[4 * 33], s[5 * 33], s[6 * 33], s[7 * 33]);
        *(u32x2*)(WT + (size_t)(p0 + n) * 1024 + k0 + 8 * c) = o; }
    LDS_WAIT(); asm volatile("" ::: "memory");
}


#define XB_TMO      128
#define XB_XCNT(j)  (256  + 64 * (j))
#define XB_XSUB(j)  (1280 + 64 * (j))
#define XB_XGEN(j)  (2304 + 64 * (j))
#define XB_TOP      3328
#define XB_TOPGEN   3392
#define XCD_BAR_WORDS 3456
#define XB_SPIN_CAP (1u << 18)
__device__ __forceinline__ unsigned xb_ld(unsigned* p)              { return __hip_atomic_load(p, __ATOMIC_RELAXED, __HIP_MEMORY_SCOPE_AGENT); }
__device__ __forceinline__ unsigned xb_add(unsigned* p, unsigned v) { return __hip_atomic_fetch_add(p, v, __ATOMIC_RELAXED, __HIP_MEMORY_SCOPE_AGENT); }
__device__ __forceinline__ unsigned xb_xcc_id() { return (unsigned)__builtin_amdgcn_s_getreg((3 << 11) | 20) & 0xFu; }
#define XB_SPIN(cond, bar) do { unsigned _sp = 0; while (cond) { __builtin_amdgcn_s_sleep(1); \
    if ((++_sp & 255u) == 0u) { if (xb_ld(&(bar)[XB_TMO])) break; if (_sp > XB_SPIN_CAP) { atomicAdd(&(bar)[XB_TMO], 1u); break; } } } } while (0)
struct XcdBarrier { unsigned* bar; unsigned x; volatile LAS unsigned* st; };
__device__ __forceinline__ XcdBarrier xcd_barrier_post(unsigned* bar, volatile LAS unsigned* st) {
    XcdBarrier b; b.bar = bar; b.x = xb_xcc_id(); b.st = st;
    if (threadIdx.x == 0) (void)xb_add(&bar[XB_XCNT(b.x)], 1u);
    return b;
}
__device__ __forceinline__ void xcd_barrier_complete(unsigned* bar, unsigned x, unsigned& nloc, unsigned& nx) {
    const unsigned G = gridDim.x * gridDim.y * gridDim.z;
    unsigned sum, cnt, mine, sp = 0u;
    for (;;) {
        sum = 0u; cnt = 0u; mine = 0u;
#pragma unroll
        for (unsigned j = 0; j < 16; ++j) { const unsigned c = xb_ld(&bar[XB_XCNT(j)]); sum += c; cnt += (c > 0u) ? 1u : 0u; mine = (j == x) ? c : mine; }
        if (sum == G) break;
        __builtin_amdgcn_s_sleep(1);
        if ((++sp & 255u) == 0u) { if (xb_ld(&bar[XB_TMO])) break; if (sp > XB_SPIN_CAP) { atomicAdd(&bar[XB_TMO], 1u); break; } }
    }
    nloc = mine > 0u ? mine : 1u; nx = cnt > 0u ? cnt : 1u;
}
__device__ __forceinline__ void xcd_barrier(const XcdBarrier& b) {
    asm volatile("s_waitcnt vmcnt(0)" ::: "memory");
    __syncthreads();
    if (threadIdx.x == 0) {
        unsigned* bar = b.bar;
        __builtin_amdgcn_s_waitcnt(0);
        unsigned nloc = b.st[0], nx = b.st[1];
        if (nloc == 0u) { xcd_barrier_complete(bar, b.x, nloc, nx); b.st[0] = nloc; b.st[1] = nx; }
        const unsigned old = xb_add(&bar[XB_XSUB(b.x)], 1u);
        const unsigned gen = old / nloc;
        if (old + 1u == (gen + 1u) * nloc) {
            __builtin_amdgcn_fence(__ATOMIC_RELEASE, "agent");
            asm volatile("s_waitcnt vmcnt(0)" ::: "memory");
            const unsigned og = xb_add(&bar[XB_TOP], 1u);
            const unsigned tg = og / nx;
            if (og + 1u == (tg + 1u) * nx) xb_add(&bar[XB_TOPGEN], 1u);
            else XB_SPIN(xb_ld(&bar[XB_TOPGEN]) == tg, bar);
            __builtin_amdgcn_fence(__ATOMIC_ACQUIRE, "agent");
            xb_add(&bar[XB_XGEN(b.x)], 1u);
            asm volatile("s_waitcnt vmcnt(0)" ::: "memory");
        } else {
            XB_SPIN(xb_ld(&bar[XB_XGEN(b.x)]) == gen, bar);
            __builtin_amdgcn_fence(__ATOMIC_ACQUIRE, "agent");
            asm volatile("s_waitcnt vmcnt(0)" ::: "memory");
        }
    }
    __syncthreads();
}

__global__ void __launch_bounds__(NTHREADS, 2) fwd_megakernel(Params p_arg) {
    extern __shared__ __attribute__((aligned(16))) unsigned char lds_raw[];
    LAS unsigned char* lds = (LAS unsigned char*)lds_raw;
    cg::grid_group grid = cg::this_grid();
#define PHASE_IDS() int tid = threadIdx.x; asm volatile("" : "+v"(tid)); const int lane = tid & 63, wave = __builtin_amdgcn_readfirstlane(tid >> 6); (void)lane; (void)wave
    const int G = gridDim.x, bx = blockIdx.x;
    typedef const __attribute__((address_space(4))) Params* KParams;
    const KParams kp0 = (KParams)__builtin_amdgcn_kernarg_segment_ptr();
#define PHASE_PTRS() KParams _kp = kp0; asm volatile("" : "+s"(_kp)); Params p; p.x = _kp->x; p.w_in = _kp->w_in; p.b_in = _kp->b_in; p.sinks = _kp->sinks; p.w_out = _kp->w_out; p.b_out = _kp->b_out; p.ln1_g = _kp->ln1_g; p.ln1_b = _kp->ln1_b; \
    p.w_router = _kp->w_router; p.b_router = _kp->b_router; p.w1 = _kp->w1; p.b1 = _kp->b1; p.w2 = _kp->w2; p.b2 = _kp->b2; p.ln2_g = _kp->ln2_g; p.ln2_b = _kp->ln2_b; p.out = _kp->out; p.ws = _kp->ws; unsigned char* const ws = p.ws; \
    unsigned* const ctl = (unsigned*)(ws + WS_CTL); float* const ksum = (float*)(ws + WS_KSUM); float* const rope = (float*)(ws + WS_ROPE); \
    bf16_t* const w_in_t = (bf16_t*)(ws + WS_WIN_T); bf16_t* const w_out_t = (bf16_t*)(ws + WS_WOUT_T); \
    unsigned char* const w1_8 = ws + WS_W1_8; unsigned char* const w2_8 = ws + WS_W2_8; unsigned char* const x1_8 = ws + WS_X1_8; unsigned char* const act8 = ws + WS_ACT8; \
    int* const cnt_blk = (int*)(ws + WS_CNT); int* const tile_e = (int*)(ws + WS_TILE_E); bf16_t* const wr_hi = (bf16_t*)(ws + WS_WR_HI); bf16_t* const wr_lo = (bf16_t*)(ws + WS_WR_LO); \
    int* const tok = (int*)(ws + WS_TOK); int* const asg_e = (int*)(ws + WS_ASG_E); float* const asg_g = (float*)(ws + WS_ASG_G); int* const asg_d = (int*)(ws + WS_ASG_D); \
    bf16_t* const x1b = (bf16_t*)(ws + WS_X1B); bf16_t* const xb = (bf16_t*)(ws + WS_XB); bf16_t* const attn_o = xb; bf16_t* const qkv = (bf16_t*)(ws + WS_QKV); bf16_t* const yb = (bf16_t*)(ws + WS_YB); \
    (void)ctl; (void)ksum; (void)rope; (void)w_in_t; (void)w_out_t; (void)w1_8; (void)w2_8; (void)x1_8; (void)act8; (void)cnt_blk; (void)tile_e; (void)wr_hi; (void)wr_lo; (void)tok; (void)asg_e; (void)asg_g; (void)asg_d; \
    (void)x1b; (void)xb; (void)attn_o; (void)qkv; (void)yb
    if (threadIdx.x < 2) ((LAS unsigned*)(lds + LDS_BARST))[threadIdx.x] = 0u;
    __syncthreads();
    XcdBarrier xbar;
    { PHASE_PTRS(); xbar = xcd_barrier_post(ctl + CW_BAR, (volatile LAS unsigned*)(lds + LDS_BARST)); }

    REP(0) {
        PHASE_IDS(); PHASE_PTRS();
        const long gt = (long)bx * NTHREADS + tid, gsz = (long)G * NTHREADS;
        for (long i = gt; i < 2048 * 32; i += gsz) {
            const int pos = (int)(i >> 5), k = (int)(i & 31);
            double inv = 1.0; for (int q = 0; q < k; ++q) inv *= 0.7498942093324559;
            double s, c; sincos_d((double)pos * inv, s, c);
            rope[pos * 64 + k] = (float)c; rope[pos * 64 + 32 + k] = (float)s;
        }
        for (long i = gt; i < 32 * 1024; i += gsz) {
            const int e = (int)(i >> 10), k = (int)(i & 1023); const float w = p.w_router[k * 32 + e];
            const unsigned h = f2bf(w); wr_hi[i] = (bf16_t)h; wr_lo[i] = (bf16_t)f2bf(w - bf2f(h));
        }
        LAS float* scr = (LAS float*)(lds + wave * 16384);
        const int gw = bx * 8 + wave, NGW = G * 8;
        constexpr int I_IN = 16 * (INW / 32), I_OUT = 16 * 32, I_W1 = 16 * 64, I_W2 = 16 * 32;
        constexpr int NITEMS = I_IN + I_OUT + NE * I_W1 + NE * I_W2;
        for (int it = gw; it < NITEMS; it += NGW) {
            int r = it;
#if INPROJ_FP8
            if (r < I_IN) { p0_transpose_item_fp8(p.w_in, INW, (unsigned char*)w_in_t, 0, WIN_SCALE, scr, r, lane); continue; } r -= I_IN;
#else
            if (r < I_IN) { p0_transpose_item(p.w_in, INW, w_in_t, 0, scr, r, lane); continue; } r -= I_IN;
#endif
            if (r < I_OUT) { p0_transpose_item(p.w_out, 1024, w_out_t, 1, scr, r, lane); continue; } r -= I_OUT;
            if (r < NE * I_W1) { const int e = r / I_W1; p0_transpose_item_fp8(p.w1 + (size_t)e * 1024 * 2048, 2048, w1_8 + (size_t)e * 2048 * 1024, 2, W_SCALE, scr, r % I_W1, lane); continue; } r -= NE * I_W1;
            { const int e = r / I_W2; p0_transpose_item_fp8(p.w2 + (size_t)e * 1024 * 1024, 1024, w2_8 + (size_t)e * 1024 * 1024, 1, W_SCALE, scr, r % I_W2, lane); }
        }
        const f32x4* x4 = (const f32x4*)p.x;
#if INPROJ_FP8
        u32x2* x8 = (u32x2*)xb;
        for (long i = gt; i < (long)T * D / 8; i += gsz) { const f32x4 a = x4[2 * i], b = x4[2 * i + 1];
            u32x2 o; o.x = pk4_fp8(a[0], a[1], a[2], a[3]); o.y = pk4_fp8(b[0], b[1], b[2], b[3]); x8[i] = o; }
#else
        u32x4* xb4 = (u32x4*)xb;
        for (long i = gt; i < (long)T * D / 8; i += gsz) { const f32x4 a = x4[2 * i], b = x4[2 * i + 1];
            u32x4 o; o.x = cvtpk(a[0], a[1]); o.y = cvtpk(a[2], a[3]); o.z = cvtpk(b[0], b[1]); o.w = cvtpk(b[2], b[3]); xb4[i] = o; }
#endif
    }
    grid.sync();

    REP(1) {
        PHASE_PTRS();
#if INPROJ_FP8
        pg8::SchedInProj<1024> S{(const char*)xb, (const char*)w_in_t, G, bx};
        pg8::EpiInProj E{qkv, p.b_in, rope, ksum, 1.0f / WIN_SCALE};
        pg8::gemm_phase<pg8::EpiInProj, pg8::SchedInProj<1024>, false, true, 512, true>(lds, S, E);
#else
        pg8::SchedInProj<2048> S{(const char*)xb, (const char*)w_in_t, G, bx};
        pg8::EpiInProj E{qkv, p.b_in, rope, ksum, 1.0f};
        pg8::gemm_phase<pg8::EpiInProj, pg8::SchedInProj<2048>, false, true>(lds, S, E);
#endif
    }
    xcd_barrier(xbar);

    REP(2) for (int u = bx; u < 256; u += G) {
        PHASE_PTRS();
        { const int b = u >> 3, h = u & 7;
            for (int j = 0; j < 8; ++j) att::attn_item<true>((char*)lds_raw, qkv, attn_o, b, h, j, p.sinks, ksum); }
        { const int b = u >> 3, kvh = (u >> 2) & 1, oct = u & 3;
            for (int i = 0; i < 8; ++i) att::attn_item<false>((char*)lds_raw, qkv, attn_o, b, kvh, oct * 8 + i, p.sinks, ksum); }
    }
    xcd_barrier(xbar);

    REP(3) for (int pm = bx; pm < T / 256; pm += G) {
        PHASE_IDS(); PHASE_PTRS();
        {
            pg8::SchedPanel S{(const char*)attn_o, (const char*)w_out_t, pm};
            pg8::EpiOutProj E{(bf16_t*)p.out, p.b_out, p.x};
            pg8::gemm_phase<pg8::EpiOutProj, pg8::SchedPanel, false, true>(lds, S, E);
        }
        __syncthreads();
        {
#pragma unroll
            for (int i = 0; i < 16; ++i) { const int idx = tid + 512 * i, mat = idx >> 12, rw = (idx >> 7) & 31, ch = idx & 127;
                const u32x4 v = *(const u32x4*)((mat ? wr_lo : wr_hi) + rw * 1024 + ch * 8);
                *(LAS u32x4*)(lds + mat * 66048 + rw * 2064 + ch * 16) = v; }
        }
        {
            const bf16_t* ytmp = (const bf16_t*)p.out;
            f32x4 gg[2][2], bb[2][2];
#pragma unroll
            for (int j = 0; j < 2; ++j)
#pragma unroll
                for (int h = 0; h < 2; ++h) { gg[j][h] = *(const f32x4*)(p.ln1_g + 512 * j + 8 * lane + 4 * h); bb[j][h] = *(const f32x4*)(p.ln1_b + 512 * j + 8 * lane + 4 * h); }
            for (int rr = 0; rr < 32; rr += 4) {
                const size_t row0 = (size_t)pm * 256 + wave * 32 + rr;
                u32x4 raw[4][2]; float v[4][2][8]; float sm[4], sq[4];
#pragma unroll
                for (int q = 0; q < 4; ++q)
#pragma unroll
                    for (int j = 0; j < 2; ++j) raw[q][j] = *(const u32x4*)(ytmp + (row0 + q) * D + 512 * j + 8 * lane);
#pragma unroll
                for (int q = 0; q < 4; ++q) { float s_ = 0.f;
#pragma unroll
                    for (int j = 0; j < 2; ++j)
#pragma unroll
                        for (int c = 0; c < 4; ++c) { const unsigned w = raw[q][j][c]; v[q][j][2 * c] = bf2f(w & 0xffffu); v[q][j][2 * c + 1] = bf2f(w >> 16); s_ += v[q][j][2 * c] + v[q][j][2 * c + 1]; }
                    sm[q] = s_; }
#pragma unroll
                for (int o = 1; o < 64; o <<= 1) {
#pragma unroll
                    for (int q = 0; q < 4; ++q) sm[q] += __shfl_xor(sm[q], o); }
#pragma unroll
                for (int q = 0; q < 4; ++q) { const float mean = sm[q] * (1.0f / D); float s2 = 0.f;
#pragma unroll
                    for (int j = 0; j < 2; ++j)
#pragma unroll
                        for (int c = 0; c < 8; ++c) { v[q][j][c] -= mean; s2 += v[q][j][c] * v[q][j][c]; }
                    sq[q] = s2; }
#pragma unroll
                for (int o = 1; o < 64; o <<= 1) {
#pragma unroll
                    for (int q = 0; q < 4; ++q) sq[q] += __shfl_xor(sq[q], o); }
#pragma unroll
                for (int q = 0; q < 4; ++q) {
                    const float rstd = 1.0f / sqrtf(sq[q] * (1.0f / D) + LN_EPS);
#pragma unroll
                    for (int j = 0; j < 2; ++j) {
                        float xv[8];
#pragma unroll
                        for (int c = 0; c < 8; ++c) xv[c] = v[q][j][c] * rstd * gg[j][c >> 2][c & 3] + bb[j][c >> 2][c & 3];
                        u32x4 hv; hv.x = cvtpk(xv[0], xv[1]); hv.y = cvtpk(xv[2], xv[3]); hv.z = cvtpk(xv[4], xv[5]); hv.w = cvtpk(xv[6], xv[7]);
                        u32x2 fv; fv.x = pk4_fp8(xv[0], xv[1], xv[2], xv[3]); fv.y = pk4_fp8(xv[4], xv[5], xv[6], xv[7]);
                        *(u32x4*)(x1b + (row0 + q) * D + 512 * j + 8 * lane) = hv;
                        *(u32x2*)(x1_8 + (row0 + q) * D + 512 * j + 8 * lane) = fv;
                    }
                }
            }
        }
        __syncthreads();
        {
            const int fr = lane & 15, fq = lane >> 4;
            f32x4 lacc[2][2];
#pragma unroll
            for (int m = 0; m < 2; ++m)
#pragma unroll
                for (int n = 0; n < 2; ++n) lacc[m][n] = (f32x4){0.f, 0.f, 0.f, 0.f};
            const size_t r0 = (size_t)pm * 256 + wave * 32;
            const bf16_t* ah = x1b + (r0 + fr) * D + 8 * fq;
            const LAS unsigned char* bh = lds + fr * 2064 + 16 * fq; const LAS unsigned char* bl = bh + 66048;
#pragma unroll 4
            for (int k0 = 0; k0 < 1024; k0 += 32) {
                bf16x8 a_hi[2], b_hi[2], b_lo[2];
#pragma unroll
                for (int m = 0; m < 2; ++m) a_hi[m] = *(const bf16x8*)(ah + (size_t)m * 16 * D + k0);
#pragma unroll
                for (int n = 0; n < 2; ++n) { b_hi[n] = *(const LAS bf16x8*)(bh + n * 16 * 2064 + k0 * 2); b_lo[n] = *(const LAS bf16x8*)(bl + n * 16 * 2064 + k0 * 2); }
#pragma unroll
                for (int m = 0; m < 2; ++m)
#pragma unroll
                    for (int n = 0; n < 2; ++n) {
                        lacc[m][n] = __builtin_amdgcn_mfma_f32_16x16x32_bf16(a_hi[m], b_hi[n], lacc[m][n], 0, 0, 0);
                        lacc[m][n] = __builtin_amdgcn_mfma_f32_16x16x32_bf16(a_hi[m], b_lo[n], lacc[m][n], 0, 0, 0);
                    }
            }
            __syncthreads();
            LAS float* lg = (LAS float*)lds;
#pragma unroll
            for (int m = 0; m < 2; ++m)
#pragma unroll
                for (int n = 0; n < 2; ++n)
#pragma unroll
                    for (int rg = 0; rg < 4; ++rg) lg[(wave * 32 + 16 * m + 4 * fq + rg) * 33 + 16 * n + fr] = lacc[m][n][rg];
        }
        __syncthreads();
        {
            LAS float* lg = (LAS float*)lds;
            LAS int* wcnt = (LAS int*)(lds + 36864);
            float t0 = -INFINITY, t1 = -INFINITY, t2 = -INFINITY, t3 = -INFINITY; int i0 = 0, i1 = 0, i2 = 0, i3 = 0;
            int rk0 = 0, rk1 = 0, rk2 = 0, rk3 = 0;
            if (tid < 256) {
                for (int e = 0; e < NE; ++e) {
                    const float xv = lg[tid * 33 + e] + p.b_router[e];
                    if (xv > t3) {
                        if (xv > t2) { t3 = t2; i3 = i2;
                            if (xv > t1) { t2 = t1; i2 = i1;
                                if (xv > t0) { t1 = t0; i1 = i0; t0 = xv; i0 = e; } else { t1 = xv; i1 = e; }
                            } else { t2 = xv; i2 = e; }
                        } else { t3 = xv; i3 = e; }
                    }
                }
                const unsigned selm = (1u << i0) | (1u << i1) | (1u << i2) | (1u << i3);
                for (int e = 0; e < NE; ++e) {
                    const bool has = ((selm >> e) & 1u) != 0u;
                    const unsigned long long bal = __ballot(has);
                    const int pre = __popcll(bal & ((1ull << lane) - 1ull));
                    if (e == i0) rk0 = pre; if (e == i1) rk1 = pre; if (e == i2) rk2 = pre; if (e == i3) rk3 = pre;
                    if (lane == 0) wcnt[wave * 32 + e] = __popcll(bal);
                }
            }
            __syncthreads();
            if (tid < 256) {
                const float e1 = __expf(t1 - t0), e2 = __expf(t2 - t0), e3 = __expf(t3 - t0);
                const float inv = 1.0f / (1.0f + e1 + e2 + e3);
                int b0 = 0, b1 = 0, b2 = 0, b3 = 0;
                for (int w = 0; w < wave; ++w) { b0 += wcnt[w * 32 + i0]; b1 += wcnt[w * 32 + i1]; b2 += wcnt[w * 32 + i2]; b3 += wcnt[w * 32 + i3]; }
                const size_t a = ((size_t)pm * 256 + tid) * 4;
                *(int4*)(asg_e + a) = make_int4(i0, i1, i2, i3);
                *(float4*)(asg_g + a) = make_float4(inv, e1 * inv, e2 * inv, e3 * inv);
                *(int4*)(asg_d + a) = make_int4(b0 + rk0, b1 + rk1, b2 + rk2, b3 + rk3);
            }
            if (tid < 32) cnt_blk[pm * 32 + tid] = wcnt[tid] + wcnt[32 + tid] + wcnt[64 + tid] + wcnt[96 + tid];
            __syncthreads();
        }
    }
    xcd_barrier(xbar);

    for (int pm = bx; pm < T / 256; pm += G) {
        PHASE_IDS(); PHASE_PTRS();
        LAS int* part_all = (LAS int*)lds; LAS int* part_pre = part_all + 512; LAS int* tot = part_pre + 512; LAS int* pre = tot + 32; LAS int* poff = pre + 32;
        { const int e = tid & 31, seg = tid >> 5; int sa = 0, sp = 0;
            for (int bb = seg * 16; bb < seg * 16 + 16; ++bb) { const int c = cnt_blk[bb * 32 + e]; sa += c; sp += (bb < pm) ? c : 0; }
            part_all[tid] = sa; part_pre[tid] = sp; }
        __syncthreads();
        if (tid < 32) { int sa = 0, sp = 0; for (int s = 0; s < 16; ++s) { sa += part_all[s * 32 + tid]; sp += part_pre[s * 32 + tid]; } tot[tid] = sa; pre[tid] = sp; }
        __syncthreads();
        if (tid == 0) { int off = 0; for (int e = 0; e < NE; ++e) { poff[e] = off; off += ((tot[e] + 255) >> 8) << 8; } poff[32] = off; }
        __syncthreads();
        if (tid < 256) {
            const int token = pm * 256 + tid; const size_t a = (size_t)token * 4;
            const int4 ee = *(const int4*)(asg_e + a); const int4 rk = *(const int4*)(asg_d + a);
            const int d0 = poff[ee.x] + pre[ee.x] + rk.x, d1 = poff[ee.y] + pre[ee.y] + rk.y, d2 = poff[ee.z] + pre[ee.z] + rk.z, d3 = poff[ee.w] + pre[ee.w] + rk.w;
            *(int4*)(asg_d + a) = make_int4(d0, d1, d2, d3);
            tok[d0] = token; tok[d1] = token; tok[d2] = token; tok[d3] = token;
        }
        if (pm < NE) {
            const int e = pm, n = tot[e], np = ((n + 255) >> 8) << 8, o = poff[e];
            for (int i = n + tid; i < np; i += NTHREADS) tok[o + i] = 0;
            for (int i = tid; i < (np >> 8); i += NTHREADS) tile_e[(o >> 8) + i] = e;
        }
        if (pm == 0 && tid == 0) ctl[CW_NTILES] = (unsigned)(poff[32] >> 8);
        __syncthreads();
    }
    xcd_barrier(xbar);

    REP(5) {
        PHASE_PTRS(); const int ntiles = (int)ctl[CW_NTILES];
        pg8::SchedMoe<8, true> S{(const char*)x1_8, (const char*)w1_8, tile_e, tok, ntiles, G, bx};
        pg8::EpiSwiglu E{act8, p.b1};
        pg8::gemm_phase<pg8::EpiSwiglu, pg8::SchedMoe<8, true>, true, true, 512, true>(lds, S, E);
    }
    xcd_barrier(xbar);

    REP(6) {
        PHASE_PTRS(); const int ntiles = (int)ctl[CW_NTILES];
        pg8::SchedMoe<4, false> S{(const char*)act8, (const char*)w2_8, tile_e, tok, ntiles, G, bx};
        pg8::EpiDown E{yb, p.b2};
        pg8::gemm_phase<pg8::EpiDown, pg8::SchedMoe<4, false>, false, true, 512, true>(lds, S, E);
    }
    xcd_barrier(xbar);

    REP(7) {
        PHASE_IDS(); PHASE_PTRS();
        const int gw = bx * 8 + wave, NGW = G * 8;
        f32x4 gg[2][2], bb[2][2];
#pragma unroll
        for (int j = 0; j < 2; ++j)
#pragma unroll
            for (int h = 0; h < 2; ++h) { gg[j][h] = *(const f32x4*)(p.ln2_g + 512 * j + 8 * lane + 4 * h); bb[j][h] = *(const f32x4*)(p.ln2_b + 512 * j + 8 * lane + 4 * h); }
        for (int row = gw; row < T; row += NGW) {
            const size_t a = (size_t)row * 4;
            const int4 dd = *(const int4*)(asg_d + a); const float4 gt4 = *(const float4*)(asg_g + a);
            u32x4 xr[2], y0[2], y1[2], y2[2], y3[2];
#pragma unroll
            for (int j = 0; j < 2; ++j) {
                xr[j] = *(const u32x4*)(x1b + (size_t)row * D + 512 * j + 8 * lane);
                y0[j] = *(const u32x4*)(yb + (size_t)dd.x * D + 512 * j + 8 * lane);
                y1[j] = *(const u32x4*)(yb + (size_t)dd.y * D + 512 * j + 8 * lane);
                y2[j] = *(const u32x4*)(yb + (size_t)dd.z * D + 512 * j + 8 * lane);
                y3[j] = *(const u32x4*)(yb + (size_t)dd.w * D + 512 * j + 8 * lane);
            }
            float z[2][8]; float s = 0.f;
#pragma unroll
            for (int j = 0; j < 2; ++j)
#pragma unroll
                for (int q = 0; q < 4; ++q) {
                    const unsigned xw = xr[j][q], a0 = y0[j][q], a1 = y1[j][q], a2 = y2[j][q], a3 = y3[j][q];
                    const float lo = DN_ALPHA * bf2f(xw & 0xffffu) + gt4.x * bf2f(a0 & 0xffffu) + gt4.y * bf2f(a1 & 0xffffu) + gt4.z * bf2f(a2 & 0xffffu) + gt4.w * bf2f(a3 & 0xffffu);
                    const float hi = DN_ALPHA * bf2f(xw >> 16) + gt4.x * bf2f(a0 >> 16) + gt4.y * bf2f(a1 >> 16) + gt4.z * bf2f(a2 >> 16) + gt4.w * bf2f(a3 >> 16);
                    z[j][2 * q] = lo; z[j][2 * q + 1] = hi; s += lo + hi;
                }
            const float mean = wave_sum(s) * (1.0f / D); float s2 = 0.f;
#pragma unroll
            for (int j = 0; j < 2; ++j)
#pragma unroll
                for (int q = 0; q < 8; ++q) { z[j][q] -= mean; s2 += z[j][q] * z[j][q]; }
            const float rstd = 1.0f / sqrtf(wave_sum(s2) * (1.0f / D) + LN_EPS);
#pragma unroll
            for (int j = 0; j < 2; ++j)
#pragma unroll
                for (int h = 0; h < 2; ++h) {
                    f32x4 o;
#pragma unroll
                    for (int q = 0; q < 4; ++q) o[q] = z[j][4 * h + q] * rstd * gg[j][h][q] + bb[j][h][q];
                    *(f32x4*)(p.out + (size_t)row * D + 512 * j + 8 * lane + 4 * h) = o;
                }
        }
    }
}

extern "C" void kernel_launch(void* const* d_in, const int* in_sizes, int n_in, void* d_out, int out_size, void* d_ws, size_t ws_size, hipStream_t stream) {
    static int grid_blocks = 0;
    if (grid_blocks == 0) {
        if (n_in != 16 || in_sizes[0] != T * D || out_size != T * D || ws_size < WS_END) {
            fprintf(stderr, "kernel_launch: unexpected shapes: n_in %d in0 %d out %d ws %zu (need %zu)\n", n_in, n_in > 0 ? in_sizes[0] : -1, out_size, ws_size, (size_t)WS_END); grid_blocks = -1; return; }
        int dev = 0, cus = 0, per_cu = 0;
        (void)hipGetDevice(&dev);
        (void)hipDeviceGetAttribute(&cus, hipDeviceAttributeMultiprocessorCount, dev);
        (void)hipFuncSetAttribute((const void*)fwd_megakernel, hipFuncAttributeMaxDynamicSharedMemorySize, LDS_BYTES);
        (void)hipOccupancyMaxActiveBlocksPerMultiprocessor(&per_cu, (const void*)fwd_megakernel, NTHREADS, LDS_BYTES);
        if (per_cu < 1) { fprintf(stderr, "kernel_launch: occupancy query reports %d blocks per CU\n", per_cu); per_cu = 1; }
        grid_blocks = cus;
        fprintf(stderr, "kernel_launch: cus=%d per_cu=%d grid=%d ws=%zu\n", cus, per_cu, grid_blocks, ws_size);
    }
    if (grid_blocks < 0) return;
    (void)hipMemsetAsync((char*)d_ws + WS_CTL, 0, CTL_ZERO_BYTES, stream);
    Params p{};
    p.x = (const float*)d_in[0]; p.w_in = (const float*)d_in[1]; p.b_in = (const float*)d_in[2]; p.sinks = (const float*)d_in[3]; p.w_out = (const float*)d_in[4]; p.b_out = (const float*)d_in[5];
    p.ln1_g = (const float*)d_in[6]; p.ln1_b = (const float*)d_in[7]; p.w_router = (const float*)d_in[8]; p.b_router = (const float*)d_in[9];
    p.w1 = (const float*)d_in[10]; p.b1 = (const float*)d_in[11]; p.w2 = (const float*)d_in[12]; p.b2 = (const float*)d_in[13]; p.ln2_g = (const float*)d_in[14]; p.ln2_b = (const float*)d_in[15];
    p.out = (float*)d_out; p.ws = (unsigned char*)d_ws;
    void* args[] = {&p};
    hipError_t e = hipLaunchCooperativeKernel((void*)fwd_megakernel, dim3(grid_blocks), dim3(NTHREADS), args, LDS_BYTES, stream);
    if (e != hipSuccess) fprintf(stderr, "cooperative launch failed: %s (grid %d)\n", hipGetErrorString(e), grid_blocks);
}
```

```cpp
#include <hip/hip_runtime.h>
#include <hip/hip_cooperative_groups.h>
#include <cstdio>
#include <cstdint>
namespace cg = cooperative_groups;

#define LAS __attribute__((address_space(3)))
typedef unsigned short bf16_t;
typedef short bf16x8 __attribute__((ext_vector_type(8)));
typedef short s16x4 __attribute__((ext_vector_type(4)));
typedef float f32x2 __attribute__((ext_vector_type(2)));
typedef float f32x4 __attribute__((ext_vector_type(4)));
typedef float f32x16 __attribute__((ext_vector_type(16)));
typedef unsigned u32x2 __attribute__((ext_vector_type(2)));
typedef unsigned u32x4 __attribute__((ext_vector_type(4)));
typedef __bf16 bf16x2_t __attribute__((ext_vector_type(2)));

constexpr int D = 1024, BATCH = 32, SEQ = 2048, T = BATCH * SEQ;
constexpr int INW = 2304, NE = 32;
constexpr float LN_EPS = 1e-5f;
constexpr float DN_ALPHA = 1.189207115002721f;
constexpr float LOG2E = 1.4426950408889634f;
constexpr float C2 = 0.18033688011112042f;
constexpr int NTHREADS = 512;
constexpr int LDS_BYTES = 147456;
constexpr int MAX_TILES = 1056;
#ifndef INPROJ_FP8
#define INPROJ_FP8 1
#endif
#ifndef DUP_MASK
#define DUP_MASK 0
#endif
#define REP(k) for (int _rep = 0; _rep < (((DUP_MASK >> (k)) & 1) ? 2 : 1); ++_rep)

constexpr size_t MiB = 1u << 20;
constexpr size_t WS_CTL = 0, CTL_ZERO_BYTES = 2 * MiB;
constexpr size_t WS_KSUM = 1 * MiB;
constexpr size_t WS_ROPE = 2 * MiB;
constexpr size_t WS_WIN_T = 4 * MiB;
constexpr size_t WS_WOUT_T = 9 * MiB;
constexpr size_t WS_SMALL = 11 * MiB;
constexpr size_t WS_CNT = WS_SMALL, WS_TILE_E = WS_SMALL + 65536, WS_WR_HI = WS_SMALL + 131072, WS_WR_LO = WS_WR_HI + 65536;
constexpr size_t WS_TOK = 12 * MiB;
constexpr size_t WS_ASG_E = 14 * MiB, WS_ASG_G = 15 * MiB, WS_ASG_D = 16 * MiB;
constexpr size_t WS_W2_8 = 24 * MiB;
constexpr size_t WS_X1B = 56 * MiB;
constexpr size_t WS_ACT8 = 184 * MiB;
constexpr size_t WS_XB = 184 * MiB;
constexpr size_t WS_X1LO = 312 * MiB;
constexpr size_t WS_YB = 488 * MiB;
constexpr size_t WS_W1_8 = 488 * MiB;
constexpr size_t WS_X1_8 = 552 * MiB;
constexpr size_t WS_QKV = 616 * MiB;
constexpr size_t WS_END = 1016 * MiB;
constexpr float W_SCALE = 64.0f, ACT_SCALE = 4.0f, WIN_SCALE = 32.0f, Y_SCALE = 16.0f;
constexpr int CW_NTILES = 16, CW_BAR = 4096;
constexpr int LDS_BARST = LDS_BYTES - 256;

struct Params {
    const float *x, *w_in, *b_in, *sinks, *w_out, *b_out, *ln1_g, *ln1_b, *w_router, *b_router, *w1, *b1, *w2, *b2, *ln2_g, *ln2_b;
    float* out; unsigned char* ws;
};

__device__ __forceinline__ unsigned f2bf(float f) { unsigned u = __builtin_bit_cast(unsigned, f); return (u + 0x7fffu + ((u >> 16) & 1u)) >> 16; }
__device__ __forceinline__ float bf2f(unsigned h) { return __builtin_bit_cast(float, h << 16); }
__device__ __forceinline__ unsigned cvtpk(float lo, float hi) { f32x2 v = {lo, hi}; bf16x2_t b = __builtin_convertvector(v, bf16x2_t); return __builtin_bit_cast(unsigned, b); }
__device__ __forceinline__ unsigned pk4_fp8(float a, float b, float c, float d) { int w = 0; w = __builtin_amdgcn_cvt_pk_fp8_f32(a, b, w, false); w = __builtin_amdgcn_cvt_pk_fp8_f32(c, d, w, true); return (unsigned)w; }
__device__ __forceinline__ float wave_sum(float v) {
#pragma unroll
    for (int o = 1; o < 64; o <<= 1) v += __shfl_xor(v, o);
    return v;
}
#define LDS_WAIT() asm volatile("s_waitcnt lgkmcnt(0)" ::: "memory")
template <int X> __device__ __forceinline__ float swz_xor(float v) { return __builtin_bit_cast(float, __builtin_amdgcn_ds_swizzle(__builtin_bit_cast(int, v), (X << 10) | 0x1f)); }

namespace pg8 {
constexpr int BM = 256, BK = 64, HALF = 128, HTB = HALF * BK * 2, STAGE_BYTES = 8 * HTB, NXCD = 8, WGM = 8;
constexpr int KD = 1024;
__host__ __device__ __forceinline__ int lds_byte(int r, int c) { const int st = (r >> 4) * 2 + (c >> 5), rr = r & 15, cc = c & 31, ob = rr * 64 + cc * 2; return st * 1024 + (ob ^ (((ob >> 9) & 1) << 5)); }
__host__ __device__ __forceinline__ void stage_rc(int b, int& R, int& C) { const int st = b / 1024, sb = b % 1024, swz = sb ^ (((sb >> 9) & 1) << 5); R = (st >> 1) * 16 + swz / 64; C = (st & 1) * 32 + (swz % 64) / 2; }
__host__ __device__ __forceinline__ int perm32(int rho) { const int n = rho >> 4, i = rho & 15; return 8 * (i >> 2) + 4 * n + (i & 3); }

struct Unit { int pm, pn, e; unsigned ao, bo; const int* rows; };

typedef int v8i32_t __attribute__((ext_vector_type(8)));
typedef int v4i32_t __attribute__((ext_vector_type(4)));
__device__ __forceinline__ v8i32_t cat8(bf16x8 a, bf16x8 b) { const v4i32_t x = __builtin_bit_cast(v4i32_t, a), y = __builtin_bit_cast(v4i32_t, b); return __builtin_shufflevector(x, y, 0, 1, 2, 3, 4, 5, 6, 7); }
template <class Epi, class Sched, bool GATHER, bool ALIGN_EPI, int KP = 1024, bool FP8 = false>
__device__ __forceinline__ void gemm_phase(LAS unsigned char* lds, const Sched& S, const Epi& E) {
    int tid = threadIdx.x; asm volatile("" : "+v"(tid));
    const int wid = __builtin_amdgcn_readfirstlane(tid >> 6), lane = tid & 63, wr = wid >> 2, wc = wid & 3, fr = lane & 15, fq = lane >> 4;
    constexpr int K = KP, nt = K / BK;
    unsigned voffB[2], Vc[2][2], Vn[2][2]; int stR0, stC0;
    { int R, C; stage_rc(tid * 16, R, C); stR0 = R; stC0 = C; }
#pragma unroll
    for (int i = 0; i < 2; ++i) { voffB[i] = (unsigned)((stR0 + 64 * i) * K + stC0) * 2u; Vc[0][i] = voffB[i]; Vc[1][i] = voffB[i]; Vn[0][i] = voffB[i]; Vn[1][i] = voffB[i]; }
#define PG8_GATHER_LOAD(VV, rowsp) do { int _t = threadIdx.x; asm volatile("" : "+v"(_t)); int _R, _C; stage_rc(_t * 16, _R, _C);     \
        const int* _rp = (const int*)((const char*)(rowsp) + (unsigned)(_R * 4)); _Pragma("unroll") for (int _h = 0; _h < 2; ++_h) _Pragma("unroll") for (int _i = 0; _i < 2; ++_i) \
        VV[_h][_i] = ((unsigned)_rp[128 * _h + 64 * _i] * (unsigned)K + (unsigned)_C) * 2u; } while (0)
    constexpr unsigned kstep = (unsigned)(BK * 2);
    constexpr unsigned hstep = (unsigned)HALF * K * 2;
    const char* const Abase = S.A; const char* const Bbase = S.B;
    const unsigned ldsw = (unsigned)wid * 1024u;
    const int aoff = lds_byte(wr * 64 + fr, fq * 8), boff = lds_byte(wc * 32 + fr, fq * 8);
#define PG8_SA(b, h) (((b) * 2 + (h)) * HTB)
#define PG8_SB(b, h) ((4 + (b) * 2 + (h)) * HTB)
#define PG8_STAGE(bufoff, gbase, soff, voff) do { _Pragma("unroll") for (int _i = 0; _i < 2; ++_i) \
        __builtin_amdgcn_global_load_lds((const unsigned*)((gbase) + (unsigned)((voff)[_i] + (soff))), (LAS unsigned*)(lds + (bufoff) + ldsw + _i * 8192), 16, 0, 0); } while (0)
#define PG8_STAGE_B(bufoff, soff) PG8_STAGE(bufoff, Bbase, soff, voffB)
#define PG8_STAGE_A(bufoff, soff, h, VV) do { if constexpr (GATHER) { PG8_STAGE(bufoff, Abase, soff, VV[h]); } else { PG8_STAGE(bufoff, Abase, (soff) + (h) * hstep, voffB); } } while (0)
#define PG8_LDA(dst, b, h) do { _Pragma("unroll") for (int m = 0; m < 4; ++m) dst[m] = cat8(*(const LAS bf16x8*)(lds + PG8_SA(b, h) + aoff + m * 2048), *(const LAS bf16x8*)(lds + PG8_SA(b, h) + aoff + m * 2048 + 1024)); } while (0)
#define PG8_LDB(dst, b, h) do { _Pragma("unroll") for (int n = 0; n < 2; ++n) dst[n] = cat8(*(const LAS bf16x8*)(lds + PG8_SB(b, h) + boff + n * 2048), *(const LAS bf16x8*)(lds + PG8_SB(b, h) + boff + n * 2048 + 1024)); } while (0)
#define PG8_LO(v) __builtin_bit_cast(bf16x8, __builtin_shufflevector(v, v, 0, 1, 2, 3))
#define PG8_HI(v) __builtin_bit_cast(bf16x8, __builtin_shufflevector(v, v, 4, 5, 6, 7))
#define PG8_MMA(ai, bj, At, Bt) do { __builtin_amdgcn_s_setprio(1); _Pragma("unroll") for (int m = 0; m < 4; ++m) _Pragma("unroll") for (int n = 0; n < 2; ++n) { \
        if constexpr (FP8) { acc[ai][bj][m][n] = __builtin_amdgcn_mfma_scale_f32_16x16x128_f8f6f4(Bt[n], At[m], acc[ai][bj][m][n], 0, 0, 0, 0x7f7f7f7f, 0, 0x7f7f7f7f); } \
        else { acc[ai][bj][m][n] = __builtin_amdgcn_mfma_f32_16x16x32_bf16(PG8_LO(Bt[n]), PG8_LO(At[m]), acc[ai][bj][m][n], 0, 0, 0); \
               acc[ai][bj][m][n] = __builtin_amdgcn_mfma_f32_16x16x32_bf16(PG8_HI(Bt[n]), PG8_HI(At[m]), acc[ai][bj][m][n], 0, 0, 0); } } \
        __builtin_amdgcn_s_setprio(0); } while (0)
#define PG8_WAIT_V(n) asm volatile("s_waitcnt vmcnt(" #n ")" ::: "memory")
#define PG8_WAIT_L(n) asm volatile("s_waitcnt lgkmcnt(" #n ")" ::: "memory")
#define PG8_BAR __builtin_amdgcn_s_barrier()
#define PG8_SCHED __builtin_amdgcn_sched_barrier(0)
    Unit cur, nxt; int ui = 0;
    if (!S.next(0, cur)) return;
    if constexpr (GATHER) { PG8_GATHER_LOAD(Vc, cur.rows); }
    f32x4 acc[2][2][4][2];
#pragma unroll
    for (int a = 0; a < 2; ++a)
#pragma unroll
        for (int b = 0; b < 2; ++b)
#pragma unroll
            for (int m = 0; m < 4; ++m)
#pragma unroll
                for (int n = 0; n < 2; ++n) acc[a][b][m][n] = (f32x4){0.f, 0.f, 0.f, 0.f};
    v8i32_t At[4], B0[2], B1[2];
    unsigned cA = cur.ao, cB = cur.bo;
    PG8_STAGE_B(PG8_SB(0, 0), cB); PG8_STAGE_B(PG8_SB(0, 1), cB + hstep); PG8_STAGE_A(PG8_SA(0, 0), cA, 0, Vc); PG8_STAGE_A(PG8_SA(0, 1), cA, 1, Vc);
    if (wr == 1) PG8_BAR;
    PG8_WAIT_V(2); PG8_BAR;
    PG8_STAGE_B(PG8_SB(1, 0), cB + kstep); PG8_STAGE_A(PG8_SA(1, 0), cA + kstep, 0, Vc); PG8_STAGE_B(PG8_SB(1, 1), cB + hstep + kstep);
    PG8_WAIT_V(6); PG8_BAR;
    for (;;) {
        const bool has_next = S.next(ui + 1, nxt);
        const unsigned nA = has_next ? nxt.ao : cA; const unsigned nB = has_next ? nxt.bo : cB;
        if constexpr (GATHER) {
            if (has_next) { PG8_GATHER_LOAD(Vn, nxt.rows); }
            else {
#pragma unroll
                for (int i = 0; i < 2; ++i) { Vn[0][i] = Vc[0][i]; Vn[1][i] = Vc[1][i]; }
            }
        }
#pragma unroll 1
        for (int t = 0; t < nt; t += 2) {
            const bool last = (t == nt - 2);
            const unsigned a1 = cA + (unsigned)(t + 1) * kstep;
            const unsigned a2 = last ? nA : cA + (unsigned)(t + 2) * kstep; const unsigned b2 = last ? nB : cB + (unsigned)(t + 2) * kstep;
            const unsigned a3 = a2 + kstep; const unsigned b3 = b2 + kstep;
            PG8_LDB(B0, 0, 0); PG8_LDB(B1, 0, 1); PG8_SCHED; PG8_LDA(At, 0, 0); PG8_STAGE_A(PG8_SA(1, 1), a1, 1, Vc);
            if constexpr (GATHER) { if (last) {
#pragma unroll
                for (int i = 0; i < 2; ++i) { Vc[0][i] = Vn[0][i]; Vc[1][i] = Vn[1][i]; } } }
            PG8_WAIT_V(8); PG8_WAIT_L(0); PG8_BAR; PG8_MMA(0, 0, At, B0); PG8_MMA(0, 1, At, B1); PG8_BAR; PG8_SCHED;
            PG8_LDA(At, 0, 1); PG8_STAGE_B(PG8_SB(0, 0), b2); PG8_STAGE_B(PG8_SB(0, 1), b2 + hstep); PG8_STAGE_A(PG8_SA(0, 0), a2, 0, Vc);
            PG8_WAIT_V(8); PG8_WAIT_L(0); PG8_BAR; PG8_MMA(1, 0, At, B0); PG8_MMA(1, 1, At, B1); PG8_BAR; PG8_SCHED;
            PG8_LDB(B0, 1, 0); PG8_LDB(B1, 1, 1); PG8_SCHED; PG8_LDA(At, 1, 0); PG8_STAGE_A(PG8_SA(0, 1), a2, 1, Vc);
            PG8_WAIT_V(8); PG8_WAIT_L(0); PG8_BAR; PG8_MMA(0, 0, At, B0); PG8_MMA(0, 1, At, B1); PG8_BAR; PG8_SCHED;
            PG8_LDA(At, 1, 1); PG8_STAGE_B(PG8_SB(1, 0), b3); PG8_STAGE_B(PG8_SB(1, 1), b3 + hstep); PG8_STAGE_A(PG8_SA(1, 0), a3, 0, Vc);
            PG8_WAIT_V(8); PG8_WAIT_L(0); PG8_BAR; PG8_MMA(1, 0, At, B0); PG8_MMA(1, 1, At, B1); PG8_BAR; PG8_SCHED;
        }
        if constexpr (ALIGN_EPI) { if (wr == 0) PG8_BAR; }
        { int t2 = threadIdx.x; asm volatile("" : "+v"(t2));
          E(acc, cur, wr, wc, t2 & 15, (t2 & 63) >> 4); }
        if (!has_next) break;
#pragma unroll
        for (int a = 0; a < 2; ++a)
#pragma unroll
            for (int b = 0; b < 2; ++b)
#pragma unroll
                for (int m = 0; m < 4; ++m)
#pragma unroll
                    for (int n = 0; n < 2; ++n) acc[a][b][m][n] = (f32x4){0.f, 0.f, 0.f, 0.f};
        cur = nxt; cA = nA; cB = nB; ++ui;
        if constexpr (ALIGN_EPI) { if (wr == 1) PG8_BAR; }
    }
    PG8_WAIT_V(0);
    if constexpr (!ALIGN_EPI) { if (wr == 0) PG8_BAR; }
    PG8_BAR;
#undef PG8_SA
#undef PG8_SB
#undef PG8_STAGE
#undef PG8_STAGE_A
#undef PG8_STAGE_B
#undef PG8_GATHER_LOAD
#undef PG8_LDA
#undef PG8_LDB
#undef PG8_LO
#undef PG8_HI
#undef PG8_MMA
#undef PG8_WAIT_V
#undef PG8_WAIT_L
#undef PG8_BAR
#undef PG8_SCHED
}

template <int ROWB>
struct SchedInProj {
    const char* A; const char* B; int G, c;
    __device__ __forceinline__ bool next(int i, Unit& u) const {
        constexpr int nM = T / BM, nN = INW / BM, nwg = nM * nN;
        const long L = (long)i * G + c; if (L >= nwg) return false;
        int wgid = (int)L; { const int q = nwg / NXCD, r = nwg % NXCD, xcd = wgid % NXCD, off = wgid / NXCD; wgid = (xcd < r ? xcd * (q + 1) : r * (q + 1) + (xcd - r) * q) + off; }
        const int nig = WGM * nN, gid = wgid / nig, fm = gid * WGM, gsz = (nM - fm) < WGM ? (nM - fm) : WGM;
        u.pm = fm + ((wgid % nig) % gsz); u.pn = (wgid % nig) / gsz; u.e = 0; u.rows = nullptr;
        u.ao = (unsigned)u.pm * (unsigned)(256 * ROWB); u.bo = (unsigned)u.pn * (unsigned)(256 * ROWB); return true;
    }
};
struct SchedPanel {
    const char* A; const char* B; int pm;
    __device__ __forceinline__ bool next(int i, Unit& u) const {
        if (i >= 4) return false;
        u.pm = pm; u.pn = i; u.e = 0; u.rows = nullptr; u.ao = (unsigned)pm * (unsigned)(256 * KD * 2); u.bo = (unsigned)i * (unsigned)(256 * KD * 2); return true;
    }
};
template <int NPN, bool G1>
struct SchedMoe {
    const char* A; const char* B; const int* tile_e; const int* tok; int ntiles, G, c;
    __device__ __forceinline__ bool next(int i, Unit& u) const {
        const long L = (long)i * G + c; int t, pn;
        if ((G & 7) == 0) { const int x = (int)(L & 7); const long j = L >> 3; t = (int)(j / NPN) * 8 + x; pn = (int)(j % NPN); }
        else { t = (int)(L / NPN); pn = (int)(L % NPN); }
        if (t >= ntiles) return false;
        const int e = tile_e[t];
        u.pm = t; u.pn = pn; u.e = e;
        if (G1) { u.ao = 0u; u.rows = tok + (size_t)t * 256; u.bo = ((unsigned)e * 2048u + (unsigned)pn * 256u) * 1024u; }
        else { u.ao = (unsigned)t * (256u * 1024u); u.rows = nullptr; u.bo = ((unsigned)e * 1024u + (unsigned)pn * 256u) * 1024u; }
        return true;
    }
};

struct EpiInProj {
    bf16_t* qkv; const float* b_in; const float* rope; float* ksum; float descale;
    __device__ __forceinline__ void operator()(const f32x4 (&acc)[2][2][4][2], const Unit& u, int wr, int wc, int fr, int fq) const {
        const int pn = u.pn;
        const int colb = 256 * pn + 64 * wc + 8 * fq;
        const bool do_rope = !(pn >= 7 || (pn == 2 && wc >= 2));
        const bool is_q = (pn < 2) || (pn == 3) || (pn == 4);
        const bool is_kb = (pn == 5) || (pn == 6);
        const float sc = is_q ? C2 : 1.0f;
        f32x4 bv[2][2];
#pragma unroll
        for (int bj = 0; bj < 2; ++bj)
#pragma unroll
            for (int n = 0; n < 2; ++n) bv[bj][n] = *(const f32x4*)(b_in + colb + 32 * bj + 4 * n);
        f32x4 ks[2][2];
#pragma unroll
        for (int bj = 0; bj < 2; ++bj)
#pragma unroll
            for (int n = 0; n < 2; ++n) ks[bj][n] = (f32x4){0.f, 0.f, 0.f, 0.f};
#pragma unroll
        for (int ai = 0; ai < 2; ++ai)
#pragma unroll
            for (int m = 0; m < 4; ++m) {
                const int row = u.pm * 256 + ai * 128 + wr * 64 + m * 16 + fr;
                const int pos = row & (SEQ - 1);
                f32x4 o1[2], o2[2];
#pragma unroll
                for (int n = 0; n < 2; ++n) { o1[n] = acc[ai][0][m][n] * descale + bv[0][n]; o2[n] = acc[ai][1][m][n] * descale + bv[1][n]; }
                if (do_rope) {
                    const float* rp = rope + pos * 64 + 8 * fq;
#pragma unroll
                    for (int n = 0; n < 2; ++n) { const f32x4 c = *(const f32x4*)(rp + 4 * n), s = *(const f32x4*)(rp + 32 + 4 * n);
                        const f32x4 a = o1[n], b = o2[n]; o1[n] = a * c - b * s; o2[n] = b * c + a * s; }
                }
                if (is_kb) {
#pragma unroll
                    for (int n = 0; n < 2; ++n) { ks[0][n] += o1[n]; ks[1][n] += o2[n]; }
                }
                bf16_t* rowp = qkv + (size_t)row * INW + colb;
                u32x4 w1, w2;
                w1.x = cvtpk(o1[0][0] * sc, o1[0][1] * sc); w1.y = cvtpk(o1[0][2] * sc, o1[0][3] * sc); w1.z = cvtpk(o1[1][0] * sc, o1[1][1] * sc); w1.w = cvtpk(o1[1][2] * sc, o1[1][3] * sc);
                w2.x = cvtpk(o2[0][0] * sc, o2[0][1] * sc); w2.y = cvtpk(o2[0][2] * sc, o2[0][3] * sc); w2.z = cvtpk(o2[1][0] * sc, o2[1][1] * sc); w2.w = cvtpk(o2[1][2] * sc, o2[1][3] * sc);
                *(u32x4*)(rowp) = w1; *(u32x4*)(rowp + 32) = w2;
            }
        if (is_kb) {
            float* kd = ksum + (size_t)u.pm * 512 + 256 * (pn - 5) + 64 * wc + 8 * fq;
#pragma unroll
            for (int bj = 0; bj < 2; ++bj)
#pragma unroll
                for (int n = 0; n < 2; ++n)
#pragma unroll
                    for (int j = 0; j < 4; ++j) {
                        float v = ks[bj][n][j];
                        v += swz_xor<1>(v); v += swz_xor<2>(v); v += swz_xor<4>(v); v += swz_xor<8>(v);
                        if (fr == 0) atomicAdd(kd + 32 * bj + 4 * n + j, v);
                    }
        }
    }
};
struct EpiOutProj {
    bf16_t* y; const float* b_out; const float* x;
    __device__ __forceinline__ void operator()(const f32x4 (&acc)[2][2][4][2], const Unit& u, int wr, int wc, int fr, int fq) const {
        const int col0 = u.pn * 256 + wc * 32 + 8 * fq;
        f32x4 bv[2][2];
#pragma unroll
        for (int bj = 0; bj < 2; ++bj)
#pragma unroll
            for (int n = 0; n < 2; ++n) bv[bj][n] = *(const f32x4*)(b_out + col0 + 128 * bj + 4 * n);
#pragma unroll
        for (int ai = 0; ai < 2; ++ai)
#pragma unroll
            for (int m = 0; m < 4; ++m) {
                const size_t off = (size_t)(u.pm * 256 + ai * 128 + wr * 64 + m * 16 + fr) * D + col0;
#pragma unroll
                for (int bj = 0; bj < 2; ++bj) {
                    const f32x4 x0 = *(const f32x4*)(x + off + 128 * bj), x1 = *(const f32x4*)(x + off + 128 * bj + 4);
                    const f32x4 v0 = acc[ai][bj][m][0] + bv[bj][0] + x0 * DN_ALPHA, v1 = acc[ai][bj][m][1] + bv[bj][1] + x1 * DN_ALPHA;
                    u32x4 w; w.x = cvtpk(v0[0], v0[1]); w.y = cvtpk(v0[2], v0[3]); w.z = cvtpk(v1[0], v1[1]); w.w = cvtpk(v1[2], v1[3]);
                    *(u32x4*)(y + off + 128 * bj) = w; }
                if (m & 1) asm volatile("" ::: "memory");
            }
    }
};
struct EpiSwiglu {
    unsigned char* act8; const float* b1;
    __device__ __forceinline__ void operator()(const f32x4 (&acc)[2][2][4][2], const Unit& u, int wr, int wc, int fr, int fq) const {
        const int a0 = 128 * u.pn + 32 * wc + 8 * fq;
        const float* bp = b1 + (size_t)u.e * 2048 + 2 * a0;
        f32x4 bb[4];
#pragma unroll
        for (int q = 0; q < 4; ++q) bb[q] = *(const f32x4*)(bp + 4 * q);
        unsigned char* tile = act8 + (size_t)u.pm * (256 * 1024);
#pragma unroll
        for (int ai = 0; ai < 2; ++ai)
#pragma unroll
            for (int m = 0; m < 4; ++m) {
                const int row = ai * 128 + wr * 64 + m * 16 + fr;
                float r[8];
#pragma unroll
                for (int n = 0; n < 2; ++n)
#pragma unroll
                    for (int j = 0; j < 4; ++j) {
                        const int q = 4 * n + j;
                        float g = acc[ai][0][m][n][j] * (1.0f / W_SCALE) + bb[q >> 1][(2 * q) & 3];
                        float l = acc[ai][1][m][n][j] * (1.0f / W_SCALE) + bb[q >> 1][((2 * q) & 3) + 1];
                        g = fminf(g, 7.0f); l = fminf(fmaxf(l, -7.0f), 7.0f);
                        const float sg = __builtin_amdgcn_rcpf(1.0f + __builtin_amdgcn_exp2f(-1.702f * LOG2E * g));
                        r[q] = g * sg * (l + 1.0f) * ACT_SCALE;
                    }
                u32x2 w; w.x = pk4_fp8(r[0], r[1], r[2], r[3]); w.y = pk4_fp8(r[4], r[5], r[6], r[7]);
                *(u32x2*)(tile + (size_t)row * 1024 + (size_t)a0) = w;
            }
    }
};
struct EpiDown {
    unsigned char* yb; const float* b2;
    __device__ __forceinline__ void operator()(const f32x4 (&acc)[2][2][4][2], const Unit& u, int wr, int wc, int fr, int fq) const {
        const int col0 = u.pn * 256 + wc * 32 + 8 * fq;
        const float* bp = b2 + (size_t)u.e * 1024 + col0;
#pragma unroll
        for (int bj = 0; bj < 2; ++bj) {
            const f32x4 bv0 = *(const f32x4*)(bp + 128 * bj) * Y_SCALE, bv1 = *(const f32x4*)(bp + 128 * bj + 4) * Y_SCALE;
#pragma unroll
            for (int ai = 0; ai < 2; ++ai)
#pragma unroll
                for (int m = 0; m < 4; ++m) {
                    unsigned char* rowp = yb + (size_t)(u.pm * 256 + ai * 128 + wr * 64 + m * 16 + fr) * 1024 + col0;
                    const f32x4 v0 = acc[ai][bj][m][0] * (Y_SCALE / (W_SCALE * ACT_SCALE)) + bv0, v1 = acc[ai][bj][m][1] * (Y_SCALE / (W_SCALE * ACT_SCALE)) + bv1;
                    u32x2 w; w.x = pk4_fp8(v0[0], v0[1], v0[2], v0[3]); w.y = pk4_fp8(v1[0], v1[1], v1[2], v1[3]);
                    *(u32x2*)(rowp + 128 * bj) = w;
                }
        }
    }
};
}

namespace att {
constexpr int PITCH = INW, SLOTB = 8192;
constexpr int NSLOT = 4;
constexpr int L_K = 0, L_V = NSLOT * SLOTB, L_WS = 2 * NSLOT * SLOTB, L_KS = L_WS + 2048, L_OST = L_KS + 2048, L_END = L_OST + 8 * 4096;
static_assert(NSLOT == 4 && L_END <= 131072, "attention LDS map");
constexpr float NEG = -1.0e30f, M0 = -1.0e20f, THR = 8.0f;
typedef LAS const char* lds_cptr;
__device__ __forceinline__ int crow(int r, int hi) { return (r & 3) + 8 * (r >> 2) + 4 * hi; }
__device__ __forceinline__ void glds16(const void* gsrc, unsigned lds_dst) { unsigned keep;
    asm volatile("s_mov_b32 %0, m0\n\ts_mov_b32 m0, %2\n\ts_nop 0\n\tglobal_load_lds_dwordx4 %1, off\n\ts_mov_b32 m0, %0" : "=&s"(keep) : "v"(gsrc), "s"(lds_dst) : "memory"); }
#define ATT_WAIT_BAR0() asm volatile("s_waitcnt vmcnt(0) lgkmcnt(0)\n\ts_barrier" ::: "memory")
#define ATT_WAIT_BARN(N) asm volatile("s_waitcnt vmcnt(" #N ") lgkmcnt(0)\n\ts_barrier" ::: "memory")
#define ATT_SBAR() __builtin_amdgcn_sched_barrier(0)

__device__ __forceinline__ void qkt(f32x16& p0, f32x16& p1, lds_cptr kb, const bf16x8* qr, const f32x16& negm) {
#pragma unroll
    for (int d0 = 0; d0 < 4; ++d0) {
        const bf16x8 b0 = *(const LAS bf16x8*)(kb + d0 * 2048);
        const bf16x8 b1 = *(const LAS bf16x8*)(kb + d0 * 2048 + 512);
        if (d0 == 0) { p0 = __builtin_amdgcn_mfma_f32_32x32x16_bf16(b0, qr[0], negm, 0, 0, 0); p1 = __builtin_amdgcn_mfma_f32_32x32x16_bf16(b1, qr[0], negm, 0, 0, 0); }
        else { p0 = __builtin_amdgcn_mfma_f32_32x32x16_bf16(b0, qr[d0], p0, 0, 0, 0); p1 = __builtin_amdgcn_mfma_f32_32x32x16_bf16(b1, qr[d0], p1, 0, 0, 0); }
    }
}
__device__ __forceinline__ float rowmax32(const f32x16& p0, const f32x16& p1) {
    float a = fmaxf(p0[0], p1[0]);
#pragma unroll
    for (int r = 1; r < 16; ++r) a = fmaxf(a, fmaxf(p0[r], p1[r]));
    auto rr = __builtin_amdgcn_permlane32_swap(__float_as_uint(a), __float_as_uint(a), false, false);
    return fmaxf(__uint_as_float(rr[0]), __uint_as_float(rr[1]));
}
__device__ __forceinline__ void pv(f32x16* o, int vb, bf16x8 pa0, bf16x8 pa1, bf16x8 pa2, bf16x8 pa3) {
#pragma unroll
    for (int d0 = 0; d0 < 2; ++d0) { s16x4 lo[4], hi[4];
#pragma unroll
        for (int ks = 0; ks < 4; ++ks) {
            asm volatile("ds_read_b64_tr_b16 %0,%1 offset:%c2" : "=&v"(lo[ks]) : "v"(vb), "i"(d0 * 4096 + ks * 1024) : "memory");
            asm volatile("ds_read_b64_tr_b16 %0,%1 offset:%c2" : "=&v"(hi[ks]) : "v"(vb), "i"(d0 * 4096 + ks * 1024 + 512) : "memory"); }
        asm volatile("s_waitcnt lgkmcnt(0)" ::: "memory"); ATT_SBAR();
#define ATT_PK(k) (bf16x8){lo[k][0], lo[k][1], lo[k][2], lo[k][3], hi[k][0], hi[k][1], hi[k][2], hi[k][3]}
        o[d0] = __builtin_amdgcn_mfma_f32_32x32x16_bf16(pa0, ATT_PK(0), o[d0], 0, 0, 0);
        o[d0] = __builtin_amdgcn_mfma_f32_32x32x16_bf16(pa1, ATT_PK(1), o[d0], 0, 0, 0);
        o[d0] = __builtin_amdgcn_mfma_f32_32x32x16_bf16(pa2, ATT_PK(2), o[d0], 0, 0, 0);
        o[d0] = __builtin_amdgcn_mfma_f32_32x32x16_bf16(pa3, ATT_PK(3), o[d0], 0, 0, 0);
#undef ATT_PK
    }
}

template <bool MOBA>
__device__ __forceinline__ void attn_item(char* shm, const bf16_t* __restrict__ qkv, bf16_t* __restrict__ aout, int b, int hh, int qb, const float* __restrict__ sinks, const float* __restrict__ ksum) {
    int tid = threadIdx.x; asm volatile("" : "+v"(tid));
    const int lane = tid & 63, r32 = lane & 31, hi = lane >> 5; const int wid = __builtin_amdgcn_readfirstlane(tid >> 6);
    const long rowbase = (long)b * SEQ;
    int qa, qcol, kcol, vcol, ocol, kt0, kt1;
    if (MOBA) { qa = 256 * qb + 32 * wid; qcol = 768 + 64 * hh; kcol = 1280 + 64 * hh; vcol = 1792 + 64 * hh; ocol = 512 + 64 * hh; kt0 = 0; kt1 = 4 * qb + 4; }
    else { const int g = wid >> 1; qa = 64 * qb + 32 * (wid & 1); qcol = (4 * hh + g) * 64; kcol = 512 + 64 * hh; vcol = 640 + 64 * hh; ocol = qcol; kt0 = qb - 2 < 0 ? 0 : qb - 2; kt1 = qb + 1; }
    const bf16_t* Qw = qkv + (rowbase + qa) * PITCH + qcol;
    const bf16_t* Kh = qkv + rowbase * PITCH + kcol; const bf16_t* Vh = qkv + rowbase * PITCH + vcol;
    const unsigned lds0 = (unsigned)(uintptr_t)shm;
    float* wsf = (float*)(shm + L_WS) + wid * 64;
    const bf16_t* ksrc = Kh + (long)lane * PITCH + wid * 8;
    const bf16_t* vsrc = Vh + (long)(16 * (wid & 3) + (lane >> 2)) * PITCH + (wid >> 2) * 32 + (lane & 3) * 8;
    const unsigned kdst = lds0 + L_K + wid * 1024, vdst = lds0 + L_V + wid * 1024;
#define ATT_DMA_K(t, slot) glds16(ksrc + (long)(t) * 64 * PITCH, (unsigned)__builtin_amdgcn_readfirstlane(kdst + (slot)))
#define ATT_DMA_V(t, slot) glds16(vsrc + (long)(t) * 64 * PITCH, (unsigned)__builtin_amdgcn_readfirstlane(vdst + (slot)))
    const int vb0 = (int)(lds0 + L_V) + ((lane >> 4) & 1) * 32 + (lane & 3) * 8 + (4 * hi + ((lane & 15) >> 2)) * 64;
    const lds_cptr shm3 = (lds_cptr)shm; const lds_cptr kp0 = shm3 + L_K + hi * 1024 + r32 * 16;
    const int NT = kt1 - kt0;
    ATT_DMA_K(kt0, 0); ATT_DMA_V(kt0, 0);
    if (NT > 1) { ATT_DMA_K(kt0 + 1, SLOTB); ATT_DMA_V(kt0 + 1, SLOTB); }
    if (NT > 2) { ATT_DMA_K(kt0 + 2, 2 * SLOTB); ATT_DMA_V(kt0 + 2, 2 * SLOTB); }
    if (MOBA) { float* ksl = (float*)(shm + L_KS); ksl[tid] = ksum[((size_t)b * 8 + (tid >> 6)) * 512 + 64 * hh + (tid & 63)]; }
    bf16x8 qr[4];
#pragma unroll
    for (int d0 = 0; d0 < 4; ++d0) qr[d0] = *reinterpret_cast<const bf16x8*>(&Qw[(long)r32 * PITCH + d0 * 16 + hi * 8]);
    float m_run, l_run;
    if (MOBA) { m_run = M0; l_run = 0.f; }
    else { m_run = sinks[4 * hh + (wid >> 1)] * LOG2E; l_run = (hi == 0) ? 1.0f : 0.0f; }
    f32x16 negm;
#pragma unroll
    for (int r = 0; r < 16; ++r) negm[r] = MOBA ? 0.f : -m_run;
    f32x16 o[2]; o[0] = f32x16{}; o[1] = f32x16{};
    ATT_WAIT_BAR0();
    unsigned sel = 0u;
    if (MOBA) {
        if (qb <= 3) sel = (1u << qb) - 1u;
        else {
            const float* ksl = (const float*)(shm + L_KS);
            float gv[7];
#pragma unroll
            for (int i = 0; i < 7; ++i) {
                float s = 0.f;
#pragma unroll
                for (int d0 = 0; d0 < 4; ++d0) {
                    const f32x4 k0 = *(const f32x4*)(ksl + i * 64 + 16 * d0 + 8 * hi), k1 = *(const f32x4*)(ksl + i * 64 + 16 * d0 + 8 * hi + 4);
#pragma unroll
                    for (int jj = 0; jj < 4; ++jj) { s += bf2f((unsigned short)qr[d0][jj]) * k0[jj]; s += bf2f((unsigned short)qr[d0][4 + jj]) * k1[jj]; }
                }
                auto rr = __builtin_amdgcn_permlane32_swap(__float_as_uint(s), __float_as_uint(s), false, false);
                s = __uint_as_float(rr[0]) + __uint_as_float(rr[1]);
                gv[i] = (i < qb) ? s : -INFINITY;
            }
#pragma unroll
            for (int rk = 0; rk < 3; ++rk) { float best = -INFINITY; int bi = 0;
#pragma unroll
                for (int i = 0; i < 7; ++i) { const bool c = (((sel >> i) & 1u) == 0u) && (gv[i] > best); best = c ? gv[i] : best; bi = c ? i : bi; }
                sel |= 1u << bi; }
        }
    }
    for (int it = 0; it < NT; ++it) {
        const int kt = kt0 + it; const int cur = (it & (NSLOT - 1)) * SLOTB;
        if (it + 3 < NT) { const int sl = ((it + 3) & (NSLOT - 1)) * SLOTB; ATT_DMA_K(kt + 3, sl); ATT_DMA_V(kt + 3, sl); }
        bool need; bool on = true;
        if (MOBA) { if (kt < 4 * qb) { on = ((sel >> (kt >> 2)) & 1u) != 0u; need = __any(on) != 0; } else need = (64 * kt <= qa + 31); }
        else need = (64 * kt + 63 >= qa - 127) && (64 * kt <= qa + 31);
        if (need) {
            f32x16 p0, p1; qkt(p0, p1, kp0 + cur, qr, negm);
            if (MOBA && kt < 4 * qb) {
                if (!__all(on)) {
#pragma unroll
                    for (int r = 0; r < 16; ++r) { p0[r] = on ? p0[r] : NEG; p1[r] = on ? p1[r] : NEG; }
                }
            } else {
                const bool edge = MOBA ? (64 * kt + 63 > qa) : !((64 * kt + 63 <= qa) && (qa + 31 - 64 * kt <= 127));
                if (edge) {
                    const int dq = qa + r32 - 64 * kt - 4 * hi;
#pragma unroll
                    for (int r = 0; r < 16; ++r) { const int d0_ = dq - ((r & 3) + 8 * (r >> 2)), d1_ = d0_ - 32;
                        const bool v0 = MOBA ? (d0_ >= 0) : ((unsigned)d0_ < 128u), v1 = MOBA ? (d1_ >= 0) : ((unsigned)d1_ < 128u);
                        p0[r] = v0 ? p0[r] : NEG; p1[r] = v1 ? p1[r] : NEG; }
                }
            }
            const float rm = rowmax32(p0, p1);
            const bool sent = (m_run <= M0), live = (rm > 0.5f * NEG);
            const bool upd = sent ? live : (rm > THR);
            if (__any(upd)) {
                const float dl = sent ? (live ? rm : 0.f) : fmaxf(rm, 0.f);
                const float f = sent ? 1.0f : __builtin_amdgcn_exp2f(-dl);
                m_run = sent ? (live ? rm : m_run) : (m_run + dl);
                const float nm = (m_run <= M0) ? 0.f : -m_run;
#pragma unroll
                for (int r = 0; r < 16; ++r) { p0[r] -= dl; p1[r] -= dl; negm[r] = nm; }
                l_run *= f;
                if (hi == 0) wsf[r32] = f;
                LDS_WAIT();
#pragma unroll
                for (int r = 0; r < 16; ++r) { const float fr_ = wsf[crow(r, hi)]; o[0][r] *= fr_; o[1][r] *= fr_; }
            }
            float sacc = 0.f;
#pragma unroll
            for (int r = 0; r < 16; ++r) { p0[r] = __builtin_amdgcn_exp2f(p0[r]); p1[r] = __builtin_amdgcn_exp2f(p1[r]); sacc += p0[r] + p1[r]; }
            l_run += sacc;
            u32x4 pw0, pw1, pw2, pw3;
            pw0 = (u32x4){cvtpk(p0[0], p0[1]), cvtpk(p0[2], p0[3]), cvtpk(p0[4], p0[5]), cvtpk(p0[6], p0[7])};
            pw1 = (u32x4){cvtpk(p0[8], p0[9]), cvtpk(p0[10], p0[11]), cvtpk(p0[12], p0[13]), cvtpk(p0[14], p0[15])};
            pw2 = (u32x4){cvtpk(p1[0], p1[1]), cvtpk(p1[2], p1[3]), cvtpk(p1[4], p1[5]), cvtpk(p1[6], p1[7])};
            pw3 = (u32x4){cvtpk(p1[8], p1[9]), cvtpk(p1[10], p1[11]), cvtpk(p1[12], p1[13]), cvtpk(p1[14], p1[15])};
            ATT_SBAR();
            pv(o, vb0 + cur, __builtin_bit_cast(bf16x8, pw0), __builtin_bit_cast(bf16x8, pw1), __builtin_bit_cast(bf16x8, pw2), __builtin_bit_cast(bf16x8, pw3));
        }
        if (it + 1 < NT) {
            if (it + 3 < NT) ATT_WAIT_BARN(4); else if (it + 2 < NT) ATT_WAIT_BARN(2); else ATT_WAIT_BAR0();
        }
    }
    { auto rr = __builtin_amdgcn_permlane32_swap(__float_as_uint(l_run), __float_as_uint(l_run), false, false); l_run = __uint_as_float(rr[0]) + __uint_as_float(rr[1]); }
    if (hi == 0) wsf[32 + r32] = l_run;
    LDS_WAIT();
    float rli[16];
#pragma unroll
    for (int r = 0; r < 16; ++r) rli[r] = __builtin_amdgcn_rcpf(wsf[32 + crow(r, hi)]);
    bf16_t* Ow = aout + (rowbase + qa) * D + ocol;
    { bf16_t* stg = (bf16_t*)(shm + L_OST) + wid * 2048;
#pragma unroll
        for (int r = 0; r < 16; ++r) { const int orow = crow(r, hi);
#pragma unroll
            for (int d0 = 0; d0 < 2; ++d0) stg[orow * 64 + d0 * 32 + r32] = (bf16_t)f2bf(o[d0][r] * rli[r]); }
        LDS_WAIT();
#pragma unroll
        for (int i = 0; i < 4; ++i) { const int row = i * 8 + (lane >> 3), ch = lane & 7; const u32x4 v = *(const u32x4*)(stg + row * 64 + ch * 8); *(u32x4*)(Ow + (long)row * D + ch * 8) = v; } }
    asm volatile("s_waitcnt lgkmcnt(0)\n\ts_barrier" ::: "memory");
#undef ATT_DMA_K
#undef ATT_DMA_V
}
}

__device__ __forceinline__ void sincos_d(double a, double& s, double& c) {
    const double q = __builtin_rint(a * 0.63661977236758134308);
    double r = __builtin_fma(-q, 1.57079632679489655800e+00, a);
    r = __builtin_fma(-q, 6.12323399573676603587e-17, r);
    const double r2 = r * r;
    double sp = -1.0 / 1307674368000.0;
    sp = sp * r2 + 1.0 / 6227020800.0; sp = sp * r2 - 1.0 / 39916800.0; sp = sp * r2 + 1.0 / 362880.0; sp = sp * r2 - 1.0 / 5040.0; sp = sp * r2 + 1.0 / 120.0; sp = sp * r2 - 1.0 / 6.0;
    const double sr = r + r * r2 * sp;
    double cp = 1.0 / 20922789888000.0;
    cp = cp * r2 - 1.0 / 87178291200.0; cp = cp * r2 + 1.0 / 479001600.0; cp = cp * r2 - 1.0 / 3628800.0; cp = cp * r2 + 1.0 / 40320.0; cp = cp * r2 - 1.0 / 720.0; cp = cp * r2 + 1.0 / 24.0; cp = cp * r2 - 0.5;
    const double cr = 1.0 + r2 * cp;
    const int n = ((int)q) & 3;
    s = (n == 0) ? sr : (n == 1) ? cr : (n == 2) ? -sr : -cr;
    c = (n == 0) ? cr : (n == 1) ? -sr : (n == 2) ? -cr : sr;
}
__device__ __forceinline__ int sigma_col(int p, int mode) {
    if (mode == 0) return (p & ~255) + 64 * ((p >> 5) & 3) + 32 * ((p >> 7) & 1) + pg8::perm32(p & 31);
    if (mode == 1) return (p & ~31) + pg8::perm32(p & 31);
    const int pn = p >> 8, q = p & 255; return 2 * (128 * pn + 32 * ((q >> 5) & 3) + pg8::perm32(q & 31)) + (q >> 7);
}
__device__ __forceinline__ void p0_transpose_item(const float* __restrict__ W, int N, bf16_t* __restrict__ WT, int mode, LAS float* scr, int item, int lane) {
    const int nblk = N / 32, kb = item / nblk, nb = item % nblk, k0 = 64 * kb, p0 = 32 * nb;
    const int sc = sigma_col(p0 + (lane & 31), mode);
#pragma unroll 8
    for (int i = 0; i < 32; ++i) { const int kk = 2 * i + (lane >> 5); scr[kk * 33 + (lane & 31)] = W[(size_t)(k0 + kk) * N + sc]; }
    LDS_WAIT(); asm volatile("" ::: "memory");
    const int c = lane & 7;
#pragma unroll
    for (int j = 0; j < 4; ++j) { const int n = (lane >> 3) + 8 * j; const LAS float* s = scr + (8 * c) * 33 + n;
        u32x4 o; o.x = cvtpk(s[0 * 33], s[1 * 33]); o.y = cvtpk(s[2 * 33], s[3 * 33]); o.z = cvtpk(s[4 * 33], s[5 * 33]); o.w = cvtpk(s[6 * 33], s[7 * 33]);
        *(u32x4*)(WT + (size_t)(p0 + n) * 1024 + k0 + 8 * c) = o; }
    LDS_WAIT(); asm volatile("" ::: "memory");
}

__device__ __forceinline__ void p0_transpose_item_fp8(const float* __restrict__ W, int N, unsigned char* __restrict__ WT, int mode, float scale, LAS float* scr, int item, int lane) {
    const int nblk = N / 32, kb = item / nblk, nb = item % nblk, k0 = 64 * kb, p0 = 32 * nb;
    const int sc = sigma_col(p0 + (lane & 31), mode);
#pragma unroll 8
    for (int i = 0; i < 32; ++i) { const int kk = 2 * i + (lane >> 5); scr[kk * 33 + (lane & 31)] = W[(size_t)(k0 + kk) * N + sc] * scale; }
    LDS_WAIT(); asm volatile("" ::: "memory");
    const int c = lane & 7;
#pragma unroll
    for (int j = 0; j < 4; ++j) { const int n = (lane >> 3) + 8 * j; const LAS float* s = scr + (8 * c) * 33 + n;
        u32x2 o; o.x = pk4_fp8(s[0 * 33], s[1 * 33], s[2 * 33], s[3 * 33]); o.y = pk4_fp8(s[4 * 33], s[5 * 33], s[6 * 33], s[7 * 33]);
        *(u32x2*)(WT + (size_t)(p0 + n) * 1024 + k0 + 8 * c) = o; }
    LDS_WAIT(); asm volatile("" ::: "memory");
}


#define XB_TMO      128
#define XB_XCNT(j)  (256  + 64 * (j))
#define XB_XSUB(j)  (1280 + 64 * (j))
#define XB_XGEN(j)  (2304 + 64 * (j))
#define XB_TOP      3328
#define XB_TOPGEN   3392
#define XCD_BAR_WORDS 3456
#define XB_SPIN_CAP (1u << 18)
__device__ __forceinline__ unsigned xb_ld(unsigned* p)              { return __hip_atomic_load(p, __ATOMIC_RELAXED, __HIP_MEMORY_SCOPE_AGENT); }
__device__ __forceinline__ unsigned xb_add(unsigned* p, unsigned v) { return __hip_atomic_fetch_add(p, v, __ATOMIC_RELAXED, __HIP_MEMORY_SCOPE_AGENT); }
__device__ __forceinline__ unsigned xb_xcc_id() { return (unsigned)__builtin_amdgcn_s_getreg((3 << 11) | 20) & 0xFu; }
#define XB_SPIN(cond, bar) do { unsigned _sp = 0; while (cond) { __builtin_amdgcn_s_sleep(1); \
    if ((++_sp & 255u) == 0u) { if (xb_ld(&(bar)[XB_TMO])) break; if (_sp > XB_SPIN_CAP) { atomicAdd(&(bar)[XB_TMO], 1u); break; } } } } while (0)
struct XcdBarrier { unsigned* bar; unsigned x; volatile LAS unsigned* st; };
__device__ __forceinline__ XcdBarrier xcd_barrier_post(unsigned* bar, volatile LAS unsigned* st) {
    XcdBarrier b; b.bar = bar; b.x = xb_xcc_id(); b.st = st;
    if (threadIdx.x == 0) (void)xb_add(&bar[XB_XCNT(b.x)], 1u);
    return b;
}
__device__ __forceinline__ void xcd_barrier_complete(unsigned* bar, unsigned x, unsigned& nloc, unsigned& nx) {
    const unsigned G = gridDim.x * gridDim.y * gridDim.z;
    unsigned sum, cnt, mine, sp = 0u;
    for (;;) {
        sum = 0u; cnt = 0u; mine = 0u;
#pragma unroll
        for (unsigned j = 0; j < 16; ++j) { const unsigned c = xb_ld(&bar[XB_XCNT(j)]); sum += c; cnt += (c > 0u) ? 1u : 0u; mine = (j == x) ? c : mine; }
        if (sum == G) break;
        __builtin_amdgcn_s_sleep(1);
        if ((++sp & 255u) == 0u) { if (xb_ld(&bar[XB_TMO])) break; if (sp > XB_SPIN_CAP) { atomicAdd(&bar[XB_TMO], 1u); break; } }
    }
    nloc = mine > 0u ? mine : 1u; nx = cnt > 0u ? cnt : 1u;
}
__device__ __forceinline__ void xcd_barrier(const XcdBarrier& b) {
    asm volatile("s_waitcnt vmcnt(0)" ::: "memory");
    __syncthreads();
    if (threadIdx.x == 0) {
        unsigned* bar = b.bar;
        __builtin_amdgcn_s_waitcnt(0);
        unsigned nloc = b.st[0], nx = b.st[1];
        if (nloc == 0u) { xcd_barrier_complete(bar, b.x, nloc, nx); b.st[0] = nloc; b.st[1] = nx; }
        const unsigned old = xb_add(&bar[XB_XSUB(b.x)], 1u);
        const unsigned gen = old / nloc;
        if (old + 1u == (gen + 1u) * nloc) {
            __builtin_amdgcn_fence(__ATOMIC_RELEASE, "agent");
            asm volatile("s_waitcnt vmcnt(0)" ::: "memory");
            const unsigned og = xb_add(&bar[XB_TOP], 1u);
            const unsigned tg = og / nx;
            if (og + 1u == (tg + 1u) * nx) xb_add(&bar[XB_TOPGEN], 1u);
            else XB_SPIN(xb_ld(&bar[XB_TOPGEN]) == tg, bar);
            __builtin_amdgcn_fence(__ATOMIC_ACQUIRE, "agent");
            xb_add(&bar[XB_XGEN(b.x)], 1u);
            asm volatile("s_waitcnt vmcnt(0)" ::: "memory");
        } else {
            XB_SPIN(xb_ld(&bar[XB_XGEN(b.x)]) == gen, bar);
            __builtin_amdgcn_fence(__ATOMIC_ACQUIRE, "agent");
            asm volatile("s_waitcnt vmcnt(0)" ::: "memory");
        }
    }
    __syncthreads();
}

__global__ void __launch_bounds__(NTHREADS, 2) fwd_megakernel(Params p_arg) {
    extern __shared__ __attribute__((aligned(16))) unsigned char lds_raw[];
    LAS unsigned char* lds = (LAS unsigned char*)lds_raw;
    cg::grid_group grid = cg::this_grid();
#define PHASE_IDS() int tid = threadIdx.x; asm volatile("" : "+v"(tid)); const int lane = tid & 63, wave = __builtin_amdgcn_readfirstlane(tid >> 6); (void)lane; (void)wave
    const int G = gridDim.x, bx = blockIdx.x;
    typedef const __attribute__((address_space(4))) Params* KParams;
    const KParams kp0 = (KParams)__builtin_amdgcn_kernarg_segment_ptr();
#define PHASE_PTRS() KParams _kp = kp0; asm volatile("" : "+s"(_kp)); Params p; p.x = _kp->x; p.w_in = _kp->w_in; p.b_in = _kp->b_in; p.sinks = _kp->sinks; p.w_out = _kp->w_out; p.b_out = _kp->b_out; p.ln1_g = _kp->ln1_g; p.ln1_b = _kp->ln1_b; \
    p.w_router = _kp->w_router; p.b_router = _kp->b_router; p.w1 = _kp->w1; p.b1 = _kp->b1; p.w2 = _kp->w2; p.b2 = _kp->b2; p.ln2_g = _kp->ln2_g; p.ln2_b = _kp->ln2_b; p.out = _kp->out; p.ws = _kp->ws; unsigned char* const ws = p.ws; \
    unsigned* const ctl = (unsigned*)(ws + WS_CTL); float* const ksum = (float*)(ws + WS_KSUM); float* const rope = (float*)(ws + WS_ROPE); \
    bf16_t* const w_in_t = (bf16_t*)(ws + WS_WIN_T); bf16_t* const w_out_t = (bf16_t*)(ws + WS_WOUT_T); \
    unsigned char* const w1_8 = ws + WS_W1_8; unsigned char* const w2_8 = ws + WS_W2_8; unsigned char* const x1_8 = ws + WS_X1_8; unsigned char* const act8 = ws + WS_ACT8; \
    int* const cnt_blk = (int*)(ws + WS_CNT); int* const tile_e = (int*)(ws + WS_TILE_E); bf16_t* const wr_hi = (bf16_t*)(ws + WS_WR_HI); bf16_t* const wr_lo = (bf16_t*)(ws + WS_WR_LO); \
    int* const tok = (int*)(ws + WS_TOK); int* const asg_e = (int*)(ws + WS_ASG_E); float* const asg_g = (float*)(ws + WS_ASG_G); int* const asg_d = (int*)(ws + WS_ASG_D); \
    bf16_t* const x1b = (bf16_t*)(ws + WS_X1B); bf16_t* const xb = (bf16_t*)(ws + WS_XB); bf16_t* const attn_o = xb; bf16_t* const qkv = (bf16_t*)(ws + WS_QKV); unsigned char* const yb = ws + WS_YB; \
    (void)ctl; (void)ksum; (void)rope; (void)w_in_t; (void)w_out_t; (void)w1_8; (void)w2_8; (void)x1_8; (void)act8; (void)cnt_blk; (void)tile_e; (void)wr_hi; (void)wr_lo; (void)tok; (void)asg_e; (void)asg_g; (void)asg_d; \
    (void)x1b; (void)xb; (void)attn_o; (void)qkv; (void)yb
    if (threadIdx.x < 2) ((LAS unsigned*)(lds + LDS_BARST))[threadIdx.x] = 0u;
    __syncthreads();
    XcdBarrier xbar;
    { PHASE_PTRS(); xbar = xcd_barrier_post(ctl + CW_BAR, (volatile LAS unsigned*)(lds + LDS_BARST)); }

    REP(0) {
        PHASE_IDS(); PHASE_PTRS();
        const long gt = (long)bx * NTHREADS + tid, gsz = (long)G * NTHREADS;
        for (long i = gt; i < 2048 * 32; i += gsz) {
            const int pos = (int)(i >> 5), k = (int)(i & 31);
            double inv = 1.0; for (int q = 0; q < k; ++q) inv *= 0.7498942093324559;
            double s, c; sincos_d((double)pos * inv, s, c);
            rope[pos * 64 + k] = (float)c; rope[pos * 64 + 32 + k] = (float)s;
        }
        for (long i = gt; i < 32 * 1024; i += gsz) {
            const int e = (int)(i >> 10), k = (int)(i & 1023); const float w = p.w_router[k * 32 + e];
            const unsigned h = f2bf(w); wr_hi[i] = (bf16_t)h; wr_lo[i] = (bf16_t)f2bf(w - bf2f(h));
        }
        LAS float* scr = (LAS float*)(lds + wave * 16384);
        const int gw = bx * 8 + wave, NGW = G * 8;
        constexpr int I_IN = 16 * (INW / 32), I_OUT = 16 * 32, I_W1 = 16 * 64, I_W2 = 16 * 32;
        constexpr int NITEMS = I_IN + I_OUT + NE * I_W1 + NE * I_W2;
        for (int it = gw; it < NITEMS; it += NGW) {
            int r = it;
#if INPROJ_FP8
            if (r < I_IN) { p0_transpose_item_fp8(p.w_in, INW, (unsigned char*)w_in_t, 0, WIN_SCALE, scr, r, lane); continue; } r -= I_IN;
#else
            if (r < I_IN) { p0_transpose_item(p.w_in, INW, w_in_t, 0, scr, r, lane); continue; } r -= I_IN;
#endif
            if (r < I_OUT) { p0_transpose_item(p.w_out, 1024, w_out_t, 1, scr, r, lane); continue; } r -= I_OUT;
            if (r < NE * I_W1) { const int e = r / I_W1; p0_transpose_item_fp8(p.w1 + (size_t)e * 1024 * 2048, 2048, w1_8 + (size_t)e * 2048 * 1024, 2, W_SCALE, scr, r % I_W1, lane); continue; } r -= NE * I_W1;
            { const int e = r / I_W2; p0_transpose_item_fp8(p.w2 + (size_t)e * 1024 * 1024, 1024, w2_8 + (size_t)e * 1024 * 1024, 1, W_SCALE, scr, r % I_W2, lane); }
        }
        const f32x4* x4 = (const f32x4*)p.x;
#if INPROJ_FP8
        u32x2* x8 = (u32x2*)xb;
        for (long i = gt; i < (long)T * D / 8; i += gsz) { const f32x4 a = x4[2 * i], b = x4[2 * i + 1];
            u32x2 o; o.x = pk4_fp8(a[0], a[1], a[2], a[3]); o.y = pk4_fp8(b[0], b[1], b[2], b[3]); x8[i] = o; }
#else
        u32x4* xb4 = (u32x4*)xb;
        for (long i = gt; i < (long)T * D / 8; i += gsz) { const f32x4 a = x4[2 * i], b = x4[2 * i + 1];
            u32x4 o; o.x = cvtpk(a[0], a[1]); o.y = cvtpk(a[2], a[3]); o.z = cvtpk(b[0], b[1]); o.w = cvtpk(b[2], b[3]); xb4[i] = o; }
#endif
    }
    grid.sync();

    REP(1) {
        PHASE_PTRS();
#if INPROJ_FP8
        pg8::SchedInProj<1024> S{(const char*)xb, (const char*)w_in_t, G, bx};
        pg8::EpiInProj E{qkv, p.b_in, rope, ksum, 1.0f / WIN_SCALE};
        pg8::gemm_phase<pg8::EpiInProj, pg8::SchedInProj<1024>, false, true, 512, true>(lds, S, E);
#else
        pg8::SchedInProj<2048> S{(const char*)xb, (const char*)w_in_t, G, bx};
        pg8::EpiInProj E{qkv, p.b_in, rope, ksum, 1.0f};
        pg8::gemm_phase<pg8::EpiInProj, pg8::SchedInProj<2048>, false, true>(lds, S, E);
#endif
    }
    xcd_barrier(xbar);

    REP(2) for (int u = bx; u < 256; u += G) {
        PHASE_PTRS();
        { const int b = u >> 3, h = u & 7;
            for (int j = 0; j < 8; ++j) att::attn_item<true>((char*)lds_raw, qkv, attn_o, b, h, j, p.sinks, ksum); }
        { const int b = u >> 3, kvh = (u >> 2) & 1, oct = u & 3;
            for (int i = 0; i < 8; ++i) att::attn_item<false>((char*)lds_raw, qkv, attn_o, b, kvh, oct * 8 + i, p.sinks, ksum); }
    }
    xcd_barrier(xbar);

    REP(3) for (int pm = bx; pm < T / 256; pm += G) {
        PHASE_IDS(); PHASE_PTRS();
        {
            pg8::SchedPanel S{(const char*)attn_o, (const char*)w_out_t, pm};
            pg8::EpiOutProj E{(bf16_t*)p.out, p.b_out, p.x};
            pg8::gemm_phase<pg8::EpiOutProj, pg8::SchedPanel, false, true>(lds, S, E);
        }
        __syncthreads();
        {
#pragma unroll
            for (int i = 0; i < 16; ++i) { const int idx = tid + 512 * i, mat = idx >> 12, rw = (idx >> 7) & 31, ch = idx & 127;
                const u32x4 v = *(const u32x4*)((mat ? wr_lo : wr_hi) + rw * 1024 + ch * 8);
                *(LAS u32x4*)(lds + mat * 66048 + rw * 2064 + ch * 16) = v; }
        }
        {
            const bf16_t* ytmp = (const bf16_t*)p.out;
            f32x4 gg[2][2], bb[2][2];
#pragma unroll
            for (int j = 0; j < 2; ++j)
#pragma unroll
                for (int h = 0; h < 2; ++h) { gg[j][h] = *(const f32x4*)(p.ln1_g + 512 * j + 8 * lane + 4 * h); bb[j][h] = *(const f32x4*)(p.ln1_b + 512 * j + 8 * lane + 4 * h); }
            for (int rr = 0; rr < 32; rr += 4) {
                const size_t row0 = (size_t)pm * 256 + wave * 32 + rr;
                u32x4 raw[4][2]; float v[4][2][8]; float sm[4], sq[4];
#pragma unroll
                for (int q = 0; q < 4; ++q)
#pragma unroll
                    for (int j = 0; j < 2; ++j) raw[q][j] = *(const u32x4*)(ytmp + (row0 + q) * D + 512 * j + 8 * lane);
#pragma unroll
                for (int q = 0; q < 4; ++q) { float s_ = 0.f;
#pragma unroll
                    for (int j = 0; j < 2; ++j)
#pragma unroll
                        for (int c = 0; c < 4; ++c) { const unsigned w = raw[q][j][c]; v[q][j][2 * c] = bf2f(w & 0xffffu); v[q][j][2 * c + 1] = bf2f(w >> 16); s_ += v[q][j][2 * c] + v[q][j][2 * c + 1]; }
                    sm[q] = s_; }
#pragma unroll
                for (int o = 1; o < 64; o <<= 1) {
#pragma unroll
                    for (int q = 0; q < 4; ++q) sm[q] += __shfl_xor(sm[q], o); }
#pragma unroll
                for (int q = 0; q < 4; ++q) { const float mean = sm[q] * (1.0f / D); float s2 = 0.f;
#pragma unroll
                    for (int j = 0; j < 2; ++j)
#pragma unroll
                        for (int c = 0; c < 8; ++c) { v[q][j][c] -= mean; s2 += v[q][j][c] * v[q][j][c]; }
                    sq[q] = s2; }
#pragma unroll
                for (int o = 1; o < 64; o <<= 1) {
#pragma unroll
                    for (int q = 0; q < 4; ++q) sq[q] += __shfl_xor(sq[q], o); }
#pragma unroll
                for (int q = 0; q < 4; ++q) {
                    const float rstd = 1.0f / sqrtf(sq[q] * (1.0f / D) + LN_EPS);
#pragma unroll
                    for (int j = 0; j < 2; ++j) {
                        float xv[8];
#pragma unroll
                        for (int c = 0; c < 8; ++c) xv[c] = v[q][j][c] * rstd * gg[j][c >> 2][c & 3] + bb[j][c >> 2][c & 3];
                        u32x4 hv; hv.x = cvtpk(xv[0], xv[1]); hv.y = cvtpk(xv[2], xv[3]); hv.z = cvtpk(xv[4], xv[5]); hv.w = cvtpk(xv[6], xv[7]);
                        u32x2 fv; fv.x = pk4_fp8(xv[0], xv[1], xv[2], xv[3]); fv.y = pk4_fp8(xv[4], xv[5], xv[6], xv[7]);
                        *(u32x4*)(x1b + (row0 + q) * D + 512 * j + 8 * lane) = hv;
                        *(u32x2*)(x1_8 + (row0 + q) * D + 512 * j + 8 * lane) = fv;
                    }
                }
            }
        }
        __syncthreads();
        {
            const int fr = lane & 15, fq = lane >> 4;
            f32x4 lacc[2][2];
#pragma unroll
            for (int m = 0; m < 2; ++m)
#pragma unroll
                for (int n = 0; n < 2; ++n) lacc[m][n] = (f32x4){0.f, 0.f, 0.f, 0.f};
            const size_t r0 = (size_t)pm * 256 + wave * 32;
            const bf16_t* ah = x1b + (r0 + fr) * D + 8 * fq;
            const LAS unsigned char* bh = lds + fr * 2064 + 16 * fq; const LAS unsigned char* bl = bh + 66048;
#pragma unroll 4
            for (int k0 = 0; k0 < 1024; k0 += 32) {
                bf16x8 a_hi[2], b_hi[2], b_lo[2];
#pragma unroll
                for (int m = 0; m < 2; ++m) a_hi[m] = *(const bf16x8*)(ah + (size_t)m * 16 * D + k0);
#pragma unroll
                for (int n = 0; n < 2; ++n) { b_hi[n] = *(const LAS bf16x8*)(bh + n * 16 * 2064 + k0 * 2); b_lo[n] = *(const LAS bf16x8*)(bl + n * 16 * 2064 + k0 * 2); }
#pragma unroll
                for (int m = 0; m < 2; ++m)
#pragma unroll
                    for (int n = 0; n < 2; ++n) {
                        lacc[m][n] = __builtin_amdgcn_mfma_f32_16x16x32_bf16(a_hi[m], b_hi[n], lacc[m][n], 0, 0, 0);
                        lacc[m][n] = __builtin_amdgcn_mfma_f32_16x16x32_bf16(a_hi[m], b_lo[n], lacc[m][n], 0, 0, 0);
                    }
            }
            __syncthreads();
            LAS float* lg = (LAS float*)lds;
#pragma unroll
            for (int m = 0; m < 2; ++m)
#pragma unroll
                for (int n = 0; n < 2; ++n)
#pragma unroll
                    for (int rg = 0; rg < 4; ++rg) lg[(wave * 32 + 16 * m + 4 * fq + rg) * 33 + 16 * n + fr] = lacc[m][n][rg];
        }
        __syncthreads();
        {
            LAS float* lg = (LAS float*)lds;
            LAS int* wcnt = (LAS int*)(lds + 36864);
            float t0 = -INFINITY, t1 = -INFINITY, t2 = -INFINITY, t3 = -INFINITY; int i0 = 0, i1 = 0, i2 = 0, i3 = 0;
            int rk0 = 0, rk1 = 0, rk2 = 0, rk3 = 0;
            if (tid < 256) {
                for (int e = 0; e < NE; ++e) {
                    const float xv = lg[tid * 33 + e] + p.b_router[e];
                    if (xv > t3) {
                        if (xv > t2) { t3 = t2; i3 = i2;
                            if (xv > t1) { t2 = t1; i2 = i1;
                                if (xv > t0) { t1 = t0; i1 = i0; t0 = xv; i0 = e; } else { t1 = xv; i1 = e; }
                            } else { t2 = xv; i2 = e; }
                        } else { t3 = xv; i3 = e; }
                    }
                }
                const unsigned selm = (1u << i0) | (1u << i1) | (1u << i2) | (1u << i3);
                for (int e = 0; e < NE; ++e) {
                    const bool has = ((selm >> e) & 1u) != 0u;
                    const unsigned long long bal = __ballot(has);
                    const int pre = __popcll(bal & ((1ull << lane) - 1ull));
                    if (e == i0) rk0 = pre; if (e == i1) rk1 = pre; if (e == i2) rk2 = pre; if (e == i3) rk3 = pre;
                    if (lane == 0) wcnt[wave * 32 + e] = __popcll(bal);
                }
            }
            __syncthreads();
            if (tid < 256) {
                const float e1 = __expf(t1 - t0), e2 = __expf(t2 - t0), e3 = __expf(t3 - t0);
                const float inv = 1.0f / (1.0f + e1 + e2 + e3);
                int b0 = 0, b1 = 0, b2 = 0, b3 = 0;
                for (int w = 0; w < wave; ++w) { b0 += wcnt[w * 32 + i0]; b1 += wcnt[w * 32 + i1]; b2 += wcnt[w * 32 + i2]; b3 += wcnt[w * 32 + i3]; }
                const size_t a = ((size_t)pm * 256 + tid) * 4;
                *(int4*)(asg_e + a) = make_int4(i0, i1, i2, i3);
                *(float4*)(asg_g + a) = make_float4(inv, e1 * inv, e2 * inv, e3 * inv);
                *(int4*)(asg_d + a) = make_int4(b0 + rk0, b1 + rk1, b2 + rk2, b3 + rk3);
            }
            if (tid < 32) cnt_blk[pm * 32 + tid] = wcnt[tid] + wcnt[32 + tid] + wcnt[64 + tid] + wcnt[96 + tid];
            __syncthreads();
        }
    }
    xcd_barrier(xbar);

    for (int pm = bx; pm < T / 256; pm += G) {
        PHASE_IDS(); PHASE_PTRS();
        LAS int* part_all = (LAS int*)lds; LAS int* part_pre = part_all + 512; LAS int* tot = part_pre + 512; LAS int* pre = tot + 32; LAS int* poff = pre + 32;
        { const int e = tid & 31, seg = tid >> 5; int sa = 0, sp = 0;
            for (int bb = seg * 16; bb < seg * 16 + 16; ++bb) { const int c = cnt_blk[bb * 32 + e]; sa += c; sp += (bb < pm) ? c : 0; }
            part_all[tid] = sa; part_pre[tid] = sp; }
        __syncthreads();
        if (tid < 32) { int sa = 0, sp = 0; for (int s = 0; s < 16; ++s) { sa += part_all[s * 32 + tid]; sp += part_pre[s * 32 + tid]; } tot[tid] = sa; pre[tid] = sp; }
        __syncthreads();
        if (tid == 0) { int off = 0; for (int e = 0; e < NE; ++e) { poff[e] = off; off += ((tot[e] + 255) >> 8) << 8; } poff[32] = off; }
        __syncthreads();
        if (tid < 256) {
            const int token = pm * 256 + tid; const size_t a = (size_t)token * 4;
            const int4 ee = *(const int4*)(asg_e + a); const int4 rk = *(const int4*)(asg_d + a);
            const int d0 = poff[ee.x] + pre[ee.x] + rk.x, d1 = poff[ee.y] + pre[ee.y] + rk.y, d2 = poff[ee.z] + pre[ee.z] + rk.z, d3 = poff[ee.w] + pre[ee.w] + rk.w;
            *(int4*)(asg_d + a) = make_int4(d0, d1, d2, d3);
            tok[d0] = token; tok[d1] = token; tok[d2] = token; tok[d3] = token;
        }
        if (pm < NE) {
            const int e = pm, n = tot[e], np = ((n + 255) >> 8) << 8, o = poff[e];
            for (int i = n + tid; i < np; i += NTHREADS) tok[o + i] = 0;
            for (int i = tid; i < (np >> 8); i += NTHREADS) tile_e[(o >> 8) + i] = e;
        }
        if (pm == 0 && tid == 0) ctl[CW_NTILES] = (unsigned)(poff[32] >> 8);
        __syncthreads();
    }
    xcd_barrier(xbar);

    REP(5) {
        PHASE_PTRS(); const int ntiles = (int)ctl[CW_NTILES];
        pg8::SchedMoe<8, true> S{(const char*)x1_8, (const char*)w1_8, tile_e, tok, ntiles, G, bx};
        pg8::EpiSwiglu E{act8, p.b1};
        pg8::gemm_phase<pg8::EpiSwiglu, pg8::SchedMoe<8, true>, true, true, 512, true>(lds, S, E);
    }
    xcd_barrier(xbar);

    REP(6) {
        PHASE_PTRS(); const int ntiles = (int)ctl[CW_NTILES];
        pg8::SchedMoe<4, false> S{(const char*)act8, (const char*)w2_8, tile_e, tok, ntiles, G, bx};
        pg8::EpiDown E{yb, p.b2};
        pg8::gemm_phase<pg8::EpiDown, pg8::SchedMoe<4, false>, false, true, 512, true>(lds, S, E);
    }
    xcd_barrier(xbar);

    REP(7) {
        PHASE_IDS(); PHASE_PTRS();
        const int gw = bx * 8 + wave, NGW = G * 8;
        f32x4 gg[2][2], bb[2][2];
#pragma unroll
        for (int j = 0; j < 2; ++j)
#pragma unroll
            for (int h = 0; h < 2; ++h) { gg[j][h] = *(const f32x4*)(p.ln2_g + 512 * j + 8 * lane + 4 * h); bb[j][h] = *(const f32x4*)(p.ln2_b + 512 * j + 8 * lane + 4 * h); }
        constexpr int R = 2;
        for (int row0 = gw; row0 < T; row0 += R * NGW) {
            int4 dd[R]; float4 gt[R];
#pragma unroll
            for (int q = 0; q < R; ++q) { const int row = row0 + q * NGW < T ? row0 + q * NGW : row0; dd[q] = *(const int4*)(asg_d + (size_t)row * 4); gt[q] = *(const float4*)(asg_g + (size_t)row * 4); }
            u32x4 xr[R][2]; u32x2 yk[R][4][2];
#pragma unroll
            for (int q = 0; q < R; ++q) { const int row = row0 + q * NGW < T ? row0 + q * NGW : row0;
#pragma unroll
                for (int j = 0; j < 2; ++j) {
                    xr[q][j] = *(const u32x4*)(x1b + (size_t)row * D + 512 * j + 8 * lane);
                    yk[q][0][j] = *(const u32x2*)(yb + (size_t)dd[q].x * D + 512 * j + 8 * lane);
                    yk[q][1][j] = *(const u32x2*)(yb + (size_t)dd[q].y * D + 512 * j + 8 * lane);
                    yk[q][2][j] = *(const u32x2*)(yb + (size_t)dd[q].z * D + 512 * j + 8 * lane);
                    yk[q][3][j] = *(const u32x2*)(yb + (size_t)dd[q].w * D + 512 * j + 8 * lane);
                } }
            float z[R][2][8]; float sm[R], sq[R];
#pragma unroll
            for (int q = 0; q < R; ++q) {
                const float g0 = gt[q].x * (1.0f / Y_SCALE), g1 = gt[q].y * (1.0f / Y_SCALE), g2 = gt[q].z * (1.0f / Y_SCALE), g3 = gt[q].w * (1.0f / Y_SCALE);
                float s_ = 0.f;
#pragma unroll
                for (int j = 0; j < 2; ++j)
#pragma unroll
                    for (int d = 0; d < 2; ++d) {
#define P7_PAIR(HH, SEL) do { \
                            const f32x2 a0 = __builtin_amdgcn_cvt_pk_f32_fp8((int)yk[q][0][j][d], SEL), a1 = __builtin_amdgcn_cvt_pk_f32_fp8((int)yk[q][1][j][d], SEL); \
                            const f32x2 a2 = __builtin_amdgcn_cvt_pk_f32_fp8((int)yk[q][2][j][d], SEL), a3 = __builtin_amdgcn_cvt_pk_f32_fp8((int)yk[q][3][j][d], SEL); \
                            const unsigned xw = xr[q][j][2 * d + HH]; \
                            const float lo = DN_ALPHA * bf2f(xw & 0xffffu) + g0 * a0.x + g1 * a1.x + g2 * a2.x + g3 * a3.x; \
                            const float hi = DN_ALPHA * bf2f(xw >> 16) + g0 * a0.y + g1 * a1.y + g2 * a2.y + g3 * a3.y; \
                            z[q][j][4 * d + 2 * HH] = lo; z[q][j][4 * d + 2 * HH + 1] = hi; s_ += lo + hi; } while (0)
                        P7_PAIR(0, false); P7_PAIR(1, true);
#undef P7_PAIR
                    }
                sm[q] = s_;
            }
#pragma unroll
            for (int o = 1; o < 64; o <<= 1) {
#pragma unroll
                for (int q = 0; q < R; ++q) sm[q] += __shfl_xor(sm[q], o); }
#pragma unroll
            for (int q = 0; q < R; ++q) { const float mean = sm[q] * (1.0f / D); float s2 = 0.f;
#pragma unroll
                for (int j = 0; j < 2; ++j)
#pragma unroll
                    for (int c = 0; c < 8; ++c) { z[q][j][c] -= mean; s2 += z[q][j][c] * z[q][j][c]; }
                sq[q] = s2; }
#pragma unroll
            for (int o = 1; o < 64; o <<= 1) {
#pragma unroll
                for (int q = 0; q < R; ++q) sq[q] += __shfl_xor(sq[q], o); }
#pragma unroll
            for (int q = 0; q < R; ++q) {
                const int row = row0 + q * NGW;
                if (row < T) {
                    const float rstd = 1.0f / sqrtf(sq[q] * (1.0f / D) + LN_EPS);
#pragma unroll
                    for (int j = 0; j < 2; ++j)
#pragma unroll
                        for (int h = 0; h < 2; ++h) {
                            f32x4 o;
#pragma unroll
                            for (int c = 0; c < 4; ++c) o[c] = z[q][j][4 * h + c] * rstd * gg[j][h][c] + bb[j][h][c];
                            *(f32x4*)(p.out + (size_t)row * D + 512 * j + 8 * lane + 4 * h) = o;
                        }
                }
            }
        }
    }
}

extern "C" void kernel_launch(void* const* d_in, const int* in_sizes, int n_in, void* d_out, int out_size, void* d_ws, size_t ws_size, hipStream_t stream) {
    static int grid_blocks = 0;
    if (grid_blocks == 0) {
        if (n_in != 16 || in_sizes[0] != T * D || out_size != T * D || ws_size < WS_END) {
            fprintf(stderr, "kernel_launch: unexpected shapes: n_in %d in0 %d out %d ws %zu (need %zu)\n", n_in, n_in > 0 ? in_sizes[0] : -1, out_size, ws_size, (size_t)WS_END); grid_blocks = -1; return; }
        int dev = 0, cus = 0, per_cu = 0;
        (void)hipGetDevice(&dev);
        (void)hipDeviceGetAttribute(&cus, hipDeviceAttributeMultiprocessorCount, dev);
        (void)hipFuncSetAttribute((const void*)fwd_megakernel, hipFuncAttributeMaxDynamicSharedMemorySize, LDS_BYTES);
        (void)hipOccupancyMaxActiveBlocksPerMultiprocessor(&per_cu, (const void*)fwd_megakernel, NTHREADS, LDS_BYTES);
        if (per_cu < 1) { fprintf(stderr, "kernel_launch: occupancy query reports %d blocks per CU\n", per_cu); per_cu = 1; }
        grid_blocks = cus;
        fprintf(stderr, "kernel_launch: cus=%d per_cu=%d grid=%d ws=%zu\n", cus, per_cu, grid_blocks, ws_size);
    }
    if (grid_blocks < 0) return;
    (void)hipMemsetAsync((char*)d_ws + WS_CTL, 0, CTL_ZERO_BYTES, stream);
    Params p{};
    p.x = (const float*)d_in[0]; p.w_in = (const float*)d_in[1]; p.b_in = (const float*)d_in[2]; p.sinks = (const float*)d_in[3]; p.w_out = (const float*)d_in[4]; p.b_out = (const float*)d_in[5];
    p.ln1_g = (const float*)d_in[6]; p.ln1_b = (const float*)d_in[7]; p.w_router = (const float*)d_in[8]; p.b_router = (const float*)d_in[9];
    p.w1 = (const float*)d_in[10]; p.b1 = (const float*)d_in[11]; p.w2 = (const float*)d_in[12]; p.b2 = (const float*)d_in[13]; p.ln2_g = (const float*)d_in[14]; p.ln2_b = (const float*)d_in[15];
    p.out = (float*)d_out; p.ws = (unsigned char*)d_ws;
    void* args[] = {&p};
    hipError_t e = hipLaunchCooperativeKernel((void*)fwd_megakernel, dim3(grid_blocks), dim3(NTHREADS), args, LDS_BYTES, stream);
    if (e != hipSuccess) fprintf(stderr, "cooperative launch failed: %s (grid %d)\n", hipGetErrorString(e), grid_blocks);
}
```

```cpp
#include <hip/hip_runtime.h>
#include <hip/hip_cooperative_groups.h>
#include <cstdio>
#include <cstdint>
namespace cg = cooperative_groups;

#define LAS __attribute__((address_space(3)))
typedef unsigned short bf16_t;
typedef short bf16x8 __attribute__((ext_vector_type(8)));
typedef short s16x4 __attribute__((ext_vector_type(4)));
typedef float f32x2 __attribute__((ext_vector_type(2)));
typedef float f32x4 __attribute__((ext_vector_type(4)));
typedef float f32x16 __attribute__((ext_vector_type(16)));
typedef unsigned u32x2 __attribute__((ext_vector_type(2)));
typedef unsigned u32x4 __attribute__((ext_vector_type(4)));
typedef __bf16 bf16x2_t __attribute__((ext_vector_type(2)));

constexpr int D = 1024, BATCH = 32, SEQ = 2048, T = BATCH * SEQ;
constexpr int INW = 2304, NE = 32;
constexpr float LN_EPS = 1e-5f;
constexpr float DN_ALPHA = 1.189207115002721f;
constexpr float LOG2E = 1.4426950408889634f;
constexpr float C2 = 0.18033688011112042f;
constexpr int NTHREADS = 512;
constexpr int LDS_BYTES = 147456;
constexpr int MAX_TILES = 1056;
#ifndef INPROJ_FP8
#define INPROJ_FP8 1
#endif
#ifndef DUP_MASK
#define DUP_MASK 0
#endif
#define REP(k) for (int _rep = 0; _rep < (((DUP_MASK >> (k)) & 1) ? 2 : 1); ++_rep)

constexpr size_t MiB = 1u << 20;
constexpr size_t WS_CTL = 0, CTL_ZERO_BYTES = 2 * MiB;
constexpr size_t WS_KSUM = 1 * MiB;
constexpr size_t WS_ROPE = 2 * MiB;
constexpr size_t WS_WIN_T = 4 * MiB;
constexpr size_t WS_WOUT_T = 9 * MiB;
constexpr size_t WS_SMALL = 11 * MiB;
constexpr size_t WS_CNT = WS_SMALL, WS_TILE_E = WS_SMALL + 65536, WS_WR_HI = WS_SMALL + 131072, WS_WR_LO = WS_WR_HI + 65536;
constexpr size_t WS_TOK = 12 * MiB;
constexpr size_t WS_ASG_E = 14 * MiB, WS_ASG_G = 15 * MiB, WS_ASG_D = 16 * MiB;
constexpr size_t WS_W2_8 = 24 * MiB;
constexpr size_t WS_X1B = 56 * MiB;
constexpr size_t WS_ACT8 = 184 * MiB;
constexpr size_t WS_XB = 184 * MiB;
constexpr size_t WS_X1LO = 312 * MiB;
constexpr size_t WS_YB = 488 * MiB;
constexpr size_t WS_W1_8 = 488 * MiB;
constexpr size_t WS_X1_8 = 552 * MiB;
constexpr size_t WS_QKV = 616 * MiB;
constexpr size_t WS_END = 1016 * MiB;
constexpr float W_SCALE = 64.0f, ACT_SCALE = 4.0f, WIN_SCALE = 32.0f, Y_SCALE = 16.0f;
constexpr int CW_NTILES = 16, CW_BAR = 4096;
constexpr int LDSX_TILE = 131072, LDSX_IDX = 135424, LDSX_BIAS = 136448;
constexpr int LDS_BARST = LDS_BYTES - 256;

struct Params {
    const float *x, *w_in, *b_in, *sinks, *w_out, *b_out, *ln1_g, *ln1_b, *w_router, *b_router, *w1, *b1, *w2, *b2, *ln2_g, *ln2_b;
    float* out; unsigned char* ws;
};

__device__ __forceinline__ unsigned f2bf(float f) { unsigned u = __builtin_bit_cast(unsigned, f); return (u + 0x7fffu + ((u >> 16) & 1u)) >> 16; }
__device__ __forceinline__ float bf2f(unsigned h) { return __builtin_bit_cast(float, h << 16); }
__device__ __forceinline__ unsigned cvtpk(float lo, float hi) { f32x2 v = {lo, hi}; bf16x2_t b = __builtin_convertvector(v, bf16x2_t); return __builtin_bit_cast(unsigned, b); }
__device__ __forceinline__ unsigned pk4_fp8(float a, float b, float c, float d) { int w = 0; w = __builtin_amdgcn_cvt_pk_fp8_f32(a, b, w, false); w = __builtin_amdgcn_cvt_pk_fp8_f32(c, d, w, true); return (unsigned)w; }
__device__ __forceinline__ float wave_sum(float v) {
#pragma unroll
    for (int o = 1; o < 64; o <<= 1) v += __shfl_xor(v, o);
    return v;
}
#define LDS_WAIT() asm volatile("s_waitcnt lgkmcnt(0)" ::: "memory")
template <int X> __device__ __forceinline__ float swz_xor(float v) { return __builtin_bit_cast(float, __builtin_amdgcn_ds_swizzle(__builtin_bit_cast(int, v), (X << 10) | 0x1f)); }

namespace pg8 {
constexpr int BM = 256, BK = 64, HALF = 128, HTB = HALF * BK * 2, STAGE_BYTES = 8 * HTB, NXCD = 8, WGM = 8;
constexpr int KD = 1024;
__host__ __device__ __forceinline__ int lds_byte(int r, int c) { const int st = (r >> 4) * 2 + (c >> 5), rr = r & 15, cc = c & 31, ob = rr * 64 + cc * 2; return st * 1024 + (ob ^ (((ob >> 9) & 1) << 5)); }
__host__ __device__ __forceinline__ void stage_rc(int b, int& R, int& C) { const int st = b / 1024, sb = b % 1024, swz = sb ^ (((sb >> 9) & 1) << 5); R = (st >> 1) * 16 + swz / 64; C = (st & 1) * 32 + (swz % 64) / 2; }
__host__ __device__ __forceinline__ int perm32(int rho) { const int n = rho >> 4, i = rho & 15; return 8 * (i >> 2) + 4 * n + (i & 3); }

struct Unit { int pm, pn, e; unsigned ao, bo; const int* rows; };

typedef int v8i32_t __attribute__((ext_vector_type(8)));
typedef int v4i32_t __attribute__((ext_vector_type(4)));
__device__ __forceinline__ v8i32_t cat8(bf16x8 a, bf16x8 b) { const v4i32_t x = __builtin_bit_cast(v4i32_t, a), y = __builtin_bit_cast(v4i32_t, b); return __builtin_shufflevector(x, y, 0, 1, 2, 3, 4, 5, 6, 7); }
template <class Epi, class Sched, bool GATHER, bool ALIGN_EPI, int KP = 1024, bool FP8 = false, bool MOE = false>
__device__ __forceinline__ void gemm_phase(LAS unsigned char* lds, const Sched& S, const Epi& E) {
    int tid = threadIdx.x; asm volatile("" : "+v"(tid));
    const int wid = __builtin_amdgcn_readfirstlane(tid >> 6), lane = tid & 63, wr = wid >> 2, wc = wid & 3, fr = lane & 15, fq = lane >> 4;
    constexpr int K = KP, nt = K / BK;
    unsigned voffB[2], Vc[2][2]; int stR0, stC0;
    { int R, C; stage_rc(tid * 16, R, C); stR0 = R; stC0 = C; }
#pragma unroll
    for (int i = 0; i < 2; ++i) { voffB[i] = (unsigned)((stR0 + 64 * i) * K + stC0) * 2u; Vc[0][i] = voffB[i]; Vc[1][i] = voffB[i]; }
#define PG8_GATHER_LOAD(VV) do { int _t = threadIdx.x; asm volatile("" : "+v"(_t)); int _R, _C; stage_rc(_t * 16, _R, _C);     \
        const LAS int* _rp = (const LAS int*)(lds + LDSX_IDX) + _R; _Pragma("unroll") for (int _h = 0; _h < 2; ++_h) _Pragma("unroll") for (int _i = 0; _i < 2; ++_i) \
        VV[_h][_i] = ((unsigned)_rp[128 * _h + 64 * _i] * (unsigned)K + (unsigned)_C) * 2u; } while (0)
#define PG8_DMA4(gsrc, ldsoff) __builtin_amdgcn_global_load_lds((const unsigned*)(gsrc), (LAS unsigned*)(lds + (ldsoff)), 4, 0, 0)
    constexpr unsigned kstep = (unsigned)(BK * 2);
    constexpr unsigned hstep = (unsigned)HALF * K * 2;
    const char* const Abase = S.A; const char* const Bbase = S.B;
    const unsigned ldsw = (unsigned)wid * 1024u;
    const int aoff = lds_byte(wr * 64 + fr, fq * 8), boff = lds_byte(wc * 32 + fr, fq * 8);
#define PG8_SA(b, h) (((b) * 2 + (h)) * HTB)
#define PG8_SB(b, h) ((4 + (b) * 2 + (h)) * HTB)
#define PG8_STAGE(bufoff, gbase, soff, voff) do { _Pragma("unroll") for (int _i = 0; _i < 2; ++_i) \
        __builtin_amdgcn_global_load_lds((const unsigned*)((gbase) + (unsigned)((voff)[_i] + (soff))), (LAS unsigned*)(lds + (bufoff) + ldsw + _i * 8192), 16, 0, 0); } while (0)
#define PG8_STAGE_B(bufoff, soff) PG8_STAGE(bufoff, Bbase, soff, voffB)
#define PG8_STAGE_A(bufoff, soff, h, VV) do { if constexpr (GATHER) { PG8_STAGE(bufoff, Abase, soff, VV[h]); } else { PG8_STAGE(bufoff, Abase, (soff) + (h) * hstep, voffB); } } while (0)
#define PG8_LDA(dst, b, h) do { _Pragma("unroll") for (int m = 0; m < 4; ++m) dst[m] = cat8(*(const LAS bf16x8*)(lds + PG8_SA(b, h) + aoff + m * 2048), *(const LAS bf16x8*)(lds + PG8_SA(b, h) + aoff + m * 2048 + 1024)); } while (0)
#define PG8_LDB(dst, b, h) do { _Pragma("unroll") for (int n = 0; n < 2; ++n) dst[n] = cat8(*(const LAS bf16x8*)(lds + PG8_SB(b, h) + boff + n * 2048), *(const LAS bf16x8*)(lds + PG8_SB(b, h) + boff + n * 2048 + 1024)); } while (0)
#define PG8_LO(v) __builtin_bit_cast(bf16x8, __builtin_shufflevector(v, v, 0, 1, 2, 3))
#define PG8_HI(v) __builtin_bit_cast(bf16x8, __builtin_shufflevector(v, v, 4, 5, 6, 7))
#define PG8_MMA(ai, bj, At, Bt) do { __builtin_amdgcn_s_setprio(1); _Pragma("unroll") for (int m = 0; m < 4; ++m) _Pragma("unroll") for (int n = 0; n < 2; ++n) { \
        if constexpr (FP8) { acc[ai][bj][m][n] = __builtin_amdgcn_mfma_scale_f32_16x16x128_f8f6f4(Bt[n], At[m], acc[ai][bj][m][n], 0, 0, 0, 0x7f7f7f7f, 0, 0x7f7f7f7f); } \
        else { acc[ai][bj][m][n] = __builtin_amdgcn_mfma_f32_16x16x32_bf16(PG8_LO(Bt[n]), PG8_LO(At[m]), acc[ai][bj][m][n], 0, 0, 0); \
               acc[ai][bj][m][n] = __builtin_amdgcn_mfma_f32_16x16x32_bf16(PG8_HI(Bt[n]), PG8_HI(At[m]), acc[ai][bj][m][n], 0, 0, 0); } } \
        __builtin_amdgcn_s_setprio(0); } while (0)
#define PG8_WAIT_V(n) asm volatile("s_waitcnt vmcnt(" #n ")" ::: "memory")
#define PG8_WAIT_L(n) asm volatile("s_waitcnt lgkmcnt(" #n ")" ::: "memory")
#define PG8_BAR __builtin_amdgcn_s_barrier()
#define PG8_SCHED __builtin_amdgcn_sched_barrier(0)
    Unit cur, nxt; int ui = 0;
    if (!S.next(0, cur)) return;
    if constexpr (MOE) {
        if (wid < 4) { PG8_DMA4(E.bias_src(cur) + wid * 64 + lane, LDSX_BIAS + wid * 256); if constexpr (GATHER) PG8_DMA4(cur.rows + wid * 64 + lane, LDSX_IDX + wid * 256); }
        asm volatile("s_waitcnt vmcnt(0)" ::: "memory"); __builtin_amdgcn_s_barrier(); asm volatile("" ::: "memory");
    }
    if constexpr (GATHER) { PG8_GATHER_LOAD(Vc); }
    f32x4 acc[2][2][4][2];
#pragma unroll
    for (int a = 0; a < 2; ++a)
#pragma unroll
        for (int b = 0; b < 2; ++b)
#pragma unroll
            for (int m = 0; m < 4; ++m)
#pragma unroll
                for (int n = 0; n < 2; ++n) acc[a][b][m][n] = (f32x4){0.f, 0.f, 0.f, 0.f};
    v8i32_t At[4], B0[2], B1[2];
    unsigned cA = cur.ao, cB = cur.bo;
    PG8_STAGE_B(PG8_SB(0, 0), cB); PG8_STAGE_B(PG8_SB(0, 1), cB + hstep); PG8_STAGE_A(PG8_SA(0, 0), cA, 0, Vc); PG8_STAGE_A(PG8_SA(0, 1), cA, 1, Vc);
    if (wr == 1) PG8_BAR;
    PG8_WAIT_V(2); PG8_BAR;
    PG8_STAGE_B(PG8_SB(1, 0), cB + kstep); PG8_STAGE_A(PG8_SA(1, 0), cA + kstep, 0, Vc); PG8_STAGE_B(PG8_SB(1, 1), cB + hstep + kstep);
    PG8_WAIT_V(6); PG8_BAR;
    for (;;) {
        const bool has_next = S.next(ui + 1, nxt);
        const unsigned nA = has_next ? nxt.ao : cA; const unsigned nB = has_next ? nxt.bo : cB;
        if constexpr (MOE) {
            if (has_next && wid < 4) { PG8_DMA4(E.bias_src(nxt) + wid * 64 + lane, LDSX_BIAS + ((ui + 1) % 3) * 1024 + wid * 256); if constexpr (GATHER) PG8_DMA4(nxt.rows + wid * 64 + lane, LDSX_IDX + wid * 256); }
        }
#pragma unroll 1
        for (int t = 0; t < nt; t += 2) {
            const bool last = (t == nt - 2);
            const unsigned a1 = cA + (unsigned)(t + 1) * kstep;
            const unsigned a2 = last ? nA : cA + (unsigned)(t + 2) * kstep; const unsigned b2 = last ? nB : cB + (unsigned)(t + 2) * kstep;
            const unsigned a3 = a2 + kstep; const unsigned b3 = b2 + kstep;
            PG8_LDB(B0, 0, 0); PG8_LDB(B1, 0, 1); PG8_SCHED; PG8_LDA(At, 0, 0); PG8_STAGE_A(PG8_SA(1, 1), a1, 1, Vc);
            if constexpr (GATHER) { if (last && has_next) { PG8_GATHER_LOAD(Vc); } }
            PG8_WAIT_V(8); PG8_WAIT_L(0); PG8_BAR; PG8_MMA(0, 0, At, B0); PG8_MMA(0, 1, At, B1); PG8_BAR; PG8_SCHED;
            PG8_LDA(At, 0, 1); PG8_STAGE_B(PG8_SB(0, 0), b2); PG8_STAGE_B(PG8_SB(0, 1), b2 + hstep); PG8_STAGE_A(PG8_SA(0, 0), a2, 0, Vc);
            PG8_WAIT_V(8); PG8_WAIT_L(0); PG8_BAR; PG8_MMA(1, 0, At, B0); PG8_MMA(1, 1, At, B1); PG8_BAR; PG8_SCHED;
            PG8_LDB(B0, 1, 0); PG8_LDB(B1, 1, 1); PG8_SCHED; PG8_LDA(At, 1, 0); PG8_STAGE_A(PG8_SA(0, 1), a2, 1, Vc);
            PG8_WAIT_V(8); PG8_WAIT_L(0); PG8_BAR; PG8_MMA(0, 0, At, B0); PG8_MMA(0, 1, At, B1); PG8_BAR; PG8_SCHED;
            PG8_LDA(At, 1, 1); PG8_STAGE_B(PG8_SB(1, 0), b3); PG8_STAGE_B(PG8_SB(1, 1), b3 + hstep); PG8_STAGE_A(PG8_SA(1, 0), a3, 0, Vc);
            PG8_WAIT_V(8); PG8_WAIT_L(0); PG8_BAR; PG8_MMA(1, 0, At, B0); PG8_MMA(1, 1, At, B1); PG8_BAR; PG8_SCHED;
        }
        if constexpr (ALIGN_EPI) { if (wr == 0) PG8_BAR; }
        { int t2 = threadIdx.x; asm volatile("" : "+v"(t2));
          if constexpr (MOE) E(acc, cur, wr, wc, t2 & 15, (t2 & 63) >> 4, (const LAS float*)(lds + LDSX_BIAS + (ui % 3) * 1024));
          else E(acc, cur, wr, wc, t2 & 15, (t2 & 63) >> 4); }
        if (!has_next) break;
#pragma unroll
        for (int a = 0; a < 2; ++a)
#pragma unroll
            for (int b = 0; b < 2; ++b)
#pragma unroll
                for (int m = 0; m < 4; ++m)
#pragma unroll
                    for (int n = 0; n < 2; ++n) acc[a][b][m][n] = (f32x4){0.f, 0.f, 0.f, 0.f};
        cur = nxt; cA = nA; cB = nB; ++ui;
        if constexpr (ALIGN_EPI) { if (wr == 1) PG8_BAR; }
    }
    PG8_WAIT_V(0);
    if constexpr (!ALIGN_EPI) { if (wr == 0) PG8_BAR; }
    PG8_BAR;
#undef PG8_SA
#undef PG8_SB
#undef PG8_STAGE
#undef PG8_STAGE_A
#undef PG8_STAGE_B
#undef PG8_GATHER_LOAD
#undef PG8_DMA4
#undef PG8_LDA
#undef PG8_LDB
#undef PG8_LO
#undef PG8_HI
#undef PG8_MMA
#undef PG8_WAIT_V
#undef PG8_WAIT_L
#undef PG8_BAR
#undef PG8_SCHED
}

template <int ROWB>
struct SchedInProj {
    const char* A; const char* B; int G, c;
    __device__ __forceinline__ bool next(int i, Unit& u) const {
        constexpr int nM = T / BM, nN = INW / BM, nwg = nM * nN;
        const long L = (long)i * G + c; if (L >= nwg) return false;
        int wgid = (int)L; { const int q = nwg / NXCD, r = nwg % NXCD, xcd = wgid % NXCD, off = wgid / NXCD; wgid = (xcd < r ? xcd * (q + 1) : r * (q + 1) + (xcd - r) * q) + off; }
        const int nig = WGM * nN, gid = wgid / nig, fm = gid * WGM, gsz = (nM - fm) < WGM ? (nM - fm) : WGM;
        u.pm = fm + ((wgid % nig) % gsz); u.pn = (wgid % nig) / gsz; u.e = 0; u.rows = nullptr;
        u.ao = (unsigned)u.pm * (unsigned)(256 * ROWB); u.bo = (unsigned)u.pn * (unsigned)(256 * ROWB); return true;
    }
};
struct SchedPanel {
    const char* A; const char* B; int pm;
    __device__ __forceinline__ bool next(int i, Unit& u) const {
        if (i >= 4) return false;
        u.pm = pm; u.pn = i; u.e = 0; u.rows = nullptr; u.ao = (unsigned)pm * (unsigned)(256 * KD * 2); u.bo = (unsigned)i * (unsigned)(256 * KD * 2); return true;
    }
};
template <int NPN, bool G1>
struct SchedMoe {
    const char* A; const char* B; const LAS int* tile_e; const int* tok; int ntiles, G, c;
    __device__ __forceinline__ bool next(int i, Unit& u) const {
        const long L = (long)i * G + c; int t, pn;
        if ((G & 7) == 0) { const int x = (int)(L & 7); const long j = L >> 3; t = (int)(j / NPN) * 8 + x; pn = (int)(j % NPN); }
        else { t = (int)(L / NPN); pn = (int)(L % NPN); }
        if (t >= ntiles) return false;
        const int e = __builtin_amdgcn_readfirstlane(tile_e[t]);
        u.pm = t; u.pn = pn; u.e = e;
        if (G1) { u.ao = 0u; u.rows = tok + (size_t)t * 256; u.bo = ((unsigned)e * 2048u + (unsigned)pn * 256u) * 1024u; }
        else { u.ao = (unsigned)t * (256u * 1024u); u.rows = nullptr; u.bo = ((unsigned)e * 1024u + (unsigned)pn * 256u) * 1024u; }
        return true;
    }
};

struct EpiInProj {
    bf16_t* qkv; const float* b_in; const float* rope; float* ksum; float descale;
    __device__ __forceinline__ void operator()(const f32x4 (&acc)[2][2][4][2], const Unit& u, int wr, int wc, int fr, int fq) const {
        const int pn = u.pn;
        const int colb = 256 * pn + 64 * wc + 8 * fq;
        const bool do_rope = !(pn >= 7 || (pn == 2 && wc >= 2));
        const bool is_q = (pn < 2) || (pn == 3) || (pn == 4);
        const bool is_kb = (pn == 5) || (pn == 6);
        const float sc = is_q ? C2 : 1.0f;
        f32x4 bv[2][2];
#pragma unroll
        for (int bj = 0; bj < 2; ++bj)
#pragma unroll
            for (int n = 0; n < 2; ++n) bv[bj][n] = *(const f32x4*)(b_in + colb + 32 * bj + 4 * n);
        f32x4 ks[2][2];
#pragma unroll
        for (int bj = 0; bj < 2; ++bj)
#pragma unroll
            for (int n = 0; n < 2; ++n) ks[bj][n] = (f32x4){0.f, 0.f, 0.f, 0.f};
#pragma unroll
        for (int ai = 0; ai < 2; ++ai)
#pragma unroll
            for (int m = 0; m < 4; ++m) {
                const int row = u.pm * 256 + ai * 128 + wr * 64 + m * 16 + fr;
                const int pos = row & (SEQ - 1);
                f32x4 o1[2], o2[2];
#pragma unroll
                for (int n = 0; n < 2; ++n) { o1[n] = acc[ai][0][m][n] * descale + bv[0][n]; o2[n] = acc[ai][1][m][n] * descale + bv[1][n]; }
                if (do_rope) {
                    const float* rp = rope + pos * 64 + 8 * fq;
#pragma unroll
                    for (int n = 0; n < 2; ++n) { const f32x4 c = *(const f32x4*)(rp + 4 * n), s = *(const f32x4*)(rp + 32 + 4 * n);
                        const f32x4 a = o1[n], b = o2[n]; o1[n] = a * c - b * s; o2[n] = b * c + a * s; }
                }
                if (is_kb) {
#pragma unroll
                    for (int n = 0; n < 2; ++n) { ks[0][n] += o1[n]; ks[1][n] += o2[n]; }
                }
                bf16_t* rowp = qkv + (size_t)row * INW + colb;
                u32x4 w1, w2;
                w1.x = cvtpk(o1[0][0] * sc, o1[0][1] * sc); w1.y = cvtpk(o1[0][2] * sc, o1[0][3] * sc); w1.z = cvtpk(o1[1][0] * sc, o1[1][1] * sc); w1.w = cvtpk(o1[1][2] * sc, o1[1][3] * sc);
                w2.x = cvtpk(o2[0][0] * sc, o2[0][1] * sc); w2.y = cvtpk(o2[0][2] * sc, o2[0][3] * sc); w2.z = cvtpk(o2[1][0] * sc, o2[1][1] * sc); w2.w = cvtpk(o2[1][2] * sc, o2[1][3] * sc);
                *(u32x4*)(rowp) = w1; *(u32x4*)(rowp + 32) = w2;
            }
        if (is_kb) {
            float* kd = ksum + (size_t)u.pm * 512 + 256 * (pn - 5) + 64 * wc + 8 * fq;
#pragma unroll
            for (int bj = 0; bj < 2; ++bj)
#pragma unroll
                for (int n = 0; n < 2; ++n)
#pragma unroll
                    for (int j = 0; j < 4; ++j) {
                        float v = ks[bj][n][j];
                        v += swz_xor<1>(v); v += swz_xor<2>(v); v += swz_xor<4>(v); v += swz_xor<8>(v);
                        if (fr == 0) atomicAdd(kd + 32 * bj + 4 * n + j, v);
                    }
        }
    }
};
struct EpiOutProj {
    bf16_t* y; const float* b_out; const float* x;
    __device__ __forceinline__ void operator()(const f32x4 (&acc)[2][2][4][2], const Unit& u, int wr, int wc, int fr, int fq) const {
        const int col0 = u.pn * 256 + wc * 32 + 8 * fq;
        f32x4 bv[2][2];
#pragma unroll
        for (int bj = 0; bj < 2; ++bj)
#pragma unroll
            for (int n = 0; n < 2; ++n) bv[bj][n] = *(const f32x4*)(b_out + col0 + 128 * bj + 4 * n);
#pragma unroll
        for (int ai = 0; ai < 2; ++ai)
#pragma unroll
            for (int m = 0; m < 4; ++m) {
                const size_t off = (size_t)(u.pm * 256 + ai * 128 + wr * 64 + m * 16 + fr) * D + col0;
#pragma unroll
                for (int bj = 0; bj < 2; ++bj) {
                    const f32x4 x0 = *(const f32x4*)(x + off + 128 * bj), x1 = *(const f32x4*)(x + off + 128 * bj + 4);
                    const f32x4 v0 = acc[ai][bj][m][0] + bv[bj][0] + x0 * DN_ALPHA, v1 = acc[ai][bj][m][1] + bv[bj][1] + x1 * DN_ALPHA;
                    u32x4 w; w.x = cvtpk(v0[0], v0[1]); w.y = cvtpk(v0[2], v0[3]); w.z = cvtpk(v1[0], v1[1]); w.w = cvtpk(v1[2], v1[3]);
                    *(u32x4*)(y + off + 128 * bj) = w; }
                if (m & 1) asm volatile("" ::: "memory");
            }
    }
};
struct EpiSwiglu {
    unsigned char* act8; const float* b1;
    __device__ __forceinline__ const float* bias_src(const Unit& u) const { return b1 + (size_t)u.e * 2048 + 256 * u.pn; }
    __device__ __forceinline__ void operator()(const f32x4 (&acc)[2][2][4][2], const Unit& u, int wr, int wc, int fr, int fq, const LAS float* bias) const {
        const int a0 = 128 * u.pn + 32 * wc + 8 * fq;
        const LAS float* bp = bias + 2 * (32 * wc + 8 * fq);
        f32x4 bb[4];
#pragma unroll
        for (int q = 0; q < 4; ++q) bb[q] = *(const LAS f32x4*)(bp + 4 * q);
        unsigned char* tile = act8 + (size_t)u.pm * (256 * 1024);
#pragma unroll
        for (int ai = 0; ai < 2; ++ai)
#pragma unroll
            for (int m = 0; m < 4; ++m) {
                const int row = ai * 128 + wr * 64 + m * 16 + fr;
                float r[8];
#pragma unroll
                for (int n = 0; n < 2; ++n)
#pragma unroll
                    for (int j = 0; j < 4; ++j) {
                        const int q = 4 * n + j;
                        float g = acc[ai][0][m][n][j] * (1.0f / W_SCALE) + bb[q >> 1][(2 * q) & 3];
                        float l = acc[ai][1][m][n][j] * (1.0f / W_SCALE) + bb[q >> 1][((2 * q) & 3) + 1];
                        g = fminf(g, 7.0f); l = fminf(fmaxf(l, -7.0f), 7.0f);
                        const float sg = __builtin_amdgcn_rcpf(1.0f + __builtin_amdgcn_exp2f(-1.702f * LOG2E * g));
                        r[q] = g * sg * (l + 1.0f) * ACT_SCALE;
                    }
                u32x2 w; w.x = pk4_fp8(r[0], r[1], r[2], r[3]); w.y = pk4_fp8(r[4], r[5], r[6], r[7]);
                *(u32x2*)(tile + (size_t)row * 1024 + (size_t)a0) = w;
            }
    }
};
struct EpiDown {
    unsigned char* yb; const float* b2;
    __device__ __forceinline__ const float* bias_src(const Unit& u) const { return b2 + (size_t)u.e * 1024 + 256 * u.pn; }
    __device__ __forceinline__ void operator()(const f32x4 (&acc)[2][2][4][2], const Unit& u, int wr, int wc, int fr, int fq, const LAS float* bias) const {
        const int col0 = u.pn * 256 + wc * 32 + 8 * fq;
        const LAS float* bp = bias + wc * 32 + 8 * fq;
#pragma unroll
        for (int bj = 0; bj < 2; ++bj) {
            const f32x4 bv0 = *(const LAS f32x4*)(bp + 128 * bj) * Y_SCALE, bv1 = *(const LAS f32x4*)(bp + 128 * bj + 4) * Y_SCALE;
#pragma unroll
            for (int ai = 0; ai < 2; ++ai)
#pragma unroll
                for (int m = 0; m < 4; ++m) {
                    unsigned char* rowp = yb + (size_t)(u.pm * 256 + ai * 128 + wr * 64 + m * 16 + fr) * 1024 + col0;
                    const f32x4 v0 = acc[ai][bj][m][0] * (Y_SCALE / (W_SCALE * ACT_SCALE)) + bv0, v1 = acc[ai][bj][m][1] * (Y_SCALE / (W_SCALE * ACT_SCALE)) + bv1;
                    u32x2 w; w.x = pk4_fp8(v0[0], v0[1], v0[2], v0[3]); w.y = pk4_fp8(v1[0], v1[1], v1[2], v1[3]);
                    *(u32x2*)(rowp + 128 * bj) = w;
                }
        }
    }
};
}

namespace att {
constexpr int PITCH = INW, SLOTB = 8192;
constexpr int NSLOT = 4;
constexpr int L_K = 0, L_V = NSLOT * SLOTB, L_WS = 2 * NSLOT * SLOTB, L_KS = L_WS + 2048, L_OST = L_KS + 2048, L_END = L_OST + 8 * 4096;
static_assert(NSLOT == 4 && L_END <= 131072, "attention LDS map");
constexpr float NEG = -1.0e30f, M0 = -1.0e20f, THR = 8.0f;
typedef LAS const char* lds_cptr;
__device__ __forceinline__ int crow(int r, int hi) { return (r & 3) + 8 * (r >> 2) + 4 * hi; }
__device__ __forceinline__ void glds16(const void* gsrc, unsigned lds_dst) { unsigned keep;
    asm volatile("s_mov_b32 %0, m0\n\ts_mov_b32 m0, %2\n\ts_nop 0\n\tglobal_load_lds_dwordx4 %1, off\n\ts_mov_b32 m0, %0" : "=&s"(keep) : "v"(gsrc), "s"(lds_dst) : "memory"); }
#define ATT_WAIT_BAR0() asm volatile("s_waitcnt vmcnt(0) lgkmcnt(0)\n\ts_barrier" ::: "memory")
#define ATT_WAIT_BARN(N) asm volatile("s_waitcnt vmcnt(" #N ") lgkmcnt(0)\n\ts_barrier" ::: "memory")
#define ATT_SBAR() __builtin_amdgcn_sched_barrier(0)

__device__ __forceinline__ void qkt(f32x16& p0, f32x16& p1, lds_cptr kb, const bf16x8* qr, const f32x16& negm) {
#pragma unroll
    for (int d0 = 0; d0 < 4; ++d0) {
        const bf16x8 b0 = *(const LAS bf16x8*)(kb + d0 * 2048);
        const bf16x8 b1 = *(const LAS bf16x8*)(kb + d0 * 2048 + 512);
        if (d0 == 0) { p0 = __builtin_amdgcn_mfma_f32_32x32x16_bf16(b0, qr[0], negm, 0, 0, 0); p1 = __builtin_amdgcn_mfma_f32_32x32x16_bf16(b1, qr[0], negm, 0, 0, 0); }
        else { p0 = __builtin_amdgcn_mfma_f32_32x32x16_bf16(b0, qr[d0], p0, 0, 0, 0); p1 = __builtin_amdgcn_mfma_f32_32x32x16_bf16(b1, qr[d0], p1, 0, 0, 0); }
    }
}
__device__ __forceinline__ float rowmax32(const f32x16& p0, const f32x16& p1) {
    float a = fmaxf(p0[0], p1[0]);
#pragma unroll
    for (int r = 1; r < 16; ++r) a = fmaxf(a, fmaxf(p0[r], p1[r]));
    auto rr = __builtin_amdgcn_permlane32_swap(__float_as_uint(a), __float_as_uint(a), false, false);
    return fmaxf(__uint_as_float(rr[0]), __uint_as_float(rr[1]));
}
__device__ __forceinline__ void pv(f32x16* o, int vb, bf16x8 pa0, bf16x8 pa1, bf16x8 pa2, bf16x8 pa3) {
#pragma unroll
    for (int d0 = 0; d0 < 2; ++d0) { s16x4 lo[4], hi[4];
#pragma unroll
        for (int ks = 0; ks < 4; ++ks) {
            asm volatile("ds_read_b64_tr_b16 %0,%1 offset:%c2" : "=&v"(lo[ks]) : "v"(vb), "i"(d0 * 4096 + ks * 1024) : "memory");
            asm volatile("ds_read_b64_tr_b16 %0,%1 offset:%c2" : "=&v"(hi[ks]) : "v"(vb), "i"(d0 * 4096 + ks * 1024 + 512) : "memory"); }
        asm volatile("s_waitcnt lgkmcnt(0)" ::: "memory"); ATT_SBAR();
#define ATT_PK(k) (bf16x8){lo[k][0], lo[k][1], lo[k][2], lo[k][3], hi[k][0], hi[k][1], hi[k][2], hi[k][3]}
        o[d0] = __builtin_amdgcn_mfma_f32_32x32x16_bf16(pa0, ATT_PK(0), o[d0], 0, 0, 0);
        o[d0] = __builtin_amdgcn_mfma_f32_32x32x16_bf16(pa1, ATT_PK(1), o[d0], 0, 0, 0);
        o[d0] = __builtin_amdgcn_mfma_f32_32x32x16_bf16(pa2, ATT_PK(2), o[d0], 0, 0, 0);
        o[d0] = __builtin_amdgcn_mfma_f32_32x32x16_bf16(pa3, ATT_PK(3), o[d0], 0, 0, 0);
#undef ATT_PK
    }
}

template <bool MOBA>
__device__ __forceinline__ void attn_item(char* shm, const bf16_t* __restrict__ qkv, bf16_t* __restrict__ aout, int b, int hh, int qb, const float* __restrict__ sinks, const float* __restrict__ ksum) {
    int tid = threadIdx.x; asm volatile("" : "+v"(tid));
    const int lane = tid & 63, r32 = lane & 31, hi = lane >> 5; const int wid = __builtin_amdgcn_readfirstlane(tid >> 6);
    const long rowbase = (long)b * SEQ;
    int qa, qcol, kcol, vcol, ocol, kt0, kt1;
    if (MOBA) { qa = 256 * qb + 32 * wid; qcol = 768 + 64 * hh; kcol = 1280 + 64 * hh; vcol = 1792 + 64 * hh; ocol = 512 + 64 * hh; kt0 = 0; kt1 = 4 * qb + 4; }
    else { const int g = wid >> 1; qa = 64 * qb + 32 * (wid & 1); qcol = (4 * hh + g) * 64; kcol = 512 + 64 * hh; vcol = 640 + 64 * hh; ocol = qcol; kt0 = qb - 2 < 0 ? 0 : qb - 2; kt1 = qb + 1; }
    const bf16_t* Qw = qkv + (rowbase + qa) * PITCH + qcol;
    const bf16_t* Kh = qkv + rowbase * PITCH + kcol; const bf16_t* Vh = qkv + rowbase * PITCH + vcol;
    const unsigned lds0 = (unsigned)(uintptr_t)shm;
    float* wsf = (float*)(shm + L_WS) + wid * 64;
    const bf16_t* ksrc = Kh + (long)lane * PITCH + wid * 8;
    const bf16_t* vsrc = Vh + (long)(16 * (wid & 3) + (lane >> 2)) * PITCH + (wid >> 2) * 32 + (lane & 3) * 8;
    const unsigned kdst = lds0 + L_K + wid * 1024, vdst = lds0 + L_V + wid * 1024;
#define ATT_DMA_K(t, slot) glds16(ksrc + (long)(t) * 64 * PITCH, (unsigned)__builtin_amdgcn_readfirstlane(kdst + (slot)))
#define ATT_DMA_V(t, slot) glds16(vsrc + (long)(t) * 64 * PITCH, (unsigned)__builtin_amdgcn_readfirstlane(vdst + (slot)))
    const int vb0 = (int)(lds0 + L_V) + ((lane >> 4) & 1) * 32 + (lane & 3) * 8 + (4 * hi + ((lane & 15) >> 2)) * 64;
    const lds_cptr shm3 = (lds_cptr)shm; const lds_cptr kp0 = shm3 + L_K + hi * 1024 + r32 * 16;
    const int NT = kt1 - kt0;
    ATT_DMA_K(kt0, 0); ATT_DMA_V(kt0, 0);
    if (NT > 1) { ATT_DMA_K(kt0 + 1, SLOTB); ATT_DMA_V(kt0 + 1, SLOTB); }
    if (NT > 2) { ATT_DMA_K(kt0 + 2, 2 * SLOTB); ATT_DMA_V(kt0 + 2, 2 * SLOTB); }
    if (MOBA) { float* ksl = (float*)(shm + L_KS); ksl[tid] = ksum[((size_t)b * 8 + (tid >> 6)) * 512 + 64 * hh + (tid & 63)]; }
    bf16x8 qr[4];
#pragma unroll
    for (int d0 = 0; d0 < 4; ++d0) qr[d0] = *reinterpret_cast<const bf16x8*>(&Qw[(long)r32 * PITCH + d0 * 16 + hi * 8]);
    float m_run, l_run;
    if (MOBA) { m_run = M0; l_run = 0.f; }
    else { m_run = sinks[4 * hh + (wid >> 1)] * LOG2E; l_run = (hi == 0) ? 1.0f : 0.0f; }
    f32x16 negm;
#pragma unroll
    for (int r = 0; r < 16; ++r) negm[r] = MOBA ? 0.f : -m_run;
    f32x16 o[2]; o[0] = f32x16{}; o[1] = f32x16{};
    ATT_WAIT_BAR0();
    unsigned sel = 0u;
    if (MOBA) {
        if (qb <= 3) sel = (1u << qb) - 1u;
        else {
            const float* ksl = (const float*)(shm + L_KS);
            float gv[7];
#pragma unroll
            for (int i = 0; i < 7; ++i) {
                float s = 0.f;
#pragma unroll
                for (int d0 = 0; d0 < 4; ++d0) {
                    const f32x4 k0 = *(const f32x4*)(ksl + i * 64 + 16 * d0 + 8 * hi), k1 = *(const f32x4*)(ksl + i * 64 + 16 * d0 + 8 * hi + 4);
#pragma unroll
                    for (int jj = 0; jj < 4; ++jj) { s += bf2f((unsigned short)qr[d0][jj]) * k0[jj]; s += bf2f((unsigned short)qr[d0][4 + jj]) * k1[jj]; }
                }
                auto rr = __builtin_amdgcn_permlane32_swap(__float_as_uint(s), __float_as_uint(s), false, false);
                s = __uint_as_float(rr[0]) + __uint_as_float(rr[1]);
                gv[i] = (i < qb) ? s : -INFINITY;
            }
#pragma unroll
            for (int rk = 0; rk < 3; ++rk) { float best = -INFINITY; int bi = 0;
#pragma unroll
                for (int i = 0; i < 7; ++i) { const bool c = (((sel >> i) & 1u) == 0u) && (gv[i] > best); best = c ? gv[i] : best; bi = c ? i : bi; }
                sel |= 1u << bi; }
        }
    }
    for (int it = 0; it < NT; ++it) {
        const int kt = kt0 + it; const int cur = (it & (NSLOT - 1)) * SLOTB;
        if (it + 3 < NT) { const int sl = ((it + 3) & (NSLOT - 1)) * SLOTB; ATT_DMA_K(kt + 3, sl); ATT_DMA_V(kt + 3, sl); }
        bool need; bool on = true;
        if (MOBA) { if (kt < 4 * qb) { on = ((sel >> (kt >> 2)) & 1u) != 0u; need = __any(on) != 0; } else need = (64 * kt <= qa + 31); }
        else need = (64 * kt + 63 >= qa - 127) && (64 * kt <= qa + 31);
        if (need) {
            f32x16 p0, p1; qkt(p0, p1, kp0 + cur, qr, negm);
            if (MOBA && kt < 4 * qb) {
                if (!__all(on)) {
#pragma unroll
                    for (int r = 0; r < 16; ++r) { p0[r] = on ? p0[r] : NEG; p1[r] = on ? p1[r] : NEG; }
                }
            } else {
                const bool edge = MOBA ? (64 * kt + 63 > qa) : !((64 * kt + 63 <= qa) && (qa + 31 - 64 * kt <= 127));
                if (edge) {
                    const int dq = qa + r32 - 64 * kt - 4 * hi;
#pragma unroll
                    for (int r = 0; r < 16; ++r) { const int d0_ = dq - ((r & 3) + 8 * (r >> 2)), d1_ = d0_ - 32;
                        const bool v0 = MOBA ? (d0_ >= 0) : ((unsigned)d0_ < 128u), v1 = MOBA ? (d1_ >= 0) : ((unsigned)d1_ < 128u);
                        p0[r] = v0 ? p0[r] : NEG; p1[r] = v1 ? p1[r] : NEG; }
                }
            }
            const float rm = rowmax32(p0, p1);
            const bool sent = (m_run <= M0), live = (rm > 0.5f * NEG);
            const bool upd = sent ? live : (rm > THR);
            if (__any(upd)) {
                const float dl = sent ? (live ? rm : 0.f) : fmaxf(rm, 0.f);
                const float f = sent ? 1.0f : __builtin_amdgcn_exp2f(-dl);
                m_run = sent ? (live ? rm : m_run) : (m_run + dl);
                const float nm = (m_run <= M0) ? 0.f : -m_run;
#pragma unroll
                for (int r = 0; r < 16; ++r) { p0[r] -= dl; p1[r] -= dl; negm[r] = nm; }
                l_run *= f;
                if (hi == 0) wsf[r32] = f;
                LDS_WAIT();
#pragma unroll
                for (int r = 0; r < 16; ++r) { const float fr_ = wsf[crow(r, hi)]; o[0][r] *= fr_; o[1][r] *= fr_; }
            }
            float sacc = 0.f;
#pragma unroll
            for (int r = 0; r < 16; ++r) { p0[r] = __builtin_amdgcn_exp2f(p0[r]); p1[r] = __builtin_amdgcn_exp2f(p1[r]); sacc += p0[r] + p1[r]; }
            l_run += sacc;
            u32x4 pw0, pw1, pw2, pw3;
            pw0 = (u32x4){cvtpk(p0[0], p0[1]), cvtpk(p0[2], p0[3]), cvtpk(p0[4], p0[5]), cvtpk(p0[6], p0[7])};
            pw1 = (u32x4){cvtpk(p0[8], p0[9]), cvtpk(p0[10], p0[11]), cvtpk(p0[12], p0[13]), cvtpk(p0[14], p0[15])};
            pw2 = (u32x4){cvtpk(p1[0], p1[1]), cvtpk(p1[2], p1[3]), cvtpk(p1[4], p1[5]), cvtpk(p1[6], p1[7])};
            pw3 = (u32x4){cvtpk(p1[8], p1[9]), cvtpk(p1[10], p1[11]), cvtpk(p1[12], p1[13]), cvtpk(p1[14], p1[15])};
            ATT_SBAR();
            pv(o, vb0 + cur, __builtin_bit_cast(bf16x8, pw0), __builtin_bit_cast(bf16x8, pw1), __builtin_bit_cast(bf16x8, pw2), __builtin_bit_cast(bf16x8, pw3));
        }
        if (it + 1 < NT) {
            if (it + 3 < NT) ATT_WAIT_BARN(4); else if (it + 2 < NT) ATT_WAIT_BARN(2); else ATT_WAIT_BAR0();
        }
    }
    { auto rr = __builtin_amdgcn_permlane32_swap(__float_as_uint(l_run), __float_as_uint(l_run), false, false); l_run = __uint_as_float(rr[0]) + __uint_as_float(rr[1]); }
    if (hi == 0) wsf[32 + r32] = l_run;
    LDS_WAIT();
    float rli[16];
#pragma unroll
    for (int r = 0; r < 16; ++r) rli[r] = __builtin_amdgcn_rcpf(wsf[32 + crow(r, hi)]);
    bf16_t* Ow = aout + (rowbase + qa) * D + ocol;
    { bf16_t* stg = (bf16_t*)(shm + L_OST) + wid * 2048;
#pragma unroll
        for (int r = 0; r < 16; ++r) { const int orow = crow(r, hi);
#pragma unroll
            for (int d0 = 0; d0 < 2; ++d0) stg[orow * 64 + d0 * 32 + r32] = (bf16_t)f2bf(o[d0][r] * rli[r]); }
        LDS_WAIT();
#pragma unroll
        for (int i = 0; i < 4; ++i) { const int row = i * 8 + (lane >> 3), ch = lane & 7; const u32x4 v = *(const u32x4*)(stg + row * 64 + ch * 8); *(u32x4*)(Ow + (long)row * D + ch * 8) = v; } }
    asm volatile("s_waitcnt lgkmcnt(0)\n\ts_barrier" ::: "memory");
#undef ATT_DMA_K
#undef ATT_DMA_V
}
}

__device__ __forceinline__ void sincos_d(double a, double& s, double& c) {
    const double q = __builtin_rint(a * 0.63661977236758134308);
    double r = __builtin_fma(-q, 1.57079632679489655800e+00, a);
    r = __builtin_fma(-q, 6.12323399573676603587e-17, r);
    const double r2 = r * r;
    double sp = -1.0 / 1307674368000.0;
    sp = sp * r2 + 1.0 / 6227020800.0; sp = sp * r2 - 1.0 / 39916800.0; sp = sp * r2 + 1.0 / 362880.0; sp = sp * r2 - 1.0 / 5040.0; sp = sp * r2 + 1.0 / 120.0; sp = sp * r2 - 1.0 / 6.0;
    const double sr = r + r * r2 * sp;
    double cp = 1.0 / 20922789888000.0;
    cp = cp * r2 - 1.0 / 87178291200.0; cp = cp * r2 + 1.0 / 479001600.0; cp = cp * r2 - 1.0 / 3628800.0; cp = cp * r2 + 1.0 / 40320.0; cp = cp * r2 - 1.0 / 720.0; cp = cp * r2 + 1.0 / 24.0; cp = cp * r2 - 0.5;
    const double cr = 1.0 + r2 * cp;
    const int n = ((int)q) & 3;
    s = (n == 0) ? sr : (n == 1) ? cr : (n == 2) ? -sr : -cr;
    c = (n == 0) ? cr : (n == 1) ? -sr : (n == 2) ? -cr : sr;
}
__device__ __forceinline__ int sigma_col(int p, int mode) {
    if (mode == 0) return (p & ~255) + 64 * ((p >> 5) & 3) + 32 * ((p >> 7) & 1) + pg8::perm32(p & 31);
    if (mode == 1) return (p & ~31) + pg8::perm32(p & 31);
    const int pn = p >> 8, q = p & 255; return 2 * (128 * pn + 32 * ((q >> 5) & 3) + pg8::perm32(q & 31)) + (q >> 7);
}
__device__ __forceinline__ void p0_transpose_item(const float* __restrict__ W, int N, bf16_t* __restrict__ WT, int mode, LAS float* scr, int item, int lane) {
    const int nblk = N / 32, kb = item / nblk, nb = item % nblk, k0 = 64 * kb, p0 = 32 * nb;
    const int sc = sigma_col(p0 + (lane & 31), mode);
#pragma unroll 8
    for (int i = 0; i < 32; ++i) { const int kk = 2 * i + (lane >> 5); scr[kk * 33 + (lane & 31)] = W[(size_t)(k0 + kk) * N + sc]; }
    LDS_WAIT(); asm volatile("" ::: "memory");
    const int c = lane & 7;
#pragma unroll
    for (int j = 0; j < 4; ++j) { const int n = (lane >> 3) + 8 * j; const LAS float* s = scr + (8 * c) * 33 + n;
        u32x4 o; o.x = cvtpk(s[0 * 33], s[1 * 33]); o.y = cvtpk(s[2 * 33], s[3 * 33]); o.z = cvtpk(s[4 * 33], s[5 * 33]); o.w = cvtpk(s[6 * 33], s[7 * 33]);
        *(u32x4*)(WT + (size_t)(p0 + n) * 1024 + k0 + 8 * c) = o; }
    LDS_WAIT(); asm volatile("" ::: "memory");
}

__device__ __forceinline__ void p0_transpose_item_fp8(const float* __restrict__ W, int N, unsigned char* __restrict__ WT, int mode, float scale, LAS float* scr, int item, int lane) {
    const int nblk = N / 32, kb = item / nblk, nb = item % nblk, k0 = 64 * kb, p0 = 32 * nb;
    const int sc = sigma_col(p0 + (lane & 31), mode);
#pragma unroll 8
    for (int i = 0; i < 32; ++i) { const int kk = 2 * i + (lane >> 5); scr[kk * 33 + (lane & 31)] = W[(size_t)(k0 + kk) * N + sc] * scale; }
    LDS_WAIT(); asm volatile("" ::: "memory");
    const int c = lane & 7;
#pragma unroll
    for (int j = 0; j < 4; ++j) { const int n = (lane >> 3) + 8 * j; const LAS float* s = scr + (8 * c) * 33 + n;
        u32x2 o; o.x = pk4_fp8(s[0 * 33], s[1 * 33], s[2 * 33], s[3 * 33]); o.y = pk4_fp8(s[4 * 33], s[5 * 33], s[6 * 33], s[7 * 33]);
        *(u32x2*)(WT + (size_t)(p0 + n) * 1024 + k0 + 8 * c) = o; }
    LDS_WAIT(); asm volatile("" ::: "memory");
}


#define XB_TMO      128
#define XB_XCNT(j)  (256  + 64 * (j))
#define XB_XSUB(j)  (1280 + 64 * (j))
#define XB_XGEN(j)  (2304 + 64 * (j))
#define XB_TOP      3328
#define XB_TOPGEN   3392
#define XCD_BAR_WORDS 3456
#define XB_SPIN_CAP (1u << 18)
__device__ __forceinline__ unsigned xb_ld(unsigned* p)              { return __hip_atomic_load(p, __ATOMIC_RELAXED, __HIP_MEMORY_SCOPE_AGENT); }
__device__ __forceinline__ unsigned xb_add(unsigned* p, unsigned v) { return __hip_atomic_fetch_add(p, v, __ATOMIC_RELAXED, __HIP_MEMORY_SCOPE_AGENT); }
__device__ __forceinline__ unsigned xb_xcc_id() { return (unsigned)__builtin_amdgcn_s_getreg((3 << 11) | 20) & 0xFu; }
#define XB_SPIN(cond, bar) do { unsigned _sp = 0; while (cond) { __builtin_amdgcn_s_sleep(1); \
    if ((++_sp & 255u) == 0u) { if (xb_ld(&(bar)[XB_TMO])) break; if (_sp > XB_SPIN_CAP) { atomicAdd(&(bar)[XB_TMO], 1u); break; } } } } while (0)
struct XcdBarrier { unsigned* bar; unsigned x; volatile LAS unsigned* st; };
__device__ __forceinline__ XcdBarrier xcd_barrier_post(unsigned* bar, volatile LAS unsigned* st) {
    XcdBarrier b; b.bar = bar; b.x = xb_xcc_id(); b.st = st;
    if (threadIdx.x == 0) (void)xb_add(&bar[XB_XCNT(b.x)], 1u);
    return b;
}
__device__ __forceinline__ void xcd_barrier_complete(unsigned* bar, unsigned x, unsigned& nloc, unsigned& nx) {
    const unsigned G = gridDim.x * gridDim.y * gridDim.z;
    unsigned sum, cnt, mine, sp = 0u;
    for (;;) {
        sum = 0u; cnt = 0u; mine = 0u;
#pragma unroll
        for (unsigned j = 0; j < 16; ++j) { const unsigned c = xb_ld(&bar[XB_XCNT(j)]); sum += c; cnt += (c > 0u) ? 1u : 0u; mine = (j == x) ? c : mine; }
        if (sum == G) break;
        __builtin_amdgcn_s_sleep(1);
        if ((++sp & 255u) == 0u) { if (xb_ld(&bar[XB_TMO])) break; if (sp > XB_SPIN_CAP) { atomicAdd(&bar[XB_TMO], 1u); break; } }
    }
    nloc = mine > 0u ? mine : 1u; nx = cnt > 0u ? cnt : 1u;
}
__device__ __forceinline__ void xcd_barrier(const XcdBarrier& b) {
    asm volatile("s_waitcnt vmcnt(0)" ::: "memory");
    __syncthreads();
    if (threadIdx.x == 0) {
        unsigned* bar = b.bar;
        __builtin_amdgcn_s_waitcnt(0);
        unsigned nloc = b.st[0], nx = b.st[1];
        if (nloc == 0u) { xcd_barrier_complete(bar, b.x, nloc, nx); b.st[0] = nloc; b.st[1] = nx; }
        const unsigned old = xb_add(&bar[XB_XSUB(b.x)], 1u);
        const unsigned gen = old / nloc;
        if (old + 1u == (gen + 1u) * nloc) {
            __builtin_amdgcn_fence(__ATOMIC_RELEASE, "agent");
            asm volatile("s_waitcnt vmcnt(0)" ::: "memory");
            const unsigned og = xb_add(&bar[XB_TOP], 1u);
            const unsigned tg = og / nx;
            if (og + 1u == (tg + 1u) * nx) xb_add(&bar[XB_TOPGEN], 1u);
            else XB_SPIN(xb_ld(&bar[XB_TOPGEN]) == tg, bar);
            __builtin_amdgcn_fence(__ATOMIC_ACQUIRE, "agent");
            xb_add(&bar[XB_XGEN(b.x)], 1u);
            asm volatile("s_waitcnt vmcnt(0)" ::: "memory");
        } else {
            XB_SPIN(xb_ld(&bar[XB_XGEN(b.x)]) == gen, bar);
            __builtin_amdgcn_fence(__ATOMIC_ACQUIRE, "agent");
            asm volatile("s_waitcnt vmcnt(0)" ::: "memory");
        }
    }
    __syncthreads();
}

__global__ void __launch_bounds__(NTHREADS, 2) fwd_megakernel(Params p_arg) {
    extern __shared__ __attribute__((aligned(16))) unsigned char lds_raw[];
    LAS unsigned char* lds = (LAS unsigned char*)lds_raw;
    cg::grid_group grid = cg::this_grid();
#define PHASE_IDS() int tid = threadIdx.x; asm volatile("" : "+v"(tid)); const int lane = tid & 63, wave = __builtin_amdgcn_readfirstlane(tid >> 6); (void)lane; (void)wave
    const int G = gridDim.x, bx = blockIdx.x;
    typedef const __attribute__((address_space(4))) Params* KParams;
    const KParams kp0 = (KParams)__builtin_amdgcn_kernarg_segment_ptr();
#define PHASE_PTRS() KParams _kp = kp0; asm volatile("" : "+s"(_kp)); Params p; p.x = _kp->x; p.w_in = _kp->w_in; p.b_in = _kp->b_in; p.sinks = _kp->sinks; p.w_out = _kp->w_out; p.b_out = _kp->b_out; p.ln1_g = _kp->ln1_g; p.ln1_b = _kp->ln1_b; \
    p.w_router = _kp->w_router; p.b_router = _kp->b_router; p.w1 = _kp->w1; p.b1 = _kp->b1; p.w2 = _kp->w2; p.b2 = _kp->b2; p.ln2_g = _kp->ln2_g; p.ln2_b = _kp->ln2_b; p.out = _kp->out; p.ws = _kp->ws; unsigned char* const ws = p.ws; \
    unsigned* const ctl = (unsigned*)(ws + WS_CTL); float* const ksum = (float*)(ws + WS_KSUM); float* const rope = (float*)(ws + WS_ROPE); \
    bf16_t* const w_in_t = (bf16_t*)(ws + WS_WIN_T); bf16_t* const w_out_t = (bf16_t*)(ws + WS_WOUT_T); \
    unsigned char* const w1_8 = ws + WS_W1_8; unsigned char* const w2_8 = ws + WS_W2_8; unsigned char* const x1_8 = ws + WS_X1_8; unsigned char* const act8 = ws + WS_ACT8; \
    int* const cnt_blk = (int*)(ws + WS_CNT); int* const tile_e = (int*)(ws + WS_TILE_E); bf16_t* const wr_hi = (bf16_t*)(ws + WS_WR_HI); bf16_t* const wr_lo = (bf16_t*)(ws + WS_WR_LO); \
    int* const tok = (int*)(ws + WS_TOK); int* const asg_e = (int*)(ws + WS_ASG_E); float* const asg_g = (float*)(ws + WS_ASG_G); int* const asg_d = (int*)(ws + WS_ASG_D); \
    bf16_t* const x1b = (bf16_t*)(ws + WS_X1B); bf16_t* const xb = (bf16_t*)(ws + WS_XB); bf16_t* const attn_o = xb; bf16_t* const qkv = (bf16_t*)(ws + WS_QKV); unsigned char* const yb = ws + WS_YB; \
    (void)ctl; (void)ksum; (void)rope; (void)w_in_t; (void)w_out_t; (void)w1_8; (void)w2_8; (void)x1_8; (void)act8; (void)cnt_blk; (void)tile_e; (void)wr_hi; (void)wr_lo; (void)tok; (void)asg_e; (void)asg_g; (void)asg_d; \
    (void)x1b; (void)xb; (void)attn_o; (void)qkv; (void)yb
    if (threadIdx.x < 2) ((LAS unsigned*)(lds + LDS_BARST))[threadIdx.x] = 0u;
    __syncthreads();
    XcdBarrier xbar;
    { PHASE_PTRS(); xbar = xcd_barrier_post(ctl + CW_BAR, (volatile LAS unsigned*)(lds + LDS_BARST)); }

    REP(0) {
        PHASE_IDS(); PHASE_PTRS();
        const long gt = (long)bx * NTHREADS + tid, gsz = (long)G * NTHREADS;
        for (long i = gt; i < 2048 * 32; i += gsz) {
            const int pos = (int)(i >> 5), k = (int)(i & 31);
            double inv = 1.0; for (int q = 0; q < k; ++q) inv *= 0.7498942093324559;
            double s, c; sincos_d((double)pos * inv, s, c);
            rope[pos * 64 + k] = (float)c; rope[pos * 64 + 32 + k] = (float)s;
        }
        for (long i = gt; i < 32 * 1024; i += gsz) {
            const int e = (int)(i >> 10), k = (int)(i & 1023); const float w = p.w_router[k * 32 + e];
            const unsigned h = f2bf(w); wr_hi[i] = (bf16_t)h; wr_lo[i] = (bf16_t)f2bf(w - bf2f(h));
        }
        LAS float* scr = (LAS float*)(lds + wave * 16384);
        const int gw = bx * 8 + wave, NGW = G * 8;
        constexpr int I_IN = 16 * (INW / 32), I_OUT = 16 * 32, I_W1 = 16 * 64, I_W2 = 16 * 32;
        constexpr int NITEMS = I_IN + I_OUT + NE * I_W1 + NE * I_W2;
        for (int it = gw; it < NITEMS; it += NGW) {
            int r = it;
#if INPROJ_FP8
            if (r < I_IN) { p0_transpose_item_fp8(p.w_in, INW, (unsigned char*)w_in_t, 0, WIN_SCALE, scr, r, lane); continue; } r -= I_IN;
#else
            if (r < I_IN) { p0_transpose_item(p.w_in, INW, w_in_t, 0, scr, r, lane); continue; } r -= I_IN;
#endif
            if (r < I_OUT) { p0_transpose_item(p.w_out, 1024, w_out_t, 1, scr, r, lane); continue; } r -= I_OUT;
            if (r < NE * I_W1) { const int e = r / I_W1; p0_transpose_item_fp8(p.w1 + (size_t)e * 1024 * 2048, 2048, w1_8 + (size_t)e * 2048 * 1024, 2, W_SCALE, scr, r % I_W1, lane); continue; } r -= NE * I_W1;
            { const int e = r / I_W2; p0_transpose_item_fp8(p.w2 + (size_t)e * 1024 * 1024, 1024, w2_8 + (size_t)e * 1024 * 1024, 1, W_SCALE, scr, r % I_W2, lane); }
        }
        const f32x4* x4 = (const f32x4*)p.x;
#if INPROJ_FP8
        u32x2* x8 = (u32x2*)xb;
        for (long i = gt; i < (long)T * D / 8; i += gsz) { const f32x4 a = x4[2 * i], b = x4[2 * i + 1];
            u32x2 o; o.x = pk4_fp8(a[0], a[1], a[2], a[3]); o.y = pk4_fp8(b[0], b[1], b[2], b[3]); x8[i] = o; }
#else
        u32x4* xb4 = (u32x4*)xb;
        for (long i = gt; i < (long)T * D / 8; i += gsz) { const f32x4 a = x4[2 * i], b = x4[2 * i + 1];
            u32x4 o; o.x = cvtpk(a[0], a[1]); o.y = cvtpk(a[2], a[3]); o.z = cvtpk(b[0], b[1]); o.w = cvtpk(b[2], b[3]); xb4[i] = o; }
#endif
    }
    grid.sync();

    REP(1) {
        PHASE_PTRS();
#if INPROJ_FP8
        pg8::SchedInProj<1024> S{(const char*)xb, (const char*)w_in_t, G, bx};
        pg8::EpiInProj E{qkv, p.b_in, rope, ksum, 1.0f / WIN_SCALE};
        pg8::gemm_phase<pg8::EpiInProj, pg8::SchedInProj<1024>, false, true, 512, true>(lds, S, E);
#else
        pg8::SchedInProj<2048> S{(const char*)xb, (const char*)w_in_t, G, bx};
        pg8::EpiInProj E{qkv, p.b_in, rope, ksum, 1.0f};
        pg8::gemm_phase<pg8::EpiInProj, pg8::SchedInProj<2048>, false, true>(lds, S, E);
#endif
    }
    xcd_barrier(xbar);

    REP(2) for (int u = bx; u < 256; u += G) {
        PHASE_PTRS();
        { const int b = u >> 3, h = u & 7;
            for (int j = 0; j < 8; ++j) att::attn_item<true>((char*)lds_raw, qkv, attn_o, b, h, j, p.sinks, ksum); }
        { const int b = u >> 3, kvh = (u >> 2) & 1, oct = u & 3;
            for (int i = 0; i < 8; ++i) att::attn_item<false>((char*)lds_raw, qkv, attn_o, b, kvh, oct * 8 + i, p.sinks, ksum); }
    }
    xcd_barrier(xbar);

    REP(3) for (int pm = bx; pm < T / 256; pm += G) {
        PHASE_IDS(); PHASE_PTRS();
        {
            pg8::SchedPanel S{(const char*)attn_o, (const char*)w_out_t, pm};
            pg8::EpiOutProj E{(bf16_t*)p.out, p.b_out, p.x};
            pg8::gemm_phase<pg8::EpiOutProj, pg8::SchedPanel, false, true>(lds, S, E);
        }
        __syncthreads();
        {
#pragma unroll
            for (int i = 0; i < 16; ++i) { const int idx = tid + 512 * i, mat = idx >> 12, rw = (idx >> 7) & 31, ch = idx & 127;
                const u32x4 v = *(const u32x4*)((mat ? wr_lo : wr_hi) + rw * 1024 + ch * 8);
                *(LAS u32x4*)(lds + mat * 66048 + rw * 2064 + ch * 16) = v; }
        }
        {
            const bf16_t* ytmp = (const bf16_t*)p.out;
            f32x4 gg[2][2], bb[2][2];
#pragma unroll
            for (int j = 0; j < 2; ++j)
#pragma unroll
                for (int h = 0; h < 2; ++h) { gg[j][h] = *(const f32x4*)(p.ln1_g + 512 * j + 8 * lane + 4 * h); bb[j][h] = *(const f32x4*)(p.ln1_b + 512 * j + 8 * lane + 4 * h); }
            for (int rr = 0; rr < 32; rr += 4) {
                const size_t row0 = (size_t)pm * 256 + wave * 32 + rr;
                u32x4 raw[4][2]; float v[4][2][8]; float sm[4], sq[4];
#pragma unroll
                for (int q = 0; q < 4; ++q)
#pragma unroll
                    for (int j = 0; j < 2; ++j) raw[q][j] = *(const u32x4*)(ytmp + (row0 + q) * D + 512 * j + 8 * lane);
#pragma unroll
                for (int q = 0; q < 4; ++q) { float s_ = 0.f;
#pragma unroll
                    for (int j = 0; j < 2; ++j)
#pragma unroll
                        for (int c = 0; c < 4; ++c) { const unsigned w = raw[q][j][c]; v[q][j][2 * c] = bf2f(w & 0xffffu); v[q][j][2 * c + 1] = bf2f(w >> 16); s_ += v[q][j][2 * c] + v[q][j][2 * c + 1]; }
                    sm[q] = s_; }
#pragma unroll
                for (int o = 1; o < 64; o <<= 1) {
#pragma unroll
                    for (int q = 0; q < 4; ++q) sm[q] += __shfl_xor(sm[q], o); }
#pragma unroll
                for (int q = 0; q < 4; ++q) { const float mean = sm[q] * (1.0f / D); float s2 = 0.f;
#pragma unroll
                    for (int j = 0; j < 2; ++j)
#pragma unroll
                        for (int c = 0; c < 8; ++c) { v[q][j][c] -= mean; s2 += v[q][j][c] * v[q][j][c]; }
                    sq[q] = s2; }
#pragma unroll
                for (int o = 1; o < 64; o <<= 1) {
#pragma unroll
                    for (int q = 0; q < 4; ++q) sq[q] += __shfl_xor(sq[q], o); }
#pragma unroll
                for (int q = 0; q < 4; ++q) {
                    const float rstd = 1.0f / sqrtf(sq[q] * (1.0f / D) + LN_EPS);
#pragma unroll
                    for (int j = 0; j < 2; ++j) {
                        float xv[8];
#pragma unroll
                        for (int c = 0; c < 8; ++c) xv[c] = v[q][j][c] * rstd * gg[j][c >> 2][c & 3] + bb[j][c >> 2][c & 3];
                        u32x4 hv; hv.x = cvtpk(xv[0], xv[1]); hv.y = cvtpk(xv[2], xv[3]); hv.z = cvtpk(xv[4], xv[5]); hv.w = cvtpk(xv[6], xv[7]);
                        u32x2 fv; fv.x = pk4_fp8(xv[0], xv[1], xv[2], xv[3]); fv.y = pk4_fp8(xv[4], xv[5], xv[6], xv[7]);
                        *(u32x4*)(x1b + (row0 + q) * D + 512 * j + 8 * lane) = hv;
                        *(u32x2*)(x1_8 + (row0 + q) * D + 512 * j + 8 * lane) = fv;
                    }
                }
            }
        }
        __syncthreads();
        {
            const int fr = lane & 15, fq = lane >> 4;
            f32x4 lacc[2][2];
#pragma unroll
            for (int m = 0; m < 2; ++m)
#pragma unroll
                for (int n = 0; n < 2; ++n) lacc[m][n] = (f32x4){0.f, 0.f, 0.f, 0.f};
            const size_t r0 = (size_t)pm * 256 + wave * 32;
            const bf16_t* ah = x1b + (r0 + fr) * D + 8 * fq;
            const LAS unsigned char* bh = lds + fr * 2064 + 16 * fq; const LAS unsigned char* bl = bh + 66048;
#pragma unroll 4
            for (int k0 = 0; k0 < 1024; k0 += 32) {
                bf16x8 a_hi[2], b_hi[2], b_lo[2];
#pragma unroll
                for (int m = 0; m < 2; ++m) a_hi[m] = *(const bf16x8*)(ah + (size_t)m * 16 * D + k0);
#pragma unroll
                for (int n = 0; n < 2; ++n) { b_hi[n] = *(const LAS bf16x8*)(bh + n * 16 * 2064 + k0 * 2); b_lo[n] = *(const LAS bf16x8*)(bl + n * 16 * 2064 + k0 * 2); }
#pragma unroll
                for (int m = 0; m < 2; ++m)
#pragma unroll
                    for (int n = 0; n < 2; ++n) {
                        lacc[m][n] = __builtin_amdgcn_mfma_f32_16x16x32_bf16(a_hi[m], b_hi[n], lacc[m][n], 0, 0, 0);
                        lacc[m][n] = __builtin_amdgcn_mfma_f32_16x16x32_bf16(a_hi[m], b_lo[n], lacc[m][n], 0, 0, 0);
                    }
            }
            __syncthreads();
            LAS float* lg = (LAS float*)lds;
#pragma unroll
            for (int m = 0; m < 2; ++m)
#pragma unroll
                for (int n = 0; n < 2; ++n)
#pragma unroll
                    for (int rg = 0; rg < 4; ++rg) lg[(wave * 32 + 16 * m + 4 * fq + rg) * 33 + 16 * n + fr] = lacc[m][n][rg];
        }
        __syncthreads();
        {
            LAS float* lg = (LAS float*)lds;
            LAS int* wcnt = (LAS int*)(lds + 36864);
            float t0 = -INFINITY, t1 = -INFINITY, t2 = -INFINITY, t3 = -INFINITY; int i0 = 0, i1 = 0, i2 = 0, i3 = 0;
            int rk0 = 0, rk1 = 0, rk2 = 0, rk3 = 0;
            if (tid < 256) {
                for (int e = 0; e < NE; ++e) {
                    const float xv = lg[tid * 33 + e] + p.b_router[e];
                    if (xv > t3) {
                        if (xv > t2) { t3 = t2; i3 = i2;
                            if (xv > t1) { t2 = t1; i2 = i1;
                                if (xv > t0) { t1 = t0; i1 = i0; t0 = xv; i0 = e; } else { t1 = xv; i1 = e; }
                            } else { t2 = xv; i2 = e; }
                        } else { t3 = xv; i3 = e; }
                    }
                }
                const unsigned selm = (1u << i0) | (1u << i1) | (1u << i2) | (1u << i3);
                for (int e = 0; e < NE; ++e) {
                    const bool has = ((selm >> e) & 1u) != 0u;
                    const unsigned long long bal = __ballot(has);
                    const int pre = __popcll(bal & ((1ull << lane) - 1ull));
                    if (e == i0) rk0 = pre; if (e == i1) rk1 = pre; if (e == i2) rk2 = pre; if (e == i3) rk3 = pre;
                    if (lane == 0) wcnt[wave * 32 + e] = __popcll(bal);
                }
            }
            __syncthreads();
            if (tid < 256) {
                const float e1 = __expf(t1 - t0), e2 = __expf(t2 - t0), e3 = __expf(t3 - t0);
                const float inv = 1.0f / (1.0f + e1 + e2 + e3);
                int b0 = 0, b1 = 0, b2 = 0, b3 = 0;
                for (int w = 0; w < wave; ++w) { b0 += wcnt[w * 32 + i0]; b1 += wcnt[w * 32 + i1]; b2 += wcnt[w * 32 + i2]; b3 += wcnt[w * 32 + i3]; }
                const size_t a = ((size_t)pm * 256 + tid) * 4;
                *(int4*)(asg_e + a) = make_int4(i0, i1, i2, i3);
                *(float4*)(asg_g + a) = make_float4(inv, e1 * inv, e2 * inv, e3 * inv);
                *(int4*)(asg_d + a) = make_int4(b0 + rk0, b1 + rk1, b2 + rk2, b3 + rk3);
            }
            if (tid < 32) cnt_blk[pm * 32 + tid] = wcnt[tid] + wcnt[32 + tid] + wcnt[64 + tid] + wcnt[96 + tid];
            __syncthreads();
        }
    }
    xcd_barrier(xbar);

    for (int pm = bx; pm < T / 256; pm += G) {
        PHASE_IDS(); PHASE_PTRS();
        LAS int* part_all = (LAS int*)lds; LAS int* part_pre = part_all + 512; LAS int* tot = part_pre + 512; LAS int* pre = tot + 32; LAS int* poff = pre + 32;
        { const int e = tid & 31, seg = tid >> 5; int sa = 0, sp = 0;
            for (int bb = seg * 16; bb < seg * 16 + 16; ++bb) { const int c = cnt_blk[bb * 32 + e]; sa += c; sp += (bb < pm) ? c : 0; }
            part_all[tid] = sa; part_pre[tid] = sp; }
        __syncthreads();
        if (tid < 32) { int sa = 0, sp = 0; for (int s = 0; s < 16; ++s) { sa += part_all[s * 32 + tid]; sp += part_pre[s * 32 + tid]; } tot[tid] = sa; pre[tid] = sp; }
        __syncthreads();
        if (tid == 0) { int off = 0; for (int e = 0; e < NE; ++e) { poff[e] = off; off += ((tot[e] + 255) >> 8) << 8; } poff[32] = off; }
        __syncthreads();
        if (tid < 256) {
            const int token = pm * 256 + tid; const size_t a = (size_t)token * 4;
            const int4 ee = *(const int4*)(asg_e + a); const int4 rk = *(const int4*)(asg_d + a);
            const int d0 = poff[ee.x] + pre[ee.x] + rk.x, d1 = poff[ee.y] + pre[ee.y] + rk.y, d2 = poff[ee.z] + pre[ee.z] + rk.z, d3 = poff[ee.w] + pre[ee.w] + rk.w;
            *(int4*)(asg_d + a) = make_int4(d0, d1, d2, d3);
            tok[d0] = token; tok[d1] = token; tok[d2] = token; tok[d3] = token;
        }
        if (pm < NE) {
            const int e = pm, n = tot[e], np = ((n + 255) >> 8) << 8, o = poff[e];
            for (int i = n + tid; i < np; i += NTHREADS) tok[o + i] = 0;
            for (int i = tid; i < (np >> 8); i += NTHREADS) tile_e[(o >> 8) + i] = e;
        }
        if (pm == 0 && tid == 0) ctl[CW_NTILES] = (unsigned)(poff[32] >> 8);
        __syncthreads();
    }
    xcd_barrier(xbar);

    REP(5) {
        PHASE_PTRS(); const int ntiles = (int)ctl[CW_NTILES];
        { LAS int* tl = (LAS int*)(lds + LDSX_TILE); for (int i = threadIdx.x; i < ntiles; i += NTHREADS) tl[i] = tile_e[i]; __syncthreads(); }
        pg8::SchedMoe<8, true> S{(const char*)x1_8, (const char*)w1_8, (const LAS int*)(lds + LDSX_TILE), tok, ntiles, G, bx};
        pg8::EpiSwiglu E{act8, p.b1};
        pg8::gemm_phase<pg8::EpiSwiglu, pg8::SchedMoe<8, true>, true, true, 512, true, true>(lds, S, E);
    }
    xcd_barrier(xbar);

    REP(6) {
        PHASE_PTRS(); const int ntiles = (int)ctl[CW_NTILES];
        { LAS int* tl = (LAS int*)(lds + LDSX_TILE); for (int i = threadIdx.x; i < ntiles; i += NTHREADS) tl[i] = tile_e[i]; __syncthreads(); }
        pg8::SchedMoe<4, false> S{(const char*)act8, (const char*)w2_8, (const LAS int*)(lds + LDSX_TILE), tok, ntiles, G, bx};
        pg8::EpiDown E{yb, p.b2};
        pg8::gemm_phase<pg8::EpiDown, pg8::SchedMoe<4, false>, false, true, 512, true, true>(lds, S, E);
    }
    xcd_barrier(xbar);

    REP(7) {
        PHASE_IDS(); PHASE_PTRS();
        const int gw = bx * 8 + wave, NGW = G * 8;
        f32x4 gg[2][2], bb[2][2];
#pragma unroll
        for (int j = 0; j < 2; ++j)
#pragma unroll
            for (int h = 0; h < 2; ++h) { gg[j][h] = *(const f32x4*)(p.ln2_g + 512 * j + 8 * lane + 4 * h); bb[j][h] = *(const f32x4*)(p.ln2_b + 512 * j + 8 * lane + 4 * h); }
        constexpr int R = 2;
        for (int row0 = gw; row0 < T; row0 += R * NGW) {
            int4 dd[R]; float4 gt[R];
#pragma unroll
            for (int q = 0; q < R; ++q) { const int row = row0 + q * NGW < T ? row0 + q * NGW : row0; dd[q] = *(const int4*)(asg_d + (size_t)row * 4); gt[q] = *(const float4*)(asg_g + (size_t)row * 4); }
            u32x4 xr[R][2]; u32x2 yk[R][4][2];
#pragma unroll
            for (int q = 0; q < R; ++q) { const int row = row0 + q * NGW < T ? row0 + q * NGW : row0;
#pragma unroll
                for (int j = 0; j < 2; ++j) {
                    xr[q][j] = *(const u32x4*)(x1b + (size_t)row * D + 512 * j + 8 * lane);
                    yk[q][0][j] = *(const u32x2*)(yb + (size_t)dd[q].x * D + 512 * j + 8 * lane);
                    yk[q][1][j] = *(const u32x2*)(yb + (size_t)dd[q].y * D + 512 * j + 8 * lane);
                    yk[q][2][j] = *(const u32x2*)(yb + (size_t)dd[q].z * D + 512 * j + 8 * lane);
                    yk[q][3][j] = *(const u32x2*)(yb + (size_t)dd[q].w * D + 512 * j + 8 * lane);
                } }
            float z[R][2][8]; float sm[R], sq[R];
#pragma unroll
            for (int q = 0; q < R; ++q) {
                const float g0 = gt[q].x * (1.0f / Y_SCALE), g1 = gt[q].y * (1.0f / Y_SCALE), g2 = gt[q].z * (1.0f / Y_SCALE), g3 = gt[q].w * (1.0f / Y_SCALE);
                float s_ = 0.f;
#pragma unroll
                for (int j = 0; j < 2; ++j)
#pragma unroll
                    for (int d = 0; d < 2; ++d) {
#define P7_PAIR(HH, SEL) do { \
                            const f32x2 a0 = __builtin_amdgcn_cvt_pk_f32_fp8((int)yk[q][0][j][d], SEL), a1 = __builtin_amdgcn_cvt_pk_f32_fp8((int)yk[q][1][j][d], SEL); \
                            const f32x2 a2 = __builtin_amdgcn_cvt_pk_f32_fp8((int)yk[q][2][j][d], SEL), a3 = __builtin_amdgcn_cvt_pk_f32_fp8((int)yk[q][3][j][d], SEL); \
                            const unsigned xw = xr[q][j][2 * d + HH]; \
                            const float lo = DN_ALPHA * bf2f(xw & 0xffffu) + g0 * a0.x + g1 * a1.x + g2 * a2.x + g3 * a3.x; \
                            const float hi = DN_ALPHA * bf2f(xw >> 16) + g0 * a0.y + g1 * a1.y + g2 * a2.y + g3 * a3.y; \
                            z[q][j][4 * d + 2 * HH] = lo; z[q][j][4 * d + 2 * HH + 1] = hi; s_ += lo + hi; } while (0)
                        P7_PAIR(0, false); P7_PAIR(1, true);
#undef P7_PAIR
                    }
                sm[q] = s_;
            }
#pragma unroll
            for (int o = 1; o < 64; o <<= 1) {
#pragma unroll
                for (int q = 0; q < R; ++q) sm[q] += __shfl_xor(sm[q], o); }
#pragma unroll
            for (int q = 0; q < R; ++q) { const float mean = sm[q] * (1.0f / D); float s2 = 0.f;
#pragma unroll
                for (int j = 0; j < 2; ++j)
#pragma unroll
                    for (int c = 0; c < 8; ++c) { z[q][j][c] -= mean; s2 += z[q][j][c] * z[q][j][c]; }
                sq[q] = s2; }
#pragma unroll
            for (int o = 1; o < 64; o <<= 1) {
#pragma unroll
                for (int q = 0; q < R; ++q) sq[q] += __shfl_xor(sq[q], o); }
#pragma unroll
            for (int q = 0; q < R; ++q) {
                const int row = row0 + q * NGW;
                if (row < T) {
                    const float rstd = 1.0f / sqrtf(sq[q] * (1.0f / D) + LN_EPS);
#pragma unroll
                    for (int j = 0; j < 2; ++j)
#pragma unroll
                        for (int h = 0; h < 2; ++h) {
                            f32x4 o;
#pragma unroll
                            for (int c = 0; c < 4; ++c) o[c] = z[q][j][4 * h + c] * rstd * gg[j][h][c] + bb[j][h][c];
                            *(f32x4*)(p.out + (size_t)row * D + 512 * j + 8 * lane + 4 * h) = o;
                        }
                }
            }
        }
    }
}

extern "C" void kernel_launch(void* const* d_in, const int* in_sizes, int n_in, void* d_out, int out_size, void* d_ws, size_t ws_size, hipStream_t stream) {
    static int grid_blocks = 0;
    if (grid_blocks == 0) {
        if (n_in != 16 || in_sizes[0] != T * D || out_size != T * D || ws_size < WS_END) {
            fprintf(stderr, "kernel_launch: unexpected shapes: n_in %d in0 %d out %d ws %zu (need %zu)\n", n_in, n_in > 0 ? in_sizes[0] : -1, out_size, ws_size, (size_t)WS_END); grid_blocks = -1; return; }
        int dev = 0, cus = 0, per_cu = 0;
        (void)hipGetDevice(&dev);
        (void)hipDeviceGetAttribute(&cus, hipDeviceAttributeMultiprocessorCount, dev);
        (void)hipFuncSetAttribute((const void*)fwd_megakernel, hipFuncAttributeMaxDynamicSharedMemorySize, LDS_BYTES);
        (void)hipOccupancyMaxActiveBlocksPerMultiprocessor(&per_cu, (const void*)fwd_megakernel, NTHREADS, LDS_BYTES);
        if (per_cu < 1) { fprintf(stderr, "kernel_launch: occupancy query reports %d blocks per CU\n", per_cu); per_cu = 1; }
        grid_blocks = cus;
        fprintf(stderr, "kernel_launch: cus=%d per_cu=%d grid=%d ws=%zu\n", cus, per_cu, grid_blocks, ws_size);
    }
    if (grid_blocks < 0) return;
    (void)hipMemsetAsync((char*)d_ws + WS_CTL, 0, CTL_ZERO_BYTES, stream);
    Params p{};
    p.x = (const float*)d_in[0]; p.w_in = (const float*)d_in[1]; p.b_in = (const float*)d_in[2]; p.sinks = (const float*)d_in[3]; p.w_out = (const float*)d_in[4]; p.b_out = (const float*)d_in[5];
    p.ln1_g = (const float*)d_in[6]; p.ln1_b = (const float*)d_in[7]; p.w_router = (const float*)d_in[8]; p.b_router = (const float*)d_in[9];
    p.w1 = (const float*)d_in[10]; p.b1 = (const float*)d_in[11]; p.w2 = (const float*)d_in[12]; p.b2 = (const float*)d_in[13]; p.ln2_g = (const float*)d_in[14]; p.ln2_b = (const float*)d_in[15];
    p.out = (float*)d_out; p.ws = (unsigned char*)d_ws;
    void* args[] = {&p};
    hipError_t e = hipLaunchCooperativeKernel((void*)fwd_megakernel, dim3(grid_blocks), dim3(NTHREADS), args, LDS_BYTES, stream);
    if (e != hipSuccess) fprintf(stderr, "cooperative launch failed: %s (grid %d)\n", hipGetErrorString(e), grid_blocks);
}
```

```cpp
#include <hip/hip_runtime.h>
#include <hip/hip_cooperative_groups.h>
#include <cstdio>
#include <cstdint>
namespace cg = cooperative_groups;

#define LAS __attribute__((address_space(3)))
typedef unsigned short bf16_t;
typedef short bf16x8 __attribute__((ext_vector_type(8)));
typedef short s16x4 __attribute__((ext_vector_type(4)));
typedef float f32x2 __attribute__((ext_vector_type(2)));
typedef float f32x4 __attribute__((ext_vector_type(4)));
typedef float f32x16 __attribute__((ext_vector_type(16)));
typedef unsigned u32x2 __attribute__((ext_vector_type(2)));
typedef unsigned u32x4 __attribute__((ext_vector_type(4)));
typedef __bf16 bf16x2_t __attribute__((ext_vector_type(2)));

constexpr int D = 1024, BATCH = 32, SEQ = 2048, T = BATCH * SEQ;
constexpr int INW = 2304, NE = 32;
constexpr float LN_EPS = 1e-5f;
constexpr float DN_ALPHA = 1.189207115002721f;
constexpr float LOG2E = 1.4426950408889634f;
constexpr float C2 = 0.18033688011112042f;
constexpr int NTHREADS = 512;
constexpr int LDS_BYTES = 147456;
constexpr int MAX_TILES = 1056;
#ifndef INPROJ_FP8
#define INPROJ_FP8 1
#endif
#ifndef EPI_DUP
#define EPI_DUP 0
#endif
#ifndef DUP_MASK
#define DUP_MASK 0
#endif
#define REP(k) for (int _rep = 0; _rep < (((DUP_MASK >> (k)) & 1) ? 2 : 1); ++_rep)

constexpr size_t MiB = 1u << 20;
constexpr size_t WS_CTL = 0, CTL_ZERO_BYTES = 2 * MiB;
constexpr size_t WS_KSUM = 1 * MiB;
constexpr size_t WS_ROPE = 2 * MiB;
constexpr size_t WS_WIN_T = 4 * MiB;
constexpr size_t WS_WOUT_T = 9 * MiB;
constexpr size_t WS_SMALL = 11 * MiB;
constexpr size_t WS_CNT = WS_SMALL, WS_TILE_E = WS_SMALL + 65536, WS_WR_HI = WS_SMALL + 131072, WS_WR_LO = WS_WR_HI + 65536;
constexpr size_t WS_TOK = 12 * MiB;
constexpr size_t WS_ASG_E = 14 * MiB, WS_ASG_G = 15 * MiB, WS_ASG_D = 16 * MiB;
constexpr size_t WS_W2_8 = 24 * MiB;
constexpr size_t WS_X1B = 56 * MiB;
constexpr size_t WS_ACT8 = 184 * MiB;
constexpr size_t WS_XB = 184 * MiB;
constexpr size_t WS_X1LO = 312 * MiB;
constexpr size_t WS_YB = 488 * MiB;
constexpr size_t WS_W1_8 = 488 * MiB;
constexpr size_t WS_X1_8 = 552 * MiB;
constexpr size_t WS_QKV = 616 * MiB;
constexpr size_t WS_END = 1016 * MiB;
constexpr float W_SCALE = 64.0f, ACT_SCALE = 4.0f, WIN_SCALE = 32.0f, Y_SCALE = 16.0f;
constexpr int CW_NTILES = 16, CW_BAR = 4096;
constexpr int LDSX_TILE = 131072, LDSX_IDX = 135424, LDSX_BIAS = 136448;
constexpr int LDS_BARST = LDS_BYTES - 256;

struct Params {
    const float *x, *w_in, *b_in, *sinks, *w_out, *b_out, *ln1_g, *ln1_b, *w_router, *b_router, *w1, *b1, *w2, *b2, *ln2_g, *ln2_b;
    float* out; unsigned char* ws;
};

__device__ __forceinline__ unsigned f2bf(float f) { unsigned u = __builtin_bit_cast(unsigned, f); return (u + 0x7fffu + ((u >> 16) & 1u)) >> 16; }
__device__ __forceinline__ float bf2f(unsigned h) { return __builtin_bit_cast(float, h << 16); }
__device__ __forceinline__ unsigned cvtpk(float lo, float hi) { f32x2 v = {lo, hi}; bf16x2_t b = __builtin_convertvector(v, bf16x2_t); return __builtin_bit_cast(unsigned, b); }
__device__ __forceinline__ unsigned pk4_fp8(float a, float b, float c, float d) { int w = 0; w = __builtin_amdgcn_cvt_pk_fp8_f32(a, b, w, false); w = __builtin_amdgcn_cvt_pk_fp8_f32(c, d, w, true); return (unsigned)w; }
__device__ __forceinline__ float wave_sum(float v) {
#pragma unroll
    for (int o = 1; o < 64; o <<= 1) v += __shfl_xor(v, o);
    return v;
}
#define LDS_WAIT() asm volatile("s_waitcnt lgkmcnt(0)" ::: "memory")
template <int X> __device__ __forceinline__ float swz_xor(float v) { return __builtin_bit_cast(float, __builtin_amdgcn_ds_swizzle(__builtin_bit_cast(int, v), (X << 10) | 0x1f)); }

namespace pg8 {
constexpr int BM = 256, BK = 64, HALF = 128, HTB = HALF * BK * 2, STAGE_BYTES = 8 * HTB, NXCD = 8, WGM = 8;
constexpr int KD = 1024;
__host__ __device__ __forceinline__ int lds_byte(int r, int c) { const int st = (r >> 4) * 2 + (c >> 5), rr = r & 15, cc = c & 31, ob = rr * 64 + cc * 2; return st * 1024 + (ob ^ (((ob >> 9) & 1) << 5)); }
__host__ __device__ __forceinline__ void stage_rc(int b, int& R, int& C) { const int st = b / 1024, sb = b % 1024, swz = sb ^ (((sb >> 9) & 1) << 5); R = (st >> 1) * 16 + swz / 64; C = (st & 1) * 32 + (swz % 64) / 2; }
__host__ __device__ __forceinline__ int perm32(int rho) { const int n = rho >> 4, i = rho & 15; return 8 * (i >> 2) + 4 * n + (i & 3); }

struct Unit { int pm, pn, e; unsigned ao, bo; const int* rows; };

typedef int v8i32_t __attribute__((ext_vector_type(8)));
typedef int v4i32_t __attribute__((ext_vector_type(4)));
__device__ __forceinline__ v8i32_t cat8(bf16x8 a, bf16x8 b) { const v4i32_t x = __builtin_bit_cast(v4i32_t, a), y = __builtin_bit_cast(v4i32_t, b); return __builtin_shufflevector(x, y, 0, 1, 2, 3, 4, 5, 6, 7); }
template <class Epi, class Sched, bool GATHER, bool ALIGN_EPI, int KP = 1024, bool FP8 = false, bool MOE = false>
__device__ __forceinline__ void gemm_phase(LAS unsigned char* lds, const Sched& S, const Epi& E) {
    int tid = threadIdx.x; asm volatile("" : "+v"(tid));
    const int wid = __builtin_amdgcn_readfirstlane(tid >> 6), lane = tid & 63, wr = wid >> 2, wc = wid & 3, fr = lane & 15, fq = lane >> 4;
    constexpr int K = KP, nt = K / BK;
    unsigned voffB[2], Vc[2][2]; int stR0, stC0;
    { int R, C; stage_rc(tid * 16, R, C); stR0 = R; stC0 = C; }
#pragma unroll
    for (int i = 0; i < 2; ++i) { voffB[i] = (unsigned)((stR0 + 64 * i) * K + stC0) * 2u; Vc[0][i] = voffB[i]; Vc[1][i] = voffB[i]; }
#define PG8_GATHER_LOAD(VV) do { int _t = threadIdx.x; asm volatile("" : "+v"(_t)); int _R, _C; stage_rc(_t * 16, _R, _C);     \
        const LAS int* _rp = (const LAS int*)(lds + LDSX_IDX) + _R; _Pragma("unroll") for (int _h = 0; _h < 2; ++_h) _Pragma("unroll") for (int _i = 0; _i < 2; ++_i) \
        VV[_h][_i] = ((unsigned)_rp[128 * _h + 64 * _i] * (unsigned)K + (unsigned)_C) * 2u; } while (0)
#define PG8_DMA4(gsrc, ldsoff) __builtin_amdgcn_global_load_lds((const unsigned*)(gsrc), (LAS unsigned*)(lds + (ldsoff)), 4, 0, 0)
    constexpr unsigned kstep = (unsigned)(BK * 2);
    constexpr unsigned hstep = (unsigned)HALF * K * 2;
    const char* const Abase = S.A; const char* const Bbase = S.B;
    const unsigned ldsw = (unsigned)wid * 1024u;
    const int aoff = lds_byte(wr * 64 + fr, fq * 8), boff = lds_byte(wc * 32 + fr, fq * 8);
#define PG8_SA(b, h) (((b) * 2 + (h)) * HTB)
#define PG8_SB(b, h) ((4 + (b) * 2 + (h)) * HTB)
#define PG8_STAGE(bufoff, gbase, soff, voff) do { _Pragma("unroll") for (int _i = 0; _i < 2; ++_i) \
        __builtin_amdgcn_global_load_lds((const unsigned*)((gbase) + (unsigned)((voff)[_i] + (soff))), (LAS unsigned*)(lds + (bufoff) + ldsw + _i * 8192), 16, 0, 0); } while (0)
#define PG8_STAGE_B(bufoff, soff) PG8_STAGE(bufoff, Bbase, soff, voffB)
#define PG8_STAGE_A(bufoff, soff, h, VV) do { if constexpr (GATHER) { PG8_STAGE(bufoff, Abase, soff, VV[h]); } else { PG8_STAGE(bufoff, Abase, (soff) + (h) * hstep, voffB); } } while (0)
#define PG8_LDA(dst, b, h) do { _Pragma("unroll") for (int m = 0; m < 4; ++m) dst[m] = cat8(*(const LAS bf16x8*)(lds + PG8_SA(b, h) + aoff + m * 2048), *(const LAS bf16x8*)(lds + PG8_SA(b, h) + aoff + m * 2048 + 1024)); } while (0)
#define PG8_LDB(dst, b, h) do { _Pragma("unroll") for (int n = 0; n < 2; ++n) dst[n] = cat8(*(const LAS bf16x8*)(lds + PG8_SB(b, h) + boff + n * 2048), *(const LAS bf16x8*)(lds + PG8_SB(b, h) + boff + n * 2048 + 1024)); } while (0)
#define PG8_LO(v) __builtin_bit_cast(bf16x8, __builtin_shufflevector(v, v, 0, 1, 2, 3))
#define PG8_HI(v) __builtin_bit_cast(bf16x8, __builtin_shufflevector(v, v, 4, 5, 6, 7))
#define PG8_MMA(ai, bj, At, Bt) do { __builtin_amdgcn_s_setprio(1); _Pragma("unroll") for (int m = 0; m < 4; ++m) _Pragma("unroll") for (int n = 0; n < 2; ++n) { \
        if constexpr (FP8) { acc[ai][bj][m][n] = __builtin_amdgcn_mfma_scale_f32_16x16x128_f8f6f4(Bt[n], At[m], acc[ai][bj][m][n], 0, 0, 0, 0x7f7f7f7f, 0, 0x7f7f7f7f); } \
        else { acc[ai][bj][m][n] = __builtin_amdgcn_mfma_f32_16x16x32_bf16(PG8_LO(Bt[n]), PG8_LO(At[m]), acc[ai][bj][m][n], 0, 0, 0); \
               acc[ai][bj][m][n] = __builtin_amdgcn_mfma_f32_16x16x32_bf16(PG8_HI(Bt[n]), PG8_HI(At[m]), acc[ai][bj][m][n], 0, 0, 0); } } \
        __builtin_amdgcn_s_setprio(0); } while (0)
#define PG8_WAIT_V(n) asm volatile("s_waitcnt vmcnt(" #n ")" ::: "memory")
#define PG8_WAIT_L(n) asm volatile("s_waitcnt lgkmcnt(" #n ")" ::: "memory")
#define PG8_BAR __builtin_amdgcn_s_barrier()
#define PG8_SCHED __builtin_amdgcn_sched_barrier(0)
    Unit cur, nxt; int ui = 0;
    if (!S.next(0, cur)) return;
    if constexpr (MOE) {
        if (wid < 4) { PG8_DMA4(E.bias_src(cur) + wid * 64 + lane, LDSX_BIAS + wid * 256); if constexpr (GATHER) PG8_DMA4(cur.rows + wid * 64 + lane, LDSX_IDX + wid * 256); }
        asm volatile("s_waitcnt vmcnt(0)" ::: "memory"); __builtin_amdgcn_s_barrier(); asm volatile("" ::: "memory");
    }
    if constexpr (GATHER) { PG8_GATHER_LOAD(Vc); }
    f32x4 acc[2][2][4][2];
#pragma unroll
    for (int a = 0; a < 2; ++a)
#pragma unroll
        for (int b = 0; b < 2; ++b)
#pragma unroll
            for (int m = 0; m < 4; ++m)
#pragma unroll
                for (int n = 0; n < 2; ++n) acc[a][b][m][n] = (f32x4){0.f, 0.f, 0.f, 0.f};
    v8i32_t At[4], B0[2], B1[2];
    unsigned cA = cur.ao, cB = cur.bo;
    PG8_STAGE_B(PG8_SB(0, 0), cB); PG8_STAGE_B(PG8_SB(0, 1), cB + hstep); PG8_STAGE_A(PG8_SA(0, 0), cA, 0, Vc); PG8_STAGE_A(PG8_SA(0, 1), cA, 1, Vc);
    if (wr == 1) PG8_BAR;
    PG8_WAIT_V(2); PG8_BAR;
    PG8_STAGE_B(PG8_SB(1, 0), cB + kstep); PG8_STAGE_A(PG8_SA(1, 0), cA + kstep, 0, Vc); PG8_STAGE_B(PG8_SB(1, 1), cB + hstep + kstep);
    PG8_WAIT_V(6); PG8_BAR;
    for (;;) {
        const bool has_next = S.next(ui + 1, nxt);
        const unsigned nA = has_next ? nxt.ao : cA; const unsigned nB = has_next ? nxt.bo : cB;
        if constexpr (MOE) {
            if (has_next && wid < 4) { PG8_DMA4(E.bias_src(nxt) + wid * 64 + lane, LDSX_BIAS + ((ui + 1) % 3) * 1024 + wid * 256); if constexpr (GATHER) PG8_DMA4(nxt.rows + wid * 64 + lane, LDSX_IDX + wid * 256); }
        }
#pragma unroll 1
        for (int t = 0; t < nt; t += 2) {
            const bool last = (t == nt - 2);
            const unsigned a1 = cA + (unsigned)(t + 1) * kstep;
            const unsigned a2 = last ? nA : cA + (unsigned)(t + 2) * kstep; const unsigned b2 = last ? nB : cB + (unsigned)(t + 2) * kstep;
            const unsigned a3 = a2 + kstep; const unsigned b3 = b2 + kstep;
            PG8_LDB(B0, 0, 0); PG8_LDB(B1, 0, 1); PG8_SCHED; PG8_LDA(At, 0, 0); PG8_STAGE_A(PG8_SA(1, 1), a1, 1, Vc);
            if constexpr (GATHER) { if (last && has_next) { PG8_GATHER_LOAD(Vc); } }
            PG8_WAIT_V(8); PG8_WAIT_L(0); PG8_BAR; PG8_MMA(0, 0, At, B0); PG8_MMA(0, 1, At, B1); PG8_BAR; PG8_SCHED;
            PG8_LDA(At, 0, 1); PG8_STAGE_B(PG8_SB(0, 0), b2); PG8_STAGE_B(PG8_SB(0, 1), b2 + hstep); PG8_STAGE_A(PG8_SA(0, 0), a2, 0, Vc);
            PG8_WAIT_V(8); PG8_WAIT_L(0); PG8_BAR; PG8_MMA(1, 0, At, B0); PG8_MMA(1, 1, At, B1); PG8_BAR; PG8_SCHED;
            PG8_LDB(B0, 1, 0); PG8_LDB(B1, 1, 1); PG8_SCHED; PG8_LDA(At, 1, 0); PG8_STAGE_A(PG8_SA(0, 1), a2, 1, Vc);
            PG8_WAIT_V(8); PG8_WAIT_L(0); PG8_BAR; PG8_MMA(0, 0, At, B0); PG8_MMA(0, 1, At, B1); PG8_BAR; PG8_SCHED;
            PG8_LDA(At, 1, 1); PG8_STAGE_B(PG8_SB(1, 0), b3); PG8_STAGE_B(PG8_SB(1, 1), b3 + hstep); PG8_STAGE_A(PG8_SA(1, 0), a3, 0, Vc);
            PG8_WAIT_V(8); PG8_WAIT_L(0); PG8_BAR; PG8_MMA(1, 0, At, B0); PG8_MMA(1, 1, At, B1); PG8_BAR; PG8_SCHED;
        }
        if constexpr (ALIGN_EPI) { if (wr == 0) PG8_BAR; }
        { int t2 = threadIdx.x; asm volatile("" : "+v"(t2));
          if constexpr (MOE) { E(acc, cur, wr, wc, t2 & 15, (t2 & 63) >> 4, (const LAS float*)(lds + LDSX_BIAS + (ui % 3) * 1024));
              if (EPI_DUP) { asm volatile("" : "+v"(t2)); E(acc, cur, wr, wc, t2 & 15, (t2 & 63) >> 4, (const LAS float*)(lds + LDSX_BIAS + (ui % 3) * 1024)); } }
          else E(acc, cur, wr, wc, t2 & 15, (t2 & 63) >> 4); }
        if (!has_next) break;
#pragma unroll
        for (int a = 0; a < 2; ++a)
#pragma unroll
            for (int b = 0; b < 2; ++b)
#pragma unroll
                for (int m = 0; m < 4; ++m)
#pragma unroll
                    for (int n = 0; n < 2; ++n) acc[a][b][m][n] = (f32x4){0.f, 0.f, 0.f, 0.f};
        cur = nxt; cA = nA; cB = nB; ++ui;
        if constexpr (ALIGN_EPI) { if (wr == 1) PG8_BAR; }
    }
    PG8_WAIT_V(0);
    if constexpr (!ALIGN_EPI) { if (wr == 0) PG8_BAR; }
    PG8_BAR;
#undef PG8_SA
#undef PG8_SB
#undef PG8_STAGE
#undef PG8_STAGE_A
#undef PG8_STAGE_B
#undef PG8_GATHER_LOAD
#undef PG8_DMA4
#undef PG8_LDA
#undef PG8_LDB
#undef PG8_LO
#undef PG8_HI
#undef PG8_MMA
#undef PG8_WAIT_V
#undef PG8_WAIT_L
#undef PG8_BAR
#undef PG8_SCHED
}

template <int ROWB>
struct SchedInProj {
    const char* A; const char* B; int G, c;
    __device__ __forceinline__ bool next(int i, Unit& u) const {
        constexpr int nM = T / BM, nN = INW / BM, nwg = nM * nN;
        const long L = (long)i * G + c; if (L >= nwg) return false;
        int wgid = (int)L; { const int q = nwg / NXCD, r = nwg % NXCD, xcd = wgid % NXCD, off = wgid / NXCD; wgid = (xcd < r ? xcd * (q + 1) : r * (q + 1) + (xcd - r) * q) + off; }
        const int nig = WGM * nN, gid = wgid / nig, fm = gid * WGM, gsz = (nM - fm) < WGM ? (nM - fm) : WGM;
        u.pm = fm + ((wgid % nig) % gsz); u.pn = (wgid % nig) / gsz; u.e = 0; u.rows = nullptr;
        u.ao = (unsigned)u.pm * (unsigned)(256 * ROWB); u.bo = (unsigned)u.pn * (unsigned)(256 * ROWB); return true;
    }
};
struct SchedPanel {
    const char* A; const char* B; int pm;
    __device__ __forceinline__ bool next(int i, Unit& u) const {
        if (i >= 4) return false;
        u.pm = pm; u.pn = i; u.e = 0; u.rows = nullptr; u.ao = (unsigned)pm * (unsigned)(256 * KD * 2); u.bo = (unsigned)i * (unsigned)(256 * KD * 2); return true;
    }
};
template <int NPN, bool G1>
struct SchedMoe {
    const char* A; const char* B; const LAS int* tile_e; const int* tok; int ntiles, G, c;
    __device__ __forceinline__ bool next(int i, Unit& u) const {
        const long L = (long)i * G + c; int t, pn;
        if ((G & 7) == 0) { const int x = (int)(L & 7); const long j = L >> 3; t = (int)(j / NPN) * 8 + x; pn = (int)(j % NPN); }
        else { t = (int)(L / NPN); pn = (int)(L % NPN); }
        if (t >= ntiles) return false;
        const int e = __builtin_amdgcn_readfirstlane(tile_e[t]);
        u.pm = t; u.pn = pn; u.e = e;
        if (G1) { u.ao = 0u; u.rows = tok + (size_t)t * 256; u.bo = ((unsigned)e * 2048u + (unsigned)pn * 256u) * 1024u; }
        else { u.ao = (unsigned)t * (256u * 1024u); u.rows = nullptr; u.bo = ((unsigned)e * 1024u + (unsigned)pn * 256u) * 1024u; }
        return true;
    }
};

struct EpiInProj {
    bf16_t* qkv; const float* b_in; const float* rope; float* ksum; float descale;
    __device__ __forceinline__ void operator()(const f32x4 (&acc)[2][2][4][2], const Unit& u, int wr, int wc, int fr, int fq) const {
        const int pn = u.pn;
        const int colb = 256 * pn + 64 * wc + 8 * fq;
        const bool do_rope = !(pn >= 7 || (pn == 2 && wc >= 2));
        const bool is_q = (pn < 2) || (pn == 3) || (pn == 4);
        const bool is_kb = (pn == 5) || (pn == 6);
        const float sc = is_q ? C2 : 1.0f;
        f32x4 bv[2][2];
#pragma unroll
        for (int bj = 0; bj < 2; ++bj)
#pragma unroll
            for (int n = 0; n < 2; ++n) bv[bj][n] = *(const f32x4*)(b_in + colb + 32 * bj + 4 * n);
        f32x4 ks[2][2];
#pragma unroll
        for (int bj = 0; bj < 2; ++bj)
#pragma unroll
            for (int n = 0; n < 2; ++n) ks[bj][n] = (f32x4){0.f, 0.f, 0.f, 0.f};
#pragma unroll
        for (int ai = 0; ai < 2; ++ai)
#pragma unroll
            for (int m = 0; m < 4; ++m) {
                const int row = u.pm * 256 + ai * 128 + wr * 64 + m * 16 + fr;
                const int pos = row & (SEQ - 1);
                f32x4 o1[2], o2[2];
#pragma unroll
                for (int n = 0; n < 2; ++n) { o1[n] = acc[ai][0][m][n] * descale + bv[0][n]; o2[n] = acc[ai][1][m][n] * descale + bv[1][n]; }
                if (do_rope) {
                    const float* rp = rope + pos * 64 + 8 * fq;
#pragma unroll
                    for (int n = 0; n < 2; ++n) { const f32x4 c = *(const f32x4*)(rp + 4 * n), s = *(const f32x4*)(rp + 32 + 4 * n);
                        const f32x4 a = o1[n], b = o2[n]; o1[n] = a * c - b * s; o2[n] = b * c + a * s; }
                }
                if (is_kb) {
#pragma unroll
                    for (int n = 0; n < 2; ++n) { ks[0][n] += o1[n]; ks[1][n] += o2[n]; }
                }
                bf16_t* rowp = qkv + (size_t)row * INW + colb;
                u32x4 w1, w2;
                w1.x = cvtpk(o1[0][0] * sc, o1[0][1] * sc); w1.y = cvtpk(o1[0][2] * sc, o1[0][3] * sc); w1.z = cvtpk(o1[1][0] * sc, o1[1][1] * sc); w1.w = cvtpk(o1[1][2] * sc, o1[1][3] * sc);
                w2.x = cvtpk(o2[0][0] * sc, o2[0][1] * sc); w2.y = cvtpk(o2[0][2] * sc, o2[0][3] * sc); w2.z = cvtpk(o2[1][0] * sc, o2[1][1] * sc); w2.w = cvtpk(o2[1][2] * sc, o2[1][3] * sc);
                *(u32x4*)(rowp) = w1; *(u32x4*)(rowp + 32) = w2;
            }
        if (is_kb) {
            float* kd = ksum + (size_t)u.pm * 512 + 256 * (pn - 5) + 64 * wc + 8 * fq;
#pragma unroll
            for (int bj = 0; bj < 2; ++bj)
#pragma unroll
                for (int n = 0; n < 2; ++n)
#pragma unroll
                    for (int j = 0; j < 4; ++j) {
                        float v = ks[bj][n][j];
                        v += swz_xor<1>(v); v += swz_xor<2>(v); v += swz_xor<4>(v); v += swz_xor<8>(v);
                        if (fr == 0) atomicAdd(kd + 32 * bj + 4 * n + j, v);
                    }
        }
    }
};
struct EpiOutProj {
    bf16_t* y; const float* b_out; const float* x;
    __device__ __forceinline__ void operator()(const f32x4 (&acc)[2][2][4][2], const Unit& u, int wr, int wc, int fr, int fq) const {
        const int col0 = u.pn * 256 + wc * 32 + 8 * fq;
        f32x4 bv[2][2];
#pragma unroll
        for (int bj = 0; bj < 2; ++bj)
#pragma unroll
            for (int n = 0; n < 2; ++n) bv[bj][n] = *(const f32x4*)(b_out + col0 + 128 * bj + 4 * n);
#pragma unroll
        for (int ai = 0; ai < 2; ++ai)
#pragma unroll
            for (int m = 0; m < 4; ++m) {
                const size_t off = (size_t)(u.pm * 256 + ai * 128 + wr * 64 + m * 16 + fr) * D + col0;
#pragma unroll
                for (int bj = 0; bj < 2; ++bj) {
                    const f32x4 x0 = *(const f32x4*)(x + off + 128 * bj), x1 = *(const f32x4*)(x + off + 128 * bj + 4);
                    const f32x4 v0 = acc[ai][bj][m][0] + bv[bj][0] + x0 * DN_ALPHA, v1 = acc[ai][bj][m][1] + bv[bj][1] + x1 * DN_ALPHA;
                    u32x4 w; w.x = cvtpk(v0[0], v0[1]); w.y = cvtpk(v0[2], v0[3]); w.z = cvtpk(v1[0], v1[1]); w.w = cvtpk(v1[2], v1[3]);
                    *(u32x4*)(y + off + 128 * bj) = w; }
                if (m & 1) asm volatile("" ::: "memory");
            }
    }
};
struct EpiSwiglu {
    unsigned char* act8; const float* b1;
    __device__ __forceinline__ const float* bias_src(const Unit& u) const { return b1 + (size_t)u.e * 2048 + 256 * u.pn; }
    __device__ __forceinline__ void operator()(const f32x4 (&acc)[2][2][4][2], const Unit& u, int wr, int wc, int fr, int fq, const LAS float* bias) const {
        const int a0 = 128 * u.pn + 32 * wc + 8 * fq;
        const LAS float* bp = bias + 2 * (32 * wc + 8 * fq);
        f32x4 bb[4];
#pragma unroll
        for (int q = 0; q < 4; ++q) bb[q] = *(const LAS f32x4*)(bp + 4 * q);
        f32x2 bg[2][2], bl[2][2];
#pragma unroll
        for (int n = 0; n < 2; ++n)
#pragma unroll
            for (int jp = 0; jp < 2; ++jp) { bg[n][jp] = (f32x2){bb[2 * n + jp][0], bb[2 * n + jp][2]}; bl[n][jp] = (f32x2){bb[2 * n + jp][1], bb[2 * n + jp][3]}; }
        unsigned char* tile = act8 + (size_t)u.pm * (256 * 1024);
#pragma unroll
        for (int ai = 0; ai < 2; ++ai)
#pragma unroll
            for (int m = 0; m < 4; ++m) {
                const int row = ai * 128 + wr * 64 + m * 16 + fr;
                f32x2 r[2][2];
#pragma unroll
                for (int n = 0; n < 2; ++n)
#pragma unroll
                    for (int jp = 0; jp < 2; ++jp) {
                        const f32x2 ag = {acc[ai][0][m][n][2 * jp], acc[ai][0][m][n][2 * jp + 1]}, al = {acc[ai][1][m][n][2 * jp], acc[ai][1][m][n][2 * jp + 1]};
                        f32x2 g = ag * (1.0f / W_SCALE) + bg[n][jp], l = al * (1.0f / W_SCALE) + bl[n][jp];
                        g.x = fminf(g.x, 7.0f); g.y = fminf(g.y, 7.0f);
                        l.x = __builtin_amdgcn_fmed3f(l.x, -7.0f, 7.0f); l.y = __builtin_amdgcn_fmed3f(l.y, -7.0f, 7.0f);
                        const f32x2 uarg = g * (-1.702f * LOG2E);
                        f32x2 t; t.x = __builtin_amdgcn_exp2f(uarg.x); t.y = __builtin_amdgcn_exp2f(uarg.y);
                        const f32x2 d = t + 1.0f;
                        f32x2 sg; sg.x = __builtin_amdgcn_rcpf(d.x); sg.y = __builtin_amdgcn_rcpf(d.y);
                        const f32x2 lf = l * ACT_SCALE + ACT_SCALE;
                        r[n][jp] = (g * sg) * lf;
                    }
                u32x2 w; w.x = pk4_fp8(r[0][0].x, r[0][0].y, r[0][1].x, r[0][1].y); w.y = pk4_fp8(r[1][0].x, r[1][0].y, r[1][1].x, r[1][1].y);
                *(u32x2*)(tile + (size_t)row * 1024 + (size_t)a0) = w;
            }
    }
};
struct EpiDown {
    unsigned char* yb; const float* b2;
    __device__ __forceinline__ const float* bias_src(const Unit& u) const { return b2 + (size_t)u.e * 1024 + 256 * u.pn; }
    __device__ __forceinline__ void operator()(const f32x4 (&acc)[2][2][4][2], const Unit& u, int wr, int wc, int fr, int fq, const LAS float* bias) const {
        const int col0 = u.pn * 256 + wc * 32 + 8 * fq;
        const LAS float* bp = bias + wc * 32 + 8 * fq;
#pragma unroll
        for (int bj = 0; bj < 2; ++bj) {
            const f32x4 bv0 = *(const LAS f32x4*)(bp + 128 * bj) * Y_SCALE, bv1 = *(const LAS f32x4*)(bp + 128 * bj + 4) * Y_SCALE;
#pragma unroll
            for (int ai = 0; ai < 2; ++ai)
#pragma unroll
                for (int m = 0; m < 4; ++m) {
                    unsigned char* rowp = yb + (size_t)(u.pm * 256 + ai * 128 + wr * 64 + m * 16 + fr) * 1024 + col0;
                    const f32x4 v0 = acc[ai][bj][m][0] * (Y_SCALE / (W_SCALE * ACT_SCALE)) + bv0, v1 = acc[ai][bj][m][1] * (Y_SCALE / (W_SCALE * ACT_SCALE)) + bv1;
                    u32x2 w; w.x = pk4_fp8(v0[0], v0[1], v0[2], v0[3]); w.y = pk4_fp8(v1[0], v1[1], v1[2], v1[3]);
                    *(u32x2*)(rowp + 128 * bj) = w;
                }
        }
    }
};
}

namespace att {
constexpr int PITCH = INW, SLOTB = 8192;
constexpr int NSLOT = 4;
constexpr int L_K = 0, L_V = NSLOT * SLOTB, L_WS = 2 * NSLOT * SLOTB, L_KS = L_WS + 2048, L_OST = L_KS + 2048, L_END = L_OST + 8 * 4096;
static_assert(NSLOT == 4 && L_END <= 131072, "attention LDS map");
constexpr float NEG = -1.0e30f, M0 = -1.0e20f, THR = 8.0f;
typedef LAS const char* lds_cptr;
__device__ __forceinline__ int crow(int r, int hi) { return (r & 3) + 8 * (r >> 2) + 4 * hi; }
__device__ __forceinline__ void glds16(const void* gsrc, unsigned lds_dst) { unsigned keep;
    asm volatile("s_mov_b32 %0, m0\n\ts_mov_b32 m0, %2\n\ts_nop 0\n\tglobal_load_lds_dwordx4 %1, off\n\ts_mov_b32 m0, %0" : "=&s"(keep) : "v"(gsrc), "s"(lds_dst) : "memory"); }
#define ATT_WAIT_BAR0() asm volatile("s_waitcnt vmcnt(0) lgkmcnt(0)\n\ts_barrier" ::: "memory")
#define ATT_WAIT_BARN(N) asm volatile("s_waitcnt vmcnt(" #N ") lgkmcnt(0)\n\ts_barrier" ::: "memory")
#define ATT_SBAR() __builtin_amdgcn_sched_barrier(0)

__device__ __forceinline__ void qkt(f32x16& p0, f32x16& p1, lds_cptr kb, const bf16x8* qr, const f32x16& negm) {
#pragma unroll
    for (int d0 = 0; d0 < 4; ++d0) {
        const bf16x8 b0 = *(const LAS bf16x8*)(kb + d0 * 2048);
        const bf16x8 b1 = *(const LAS bf16x8*)(kb + d0 * 2048 + 512);
        if (d0 == 0) { p0 = __builtin_amdgcn_mfma_f32_32x32x16_bf16(b0, qr[0], negm, 0, 0, 0); p1 = __builtin_amdgcn_mfma_f32_32x32x16_bf16(b1, qr[0], negm, 0, 0, 0); }
        else { p0 = __builtin_amdgcn_mfma_f32_32x32x16_bf16(b0, qr[d0], p0, 0, 0, 0); p1 = __builtin_amdgcn_mfma_f32_32x32x16_bf16(b1, qr[d0], p1, 0, 0, 0); }
    }
}
__device__ __forceinline__ float rowmax32(const f32x16& p0, const f32x16& p1) {
    float a = fmaxf(p0[0], p1[0]);
#pragma unroll
    for (int r = 1; r < 16; ++r) a = fmaxf(a, fmaxf(p0[r], p1[r]));
    auto rr = __builtin_amdgcn_permlane32_swap(__float_as_uint(a), __float_as_uint(a), false, false);
    return fmaxf(__uint_as_float(rr[0]), __uint_as_float(rr[1]));
}
__device__ __forceinline__ void pv(f32x16* o, int vb, bf16x8 pa0, bf16x8 pa1, bf16x8 pa2, bf16x8 pa3) {
#pragma unroll
    for (int d0 = 0; d0 < 2; ++d0) { s16x4 lo[4], hi[4];
#pragma unroll
        for (int ks = 0; ks < 4; ++ks) {
            asm volatile("ds_read_b64_tr_b16 %0,%1 offset:%c2" : "=&v"(lo[ks]) : "v"(vb), "i"(d0 * 4096 + ks * 1024) : "memory");
            asm volatile("ds_read_b64_tr_b16 %0,%1 offset:%c2" : "=&v"(hi[ks]) : "v"(vb), "i"(d0 * 4096 + ks * 1024 + 512) : "memory"); }
        asm volatile("s_waitcnt lgkmcnt(0)" ::: "memory"); ATT_SBAR();
#define ATT_PK(k) (bf16x8){lo[k][0], lo[k][1], lo[k][2], lo[k][3], hi[k][0], hi[k][1], hi[k][2], hi[k][3]}
        o[d0] = __builtin_amdgcn_mfma_f32_32x32x16_bf16(pa0, ATT_PK(0), o[d0], 0, 0, 0);
        o[d0] = __builtin_amdgcn_mfma_f32_32x32x16_bf16(pa1, ATT_PK(1), o[d0], 0, 0, 0);
        o[d0] = __builtin_amdgcn_mfma_f32_32x32x16_bf16(pa2, ATT_PK(2), o[d0], 0, 0, 0);
        o[d0] = __builtin_amdgcn_mfma_f32_32x32x16_bf16(pa3, ATT_PK(3), o[d0], 0, 0, 0);
#undef ATT_PK
    }
}

template <bool MOBA>
__device__ __forceinline__ void attn_item(char* shm, const bf16_t* __restrict__ qkv, bf16_t* __restrict__ aout, int b, int hh, int qb, const float* __restrict__ sinks, const float* __restrict__ ksum) {
    int tid = threadIdx.x; asm volatile("" : "+v"(tid));
    const int lane = tid & 63, r32 = lane & 31, hi = lane >> 5; const int wid = __builtin_amdgcn_readfirstlane(tid >> 6);
    const long rowbase = (long)b * SEQ;
    int qa, qcol, kcol, vcol, ocol, kt0, kt1;
    if (MOBA) { qa = 256 * qb + 32 * wid; qcol = 768 + 64 * hh; kcol = 1280 + 64 * hh; vcol = 1792 + 64 * hh; ocol = 512 + 64 * hh; kt0 = 0; kt1 = 4 * qb + 4; }
    else { const int g = wid >> 1; qa = 64 * qb + 32 * (wid & 1); qcol = (4 * hh + g) * 64; kcol = 512 + 64 * hh; vcol = 640 + 64 * hh; ocol = qcol; kt0 = qb - 2 < 0 ? 0 : qb - 2; kt1 = qb + 1; }
    const bf16_t* Qw = qkv + (rowbase + qa) * PITCH + qcol;
    const bf16_t* Kh = qkv + rowbase * PITCH + kcol; const bf16_t* Vh = qkv + rowbase * PITCH + vcol;
    const unsigned lds0 = (unsigned)(uintptr_t)shm;
    float* wsf = (float*)(shm + L_WS) + wid * 64;
    const bf16_t* ksrc = Kh + (long)lane * PITCH + wid * 8;
    const bf16_t* vsrc = Vh + (long)(16 * (wid & 3) + (lane >> 2)) * PITCH + (wid >> 2) * 32 + (lane & 3) * 8;
    const unsigned kdst = lds0 + L_K + wid * 1024, vdst = lds0 + L_V + wid * 1024;
#define ATT_DMA_K(t, slot) glds16(ksrc + (long)(t) * 64 * PITCH, (unsigned)__builtin_amdgcn_readfirstlane(kdst + (slot)))
#define ATT_DMA_V(t, slot) glds16(vsrc + (long)(t) * 64 * PITCH, (unsigned)__builtin_amdgcn_readfirstlane(vdst + (slot)))
    const int vb0 = (int)(lds0 + L_V) + ((lane >> 4) & 1) * 32 + (lane & 3) * 8 + (4 * hi + ((lane & 15) >> 2)) * 64;
    const lds_cptr shm3 = (lds_cptr)shm; const lds_cptr kp0 = shm3 + L_K + hi * 1024 + r32 * 16;
    const int NT = kt1 - kt0;
    ATT_DMA_K(kt0, 0); ATT_DMA_V(kt0, 0);
    if (NT > 1) { ATT_DMA_K(kt0 + 1, SLOTB); ATT_DMA_V(kt0 + 1, SLOTB); }
    if (NT > 2) { ATT_DMA_K(kt0 + 2, 2 * SLOTB); ATT_DMA_V(kt0 + 2, 2 * SLOTB); }
    if (MOBA) { float* ksl = (float*)(shm + L_KS); ksl[tid] = ksum[((size_t)b * 8 + (tid >> 6)) * 512 + 64 * hh + (tid & 63)]; }
    bf16x8 qr[4];
#pragma unroll
    for (int d0 = 0; d0 < 4; ++d0) qr[d0] = *reinterpret_cast<const bf16x8*>(&Qw[(long)r32 * PITCH + d0 * 16 + hi * 8]);
    float m_run, l_run;
    if (MOBA) { m_run = M0; l_run = 0.f; }
    else { m_run = sinks[4 * hh + (wid >> 1)] * LOG2E; l_run = (hi == 0) ? 1.0f : 0.0f; }
    f32x16 negm;
#pragma unroll
    for (int r = 0; r < 16; ++r) negm[r] = MOBA ? 0.f : -m_run;
    f32x16 o[2]; o[0] = f32x16{}; o[1] = f32x16{};
    ATT_WAIT_BAR0();
    unsigned sel = 0u;
    if (MOBA) {
        if (qb <= 3) sel = (1u << qb) - 1u;
        else {
            const float* ksl = (const float*)(shm + L_KS);
            float gv[7];
#pragma unroll
            for (int i = 0; i < 7; ++i) {
                float s = 0.f;
#pragma unroll
                for (int d0 = 0; d0 < 4; ++d0) {
                    const f32x4 k0 = *(const f32x4*)(ksl + i * 64 + 16 * d0 + 8 * hi), k1 = *(const f32x4*)(ksl + i * 64 + 16 * d0 + 8 * hi + 4);
#pragma unroll
                    for (int jj = 0; jj < 4; ++jj) { s += bf2f((unsigned short)qr[d0][jj]) * k0[jj]; s += bf2f((unsigned short)qr[d0][4 + jj]) * k1[jj]; }
                }
                auto rr = __builtin_amdgcn_permlane32_swap(__float_as_uint(s), __float_as_uint(s), false, false);
                s = __uint_as_float(rr[0]) + __uint_as_float(rr[1]);
                gv[i] = (i < qb) ? s : -INFINITY;
            }
#pragma unroll
            for (int rk = 0; rk < 3; ++rk) { float best = -INFINITY; int bi = 0;
#pragma unroll
                for (int i = 0; i < 7; ++i) { const bool c = (((sel >> i) & 1u) == 0u) && (gv[i] > best); best = c ? gv[i] : best; bi = c ? i : bi; }
                sel |= 1u << bi; }
        }
    }
    for (int it = 0; it < NT; ++it) {
        const int kt = kt0 + it; const int cur = (it & (NSLOT - 1)) * SLOTB;
        if (it + 3 < NT) { const int sl = ((it + 3) & (NSLOT - 1)) * SLOTB; ATT_DMA_K(kt + 3, sl); ATT_DMA_V(kt + 3, sl); }
        bool need; bool on = true;
        if (MOBA) { if (kt < 4 * qb) { on = ((sel >> (kt >> 2)) & 1u) != 0u; need = __any(on) != 0; } else need = (64 * kt <= qa + 31); }
        else need = (64 * kt + 63 >= qa - 127) && (64 * kt <= qa + 31);
        if (need) {
            f32x16 p0, p1; qkt(p0, p1, kp0 + cur, qr, negm);
            if (MOBA && kt < 4 * qb) {
                if (!__all(on)) {
#pragma unroll
                    for (int r = 0; r < 16; ++r) { p0[r] = on ? p0[r] : NEG; p1[r] = on ? p1[r] : NEG; }
                }
            } else {
                const bool edge = MOBA ? (64 * kt + 63 > qa) : !((64 * kt + 63 <= qa) && (qa + 31 - 64 * kt <= 127));
                if (edge) {
                    const int dq = qa + r32 - 64 * kt - 4 * hi;
#pragma unroll
                    for (int r = 0; r < 16; ++r) { const int d0_ = dq - ((r & 3) + 8 * (r >> 2)), d1_ = d0_ - 32;
                        const bool v0 = MOBA ? (d0_ >= 0) : ((unsigned)d0_ < 128u), v1 = MOBA ? (d1_ >= 0) : ((unsigned)d1_ < 128u);
                        p0[r] = v0 ? p0[r] : NEG; p1[r] = v1 ? p1[r] : NEG; }
                }
            }
            const float rm = rowmax32(p0, p1);
            const bool sent = (m_run <= M0), live = (rm > 0.5f * NEG);
            const bool upd = sent ? live : (rm > THR);
            if (__any(upd)) {
                const float dl = sent ? (live ? rm : 0.f) : fmaxf(rm, 0.f);
                const float f = sent ? 1.0f : __builtin_amdgcn_exp2f(-dl);
                m_run = sent ? (live ? rm : m_run) : (m_run + dl);
                const float nm = (m_run <= M0) ? 0.f : -m_run;
#pragma unroll
                for (int r = 0; r < 16; ++r) { p0[r] -= dl; p1[r] -= dl; negm[r] = nm; }
                l_run *= f;
                if (hi == 0) wsf[r32] = f;
                LDS_WAIT();
#pragma unroll
                for (int r = 0; r < 16; ++r) { const float fr_ = wsf[crow(r, hi)]; o[0][r] *= fr_; o[1][r] *= fr_; }
            }
            float sacc = 0.f;
#pragma unroll
            for (int r = 0; r < 16; ++r) { p0[r] = __builtin_amdgcn_exp2f(p0[r]); p1[r] = __builtin_amdgcn_exp2f(p1[r]); sacc += p0[r] + p1[r]; }
            l_run += sacc;
            u32x4 pw0, pw1, pw2, pw3;
            pw0 = (u32x4){cvtpk(p0[0], p0[1]), cvtpk(p0[2], p0[3]), cvtpk(p0[4], p0[5]), cvtpk(p0[6], p0[7])};
            pw1 = (u32x4){cvtpk(p0[8], p0[9]), cvtpk(p0[10], p0[11]), cvtpk(p0[12], p0[13]), cvtpk(p0[14], p0[15])};
            pw2 = (u32x4){cvtpk(p1[0], p1[1]), cvtpk(p1[2], p1[3]), cvtpk(p1[4], p1[5]), cvtpk(p1[6], p1[7])};
            pw3 = (u32x4){cvtpk(p1[8], p1[9]), cvtpk(p1[10], p1[11]), cvtpk(p1[12], p1[13]), cvtpk(p1[14], p1[15])};
            ATT_SBAR();
            pv(o, vb0 + cur, __builtin_bit_cast(bf16x8, pw0), __builtin_bit_cast(bf16x8, pw1), __builtin_bit_cast(bf16x8, pw2), __builtin_bit_cast(bf16x8, pw3));
        }
        if (it + 1 < NT) {
            if (it + 3 < NT) ATT_WAIT_BARN(4); else if (it + 2 < NT) ATT_WAIT_BARN(2); else ATT_WAIT_BAR0();
        }
    }
    { auto rr = __builtin_amdgcn_permlane32_swap(__float_as_uint(l_run), __float_as_uint(l_run), false, false); l_run = __uint_as_float(rr[0]) + __uint_as_float(rr[1]); }
    if (hi == 0) wsf[32 + r32] = l_run;
    LDS_WAIT();
    float rli[16];
#pragma unroll
    for (int r = 0; r < 16; ++r) rli[r] = __builtin_amdgcn_rcpf(wsf[32 + crow(r, hi)]);
    bf16_t* Ow = aout + (rowbase + qa) * D + ocol;
    { bf16_t* stg = (bf16_t*)(shm + L_OST) + wid * 2048;
#pragma unroll
        for (int r = 0; r < 16; ++r) { const int orow = crow(r, hi);
#pragma unroll
            for (int d0 = 0; d0 < 2; ++d0) stg[orow * 64 + d0 * 32 + r32] = (bf16_t)f2bf(o[d0][r] * rli[r]); }
        LDS_WAIT();
#pragma unroll
        for (int i = 0; i < 4; ++i) { const int row = i * 8 + (lane >> 3), ch = lane & 7; const u32x4 v = *(const u32x4*)(stg + row * 64 + ch * 8); *(u32x4*)(Ow + (long)row * D + ch * 8) = v; } }
    asm volatile("s_waitcnt lgkmcnt(0)\n\ts_barrier" ::: "memory");
#undef ATT_DMA_K
#undef ATT_DMA_V
}
}

__device__ __forceinline__ void sincos_d(double a, double& s, double& c) {
    const double q = __builtin_rint(a * 0.63661977236758134308);
    double r = __builtin_fma(-q, 1.57079632679489655800e+00, a);
    r = __builtin_fma(-q, 6.12323399573676603587e-17, r);
    const double r2 = r * r;
    double sp = -1.0 / 1307674368000.0;
    sp = sp * r2 + 1.0 / 6227020800.0; sp = sp * r2 - 1.0 / 39916800.0; sp = sp * r2 + 1.0 / 362880.0; sp = sp * r2 - 1.0 / 5040.0; sp = sp * r2 + 1.0 / 120.0; sp = sp * r2 - 1.0 / 6.0;
    const double sr = r + r * r2 * sp;
    double cp = 1.0 / 20922789888000.0;
    cp = cp * r2 - 1.0 / 87178291200.0; cp = cp * r2 + 1.0 / 479001600.0; cp = cp * r2 - 1.0 / 3628800.0; cp = cp * r2 + 1.0 / 40320.0; cp = cp * r2 - 1.0 / 720.0; cp = cp * r2 + 1.0 / 24.0; cp = cp * r2 - 0.5;
    const double cr = 1.0 + r2 * cp;
    const int n = ((int)q) & 3;
    s = (n == 0) ? sr : (n == 1) ? cr : (n == 2) ? -sr : -cr;
    c = (n == 0) ? cr : (n == 1) ? -sr : (n == 2) ? -cr : sr;
}
__device__ __forceinline__ int sigma_col(int p, int mode) {
    if (mode == 0) return (p & ~255) + 64 * ((p >> 5) & 3) + 32 * ((p >> 7) & 1) + pg8::perm32(p & 31);
    if (mode == 1) return (p & ~31) + pg8::perm32(p & 31);
    const int pn = p >> 8, q = p & 255; return 2 * (128 * pn + 32 * ((q >> 5) & 3) + pg8::perm32(q & 31)) + (q >> 7);
}
__device__ __forceinline__ void p0_transpose_item(const float* __restrict__ W, int N, bf16_t* __restrict__ WT, int mode, LAS float* scr, int item, int lane) {
    const int nblk = N / 32, kb = item / nblk, nb = item % nblk, k0 = 64 * kb, p0 = 32 * nb;
    const int sc = sigma_col(p0 + (lane & 31), mode);
#pragma unroll 8
    for (int i = 0; i < 32; ++i) { const int kk = 2 * i + (lane >> 5); scr[kk * 33 + (lane & 31)] = W[(size_t)(k0 + kk) * N + sc]; }
    LDS_WAIT(); asm volatile("" ::: "memory");
    const int c = lane & 7;
#pragma unroll
    for (int j = 0; j < 4; ++j) { const int n = (lane >> 3) + 8 * j; const LAS float* s = scr + (8 * c) * 33 + n;
        u32x4 o; o.x = cvtpk(s[0 * 33], s[1 * 33]); o.y = cvtpk(s[2 * 33], s[3 * 33]); o.z = cvtpk(s[4 * 33], s[5 * 33]); o.w = cvtpk(s[6 * 33], s[7 * 33]);
        *(u32x4*)(WT + (size_t)(p0 + n) * 1024 + k0 + 8 * c) = o; }
    LDS_WAIT(); asm volatile("" ::: "memory");
}

__device__ __forceinline__ void p0_transpose_item_fp8(const float* __restrict__ W, int N, unsigned char* __restrict__ WT, int mode, float scale, LAS float* scr, int item, int lane) {
    const int nblk = N / 32, kb = item / nblk, nb = item % nblk, k0 = 64 * kb, p0 = 32 * nb;
    const int sc = sigma_col(p0 + (lane & 31), mode);
#pragma unroll 8
    for (int i = 0; i < 32; ++i) { const int kk = 2 * i + (lane >> 5); scr[kk * 33 + (lane & 31)] = W[(size_t)(k0 + kk) * N + sc] * scale; }
    LDS_WAIT(); asm volatile("" ::: "memory");
    const int c = lane & 7;
#pragma unroll
    for (int j = 0; j < 4; ++j) { const int n = (lane >> 3) + 8 * j; const LAS float* s = scr + (8 * c) * 33 + n;
        u32x2 o; o.x = pk4_fp8(s[0 * 33], s[1 * 33], s[2 * 33], s[3 * 33]); o.y = pk4_fp8(s[4 * 33], s[5 * 33], s[6 * 33], s[7 * 33]);
        *(u32x2*)(WT + (size_t)(p0 + n) * 1024 + k0 + 8 * c) = o; }
    LDS_WAIT(); asm volatile("" ::: "memory");
}


#define XB_TMO      128
#define XB_XCNT(j)  (256  + 64 * (j))
#define XB_XSUB(j)  (1280 + 64 * (j))
#define XB_XGEN(j)  (2304 + 64 * (j))
#define XB_TOP      3328
#define XB_TOPGEN   3392
#define XCD_BAR_WORDS 3456
#define XB_SPIN_CAP (1u << 18)
__device__ __forceinline__ unsigned xb_ld(unsigned* p)              { return __hip_atomic_load(p, __ATOMIC_RELAXED, __HIP_MEMORY_SCOPE_AGENT); }
__device__ __forceinline__ unsigned xb_add(unsigned* p, unsigned v) { return __hip_atomic_fetch_add(p, v, __ATOMIC_RELAXED, __HIP_MEMORY_SCOPE_AGENT); }
__device__ __forceinline__ unsigned xb_xcc_id() { return (unsigned)__builtin_amdgcn_s_getreg((3 << 11) | 20) & 0xFu; }
#define XB_SPIN(cond, bar) do { unsigned _sp = 0; while (cond) { __builtin_amdgcn_s_sleep(1); \
    if ((++_sp & 255u) == 0u) { if (xb_ld(&(bar)[XB_TMO])) break; if (_sp > XB_SPIN_CAP) { atomicAdd(&(bar)[XB_TMO], 1u); break; } } } } while (0)
struct XcdBarrier { unsigned* bar; unsigned x; volatile LAS unsigned* st; };
__device__ __forceinline__ XcdBarrier xcd_barrier_post(unsigned* bar, volatile LAS unsigned* st) {
    XcdBarrier b; b.bar = bar; b.x = xb_xcc_id(); b.st = st;
    if (threadIdx.x == 0) (void)xb_add(&bar[XB_XCNT(b.x)], 1u);
    return b;
}
__device__ __forceinline__ void xcd_barrier_complete(unsigned* bar, unsigned x, unsigned& nloc, unsigned& nx) {
    const unsigned G = gridDim.x * gridDim.y * gridDim.z;
    unsigned sum, cnt, mine, sp = 0u;
    for (;;) {
        sum = 0u; cnt = 0u; mine = 0u;
#pragma unroll
        for (unsigned j = 0; j < 16; ++j) { const unsigned c = xb_ld(&bar[XB_XCNT(j)]); sum += c; cnt += (c > 0u) ? 1u : 0u; mine = (j == x) ? c : mine; }
        if (sum == G) break;
        __builtin_amdgcn_s_sleep(1);
        if ((++sp & 255u) == 0u) { if (xb_ld(&bar[XB_TMO])) break; if (sp > XB_SPIN_CAP) { atomicAdd(&bar[XB_TMO], 1u); break; } }
    }
    nloc = mine > 0u ? mine : 1u; nx = cnt > 0u ? cnt : 1u;
}
__device__ __forceinline__ void xcd_barrier(const XcdBarrier& b) {
    asm volatile("s_waitcnt vmcnt(0)" ::: "memory");
    __syncthreads();
    if (threadIdx.x == 0) {
        unsigned* bar = b.bar;
        __builtin_amdgcn_s_waitcnt(0);
        unsigned nloc = b.st[0], nx = b.st[1];
        if (nloc == 0u) { xcd_barrier_complete(bar, b.x, nloc, nx); b.st[0] = nloc; b.st[1] = nx; }
        const unsigned old = xb_add(&bar[XB_XSUB(b.x)], 1u);
        const unsigned gen = old / nloc;
        if (old + 1u == (gen + 1u) * nloc) {
            __builtin_amdgcn_fence(__ATOMIC_RELEASE, "agent");
            asm volatile("s_waitcnt vmcnt(0)" ::: "memory");
            const unsigned og = xb_add(&bar[XB_TOP], 1u);
            const unsigned tg = og / nx;
            if (og + 1u == (tg + 1u) * nx) xb_add(&bar[XB_TOPGEN], 1u);
            else XB_SPIN(xb_ld(&bar[XB_TOPGEN]) == tg, bar);
            __builtin_amdgcn_fence(__ATOMIC_ACQUIRE, "agent");
            xb_add(&bar[XB_XGEN(b.x)], 1u);
            asm volatile("s_waitcnt vmcnt(0)" ::: "memory");
        } else {
            XB_SPIN(xb_ld(&bar[XB_XGEN(b.x)]) == gen, bar);
            __builtin_amdgcn_fence(__ATOMIC_ACQUIRE, "agent");
            asm volatile("s_waitcnt vmcnt(0)" ::: "memory");
        }
    }
    __syncthreads();
}

__global__ void __launch_bounds__(NTHREADS, 2) fwd_megakernel(Params p_arg) {
    extern __shared__ __attribute__((aligned(16))) unsigned char lds_raw[];
    LAS unsigned char* lds = (LAS unsigned char*)lds_raw;
    cg::grid_group grid = cg::this_grid();
#define PHASE_IDS() int tid = threadIdx.x; asm volatile("" : "+v"(tid)); const int lane = tid & 63, wave = __builtin_amdgcn_readfirstlane(tid >> 6); (void)lane; (void)wave
    const int G = gridDim.x, bx = blockIdx.x;
    typedef const __attribute__((address_space(4))) Params* KParams;
    const KParams kp0 = (KParams)__builtin_amdgcn_kernarg_segment_ptr();
#define PHASE_PTRS() KParams _kp = kp0; asm volatile("" : "+s"(_kp)); Params p; p.x = _kp->x; p.w_in = _kp->w_in; p.b_in = _kp->b_in; p.sinks = _kp->sinks; p.w_out = _kp->w_out; p.b_out = _kp->b_out; p.ln1_g = _kp->ln1_g; p.ln1_b = _kp->ln1_b; \
    p.w_router = _kp->w_router; p.b_router = _kp->b_router; p.w1 = _kp->w1; p.b1 = _kp->b1; p.w2 = _kp->w2; p.b2 = _kp->b2; p.ln2_g = _kp->ln2_g; p.ln2_b = _kp->ln2_b; p.out = _kp->out; p.ws = _kp->ws; unsigned char* const ws = p.ws; \
    unsigned* const ctl = (unsigned*)(ws + WS_CTL); float* const ksum = (float*)(ws + WS_KSUM); float* const rope = (float*)(ws + WS_ROPE); \
    bf16_t* const w_in_t = (bf16_t*)(ws + WS_WIN_T); bf16_t* const w_out_t = (bf16_t*)(ws + WS_WOUT_T); \
    unsigned char* const w1_8 = ws + WS_W1_8; unsigned char* const w2_8 = ws + WS_W2_8; unsigned char* const x1_8 = ws + WS_X1_8; unsigned char* const act8 = ws + WS_ACT8; \
    int* const cnt_blk = (int*)(ws + WS_CNT); int* const tile_e = (int*)(ws + WS_TILE_E); bf16_t* const wr_hi = (bf16_t*)(ws + WS_WR_HI); bf16_t* const wr_lo = (bf16_t*)(ws + WS_WR_LO); \
    int* const tok = (int*)(ws + WS_TOK); int* const asg_e = (int*)(ws + WS_ASG_E); float* const asg_g = (float*)(ws + WS_ASG_G); int* const asg_d = (int*)(ws + WS_ASG_D); \
    bf16_t* const x1b = (bf16_t*)(ws + WS_X1B); bf16_t* const xb = (bf16_t*)(ws + WS_XB); bf16_t* const attn_o = xb; bf16_t* const qkv = (bf16_t*)(ws + WS_QKV); unsigned char* const yb = ws + WS_YB; \
    (void)ctl; (void)ksum; (void)rope; (void)w_in_t; (void)w_out_t; (void)w1_8; (void)w2_8; (void)x1_8; (void)act8; (void)cnt_blk; (void)tile_e; (void)wr_hi; (void)wr_lo; (void)tok; (void)asg_e; (void)asg_g; (void)asg_d; \
    (void)x1b; (void)xb; (void)attn_o; (void)qkv; (void)yb
    if (threadIdx.x < 2) ((LAS unsigned*)(lds + LDS_BARST))[threadIdx.x] = 0u;
    __syncthreads();
    XcdBarrier xbar;
    { PHASE_PTRS(); xbar = xcd_barrier_post(ctl + CW_BAR, (volatile LAS unsigned*)(lds + LDS_BARST)); }

    REP(0) {
        PHASE_IDS(); PHASE_PTRS();
        const long gt = (long)bx * NTHREADS + tid, gsz = (long)G * NTHREADS;
        for (long i = gt; i < 2048 * 32; i += gsz) {
            const int pos = (int)(i >> 5), k = (int)(i & 31);
            double inv = 1.0; for (int q = 0; q < k; ++q) inv *= 0.7498942093324559;
            double s, c; sincos_d((double)pos * inv, s, c);
            rope[pos * 64 + k] = (float)c; rope[pos * 64 + 32 + k] = (float)s;
        }
        for (long i = gt; i < 32 * 1024; i += gsz) {
            const int e = (int)(i >> 10), k = (int)(i & 1023); const float w = p.w_router[k * 32 + e];
            const unsigned h = f2bf(w); wr_hi[i] = (bf16_t)h; wr_lo[i] = (bf16_t)f2bf(w - bf2f(h));
        }
        LAS float* scr = (LAS float*)(lds + wave * 16384);
        const int gw = bx * 8 + wave, NGW = G * 8;
        constexpr int I_IN = 16 * (INW / 32), I_OUT = 16 * 32, I_W1 = 16 * 64, I_W2 = 16 * 32;
        constexpr int NITEMS = I_IN + I_OUT + NE * I_W1 + NE * I_W2;
        for (int it = gw; it < NITEMS; it += NGW) {
            int r = it;
#if INPROJ_FP8
            if (r < I_IN) { p0_transpose_item_fp8(p.w_in, INW, (unsigned char*)w_in_t, 0, WIN_SCALE, scr, r, lane); continue; } r -= I_IN;
#else
            if (r < I_IN) { p0_transpose_item(p.w_in, INW, w_in_t, 0, scr, r, lane); continue; } r -= I_IN;
#endif
            if (r < I_OUT) { p0_transpose_item(p.w_out, 1024, w_out_t, 1, scr, r, lane); continue; } r -= I_OUT;
            if (r < NE * I_W1) { const int e = r / I_W1; p0_transpose_item_fp8(p.w1 + (size_t)e * 1024 * 2048, 2048, w1_8 + (size_t)e * 2048 * 1024, 2, W_SCALE, scr, r % I_W1, lane); continue; } r -= NE * I_W1;
            { const int e = r / I_W2; p0_transpose_item_fp8(p.w2 + (size_t)e * 1024 * 1024, 1024, w2_8 + (size_t)e * 1024 * 1024, 1, W_SCALE, scr, r % I_W2, lane); }
        }
        const f32x4* x4 = (const f32x4*)p.x;
#if INPROJ_FP8
        u32x2* x8 = (u32x2*)xb;
        for (long i = gt; i < (long)T * D / 8; i += gsz) { const f32x4 a = x4[2 * i], b = x4[2 * i + 1];
            u32x2 o; o.x = pk4_fp8(a[0], a[1], a[2], a[3]); o.y = pk4_fp8(b[0], b[1], b[2], b[3]); x8[i] = o; }
#else
        u32x4* xb4 = (u32x4*)xb;
        for (long i = gt; i < (long)T * D / 8; i += gsz) { const f32x4 a = x4[2 * i], b = x4[2 * i + 1];
            u32x4 o; o.x = cvtpk(a[0], a[1]); o.y = cvtpk(a[2], a[3]); o.z = cvtpk(b[0], b[1]); o.w = cvtpk(b[2], b[3]); xb4[i] = o; }
#endif
    }
    grid.sync();

    REP(1) {
        PHASE_PTRS();
#if INPROJ_FP8
        pg8::SchedInProj<1024> S{(const char*)xb, (const char*)w_in_t, G, bx};
        pg8::EpiInProj E{qkv, p.b_in, rope, ksum, 1.0f / WIN_SCALE};
        pg8::gemm_phase<pg8::EpiInProj, pg8::SchedInProj<1024>, false, true, 512, true>(lds, S, E);
#else
        pg8::SchedInProj<2048> S{(const char*)xb, (const char*)w_in_t, G, bx};
        pg8::EpiInProj E{qkv, p.b_in, rope, ksum, 1.0f};
        pg8::gemm_phase<pg8::EpiInProj, pg8::SchedInProj<2048>, false, true>(lds, S, E);
#endif
    }
    xcd_barrier(xbar);

    REP(2) for (int u = bx; u < 256; u += G) {
        PHASE_PTRS();
        { const int b = u >> 3, h = u & 7;
            for (int j = 0; j < 8; ++j) att::attn_item<true>((char*)lds_raw, qkv, attn_o, b, h, j, p.sinks, ksum); }
        { const int b = u >> 3, kvh = (u >> 2) & 1, oct = u & 3;
            for (int i = 0; i < 8; ++i) att::attn_item<false>((char*)lds_raw, qkv, attn_o, b, kvh, oct * 8 + i, p.sinks, ksum); }
    }
    xcd_barrier(xbar);

    REP(3) for (int pm = bx; pm < T / 256; pm += G) {
        PHASE_IDS(); PHASE_PTRS();
        {
            pg8::SchedPanel S{(const char*)attn_o, (const char*)w_out_t, pm};
            pg8::EpiOutProj E{(bf16_t*)p.out, p.b_out, p.x};
            pg8::gemm_phase<pg8::EpiOutProj, pg8::SchedPanel, false, true>(lds, S, E);
        }
        __syncthreads();
        {
#pragma unroll
            for (int i = 0; i < 16; ++i) { const int idx = tid + 512 * i, mat = idx >> 12, rw = (idx >> 7) & 31, ch = idx & 127;
                const u32x4 v = *(const u32x4*)((mat ? wr_lo : wr_hi) + rw * 1024 + ch * 8);
                *(LAS u32x4*)(lds + mat * 66048 + rw * 2064 + ch * 16) = v; }
        }
        {
            const bf16_t* ytmp = (const bf16_t*)p.out;
            f32x4 gg[2][2], bb[2][2];
#pragma unroll
            for (int j = 0; j < 2; ++j)
#pragma unroll
                for (int h = 0; h < 2; ++h) { gg[j][h] = *(const f32x4*)(p.ln1_g + 512 * j + 8 * lane + 4 * h); bb[j][h] = *(const f32x4*)(p.ln1_b + 512 * j + 8 * lane + 4 * h); }
            for (int rr = 0; rr < 32; rr += 4) {
                const size_t row0 = (size_t)pm * 256 + wave * 32 + rr;
                u32x4 raw[4][2]; float v[4][2][8]; float sm[4], sq[4];
#pragma unroll
                for (int q = 0; q < 4; ++q)
#pragma unroll
                    for (int j = 0; j < 2; ++j) raw[q][j] = *(const u32x4*)(ytmp + (row0 + q) * D + 512 * j + 8 * lane);
#pragma unroll
                for (int q = 0; q < 4; ++q) { float s_ = 0.f;
#pragma unroll
                    for (int j = 0; j < 2; ++j)
#pragma unroll
                        for (int c = 0; c < 4; ++c) { const unsigned w = raw[q][j][c]; v[q][j][2 * c] = bf2f(w & 0xffffu); v[q][j][2 * c + 1] = bf2f(w >> 16); s_ += v[q][j][2 * c] + v[q][j][2 * c + 1]; }
                    sm[q] = s_; }
#pragma unroll
                for (int o = 1; o < 64; o <<= 1) {
#pragma unroll
                    for (int q = 0; q < 4; ++q) sm[q] += __shfl_xor(sm[q], o); }
#pragma unroll
                for (int q = 0; q < 4; ++q) { const float mean = sm[q] * (1.0f / D); float s2 = 0.f;
#pragma unroll
                    for (int j = 0; j < 2; ++j)
#pragma unroll
                        for (int c = 0; c < 8; ++c) { v[q][j][c] -= mean; s2 += v[q][j][c] * v[q][j][c]; }
                    sq[q] = s2; }
#pragma unroll
                for (int o = 1; o < 64; o <<= 1) {
#pragma unroll
                    for (int q = 0; q < 4; ++q) sq[q] += __shfl_xor(sq[q], o); }
#pragma unroll
                for (int q = 0; q < 4; ++q) {
                    const float rstd = 1.0f / sqrtf(sq[q] * (1.0f / D) + LN_EPS);
#pragma unroll
                    for (int j = 0; j < 2; ++j) {
                        float xv[8];
#pragma unroll
                        for (int c = 0; c < 8; ++c) xv[c] = v[q][j][c] * rstd * gg[j][c >> 2][c & 3] + bb[j][c >> 2][c & 3];
                        u32x4 hv; hv.x = cvtpk(xv[0], xv[1]); hv.y = cvtpk(xv[2], xv[3]); hv.z = cvtpk(xv[4], xv[5]); hv.w = cvtpk(xv[6], xv[7]);
                        u32x2 fv; fv.x = pk4_fp8(xv[0], xv[1], xv[2], xv[3]); fv.y = pk4_fp8(xv[4], xv[5], xv[6], xv[7]);
                        *(u32x4*)(x1b + (row0 + q) * D + 512 * j + 8 * lane) = hv;
                        *(u32x2*)(x1_8 + (row0 + q) * D + 512 * j + 8 * lane) = fv;
                    }
                }
            }
        }
        __syncthreads();
        {
            const int fr = lane & 15, fq = lane >> 4;
            f32x4 lacc[2][2];
#pragma unroll
            for (int m = 0; m < 2; ++m)
#pragma unroll
                for (int n = 0; n < 2; ++n) lacc[m][n] = (f32x4){0.f, 0.f, 0.f, 0.f};
            const size_t r0 = (size_t)pm * 256 + wave * 32;
            const bf16_t* ah = x1b + (r0 + fr) * D + 8 * fq;
            const LAS unsigned char* bh = lds + fr * 2064 + 16 * fq; const LAS unsigned char* bl = bh + 66048;
#pragma unroll 4
            for (int k0 = 0; k0 < 1024; k0 += 32) {
                bf16x8 a_hi[2], b_hi[2], b_lo[2];
#pragma unroll
                for (int m = 0; m < 2; ++m) a_hi[m] = *(const bf16x8*)(ah + (size_t)m * 16 * D + k0);
#pragma unroll
                for (int n = 0; n < 2; ++n) { b_hi[n] = *(const LAS bf16x8*)(bh + n * 16 * 2064 + k0 * 2); b_lo[n] = *(const LAS bf16x8*)(bl + n * 16 * 2064 + k0 * 2); }
#pragma unroll
                for (int m = 0; m < 2; ++m)
#pragma unroll
                    for (int n = 0; n < 2; ++n) {
                        lacc[m][n] = __builtin_amdgcn_mfma_f32_16x16x32_bf16(a_hi[m], b_hi[n], lacc[m][n], 0, 0, 0);
                        lacc[m][n] = __builtin_amdgcn_mfma_f32_16x16x32_bf16(a_hi[m], b_lo[n], lacc[m][n], 0, 0, 0);
                    }
            }
            __syncthreads();
            LAS float* lg = (LAS float*)lds;
#pragma unroll
            for (int m = 0; m < 2; ++m)
#pragma unroll
                for (int n = 0; n < 2; ++n)
#pragma unroll
                    for (int rg = 0; rg < 4; ++rg) lg[(wave * 32 + 16 * m + 4 * fq + rg) * 33 + 16 * n + fr] = lacc[m][n][rg];
        }
        __syncthreads();
        {
            LAS float* lg = (LAS float*)lds;
            LAS int* wcnt = (LAS int*)(lds + 36864);
            float t0 = -INFINITY, t1 = -INFINITY, t2 = -INFINITY, t3 = -INFINITY; int i0 = 0, i1 = 0, i2 = 0, i3 = 0;
            int rk0 = 0, rk1 = 0, rk2 = 0, rk3 = 0;
            if (tid < 256) {
                for (int e = 0; e < NE; ++e) {
                    const float xv = lg[tid * 33 + e] + p.b_router[e];
                    if (xv > t3) {
                        if (xv > t2) { t3 = t2; i3 = i2;
                            if (xv > t1) { t2 = t1; i2 = i1;
                                if (xv > t0) { t1 = t0; i1 = i0; t0 = xv; i0 = e; } else { t1 = xv; i1 = e; }
                            } else { t2 = xv; i2 = e; }
                        } else { t3 = xv; i3 = e; }
                    }
                }
                const unsigned selm = (1u << i0) | (1u << i1) | (1u << i2) | (1u << i3);
                for (int e = 0; e < NE; ++e) {
                    const bool has = ((selm >> e) & 1u) != 0u;
                    const unsigned long long bal = __ballot(has);
                    const int pre = __popcll(bal & ((1ull << lane) - 1ull));
                    if (e == i0) rk0 = pre; if (e == i1) rk1 = pre; if (e == i2) rk2 = pre; if (e == i3) rk3 = pre;
                    if (lane == 0) wcnt[wave * 32 + e] = __popcll(bal);
                }
            }
            __syncthreads();
            if (tid < 256) {
                const float e1 = __expf(t1 - t0), e2 = __expf(t2 - t0), e3 = __expf(t3 - t0);
                const float inv = 1.0f / (1.0f + e1 + e2 + e3);
                int b0 = 0, b1 = 0, b2 = 0, b3 = 0;
                for (int w = 0; w < wave; ++w) { b0 += wcnt[w * 32 + i0]; b1 += wcnt[w * 32 + i1]; b2 += wcnt[w * 32 + i2]; b3 += wcnt[w * 32 + i3]; }
                const size_t a = ((size_t)pm * 256 + tid) * 4;
                *(int4*)(asg_e + a) = make_int4(i0, i1, i2, i3);
                *(float4*)(asg_g + a) = make_float4(inv, e1 * inv, e2 * inv, e3 * inv);
                *(int4*)(asg_d + a) = make_int4(b0 + rk0, b1 + rk1, b2 + rk2, b3 + rk3);
            }
            if (tid < 32) cnt_blk[pm * 32 + tid] = wcnt[tid] + wcnt[32 + tid] + wcnt[64 + tid] + wcnt[96 + tid];
            __syncthreads();
        }
    }
    xcd_barrier(xbar);

    for (int pm = bx; pm < T / 256; pm += G) {
        PHASE_IDS(); PHASE_PTRS();
        LAS int* part_all = (LAS int*)lds; LAS int* part_pre = part_all + 512; LAS int* tot = part_pre + 512; LAS int* pre = tot + 32; LAS int* poff = pre + 32;
        { const int e = tid & 31, seg = tid >> 5; int sa = 0, sp = 0;
            for (int bb = seg * 16; bb < seg * 16 + 16; ++bb) { const int c = cnt_blk[bb * 32 + e]; sa += c; sp += (bb < pm) ? c : 0; }
            part_all[tid] = sa; part_pre[tid] = sp; }
        __syncthreads();
        if (tid < 32) { int sa = 0, sp = 0; for (int s = 0; s < 16; ++s) { sa += part_all[s * 32 + tid]; sp += part_pre[s * 32 + tid]; } tot[tid] = sa; pre[tid] = sp; }
        __syncthreads();
        if (tid == 0) { int off = 0; for (int e = 0; e < NE; ++e) { poff[e] = off; off += ((tot[e] + 255) >> 8) << 8; } poff[32] = off; }
        __syncthreads();
        if (tid < 256) {
            const int token = pm * 256 + tid; const size_t a = (size_t)token * 4;
            const int4 ee = *(const int4*)(asg_e + a); const int4 rk = *(const int4*)(asg_d + a);
            const int d0 = poff[ee.x] + pre[ee.x] + rk.x, d1 = poff[ee.y] + pre[ee.y] + rk.y, d2 = poff[ee.z] + pre[ee.z] + rk.z, d3 = poff[ee.w] + pre[ee.w] + rk.w;
            *(int4*)(asg_d + a) = make_int4(d0, d1, d2, d3);
            tok[d0] = token; tok[d1] = token; tok[d2] = token; tok[d3] = token;
        }
        if (pm < NE) {
            const int e = pm, n = tot[e], np = ((n + 255) >> 8) << 8, o = poff[e];
            for (int i = n + tid; i < np; i += NTHREADS) tok[o + i] = 0;
            for (int i = tid; i < (np >> 8); i += NTHREADS) tile_e[(o >> 8) + i] = e;
        }
        if (pm == 0 && tid == 0) ctl[CW_NTILES] = (unsigned)(poff[32] >> 8);
        __syncthreads();
    }
    xcd_barrier(xbar);

    REP(5) {
        PHASE_PTRS(); const int ntiles = (int)ctl[CW_NTILES];
        { LAS int* tl = (LAS int*)(lds + LDSX_TILE); for (int i = threadIdx.x; i < ntiles; i += NTHREADS) tl[i] = tile_e[i]; __syncthreads(); }
        pg8::SchedMoe<8, true> S{(const char*)x1_8, (const char*)w1_8, (const LAS int*)(lds + LDSX_TILE), tok, ntiles, G, bx};
        pg8::EpiSwiglu E{act8, p.b1};
        pg8::gemm_phase<pg8::EpiSwiglu, pg8::SchedMoe<8, true>, true, true, 512, true, true>(lds, S, E);
    }
    xcd_barrier(xbar);

    REP(6) {
        PHASE_PTRS(); const int ntiles = (int)ctl[CW_NTILES];
        { LAS int* tl = (LAS int*)(lds + LDSX_TILE); for (int i = threadIdx.x; i < ntiles; i += NTHREADS) tl[i] = tile_e[i]; __syncthreads(); }
        pg8::SchedMoe<4, false> S{(const char*)act8, (const char*)w2_8, (const LAS int*)(lds + LDSX_TILE), tok, ntiles, G, bx};
        pg8::EpiDown E{yb, p.b2};
        pg8::gemm_phase<pg8::EpiDown, pg8::SchedMoe<4, false>, false, true, 512, true, true>(lds, S, E);
    }
    xcd_barrier(xbar);

    REP(7) {
        PHASE_IDS(); PHASE_PTRS();
        const int gw = bx * 8 + wave, NGW = G * 8;
        f32x4 gg[2][2], bb[2][2];
#pragma unroll
        for (int j = 0; j < 2; ++j)
#pragma unroll
            for (int h = 0; h < 2; ++h) { gg[j][h] = *(const f32x4*)(p.ln2_g + 512 * j + 8 * lane + 4 * h); bb[j][h] = *(const f32x4*)(p.ln2_b + 512 * j + 8 * lane + 4 * h); }
        constexpr int R = 2;
        for (int row0 = gw; row0 < T; row0 += R * NGW) {
            int4 dd[R]; float4 gt[R];
#pragma unroll
            for (int q = 0; q < R; ++q) { const int row = row0 + q * NGW < T ? row0 + q * NGW : row0; dd[q] = *(const int4*)(asg_d + (size_t)row * 4); gt[q] = *(const float4*)(asg_g + (size_t)row * 4); }
            u32x4 xr[R][2]; u32x2 yk[R][4][2];
#pragma unroll
            for (int q = 0; q < R; ++q) { const int row = row0 + q * NGW < T ? row0 + q * NGW : row0;
#pragma unroll
                for (int j = 0; j < 2; ++j) {
                    xr[q][j] = *(const u32x4*)(x1b + (size_t)row * D + 512 * j + 8 * lane);
                    yk[q][0][j] = *(const u32x2*)(yb + (size_t)dd[q].x * D + 512 * j + 8 * lane);
                    yk[q][1][j] = *(const u32x2*)(yb + (size_t)dd[q].y * D + 512 * j + 8 * lane);
                    yk[q][2][j] = *(const u32x2*)(yb + (size_t)dd[q].z * D + 512 * j + 8 * lane);
                    yk[q][3][j] = *(const u32x2*)(yb + (size_t)dd[q].w * D + 512 * j + 8 * lane);
                } }
            float z[R][2][8]; float sm[R], sq[R];
#pragma unroll
            for (int q = 0; q < R; ++q) {
                const float g0 = gt[q].x * (1.0f / Y_SCALE), g1 = gt[q].y * (1.0f / Y_SCALE), g2 = gt[q].z * (1.0f / Y_SCALE), g3 = gt[q].w * (1.0f / Y_SCALE);
                float s_ = 0.f;
#pragma unroll
                for (int j = 0; j < 2; ++j)
#pragma unroll
                    for (int d = 0; d < 2; ++d) {
#define P7_PAIR(HH, SEL) do { \
                            const f32x2 a0 = __builtin_amdgcn_cvt_pk_f32_fp8((int)yk[q][0][j][d], SEL), a1 = __builtin_amdgcn_cvt_pk_f32_fp8((int)yk[q][1][j][d], SEL); \
                            const f32x2 a2 = __builtin_amdgcn_cvt_pk_f32_fp8((int)yk[q][2][j][d], SEL), a3 = __builtin_amdgcn_cvt_pk_f32_fp8((int)yk[q][3][j][d], SEL); \
                            const unsigned xw = xr[q][j][2 * d + HH]; \
                            const float lo = DN_ALPHA * bf2f(xw & 0xffffu) + g0 * a0.x + g1 * a1.x + g2 * a2.x + g3 * a3.x; \
                            const float hi = DN_ALPHA * bf2f(xw >> 16) + g0 * a0.y + g1 * a1.y + g2 * a2.y + g3 * a3.y; \
                            z[q][j][4 * d + 2 * HH] = lo; z[q][j][4 * d + 2 * HH + 1] = hi; s_ += lo + hi; } while (0)
                        P7_PAIR(0, false); P7_PAIR(1, true);
#undef P7_PAIR
                    }
                sm[q] = s_;
            }
#pragma unroll
            for (int o = 1; o < 64; o <<= 1) {
#pragma unroll
                for (int q = 0; q < R; ++q) sm[q] += __shfl_xor(sm[q], o); }
#pragma unroll
            for (int q = 0; q < R; ++q) { const float mean = sm[q] * (1.0f / D); float s2 = 0.f;
#pragma unroll
                for (int j = 0; j < 2; ++j)
#pragma unroll
                    for (int c = 0; c < 8; ++c) { z[q][j][c] -= mean; s2 += z[q][j][c] * z[q][j][c]; }
                sq[q] = s2; }
#pragma unroll
            for (int o = 1; o < 64; o <<= 1) {
#pragma unroll
                for (int q = 0; q < R; ++q) sq[q] += __shfl_xor(sq[q], o); }
#pragma unroll
            for (int q = 0; q < R; ++q) {
                const int row = row0 + q * NGW;
                if (row < T) {
                    const float rstd = 1.0f / sqrtf(sq[q] * (1.0f / D) + LN_EPS);
#pragma unroll
                    for (int j = 0; j < 2; ++j)
#pragma unroll
                        for (int h = 0; h < 2; ++h) {
                            f32x4 o;
#pragma unroll
                            for (int c = 0; c < 4; ++c) o[c] = z[q][j][4 * h + c] * rstd * gg[j][h][c] + bb[j][h][c];
                            *(f32x4*)(p.out + (size_t)row * D + 512 * j + 8 * lane + 4 * h) = o;
                        }
                }
            }
        }
    }
}

extern "C" void kernel_launch(void* const* d_in, const int* in_sizes, int n_in, void* d_out, int out_size, void* d_ws, size_t ws_size, hipStream_t stream) {
    static int grid_blocks = 0;
    if (grid_blocks == 0) {
        if (n_in != 16 || in_sizes[0] != T * D || out_size != T * D || ws_size < WS_END) {
            fprintf(stderr, "kernel_launch: unexpected shapes: n_in %d in0 %d out %d ws %zu (need %zu)\n", n_in, n_in > 0 ? in_sizes[0] : -1, out_size, ws_size, (size_t)WS_END); grid_blocks = -1; return; }
        int dev = 0, cus = 0, per_cu = 0;
        (void)hipGetDevice(&dev);
        (void)hipDeviceGetAttribute(&cus, hipDeviceAttributeMultiprocessorCount, dev);
        (void)hipFuncSetAttribute((const void*)fwd_megakernel, hipFuncAttributeMaxDynamicSharedMemorySize, LDS_BYTES);
        (void)hipOccupancyMaxActiveBlocksPerMultiprocessor(&per_cu, (const void*)fwd_megakernel, NTHREADS, LDS_BYTES);
        if (per_cu < 1) { fprintf(stderr, "kernel_launch: occupancy query reports %d blocks per CU\n", per_cu); per_cu = 1; }
        grid_blocks = cus;
        fprintf(stderr, "kernel_launch: cus=%d per_cu=%d grid=%d ws=%zu\n", cus, per_cu, grid_blocks, ws_size);
    }
    if (grid_blocks < 0) return;
    (void)hipMemsetAsync((char*)d_ws + WS_CTL, 0, CTL_ZERO_BYTES, stream);
    Params p{};
    p.x = (const float*)d_in[0]; p.w_in = (const float*)d_in[1]; p.b_in = (const float*)d_in[2]; p.sinks = (const float*)d_in[3]; p.w_out = (const float*)d_in[4]; p.b_out = (const float*)d_in[5];
    p.ln1_g = (const float*)d_in[6]; p.ln1_b = (const float*)d_in[7]; p.w_router = (const float*)d_in[8]; p.b_router = (const float*)d_in[9];
    p.w1 = (const float*)d_in[10]; p.b1 = (const float*)d_in[11]; p.w2 = (const float*)d_in[12]; p.b2 = (const float*)d_in[13]; p.ln2_g = (const float*)d_in[14]; p.ln2_b = (const float*)d_in[15];
    p.out = (float*)d_out; p.ws = (unsigned char*)d_ws;
    void* args[] = {&p};
    hipError_t e = hipLaunchCooperativeKernel((void*)fwd_megakernel, dim3(grid_blocks), dim3(NTHREADS), args, LDS_BYTES, stream);
    if (e != hipSuccess) fprintf(stderr, "cooperative launch failed: %s (grid %d)\n", hipGetErrorString(e), grid_blocks);
}
```

```cpp
#include <hip/hip_runtime.h>
#include <cstdio>
#include <cstdint>

#define LAS __attribute__((address_space(3)))
typedef unsigned short bf16_t;
typedef short bf16x8 __attribute__((ext_vector_type(8)));
typedef short s16x4 __attribute__((ext_vector_type(4)));
typedef float f32x2 __attribute__((ext_vector_type(2)));
typedef float f32x4 __attribute__((ext_vector_type(4)));
typedef float f32x16 __attribute__((ext_vector_type(16)));
typedef unsigned u32x2 __attribute__((ext_vector_type(2)));
typedef unsigned u32x4 __attribute__((ext_vector_type(4)));
typedef __bf16 bf16x2_t __attribute__((ext_vector_type(2)));

constexpr int D = 1024, BATCH = 32, SEQ = 2048, T = BATCH * SEQ;
constexpr int INW = 2304, NE = 32;
constexpr float LN_EPS = 1e-5f;
constexpr float DN_ALPHA = 1.189207115002721f;
constexpr float LOG2E = 1.4426950408889634f;
constexpr float C2 = 0.18033688011112042f;
constexpr int NTHREADS = 512;
constexpr int LDS_BYTES = 147456;
constexpr int MAX_TILES = 1056;
#ifndef INPROJ_FP8
#define INPROJ_FP8 1
#endif
#ifndef EPI_DUP
#define EPI_DUP 0
#endif
#ifndef DUP_MASK
#define DUP_MASK 0
#endif
#define REP(k) for (int _rep = 0; _rep < (((DUP_MASK >> (k)) & 1) ? 2 : 1); ++_rep)

constexpr size_t MiB = 1u << 20;
constexpr size_t WS_CTL = 0, CTL_ZERO_BYTES = 2 * MiB;
constexpr size_t WS_KSUM = 1 * MiB;
constexpr size_t WS_ROPE = 2 * MiB;
constexpr size_t WS_WIN_T = 4 * MiB;
constexpr size_t WS_WOUT_T = 9 * MiB;
constexpr size_t WS_SMALL = 11 * MiB;
constexpr size_t WS_CNT = WS_SMALL, WS_TILE_E = WS_SMALL + 65536, WS_WR_HI = WS_SMALL + 131072, WS_WR_LO = WS_WR_HI + 65536;
constexpr size_t WS_TOK = 12 * MiB;
constexpr size_t WS_ASG_E = 14 * MiB, WS_ASG_G = 15 * MiB, WS_ASG_D = 16 * MiB;
constexpr size_t WS_W2_8 = 24 * MiB;
constexpr size_t WS_X1B = 56 * MiB;
constexpr size_t WS_ACT8 = 184 * MiB;
constexpr size_t WS_XB = 184 * MiB;
constexpr size_t WS_X1LO = 312 * MiB;
constexpr size_t WS_YB = 488 * MiB;
constexpr size_t WS_W1_8 = 488 * MiB;
constexpr size_t WS_X1_8 = 552 * MiB;
constexpr size_t WS_QKV = 616 * MiB;
constexpr size_t WS_END = 1016 * MiB;
constexpr float W_SCALE = 64.0f, ACT_SCALE = 4.0f, WIN_SCALE = 32.0f, Y_SCALE = 16.0f;
constexpr int CW_NTILES = 16, CW_BAR = 4096;
constexpr int LDSX_TILE = 131072, LDSX_IDX = 135424, LDSX_BIAS = 136448;
constexpr int LDS_BARST = LDS_BYTES - 256;

struct Params {
    const float *x, *w_in, *b_in, *sinks, *w_out, *b_out, *ln1_g, *ln1_b, *w_router, *b_router, *w1, *b1, *w2, *b2, *ln2_g, *ln2_b;
    float* out; unsigned char* ws;
};

__device__ __forceinline__ unsigned f2bf(float f) { unsigned u = __builtin_bit_cast(unsigned, f); return (u + 0x7fffu + ((u >> 16) & 1u)) >> 16; }
__device__ __forceinline__ float bf2f(unsigned h) { return __builtin_bit_cast(float, h << 16); }
__device__ __forceinline__ unsigned cvtpk(float lo, float hi) { f32x2 v = {lo, hi}; bf16x2_t b = __builtin_convertvector(v, bf16x2_t); return __builtin_bit_cast(unsigned, b); }
__device__ __forceinline__ unsigned pk4_fp8(float a, float b, float c, float d) { int w = 0; w = __builtin_amdgcn_cvt_pk_fp8_f32(a, b, w, false); w = __builtin_amdgcn_cvt_pk_fp8_f32(c, d, w, true); return (unsigned)w; }
__device__ __forceinline__ float wave_sum(float v) {
#pragma unroll
    for (int o = 1; o < 64; o <<= 1) v += __shfl_xor(v, o);
    return v;
}
#define LDS_WAIT() asm volatile("s_waitcnt lgkmcnt(0)" ::: "memory")
template <int X> __device__ __forceinline__ float swz_xor(float v) { return __builtin_bit_cast(float, __builtin_amdgcn_ds_swizzle(__builtin_bit_cast(int, v), (X << 10) | 0x1f)); }

namespace pg8 {
constexpr int BM = 256, BK = 64, HALF = 128, HTB = HALF * BK * 2, STAGE_BYTES = 8 * HTB, NXCD = 8, WGM = 8;
constexpr int KD = 1024;
__host__ __device__ __forceinline__ int lds_byte(int r, int c) { const int st = (r >> 4) * 2 + (c >> 5), rr = r & 15, cc = c & 31, ob = rr * 64 + cc * 2; return st * 1024 + (ob ^ (((ob >> 9) & 1) << 5)); }
__host__ __device__ __forceinline__ void stage_rc(int b, int& R, int& C) { const int st = b / 1024, sb = b % 1024, swz = sb ^ (((sb >> 9) & 1) << 5); R = (st >> 1) * 16 + swz / 64; C = (st & 1) * 32 + (swz % 64) / 2; }
__host__ __device__ __forceinline__ int perm32(int rho) { const int n = rho >> 4, i = rho & 15; return 8 * (i >> 2) + 4 * n + (i & 3); }

struct Unit { int pm, pn, e; unsigned ao, bo; const int* rows; };

typedef int v8i32_t __attribute__((ext_vector_type(8)));
typedef int v4i32_t __attribute__((ext_vector_type(4)));
__device__ __forceinline__ v8i32_t cat8(bf16x8 a, bf16x8 b) { const v4i32_t x = __builtin_bit_cast(v4i32_t, a), y = __builtin_bit_cast(v4i32_t, b); return __builtin_shufflevector(x, y, 0, 1, 2, 3, 4, 5, 6, 7); }
template <class Epi, class Sched, bool GATHER, bool ALIGN_EPI, int KP = 1024, bool FP8 = false, bool MOE = false>
__device__ __forceinline__ void gemm_phase(LAS unsigned char* lds, const Sched& S, const Epi& E) {
    int tid = threadIdx.x; asm volatile("" : "+v"(tid));
    const int wid = __builtin_amdgcn_readfirstlane(tid >> 6), lane = tid & 63, wr = wid >> 2, wc = wid & 3, fr = lane & 15, fq = lane >> 4;
    constexpr int K = KP, nt = K / BK;
    unsigned voffB[2], Vc[2][2]; int stR0, stC0;
    { int R, C; stage_rc(tid * 16, R, C); stR0 = R; stC0 = C; }
#pragma unroll
    for (int i = 0; i < 2; ++i) { voffB[i] = (unsigned)((stR0 + 64 * i) * K + stC0) * 2u; Vc[0][i] = voffB[i]; Vc[1][i] = voffB[i]; }
#define PG8_GATHER_LOAD(VV) do { int _t = threadIdx.x; asm volatile("" : "+v"(_t)); int _R, _C; stage_rc(_t * 16, _R, _C);     \
        const LAS int* _rp = (const LAS int*)(lds + LDSX_IDX) + _R; _Pragma("unroll") for (int _h = 0; _h < 2; ++_h) _Pragma("unroll") for (int _i = 0; _i < 2; ++_i) \
        VV[_h][_i] = ((unsigned)_rp[128 * _h + 64 * _i] * (unsigned)K + (unsigned)_C) * 2u; } while (0)
#define PG8_DMA4(gsrc, ldsoff) __builtin_amdgcn_global_load_lds((const unsigned*)(gsrc), (LAS unsigned*)(lds + (ldsoff)), 4, 0, 0)
    constexpr unsigned kstep = (unsigned)(BK * 2);
    constexpr unsigned hstep = (unsigned)HALF * K * 2;
    const char* const Abase = S.A; const char* const Bbase = S.B;
    const unsigned ldsw = (unsigned)wid * 1024u;
    const int aoff = lds_byte(wr * 64 + fr, fq * 8), boff = lds_byte(wc * 32 + fr, fq * 8);
#define PG8_SA(b, h) (((b) * 2 + (h)) * HTB)
#define PG8_SB(b, h) ((4 + (b) * 2 + (h)) * HTB)
#define PG8_STAGE(bufoff, gbase, soff, voff) do { _Pragma("unroll") for (int _i = 0; _i < 2; ++_i) \
        __builtin_amdgcn_global_load_lds((const unsigned*)((gbase) + (unsigned)((voff)[_i] + (soff))), (LAS unsigned*)(lds + (bufoff) + ldsw + _i * 8192), 16, 0, 0); } while (0)
#define PG8_STAGE_B(bufoff, soff) PG8_STAGE(bufoff, Bbase, soff, voffB)
#define PG8_STAGE_A(bufoff, soff, h, VV) do { if constexpr (GATHER) { PG8_STAGE(bufoff, Abase, soff, VV[h]); } else { PG8_STAGE(bufoff, Abase, (soff) + (h) * hstep, voffB); } } while (0)
#define PG8_LDA(dst, b, h) do { _Pragma("unroll") for (int m = 0; m < 4; ++m) dst[m] = cat8(*(const LAS bf16x8*)(lds + PG8_SA(b, h) + aoff + m * 2048), *(const LAS bf16x8*)(lds + PG8_SA(b, h) + aoff + m * 2048 + 1024)); } while (0)
#define PG8_LDB(dst, b, h) do { _Pragma("unroll") for (int n = 0; n < 2; ++n) dst[n] = cat8(*(const LAS bf16x8*)(lds + PG8_SB(b, h) + boff + n * 2048), *(const LAS bf16x8*)(lds + PG8_SB(b, h) + boff + n * 2048 + 1024)); } while (0)
#define PG8_LO(v) __builtin_bit_cast(bf16x8, __builtin_shufflevector(v, v, 0, 1, 2, 3))
#define PG8_HI(v) __builtin_bit_cast(bf16x8, __builtin_shufflevector(v, v, 4, 5, 6, 7))
#define PG8_MMA(ai, bj, At, Bt) do { __builtin_amdgcn_s_setprio(1); _Pragma("unroll") for (int m = 0; m < 4; ++m) _Pragma("unroll") for (int n = 0; n < 2; ++n) { \
        if constexpr (FP8) { acc[ai][bj][m][n] = __builtin_amdgcn_mfma_scale_f32_16x16x128_f8f6f4(Bt[n], At[m], acc[ai][bj][m][n], 0, 0, 0, 0x7f7f7f7f, 0, 0x7f7f7f7f); } \
        else { acc[ai][bj][m][n] = __builtin_amdgcn_mfma_f32_16x16x32_bf16(PG8_LO(Bt[n]), PG8_LO(At[m]), acc[ai][bj][m][n], 0, 0, 0); \
               acc[ai][bj][m][n] = __builtin_amdgcn_mfma_f32_16x16x32_bf16(PG8_HI(Bt[n]), PG8_HI(At[m]), acc[ai][bj][m][n], 0, 0, 0); } } \
        __builtin_amdgcn_s_setprio(0); } while (0)
#define PG8_WAIT_V(n) asm volatile("s_waitcnt vmcnt(" #n ")" ::: "memory")
#define PG8_WAIT_L(n) asm volatile("s_waitcnt lgkmcnt(" #n ")" ::: "memory")
#define PG8_BAR __builtin_amdgcn_s_barrier()
#define PG8_SCHED __builtin_amdgcn_sched_barrier(0)
    Unit cur, nxt; int ui = 0;
    if (!S.next(0, cur)) return;
    if constexpr (MOE) {
        if (wid < 4) { PG8_DMA4(E.bias_src(cur) + wid * 64 + lane, LDSX_BIAS + wid * 256); if constexpr (GATHER) PG8_DMA4(cur.rows + wid * 64 + lane, LDSX_IDX + wid * 256); }
        asm volatile("s_waitcnt vmcnt(0)" ::: "memory"); __builtin_amdgcn_s_barrier(); asm volatile("" ::: "memory");
    }
    if constexpr (GATHER) { PG8_GATHER_LOAD(Vc); }
    f32x4 acc[2][2][4][2];
#pragma unroll
    for (int a = 0; a < 2; ++a)
#pragma unroll
        for (int b = 0; b < 2; ++b)
#pragma unroll
            for (int m = 0; m < 4; ++m)
#pragma unroll
                for (int n = 0; n < 2; ++n) acc[a][b][m][n] = (f32x4){0.f, 0.f, 0.f, 0.f};
    v8i32_t At[4], B0[2], B1[2];
    unsigned cA = cur.ao, cB = cur.bo;
    PG8_STAGE_B(PG8_SB(0, 0), cB); PG8_STAGE_B(PG8_SB(0, 1), cB + hstep); PG8_STAGE_A(PG8_SA(0, 0), cA, 0, Vc); PG8_STAGE_A(PG8_SA(0, 1), cA, 1, Vc);
    if (wr == 1) PG8_BAR;
    PG8_WAIT_V(2); PG8_BAR;
    PG8_STAGE_B(PG8_SB(1, 0), cB + kstep); PG8_STAGE_A(PG8_SA(1, 0), cA + kstep, 0, Vc); PG8_STAGE_B(PG8_SB(1, 1), cB + hstep + kstep);
    PG8_WAIT_V(6); PG8_BAR;
    for (;;) {
        const bool has_next = S.next(ui + 1, nxt);
        const unsigned nA = has_next ? nxt.ao : cA; const unsigned nB = has_next ? nxt.bo : cB;
        if constexpr (MOE) {
            if (has_next && wid < 4) { PG8_DMA4(E.bias_src(nxt) + wid * 64 + lane, LDSX_BIAS + ((ui + 1) % 3) * 1024 + wid * 256); if constexpr (GATHER) PG8_DMA4(nxt.rows + wid * 64 + lane, LDSX_IDX + wid * 256); }
        }
#pragma unroll 1
        for (int t = 0; t < nt; t += 2) {
            const bool last = (t == nt - 2);
            const unsigned a1 = cA + (unsigned)(t + 1) * kstep;
            const unsigned a2 = last ? nA : cA + (unsigned)(t + 2) * kstep; const unsigned b2 = last ? nB : cB + (unsigned)(t + 2) * kstep;
            const unsigned a3 = a2 + kstep; const unsigned b3 = b2 + kstep;
            PG8_LDB(B0, 0, 0); PG8_LDB(B1, 0, 1); PG8_SCHED; PG8_LDA(At, 0, 0); PG8_STAGE_A(PG8_SA(1, 1), a1, 1, Vc);
            if constexpr (GATHER) { if (last && has_next) { PG8_GATHER_LOAD(Vc); } }
            PG8_WAIT_V(8); PG8_WAIT_L(0); PG8_BAR; PG8_MMA(0, 0, At, B0); PG8_MMA(0, 1, At, B1); PG8_BAR; PG8_SCHED;
            PG8_LDA(At, 0, 1); PG8_STAGE_B(PG8_SB(0, 0), b2); PG8_STAGE_B(PG8_SB(0, 1), b2 + hstep); PG8_STAGE_A(PG8_SA(0, 0), a2, 0, Vc);
            PG8_WAIT_V(8); PG8_WAIT_L(0); PG8_BAR; PG8_MMA(1, 0, At, B0); PG8_MMA(1, 1, At, B1); PG8_BAR; PG8_SCHED;
            PG8_LDB(B0, 1, 0); PG8_LDB(B1, 1, 1); PG8_SCHED; PG8_LDA(At, 1, 0); PG8_STAGE_A(PG8_SA(0, 1), a2, 1, Vc);
            PG8_WAIT_V(8); PG8_WAIT_L(0); PG8_BAR; PG8_MMA(0, 0, At, B0); PG8_MMA(0, 1, At, B1); PG8_BAR; PG8_SCHED;
            PG8_LDA(At, 1, 1); PG8_STAGE_B(PG8_SB(1, 0), b3); PG8_STAGE_B(PG8_SB(1, 1), b3 + hstep); PG8_STAGE_A(PG8_SA(1, 0), a3, 0, Vc);
            PG8_WAIT_V(8); PG8_WAIT_L(0); PG8_BAR; PG8_MMA(1, 0, At, B0); PG8_MMA(1, 1, At, B1); PG8_BAR; PG8_SCHED;
        }
        if constexpr (ALIGN_EPI) { if (wr == 0) PG8_BAR; }
        { int t2 = threadIdx.x; asm volatile("" : "+v"(t2));
          if constexpr (MOE) { E(acc, cur, wr, wc, t2 & 15, (t2 & 63) >> 4, (const LAS float*)(lds + LDSX_BIAS + (ui % 3) * 1024));
              if (EPI_DUP) { asm volatile("" : "+v"(t2)); E(acc, cur, wr, wc, t2 & 15, (t2 & 63) >> 4, (const LAS float*)(lds + LDSX_BIAS + (ui % 3) * 1024)); } }
          else E(acc, cur, wr, wc, t2 & 15, (t2 & 63) >> 4); }
        if (!has_next) break;
#pragma unroll
        for (int a = 0; a < 2; ++a)
#pragma unroll
            for (int b = 0; b < 2; ++b)
#pragma unroll
                for (int m = 0; m < 4; ++m)
#pragma unroll
                    for (int n = 0; n < 2; ++n) acc[a][b][m][n] = (f32x4){0.f, 0.f, 0.f, 0.f};
        cur = nxt; cA = nA; cB = nB; ++ui;
        if constexpr (ALIGN_EPI) { if (wr == 1) PG8_BAR; }
    }
    PG8_WAIT_V(0);
    if constexpr (!ALIGN_EPI) { if (wr == 0) PG8_BAR; }
    PG8_BAR;
#undef PG8_SA
#undef PG8_SB
#undef PG8_STAGE
#undef PG8_STAGE_A
#undef PG8_STAGE_B
#undef PG8_GATHER_LOAD
#undef PG8_DMA4
#undef PG8_LDA
#undef PG8_LDB
#undef PG8_LO
#undef PG8_HI
#undef PG8_MMA
#undef PG8_WAIT_V
#undef PG8_WAIT_L
#undef PG8_BAR
#undef PG8_SCHED
}

template <int ROWB>
struct SchedInProj {
    const char* A; const char* B; int G, c;
    __device__ __forceinline__ bool next(int i, Unit& u) const {
        constexpr int nM = T / BM, nN = INW / BM, nwg = nM * nN;
        const long L = (long)i * G + c; if (L >= nwg) return false;
        int wgid = (int)L; { const int q = nwg / NXCD, r = nwg % NXCD, xcd = wgid % NXCD, off = wgid / NXCD; wgid = (xcd < r ? xcd * (q + 1) : r * (q + 1) + (xcd - r) * q) + off; }
        const int nig = WGM * nN, gid = wgid / nig, fm = gid * WGM, gsz = (nM - fm) < WGM ? (nM - fm) : WGM;
        u.pm = fm + ((wgid % nig) % gsz); u.pn = (wgid % nig) / gsz; u.e = 0; u.rows = nullptr;
        u.ao = (unsigned)u.pm * (unsigned)(256 * ROWB); u.bo = (unsigned)u.pn * (unsigned)(256 * ROWB); return true;
    }
};
struct SchedPanel {
    const char* A; const char* B; int pm;
    __device__ __forceinline__ bool next(int i, Unit& u) const {
        if (i >= 4) return false;
        u.pm = pm; u.pn = i; u.e = 0; u.rows = nullptr; u.ao = (unsigned)pm * (unsigned)(256 * KD * 2); u.bo = (unsigned)i * (unsigned)(256 * KD * 2); return true;
    }
};
template <int NPN, bool G1>
struct SchedMoe {
    const char* A; const char* B; const LAS int* tile_e; const int* tok; int ntiles, G, c;
    __device__ __forceinline__ bool next(int i, Unit& u) const {
        const long L = (long)i * G + c; int t, pn;
        if ((G & 7) == 0) { const int x = (int)(L & 7); const long j = L >> 3; t = (int)(j / NPN) * 8 + x; pn = (int)(j % NPN); }
        else { t = (int)(L / NPN); pn = (int)(L % NPN); }
        if (t >= ntiles) return false;
        const int e = __builtin_amdgcn_readfirstlane(tile_e[t]);
        u.pm = t; u.pn = pn; u.e = e;
        if (G1) { u.ao = 0u; u.rows = tok + (size_t)t * 256; u.bo = ((unsigned)e * 2048u + (unsigned)pn * 256u) * 1024u; }
        else { u.ao = (unsigned)t * (256u * 1024u); u.rows = nullptr; u.bo = ((unsigned)e * 1024u + (unsigned)pn * 256u) * 1024u; }
        return true;
    }
};

struct EpiInProj {
    bf16_t* qkv; const float* b_in; const float* rope; float* ksum; float descale;
    __device__ __forceinline__ void operator()(const f32x4 (&acc)[2][2][4][2], const Unit& u, int wr, int wc, int fr, int fq) const {
        const int pn = u.pn;
        const int colb = 256 * pn + 64 * wc + 8 * fq;
        const bool do_rope = !(pn >= 7 || (pn == 2 && wc >= 2));
        const bool is_q = (pn < 2) || (pn == 3) || (pn == 4);
        const bool is_kb = (pn == 5) || (pn == 6);
        const float sc = is_q ? C2 : 1.0f;
        f32x4 bv[2][2];
#pragma unroll
        for (int bj = 0; bj < 2; ++bj)
#pragma unroll
            for (int n = 0; n < 2; ++n) bv[bj][n] = *(const f32x4*)(b_in + colb + 32 * bj + 4 * n);
        f32x4 ks[2][2];
#pragma unroll
        for (int bj = 0; bj < 2; ++bj)
#pragma unroll
            for (int n = 0; n < 2; ++n) ks[bj][n] = (f32x4){0.f, 0.f, 0.f, 0.f};
#pragma unroll
        for (int ai = 0; ai < 2; ++ai)
#pragma unroll
            for (int m = 0; m < 4; ++m) {
                const int row = u.pm * 256 + ai * 128 + wr * 64 + m * 16 + fr;
                const int pos = row & (SEQ - 1);
                f32x4 o1[2], o2[2];
#pragma unroll
                for (int n = 0; n < 2; ++n) { o1[n] = acc[ai][0][m][n] * descale + bv[0][n]; o2[n] = acc[ai][1][m][n] * descale + bv[1][n]; }
                if (do_rope) {
                    const float* rp = rope + pos * 64 + 8 * fq;
#pragma unroll
                    for (int n = 0; n < 2; ++n) { const f32x4 c = *(const f32x4*)(rp + 4 * n), s = *(const f32x4*)(rp + 32 + 4 * n);
                        const f32x4 a = o1[n], b = o2[n]; o1[n] = a * c - b * s; o2[n] = b * c + a * s; }
                }
                if (is_kb) {
#pragma unroll
                    for (int n = 0; n < 2; ++n) { ks[0][n] += o1[n]; ks[1][n] += o2[n]; }
                }
                bf16_t* rowp = qkv + (size_t)row * INW + colb;
                u32x4 w1, w2;
                w1.x = cvtpk(o1[0][0] * sc, o1[0][1] * sc); w1.y = cvtpk(o1[0][2] * sc, o1[0][3] * sc); w1.z = cvtpk(o1[1][0] * sc, o1[1][1] * sc); w1.w = cvtpk(o1[1][2] * sc, o1[1][3] * sc);
                w2.x = cvtpk(o2[0][0] * sc, o2[0][1] * sc); w2.y = cvtpk(o2[0][2] * sc, o2[0][3] * sc); w2.z = cvtpk(o2[1][0] * sc, o2[1][1] * sc); w2.w = cvtpk(o2[1][2] * sc, o2[1][3] * sc);
                *(u32x4*)(rowp) = w1; *(u32x4*)(rowp + 32) = w2;
            }
        if (is_kb) {
            float* kd = ksum + (size_t)u.pm * 512 + 256 * (pn - 5) + 64 * wc + 8 * fq;
#pragma unroll
            for (int bj = 0; bj < 2; ++bj)
#pragma unroll
                for (int n = 0; n < 2; ++n)
#pragma unroll
                    for (int j = 0; j < 4; ++j) {
                        float v = ks[bj][n][j];
                        v += swz_xor<1>(v); v += swz_xor<2>(v); v += swz_xor<4>(v); v += swz_xor<8>(v);
                        if (fr == 0) atomicAdd(kd + 32 * bj + 4 * n + j, v);
                    }
        }
    }
};
struct EpiOutProj {
    bf16_t* y; const float* b_out; const float* x;
    __device__ __forceinline__ void operator()(const f32x4 (&acc)[2][2][4][2], const Unit& u, int wr, int wc, int fr, int fq) const {
        const int col0 = u.pn * 256 + wc * 32 + 8 * fq;
        f32x4 bv[2][2];
#pragma unroll
        for (int bj = 0; bj < 2; ++bj)
#pragma unroll
            for (int n = 0; n < 2; ++n) bv[bj][n] = *(const f32x4*)(b_out + col0 + 128 * bj + 4 * n);
#pragma unroll
        for (int ai = 0; ai < 2; ++ai)
#pragma unroll
            for (int m = 0; m < 4; ++m) {
                const size_t off = (size_t)(u.pm * 256 + ai * 128 + wr * 64 + m * 16 + fr) * D + col0;
#pragma unroll
                for (int bj = 0; bj < 2; ++bj) {
                    const f32x4 x0 = *(const f32x4*)(x + off + 128 * bj), x1 = *(const f32x4*)(x + off + 128 * bj + 4);
                    const f32x4 v0 = acc[ai][bj][m][0] + bv[bj][0] + x0 * DN_ALPHA, v1 = acc[ai][bj][m][1] + bv[bj][1] + x1 * DN_ALPHA;
                    u32x4 w; w.x = cvtpk(v0[0], v0[1]); w.y = cvtpk(v0[2], v0[3]); w.z = cvtpk(v1[0], v1[1]); w.w = cvtpk(v1[2], v1[3]);
                    *(u32x4*)(y + off + 128 * bj) = w; }
                if (m & 1) asm volatile("" ::: "memory");
            }
    }
};
struct EpiSwiglu {
    unsigned char* act8; const float* b1;
    __device__ __forceinline__ const float* bias_src(const Unit& u) const { return b1 + (size_t)u.e * 2048 + 256 * u.pn; }
    __device__ __forceinline__ void operator()(const f32x4 (&acc)[2][2][4][2], const Unit& u, int wr, int wc, int fr, int fq, const LAS float* bias) const {
        const int a0 = 128 * u.pn + 32 * wc + 8 * fq;
        const LAS float* bp = bias + 2 * (32 * wc + 8 * fq);
        f32x4 bb[4];
#pragma unroll
        for (int q = 0; q < 4; ++q) bb[q] = *(const LAS f32x4*)(bp + 4 * q);
        f32x2 bg[2][2], bl[2][2];
#pragma unroll
        for (int n = 0; n < 2; ++n)
#pragma unroll
            for (int jp = 0; jp < 2; ++jp) { bg[n][jp] = (f32x2){bb[2 * n + jp][0], bb[2 * n + jp][2]}; bl[n][jp] = (f32x2){bb[2 * n + jp][1], bb[2 * n + jp][3]}; }
        unsigned char* tile = act8 + (size_t)u.pm * (256 * 1024);
#pragma unroll
        for (int ai = 0; ai < 2; ++ai)
#pragma unroll
            for (int m = 0; m < 4; ++m) {
                const int row = ai * 128 + wr * 64 + m * 16 + fr;
                f32x2 r[2][2];
#pragma unroll
                for (int n = 0; n < 2; ++n)
#pragma unroll
                    for (int jp = 0; jp < 2; ++jp) {
                        const f32x2 ag = {acc[ai][0][m][n][2 * jp], acc[ai][0][m][n][2 * jp + 1]}, al = {acc[ai][1][m][n][2 * jp], acc[ai][1][m][n][2 * jp + 1]};
                        f32x2 g = ag * (1.0f / W_SCALE) + bg[n][jp], l = al * (1.0f / W_SCALE) + bl[n][jp];
                        g.x = fminf(g.x, 7.0f); g.y = fminf(g.y, 7.0f);
                        l.x = __builtin_amdgcn_fmed3f(l.x, -7.0f, 7.0f); l.y = __builtin_amdgcn_fmed3f(l.y, -7.0f, 7.0f);
                        const f32x2 uarg = g * (-1.702f * LOG2E);
                        f32x2 t; t.x = __builtin_amdgcn_exp2f(uarg.x); t.y = __builtin_amdgcn_exp2f(uarg.y);
                        const f32x2 d = t + 1.0f;
                        f32x2 sg; sg.x = __builtin_amdgcn_rcpf(d.x); sg.y = __builtin_amdgcn_rcpf(d.y);
                        const f32x2 lf = l * ACT_SCALE + ACT_SCALE;
                        r[n][jp] = (g * sg) * lf;
                    }
                u32x2 w; w.x = pk4_fp8(r[0][0].x, r[0][0].y, r[0][1].x, r[0][1].y); w.y = pk4_fp8(r[1][0].x, r[1][0].y, r[1][1].x, r[1][1].y);
                *(u32x2*)(tile + (size_t)row * 1024 + (size_t)a0) = w;
            }
    }
};
struct EpiDown {
    unsigned char* yb; const float* b2;
    __device__ __forceinline__ const float* bias_src(const Unit& u) const { return b2 + (size_t)u.e * 1024 + 256 * u.pn; }
    __device__ __forceinline__ void operator()(const f32x4 (&acc)[2][2][4][2], const Unit& u, int wr, int wc, int fr, int fq, const LAS float* bias) const {
        const int col0 = u.pn * 256 + wc * 32 + 8 * fq;
        const LAS float* bp = bias + wc * 32 + 8 * fq;
#pragma unroll
        for (int bj = 0; bj < 2; ++bj) {
            const f32x4 bv0 = *(const LAS f32x4*)(bp + 128 * bj) * Y_SCALE, bv1 = *(const LAS f32x4*)(bp + 128 * bj + 4) * Y_SCALE;
#pragma unroll
            for (int ai = 0; ai < 2; ++ai)
#pragma unroll
                for (int m = 0; m < 4; ++m) {
                    unsigned char* rowp = yb + (size_t)(u.pm * 256 + ai * 128 + wr * 64 + m * 16 + fr) * 1024 + col0;
                    const f32x4 v0 = acc[ai][bj][m][0] * (Y_SCALE / (W_SCALE * ACT_SCALE)) + bv0, v1 = acc[ai][bj][m][1] * (Y_SCALE / (W_SCALE * ACT_SCALE)) + bv1;
                    u32x2 w; w.x = pk4_fp8(v0[0], v0[1], v0[2], v0[3]); w.y = pk4_fp8(v1[0], v1[1], v1[2], v1[3]);
                    *(u32x2*)(rowp + 128 * bj) = w;
                }
        }
    }
};
}

namespace att {
constexpr int PITCH = INW, SLOTB = 8192;
constexpr int NSLOT = 4;
constexpr int L_K = 0, L_V = NSLOT * SLOTB, L_WS = 2 * NSLOT * SLOTB, L_KS = L_WS + 2048, L_OST = L_KS + 2048, L_END = L_OST + 8 * 4096;
static_assert(NSLOT == 4 && L_END <= 131072, "attention LDS map");
constexpr float NEG = -1.0e30f, M0 = -1.0e20f, THR = 8.0f;
typedef LAS const char* lds_cptr;
__device__ __forceinline__ int crow(int r, int hi) { return (r & 3) + 8 * (r >> 2) + 4 * hi; }
__device__ __forceinline__ void glds16(const void* gsrc, unsigned lds_dst) { unsigned keep;
    asm volatile("s_mov_b32 %0, m0\n\ts_mov_b32 m0, %2\n\ts_nop 0\n\tglobal_load_lds_dwordx4 %1, off\n\ts_mov_b32 m0, %0" : "=&s"(keep) : "v"(gsrc), "s"(lds_dst) : "memory"); }
#define ATT_WAIT_BAR0() asm volatile("s_waitcnt vmcnt(0) lgkmcnt(0)\n\ts_barrier" ::: "memory")
#define ATT_WAIT_BARN(N) asm volatile("s_waitcnt vmcnt(" #N ") lgkmcnt(0)\n\ts_barrier" ::: "memory")
#define ATT_SBAR() __builtin_amdgcn_sched_barrier(0)

__device__ __forceinline__ void qkt(f32x16& p0, f32x16& p1, lds_cptr kb, const bf16x8* qr, const f32x16& negm) {
#pragma unroll
    for (int d0 = 0; d0 < 4; ++d0) {
        const bf16x8 b0 = *(const LAS bf16x8*)(kb + d0 * 2048);
        const bf16x8 b1 = *(const LAS bf16x8*)(kb + d0 * 2048 + 512);
        if (d0 == 0) { p0 = __builtin_amdgcn_mfma_f32_32x32x16_bf16(b0, qr[0], negm, 0, 0, 0); p1 = __builtin_amdgcn_mfma_f32_32x32x16_bf16(b1, qr[0], negm, 0, 0, 0); }
        else { p0 = __builtin_amdgcn_mfma_f32_32x32x16_bf16(b0, qr[d0], p0, 0, 0, 0); p1 = __builtin_amdgcn_mfma_f32_32x32x16_bf16(b1, qr[d0], p1, 0, 0, 0); }
    }
}
__device__ __forceinline__ float rowmax32(const f32x16& p0, const f32x16& p1) {
    float a = fmaxf(p0[0], p1[0]);
#pragma unroll
    for (int r = 1; r < 16; ++r) a = fmaxf(a, fmaxf(p0[r], p1[r]));
    auto rr = __builtin_amdgcn_permlane32_swap(__float_as_uint(a), __float_as_uint(a), false, false);
    return fmaxf(__uint_as_float(rr[0]), __uint_as_float(rr[1]));
}
__device__ __forceinline__ void pv(f32x16* o, int vb, bf16x8 pa0, bf16x8 pa1, bf16x8 pa2, bf16x8 pa3) {
#pragma unroll
    for (int d0 = 0; d0 < 2; ++d0) { s16x4 lo[4], hi[4];
#pragma unroll
        for (int ks = 0; ks < 4; ++ks) {
            asm volatile("ds_read_b64_tr_b16 %0,%1 offset:%c2" : "=&v"(lo[ks]) : "v"(vb), "i"(d0 * 4096 + ks * 1024) : "memory");
            asm volatile("ds_read_b64_tr_b16 %0,%1 offset:%c2" : "=&v"(hi[ks]) : "v"(vb), "i"(d0 * 4096 + ks * 1024 + 512) : "memory"); }
        asm volatile("s_waitcnt lgkmcnt(0)" ::: "memory"); ATT_SBAR();
#define ATT_PK(k) (bf16x8){lo[k][0], lo[k][1], lo[k][2], lo[k][3], hi[k][0], hi[k][1], hi[k][2], hi[k][3]}
        o[d0] = __builtin_amdgcn_mfma_f32_32x32x16_bf16(pa0, ATT_PK(0), o[d0], 0, 0, 0);
        o[d0] = __builtin_amdgcn_mfma_f32_32x32x16_bf16(pa1, ATT_PK(1), o[d0], 0, 0, 0);
        o[d0] = __builtin_amdgcn_mfma_f32_32x32x16_bf16(pa2, ATT_PK(2), o[d0], 0, 0, 0);
        o[d0] = __builtin_amdgcn_mfma_f32_32x32x16_bf16(pa3, ATT_PK(3), o[d0], 0, 0, 0);
#undef ATT_PK
    }
}

template <bool MOBA>
__device__ __forceinline__ void attn_item(char* shm, const bf16_t* __restrict__ qkv, bf16_t* __restrict__ aout, int b, int hh, int qb, const float* __restrict__ sinks, const float* __restrict__ ksum) {
    int tid = threadIdx.x; asm volatile("" : "+v"(tid));
    const int lane = tid & 63, r32 = lane & 31, hi = lane >> 5; const int wid = __builtin_amdgcn_readfirstlane(tid >> 6);
    const long rowbase = (long)b * SEQ;
    int qa, qcol, kcol, vcol, ocol, kt0, kt1;
    if (MOBA) { qa = 256 * qb + 32 * wid; qcol = 768 + 64 * hh; kcol = 1280 + 64 * hh; vcol = 1792 + 64 * hh; ocol = 512 + 64 * hh; kt0 = 0; kt1 = 4 * qb + 4; }
    else { const int g = wid >> 1; qa = 64 * qb + 32 * (wid & 1); qcol = (4 * hh + g) * 64; kcol = 512 + 64 * hh; vcol = 640 + 64 * hh; ocol = qcol; kt0 = qb - 2 < 0 ? 0 : qb - 2; kt1 = qb + 1; }
    const bf16_t* Qw = qkv + (rowbase + qa) * PITCH + qcol;
    const bf16_t* Kh = qkv + rowbase * PITCH + kcol; const bf16_t* Vh = qkv + rowbase * PITCH + vcol;
    const unsigned lds0 = (unsigned)(uintptr_t)shm;
    float* wsf = (float*)(shm + L_WS) + wid * 64;
    const bf16_t* ksrc = Kh + (long)lane * PITCH + wid * 8;
    const bf16_t* vsrc = Vh + (long)(16 * (wid & 3) + (lane >> 2)) * PITCH + (wid >> 2) * 32 + (lane & 3) * 8;
    const unsigned kdst = lds0 + L_K + wid * 1024, vdst = lds0 + L_V + wid * 1024;
#define ATT_DMA_K(t, slot) glds16(ksrc + (long)(t) * 64 * PITCH, (unsigned)__builtin_amdgcn_readfirstlane(kdst + (slot)))
#define ATT_DMA_V(t, slot) glds16(vsrc + (long)(t) * 64 * PITCH, (unsigned)__builtin_amdgcn_readfirstlane(vdst + (slot)))
    const int vb0 = (int)(lds0 + L_V) + ((lane >> 4) & 1) * 32 + (lane & 3) * 8 + (4 * hi + ((lane & 15) >> 2)) * 64;
    const lds_cptr shm3 = (lds_cptr)shm; const lds_cptr kp0 = shm3 + L_K + hi * 1024 + r32 * 16;
    const int NT = kt1 - kt0;
    ATT_DMA_K(kt0, 0); ATT_DMA_V(kt0, 0);
    if (NT > 1) { ATT_DMA_K(kt0 + 1, SLOTB); ATT_DMA_V(kt0 + 1, SLOTB); }
    if (NT > 2) { ATT_DMA_K(kt0 + 2, 2 * SLOTB); ATT_DMA_V(kt0 + 2, 2 * SLOTB); }
    if (MOBA) { float* ksl = (float*)(shm + L_KS); ksl[tid] = ksum[((size_t)b * 8 + (tid >> 6)) * 512 + 64 * hh + (tid & 63)]; }
    bf16x8 qr[4];
#pragma unroll
    for (int d0 = 0; d0 < 4; ++d0) qr[d0] = *reinterpret_cast<const bf16x8*>(&Qw[(long)r32 * PITCH + d0 * 16 + hi * 8]);
    float m_run, l_run;
    if (MOBA) { m_run = M0; l_run = 0.f; }
    else { m_run = sinks[4 * hh + (wid >> 1)] * LOG2E; l_run = (hi == 0) ? 1.0f : 0.0f; }
    f32x16 negm;
#pragma unroll
    for (int r = 0; r < 16; ++r) negm[r] = MOBA ? 0.f : -m_run;
    f32x16 o[2]; o[0] = f32x16{}; o[1] = f32x16{};
    ATT_WAIT_BAR0();
    unsigned sel = 0u;
    if (MOBA) {
        if (qb <= 3) sel = (1u << qb) - 1u;
        else {
            const float* ksl = (const float*)(shm + L_KS);
            float gv[7];
#pragma unroll
            for (int i = 0; i < 7; ++i) {
                float s = 0.f;
#pragma unroll
                for (int d0 = 0; d0 < 4; ++d0) {
                    const f32x4 k0 = *(const f32x4*)(ksl + i * 64 + 16 * d0 + 8 * hi), k1 = *(const f32x4*)(ksl + i * 64 + 16 * d0 + 8 * hi + 4);
#pragma unroll
                    for (int jj = 0; jj < 4; ++jj) { s += bf2f((unsigned short)qr[d0][jj]) * k0[jj]; s += bf2f((unsigned short)qr[d0][4 + jj]) * k1[jj]; }
                }
                auto rr = __builtin_amdgcn_permlane32_swap(__float_as_uint(s), __float_as_uint(s), false, false);
                s = __uint_as_float(rr[0]) + __uint_as_float(rr[1]);
                gv[i] = (i < qb) ? s : -INFINITY;
            }
#pragma unroll
            for (int rk = 0; rk < 3; ++rk) { float best = -INFINITY; int bi = 0;
#pragma unroll
                for (int i = 0; i < 7; ++i) { const bool c = (((sel >> i) & 1u) == 0u) && (gv[i] > best); best = c ? gv[i] : best; bi = c ? i : bi; }
                sel |= 1u << bi; }
        }
    }
    for (int it = 0; it < NT; ++it) {
        const int kt = kt0 + it; const int cur = (it & (NSLOT - 1)) * SLOTB;
        if (it + 3 < NT) { const int sl = ((it + 3) & (NSLOT - 1)) * SLOTB; ATT_DMA_K(kt + 3, sl); ATT_DMA_V(kt + 3, sl); }
        bool need; bool on = true;
        if (MOBA) { if (kt < 4 * qb) { on = ((sel >> (kt >> 2)) & 1u) != 0u; need = __any(on) != 0; } else need = (64 * kt <= qa + 31); }
        else need = (64 * kt + 63 >= qa - 127) && (64 * kt <= qa + 31);
        if (need) {
            f32x16 p0, p1; qkt(p0, p1, kp0 + cur, qr, negm);
            if (MOBA && kt < 4 * qb) {
                if (!__all(on)) {
#pragma unroll
                    for (int r = 0; r < 16; ++r) { p0[r] = on ? p0[r] : NEG; p1[r] = on ? p1[r] : NEG; }
                }
            } else {
                const bool edge = MOBA ? (64 * kt + 63 > qa) : !((64 * kt + 63 <= qa) && (qa + 31 - 64 * kt <= 127));
                if (edge) {
                    const int dq = qa + r32 - 64 * kt - 4 * hi;
#pragma unroll
                    for (int r = 0; r < 16; ++r) { const int d0_ = dq - ((r & 3) + 8 * (r >> 2)), d1_ = d0_ - 32;
                        const bool v0 = MOBA ? (d0_ >= 0) : ((unsigned)d0_ < 128u), v1 = MOBA ? (d1_ >= 0) : ((unsigned)d1_ < 128u);
                        p0[r] = v0 ? p0[r] : NEG; p1[r] = v1 ? p1[r] : NEG; }
                }
            }
            const float rm = rowmax32(p0, p1);
            const bool sent = (m_run <= M0), live = (rm > 0.5f * NEG);
            const bool upd = sent ? live : (rm > THR);
            if (__any(upd)) {
                const float dl = sent ? (live ? rm : 0.f) : fmaxf(rm, 0.f);
                const float f = sent ? 1.0f : __builtin_amdgcn_exp2f(-dl);
                m_run = sent ? (live ? rm : m_run) : (m_run + dl);
                const float nm = (m_run <= M0) ? 0.f : -m_run;
#pragma unroll
                for (int r = 0; r < 16; ++r) { p0[r] -= dl; p1[r] -= dl; negm[r] = nm; }
                l_run *= f;
                if (hi == 0) wsf[r32] = f;
                LDS_WAIT();
#pragma unroll
                for (int r = 0; r < 16; ++r) { const float fr_ = wsf[crow(r, hi)]; o[0][r] *= fr_; o[1][r] *= fr_; }
            }
            float sacc = 0.f;
#pragma unroll
            for (int r = 0; r < 16; ++r) { p0[r] = __builtin_amdgcn_exp2f(p0[r]); p1[r] = __builtin_amdgcn_exp2f(p1[r]); sacc += p0[r] + p1[r]; }
            l_run += sacc;
            u32x4 pw0, pw1, pw2, pw3;
            pw0 = (u32x4){cvtpk(p0[0], p0[1]), cvtpk(p0[2], p0[3]), cvtpk(p0[4], p0[5]), cvtpk(p0[6], p0[7])};
            pw1 = (u32x4){cvtpk(p0[8], p0[9]), cvtpk(p0[10], p0[11]), cvtpk(p0[12], p0[13]), cvtpk(p0[14], p0[15])};
            pw2 = (u32x4){cvtpk(p1[0], p1[1]), cvtpk(p1[2], p1[3]), cvtpk(p1[4], p1[5]), cvtpk(p1[6], p1[7])};
            pw3 = (u32x4){cvtpk(p1[8], p1[9]), cvtpk(p1[10], p1[11]), cvtpk(p1[12], p1[13]), cvtpk(p1[14], p1[15])};
            ATT_SBAR();
            pv(o, vb0 + cur, __builtin_bit_cast(bf16x8, pw0), __builtin_bit_cast(bf16x8, pw1), __builtin_bit_cast(bf16x8, pw2), __builtin_bit_cast(bf16x8, pw3));
        }
        if (it + 1 < NT) {
            if (it + 3 < NT) ATT_WAIT_BARN(4); else if (it + 2 < NT) ATT_WAIT_BARN(2); else ATT_WAIT_BAR0();
        }
    }
    { auto rr = __builtin_amdgcn_permlane32_swap(__float_as_uint(l_run), __float_as_uint(l_run), false, false); l_run = __uint_as_float(rr[0]) + __uint_as_float(rr[1]); }
    if (hi == 0) wsf[32 + r32] = l_run;
    LDS_WAIT();
    float rli[16];
#pragma unroll
    for (int r = 0; r < 16; ++r) rli[r] = __builtin_amdgcn_rcpf(wsf[32 + crow(r, hi)]);
    bf16_t* Ow = aout + (rowbase + qa) * D + ocol;
    { bf16_t* stg = (bf16_t*)(shm + L_OST) + wid * 2048;
#pragma unroll
        for (int r = 0; r < 16; ++r) { const int orow = crow(r, hi);
#pragma unroll
            for (int d0 = 0; d0 < 2; ++d0) stg[orow * 64 + d0 * 32 + r32] = (bf16_t)f2bf(o[d0][r] * rli[r]); }
        LDS_WAIT();
#pragma unroll
        for (int i = 0; i < 4; ++i) { const int row = i * 8 + (lane >> 3), ch = lane & 7; const u32x4 v = *(const u32x4*)(stg + row * 64 + ch * 8); *(u32x4*)(Ow + (long)row * D + ch * 8) = v; } }
    asm volatile("s_waitcnt lgkmcnt(0)\n\ts_barrier" ::: "memory");
#undef ATT_DMA_K
#undef ATT_DMA_V
}
}

__device__ __forceinline__ void sincos_d(double a, double& s, double& c) {
    const double q = __builtin_rint(a * 0.63661977236758134308);
    double r = __builtin_fma(-q, 1.57079632679489655800e+00, a);
    r = __builtin_fma(-q, 6.12323399573676603587e-17, r);
    const double r2 = r * r;
    double sp = -1.0 / 1307674368000.0;
    sp = sp * r2 + 1.0 / 6227020800.0; sp = sp * r2 - 1.0 / 39916800.0; sp = sp * r2 + 1.0 / 362880.0; sp = sp * r2 - 1.0 / 5040.0; sp = sp * r2 + 1.0 / 120.0; sp = sp * r2 - 1.0 / 6.0;
    const double sr = r + r * r2 * sp;
    double cp = 1.0 / 20922789888000.0;
    cp = cp * r2 - 1.0 / 87178291200.0; cp = cp * r2 + 1.0 / 479001600.0; cp = cp * r2 - 1.0 / 3628800.0; cp = cp * r2 + 1.0 / 40320.0; cp = cp * r2 - 1.0 / 720.0; cp = cp * r2 + 1.0 / 24.0; cp = cp * r2 - 0.5;
    const double cr = 1.0 + r2 * cp;
    const int n = ((int)q) & 3;
    s = (n == 0) ? sr : (n == 1) ? cr : (n == 2) ? -sr : -cr;
    c = (n == 0) ? cr : (n == 1) ? -sr : (n == 2) ? -cr : sr;
}
__device__ __forceinline__ int sigma_col(int p, int mode) {
    if (mode == 0) return (p & ~255) + 64 * ((p >> 5) & 3) + 32 * ((p >> 7) & 1) + pg8::perm32(p & 31);
    if (mode == 1) return (p & ~31) + pg8::perm32(p & 31);
    const int pn = p >> 8, q = p & 255; return 2 * (128 * pn + 32 * ((q >> 5) & 3) + pg8::perm32(q & 31)) + (q >> 7);
}
__device__ __forceinline__ void p0_transpose_item(const float* __restrict__ W, int N, bf16_t* __restrict__ WT, int mode, LAS float* scr, int item, int lane) {
    const int nblk = N / 32, kb = item / nblk, nb = item % nblk, k0 = 64 * kb, p0 = 32 * nb;
    const int sc = sigma_col(p0 + (lane & 31), mode);
#pragma unroll 8
    for (int i = 0; i < 32; ++i) { const int kk = 2 * i + (lane >> 5); scr[kk * 33 + (lane & 31)] = W[(size_t)(k0 + kk) * N + sc]; }
    LDS_WAIT(); asm volatile("" ::: "memory");
    const int c = lane & 7;
#pragma unroll
    for (int j = 0; j < 4; ++j) { const int n = (lane >> 3) + 8 * j; const LAS float* s = scr + (8 * c) * 33 + n;
        u32x4 o; o.x = cvtpk(s[0 * 33], s[1 * 33]); o.y = cvtpk(s[2 * 33], s[3 * 33]); o.z = cvtpk(s[4 * 33], s[5 * 33]); o.w = cvtpk(s[6 * 33], s[7 * 33]);
        *(u32x4*)(WT + (size_t)(p0 + n) * 1024 + k0 + 8 * c) = o; }
    LDS_WAIT(); asm volatile("" ::: "memory");
}

__device__ __forceinline__ void p0_transpose_item_fp8(const float* __restrict__ W, int N, unsigned char* __restrict__ WT, int mode, float scale, LAS float* scr, int item, int lane) {
    const int nblk = N / 32, kb = item / nblk, nb = item % nblk, k0 = 64 * kb, p0 = 32 * nb;
    const int sc = sigma_col(p0 + (lane & 31), mode);
#pragma unroll 8
    for (int i = 0; i < 32; ++i) { const int kk = 2 * i + (lane >> 5); scr[kk * 33 + (lane & 31)] = W[(size_t)(k0 + kk) * N + sc] * scale; }
    LDS_WAIT(); asm volatile("" ::: "memory");
    const int c = lane & 7;
#pragma unroll
    for (int j = 0; j < 4; ++j) { const int n = (lane >> 3) + 8 * j; const LAS float* s = scr + (8 * c) * 33 + n;
        u32x2 o; o.x = pk4_fp8(s[0 * 33], s[1 * 33], s[2 * 33], s[3 * 33]); o.y = pk4_fp8(s[4 * 33], s[5 * 33], s[6 * 33], s[7 * 33]);
        *(u32x2*)(WT + (size_t)(p0 + n) * 1024 + k0 + 8 * c) = o; }
    LDS_WAIT(); asm volatile("" ::: "memory");
}


#define XB_TMO      128
#define XB_XCNT(j)  (256  + 64 * (j))
#define XB_XSUB(j)  (1280 + 64 * (j))
#define XB_XGEN(j)  (2304 + 64 * (j))
#define XB_TOP      3328
#define XB_TOPGEN   3392
#define XCD_BAR_WORDS 3456
#define XB_SPIN_CAP (1u << 18)
__device__ __forceinline__ unsigned xb_ld(unsigned* p)              { return __hip_atomic_load(p, __ATOMIC_RELAXED, __HIP_MEMORY_SCOPE_AGENT); }
__device__ __forceinline__ unsigned xb_add(unsigned* p, unsigned v) { return __hip_atomic_fetch_add(p, v, __ATOMIC_RELAXED, __HIP_MEMORY_SCOPE_AGENT); }
__device__ __forceinline__ unsigned xb_xcc_id() { return (unsigned)__builtin_amdgcn_s_getreg((3 << 11) | 20) & 0xFu; }
#define XB_SPIN(cond, bar) do { unsigned _sp = 0; while (cond) { __builtin_amdgcn_s_sleep(1); \
    if ((++_sp & 255u) == 0u) { if (xb_ld(&(bar)[XB_TMO])) break; if (_sp > XB_SPIN_CAP) { atomicAdd(&(bar)[XB_TMO], 1u); break; } } } } while (0)
struct XcdBarrier { unsigned* bar; unsigned x; volatile LAS unsigned* st; };
__device__ __forceinline__ XcdBarrier xcd_barrier_post(unsigned* bar, volatile LAS unsigned* st) {
    XcdBarrier b; b.bar = bar; b.x = xb_xcc_id(); b.st = st;
    if (threadIdx.x == 0) (void)xb_add(&bar[XB_XCNT(b.x)], 1u);
    return b;
}
__device__ __forceinline__ void xcd_barrier_complete(unsigned* bar, unsigned x, unsigned& nloc, unsigned& nx) {
    const unsigned G = gridDim.x * gridDim.y * gridDim.z;
    unsigned sum, cnt, mine, sp = 0u;
    for (;;) {
        sum = 0u; cnt = 0u; mine = 0u;
#pragma unroll
        for (unsigned j = 0; j < 16; ++j) { const unsigned c = xb_ld(&bar[XB_XCNT(j)]); sum += c; cnt += (c > 0u) ? 1u : 0u; mine = (j == x) ? c : mine; }
        if (sum == G) break;
        __builtin_amdgcn_s_sleep(1);
        if ((++sp & 255u) == 0u) { if (xb_ld(&bar[XB_TMO])) break; if (sp > XB_SPIN_CAP) { atomicAdd(&bar[XB_TMO], 1u); break; } }
    }
    nloc = mine > 0u ? mine : 1u; nx = cnt > 0u ? cnt : 1u;
}
__device__ __forceinline__ void xcd_barrier(const XcdBarrier& b) {
    asm volatile("s_waitcnt vmcnt(0)" ::: "memory");
    __syncthreads();
    if (threadIdx.x == 0) {
        unsigned* bar = b.bar;
        __builtin_amdgcn_s_waitcnt(0);
        unsigned nloc = b.st[0], nx = b.st[1];
        if (nloc == 0u) { xcd_barrier_complete(bar, b.x, nloc, nx); b.st[0] = nloc; b.st[1] = nx; }
        const unsigned old = xb_add(&bar[XB_XSUB(b.x)], 1u);
        const unsigned gen = old / nloc;
        if (old + 1u == (gen + 1u) * nloc) {
            __builtin_amdgcn_fence(__ATOMIC_RELEASE, "agent");
            asm volatile("s_waitcnt vmcnt(0)" ::: "memory");
            const unsigned og = xb_add(&bar[XB_TOP], 1u);
            const unsigned tg = og / nx;
            if (og + 1u == (tg + 1u) * nx) xb_add(&bar[XB_TOPGEN], 1u);
            else XB_SPIN(xb_ld(&bar[XB_TOPGEN]) == tg, bar);
            __builtin_amdgcn_fence(__ATOMIC_ACQUIRE, "agent");
            xb_add(&bar[XB_XGEN(b.x)], 1u);
            asm volatile("s_waitcnt vmcnt(0)" ::: "memory");
        } else {
            XB_SPIN(xb_ld(&bar[XB_XGEN(b.x)]) == gen, bar);
            __builtin_amdgcn_fence(__ATOMIC_ACQUIRE, "agent");
            asm volatile("s_waitcnt vmcnt(0)" ::: "memory");
        }
    }
    __syncthreads();
}

__global__ void __launch_bounds__(NTHREADS, 2) fwd_megakernel(Params p_arg) {
    extern __shared__ __attribute__((aligned(16))) unsigned char lds_raw[];
    LAS unsigned char* lds = (LAS unsigned char*)lds_raw;
#define PHASE_IDS() int tid = threadIdx.x; asm volatile("" : "+v"(tid)); const int lane = tid & 63, wave = __builtin_amdgcn_readfirstlane(tid >> 6); (void)lane; (void)wave
    const int G = gridDim.x, bx = blockIdx.x;
    typedef const __attribute__((address_space(4))) Params* KParams;
    const KParams kp0 = (KParams)__builtin_amdgcn_kernarg_segment_ptr();
#define PHASE_PTRS() KParams _kp = kp0; asm volatile("" : "+s"(_kp)); Params p; p.x = _kp->x; p.w_in = _kp->w_in; p.b_in = _kp->b_in; p.sinks = _kp->sinks; p.w_out = _kp->w_out; p.b_out = _kp->b_out; p.ln1_g = _kp->ln1_g; p.ln1_b = _kp->ln1_b; \
    p.w_router = _kp->w_router; p.b_router = _kp->b_router; p.w1 = _kp->w1; p.b1 = _kp->b1; p.w2 = _kp->w2; p.b2 = _kp->b2; p.ln2_g = _kp->ln2_g; p.ln2_b = _kp->ln2_b; p.out = _kp->out; p.ws = _kp->ws; unsigned char* const ws = p.ws; \
    unsigned* const ctl = (unsigned*)(ws + WS_CTL); float* const ksum = (float*)(ws + WS_KSUM); float* const rope = (float*)(ws + WS_ROPE); \
    bf16_t* const w_in_t = (bf16_t*)(ws + WS_WIN_T); bf16_t* const w_out_t = (bf16_t*)(ws + WS_WOUT_T); \
    unsigned char* const w1_8 = ws + WS_W1_8; unsigned char* const w2_8 = ws + WS_W2_8; unsigned char* const x1_8 = ws + WS_X1_8; unsigned char* const act8 = ws + WS_ACT8; \
    int* const cnt_blk = (int*)(ws + WS_CNT); int* const tile_e = (int*)(ws + WS_TILE_E); bf16_t* const wr_hi = (bf16_t*)(ws + WS_WR_HI); bf16_t* const wr_lo = (bf16_t*)(ws + WS_WR_LO); \
    int* const tok = (int*)(ws + WS_TOK); int* const asg_e = (int*)(ws + WS_ASG_E); float* const asg_g = (float*)(ws + WS_ASG_G); int* const asg_d = (int*)(ws + WS_ASG_D); \
    bf16_t* const x1b = (bf16_t*)(ws + WS_X1B); bf16_t* const xb = (bf16_t*)(ws + WS_XB); bf16_t* const attn_o = xb; bf16_t* const qkv = (bf16_t*)(ws + WS_QKV); unsigned char* const yb = ws + WS_YB; \
    (void)ctl; (void)ksum; (void)rope; (void)w_in_t; (void)w_out_t; (void)w1_8; (void)w2_8; (void)x1_8; (void)act8; (void)cnt_blk; (void)tile_e; (void)wr_hi; (void)wr_lo; (void)tok; (void)asg_e; (void)asg_g; (void)asg_d; \
    (void)x1b; (void)xb; (void)attn_o; (void)qkv; (void)yb
    if (threadIdx.x < 2) ((LAS unsigned*)(lds + LDS_BARST))[threadIdx.x] = 0u;
    __syncthreads();
    XcdBarrier xbar;
    { PHASE_PTRS(); xbar = xcd_barrier_post(ctl + CW_BAR, (volatile LAS unsigned*)(lds + LDS_BARST)); }

    REP(0) {
        PHASE_IDS(); PHASE_PTRS();
        const long gt = (long)bx * NTHREADS + tid, gsz = (long)G * NTHREADS;
        for (long i = gt; i < 2048 * 32; i += gsz) {
            const int pos = (int)(i >> 5), k = (int)(i & 31);
            double inv = 1.0; for (int q = 0; q < k; ++q) inv *= 0.7498942093324559;
            double s, c; sincos_d((double)pos * inv, s, c);
            rope[pos * 64 + k] = (float)c; rope[pos * 64 + 32 + k] = (float)s;
        }
        for (long i = gt; i < 32 * 1024; i += gsz) {
            const int e = (int)(i >> 10), k = (int)(i & 1023); const float w = p.w_router[k * 32 + e];
            const unsigned h = f2bf(w); wr_hi[i] = (bf16_t)h; wr_lo[i] = (bf16_t)f2bf(w - bf2f(h));
        }
        LAS float* scr = (LAS float*)(lds + wave * 16384);
        const int gw = bx * 8 + wave, NGW = G * 8;
        constexpr int I_IN = 16 * (INW / 32), I_OUT = 16 * 32, I_W1 = 16 * 64, I_W2 = 16 * 32;
        constexpr int NITEMS = I_IN + I_OUT + NE * I_W1 + NE * I_W2;
        for (int it = gw; it < NITEMS; it += NGW) {
            int r = it;
#if INPROJ_FP8
            if (r < I_IN) { p0_transpose_item_fp8(p.w_in, INW, (unsigned char*)w_in_t, 0, WIN_SCALE, scr, r, lane); continue; } r -= I_IN;
#else
            if (r < I_IN) { p0_transpose_item(p.w_in, INW, w_in_t, 0, scr, r, lane); continue; } r -= I_IN;
#endif
            if (r < I_OUT) { p0_transpose_item(p.w_out, 1024, w_out_t, 1, scr, r, lane); continue; } r -= I_OUT;
            if (r < NE * I_W1) { const int e = r / I_W1; p0_transpose_item_fp8(p.w1 + (size_t)e * 1024 * 2048, 2048, w1_8 + (size_t)e * 2048 * 1024, 2, W_SCALE, scr, r % I_W1, lane); continue; } r -= NE * I_W1;
            { const int e = r / I_W2; p0_transpose_item_fp8(p.w2 + (size_t)e * 1024 * 1024, 1024, w2_8 + (size_t)e * 1024 * 1024, 1, W_SCALE, scr, r % I_W2, lane); }
        }
        const f32x4* x4 = (const f32x4*)p.x;
#if INPROJ_FP8
        u32x2* x8 = (u32x2*)xb;
        for (long i = gt; i < (long)T * D / 8; i += gsz) { const f32x4 a = x4[2 * i], b = x4[2 * i + 1];
            u32x2 o; o.x = pk4_fp8(a[0], a[1], a[2], a[3]); o.y = pk4_fp8(b[0], b[1], b[2], b[3]); x8[i] = o; }
#else
        u32x4* xb4 = (u32x4*)xb;
        for (long i = gt; i < (long)T * D / 8; i += gsz) { const f32x4 a = x4[2 * i], b = x4[2 * i + 1];
            u32x4 o; o.x = cvtpk(a[0], a[1]); o.y = cvtpk(a[2], a[3]); o.z = cvtpk(b[0], b[1]); o.w = cvtpk(b[2], b[3]); xb4[i] = o; }
#endif
    }
    xcd_barrier(xbar);

    REP(1) {
        PHASE_PTRS();
#if INPROJ_FP8
        pg8::SchedInProj<1024> S{(const char*)xb, (const char*)w_in_t, G, bx};
        pg8::EpiInProj E{qkv, p.b_in, rope, ksum, 1.0f / WIN_SCALE};
        pg8::gemm_phase<pg8::EpiInProj, pg8::SchedInProj<1024>, false, true, 512, true>(lds, S, E);
#else
        pg8::SchedInProj<2048> S{(const char*)xb, (const char*)w_in_t, G, bx};
        pg8::EpiInProj E{qkv, p.b_in, rope, ksum, 1.0f};
        pg8::gemm_phase<pg8::EpiInProj, pg8::SchedInProj<2048>, false, true>(lds, S, E);
#endif
    }
    xcd_barrier(xbar);

    REP(2) for (int u = bx; u < 256; u += G) {
        PHASE_PTRS();
        { const int b = u >> 3, h = u & 7;
            for (int j = 0; j < 8; ++j) att::attn_item<true>((char*)lds_raw, qkv, attn_o, b, h, j, p.sinks, ksum); }
        { const int b = u >> 3, kvh = (u >> 2) & 1, oct = u & 3;
            for (int i = 0; i < 8; ++i) att::attn_item<false>((char*)lds_raw, qkv, attn_o, b, kvh, oct * 8 + i, p.sinks, ksum); }
    }
    xcd_barrier(xbar);

    REP(3) for (int pm = bx; pm < T / 256; pm += G) {
        PHASE_IDS(); PHASE_PTRS();
        {
            pg8::SchedPanel S{(const char*)attn_o, (const char*)w_out_t, pm};
            pg8::EpiOutProj E{(bf16_t*)p.out, p.b_out, p.x};
            pg8::gemm_phase<pg8::EpiOutProj, pg8::SchedPanel, false, true>(lds, S, E);
        }
        __syncthreads();
        {
#pragma unroll
            for (int i = 0; i < 16; ++i) { const int idx = tid + 512 * i, mat = idx >> 12, rw = (idx >> 7) & 31, ch = idx & 127;
                const u32x4 v = *(const u32x4*)((mat ? wr_lo : wr_hi) + rw * 1024 + ch * 8);
                *(LAS u32x4*)(lds + mat * 66048 + rw * 2064 + ch * 16) = v; }
        }
        {
            const bf16_t* ytmp = (const bf16_t*)p.out;
            f32x4 gg[2][2], bb[2][2];
#pragma unroll
            for (int j = 0; j < 2; ++j)
#pragma unroll
                for (int h = 0; h < 2; ++h) { gg[j][h] = *(const f32x4*)(p.ln1_g + 512 * j + 8 * lane + 4 * h); bb[j][h] = *(const f32x4*)(p.ln1_b + 512 * j + 8 * lane + 4 * h); }
            for (int rr = 0; rr < 32; rr += 4) {
                const size_t row0 = (size_t)pm * 256 + wave * 32 + rr;
                u32x4 raw[4][2]; float v[4][2][8]; float sm[4], sq[4];
#pragma unroll
                for (int q = 0; q < 4; ++q)
#pragma unroll
                    for (int j = 0; j < 2; ++j) raw[q][j] = *(const u32x4*)(ytmp + (row0 + q) * D + 512 * j + 8 * lane);
#pragma unroll
                for (int q = 0; q < 4; ++q) { float s_ = 0.f;
#pragma unroll
                    for (int j = 0; j < 2; ++j)
#pragma unroll
                        for (int c = 0; c < 4; ++c) { const unsigned w = raw[q][j][c]; v[q][j][2 * c] = bf2f(w & 0xffffu); v[q][j][2 * c + 1] = bf2f(w >> 16); s_ += v[q][j][2 * c] + v[q][j][2 * c + 1]; }
                    sm[q] = s_; }
#pragma unroll
                for (int o = 1; o < 64; o <<= 1) {
#pragma unroll
                    for (int q = 0; q < 4; ++q) sm[q] += __shfl_xor(sm[q], o); }
#pragma unroll
                for (int q = 0; q < 4; ++q) { const float mean = sm[q] * (1.0f / D); float s2 = 0.f;
#pragma unroll
                    for (int j = 0; j < 2; ++j)
#pragma unroll
                        for (int c = 0; c < 8; ++c) { v[q][j][c] -= mean; s2 += v[q][j][c] * v[q][j][c]; }
                    sq[q] = s2; }
#pragma unroll
                for (int o = 1; o < 64; o <<= 1) {
#pragma unroll
                    for (int q = 0; q < 4; ++q) sq[q] += __shfl_xor(sq[q], o); }
#pragma unroll
                for (int q = 0; q < 4; ++q) {
                    const float rstd = 1.0f / sqrtf(sq[q] * (1.0f / D) + LN_EPS);
#pragma unroll
                    for (int j = 0; j < 2; ++j) {
                        float xv[8];
#pragma unroll
                        for (int c = 0; c < 8; ++c) xv[c] = v[q][j][c] * rstd * gg[j][c >> 2][c & 3] + bb[j][c >> 2][c & 3];
                        u32x4 hv; hv.x = cvtpk(xv[0], xv[1]); hv.y = cvtpk(xv[2], xv[3]); hv.z = cvtpk(xv[4], xv[5]); hv.w = cvtpk(xv[6], xv[7]);
                        u32x2 fv; fv.x = pk4_fp8(xv[0], xv[1], xv[2], xv[3]); fv.y = pk4_fp8(xv[4], xv[5], xv[6], xv[7]);
                        *(u32x4*)(x1b + (row0 + q) * D + 512 * j + 8 * lane) = hv;
                        *(u32x2*)(x1_8 + (row0 + q) * D + 512 * j + 8 * lane) = fv;
                    }
                }
            }
        }
        __syncthreads();
        {
            const int fr = lane & 15, fq = lane >> 4;
            f32x4 lacc[2][2];
#pragma unroll
            for (int m = 0; m < 2; ++m)
#pragma unroll
                for (int n = 0; n < 2; ++n) lacc[m][n] = (f32x4){0.f, 0.f, 0.f, 0.f};
            const size_t r0 = (size_t)pm * 256 + wave * 32;
            const bf16_t* ah = x1b + (r0 + fr) * D + 8 * fq;
            const LAS unsigned char* bh = lds + fr * 2064 + 16 * fq; const LAS unsigned char* bl = bh + 66048;
#pragma unroll 4
            for (int k0 = 0; k0 < 1024; k0 += 32) {
                bf16x8 a_hi[2], b_hi[2], b_lo[2];
#pragma unroll
                for (int m = 0; m < 2; ++m) a_hi[m] = *(const bf16x8*)(ah + (size_t)m * 16 * D + k0);
#pragma unroll
                for (int n = 0; n < 2; ++n) { b_hi[n] = *(const LAS bf16x8*)(bh + n * 16 * 2064 + k0 * 2); b_lo[n] = *(const LAS bf16x8*)(bl + n * 16 * 2064 + k0 * 2); }
#pragma unroll
                for (int m = 0; m < 2; ++m)
#pragma unroll
                    for (int n = 0; n < 2; ++n) {
                        lacc[m][n] = __builtin_amdgcn_mfma_f32_16x16x32_bf16(a_hi[m], b_hi[n], lacc[m][n], 0, 0, 0);
                        lacc[m][n] = __builtin_amdgcn_mfma_f32_16x16x32_bf16(a_hi[m], b_lo[n], lacc[m][n], 0, 0, 0);
                    }
            }
            __syncthreads();
            LAS float* lg = (LAS float*)lds;
#pragma unroll
            for (int m = 0; m < 2; ++m)
#pragma unroll
                for (int n = 0; n < 2; ++n)
#pragma unroll
                    for (int rg = 0; rg < 4; ++rg) lg[(wave * 32 + 16 * m + 4 * fq + rg) * 33 + 16 * n + fr] = lacc[m][n][rg];
        }
        __syncthreads();
        {
            LAS float* lg = (LAS float*)lds;
            LAS int* wcnt = (LAS int*)(lds + 36864);
            float t0 = -INFINITY, t1 = -INFINITY, t2 = -INFINITY, t3 = -INFINITY; int i0 = 0, i1 = 0, i2 = 0, i3 = 0;
            int rk0 = 0, rk1 = 0, rk2 = 0, rk3 = 0;
            if (tid < 256) {
                for (int e = 0; e < NE; ++e) {
                    const float xv = lg[tid * 33 + e] + p.b_router[e];
                    if (xv > t3) {
                        if (xv > t2) { t3 = t2; i3 = i2;
                            if (xv > t1) { t2 = t1; i2 = i1;
                                if (xv > t0) { t1 = t0; i1 = i0; t0 = xv; i0 = e; } else { t1 = xv; i1 = e; }
                            } else { t2 = xv; i2 = e; }
                        } else { t3 = xv; i3 = e; }
                    }
                }
                const unsigned selm = (1u << i0) | (1u << i1) | (1u << i2) | (1u << i3);
                for (int e = 0; e < NE; ++e) {
                    const bool has = ((selm >> e) & 1u) != 0u;
                    const unsigned long long bal = __ballot(has);
                    const int pre = __popcll(bal & ((1ull << lane) - 1ull));
                    if (e == i0) rk0 = pre; if (e == i1) rk1 = pre; if (e == i2) rk2 = pre; if (e == i3) rk3 = pre;
                    if (lane == 0) wcnt[wave * 32 + e] = __popcll(bal);
                }
            }
            __syncthreads();
            if (tid < 256) {
                const float e1 = __expf(t1 - t0), e2 = __expf(t2 - t0), e3 = __expf(t3 - t0);
                const float inv = 1.0f / (1.0f + e1 + e2 + e3);
                int b0 = 0, b1 = 0, b2 = 0, b3 = 0;
                for (int w = 0; w < wave; ++w) { b0 += wcnt[w * 32 + i0]; b1 += wcnt[w * 32 + i1]; b2 += wcnt[w * 32 + i2]; b3 += wcnt[w * 32 + i3]; }
                const size_t a = ((size_t)pm * 256 + tid) * 4;
                *(int4*)(asg_e + a) = make_int4(i0, i1, i2, i3);
                *(float4*)(asg_g + a) = make_float4(inv, e1 * inv, e2 * inv, e3 * inv);
                *(int4*)(asg_d + a) = make_int4(b0 + rk0, b1 + rk1, b2 + rk2, b3 + rk3);
            }
            if (tid < 32) cnt_blk[pm * 32 + tid] = wcnt[tid] + wcnt[32 + tid] + wcnt[64 + tid] + wcnt[96 + tid];
            __syncthreads();
        }
    }
    xcd_barrier(xbar);

    for (int pm = bx; pm < T / 256; pm += G) {
        PHASE_IDS(); PHASE_PTRS();
        LAS int* part_all = (LAS int*)lds; LAS int* part_pre = part_all + 512; LAS int* tot = part_pre + 512; LAS int* pre = tot + 32; LAS int* poff = pre + 32;
        { const int e = tid & 31, seg = tid >> 5; int sa = 0, sp = 0;
            for (int bb = seg * 16; bb < seg * 16 + 16; ++bb) { const int c = cnt_blk[bb * 32 + e]; sa += c; sp += (bb < pm) ? c : 0; }
            part_all[tid] = sa; part_pre[tid] = sp; }
        __syncthreads();
        if (tid < 32) { int sa = 0, sp = 0; for (int s = 0; s < 16; ++s) { sa += part_all[s * 32 + tid]; sp += part_pre[s * 32 + tid]; } tot[tid] = sa; pre[tid] = sp; }
        __syncthreads();
        if (tid == 0) { int off = 0; for (int e = 0; e < NE; ++e) { poff[e] = off; off += ((tot[e] + 255) >> 8) << 8; } poff[32] = off; }
        __syncthreads();
        if (tid < 256) {
            const int token = pm * 256 + tid; const size_t a = (size_t)token * 4;
            const int4 ee = *(const int4*)(asg_e + a); const int4 rk = *(const int4*)(asg_d + a);
            const int d0 = poff[ee.x] + pre[ee.x] + rk.x, d1 = poff[ee.y] + pre[ee.y] + rk.y, d2 = poff[ee.z] + pre[ee.z] + rk.z, d3 = poff[ee.w] + pre[ee.w] + rk.w;
            *(int4*)(asg_d + a) = make_int4(d0, d1, d2, d3);
            tok[d0] = token; tok[d1] = token; tok[d2] = token; tok[d3] = token;
        }
        if (pm < NE) {
            const int e = pm, n = tot[e], np = ((n + 255) >> 8) << 8, o = poff[e];
            for (int i = n + tid; i < np; i += NTHREADS) tok[o + i] = 0;
            for (int i = tid; i < (np >> 8); i += NTHREADS) tile_e[(o >> 8) + i] = e;
        }
        if (pm == 0 && tid == 0) ctl[CW_NTILES] = (unsigned)(poff[32] >> 8);
        __syncthreads();
    }
    xcd_barrier(xbar);

    REP(5) {
        PHASE_PTRS(); const int ntiles = (int)ctl[CW_NTILES];
        { LAS int* tl = (LAS int*)(lds + LDSX_TILE); for (int i = threadIdx.x; i < ntiles; i += NTHREADS) tl[i] = tile_e[i]; __syncthreads(); }
        pg8::SchedMoe<8, true> S{(const char*)x1_8, (const char*)w1_8, (const LAS int*)(lds + LDSX_TILE), tok, ntiles, G, bx};
        pg8::EpiSwiglu E{act8, p.b1};
        pg8::gemm_phase<pg8::EpiSwiglu, pg8::SchedMoe<8, true>, true, true, 512, true, true>(lds, S, E);
    }
    xcd_barrier(xbar);

    REP(6) {
        PHASE_PTRS(); const int ntiles = (int)ctl[CW_NTILES];
        { LAS int* tl = (LAS int*)(lds + LDSX_TILE); for (int i = threadIdx.x; i < ntiles; i += NTHREADS) tl[i] = tile_e[i]; __syncthreads(); }
        pg8::SchedMoe<4, false> S{(const char*)act8, (const char*)w2_8, (const LAS int*)(lds + LDSX_TILE), tok, ntiles, G, bx};
        pg8::EpiDown E{yb, p.b2};
        pg8::gemm_phase<pg8::EpiDown, pg8::SchedMoe<4, false>, false, true, 512, true, true>(lds, S, E);
    }
    xcd_barrier(xbar);

    REP(7) {
        PHASE_IDS(); PHASE_PTRS();
        const int gw = bx * 8 + wave, NGW = G * 8;
        f32x4 gg[2][2], bb[2][2];
#pragma unroll
        for (int j = 0; j < 2; ++j)
#pragma unroll
            for (int h = 0; h < 2; ++h) { gg[j][h] = *(const f32x4*)(p.ln2_g + 512 * j + 8 * lane + 4 * h); bb[j][h] = *(const f32x4*)(p.ln2_b + 512 * j + 8 * lane + 4 * h); }
        constexpr int R = 2;
        for (int row0 = gw; row0 < T; row0 += R * NGW) {
            int4 dd[R]; float4 gt[R];
#pragma unroll
            for (int q = 0; q < R; ++q) { const int row = row0 + q * NGW < T ? row0 + q * NGW : row0; dd[q] = *(const int4*)(asg_d + (size_t)row * 4); gt[q] = *(const float4*)(asg_g + (size_t)row * 4); }
            u32x4 xr[R][2]; u32x2 yk[R][4][2];
#pragma unroll
            for (int q = 0; q < R; ++q) { const int row = row0 + q * NGW < T ? row0 + q * NGW : row0;
#pragma unroll
                for (int j = 0; j < 2; ++j) {
                    xr[q][j] = *(const u32x4*)(x1b + (size_t)row * D + 512 * j + 8 * lane);
                    yk[q][0][j] = *(const u32x2*)(yb + (size_t)dd[q].x * D + 512 * j + 8 * lane);
                    yk[q][1][j] = *(const u32x2*)(yb + (size_t)dd[q].y * D + 512 * j + 8 * lane);
                    yk[q][2][j] = *(const u32x2*)(yb + (size_t)dd[q].z * D + 512 * j + 8 * lane);
                    yk[q][3][j] = *(const u32x2*)(yb + (size_t)dd[q].w * D + 512 * j + 8 * lane);
                } }
            float z[R][2][8]; float sm[R], sq[R];
#pragma unroll
            for (int q = 0; q < R; ++q) {
                const float g0 = gt[q].x * (1.0f / Y_SCALE), g1 = gt[q].y * (1.0f / Y_SCALE), g2 = gt[q].z * (1.0f / Y_SCALE), g3 = gt[q].w * (1.0f / Y_SCALE);
                float s_ = 0.f;
#pragma unroll
                for (int j = 0; j < 2; ++j)
#pragma unroll
                    for (int d = 0; d < 2; ++d) {
#define P7_PAIR(HH, SEL) do { \
                            const f32x2 a0 = __builtin_amdgcn_cvt_pk_f32_fp8((int)yk[q][0][j][d], SEL), a1 = __builtin_amdgcn_cvt_pk_f32_fp8((int)yk[q][1][j][d], SEL); \
                            const f32x2 a2 = __builtin_amdgcn_cvt_pk_f32_fp8((int)yk[q][2][j][d], SEL), a3 = __builtin_amdgcn_cvt_pk_f32_fp8((int)yk[q][3][j][d], SEL); \
                            const unsigned xw = xr[q][j][2 * d + HH]; \
                            const float lo = DN_ALPHA * bf2f(xw & 0xffffu) + g0 * a0.x + g1 * a1.x + g2 * a2.x + g3 * a3.x; \
                            const float hi = DN_ALPHA * bf2f(xw >> 16) + g0 * a0.y + g1 * a1.y + g2 * a2.y + g3 * a3.y; \
                            z[q][j][4 * d + 2 * HH] = lo; z[q][j][4 * d + 2 * HH + 1] = hi; s_ += lo + hi; } while (0)
                        P7_PAIR(0, false); P7_PAIR(1, true);
#undef P7_PAIR
                    }
                sm[q] = s_;
            }
#pragma unroll
            for (int o = 1; o < 64; o <<= 1) {
#pragma unroll
                for (int q = 0; q < R; ++q) sm[q] += __shfl_xor(sm[q], o); }
#pragma unroll
            for (int q = 0; q < R; ++q) { const float mean = sm[q] * (1.0f / D); float s2 = 0.f;
#pragma unroll
                for (int j = 0; j < 2; ++j)
#pragma unroll
                    for (int c = 0; c < 8; ++c) { z[q][j][c] -= mean; s2 += z[q][j][c] * z[q][j][c]; }
                sq[q] = s2; }
#pragma unroll
            for (int o = 1; o < 64; o <<= 1) {
#pragma unroll
                for (int q = 0; q < R; ++q) sq[q] += __shfl_xor(sq[q], o); }
#pragma unroll
            for (int q = 0; q < R; ++q) {
                const int row = row0 + q * NGW;
                if (row < T) {
                    const float rstd = 1.0f / sqrtf(sq[q] * (1.0f / D) + LN_EPS);
#pragma unroll
                    for (int j = 0; j < 2; ++j)
#pragma unroll
                        for (int h = 0; h < 2; ++h) {
                            f32x4 o;
#pragma unroll
                            for (int c = 0; c < 4; ++c) o[c] = z[q][j][4 * h + c] * rstd * gg[j][h][c] + bb[j][h][c];
                            *(f32x4*)(p.out + (size_t)row * D + 512 * j + 8 * lane + 4 * h) = o;
                        }
                }
            }
        }
    }
}

extern "C" void kernel_launch(void* const* d_in, const int* in_sizes, int n_in, void* d_out, int out_size, void* d_ws, size_t ws_size, hipStream_t stream) {
    static int grid_blocks = 0;
    if (grid_blocks == 0) {
        if (n_in != 16 || in_sizes[0] != T * D || out_size != T * D || ws_size < WS_END) {
            fprintf(stderr, "kernel_launch: unexpected shapes: n_in %d in0 %d out %d ws %zu (need %zu)\n", n_in, n_in > 0 ? in_sizes[0] : -1, out_size, ws_size, (size_t)WS_END); grid_blocks = -1; return; }
        int dev = 0, cus = 0, per_cu = 0;
        (void)hipGetDevice(&dev);
        (void)hipDeviceGetAttribute(&cus, hipDeviceAttributeMultiprocessorCount, dev);
        (void)hipFuncSetAttribute((const void*)fwd_megakernel, hipFuncAttributeMaxDynamicSharedMemorySize, LDS_BYTES);
        (void)hipOccupancyMaxActiveBlocksPerMultiprocessor(&per_cu, (const void*)fwd_megakernel, NTHREADS, LDS_BYTES);
        if (per_cu < 1) { fprintf(stderr, "kernel_launch: occupancy query reports %d blocks per CU\n", per_cu); per_cu = 1; }
        grid_blocks = cus;
        fprintf(stderr, "kernel_launch: cus=%d per_cu=%d grid=%d ws=%zu\n", cus, per_cu, grid_blocks, ws_size);
    }
    if (grid_blocks < 0) return;
    (void)hipMemsetAsync((char*)d_ws + WS_CTL, 0, CTL_ZERO_BYTES, stream);
    Params p{};
    p.x = (const float*)d_in[0]; p.w_in = (const float*)d_in[1]; p.b_in = (const float*)d_in[2]; p.sinks = (const float*)d_in[3]; p.w_out = (const float*)d_in[4]; p.b_out = (const float*)d_in[5];
    p.ln1_g = (const float*)d_in[6]; p.ln1_b = (const float*)d_in[7]; p.w_router = (const float*)d_in[8]; p.b_router = (const float*)d_in[9];
    p.w1 = (const float*)d_in[10]; p.b1 = (const float*)d_in[11]; p.w2 = (const float*)d_in[12]; p.b2 = (const float*)d_in[13]; p.ln2_g = (const float*)d_in[14]; p.ln2_b = (const float*)d_in[15];
    p.out = (float*)d_out; p.ws = (unsigned char*)d_ws;
    hipLaunchKernelGGL(fwd_megakernel, dim3(grid_blocks), dim3(NTHREADS), LDS_BYTES, stream, p);
    hipError_t e = hipPeekAtLastError();
    if (e != hipSuccess) fprintf(stderr, "launch failed: %s (grid %d)\n", hipGetErrorString(e), grid_blocks);
}
```

```cpp
#include <hip/hip_runtime.h>
#include <cstdio>
#include <cstdint>

#define LAS __attribute__((address_space(3)))
typedef unsigned short bf16_t;
typedef short bf16x8 __attribute__((ext_vector_type(8)));
typedef short s16x4 __attribute__((ext_vector_type(4)));
typedef float f32x2 __attribute__((ext_vector_type(2)));
typedef float f32x4 __attribute__((ext_vector_type(4)));
typedef float f32x16 __attribute__((ext_vector_type(16)));
typedef unsigned u32x2 __attribute__((ext_vector_type(2)));
typedef unsigned u32x4 __attribute__((ext_vector_type(4)));
typedef __bf16 bf16x2_t __attribute__((ext_vector_type(2)));

constexpr int D = 1024, BATCH = 32, SEQ = 2048, T = BATCH * SEQ;
constexpr int INW = 2304, NE = 32;
constexpr float LN_EPS = 1e-5f;
constexpr float DN_ALPHA = 1.189207115002721f;
constexpr float LOG2E = 1.4426950408889634f;
constexpr float C2 = 0.18033688011112042f;
constexpr int NTHREADS = 512;
constexpr int LDS_BYTES = 147456;
constexpr int MAX_TILES = 1056;
#ifndef INPROJ_FP8
#define INPROJ_FP8 1
#endif
#ifndef EPI_DUP
#define EPI_DUP 0
#endif
#ifndef DUP_MASK
#define DUP_MASK 0
#endif
#define REP(k) for (int _rep = 0; _rep < (((DUP_MASK >> (k)) & 1) ? 2 : 1); ++_rep)

constexpr size_t MiB = 1u << 20;
constexpr size_t WS_CTL = 0, CTL_ZERO_BYTES = 2 * MiB;
constexpr size_t WS_KSUM = 1 * MiB;
constexpr size_t WS_ROPE = 2 * MiB;
constexpr size_t WS_WIN_T = 4 * MiB;
constexpr size_t WS_WOUT_T = 9 * MiB;
constexpr size_t WS_SMALL = 11 * MiB;
constexpr size_t WS_CNT = WS_SMALL, WS_TILE_E = WS_SMALL + 65536, WS_WR_HI = WS_SMALL + 131072, WS_WR_LO = WS_WR_HI + 65536;
constexpr size_t WS_TOK = 12 * MiB;
constexpr size_t WS_ASG_E = 14 * MiB, WS_ASG_G = 15 * MiB, WS_ASG_D = 16 * MiB;
constexpr size_t WS_W2_8 = 24 * MiB;
constexpr size_t WS_X1B = 56 * MiB;
constexpr size_t WS_ACT8 = 184 * MiB;
constexpr size_t WS_XB = 184 * MiB;
constexpr size_t WS_X1LO = 312 * MiB;
constexpr size_t WS_YB = 488 * MiB;
constexpr size_t WS_W1_8 = 488 * MiB;
constexpr size_t WS_X1_8 = 552 * MiB;
constexpr size_t WS_QKV = 616 * MiB;
constexpr size_t WS_END = 1016 * MiB;
constexpr float W_SCALE = 64.0f, ACT_SCALE = 4.0f, WIN_SCALE = 32.0f, Y_SCALE = 16.0f;
constexpr int CW_NTILES = 16, CW_BAR = 4096;
constexpr int LDSX_TILE = 131072, LDSX_IDX = 135424, LDSX_BIAS = 136448;
constexpr int LDS_BARST = LDS_BYTES - 256;

struct Params {
    const float *x, *w_in, *b_in, *sinks, *w_out, *b_out, *ln1_g, *ln1_b, *w_router, *b_router, *w1, *b1, *w2, *b2, *ln2_g, *ln2_b;
    float* out; unsigned char* ws;
};

__device__ __forceinline__ unsigned f2bf(float f) { unsigned u = __builtin_bit_cast(unsigned, f); return (u + 0x7fffu + ((u >> 16) & 1u)) >> 16; }
__device__ __forceinline__ float bf2f(unsigned h) { return __builtin_bit_cast(float, h << 16); }
__device__ __forceinline__ unsigned cvtpk(float lo, float hi) { f32x2 v = {lo, hi}; bf16x2_t b = __builtin_convertvector(v, bf16x2_t); return __builtin_bit_cast(unsigned, b); }
__device__ __forceinline__ unsigned pk4_fp8(float a, float b, float c, float d) { int w = 0; w = __builtin_amdgcn_cvt_pk_fp8_f32(a, b, w, false); w = __builtin_amdgcn_cvt_pk_fp8_f32(c, d, w, true); return (unsigned)w; }
__device__ __forceinline__ float wave_sum(float v) {
#pragma unroll
    for (int o = 1; o < 64; o <<= 1) v += __shfl_xor(v, o);
    return v;
}
#define LDS_WAIT() asm volatile("s_waitcnt lgkmcnt(0)" ::: "memory")
__device__ __forceinline__ int tid_of(int wave_s) { unsigned z = 0u; asm volatile("" : "+v"(z));
    return wave_s * 64 + (int)__builtin_amdgcn_mbcnt_hi(~0u, __builtin_amdgcn_mbcnt_lo(~0u, z)); }
template <int X> __device__ __forceinline__ float swz_xor(float v) { return __builtin_bit_cast(float, __builtin_amdgcn_ds_swizzle(__builtin_bit_cast(int, v), (X << 10) | 0x1f)); }

namespace pg8 {
constexpr int BM = 256, BK = 64, HALF = 128, HTB = HALF * BK * 2, STAGE_BYTES = 8 * HTB, NXCD = 8, WGM = 8;
constexpr int KD = 1024;
__host__ __device__ __forceinline__ int lds_byte(int r, int c) { const int st = (r >> 4) * 2 + (c >> 5), rr = r & 15, cc = c & 31, ob = rr * 64 + cc * 2; return st * 1024 + (ob ^ (((ob >> 9) & 1) << 5)); }
__host__ __device__ __forceinline__ void stage_rc(int b, int& R, int& C) { const int st = b / 1024, sb = b % 1024, swz = sb ^ (((sb >> 9) & 1) << 5); R = (st >> 1) * 16 + swz / 64; C = (st & 1) * 32 + (swz % 64) / 2; }
__host__ __device__ __forceinline__ int perm32(int rho) { const int n = rho >> 4, i = rho & 15; return 8 * (i >> 2) + 4 * n + (i & 3); }

struct Unit { int pm, pn, e; unsigned ao, bo; const int* rows; };

typedef int v8i32_t __attribute__((ext_vector_type(8)));
typedef int v4i32_t __attribute__((ext_vector_type(4)));
__device__ __forceinline__ v8i32_t cat8(bf16x8 a, bf16x8 b) { const v4i32_t x = __builtin_bit_cast(v4i32_t, a), y = __builtin_bit_cast(v4i32_t, b); return __builtin_shufflevector(x, y, 0, 1, 2, 3, 4, 5, 6, 7); }
template <class Epi, class Sched, bool GATHER, bool ALIGN_EPI, int KP = 1024, bool FP8 = false, bool MOE = false>
__device__ __forceinline__ void gemm_phase(LAS unsigned char* lds, const Sched& S, const Epi& E, const int wave_s) {
    int tid = tid_of(wave_s); asm volatile("" : "+v"(tid));
    const int wid = __builtin_amdgcn_readfirstlane(tid >> 6), lane = tid & 63, wr = wid >> 2, wc = wid & 3, fr = lane & 15, fq = lane >> 4;
    constexpr int K = KP, nt = K / BK;
    unsigned voffB[2], Vc[2][2]; int stR0, stC0;
    { int R, C; stage_rc(tid * 16, R, C); stR0 = R; stC0 = C; }
#pragma unroll
    for (int i = 0; i < 2; ++i) { voffB[i] = (unsigned)((stR0 + 64 * i) * K + stC0) * 2u; Vc[0][i] = voffB[i]; Vc[1][i] = voffB[i]; }
#define PG8_GATHER_LOAD(VV) do { int _t = tid_of(wave_s); asm volatile("" : "+v"(_t)); int _R, _C; stage_rc(_t * 16, _R, _C);     \
        const LAS int* _rp = (const LAS int*)(lds + LDSX_IDX) + _R; _Pragma("unroll") for (int _h = 0; _h < 2; ++_h) _Pragma("unroll") for (int _i = 0; _i < 2; ++_i) \
        VV[_h][_i] = ((unsigned)_rp[128 * _h + 64 * _i] * (unsigned)K + (unsigned)_C) * 2u; } while (0)
#define PG8_DMA4(gsrc, ldsoff) __builtin_amdgcn_global_load_lds((const unsigned*)(gsrc), (LAS unsigned*)(lds + (ldsoff)), 4, 0, 0)
    constexpr unsigned kstep = (unsigned)(BK * 2);
    constexpr unsigned hstep = (unsigned)HALF * K * 2;
    const char* const Abase = S.A; const char* const Bbase = S.B;
    const unsigned ldsw = (unsigned)wid * 1024u;
    const int aoff = lds_byte(wr * 64 + fr, fq * 8), boff = lds_byte(wc * 32 + fr, fq * 8);
#define PG8_SA(b, h) (((b) * 2 + (h)) * HTB)
#define PG8_SB(b, h) ((4 + (b) * 2 + (h)) * HTB)
#define PG8_STAGE(bufoff, gbase, soff, voff) do { _Pragma("unroll") for (int _i = 0; _i < 2; ++_i) \
        __builtin_amdgcn_global_load_lds((const unsigned*)((gbase) + (unsigned)((voff)[_i] + (soff))), (LAS unsigned*)(lds + (bufoff) + ldsw + _i * 8192), 16, 0, 0); } while (0)
#define PG8_STAGE_B(bufoff, soff) PG8_STAGE(bufoff, Bbase, soff, voffB)
#define PG8_STAGE_A(bufoff, soff, h, VV) do { if constexpr (GATHER) { PG8_STAGE(bufoff, Abase, soff, VV[h]); } else { PG8_STAGE(bufoff, Abase, (soff) + (h) * hstep, voffB); } } while (0)
#define PG8_LDA(dst, b, h) do { _Pragma("unroll") for (int m = 0; m < 4; ++m) dst[m] = cat8(*(const LAS bf16x8*)(lds + PG8_SA(b, h) + aoff + m * 2048), *(const LAS bf16x8*)(lds + PG8_SA(b, h) + aoff + m * 2048 + 1024)); } while (0)
#define PG8_LDB(dst, b, h) do { _Pragma("unroll") for (int n = 0; n < 2; ++n) dst[n] = cat8(*(const LAS bf16x8*)(lds + PG8_SB(b, h) + boff + n * 2048), *(const LAS bf16x8*)(lds + PG8_SB(b, h) + boff + n * 2048 + 1024)); } while (0)
#define PG8_LO(v) __builtin_bit_cast(bf16x8, __builtin_shufflevector(v, v, 0, 1, 2, 3))
#define PG8_HI(v) __builtin_bit_cast(bf16x8, __builtin_shufflevector(v, v, 4, 5, 6, 7))
#define PG8_MMA(ai, bj, At, Bt) do { __builtin_amdgcn_s_setprio(1); _Pragma("unroll") for (int m = 0; m < 4; ++m) _Pragma("unroll") for (int n = 0; n < 2; ++n) { \
        if constexpr (FP8) { acc[ai][bj][m][n] = __builtin_amdgcn_mfma_scale_f32_16x16x128_f8f6f4(Bt[n], At[m], acc[ai][bj][m][n], 0, 0, 0, 0x7f7f7f7f, 0, 0x7f7f7f7f); } \
        else { acc[ai][bj][m][n] = __builtin_amdgcn_mfma_f32_16x16x32_bf16(PG8_LO(Bt[n]), PG8_LO(At[m]), acc[ai][bj][m][n], 0, 0, 0); \
               acc[ai][bj][m][n] = __builtin_amdgcn_mfma_f32_16x16x32_bf16(PG8_HI(Bt[n]), PG8_HI(At[m]), acc[ai][bj][m][n], 0, 0, 0); } } \
        __builtin_amdgcn_s_setprio(0); } while (0)
#define PG8_WAIT_V(n) asm volatile("s_waitcnt vmcnt(" #n ")" ::: "memory")
#define PG8_WAIT_L(n) asm volatile("s_waitcnt lgkmcnt(" #n ")" ::: "memory")
#define PG8_BAR __builtin_amdgcn_s_barrier()
#define PG8_SCHED __builtin_amdgcn_sched_barrier(0)
    Unit cur, nxt; int ui = 0;
    if (!S.next(0, cur)) return;
    if constexpr (MOE) {
        if (wid < 4) { PG8_DMA4(E.bias_src(cur) + wid * 64 + lane, LDSX_BIAS + wid * 256); if constexpr (GATHER) PG8_DMA4(cur.rows + wid * 64 + lane, LDSX_IDX + wid * 256); }
        asm volatile("s_waitcnt vmcnt(0)" ::: "memory"); __builtin_amdgcn_s_barrier(); asm volatile("" ::: "memory");
    }
    if constexpr (GATHER) { PG8_GATHER_LOAD(Vc); }
    f32x4 acc[2][2][4][2];
#pragma unroll
    for (int a = 0; a < 2; ++a)
#pragma unroll
        for (int b = 0; b < 2; ++b)
#pragma unroll
            for (int m = 0; m < 4; ++m)
#pragma unroll
                for (int n = 0; n < 2; ++n) acc[a][b][m][n] = (f32x4){0.f, 0.f, 0.f, 0.f};
    v8i32_t At[4], B0[2], B1[2];
    unsigned cA = cur.ao, cB = cur.bo;
    PG8_STAGE_B(PG8_SB(0, 0), cB); PG8_STAGE_B(PG8_SB(0, 1), cB + hstep); PG8_STAGE_A(PG8_SA(0, 0), cA, 0, Vc); PG8_STAGE_A(PG8_SA(0, 1), cA, 1, Vc);
    if (wr == 1) PG8_BAR;
    PG8_WAIT_V(2); PG8_BAR;
    PG8_STAGE_B(PG8_SB(1, 0), cB + kstep); PG8_STAGE_A(PG8_SA(1, 0), cA + kstep, 0, Vc); PG8_STAGE_B(PG8_SB(1, 1), cB + hstep + kstep);
    PG8_WAIT_V(6); PG8_BAR;
    for (;;) {
        const bool has_next = S.next(ui + 1, nxt);
        const unsigned nA = has_next ? nxt.ao : cA; const unsigned nB = has_next ? nxt.bo : cB;
        if constexpr (MOE) {
            if (has_next && wid < 4) { PG8_DMA4(E.bias_src(nxt) + wid * 64 + lane, LDSX_BIAS + ((ui + 1) % 3) * 1024 + wid * 256); if constexpr (GATHER) PG8_DMA4(nxt.rows + wid * 64 + lane, LDSX_IDX + wid * 256); }
        }
#pragma unroll 1
        for (int t = 0; t < nt; t += 2) {
            const bool last = (t == nt - 2);
            const unsigned a1 = cA + (unsigned)(t + 1) * kstep;
            const unsigned a2 = last ? nA : cA + (unsigned)(t + 2) * kstep; const unsigned b2 = last ? nB : cB + (unsigned)(t + 2) * kstep;
            const unsigned a3 = a2 + kstep; const unsigned b3 = b2 + kstep;
            PG8_LDB(B0, 0, 0); PG8_LDB(B1, 0, 1); PG8_SCHED; PG8_LDA(At, 0, 0); PG8_STAGE_A(PG8_SA(1, 1), a1, 1, Vc);
            if constexpr (GATHER) { if (last && has_next) { PG8_GATHER_LOAD(Vc); } }
            PG8_WAIT_V(8); PG8_WAIT_L(0); PG8_BAR; PG8_MMA(0, 0, At, B0); PG8_MMA(0, 1, At, B1); PG8_BAR; PG8_SCHED;
            PG8_LDA(At, 0, 1); PG8_STAGE_B(PG8_SB(0, 0), b2); PG8_STAGE_B(PG8_SB(0, 1), b2 + hstep); PG8_STAGE_A(PG8_SA(0, 0), a2, 0, Vc);
            PG8_WAIT_V(8); PG8_WAIT_L(0); PG8_BAR; PG8_MMA(1, 0, At, B0); PG8_MMA(1, 1, At, B1); PG8_BAR; PG8_SCHED;
            PG8_LDB(B0, 1, 0); PG8_LDB(B1, 1, 1); PG8_SCHED; PG8_LDA(At, 1, 0); PG8_STAGE_A(PG8_SA(0, 1), a2, 1, Vc);
            PG8_WAIT_V(8); PG8_WAIT_L(0); PG8_BAR; PG8_MMA(0, 0, At, B0); PG8_MMA(0, 1, At, B1); PG8_BAR; PG8_SCHED;
            PG8_LDA(At, 1, 1); PG8_STAGE_B(PG8_SB(1, 0), b3); PG8_STAGE_B(PG8_SB(1, 1), b3 + hstep); PG8_STAGE_A(PG8_SA(1, 0), a3, 0, Vc);
            PG8_WAIT_V(8); PG8_WAIT_L(0); PG8_BAR; PG8_MMA(1, 0, At, B0); PG8_MMA(1, 1, At, B1); PG8_BAR; PG8_SCHED;
        }
        if constexpr (ALIGN_EPI) { if (wr == 0) PG8_BAR; }
        { int t2 = tid_of(wave_s); asm volatile("" : "+v"(t2));
          if constexpr (MOE) { E(acc, cur, wr, wc, t2 & 15, (t2 & 63) >> 4, (const LAS float*)(lds + LDSX_BIAS + (ui % 3) * 1024));
              if (EPI_DUP) { asm volatile("" : "+v"(t2)); E(acc, cur, wr, wc, t2 & 15, (t2 & 63) >> 4, (const LAS float*)(lds + LDSX_BIAS + (ui % 3) * 1024)); } }
          else E(acc, cur, wr, wc, t2 & 15, (t2 & 63) >> 4); }
        if (!has_next) break;
#pragma unroll
        for (int a = 0; a < 2; ++a)
#pragma unroll
            for (int b = 0; b < 2; ++b)
#pragma unroll
                for (int m = 0; m < 4; ++m)
#pragma unroll
                    for (int n = 0; n < 2; ++n) acc[a][b][m][n] = (f32x4){0.f, 0.f, 0.f, 0.f};
        cur = nxt; cA = nA; cB = nB; ++ui;
        if constexpr (ALIGN_EPI) { if (wr == 1) PG8_BAR; }
    }
    PG8_WAIT_V(0);
    if constexpr (!ALIGN_EPI) { if (wr == 0) PG8_BAR; }
    PG8_BAR;
#undef PG8_SA
#undef PG8_SB
#undef PG8_STAGE
#undef PG8_STAGE_A
#undef PG8_STAGE_B
#undef PG8_GATHER_LOAD
#undef PG8_DMA4
#undef PG8_LDA
#undef PG8_LDB
#undef PG8_LO
#undef PG8_HI
#undef PG8_MMA
#undef PG8_WAIT_V
#undef PG8_WAIT_L
#undef PG8_BAR
#undef PG8_SCHED
}

template <int ROWB>
struct SchedInProj {
    const char* A; const char* B; int G, c;
    __device__ __forceinline__ bool next(int i, Unit& u) const {
        constexpr int nM = T / BM, nN = INW / BM, nwg = nM * nN;
        const long L = (long)i * G + c; if (L >= nwg) return false;
        int wgid = (int)L; { const int q = nwg / NXCD, r = nwg % NXCD, xcd = wgid % NXCD, off = wgid / NXCD; wgid = (xcd < r ? xcd * (q + 1) : r * (q + 1) + (xcd - r) * q) + off; }
        const int nig = WGM * nN, gid = wgid / nig, fm = gid * WGM, gsz = (nM - fm) < WGM ? (nM - fm) : WGM;
        u.pm = fm + ((wgid % nig) % gsz); u.pn = (wgid % nig) / gsz; u.e = 0; u.rows = nullptr;
        u.ao = (unsigned)u.pm * (unsigned)(256 * ROWB); u.bo = (unsigned)u.pn * (unsigned)(256 * ROWB); return true;
    }
};
struct SchedPanel {
    const char* A; const char* B; int pm;
    __device__ __forceinline__ bool next(int i, Unit& u) const {
        if (i >= 4) return false;
        u.pm = pm; u.pn = i; u.e = 0; u.rows = nullptr; u.ao = (unsigned)pm * (unsigned)(256 * KD * 2); u.bo = (unsigned)i * (unsigned)(256 * KD * 2); return true;
    }
};
template <int NPN, bool G1>
struct SchedMoe {
    const char* A; const char* B; const LAS int* tile_e; const int* tok; int ntiles, G, c;
    __device__ __forceinline__ bool next(int i, Unit& u) const {
        const long L = (long)i * G + c; int t, pn;
        if ((G & 7) == 0) { const int x = (int)(L & 7); const long j = L >> 3; t = (int)(j / NPN) * 8 + x; pn = (int)(j % NPN); }
        else { t = (int)(L / NPN); pn = (int)(L % NPN); }
        if (t >= ntiles) return false;
        const int e = __builtin_amdgcn_readfirstlane(tile_e[t]);
        u.pm = t; u.pn = pn; u.e = e;
        if (G1) { u.ao = 0u; u.rows = tok + (size_t)t * 256; u.bo = ((unsigned)e * 2048u + (unsigned)pn * 256u) * 1024u; }
        else { u.ao = (unsigned)t * (256u * 1024u); u.rows = nullptr; u.bo = ((unsigned)e * 1024u + (unsigned)pn * 256u) * 1024u; }
        return true;
    }
};

struct EpiInProj {
    bf16_t* qkv; const float* b_in; const float* rope; float* ksum; float descale;
    __device__ __forceinline__ void operator()(const f32x4 (&acc)[2][2][4][2], const Unit& u, int wr, int wc, int fr, int fq) const {
        const int pn = u.pn;
        const int colb = 256 * pn + 64 * wc + 8 * fq;
        const bool do_rope = !(pn >= 7 || (pn == 2 && wc >= 2));
        const bool is_q = (pn < 2) || (pn == 3) || (pn == 4);
        const bool is_kb = (pn == 5) || (pn == 6);
        const float sc = is_q ? C2 : 1.0f;
        f32x4 bv[2][2];
#pragma unroll
        for (int bj = 0; bj < 2; ++bj)
#pragma unroll
            for (int n = 0; n < 2; ++n) bv[bj][n] = *(const f32x4*)(b_in + colb + 32 * bj + 4 * n);
        f32x4 ks[2][2];
#pragma unroll
        for (int bj = 0; bj < 2; ++bj)
#pragma unroll
            for (int n = 0; n < 2; ++n) ks[bj][n] = (f32x4){0.f, 0.f, 0.f, 0.f};
#pragma unroll
        for (int ai = 0; ai < 2; ++ai)
#pragma unroll
            for (int m = 0; m < 4; ++m) {
                const int row = u.pm * 256 + ai * 128 + wr * 64 + m * 16 + fr;
                const int pos = row & (SEQ - 1);
                f32x4 o1[2], o2[2];
#pragma unroll
                for (int n = 0; n < 2; ++n) { o1[n] = acc[ai][0][m][n] * descale + bv[0][n]; o2[n] = acc[ai][1][m][n] * descale + bv[1][n]; }
                if (do_rope) {
                    const float* rp = rope + pos * 64 + 8 * fq;
#pragma unroll
                    for (int n = 0; n < 2; ++n) { const f32x4 c = *(const f32x4*)(rp + 4 * n), s = *(const f32x4*)(rp + 32 + 4 * n);
                        const f32x4 a = o1[n], b = o2[n]; o1[n] = a * c - b * s; o2[n] = b * c + a * s; }
                }
                if (is_kb) {
#pragma unroll
                    for (int n = 0; n < 2; ++n) { ks[0][n] += o1[n]; ks[1][n] += o2[n]; }
                }
                bf16_t* rowp = qkv + (size_t)row * INW + colb;
                u32x4 w1, w2;
                w1.x = cvtpk(o1[0][0] * sc, o1[0][1] * sc); w1.y = cvtpk(o1[0][2] * sc, o1[0][3] * sc); w1.z = cvtpk(o1[1][0] * sc, o1[1][1] * sc); w1.w = cvtpk(o1[1][2] * sc, o1[1][3] * sc);
                w2.x = cvtpk(o2[0][0] * sc, o2[0][1] * sc); w2.y = cvtpk(o2[0][2] * sc, o2[0][3] * sc); w2.z = cvtpk(o2[1][0] * sc, o2[1][1] * sc); w2.w = cvtpk(o2[1][2] * sc, o2[1][3] * sc);
                *(u32x4*)(rowp) = w1; *(u32x4*)(rowp + 32) = w2;
            }
        if (is_kb) {
            float* kd = ksum + (size_t)u.pm * 512 + 256 * (pn - 5) + 64 * wc + 8 * fq;
#pragma unroll
            for (int bj = 0; bj < 2; ++bj)
#pragma unroll
                for (int n = 0; n < 2; ++n)
#pragma unroll
                    for (int j = 0; j < 4; ++j) {
                        float v = ks[bj][n][j];
                        v += swz_xor<1>(v); v += swz_xor<2>(v); v += swz_xor<4>(v); v += swz_xor<8>(v);
                        if (fr == 0) atomicAdd(kd + 32 * bj + 4 * n + j, v);
                    }
        }
    }
};
struct EpiOutProj {
    bf16_t* y; const float* b_out; const float* x;
    __device__ __forceinline__ void operator()(const f32x4 (&acc)[2][2][4][2], const Unit& u, int wr, int wc, int fr, int fq) const {
        const int col0 = u.pn * 256 + wc * 32 + 8 * fq;
        f32x4 bv[2][2];
#pragma unroll
        for (int bj = 0; bj < 2; ++bj)
#pragma unroll
            for (int n = 0; n < 2; ++n) bv[bj][n] = *(const f32x4*)(b_out + col0 + 128 * bj + 4 * n);
#pragma unroll
        for (int ai = 0; ai < 2; ++ai)
#pragma unroll
            for (int m = 0; m < 4; ++m) {
                const size_t off = (size_t)(u.pm * 256 + ai * 128 + wr * 64 + m * 16 + fr) * D + col0;
#pragma unroll
                for (int bj = 0; bj < 2; ++bj) {
                    const f32x4 x0 = *(const f32x4*)(x + off + 128 * bj), x1 = *(const f32x4*)(x + off + 128 * bj + 4);
                    const f32x4 v0 = acc[ai][bj][m][0] + bv[bj][0] + x0 * DN_ALPHA, v1 = acc[ai][bj][m][1] + bv[bj][1] + x1 * DN_ALPHA;
                    u32x4 w; w.x = cvtpk(v0[0], v0[1]); w.y = cvtpk(v0[2], v0[3]); w.z = cvtpk(v1[0], v1[1]); w.w = cvtpk(v1[2], v1[3]);
                    *(u32x4*)(y + off + 128 * bj) = w; }
                if (m & 1) asm volatile("" ::: "memory");
            }
    }
};
struct EpiSwiglu {
    unsigned char* act8; const float* b1;
    __device__ __forceinline__ const float* bias_src(const Unit& u) const { return b1 + (size_t)u.e * 2048 + 256 * u.pn; }
    __device__ __forceinline__ void operator()(const f32x4 (&acc)[2][2][4][2], const Unit& u, int wr, int wc, int fr, int fq, const LAS float* bias) const {
        const int a0 = 128 * u.pn + 32 * wc + 8 * fq;
        const LAS float* bp = bias + 2 * (32 * wc + 8 * fq);
        f32x4 bb[4];
#pragma unroll
        for (int q = 0; q < 4; ++q) bb[q] = *(const LAS f32x4*)(bp + 4 * q);
        f32x2 bg[2][2], bl[2][2];
#pragma unroll
        for (int n = 0; n < 2; ++n)
#pragma unroll
            for (int jp = 0; jp < 2; ++jp) { bg[n][jp] = (f32x2){bb[2 * n + jp][0], bb[2 * n + jp][2]}; bl[n][jp] = (f32x2){bb[2 * n + jp][1], bb[2 * n + jp][3]}; }
        unsigned char* tile = act8 + (size_t)u.pm * (256 * 1024);
#pragma unroll
        for (int ai = 0; ai < 2; ++ai)
#pragma unroll
            for (int m = 0; m < 4; ++m) {
                const int row = ai * 128 + wr * 64 + m * 16 + fr;
                f32x2 r[2][2];
#pragma unroll
                for (int n = 0; n < 2; ++n)
#pragma unroll
                    for (int jp = 0; jp < 2; ++jp) {
                        const f32x2 ag = {acc[ai][0][m][n][2 * jp], acc[ai][0][m][n][2 * jp + 1]}, al = {acc[ai][1][m][n][2 * jp], acc[ai][1][m][n][2 * jp + 1]};
                        f32x2 g = ag * (1.0f / W_SCALE) + bg[n][jp], l = al * (1.0f / W_SCALE) + bl[n][jp];
                        g.x = fminf(g.x, 7.0f); g.y = fminf(g.y, 7.0f);
                        l.x = __builtin_amdgcn_fmed3f(l.x, -7.0f, 7.0f); l.y = __builtin_amdgcn_fmed3f(l.y, -7.0f, 7.0f);
                        const f32x2 uarg = g * (-1.702f * LOG2E);
                        f32x2 t; t.x = __builtin_amdgcn_exp2f(uarg.x); t.y = __builtin_amdgcn_exp2f(uarg.y);
                        const f32x2 d = t + 1.0f;
                        f32x2 sg; sg.x = __builtin_amdgcn_rcpf(d.x); sg.y = __builtin_amdgcn_rcpf(d.y);
                        const f32x2 lf = l * ACT_SCALE + ACT_SCALE;
                        r[n][jp] = (g * sg) * lf;
                    }
                u32x2 w; w.x = pk4_fp8(r[0][0].x, r[0][0].y, r[0][1].x, r[0][1].y); w.y = pk4_fp8(r[1][0].x, r[1][0].y, r[1][1].x, r[1][1].y);
                *(u32x2*)(tile + (size_t)row * 1024 + (size_t)a0) = w;
            }
    }
};
struct EpiDown {
    unsigned char* yb; const float* b2;
    __device__ __forceinline__ const float* bias_src(const Unit& u) const { return b2 + (size_t)u.e * 1024 + 256 * u.pn; }
    __device__ __forceinline__ void operator()(const f32x4 (&acc)[2][2][4][2], const Unit& u, int wr, int wc, int fr, int fq, const LAS float* bias) const {
        const int col0 = u.pn * 256 + wc * 32 + 8 * fq;
        const LAS float* bp = bias + wc * 32 + 8 * fq;
#pragma unroll
        for (int bj = 0; bj < 2; ++bj) {
            const f32x4 bv0 = *(const LAS f32x4*)(bp + 128 * bj) * Y_SCALE, bv1 = *(const LAS f32x4*)(bp + 128 * bj + 4) * Y_SCALE;
#pragma unroll
            for (int ai = 0; ai < 2; ++ai)
#pragma unroll
                for (int m = 0; m < 4; ++m) {
                    unsigned char* rowp = yb + (size_t)(u.pm * 256 + ai * 128 + wr * 64 + m * 16 + fr) * 1024 + col0;
                    const f32x4 v0 = acc[ai][bj][m][0] * (Y_SCALE / (W_SCALE * ACT_SCALE)) + bv0, v1 = acc[ai][bj][m][1] * (Y_SCALE / (W_SCALE * ACT_SCALE)) + bv1;
                    u32x2 w; w.x = pk4_fp8(v0[0], v0[1], v0[2], v0[3]); w.y = pk4_fp8(v1[0], v1[1], v1[2], v1[3]);
                    *(u32x2*)(rowp + 128 * bj) = w;
                }
        }
    }
};
}

namespace att {
constexpr int PITCH = INW, SLOTB = 8192;
constexpr int NSLOT = 4;
constexpr int L_K = 0, L_V = NSLOT * SLOTB, L_WS = 2 * NSLOT * SLOTB, L_KS = L_WS + 2048, L_OST = L_KS + 2048, L_END = L_OST + 8 * 4096;
static_assert(NSLOT == 4 && L_END <= 131072, "attention LDS map");
constexpr float NEG = -1.0e30f, M0 = -1.0e20f, THR = 8.0f;
typedef LAS const char* lds_cptr;
__device__ __forceinline__ int crow(int r, int hi) { return (r & 3) + 8 * (r >> 2) + 4 * hi; }
__device__ __forceinline__ void glds16(const void* gsrc, unsigned lds_dst) { unsigned keep;
    asm volatile("s_mov_b32 %0, m0\n\ts_mov_b32 m0, %2\n\ts_nop 0\n\tglobal_load_lds_dwordx4 %1, off\n\ts_mov_b32 m0, %0" : "=&s"(keep) : "v"(gsrc), "s"(lds_dst) : "memory"); }
__device__ __forceinline__ void glds16s(unsigned voff, const void* sbase, unsigned lds_dst) { unsigned keep;
    asm volatile("s_mov_b32 %0, m0\n\ts_mov_b32 m0, %3\n\ts_nop 0\n\tglobal_load_lds_dwordx4 %1, %2\n\ts_mov_b32 m0, %0" : "=&s"(keep) : "v"(voff), "s"(sbase), "s"(lds_dst) : "memory"); }
#define ATT_WAIT_BAR0() asm volatile("s_waitcnt vmcnt(0) lgkmcnt(0)\n\ts_barrier" ::: "memory")
#define ATT_WAIT_BARN(N) asm volatile("s_waitcnt vmcnt(" #N ") lgkmcnt(0)\n\ts_barrier" ::: "memory")
#define ATT_SBAR() __builtin_amdgcn_sched_barrier(0)

__device__ __forceinline__ void qkt(f32x16& p0, f32x16& p1, lds_cptr kb, const bf16x8* qr, const f32x16& negm) {
#pragma unroll
    for (int d0 = 0; d0 < 4; ++d0) {
        const bf16x8 b0 = *(const LAS bf16x8*)(kb + d0 * 2048);
        const bf16x8 b1 = *(const LAS bf16x8*)(kb + d0 * 2048 + 512);
        if (d0 == 0) { p0 = __builtin_amdgcn_mfma_f32_32x32x16_bf16(b0, qr[0], negm, 0, 0, 0); p1 = __builtin_amdgcn_mfma_f32_32x32x16_bf16(b1, qr[0], negm, 0, 0, 0); }
        else { p0 = __builtin_amdgcn_mfma_f32_32x32x16_bf16(b0, qr[d0], p0, 0, 0, 0); p1 = __builtin_amdgcn_mfma_f32_32x32x16_bf16(b1, qr[d0], p1, 0, 0, 0); }
    }
}
__device__ __forceinline__ float rowmax32(const f32x16& p0, const f32x16& p1) {
    float a = fmaxf(p0[0], p1[0]);
#pragma unroll
    for (int r = 1; r < 16; ++r) a = fmaxf(a, fmaxf(p0[r], p1[r]));
    auto rr = __builtin_amdgcn_permlane32_swap(__float_as_uint(a), __float_as_uint(a), false, false);
    return fmaxf(__uint_as_float(rr[0]), __uint_as_float(rr[1]));
}
__device__ __forceinline__ void pv(f32x16* o, int vb, bf16x8 pa0, bf16x8 pa1, bf16x8 pa2, bf16x8 pa3) {
#pragma unroll
    for (int d0 = 0; d0 < 2; ++d0) { s16x4 lo[4], hi[4];
#pragma unroll
        for (int ks = 0; ks < 4; ++ks) {
            asm volatile("ds_read_b64_tr_b16 %0,%1 offset:%c2" : "=&v"(lo[ks]) : "v"(vb), "i"(d0 * 4096 + ks * 1024) : "memory");
            asm volatile("ds_read_b64_tr_b16 %0,%1 offset:%c2" : "=&v"(hi[ks]) : "v"(vb), "i"(d0 * 4096 + ks * 1024 + 512) : "memory"); }
        asm volatile("s_waitcnt lgkmcnt(0)" ::: "memory"); ATT_SBAR();
#define ATT_PK(k) (bf16x8){lo[k][0], lo[k][1], lo[k][2], lo[k][3], hi[k][0], hi[k][1], hi[k][2], hi[k][3]}
        o[d0] = __builtin_amdgcn_mfma_f32_32x32x16_bf16(pa0, ATT_PK(0), o[d0], 0, 0, 0);
        o[d0] = __builtin_amdgcn_mfma_f32_32x32x16_bf16(pa1, ATT_PK(1), o[d0], 0, 0, 0);
        o[d0] = __builtin_amdgcn_mfma_f32_32x32x16_bf16(pa2, ATT_PK(2), o[d0], 0, 0, 0);
        o[d0] = __builtin_amdgcn_mfma_f32_32x32x16_bf16(pa3, ATT_PK(3), o[d0], 0, 0, 0);
#undef ATT_PK
    }
}

template <bool MOBA>
__device__ __forceinline__ void attn_item(LAS char* shm, const bf16_t* __restrict__ qkv, bf16_t* __restrict__ aout, int b, int hh, int qb, const float* __restrict__ sinks, const float* __restrict__ ksum, const int wave_s) {
    int tid = tid_of(wave_s); asm volatile("" : "+v"(tid));
    const int lane = tid & 63, r32 = lane & 31, hi = lane >> 5; const int wid = __builtin_amdgcn_readfirstlane(tid >> 6);
    const long rowbase = (long)b * SEQ;
    int qa, qcol, kcol, vcol, ocol, kt0, kt1;
    if (MOBA) { qa = 256 * qb + 32 * wid; qcol = 768 + 64 * hh; kcol = 1280 + 64 * hh; vcol = 1792 + 64 * hh; ocol = 512 + 64 * hh; kt0 = 0; kt1 = 4 * qb + 4; }
    else { const int g = wid >> 1; qa = 64 * qb + 32 * (wid & 1); qcol = (4 * hh + g) * 64; kcol = 512 + 64 * hh; vcol = 640 + 64 * hh; ocol = qcol; kt0 = qb - 2 < 0 ? 0 : qb - 2; kt1 = qb + 1; }
    const bf16_t* Qw = qkv + (rowbase + qa) * PITCH + qcol;
    const bf16_t* Kh = qkv + rowbase * PITCH + kcol; const bf16_t* Vh = qkv + rowbase * PITCH + vcol;
    const unsigned lds0 = (unsigned)(uintptr_t)shm;
    LAS float* wsf = (LAS float*)(shm + L_WS) + wid * 64;
    const bf16_t* ksrc = Kh + (long)lane * PITCH + wid * 8;
    const bf16_t* vsrc = Vh + (long)(16 * (wid & 3) + (lane >> 2)) * PITCH + (wid >> 2) * 32 + (lane & 3) * 8;
    const unsigned kdst = lds0 + L_K + wid * 1024, vdst = lds0 + L_V + wid * 1024;
#define ATT_DMA_K(t, slot) glds16(ksrc + (long)(t) * 64 * PITCH, (unsigned)__builtin_amdgcn_readfirstlane(kdst + (slot)))
#define ATT_DMA_V(t, slot) glds16(vsrc + (long)(t) * 64 * PITCH, (unsigned)__builtin_amdgcn_readfirstlane(vdst + (slot)))
    const int vb0 = (int)(lds0 + L_V) + ((lane >> 4) & 1) * 32 + (lane & 3) * 8 + (4 * hi + ((lane & 15) >> 2)) * 64;
    const lds_cptr shm3 = (lds_cptr)shm; const lds_cptr kp0 = shm3 + L_K + hi * 1024 + r32 * 16;
    const int NT = kt1 - kt0;
    ATT_DMA_K(kt0, 0); ATT_DMA_V(kt0, 0);
    if (NT > 1) { ATT_DMA_K(kt0 + 1, SLOTB); ATT_DMA_V(kt0 + 1, SLOTB); }
    if (NT > 2) { ATT_DMA_K(kt0 + 2, 2 * SLOTB); ATT_DMA_V(kt0 + 2, 2 * SLOTB); }
    if (MOBA) { LAS float* ksl = (LAS float*)(shm + L_KS); ksl[tid] = ksum[((size_t)b * 8 + (tid >> 6)) * 512 + 64 * hh + (tid & 63)]; }
    bf16x8 qr[4];
#pragma unroll
    for (int d0 = 0; d0 < 4; ++d0) qr[d0] = *reinterpret_cast<const bf16x8*>(&Qw[(long)r32 * PITCH + d0 * 16 + hi * 8]);
    float m_run, l_run;
    if (MOBA) { m_run = M0; l_run = 0.f; }
    else { m_run = sinks[4 * hh + (wid >> 1)] * LOG2E; l_run = (hi == 0) ? 1.0f : 0.0f; }
    f32x16 negm;
#pragma unroll
    for (int r = 0; r < 16; ++r) negm[r] = MOBA ? 0.f : -m_run;
    f32x16 o[2];
    { float zf = 0.f; asm volatile("" : "+v"(zf));
#pragma unroll
      for (int r = 0; r < 16; ++r) { o[0][r] = zf; o[1][r] = zf; } }
    ATT_WAIT_BAR0();
    unsigned sel = 0u;
    if (MOBA) {
        if (qb <= 3) sel = (1u << qb) - 1u;
        else {
            const LAS float* ksl = (const LAS float*)(shm + L_KS);
            float gv[7];
#pragma unroll
            for (int i = 0; i < 7; ++i) {
                float s = 0.f;
#pragma unroll
                for (int d0 = 0; d0 < 4; ++d0) {
                    const f32x4 k0 = *(const LAS f32x4*)(ksl + i * 64 + 16 * d0 + 8 * hi), k1 = *(const LAS f32x4*)(ksl + i * 64 + 16 * d0 + 8 * hi + 4);
#pragma unroll
                    for (int jj = 0; jj < 4; ++jj) { s += bf2f((unsigned short)qr[d0][jj]) * k0[jj]; s += bf2f((unsigned short)qr[d0][4 + jj]) * k1[jj]; }
                }
                auto rr = __builtin_amdgcn_permlane32_swap(__float_as_uint(s), __float_as_uint(s), false, false);
                s = __uint_as_float(rr[0]) + __uint_as_float(rr[1]);
                gv[i] = (i < qb) ? s : -INFINITY;
            }
#pragma unroll
            for (int rk = 0; rk < 3; ++rk) { float best = -INFINITY; int bi = 0;
#pragma unroll
                for (int i = 0; i < 7; ++i) { const bool c = (((sel >> i) & 1u) == 0u) && (gv[i] > best); best = c ? gv[i] : best; bi = c ? i : bi; }
                sel |= 1u << bi; }
        }
    }
    for (int it = 0; it < NT; ++it) {
        const int kt = kt0 + it; const int cur = (it & (NSLOT - 1)) * SLOTB;
        if (it + 3 < NT) { const int sl = ((it + 3) & (NSLOT - 1)) * SLOTB; ATT_DMA_K(kt + 3, sl); ATT_DMA_V(kt + 3, sl); }
        bool need; bool on = true;
        if (MOBA) { if (kt < 4 * qb) { on = ((sel >> (kt >> 2)) & 1u) != 0u; need = __any(on) != 0; } else need = (64 * kt <= qa + 31); }
        else need = (64 * kt + 63 >= qa - 127) && (64 * kt <= qa + 31);
        if (need) {
            f32x16 p0, p1; qkt(p0, p1, kp0 + cur, qr, negm);
            if (MOBA && kt < 4 * qb) {
                if (!__all(on)) {
#pragma unroll
                    for (int r = 0; r < 16; ++r) { p0[r] = on ? p0[r] : NEG; p1[r] = on ? p1[r] : NEG; }
                }
            } else {
                const bool edge = MOBA ? (64 * kt + 63 > qa) : !((64 * kt + 63 <= qa) && (qa + 31 - 64 * kt <= 127));
                if (edge) {
                    const int dq = qa + r32 - 64 * kt - 4 * hi;
#pragma unroll
                    for (int r = 0; r < 16; ++r) { const int d0_ = dq - ((r & 3) + 8 * (r >> 2)), d1_ = d0_ - 32;
                        const bool v0 = MOBA ? (d0_ >= 0) : ((unsigned)d0_ < 128u), v1 = MOBA ? (d1_ >= 0) : ((unsigned)d1_ < 128u);
                        p0[r] = v0 ? p0[r] : NEG; p1[r] = v1 ? p1[r] : NEG; }
                }
            }
            const float rm = rowmax32(p0, p1);
            const bool sent = (m_run <= M0), live = (rm > 0.5f * NEG);
            const bool upd = sent ? live : (rm > THR);
            if (__any(upd)) {
                const float dl = sent ? (live ? rm : 0.f) : fmaxf(rm, 0.f);
                const float f = sent ? 1.0f : __builtin_amdgcn_exp2f(-dl);
                m_run = sent ? (live ? rm : m_run) : (m_run + dl);
                const float nm = (m_run <= M0) ? 0.f : -m_run;
#pragma unroll
                for (int r = 0; r < 16; ++r) { p0[r] -= dl; p1[r] -= dl; negm[r] = nm; }
                l_run *= f;
                if (hi == 0) wsf[r32] = f;
                LDS_WAIT();
#pragma unroll
                for (int r = 0; r < 16; ++r) { const float fr_ = wsf[crow(r, hi)]; o[0][r] *= fr_; o[1][r] *= fr_; }
            }
            float sacc = 0.f;
#pragma unroll
            for (int r = 0; r < 16; ++r) { p0[r] = __builtin_amdgcn_exp2f(p0[r]); p1[r] = __builtin_amdgcn_exp2f(p1[r]); sacc += p0[r] + p1[r]; }
            l_run += sacc;
            u32x4 pw0, pw1, pw2, pw3;
            pw0 = (u32x4){cvtpk(p0[0], p0[1]), cvtpk(p0[2], p0[3]), cvtpk(p0[4], p0[5]), cvtpk(p0[6], p0[7])};
            pw1 = (u32x4){cvtpk(p0[8], p0[9]), cvtpk(p0[10], p0[11]), cvtpk(p0[12], p0[13]), cvtpk(p0[14], p0[15])};
            pw2 = (u32x4){cvtpk(p1[0], p1[1]), cvtpk(p1[2], p1[3]), cvtpk(p1[4], p1[5]), cvtpk(p1[6], p1[7])};
            pw3 = (u32x4){cvtpk(p1[8], p1[9]), cvtpk(p1[10], p1[11]), cvtpk(p1[12], p1[13]), cvtpk(p1[14], p1[15])};
            ATT_SBAR();
            pv(o, vb0 + cur, __builtin_bit_cast(bf16x8, pw0), __builtin_bit_cast(bf16x8, pw1), __builtin_bit_cast(bf16x8, pw2), __builtin_bit_cast(bf16x8, pw3));
        }
        if (it + 1 < NT) {
            if (it + 3 < NT) ATT_WAIT_BARN(4); else if (it + 2 < NT) ATT_WAIT_BARN(2); else ATT_WAIT_BAR0();
        }
    }
    { auto rr = __builtin_amdgcn_permlane32_swap(__float_as_uint(l_run), __float_as_uint(l_run), false, false); l_run = __uint_as_float(rr[0]) + __uint_as_float(rr[1]); }
    if (hi == 0) wsf[32 + r32] = l_run;
    LDS_WAIT();
    float rli[16];
#pragma unroll
    for (int r = 0; r < 16; ++r) rli[r] = __builtin_amdgcn_rcpf(wsf[32 + crow(r, hi)]);
    bf16_t* Ow = aout + (rowbase + qa) * D + ocol;
    { LAS bf16_t* stg = (LAS bf16_t*)(shm + L_OST) + wid * 2048;
#pragma unroll
        for (int r = 0; r < 16; ++r) { const int orow = crow(r, hi);
#pragma unroll
            for (int d0 = 0; d0 < 2; ++d0) stg[orow * 64 + d0 * 32 + r32] = (bf16_t)f2bf(o[d0][r] * rli[r]); }
        LDS_WAIT();
#pragma unroll
        for (int i = 0; i < 4; ++i) { const int row = i * 8 + (lane >> 3), ch = lane & 7; const u32x4 v = *(const LAS u32x4*)(stg + row * 64 + ch * 8); *(u32x4*)(Ow + (long)row * D + ch * 8) = v; } }
    asm volatile("s_waitcnt lgkmcnt(0)\n\ts_barrier" ::: "memory");
#undef ATT_DMA_K
#undef ATT_DMA_V
}

constexpr int MK_K = 0, MK_V = 3 * SLOTB, MK_WS = 6 * SLOTB, MK_OST = MK_WS + 8 * 256, MK_KS = MK_OST + 8 * 4096, MK_END = MK_KS + 2048;
constexpr float NEGB = -1.0e30f;
__device__ __forceinline__ float max3f(float a, float b, float c) { float r; asm("v_max3_f32 %0, %1, %2, %3" : "=v"(r) : "v"(a), "v"(b), "v"(c)); return r; }
__device__ __forceinline__ float max2f(float a, float b) { float r; asm("v_max_f32_e32 %0, %1, %2" : "=v"(r) : "v"(a), "v"(b)); return r; }
__device__ __forceinline__ float fadd_s(float a, float b) { float r; asm("v_add_f32_e32 %0, %1, %2" : "=v"(r) : "v"(a), "v"(b)); return r; }
__device__ __forceinline__ float fsub_s(float a, float b) { float r; asm("v_sub_f32_e32 %0, %1, %2" : "=v"(r) : "v"(a), "v"(b)); return r; }
typedef short v4i16_t __attribute__((ext_vector_type(4)));
#define MK_WAIT_BAR(N) asm volatile("s_waitcnt vmcnt(" #N ") lgkmcnt(0)\n\ts_barrier" ::: "memory")
__device__ __forceinline__ void kload8(bf16x8* kf, lds_cptr kp) {
    kf[0] = *(const LAS bf16x8*)(kp);        kf[1] = *(const LAS bf16x8*)(kp + 512);
    kf[2] = *(const LAS bf16x8*)(kp + 2048); kf[3] = *(const LAS bf16x8*)(kp + 2560);
    kf[4] = *(const LAS bf16x8*)(kp + 4096); kf[5] = *(const LAS bf16x8*)(kp + 4608);
    kf[6] = *(const LAS bf16x8*)(kp + 6144); kf[7] = *(const LAS bf16x8*)(kp + 6656);
}
__device__ __forceinline__ void kload2(bf16x8* kf, lds_cptr kp, int j) { kf[2 * j] = *(const LAS bf16x8*)(kp + j * 2048); kf[2 * j + 1] = *(const LAS bf16x8*)(kp + j * 2048 + 512); }
__device__ __forceinline__ s16x4 vtr(lds_cptr p) { return __builtin_bit_cast(s16x4, __builtin_amdgcn_ds_read_tr16_b64_v4i16((LAS v4i16_t*)p)); }
__device__ __forceinline__ float rowmax_a(const f32x16& p0, const f32x16& p1) {
    float a = max3f(p0[0], p0[1], p1[0]), b = max3f(p0[2], p0[3], p1[1]); a = max3f(a, p1[2], p1[3]);
#pragma unroll
    for (int r = 4; r < 16; r += 4) { a = max3f(a, p0[r], p0[r + 1]); b = max3f(b, p0[r + 2], p0[r + 3]); a = max3f(a, p1[r], p1[r + 1]); b = max3f(b, p1[r + 2], p1[r + 3]); }
    const float m = max2f(a, b);
    auto rr = __builtin_amdgcn_permlane32_swap(__float_as_uint(m), __float_as_uint(m), false, false);
    return max2f(__uint_as_float(rr[0]), __uint_as_float(rr[1]));
}
__device__ __forceinline__ void cmask(f32x16& p0, f32x16& p1, int jb, int qrel, int hi) {
    const float NEGI = -INFINITY; const int kb = 64 * jb + 4 * hi;
#pragma unroll
    for (int r = 0; r < 16; ++r) { const int kv = kb + (r & 3) + 8 * (r >> 2); if (kv > qrel) p0[r] = NEGI; if (kv + 32 > qrel) p1[r] = NEGI; }
}

template <int THRL>
__device__ __forceinline__ void moba_unit(int b, int h, int qb, const bf16_t* __restrict__ qkv, bf16_t* __restrict__ aout, const float* __restrict__ ksum, LAS char* shm, const int wave_s) {
    int tid = tid_of(wave_s); asm volatile("" : "+v"(tid));
    const int lane = tid & 63, r32 = lane & 31, hi = lane >> 5; const int wid = __builtin_amdgcn_readfirstlane(tid >> 6);
    const long rowbase = (long)b * SEQ; const int q0 = qb * 256;
    const bf16_t* Qw = qkv + (rowbase + q0 + wid * 32) * PITCH + 768 + 64 * h;
    const bf16_t* Kh = qkv + rowbase * PITCH + 1280 + 64 * h; const bf16_t* Vh = qkv + rowbase * PITCH + 1792 + 64 * h;
    const unsigned lds0 = (unsigned)(uintptr_t)shm;
    LAS float* wsf = (LAS float*)(shm + MK_WS) + wid * 64;
    const unsigned koff = (unsigned)(lane * PITCH + wid * 8) * 2u;
    const unsigned voff = (unsigned)((16 * (wid & 3) + (lane >> 2)) * PITCH + (wid >> 2) * 32 + (lane & 3) * 8) * 2u;
    const unsigned kdst = lds0 + MK_K + wid * 1024, vdst = lds0 + MK_V + wid * 1024;
#define DMA_K(t, slot) glds16s(koff, Kh + (long)(t) * 64 * PITCH, (unsigned)__builtin_amdgcn_readfirstlane(kdst + (slot)))
#define DMA_V(t, slot) glds16s(voff, Vh + (long)(t) * 64 * PITCH, (unsigned)__builtin_amdgcn_readfirstlane(vdst + (slot)))
    bf16x8 kf[8];
    const lds_cptr shm3 = (lds_cptr)shm; const lds_cptr kp0 = shm3 + MK_K + hi * 1024 + r32 * 16; const lds_cptr vp0 = shm3 + MK_V + ((lane >> 4) & 1) * 32 + (lane & 3) * 8 + (4 * hi + ((lane & 15) >> 2)) * 64;
    const int NT = (q0 + 256) / 64;
    DMA_K(0, 0); DMA_V(0, 0); DMA_K(1, SLOTB);
    { LAS float* ksl = (LAS float*)(shm + MK_KS); ksl[tid] = ksum[((size_t)b * 8 + (tid >> 6)) * 512 + 64 * h + (tid & 63)]; }
    bf16x8 qr[4];
#pragma unroll
    for (int d0 = 0; d0 < 4; ++d0) qr[d0] = *reinterpret_cast<const bf16x8*>(&Qw[(long)r32 * PITCH + d0 * 16 + hi * 8]);
    float mhat = 0.f, l_reg = 0.f; f32x16 o[2], negm;
    { float zf = 0.f; asm volatile("" : "+v"(zf));
#pragma unroll
      for (int r = 0; r < 16; ++r) { o[0][r] = zf; o[1][r] = zf; negm[r] = zf; } }
    asm volatile("" : "+v"(negm));
    const int qrel = wid * 32 + r32;
#define CMASK(P0, P1, t) do { int jb_ = (t) - (NT - 4); if (jb_ >= 0) cmask(P0, P1, jb_, qrel, hi); } while (0)
    bool resc = false;
#define START(P0, P1) do { const float rm = rowmax_a(P0, P1); resc = false; \
    { const float dl = (rm > 0.1f * NEGB) ? rm : 0.f;      mhat = fadd_s(mhat, dl); \
      _Pragma("unroll") for (int r = 0; r < 16; ++r) { P0[r] = fsub_s(P0[r], dl); P1[r] = fsub_s(P1[r], dl); } \
      const float nm_ = ONB(1) ? -mhat : NEGB; \
      _Pragma("unroll") for (int r = 0; r < 16; ++r) negm[r] = nm_; asm volatile("" : "+v"(negm)); } \
    _Pragma("unroll") for (int r = 0; r < 16; ++r) P0[r] = __builtin_amdgcn_exp2f(P0[r]); } while (0)
#define RESC() do { if (resc) { asm volatile("s_waitcnt lgkmcnt(0)" ::: "memory"); \
      _Pragma("unroll") for (int d_ = 0; d_ < 2; ++d_) _Pragma("unroll") for (int r = 0; r < 16; ++r) o[d_][r] *= wsf[crow(r, hi)]; } } while (0)
    f32x16 pA0, pA1, pB0, pB1;
    int sl_prev = 0, sl_cur = 0, sl_next = SLOTB;
#define ROT() do { sl_prev = sl_cur; sl_cur = sl_next; sl_next = (sl_next == 2 * SLOTB) ? 0 : sl_next + SLOTB; } while (0)
    DMA_K(2, 2 * SLOTB);
    MK_WAIT_BAR(3);
    unsigned sel = 0u;
    if (qb <= 3) sel = (1u << qb) - 1u;
    else {
        const LAS float* ksl = (const LAS float*)(shm + MK_KS);
        float gv[7];
#pragma unroll
        for (int i = 0; i < 7; ++i) {
            float s = 0.f;
#pragma unroll
            for (int d0 = 0; d0 < 4; ++d0) {
                const f32x4 k0 = *(const LAS f32x4*)(ksl + i * 64 + 16 * d0 + 8 * hi), k1 = *(const LAS f32x4*)(ksl + i * 64 + 16 * d0 + 8 * hi + 4);
#pragma unroll
                for (int jj = 0; jj < 4; ++jj) { s += bf2f((unsigned short)qr[d0][jj]) * k0[jj]; s += bf2f((unsigned short)qr[d0][4 + jj]) * k1[jj]; }
            }
            auto rr = __builtin_amdgcn_permlane32_swap(__float_as_uint(s), __float_as_uint(s), false, false);
            s = __uint_as_float(rr[0]) + __uint_as_float(rr[1]);
            gv[i] = (i < qb) ? s : -INFINITY;
        }
#pragma unroll
        for (int rk = 0; rk < 3; ++rk) { float best = -INFINITY; int bi = 0;
#pragma unroll
            for (int i = 0; i < 7; ++i) { const bool c = (((sel >> i) & 1u) == 0u) && (gv[i] > best); best = c ? gv[i] : best; bi = c ? i : bi; }
            sel |= 1u << bi; }
    }
#define ONB(tt) (((tt) >= NT - 4) ? true : (((sel >> ((tt) >> 2)) & 1u) != 0u))
#define SETNEGM(tt) do { const float nm_ = ONB(tt) ? -mhat : NEGB; _Pragma("unroll") for (int r = 0; r < 16; ++r) negm[r] = nm_; asm volatile("" : "+v"(negm)); } while (0)
    SETNEGM(0);
    qkt(pA0, pA1, kp0, qr, negm); asm volatile("s_nop 15\n\ts_nop 7" : "+v"(pA0), "+v"(pA1)); CMASK(pA0, pA1, 0);
    START(pA0, pA1);
    _Pragma("unroll") for (int r = 0; r < 16; ++r) pA1[r] = __builtin_amdgcn_exp2f(pA1[r]);
    MK_WAIT_BAR(0);
    DMA_K(3, 0); DMA_V(1, SLOTB);
    ROT();
    kload8(kf, kp0 + sl_cur);
    MK_WAIT_BAR(2);
    s16x4 vlo[8], vhi[8]; u32x4 pw0, pw1, pw2, pw3;
#define PKW(P, B) cvtpk(P[B], P[B + 1])
#define PAF(k) __builtin_bit_cast(bf16x8, pw##k)
#define VFR(i) (bf16x8){vlo[i][0], vlo[i][1], vlo[i][2], vlo[i][3], vhi[i][0], vhi[i][1], vhi[i][2], vhi[i][3]}
#define PIN(x) asm volatile("" : "+v"(x))
#define MX3(a, b, c) __builtin_fmaxf(__builtin_fmaxf((a), (b)), (c))
#define GAPA(MF, A0, A1, A2, A3, W0, W1, PW) do { MF; sacc += A0; sacc += A1; sacc += A2; sacc += A3; PIN(sacc); W0; W1; PIN(PW); ATT_SBAR(); } while (0)
#define EX(v) __builtin_amdgcn_exp2f(v)
#define GAPB(MF, X, B) do { MF; X[B] = EX(X[B]); X[B + 1] = EX(X[B + 1]); X[B + 2] = EX(X[B + 2]); X[B + 3] = EX(X[B + 3]); PIN(X); ATT_SBAR(); } while (0)
#define VRD(i) do { vlo[i] = vtr(vp_ + (((i) >> 2) * 4096 + ((i) & 3) * 1024)); vhi[i] = vtr(vp_ + (((i) >> 2) * 4096 + ((i) & 3) * 1024 + 512)); } while (0)
#define KRD(G, j) do { if (G) { kload2(kf, kp0 + sl_next, j); ATT_SBAR(); } } while (0)
#define MF32(a, b, c) __builtin_amdgcn_mfma_f32_32x32x16_bf16(a, b, c, 0, 0, 0)
#define STEP(C0, C1, P0, P1, t, GK, GV, GL) do { ATT_SBAR(); \
    const lds_cptr vp_ = vp0 + sl_prev; \
    VRD(0); ATT_SBAR(); float sacc = (P0[0] + P0[1]); \
    GAPA(C0 = MF32(kf[0], qr[0], negm), P0[2], P0[3], P0[4], P0[5],     pw0[0] = PKW(P0, 0), pw0[1] = PKW(P0, 2), pw0); \
    VRD(4); ATT_SBAR(); GAPA(C1 = MF32(kf[1], qr[0], negm), P0[6], P0[7], P0[8], P0[9],     pw0[2] = PKW(P0, 4), pw0[3] = PKW(P0, 6), pw0); \
    VRD(1); ATT_SBAR(); GAPA(C0 = MF32(kf[2], qr[1], C0),   P0[10], P0[11], P0[12], P0[13], pw1[0] = PKW(P0, 8), pw1[1] = PKW(P0, 10), pw1); \
    VRD(5); ATT_SBAR(); GAPA(C1 = MF32(kf[3], qr[1], C1),   P0[14], P0[15], P1[0], P1[1],   pw1[2] = PKW(P0, 12), pw1[3] = PKW(P0, 14), pw1); \
    VRD(2); ATT_SBAR(); GAPA(C0 = MF32(kf[4], qr[2], C0),   P1[2], P1[3], P1[4], P1[5],     pw2[0] = PKW(P1, 0), pw2[1] = PKW(P1, 2), pw2); \
    VRD(6); ATT_SBAR(); GAPA(C1 = MF32(kf[5], qr[2], C1),   P1[6], P1[7], P1[8], P1[9],     pw2[2] = PKW(P1, 4), pw2[3] = PKW(P1, 6), pw2); \
    VRD(3); ATT_SBAR(); GAPA(C0 = MF32(kf[6], qr[3], C0),   P1[10], P1[11], P1[12], P1[13], pw3[0] = PKW(P1, 8), pw3[1] = PKW(P1, 10), pw3); \
    VRD(7); ATT_SBAR(); GAPA(C1 = MF32(kf[7], qr[3], C1),   P1[14], P1[15], 0.f, 0.f,       pw3[2] = PKW(P1, 12), pw3[3] = PKW(P1, 14), pw3); \
    l_reg += sacc; \
    if (GK) { DMA_K((t) + 3, sl_cur); } if (GV) { DMA_V((t) + 1, sl_next); } \
    CMASK(C0, C1, t); \
    { float a = MX3(C0[0], C0[1], C1[0]), b_ = MX3(C0[2], C0[3], C1[1]); a = MX3(a, C1[2], C1[3]); \
      _Pragma("unroll") for (int r = 4; r < 16; r += 4) { a = MX3(a, C0[r], C0[r + 1]); b_ = MX3(b_, C0[r + 2], C0[r + 3]); a = MX3(a, C1[r], C1[r + 1]); b_ = MX3(b_, C1[r + 2], C1[r + 3]); } \
      float rm = __builtin_fmaxf(a, b_); { auto rr = __builtin_amdgcn_permlane32_swap(__float_as_uint(rm), __float_as_uint(rm), false, false); rm = __builtin_fmaxf(__uint_as_float(rr[0]), __uint_as_float(rr[1])); } \
      resc = false; \
      const bool blk_ = (((t) + 1) & 3) == 0;                    \
      if (__builtin_expect(__any(rm > (float)THRL), 0)) { const float dl = __builtin_fmaxf(rm, 0.f); mhat += dl; \
        _Pragma("unroll") for (int r = 0; r < 16; ++r) { C0[r] -= dl; C1[r] -= dl; } \
        const float nm_ = ONB((t) + 1) ? -mhat : NEGB; \
        _Pragma("unroll") for (int r = 0; r < 16; ++r) negm[r] = nm_; asm volatile("" : "+v"(negm)); \
        const float f = __builtin_amdgcn_exp2f(-dl); l_reg *= f; if (hi == 0) wsf[r32] = f; resc = true; } \
      else if (blk_) { SETNEGM((t) + 1); } } \
    ATT_SBAR(); \
    GAPB(o[0] = MF32(PAF(0), VFR(0), o[0]), C0, 0); \
    GAPB(o[1] = MF32(PAF(0), VFR(4), o[1]), C0, 4); \
    KRD(GL, 0); GAPB(o[0] = MF32(PAF(1), VFR(1), o[0]), C0, 8); \
    KRD(GL, 1); GAPB(o[1] = MF32(PAF(1), VFR(5), o[1]), C0, 12); \
    KRD(GL, 2); GAPB(o[0] = MF32(PAF(2), VFR(2), o[0]), C1, 0); \
    KRD(GL, 3); GAPB(o[1] = MF32(PAF(2), VFR(6), o[1]), C1, 4); \
    GAPB(o[0] = MF32(PAF(3), VFR(3), o[0]), C1, 8); \
    GAPB(o[1] = MF32(PAF(3), VFR(7), o[1]), C1, 12); \
    } while (0)
    int t = 1;
#undef CMASK
#define CMASK(P0, P1, t) do { } while (0)
    for (; t + 5 < NT; t += 2) {
        STEP(pB0, pB1, pA0, pA1, t, true, true, true);       MK_WAIT_BAR(2); RESC(); ROT();
        STEP(pA0, pA1, pB0, pB1, t + 1, true, true, true);   MK_WAIT_BAR(2); RESC(); ROT();
    }
#undef CMASK
#define CMASK(P0, P1, t) do { int jb_ = (t) - (NT - 4); if (jb_ >= 0) cmask(P0, P1, jb_, qrel, hi); } while (0)
#define ENDW(tt) do { if ((tt) + 3 < NT) { MK_WAIT_BAR(2); } else if ((tt) + 2 < NT) { MK_WAIT_BAR(1); } else { MK_WAIT_BAR(0); } } while (0)
    for (; t + 1 < NT; t += 2) {
        STEP(pB0, pB1, pA0, pA1, t, (t + 3 < NT), (t + 1 < NT), (t + 1 < NT));           ENDW(t);     RESC(); ROT();
        STEP(pA0, pA1, pB0, pB1, t + 1, (t + 4 < NT), (t + 2 < NT), (t + 2 < NT));       ENDW(t + 1); RESC(); ROT();
    }
    STEP(pB0, pB1, pA0, pA1, NT - 1, false, false, false); RESC();
    { float sacc = pB0[0] + pB0[1]; _Pragma("unroll") for (int r = 2; r < 16; ++r) sacc += pB0[r]; _Pragma("unroll") for (int r = 0; r < 16; ++r) sacc += pB1[r]; l_reg += sacc;
      pw0 = (u32x4){PKW(pB0, 0), PKW(pB0, 2), PKW(pB0, 4), PKW(pB0, 6)}; pw1 = (u32x4){PKW(pB0, 8), PKW(pB0, 10), PKW(pB0, 12), PKW(pB0, 14)}; pw2 = (u32x4){PKW(pB1, 0), PKW(pB1, 2), PKW(pB1, 4), PKW(pB1, 6)}; pw3 = (u32x4){PKW(pB1, 8), PKW(pB1, 10), PKW(pB1, 12), PKW(pB1, 14)};
      ATT_SBAR(); const int vb0 = (int)(lds0 + MK_V) + ((lane >> 4) & 1) * 32 + (lane & 3) * 8 + (4 * hi + ((lane & 15) >> 2)) * 64; pv(o, vb0 + sl_cur, PAF(0), PAF(1), PAF(2), PAF(3)); }
#undef PKW
#undef PAF
#undef VFR
#undef PIN
#undef MX3
#undef GAPA
#undef GAPB
#undef EX
#undef VRD
#undef KRD
#undef MF32
#undef STEP
#undef ENDW
    { auto rr = __builtin_amdgcn_permlane32_swap(__float_as_uint(l_reg), __float_as_uint(l_reg), false, false); l_reg = __uint_as_float(rr[0]) + __uint_as_float(rr[1]); }
    if (hi == 0) wsf[32 + r32] = l_reg; asm volatile("s_waitcnt lgkmcnt(0)" ::: "memory");
    float rli[16];
#pragma unroll
    for (int r = 0; r < 16; ++r) rli[r] = __builtin_amdgcn_rcpf(wsf[32 + crow(r, hi)]);
    bf16_t* Ow = aout + (rowbase + q0 + wid * 32) * D + 512 + 64 * h;
    { LAS bf16_t* stg = (LAS bf16_t*)(shm + MK_OST) + wid * 2048;
#pragma unroll
      for (int r = 0; r < 16; ++r) { const int orow = crow(r, hi);
#pragma unroll
          for (int d0 = 0; d0 < 2; ++d0) stg[orow * 64 + d0 * 32 + r32] = (bf16_t)f2bf(o[d0][r] * rli[r]); }
      asm volatile("s_waitcnt lgkmcnt(0)" ::: "memory");
#pragma unroll
      for (int i = 0; i < 4; ++i) { const int row = i * 8 + (lane >> 3), ch = lane & 7; const u32x4 v = *(const LAS u32x4*)(stg + row * 64 + ch * 8); *(u32x4*)(Ow + (long)row * D + ch * 8) = v; } }
    asm volatile("s_waitcnt lgkmcnt(0)\n\ts_barrier" ::: "memory");
#undef DMA_K
#undef DMA_V
#undef CMASK
#undef START
#undef RESC
#undef ROT
#undef ONB
#undef SETNEGM
}
}

__device__ __forceinline__ void sincos_d(double a, double& s, double& c) {
    const double q = __builtin_rint(a * 0.63661977236758134308);
    double r = __builtin_fma(-q, 1.57079632679489655800e+00, a);
    r = __builtin_fma(-q, 6.12323399573676603587e-17, r);
    const double r2 = r * r;
    double sp = -1.0 / 1307674368000.0;
    sp = sp * r2 + 1.0 / 6227020800.0; sp = sp * r2 - 1.0 / 39916800.0; sp = sp * r2 + 1.0 / 362880.0; sp = sp * r2 - 1.0 / 5040.0; sp = sp * r2 + 1.0 / 120.0; sp = sp * r2 - 1.0 / 6.0;
    const double sr = r + r * r2 * sp;
    double cp = 1.0 / 20922789888000.0;
    cp = cp * r2 - 1.0 / 87178291200.0; cp = cp * r2 + 1.0 / 479001600.0; cp = cp * r2 - 1.0 / 3628800.0; cp = cp * r2 + 1.0 / 40320.0; cp = cp * r2 - 1.0 / 720.0; cp = cp * r2 + 1.0 / 24.0; cp = cp * r2 - 0.5;
    const double cr = 1.0 + r2 * cp;
    const int n = ((int)q) & 3;
    s = (n == 0) ? sr : (n == 1) ? cr : (n == 2) ? -sr : -cr;
    c = (n == 0) ? cr : (n == 1) ? -sr : (n == 2) ? -cr : sr;
}
__device__ __forceinline__ int sigma_col(int p, int mode) {
    if (mode == 0) return (p & ~255) + 64 * ((p >> 5) & 3) + 32 * ((p >> 7) & 1) + pg8::perm32(p & 31);
    if (mode == 1) return (p & ~31) + pg8::perm32(p & 31);
    const int pn = p >> 8, q = p & 255; return 2 * (128 * pn + 32 * ((q >> 5) & 3) + pg8::perm32(q & 31)) + (q >> 7);
}
__device__ __forceinline__ void p0_transpose_item(const float* __restrict__ W, int N, bf16_t* __restrict__ WT, int mode, LAS float* scr, int item, int lane) {
    const int nblk = N / 32, kb = item / nblk, nb = item % nblk, k0 = 64 * kb, p0 = 32 * nb;
    const int sc = sigma_col(p0 + (lane & 31), mode);
#pragma unroll 8
    for (int i = 0; i < 32; ++i) { const int kk = 2 * i + (lane >> 5); scr[kk * 33 + (lane & 31)] = W[(size_t)(k0 + kk) * N + sc]; }
    LDS_WAIT(); asm volatile("" ::: "memory");
    const int c = lane & 7;
#pragma unroll
    for (int j = 0; j < 4; ++j) { const int n = (lane >> 3) + 8 * j; const LAS float* s = scr + (8 * c) * 33 + n;
        u32x4 o; o.x = cvtpk(s[0 * 33], s[1 * 33]); o.y = cvtpk(s[2 * 33], s[3 * 33]); o.z = cvtpk(s[4 * 33], s[5 * 33]); o.w = cvtpk(s[6 * 33], s[7 * 33]);
        *(u32x4*)(WT + (size_t)(p0 + n) * 1024 + k0 + 8 * c) = o; }
    LDS_WAIT(); asm volatile("" ::: "memory");
}

__device__ __forceinline__ void p0_transpose_item_fp8(const float* __restrict__ W, int N, unsigned char* __restrict__ WT, int mode, float scale, LAS float* scr, int item, int lane) {
    const int nblk = N / 32, kb = item / nblk, nb = item % nblk, k0 = 64 * kb, p0 = 32 * nb;
    const int sc = sigma_col(p0 + (lane & 31), mode);
#pragma unroll 8
    for (int i = 0; i < 32; ++i) { const int kk = 2 * i + (lane >> 5); scr[kk * 33 + (lane & 31)] = W[(size_t)(k0 + kk) * N + sc] * scale; }
    LDS_WAIT(); asm volatile("" ::: "memory");
    const int c = lane & 7;
#pragma unroll
    for (int j = 0; j < 4; ++j) { const int n = (lane >> 3) + 8 * j; const LAS float* s = scr + (8 * c) * 33 + n;
        u32x2 o; o.x = pk4_fp8(s[0 * 33], s[1 * 33], s[2 * 33], s[3 * 33]); o.y = pk4_fp8(s[4 * 33], s[5 * 33], s[6 * 33], s[7 * 33]);
        *(u32x2*)(WT + (size_t)(p0 + n) * 1024 + k0 + 8 * c) = o; }
    LDS_WAIT(); asm volatile("" ::: "memory");
}


#define XB_TMO      128
#define XB_XCNT(j)  (256  + 64 * (j))
#define XB_XSUB(j)  (1280 + 64 * (j))
#define XB_XGEN(j)  (2304 + 64 * (j))
#define XB_TOP      3328
#define XB_TOPGEN   3392
#define XCD_BAR_WORDS 3456
#define XB_SPIN_CAP (1u << 18)
__device__ __forceinline__ unsigned xb_ld(unsigned* p)              { return __hip_atomic_load(p, __ATOMIC_RELAXED, __HIP_MEMORY_SCOPE_AGENT); }
__device__ __forceinline__ unsigned xb_add(unsigned* p, unsigned v) { return __hip_atomic_fetch_add(p, v, __ATOMIC_RELAXED, __HIP_MEMORY_SCOPE_AGENT); }
__device__ __forceinline__ unsigned xb_xcc_id() { return (unsigned)__builtin_amdgcn_s_getreg((3 << 11) | 20) & 0xFu; }
#define XB_SPIN(cond, bar) do { unsigned _sp = 0; while (cond) { __builtin_amdgcn_s_sleep(1); \
    if ((++_sp & 255u) == 0u) { if (xb_ld(&(bar)[XB_TMO])) break; if (_sp > XB_SPIN_CAP) { atomicAdd(&(bar)[XB_TMO], 1u); break; } } } } while (0)
struct XcdBarrier { unsigned* bar; unsigned x; volatile LAS unsigned* st; };
__device__ __forceinline__ XcdBarrier xcd_barrier_post(unsigned* bar, volatile LAS unsigned* st, const int wave_s) {
    XcdBarrier b; b.bar = bar; b.x = xb_xcc_id(); b.st = st;
    if (tid_of(wave_s) == 0) (void)xb_add(&bar[XB_XCNT(b.x)], 1u);
    return b;
}
__device__ __forceinline__ void xcd_barrier_complete(unsigned* bar, unsigned x, unsigned& nloc, unsigned& nx) {
    const unsigned G = gridDim.x * gridDim.y * gridDim.z;
    unsigned sum, cnt, mine, sp = 0u;
    for (;;) {
        sum = 0u; cnt = 0u; mine = 0u;
#pragma unroll
        for (unsigned j = 0; j < 16; ++j) { const unsigned c = xb_ld(&bar[XB_XCNT(j)]); sum += c; cnt += (c > 0u) ? 1u : 0u; mine = (j == x) ? c : mine; }
        if (sum == G) break;
        __builtin_amdgcn_s_sleep(1);
        if ((++sp & 255u) == 0u) { if (xb_ld(&bar[XB_TMO])) break; if (sp > XB_SPIN_CAP) { atomicAdd(&bar[XB_TMO], 1u); break; } }
    }
    nloc = mine > 0u ? mine : 1u; nx = cnt > 0u ? cnt : 1u;
}
__device__ __forceinline__ void xcd_barrier(const XcdBarrier& b, const int wave_s) {
    asm volatile("s_waitcnt vmcnt(0)" ::: "memory");
    __syncthreads();
    if (tid_of(wave_s) == 0) {
        unsigned* bar = b.bar;
        __builtin_amdgcn_s_waitcnt(0);
        unsigned nloc = b.st[0], nx = b.st[1];
        if (nloc == 0u) { xcd_barrier_complete(bar, b.x, nloc, nx); b.st[0] = nloc; b.st[1] = nx; }
        const unsigned old = xb_add(&bar[XB_XSUB(b.x)], 1u);
        const unsigned gen = old / nloc;
        if (old + 1u == (gen + 1u) * nloc) {
            __builtin_amdgcn_fence(__ATOMIC_RELEASE, "agent");
            asm volatile("s_waitcnt vmcnt(0)" ::: "memory");
            const unsigned og = xb_add(&bar[XB_TOP], 1u);
            const unsigned tg = og / nx;
            if (og + 1u == (tg + 1u) * nx) xb_add(&bar[XB_TOPGEN], 1u);
            else XB_SPIN(xb_ld(&bar[XB_TOPGEN]) == tg, bar);
            __builtin_amdgcn_fence(__ATOMIC_ACQUIRE, "agent");
            xb_add(&bar[XB_XGEN(b.x)], 1u);
            asm volatile("s_waitcnt vmcnt(0)" ::: "memory");
        } else {
            XB_SPIN(xb_ld(&bar[XB_XGEN(b.x)]) == gen, bar);
            __builtin_amdgcn_fence(__ATOMIC_ACQUIRE, "agent");
            asm volatile("s_waitcnt vmcnt(0)" ::: "memory");
        }
    }
    __syncthreads();
}

__global__ void __launch_bounds__(NTHREADS, 2) fwd_megakernel(Params p_arg) {
    extern __shared__ __attribute__((aligned(16))) unsigned char lds_raw[];
    LAS unsigned char* lds = (LAS unsigned char*)lds_raw;
#define PHASE_IDS() int tid = tid_of(wave_s); asm volatile("" : "+v"(tid)); const int lane = tid & 63, wave = wave_s; (void)lane; (void)wave
    const int G = gridDim.x, bx = blockIdx.x;
    const int wave_s = __builtin_amdgcn_readfirstlane((int)threadIdx.x >> 6);
    typedef const __attribute__((address_space(4))) Params* KParams;
    const KParams kp0 = (KParams)__builtin_amdgcn_kernarg_segment_ptr();
#define PHASE_PTRS() KParams _kp = kp0; asm volatile("" : "+s"(_kp)); Params p; p.x = _kp->x; p.w_in = _kp->w_in; p.b_in = _kp->b_in; p.sinks = _kp->sinks; p.w_out = _kp->w_out; p.b_out = _kp->b_out; p.ln1_g = _kp->ln1_g; p.ln1_b = _kp->ln1_b; \
    p.w_router = _kp->w_router; p.b_router = _kp->b_router; p.w1 = _kp->w1; p.b1 = _kp->b1; p.w2 = _kp->w2; p.b2 = _kp->b2; p.ln2_g = _kp->ln2_g; p.ln2_b = _kp->ln2_b; p.out = _kp->out; p.ws = _kp->ws; unsigned char* const ws = p.ws; \
    unsigned* const ctl = (unsigned*)(ws + WS_CTL); float* const ksum = (float*)(ws + WS_KSUM); float* const rope = (float*)(ws + WS_ROPE); \
    bf16_t* const w_in_t = (bf16_t*)(ws + WS_WIN_T); bf16_t* const w_out_t = (bf16_t*)(ws + WS_WOUT_T); \
    unsigned char* const w1_8 = ws + WS_W1_8; unsigned char* const w2_8 = ws + WS_W2_8; unsigned char* const x1_8 = ws + WS_X1_8; unsigned char* const act8 = ws + WS_ACT8; \
    int* const cnt_blk = (int*)(ws + WS_CNT); int* const tile_e = (int*)(ws + WS_TILE_E); bf16_t* const wr_hi = (bf16_t*)(ws + WS_WR_HI); bf16_t* const wr_lo = (bf16_t*)(ws + WS_WR_LO); \
    int* const tok = (int*)(ws + WS_TOK); int* const asg_e = (int*)(ws + WS_ASG_E); float* const asg_g = (float*)(ws + WS_ASG_G); int* const asg_d = (int*)(ws + WS_ASG_D); \
    bf16_t* const x1b = (bf16_t*)(ws + WS_X1B); bf16_t* const xb = (bf16_t*)(ws + WS_XB); bf16_t* const attn_o = xb; bf16_t* const qkv = (bf16_t*)(ws + WS_QKV); unsigned char* const yb = ws + WS_YB; \
    (void)ctl; (void)ksum; (void)rope; (void)w_in_t; (void)w_out_t; (void)w1_8; (void)w2_8; (void)x1_8; (void)act8; (void)cnt_blk; (void)tile_e; (void)wr_hi; (void)wr_lo; (void)tok; (void)asg_e; (void)asg_g; (void)asg_d; \
    (void)x1b; (void)xb; (void)attn_o; (void)qkv; (void)yb
    { const int t0 = tid_of(wave_s); if (t0 < 2) ((LAS unsigned*)(lds + LDS_BARST))[t0] = 0u; }
    __syncthreads();
    XcdBarrier xbar;
    { PHASE_PTRS(); xbar = xcd_barrier_post(ctl + CW_BAR, (volatile LAS unsigned*)(lds + LDS_BARST), wave_s); }

    REP(0) {
        PHASE_IDS(); PHASE_PTRS();
        const long gt = (long)bx * NTHREADS + tid, gsz = (long)G * NTHREADS;
        for (long i = gt; i < 2048 * 32; i += gsz) {
            const int pos = (int)(i >> 5), k = (int)(i & 31);
            double inv = 1.0; for (int q = 0; q < k; ++q) inv *= 0.7498942093324559;
            double s, c; sincos_d((double)pos * inv, s, c);
            rope[pos * 64 + k] = (float)c; rope[pos * 64 + 32 + k] = (float)s;
        }
        for (long i = gt; i < 32 * 1024; i += gsz) {
            const int e = (int)(i >> 10), k = (int)(i & 1023); const float w = p.w_router[k * 32 + e];
            const unsigned h = f2bf(w); wr_hi[i] = (bf16_t)h; wr_lo[i] = (bf16_t)f2bf(w - bf2f(h));
        }
        LAS float* scr = (LAS float*)(lds + wave * 16384);
        const int gw = bx * 8 + wave, NGW = G * 8;
        constexpr int I_IN = 16 * (INW / 32), I_OUT = 16 * 32, I_W1 = 16 * 64, I_W2 = 16 * 32;
        constexpr int NITEMS = I_IN + I_OUT + NE * I_W1 + NE * I_W2;
        for (int it = gw; it < NITEMS; it += NGW) {
            int r = it;
#if INPROJ_FP8
            if (r < I_IN) { p0_transpose_item_fp8(p.w_in, INW, (unsigned char*)w_in_t, 0, WIN_SCALE, scr, r, lane); continue; } r -= I_IN;
#else
            if (r < I_IN) { p0_transpose_item(p.w_in, INW, w_in_t, 0, scr, r, lane); continue; } r -= I_IN;
#endif
            if (r < I_OUT) { p0_transpose_item(p.w_out, 1024, w_out_t, 1, scr, r, lane); continue; } r -= I_OUT;
            if (r < NE * I_W1) { const int e = r / I_W1; p0_transpose_item_fp8(p.w1 + (size_t)e * 1024 * 2048, 2048, w1_8 + (size_t)e * 2048 * 1024, 2, W_SCALE, scr, r % I_W1, lane); continue; } r -= NE * I_W1;
            { const int e = r / I_W2; p0_transpose_item_fp8(p.w2 + (size_t)e * 1024 * 1024, 1024, w2_8 + (size_t)e * 1024 * 1024, 1, W_SCALE, scr, r % I_W2, lane); }
        }
        const f32x4* x4 = (const f32x4*)p.x;
#if INPROJ_FP8
        u32x2* x8 = (u32x2*)xb;
        for (long i = gt; i < (long)T * D / 8; i += gsz) { const f32x4 a = x4[2 * i], b = x4[2 * i + 1];
            u32x2 o; o.x = pk4_fp8(a[0], a[1], a[2], a[3]); o.y = pk4_fp8(b[0], b[1], b[2], b[3]); x8[i] = o; }
#else
        u32x4* xb4 = (u32x4*)xb;
        for (long i = gt; i < (long)T * D / 8; i += gsz) { const f32x4 a = x4[2 * i], b = x4[2 * i + 1];
            u32x4 o; o.x = cvtpk(a[0], a[1]); o.y = cvtpk(a[2], a[3]); o.z = cvtpk(b[0], b[1]); o.w = cvtpk(b[2], b[3]); xb4[i] = o; }
#endif
    }
    xcd_barrier(xbar, wave_s);

    REP(1) {
        PHASE_PTRS();
#if INPROJ_FP8
        pg8::SchedInProj<1024> S{(const char*)xb, (const char*)w_in_t, G, bx};
        pg8::EpiInProj E{qkv, p.b_in, rope, ksum, 1.0f / WIN_SCALE};
        pg8::gemm_phase<pg8::EpiInProj, pg8::SchedInProj<1024>, false, true, 512, true>(lds, S, E, wave_s);
#else
        pg8::SchedInProj<2048> S{(const char*)xb, (const char*)w_in_t, G, bx};
        pg8::EpiInProj E{qkv, p.b_in, rope, ksum, 1.0f};
        pg8::gemm_phase<pg8::EpiInProj, pg8::SchedInProj<2048>, false, true>(lds, S, E, wave_s);
#endif
    }
    xcd_barrier(xbar, wave_s);

    REP(2) for (int u = bx; u < 256; u += G) {
        PHASE_PTRS();
        { const int b = u >> 3, h = u & 7;
            for (int j = 0; j < 8; ++j) att::moba_unit<8>(b, h, j, qkv, attn_o, ksum, (LAS char*)lds, wave_s); }
        { const int b = u >> 3, kvh = (u >> 2) & 1, oct = u & 3;
            for (int i = 0; i < 8; ++i) att::attn_item<false>((LAS char*)lds, qkv, attn_o, b, kvh, oct * 8 + i, p.sinks, ksum, wave_s); }
    }
    xcd_barrier(xbar, wave_s);

    REP(3) for (int pm = bx; pm < T / 256; pm += G) {
        PHASE_IDS(); PHASE_PTRS();
        {
            pg8::SchedPanel S{(const char*)attn_o, (const char*)w_out_t, pm};
            pg8::EpiOutProj E{(bf16_t*)p.out, p.b_out, p.x};
            pg8::gemm_phase<pg8::EpiOutProj, pg8::SchedPanel, false, true>(lds, S, E, wave_s);
        }
        __syncthreads();
        {
#pragma unroll
            for (int i = 0; i < 16; ++i) { const int idx = tid + 512 * i, mat = idx >> 12, rw = (idx >> 7) & 31, ch = idx & 127;
                const u32x4 v = *(const u32x4*)((mat ? wr_lo : wr_hi) + rw * 1024 + ch * 8);
                *(LAS u32x4*)(lds + mat * 66048 + rw * 2064 + ch * 16) = v; }
        }
        {
            const bf16_t* ytmp = (const bf16_t*)p.out;
            f32x4 gg[2][2], bb[2][2];
#pragma unroll
            for (int j = 0; j < 2; ++j)
#pragma unroll
                for (int h = 0; h < 2; ++h) { gg[j][h] = *(const f32x4*)(p.ln1_g + 512 * j + 8 * lane + 4 * h); bb[j][h] = *(const f32x4*)(p.ln1_b + 512 * j + 8 * lane + 4 * h); }
            for (int rr = 0; rr < 32; rr += 4) {
                const size_t row0 = (size_t)pm * 256 + wave * 32 + rr;
                u32x4 raw[4][2]; float v[4][2][8]; float sm[4], sq[4];
#pragma unroll
                for (int q = 0; q < 4; ++q)
#pragma unroll
                    for (int j = 0; j < 2; ++j) raw[q][j] = *(const u32x4*)(ytmp + (row0 + q) * D + 512 * j + 8 * lane);
#pragma unroll
                for (int q = 0; q < 4; ++q) { float s_ = 0.f;
#pragma unroll
                    for (int j = 0; j < 2; ++j)
#pragma unroll
                        for (int c = 0; c < 4; ++c) { const unsigned w = raw[q][j][c]; v[q][j][2 * c] = bf2f(w & 0xffffu); v[q][j][2 * c + 1] = bf2f(w >> 16); s_ += v[q][j][2 * c] + v[q][j][2 * c + 1]; }
                    sm[q] = s_; }
#pragma unroll
                for (int o = 1; o < 64; o <<= 1) {
#pragma unroll
                    for (int q = 0; q < 4; ++q) sm[q] += __shfl_xor(sm[q], o); }
#pragma unroll
                for (int q = 0; q < 4; ++q) { const float mean = sm[q] * (1.0f / D); float s2 = 0.f;
#pragma unroll
                    for (int j = 0; j < 2; ++j)
#pragma unroll
                        for (int c = 0; c < 8; ++c) { v[q][j][c] -= mean; s2 += v[q][j][c] * v[q][j][c]; }
                    sq[q] = s2; }
#pragma unroll
                for (int o = 1; o < 64; o <<= 1) {
#pragma unroll
                    for (int q = 0; q < 4; ++q) sq[q] += __shfl_xor(sq[q], o); }
#pragma unroll
                for (int q = 0; q < 4; ++q) {
                    const float rstd = 1.0f / sqrtf(sq[q] * (1.0f / D) + LN_EPS);
#pragma unroll
                    for (int j = 0; j < 2; ++j) {
                        float xv[8];
#pragma unroll
                        for (int c = 0; c < 8; ++c) xv[c] = v[q][j][c] * rstd * gg[j][c >> 2][c & 3] + bb[j][c >> 2][c & 3];
                        u32x4 hv; hv.x = cvtpk(xv[0], xv[1]); hv.y = cvtpk(xv[2], xv[3]); hv.z = cvtpk(xv[4], xv[5]); hv.w = cvtpk(xv[6], xv[7]);
                        u32x2 fv; fv.x = pk4_fp8(xv[0], xv[1], xv[2], xv[3]); fv.y = pk4_fp8(xv[4], xv[5], xv[6], xv[7]);
                        *(u32x4*)(x1b + (row0 + q) * D + 512 * j + 8 * lane) = hv;
                        *(u32x2*)(x1_8 + (row0 + q) * D + 512 * j + 8 * lane) = fv;
                    }
                }
            }
        }
        __syncthreads();
        {
            const int fr = lane & 15, fq = lane >> 4;
            f32x4 lacc[2][2];
#pragma unroll
            for (int m = 0; m < 2; ++m)
#pragma unroll
                for (int n = 0; n < 2; ++n) lacc[m][n] = (f32x4){0.f, 0.f, 0.f, 0.f};
            const size_t r0 = (size_t)pm * 256 + wave * 32;
            const bf16_t* ah = x1b + (r0 + fr) * D + 8 * fq;
            const LAS unsigned char* bh = lds + fr * 2064 + 16 * fq; const LAS unsigned char* bl = bh + 66048;
#pragma unroll 4
            for (int k0 = 0; k0 < 1024; k0 += 32) {
                bf16x8 a_hi[2], b_hi[2], b_lo[2];
#pragma unroll
                for (int m = 0; m < 2; ++m) a_hi[m] = *(const bf16x8*)(ah + (size_t)m * 16 * D + k0);
#pragma unroll
                for (int n = 0; n < 2; ++n) { b_hi[n] = *(const LAS bf16x8*)(bh + n * 16 * 2064 + k0 * 2); b_lo[n] = *(const LAS bf16x8*)(bl + n * 16 * 2064 + k0 * 2); }
#pragma unroll
                for (int m = 0; m < 2; ++m)
#pragma unroll
                    for (int n = 0; n < 2; ++n) {
                        lacc[m][n] = __builtin_amdgcn_mfma_f32_16x16x32_bf16(a_hi[m], b_hi[n], lacc[m][n], 0, 0, 0);
                        lacc[m][n] = __builtin_amdgcn_mfma_f32_16x16x32_bf16(a_hi[m], b_lo[n], lacc[m][n], 0, 0, 0);
                    }
            }
            __syncthreads();
            LAS float* lg = (LAS float*)lds;
#pragma unroll
            for (int m = 0; m < 2; ++m)
#pragma unroll
                for (int n = 0; n < 2; ++n)
#pragma unroll
                    for (int rg = 0; rg < 4; ++rg) lg[(wave * 32 + 16 * m + 4 * fq + rg) * 33 + 16 * n + fr] = lacc[m][n][rg];
        }
        __syncthreads();
        {
            LAS float* lg = (LAS float*)lds;
            LAS int* wcnt = (LAS int*)(lds + 36864);
            float t0 = -INFINITY, t1 = -INFINITY, t2 = -INFINITY, t3 = -INFINITY; int i0 = 0, i1 = 0, i2 = 0, i3 = 0;
            int rk0 = 0, rk1 = 0, rk2 = 0, rk3 = 0;
            if (tid < 256) {
                for (int e = 0; e < NE; ++e) {
                    const float xv = lg[tid * 33 + e] + p.b_router[e];
                    if (xv > t3) {
                        if (xv > t2) { t3 = t2; i3 = i2;
                            if (xv > t1) { t2 = t1; i2 = i1;
                                if (xv > t0) { t1 = t0; i1 = i0; t0 = xv; i0 = e; } else { t1 = xv; i1 = e; }
                            } else { t2 = xv; i2 = e; }
                        } else { t3 = xv; i3 = e; }
                    }
                }
                const unsigned selm = (1u << i0) | (1u << i1) | (1u << i2) | (1u << i3);
                for (int e = 0; e < NE; ++e) {
                    const bool has = ((selm >> e) & 1u) != 0u;
                    const unsigned long long bal = __ballot(has);
                    const int pre = __popcll(bal & ((1ull << lane) - 1ull));
                    if (e == i0) rk0 = pre; if (e == i1) rk1 = pre; if (e == i2) rk2 = pre; if (e == i3) rk3 = pre;
                    if (lane == 0) wcnt[wave * 32 + e] = __popcll(bal);
                }
            }
            __syncthreads();
            if (tid < 256) {
                const float e1 = __expf(t1 - t0), e2 = __expf(t2 - t0), e3 = __expf(t3 - t0);
                const float inv = 1.0f / (1.0f + e1 + e2 + e3);
                int b0 = 0, b1 = 0, b2 = 0, b3 = 0;
                for (int w = 0; w < wave; ++w) { b0 += wcnt[w * 32 + i0]; b1 += wcnt[w * 32 + i1]; b2 += wcnt[w * 32 + i2]; b3 += wcnt[w * 32 + i3]; }
                const size_t a = ((size_t)pm * 256 + tid) * 4;
                *(int4*)(asg_e + a) = make_int4(i0, i1, i2, i3);
                *(float4*)(asg_g + a) = make_float4(inv, e1 * inv, e2 * inv, e3 * inv);
                *(int4*)(asg_d + a) = make_int4(b0 + rk0, b1 + rk1, b2 + rk2, b3 + rk3);
            }
            if (tid < 32) cnt_blk[pm * 32 + tid] = wcnt[tid] + wcnt[32 + tid] + wcnt[64 + tid] + wcnt[96 + tid];
            __syncthreads();
        }
    }
    xcd_barrier(xbar, wave_s);

    for (int pm = bx; pm < T / 256; pm += G) {
        PHASE_IDS(); PHASE_PTRS();
        LAS int* part_all = (LAS int*)lds; LAS int* part_pre = part_all + 512; LAS int* tot = part_pre + 512; LAS int* pre = tot + 32; LAS int* poff = pre + 32;
        { const int e = tid & 31, seg = tid >> 5; int sa = 0, sp = 0;
            for (int bb = seg * 16; bb < seg * 16 + 16; ++bb) { const int c = cnt_blk[bb * 32 + e]; sa += c; sp += (bb < pm) ? c : 0; }
            part_all[tid] = sa; part_pre[tid] = sp; }
        __syncthreads();
        if (tid < 32) { int sa = 0, sp = 0; for (int s = 0; s < 16; ++s) { sa += part_all[s * 32 + tid]; sp += part_pre[s * 32 + tid]; } tot[tid] = sa; pre[tid] = sp; }
        __syncthreads();
        if (tid == 0) { int off = 0; for (int e = 0; e < NE; ++e) { poff[e] = off; off += ((tot[e] + 255) >> 8) << 8; } poff[32] = off; }
        __syncthreads();
        if (tid < 256) {
            const int token = pm * 256 + tid; const size_t a = (size_t)token * 4;
            const int4 ee = *(const int4*)(asg_e + a); const int4 rk = *(const int4*)(asg_d + a);
            const int d0 = poff[ee.x] + pre[ee.x] + rk.x, d1 = poff[ee.y] + pre[ee.y] + rk.y, d2 = poff[ee.z] + pre[ee.z] + rk.z, d3 = poff[ee.w] + pre[ee.w] + rk.w;
            *(int4*)(asg_d + a) = make_int4(d0, d1, d2, d3);
            tok[d0] = token; tok[d1] = token; tok[d2] = token; tok[d3] = token;
        }
        if (pm < NE) {
            const int e = pm, n = tot[e], np = ((n + 255) >> 8) << 8, o = poff[e];
            for (int i = n + tid; i < np; i += NTHREADS) tok[o + i] = 0;
            for (int i = tid; i < (np >> 8); i += NTHREADS) tile_e[(o >> 8) + i] = e;
        }
        if (pm == 0 && tid == 0) ctl[CW_NTILES] = (unsigned)(poff[32] >> 8);
        __syncthreads();
    }
    xcd_barrier(xbar, wave_s);

    REP(5) {
        PHASE_PTRS(); const int ntiles = (int)ctl[CW_NTILES];
        { LAS int* tl = (LAS int*)(lds + LDSX_TILE); for (int i = tid_of(wave_s); i < ntiles; i += NTHREADS) tl[i] = tile_e[i]; __syncthreads(); }
        pg8::SchedMoe<8, true> S{(const char*)x1_8, (const char*)w1_8, (const LAS int*)(lds + LDSX_TILE), tok, ntiles, G, bx};
        pg8::EpiSwiglu E{act8, p.b1};
        pg8::gemm_phase<pg8::EpiSwiglu, pg8::SchedMoe<8, true>, true, true, 512, true, true>(lds, S, E, wave_s);
    }
    xcd_barrier(xbar, wave_s);

    REP(6) {
        PHASE_PTRS(); const int ntiles = (int)ctl[CW_NTILES];
        { LAS int* tl = (LAS int*)(lds + LDSX_TILE); for (int i = tid_of(wave_s); i < ntiles; i += NTHREADS) tl[i] = tile_e[i]; __syncthreads(); }
        pg8::SchedMoe<4, false> S{(const char*)act8, (const char*)w2_8, (const LAS int*)(lds + LDSX_TILE), tok, ntiles, G, bx};
        pg8::EpiDown E{yb, p.b2};
        pg8::gemm_phase<pg8::EpiDown, pg8::SchedMoe<4, false>, false, true, 512, true, true>(lds, S, E, wave_s);
    }
    xcd_barrier(xbar, wave_s);

    REP(7) {
        PHASE_IDS(); PHASE_PTRS();
        const int gw = bx * 8 + wave, NGW = G * 8;
        f32x4 gg[2][2], bb[2][2];
#pragma unroll
        for (int j = 0; j < 2; ++j)
#pragma unroll
            for (int h = 0; h < 2; ++h) { gg[j][h] = *(const f32x4*)(p.ln2_g + 512 * j + 8 * lane + 4 * h); bb[j][h] = *(const f32x4*)(p.ln2_b + 512 * j + 8 * lane + 4 * h); }
        constexpr int R = 2;
        for (int row0 = gw; row0 < T; row0 += R * NGW) {
            int4 dd[R]; float4 gt[R];
#pragma unroll
            for (int q = 0; q < R; ++q) { const int row = row0 + q * NGW < T ? row0 + q * NGW : row0; dd[q] = *(const int4*)(asg_d + (size_t)row * 4); gt[q] = *(const float4*)(asg_g + (size_t)row * 4); }
            u32x4 xr[R][2]; u32x2 yk[R][4][2];
#pragma unroll
            for (int q = 0; q < R; ++q) { const int row = row0 + q * NGW < T ? row0 + q * NGW : row0;
#pragma unroll
                for (int j = 0; j < 2; ++j) {
                    xr[q][j] = *(const u32x4*)(x1b + (size_t)row * D + 512 * j + 8 * lane);
                    yk[q][0][j] = *(const u32x2*)(yb + (size_t)dd[q].x * D + 512 * j + 8 * lane);
                    yk[q][1][j] = *(const u32x2*)(yb + (size_t)dd[q].y * D + 512 * j + 8 * lane);
                    yk[q][2][j] = *(const u32x2*)(yb + (size_t)dd[q].z * D + 512 * j + 8 * lane);
                    yk[q][3][j] = *(const u32x2*)(yb + (size_t)dd[q].w * D + 512 * j + 8 * lane);
                } }
            float z[R][2][8]; float sm[R], sq[R];
#pragma unroll
            for (int q = 0; q < R; ++q) {
                const float g0 = gt[q].x * (1.0f / Y_SCALE), g1 = gt[q].y * (1.0f / Y_SCALE), g2 = gt[q].z * (1.0f / Y_SCALE), g3 = gt[q].w * (1.0f / Y_SCALE);
                float s_ = 0.f;
#pragma unroll
                for (int j = 0; j < 2; ++j)
#pragma unroll
                    for (int d = 0; d < 2; ++d) {
#define P7_PAIR(HH, SEL) do { \
                            const f32x2 a0 = __builtin_amdgcn_cvt_pk_f32_fp8((int)yk[q][0][j][d], SEL), a1 = __builtin_amdgcn_cvt_pk_f32_fp8((int)yk[q][1][j][d], SEL); \
                            const f32x2 a2 = __builtin_amdgcn_cvt_pk_f32_fp8((int)yk[q][2][j][d], SEL), a3 = __builtin_amdgcn_cvt_pk_f32_fp8((int)yk[q][3][j][d], SEL); \
                            const unsigned xw = xr[q][j][2 * d + HH]; \
                            const float lo = DN_ALPHA * bf2f(xw & 0xffffu) + g0 * a0.x + g1 * a1.x + g2 * a2.x + g3 * a3.x; \
                            const float hi = DN_ALPHA * bf2f(xw >> 16) + g0 * a0.y + g1 * a1.y + g2 * a2.y + g3 * a3.y; \
                            z[q][j][4 * d + 2 * HH] = lo; z[q][j][4 * d + 2 * HH + 1] = hi; s_ += lo + hi; } while (0)
                        P7_PAIR(0, false); P7_PAIR(1, true);
#undef P7_PAIR
                    }
                sm[q] = s_;
            }
#pragma unroll
            for (int o = 1; o < 64; o <<= 1) {
#pragma unroll
                for (int q = 0; q < R; ++q) sm[q] += __shfl_xor(sm[q], o); }
#pragma unroll
            for (int q = 0; q < R; ++q) { const float mean = sm[q] * (1.0f / D); float s2 = 0.f;
#pragma unroll
                for (int j = 0; j < 2; ++j)
#pragma unroll
                    for (int c = 0; c < 8; ++c) { z[q][j][c] -= mean; s2 += z[q][j][c] * z[q][j][c]; }
                sq[q] = s2; }
#pragma unroll
            for (int o = 1; o < 64; o <<= 1) {
#pragma unroll
                for (int q = 0; q < R; ++q) sq[q] += __shfl_xor(sq[q], o); }
#pragma unroll
            for (int q = 0; q < R; ++q) {
                const int row = row0 + q * NGW;
                if (row < T) {
                    const float rstd = 1.0f / sqrtf(sq[q] * (1.0f / D) + LN_EPS);
#pragma unroll
                    for (int j = 0; j < 2; ++j)
#pragma unroll
                        for (int h = 0; h < 2; ++h) {
                            f32x4 o;
#pragma unroll
                            for (int c = 0; c < 4; ++c) o[c] = z[q][j][4 * h + c] * rstd * gg[j][h][c] + bb[j][h][c];
                            *(f32x4*)(p.out + (size_t)row * D + 512 * j + 8 * lane + 4 * h) = o;
                        }
                }
            }
        }
    }
}

extern "C" void kernel_launch(void* const* d_in, const int* in_sizes, int n_in, void* d_out, int out_size, void* d_ws, size_t ws_size, hipStream_t stream) {
    static int grid_blocks = 0;
    if (grid_blocks == 0) {
        if (n_in != 16 || in_sizes[0] != T * D || out_size != T * D || ws_size < WS_END) {
            fprintf(stderr, "kernel_launch: unexpected shapes: n_in %d in0 %d out %d ws %zu (need %zu)\n", n_in, n_in > 0 ? in_sizes[0] : -1, out_size, ws_size, (size_t)WS_END); grid_blocks = -1; return; }
        int dev = 0, cus = 0, per_cu = 0;
        (void)hipGetDevice(&dev);
        (void)hipDeviceGetAttribute(&cus, hipDeviceAttributeMultiprocessorCount, dev);
        (void)hipFuncSetAttribute((const void*)fwd_megakernel, hipFuncAttributeMaxDynamicSharedMemorySize, LDS_BYTES);
        (void)hipOccupancyMaxActiveBlocksPerMultiprocessor(&per_cu, (const void*)fwd_megakernel, NTHREADS, LDS_BYTES);
        if (per_cu < 1) { fprintf(stderr, "kernel_launch: occupancy query reports %d blocks per CU\n", per_cu); per_cu = 1; }
        grid_blocks = cus;
        fprintf(stderr, "kernel_launch: cus=%d per_cu=%d grid=%d ws=%zu\n", cus, per_cu, grid_blocks, ws_size);
    }
    if (grid_blocks < 0) return;
    (void)hipMemsetAsync((char*)d_ws + WS_CTL, 0, CTL_ZERO_BYTES, stream);
    Params p{};
    p.x = (const float*)d_in[0]; p.w_in = (const float*)d_in[1]; p.b_in = (const float*)d_in[2]; p.sinks = (const float*)d_in[3]; p.w_out = (const float*)d_in[4]; p.b_out = (const float*)d_in[5];
    p.ln1_g = (const float*)d_in[6]; p.ln1_b = (const float*)d_in[7]; p.w_router = (const float*)d_in[8]; p.b_router = (const float*)d_in[9];
    p.w1 = (const float*)d_in[10]; p.b1 = (const float*)d_in[11]; p.w2 = (const float*)d_in[12]; p.b2 = (const float*)d_in[13]; p.ln2_g = (const float*)d_in[14]; p.ln2_b = (const float*)d_in[15];
    p.out = (float*)d_out; p.ws = (unsigned char*)d_ws;
    hipLaunchKernelGGL(fwd_megakernel, dim3(grid_blocks), dim3(NTHREADS), LDS_BYTES, stream, p);
    hipError_t e = hipPeekAtLastError();
    if (e != hipSuccess) fprintf(stderr, "launch failed: %s (grid %d)\n", hipGetErrorString(e), grid_blocks);
}
```

```cpp
#include <hip/hip_runtime.h>
#include <cstdio>
#include <cstdint>

#define LAS __attribute__((address_space(3)))
typedef unsigned short bf16_t;
typedef short bf16x8 __attribute__((ext_vector_type(8)));
typedef short s16x4 __attribute__((ext_vector_type(4)));
typedef float f32x2 __attribute__((ext_vector_type(2)));
typedef float f32x4 __attribute__((ext_vector_type(4)));
typedef float f32x16 __attribute__((ext_vector_type(16)));
typedef unsigned u32x2 __attribute__((ext_vector_type(2)));
typedef unsigned u32x4 __attribute__((ext_vector_type(4)));
typedef __bf16 bf16x2_t __attribute__((ext_vector_type(2)));

constexpr int D = 1024, BATCH = 32, SEQ = 2048, T = BATCH * SEQ;
constexpr int INW = 2304, NE = 32;
constexpr float LN_EPS = 1e-5f;
constexpr float DN_ALPHA = 1.189207115002721f;
constexpr float LOG2E = 1.4426950408889634f;
constexpr float C2 = 0.18033688011112042f;
constexpr int NTHREADS = 512;
constexpr int LDS_BYTES = 147456;
constexpr int MAX_TILES = 1056;
#ifndef INPROJ_FP8
#define INPROJ_FP8 1
#endif
#ifndef EPI_DUP
#define EPI_DUP 0
#endif
#ifndef DUP_MASK
#define DUP_MASK 0
#endif
#define REP(k) for (int _rep = 0; _rep < (((DUP_MASK >> (k)) & 1) ? 2 : 1); ++_rep)

constexpr size_t MiB = 1u << 20;
constexpr size_t WS_CTL = 0, CTL_ZERO_BYTES = 2 * MiB;
constexpr size_t WS_KSUM = 1 * MiB;
constexpr size_t WS_ROPE = 2 * MiB;
constexpr size_t WS_WIN_T = 4 * MiB;
constexpr size_t WS_WOUT_T = 9 * MiB;
constexpr size_t WS_SMALL = 11 * MiB;
constexpr size_t WS_CNT = WS_SMALL, WS_TILE_E = WS_SMALL + 65536, WS_WR_HI = WS_SMALL + 131072, WS_WR_LO = WS_WR_HI + 65536;
constexpr size_t WS_TOK = 12 * MiB;
constexpr size_t WS_ASG_E = 14 * MiB, WS_ASG_G = 15 * MiB, WS_ASG_D = 16 * MiB;
constexpr size_t WS_W2_8 = 24 * MiB;
constexpr size_t WS_X1B = 56 * MiB;
constexpr size_t WS_ACT8 = 184 * MiB;
constexpr size_t WS_XB = 184 * MiB;
constexpr size_t WS_X1LO = 312 * MiB;
constexpr size_t WS_YB = 488 * MiB;
constexpr size_t WS_W1_8 = 488 * MiB;
constexpr size_t WS_X1_8 = 552 * MiB;
constexpr size_t WS_QKV = 616 * MiB;
constexpr size_t WS_END = 1016 * MiB;
constexpr float W_SCALE = 64.0f, ACT_SCALE = 4.0f, WIN_SCALE = 32.0f, Y_SCALE = 16.0f;
constexpr int CW_NTILES = 16, CW_BAR = 4096;
constexpr int LDSX_TILE = 131072, LDSX_IDX = 135424, LDSX_BIAS = 136448;
constexpr int LDS_BARST = LDS_BYTES - 256;

struct Params {
    const float *x, *w_in, *b_in, *sinks, *w_out, *b_out, *ln1_g, *ln1_b, *w_router, *b_router, *w1, *b1, *w2, *b2, *ln2_g, *ln2_b;
    float* out; unsigned char* ws;
};

__device__ __forceinline__ unsigned f2bf(float f) { unsigned u = __builtin_bit_cast(unsigned, f); return (u + 0x7fffu + ((u >> 16) & 1u)) >> 16; }
__device__ __forceinline__ float bf2f(unsigned h) { return __builtin_bit_cast(float, h << 16); }
__device__ __forceinline__ unsigned cvtpk(float lo, float hi) { f32x2 v = {lo, hi}; bf16x2_t b = __builtin_convertvector(v, bf16x2_t); return __builtin_bit_cast(unsigned, b); }
__device__ __forceinline__ unsigned pk4_fp8(float a, float b, float c, float d) { int w = 0; w = __builtin_amdgcn_cvt_pk_fp8_f32(a, b, w, false); w = __builtin_amdgcn_cvt_pk_fp8_f32(c, d, w, true); return (unsigned)w; }
__device__ __forceinline__ float wave_sum(float v) {
#pragma unroll
    for (int o = 1; o < 64; o <<= 1) v += __shfl_xor(v, o);
    return v;
}
#define LDS_WAIT() asm volatile("s_waitcnt lgkmcnt(0)" ::: "memory")
__device__ __forceinline__ int tid_of(int wave_s) { unsigned z = 0u; asm volatile("" : "+v"(z));
    return wave_s * 64 + (int)__builtin_amdgcn_mbcnt_hi(~0u, __builtin_amdgcn_mbcnt_lo(~0u, z)); }
template <int X> __device__ __forceinline__ float swz_xor(float v) { return __builtin_bit_cast(float, __builtin_amdgcn_ds_swizzle(__builtin_bit_cast(int, v), (X << 10) | 0x1f)); }

namespace pg8 {
constexpr int BM = 256, BK = 64, HALF = 128, HTB = HALF * BK * 2, STAGE_BYTES = 8 * HTB, NXCD = 8, WGM = 8;
constexpr int KD = 1024;
__host__ __device__ __forceinline__ int lds_byte(int r, int c) { const int st = (r >> 4) * 2 + (c >> 5), rr = r & 15, cc = c & 31, ob = rr * 64 + cc * 2; return st * 1024 + (ob ^ (((ob >> 9) & 1) << 5)); }
__host__ __device__ __forceinline__ void stage_rc(int b, int& R, int& C) { const int st = b / 1024, sb = b % 1024, swz = sb ^ (((sb >> 9) & 1) << 5); R = (st >> 1) * 16 + swz / 64; C = (st & 1) * 32 + (swz % 64) / 2; }
__host__ __device__ __forceinline__ int perm32(int rho) { const int n = rho >> 4, i = rho & 15; return 8 * (i >> 2) + 4 * n + (i & 3); }

struct Unit { int pm, pn, e; unsigned ao, bo; const int* rows; };

typedef int v8i32_t __attribute__((ext_vector_type(8)));
typedef int v4i32_t __attribute__((ext_vector_type(4)));
__device__ __forceinline__ v8i32_t cat8(bf16x8 a, bf16x8 b) { const v4i32_t x = __builtin_bit_cast(v4i32_t, a), y = __builtin_bit_cast(v4i32_t, b); return __builtin_shufflevector(x, y, 0, 1, 2, 3, 4, 5, 6, 7); }
template <class Epi, class Sched, bool GATHER, bool ALIGN_EPI, int KP = 1024, bool FP8 = false, bool MOE = false>
__device__ __forceinline__ void gemm_phase(LAS unsigned char* lds, const Sched& S, const Epi& E, const int wave_s) {
    int tid = tid_of(wave_s); asm volatile("" : "+v"(tid));
    const int wid = __builtin_amdgcn_readfirstlane(tid >> 6), lane = tid & 63, wr = wid >> 2, wc = wid & 3, fr = lane & 15, fq = lane >> 4;
    constexpr int K = KP, nt = K / BK;
    unsigned voffB[2], Vc[2][2]; int stR0, stC0;
    { int R, C; stage_rc(tid * 16, R, C); stR0 = R; stC0 = C; }
#pragma unroll
    for (int i = 0; i < 2; ++i) { voffB[i] = (unsigned)((stR0 + 64 * i) * K + stC0) * 2u; Vc[0][i] = voffB[i]; Vc[1][i] = voffB[i]; }
#define PG8_GATHER_LOAD(VV) do { int _t = tid_of(wave_s); asm volatile("" : "+v"(_t)); int _R, _C; stage_rc(_t * 16, _R, _C);     \
        const LAS int* _rp = (const LAS int*)(lds + LDSX_IDX) + _R; _Pragma("unroll") for (int _h = 0; _h < 2; ++_h) _Pragma("unroll") for (int _i = 0; _i < 2; ++_i) \
        VV[_h][_i] = ((unsigned)_rp[128 * _h + 64 * _i] * (unsigned)K + (unsigned)_C) * 2u; } while (0)
#define PG8_DMA4(gsrc, ldsoff) __builtin_amdgcn_global_load_lds((const unsigned*)(gsrc), (LAS unsigned*)(lds + (ldsoff)), 4, 0, 0)
    constexpr unsigned kstep = (unsigned)(BK * 2);
    constexpr unsigned hstep = (unsigned)HALF * K * 2;
    const char* const Abase = S.A; const char* const Bbase = S.B;
    const unsigned ldsw = (unsigned)wid * 1024u;
    const int aoff = lds_byte(wr * 64 + fr, fq * 8), boff = lds_byte(wc * 32 + fr, fq * 8);
#define PG8_SA(b, h) (((b) * 2 + (h)) * HTB)
#define PG8_SB(b, h) ((4 + (b) * 2 + (h)) * HTB)
#define PG8_STAGE(bufoff, gbase, soff, voff) do { _Pragma("unroll") for (int _i = 0; _i < 2; ++_i) \
        __builtin_amdgcn_global_load_lds((const unsigned*)((gbase) + (unsigned)((voff)[_i] + (soff))), (LAS unsigned*)(lds + (bufoff) + ldsw + _i * 8192), 16, 0, 0); } while (0)
#define PG8_STAGE_B(bufoff, soff) PG8_STAGE(bufoff, Bbase, soff, voffB)
#define PG8_STAGE_A(bufoff, soff, h, VV) do { if constexpr (GATHER) { PG8_STAGE(bufoff, Abase, soff, VV[h]); } else { PG8_STAGE(bufoff, Abase, (soff) + (h) * hstep, voffB); } } while (0)
#define PG8_LDA(dst, b, h) do { _Pragma("unroll") for (int m = 0; m < 4; ++m) dst[m] = cat8(*(const LAS bf16x8*)(lds + PG8_SA(b, h) + aoff + m * 2048), *(const LAS bf16x8*)(lds + PG8_SA(b, h) + aoff + m * 2048 + 1024)); } while (0)
#define PG8_LDB(dst, b, h) do { _Pragma("unroll") for (int n = 0; n < 2; ++n) dst[n] = cat8(*(const LAS bf16x8*)(lds + PG8_SB(b, h) + boff + n * 2048), *(const LAS bf16x8*)(lds + PG8_SB(b, h) + boff + n * 2048 + 1024)); } while (0)
#define PG8_LO(v) __builtin_bit_cast(bf16x8, __builtin_shufflevector(v, v, 0, 1, 2, 3))
#define PG8_HI(v) __builtin_bit_cast(bf16x8, __builtin_shufflevector(v, v, 4, 5, 6, 7))
#define PG8_MMA(ai, bj, At, Bt) do { __builtin_amdgcn_s_setprio(1); _Pragma("unroll") for (int m = 0; m < 4; ++m) _Pragma("unroll") for (int n = 0; n < 2; ++n) { \
        if constexpr (FP8) { acc[ai][bj][m][n] = __builtin_amdgcn_mfma_scale_f32_16x16x128_f8f6f4(Bt[n], At[m], acc[ai][bj][m][n], 0, 0, 0, 0x7f7f7f7f, 0, 0x7f7f7f7f); } \
        else { acc[ai][bj][m][n] = __builtin_amdgcn_mfma_f32_16x16x32_bf16(PG8_LO(Bt[n]), PG8_LO(At[m]), acc[ai][bj][m][n], 0, 0, 0); \
               acc[ai][bj][m][n] = __builtin_amdgcn_mfma_f32_16x16x32_bf16(PG8_HI(Bt[n]), PG8_HI(At[m]), acc[ai][bj][m][n], 0, 0, 0); } } \
        __builtin_amdgcn_s_setprio(0); } while (0)
#define PG8_WAIT_V(n) asm volatile("s_waitcnt vmcnt(" #n ")" ::: "memory")
#define PG8_WAIT_L(n) asm volatile("s_waitcnt lgkmcnt(" #n ")" ::: "memory")
#define PG8_BAR __builtin_amdgcn_s_barrier()
#define PG8_SCHED __builtin_amdgcn_sched_barrier(0)
    Unit cur, nxt; int ui = 0;
    if (!S.next(0, cur)) return;
    if constexpr (MOE) {
        if (wid < 4) { PG8_DMA4(E.bias_src(cur) + wid * 64 + lane, LDSX_BIAS + wid * 256); if constexpr (GATHER) PG8_DMA4(cur.rows + wid * 64 + lane, LDSX_IDX + wid * 256); }
        asm volatile("s_waitcnt vmcnt(0)" ::: "memory"); __builtin_amdgcn_s_barrier(); asm volatile("" ::: "memory");
    }
    if constexpr (GATHER) { PG8_GATHER_LOAD(Vc); }
    f32x4 acc[2][2][4][2];
#pragma unroll
    for (int a = 0; a < 2; ++a)
#pragma unroll
        for (int b = 0; b < 2; ++b)
#pragma unroll
            for (int m = 0; m < 4; ++m)
#pragma unroll
                for (int n = 0; n < 2; ++n) acc[a][b][m][n] = (f32x4){0.f, 0.f, 0.f, 0.f};
    v8i32_t At[4], B0[2], B1[2];
    unsigned cA = cur.ao, cB = cur.bo;
    PG8_STAGE_B(PG8_SB(0, 0), cB); PG8_STAGE_B(PG8_SB(0, 1), cB + hstep); PG8_STAGE_A(PG8_SA(0, 0), cA, 0, Vc); PG8_STAGE_A(PG8_SA(0, 1), cA, 1, Vc);
    if (wr == 1) PG8_BAR;
    PG8_WAIT_V(2); PG8_BAR;
    PG8_STAGE_B(PG8_SB(1, 0), cB + kstep); PG8_STAGE_A(PG8_SA(1, 0), cA + kstep, 0, Vc); PG8_STAGE_B(PG8_SB(1, 1), cB + hstep + kstep);
    PG8_WAIT_V(6); PG8_BAR;
    for (;;) {
        const bool has_next = S.next(ui + 1, nxt);
        const unsigned nA = has_next ? nxt.ao : cA; const unsigned nB = has_next ? nxt.bo : cB;
        if constexpr (MOE) {
            if (has_next && wid < 4) { PG8_DMA4(E.bias_src(nxt) + wid * 64 + lane, LDSX_BIAS + ((ui + 1) % 3) * 1024 + wid * 256); if constexpr (GATHER) PG8_DMA4(nxt.rows + wid * 64 + lane, LDSX_IDX + wid * 256); }
        }
#pragma unroll 1
        for (int t = 0; t < nt; t += 2) {
            const bool last = (t == nt - 2);
            const unsigned a1 = cA + (unsigned)(t + 1) * kstep;
            const unsigned a2 = last ? nA : cA + (unsigned)(t + 2) * kstep; const unsigned b2 = last ? nB : cB + (unsigned)(t + 2) * kstep;
            const unsigned a3 = a2 + kstep; const unsigned b3 = b2 + kstep;
            PG8_LDB(B0, 0, 0); PG8_LDB(B1, 0, 1); PG8_SCHED; PG8_LDA(At, 0, 0); PG8_STAGE_A(PG8_SA(1, 1), a1, 1, Vc);
            if constexpr (GATHER) { if (last && has_next) { PG8_GATHER_LOAD(Vc); } }
            PG8_WAIT_V(8); PG8_WAIT_L(0); PG8_BAR; PG8_MMA(0, 0, At, B0); PG8_MMA(0, 1, At, B1); PG8_BAR; PG8_SCHED;
            PG8_LDA(At, 0, 1); PG8_STAGE_B(PG8_SB(0, 0), b2); PG8_STAGE_B(PG8_SB(0, 1), b2 + hstep); PG8_STAGE_A(PG8_SA(0, 0), a2, 0, Vc);
            PG8_WAIT_V(8); PG8_WAIT_L(0); PG8_BAR; PG8_MMA(1, 0, At, B0); PG8_MMA(1, 1, At, B1); PG8_BAR; PG8_SCHED;
            PG8_LDB(B0, 1, 0); PG8_LDB(B1, 1, 1); PG8_SCHED; PG8_LDA(At, 1, 0); PG8_STAGE_A(PG8_SA(0, 1), a2, 1, Vc);
            PG8_WAIT_V(8); PG8_WAIT_L(0); PG8_BAR; PG8_MMA(0, 0, At, B0); PG8_MMA(0, 1, At, B1); PG8_BAR; PG8_SCHED;
            PG8_LDA(At, 1, 1); PG8_STAGE_B(PG8_SB(1, 0), b3); PG8_STAGE_B(PG8_SB(1, 1), b3 + hstep); PG8_STAGE_A(PG8_SA(1, 0), a3, 0, Vc);
            PG8_WAIT_V(8); PG8_WAIT_L(0); PG8_BAR; PG8_MMA(1, 0, At, B0); PG8_MMA(1, 1, At, B1); PG8_BAR; PG8_SCHED;
        }
        if constexpr (ALIGN_EPI) { if (wr == 0) PG8_BAR; }
        { int t2 = tid_of(wave_s); asm volatile("" : "+v"(t2));
          if constexpr (MOE) { E(acc, cur, wr, wc, t2 & 15, (t2 & 63) >> 4, (const LAS float*)(lds + LDSX_BIAS + (ui % 3) * 1024));
              if (EPI_DUP) { asm volatile("" : "+v"(t2)); E(acc, cur, wr, wc, t2 & 15, (t2 & 63) >> 4, (const LAS float*)(lds + LDSX_BIAS + (ui % 3) * 1024)); } }
          else E(acc, cur, wr, wc, t2 & 15, (t2 & 63) >> 4); }
        if (!has_next) break;
#pragma unroll
        for (int a = 0; a < 2; ++a)
#pragma unroll
            for (int b = 0; b < 2; ++b)
#pragma unroll
                for (int m = 0; m < 4; ++m)
#pragma unroll
                    for (int n = 0; n < 2; ++n) acc[a][b][m][n] = (f32x4){0.f, 0.f, 0.f, 0.f};
        cur = nxt; cA = nA; cB = nB; ++ui;
        if constexpr (ALIGN_EPI) { if (wr == 1) PG8_BAR; }
    }
    PG8_WAIT_V(0);
    if constexpr (!ALIGN_EPI) { if (wr == 0) PG8_BAR; }
    PG8_BAR;
#undef PG8_SA
#undef PG8_SB
#undef PG8_STAGE
#undef PG8_STAGE_A
#undef PG8_STAGE_B
#undef PG8_GATHER_LOAD
#undef PG8_DMA4
#undef PG8_LDA
#undef PG8_LDB
#undef PG8_LO
#undef PG8_HI
#undef PG8_MMA
#undef PG8_WAIT_V
#undef PG8_WAIT_L
#undef PG8_BAR
#undef PG8_SCHED
}

template <int ROWB>
struct SchedInProj {
    const char* A; const char* B; int G, c;
    __device__ __forceinline__ bool next(int i, Unit& u) const {
        constexpr int nM = T / BM, nN = INW / BM, nwg = nM * nN;
        const long L = (long)i * G + c; if (L >= nwg) return false;
        int wgid = (int)L; { const int q = nwg / NXCD, r = nwg % NXCD, xcd = wgid % NXCD, off = wgid / NXCD; wgid = (xcd < r ? xcd * (q + 1) : r * (q + 1) + (xcd - r) * q) + off; }
        const int nig = WGM * nN, gid = wgid / nig, fm = gid * WGM, gsz = (nM - fm) < WGM ? (nM - fm) : WGM;
        u.pm = fm + ((wgid % nig) % gsz); u.pn = (wgid % nig) / gsz; u.e = 0; u.rows = nullptr;
        u.ao = (unsigned)u.pm * (unsigned)(256 * ROWB); u.bo = (unsigned)u.pn * (unsigned)(256 * ROWB); return true;
    }
};
struct SchedPanel {
    const char* A; const char* B; int pm;
    __device__ __forceinline__ bool next(int i, Unit& u) const {
        if (i >= 4) return false;
        u.pm = pm; u.pn = i; u.e = 0; u.rows = nullptr; u.ao = (unsigned)pm * (unsigned)(256 * KD * 2); u.bo = (unsigned)i * (unsigned)(256 * KD * 2); return true;
    }
};
template <int NPN, bool G1>
struct SchedMoe {
    const char* A; const char* B; const LAS int* tile_e; const int* tok; int ntiles, G, c;
    __device__ __forceinline__ bool next(int i, Unit& u) const {
        const long L = (long)i * G + c; int t, pn;
        if ((G & 7) == 0) { const int x = (int)(L & 7); const long j = L >> 3; t = (int)(j / NPN) * 8 + x; pn = (int)(j % NPN); }
        else { t = (int)(L / NPN); pn = (int)(L % NPN); }
        if (t >= ntiles) return false;
        const int e = __builtin_amdgcn_readfirstlane(tile_e[t]);
        u.pm = t; u.pn = pn; u.e = e;
        if (G1) { u.ao = 0u; u.rows = tok + (size_t)t * 256; u.bo = ((unsigned)e * 2048u + (unsigned)pn * 256u) * 1024u; }
        else { u.ao = (unsigned)t * (256u * 1024u); u.rows = nullptr; u.bo = ((unsigned)e * 1024u + (unsigned)pn * 256u) * 1024u; }
        return true;
    }
};

struct EpiInProj {
    bf16_t* qkv; const float* b_in; const float* rope; float* ksum; float descale;
    __device__ __forceinline__ void operator()(const f32x4 (&acc)[2][2][4][2], const Unit& u, int wr, int wc, int fr, int fq) const {
        const int pn = u.pn;
        const int colb = 256 * pn + 64 * wc + 8 * fq;
        const bool do_rope = !(pn >= 7 || (pn == 2 && wc >= 2));
        const bool is_q = (pn < 2) || (pn == 3) || (pn == 4);
        const bool is_kb = (pn == 5) || (pn == 6);
        const float sc = is_q ? C2 : 1.0f;
        f32x4 bv[2][2];
#pragma unroll
        for (int bj = 0; bj < 2; ++bj)
#pragma unroll
            for (int n = 0; n < 2; ++n) bv[bj][n] = *(const f32x4*)(b_in + colb + 32 * bj + 4 * n);
        f32x4 ks[2][2];
#pragma unroll
        for (int bj = 0; bj < 2; ++bj)
#pragma unroll
            for (int n = 0; n < 2; ++n) ks[bj][n] = (f32x4){0.f, 0.f, 0.f, 0.f};
#pragma unroll
        for (int ai = 0; ai < 2; ++ai)
#pragma unroll
            for (int m = 0; m < 4; ++m) {
                const int row = u.pm * 256 + ai * 128 + wr * 64 + m * 16 + fr;
                const int pos = row & (SEQ - 1);
                f32x4 o1[2], o2[2];
#pragma unroll
                for (int n = 0; n < 2; ++n) { o1[n] = acc[ai][0][m][n] * descale + bv[0][n]; o2[n] = acc[ai][1][m][n] * descale + bv[1][n]; }
                if (do_rope) {
                    const float* rp = rope + pos * 64 + 8 * fq;
#pragma unroll
                    for (int n = 0; n < 2; ++n) { const f32x4 c = *(const f32x4*)(rp + 4 * n), s = *(const f32x4*)(rp + 32 + 4 * n);
                        const f32x4 a = o1[n], b = o2[n]; o1[n] = a * c - b * s; o2[n] = b * c + a * s; }
                }
                if (is_kb) {
#pragma unroll
                    for (int n = 0; n < 2; ++n) { ks[0][n] += o1[n]; ks[1][n] += o2[n]; }
                }
                bf16_t* rowp = qkv + (size_t)row * INW + colb;
                u32x4 w1, w2;
                w1.x = cvtpk(o1[0][0] * sc, o1[0][1] * sc); w1.y = cvtpk(o1[0][2] * sc, o1[0][3] * sc); w1.z = cvtpk(o1[1][0] * sc, o1[1][1] * sc); w1.w = cvtpk(o1[1][2] * sc, o1[1][3] * sc);
                w2.x = cvtpk(o2[0][0] * sc, o2[0][1] * sc); w2.y = cvtpk(o2[0][2] * sc, o2[0][3] * sc); w2.z = cvtpk(o2[1][0] * sc, o2[1][1] * sc); w2.w = cvtpk(o2[1][2] * sc, o2[1][3] * sc);
                *(u32x4*)(rowp) = w1; *(u32x4*)(rowp + 32) = w2;
            }
        if (is_kb) {
            float* kd = ksum + (size_t)u.pm * 512 + 256 * (pn - 5) + 64 * wc + 8 * fq;
#pragma unroll
            for (int bj = 0; bj < 2; ++bj)
#pragma unroll
                for (int n = 0; n < 2; ++n)
#pragma unroll
                    for (int j = 0; j < 4; ++j) {
                        float v = ks[bj][n][j];
                        v += swz_xor<1>(v); v += swz_xor<2>(v); v += swz_xor<4>(v); v += swz_xor<8>(v);
                        if (fr == 0) atomicAdd(kd + 32 * bj + 4 * n + j, v);
                    }
        }
    }
};
struct EpiOutProj {
    bf16_t* y; const float* b_out; const float* x;
    __device__ __forceinline__ void operator()(const f32x4 (&acc)[2][2][4][2], const Unit& u, int wr, int wc, int fr, int fq) const {
        const int col0 = u.pn * 256 + wc * 32 + 8 * fq;
        f32x4 bv[2][2];
#pragma unroll
        for (int bj = 0; bj < 2; ++bj)
#pragma unroll
            for (int n = 0; n < 2; ++n) bv[bj][n] = *(const f32x4*)(b_out + col0 + 128 * bj + 4 * n);
#pragma unroll
        for (int ai = 0; ai < 2; ++ai)
#pragma unroll
            for (int m = 0; m < 4; ++m) {
                const size_t off = (size_t)(u.pm * 256 + ai * 128 + wr * 64 + m * 16 + fr) * D + col0;
#pragma unroll
                for (int bj = 0; bj < 2; ++bj) {
                    const f32x4 x0 = *(const f32x4*)(x + off + 128 * bj), x1 = *(const f32x4*)(x + off + 128 * bj + 4);
                    const f32x4 v0 = acc[ai][bj][m][0] + bv[bj][0] + x0 * DN_ALPHA, v1 = acc[ai][bj][m][1] + bv[bj][1] + x1 * DN_ALPHA;
                    u32x4 w; w.x = cvtpk(v0[0], v0[1]); w.y = cvtpk(v0[2], v0[3]); w.z = cvtpk(v1[0], v1[1]); w.w = cvtpk(v1[2], v1[3]);
                    *(u32x4*)(y + off + 128 * bj) = w; }
                if (m & 1) asm volatile("" ::: "memory");
            }
    }
};
struct EpiSwiglu {
    unsigned char* act8; const float* b1;
    __device__ __forceinline__ const float* bias_src(const Unit& u) const { return b1 + (size_t)u.e * 2048 + 256 * u.pn; }
    __device__ __forceinline__ void operator()(const f32x4 (&acc)[2][2][4][2], const Unit& u, int wr, int wc, int fr, int fq, const LAS float* bias) const {
        const int a0 = 128 * u.pn + 32 * wc + 8 * fq;
        const LAS float* bp = bias + 2 * (32 * wc + 8 * fq);
        f32x4 bb[4];
#pragma unroll
        for (int q = 0; q < 4; ++q) bb[q] = *(const LAS f32x4*)(bp + 4 * q);
        f32x2 bg[2][2], bl[2][2];
#pragma unroll
        for (int n = 0; n < 2; ++n)
#pragma unroll
            for (int jp = 0; jp < 2; ++jp) { bg[n][jp] = (f32x2){bb[2 * n + jp][0], bb[2 * n + jp][2]}; bl[n][jp] = (f32x2){bb[2 * n + jp][1], bb[2 * n + jp][3]}; }
        unsigned char* tile = act8 + (size_t)u.pm * (256 * 1024);
#pragma unroll
        for (int ai = 0; ai < 2; ++ai)
#pragma unroll
            for (int m = 0; m < 4; ++m) {
                const int row = ai * 128 + wr * 64 + m * 16 + fr;
                f32x2 r[2][2];
#pragma unroll
                for (int n = 0; n < 2; ++n)
#pragma unroll
                    for (int jp = 0; jp < 2; ++jp) {
                        const f32x2 ag = {acc[ai][0][m][n][2 * jp], acc[ai][0][m][n][2 * jp + 1]}, al = {acc[ai][1][m][n][2 * jp], acc[ai][1][m][n][2 * jp + 1]};
                        f32x2 g = ag * (1.0f / W_SCALE) + bg[n][jp], l = al * (1.0f / W_SCALE) + bl[n][jp];
                        g.x = fminf(g.x, 7.0f); g.y = fminf(g.y, 7.0f);
                        l.x = __builtin_amdgcn_fmed3f(l.x, -7.0f, 7.0f); l.y = __builtin_amdgcn_fmed3f(l.y, -7.0f, 7.0f);
                        const f32x2 uarg = g * (-1.702f * LOG2E);
                        f32x2 t; t.x = __builtin_amdgcn_exp2f(uarg.x); t.y = __builtin_amdgcn_exp2f(uarg.y);
                        const f32x2 d = t + 1.0f;
                        f32x2 sg; sg.x = __builtin_amdgcn_rcpf(d.x); sg.y = __builtin_amdgcn_rcpf(d.y);
                        const f32x2 lf = l * ACT_SCALE + ACT_SCALE;
                        r[n][jp] = (g * sg) * lf;
                    }
                u32x2 w; w.x = pk4_fp8(r[0][0].x, r[0][0].y, r[0][1].x, r[0][1].y); w.y = pk4_fp8(r[1][0].x, r[1][0].y, r[1][1].x, r[1][1].y);
                *(u32x2*)(tile + (size_t)row * 1024 + (size_t)a0) = w;
            }
    }
};
struct EpiDown {
    unsigned char* yb; const float* b2;
    __device__ __forceinline__ const float* bias_src(const Unit& u) const { return b2 + (size_t)u.e * 1024 + 256 * u.pn; }
    __device__ __forceinline__ void operator()(const f32x4 (&acc)[2][2][4][2], const Unit& u, int wr, int wc, int fr, int fq, const LAS float* bias) const {
        const int col0 = u.pn * 256 + wc * 32 + 8 * fq;
        const LAS float* bp = bias + wc * 32 + 8 * fq;
#pragma unroll
        for (int bj = 0; bj < 2; ++bj) {
            const f32x4 bv0 = *(const LAS f32x4*)(bp + 128 * bj) * Y_SCALE, bv1 = *(const LAS f32x4*)(bp + 128 * bj + 4) * Y_SCALE;
#pragma unroll
            for (int ai = 0; ai < 2; ++ai)
#pragma unroll
                for (int m = 0; m < 4; ++m) {
                    unsigned char* rowp = yb + (size_t)(u.pm * 256 + ai * 128 + wr * 64 + m * 16 + fr) * 1024 + col0;
                    const f32x4 v0 = acc[ai][bj][m][0] * (Y_SCALE / (W_SCALE * ACT_SCALE)) + bv0, v1 = acc[ai][bj][m][1] * (Y_SCALE / (W_SCALE * ACT_SCALE)) + bv1;
                    u32x2 w; w.x = pk4_fp8(v0[0], v0[1], v0[2], v0[3]); w.y = pk4_fp8(v1[0], v1[1], v1[2], v1[3]);
                    *(u32x2*)(rowp + 128 * bj) = w;
                }
        }
    }
};
}

namespace att {
constexpr int PITCH = INW, SLOTB = 8192;
constexpr int NSLOT = 4;
constexpr int L_K = 0, L_V = NSLOT * SLOTB, L_WS = 2 * NSLOT * SLOTB, L_KS = L_WS + 2048, L_OST = L_KS + 2048, L_END = L_OST + 8 * 4096;
static_assert(NSLOT == 4 && L_END <= 131072, "attention LDS map");
constexpr float NEG = -1.0e30f, M0 = -1.0e20f, THR = 8.0f;
typedef LAS const char* lds_cptr;
__device__ __forceinline__ int crow(int r, int hi) { return (r & 3) + 8 * (r >> 2) + 4 * hi; }
__device__ __forceinline__ void glds16(const void* gsrc, unsigned lds_dst) { unsigned keep;
    asm volatile("s_mov_b32 %0, m0\n\ts_mov_b32 m0, %2\n\ts_nop 0\n\tglobal_load_lds_dwordx4 %1, off\n\ts_mov_b32 m0, %0" : "=&s"(keep) : "v"(gsrc), "s"(lds_dst) : "memory"); }
__device__ __forceinline__ void glds16s(unsigned voff, const void* sbase, unsigned lds_dst) { unsigned keep;
    asm volatile("s_mov_b32 %0, m0\n\ts_mov_b32 m0, %3\n\ts_nop 0\n\tglobal_load_lds_dwordx4 %1, %2\n\ts_mov_b32 m0, %0" : "=&s"(keep) : "v"(voff), "s"(sbase), "s"(lds_dst) : "memory"); }
#define ATT_WAIT_BAR0() asm volatile("s_waitcnt vmcnt(0) lgkmcnt(0)\n\ts_barrier" ::: "memory")
#define ATT_WAIT_BARN(N) asm volatile("s_waitcnt vmcnt(" #N ") lgkmcnt(0)\n\ts_barrier" ::: "memory")
#define ATT_SBAR() __builtin_amdgcn_sched_barrier(0)

__device__ __forceinline__ void qkt(f32x16& p0, f32x16& p1, lds_cptr kb, const bf16x8* qr, const f32x16& negm) {
#pragma unroll
    for (int d0 = 0; d0 < 4; ++d0) {
        const bf16x8 b0 = *(const LAS bf16x8*)(kb + d0 * 2048);
        const bf16x8 b1 = *(const LAS bf16x8*)(kb + d0 * 2048 + 512);
        if (d0 == 0) { p0 = __builtin_amdgcn_mfma_f32_32x32x16_bf16(b0, qr[0], negm, 0, 0, 0); p1 = __builtin_amdgcn_mfma_f32_32x32x16_bf16(b1, qr[0], negm, 0, 0, 0); }
        else { p0 = __builtin_amdgcn_mfma_f32_32x32x16_bf16(b0, qr[d0], p0, 0, 0, 0); p1 = __builtin_amdgcn_mfma_f32_32x32x16_bf16(b1, qr[d0], p1, 0, 0, 0); }
    }
}
__device__ __forceinline__ float rowmax32(const f32x16& p0, const f32x16& p1) {
    float a = fmaxf(p0[0], p1[0]);
#pragma unroll
    for (int r = 1; r < 16; ++r) a = fmaxf(a, fmaxf(p0[r], p1[r]));
    auto rr = __builtin_amdgcn_permlane32_swap(__float_as_uint(a), __float_as_uint(a), false, false);
    return fmaxf(__uint_as_float(rr[0]), __uint_as_float(rr[1]));
}
__device__ __forceinline__ void pv(f32x16* o, int vb, bf16x8 pa0, bf16x8 pa1, bf16x8 pa2, bf16x8 pa3) {
#pragma unroll
    for (int d0 = 0; d0 < 2; ++d0) { s16x4 lo[4], hi[4];
#pragma unroll
        for (int ks = 0; ks < 4; ++ks) {
            asm volatile("ds_read_b64_tr_b16 %0,%1 offset:%c2" : "=&v"(lo[ks]) : "v"(vb), "i"(d0 * 4096 + ks * 1024) : "memory");
            asm volatile("ds_read_b64_tr_b16 %0,%1 offset:%c2" : "=&v"(hi[ks]) : "v"(vb), "i"(d0 * 4096 + ks * 1024 + 512) : "memory"); }
        asm volatile("s_waitcnt lgkmcnt(0)" ::: "memory"); ATT_SBAR();
#define ATT_PK(k) (bf16x8){lo[k][0], lo[k][1], lo[k][2], lo[k][3], hi[k][0], hi[k][1], hi[k][2], hi[k][3]}
        o[d0] = __builtin_amdgcn_mfma_f32_32x32x16_bf16(pa0, ATT_PK(0), o[d0], 0, 0, 0);
        o[d0] = __builtin_amdgcn_mfma_f32_32x32x16_bf16(pa1, ATT_PK(1), o[d0], 0, 0, 0);
        o[d0] = __builtin_amdgcn_mfma_f32_32x32x16_bf16(pa2, ATT_PK(2), o[d0], 0, 0, 0);
        o[d0] = __builtin_amdgcn_mfma_f32_32x32x16_bf16(pa3, ATT_PK(3), o[d0], 0, 0, 0);
#undef ATT_PK
    }
}

__device__ __forceinline__ void swa_stream(LAS char* shm, const bf16_t* __restrict__ qkv, bf16_t* __restrict__ aout, int b, int hh, int qb0, int nqb, const float* __restrict__ sinks, const int wave_s) {
    int tid = tid_of(wave_s); asm volatile("" : "+v"(tid));
    const int lane = tid & 63, r32 = lane & 31, hi = lane >> 5; const int wid = wave_s;
    const long rowbase = (long)b * SEQ;
    const int g = wid >> 1, qcol = (4 * hh + g) * 64, kcol = 512 + 64 * hh, vcol = 640 + 64 * hh;
    const bf16_t* Kh = qkv + rowbase * PITCH + kcol; const bf16_t* Vh = qkv + rowbase * PITCH + vcol;
    const unsigned lds0 = (unsigned)(uintptr_t)shm;
    LAS float* wsf = (LAS float*)(shm + L_WS) + wid * 64;
    const unsigned koff = (unsigned)(lane * PITCH + wid * 8) * 2u;
    const unsigned voff = (unsigned)((16 * (wid & 3) + (lane >> 2)) * PITCH + (wid >> 2) * 32 + (lane & 3) * 8) * 2u;
    const unsigned kdst = lds0 + L_K + wid * 1024, vdst = lds0 + L_V + wid * 1024;
#define SW_DMA(t) do { const unsigned sl_ = (unsigned)(((t) & (NSLOT - 1)) * SLOTB); \
        glds16s(koff, Kh + (long)(t) * 64 * PITCH, (unsigned)__builtin_amdgcn_readfirstlane(kdst + sl_)); glds16s(voff, Vh + (long)(t) * 64 * PITCH, (unsigned)__builtin_amdgcn_readfirstlane(vdst + sl_)); } while (0)
    const int vb0 = (int)(lds0 + L_V) + ((lane >> 4) & 1) * 32 + (lane & 3) * 8 + (4 * hi + ((lane & 15) >> 2)) * 64;
    const lds_cptr kp0 = (lds_cptr)shm + L_K + hi * 1024 + r32 * 16;
    const float sink2 = sinks[4 * hh + g] * LOG2E;
    const int qend = qb0 + nqb;
    for (int kt = (qb0 - 2 < 0 ? 0 : qb0 - 2); kt <= qb0; ++kt) SW_DMA(kt);
    const bf16_t* Qb = qkv + (rowbase + 32 * (wid & 1) + r32) * PITCH + qcol + hi * 8;
    bf16x8 qn[4];
#pragma unroll
    for (int d0 = 0; d0 < 4; ++d0) qn[d0] = *reinterpret_cast<const bf16x8*>(Qb + (long)qb0 * 64 * PITCH + d0 * 16);
    ATT_WAIT_BAR0();
    for (int qb = qb0; qb < qend; ++qb) {
        const int qa = 64 * qb + 32 * (wid & 1);
        if (qb + 1 < qend) SW_DMA(qb + 1);
        bf16x8 qr[4];
#pragma unroll
        for (int d0 = 0; d0 < 4; ++d0) qr[d0] = qn[d0];
        if (qb + 1 < qend) {
#pragma unroll
            for (int d0 = 0; d0 < 4; ++d0) qn[d0] = *reinterpret_cast<const bf16x8*>(Qb + (long)(qb + 1) * 64 * PITCH + d0 * 16);
        }
        float m_run = sink2, l_run = (hi == 0) ? 1.0f : 0.0f;
        f32x16 negm, o[2];
        { float zf = 0.f; asm volatile("" : "+v"(zf));
#pragma unroll
          for (int r = 0; r < 16; ++r) { o[0][r] = zf; o[1][r] = zf; negm[r] = -m_run; } }
        for (int kt = (qb - 2 < 0 ? 0 : qb - 2); kt <= qb; ++kt) {
            const int cur = (kt & (NSLOT - 1)) * SLOTB;
            f32x16 p0, p1; qkt(p0, p1, kp0 + cur, qr, negm);
            const bool edge = !((64 * kt + 63 <= qa) && (qa + 31 - 64 * kt <= 127));
            if (edge) {
                const int dq = qa + r32 - 64 * kt - 4 * hi;
#pragma unroll
                for (int r = 0; r < 16; ++r) { const int d0_ = dq - ((r & 3) + 8 * (r >> 2)), d1_ = d0_ - 32;
                    p0[r] = ((unsigned)d0_ < 128u) ? p0[r] : NEG; p1[r] = ((unsigned)d1_ < 128u) ? p1[r] : NEG; }
            }
            const float rm = rowmax32(p0, p1);
            if (__any(rm > THR)) {
                const float dl = fmaxf(rm, 0.f);
                const float f = __builtin_amdgcn_exp2f(-dl);
                m_run += dl;
#pragma unroll
                for (int r = 0; r < 16; ++r) { p0[r] -= dl; p1[r] -= dl; negm[r] = -m_run; }
                l_run *= f;
                if (hi == 0) wsf[r32] = f;
                LDS_WAIT();
#pragma unroll
                for (int r = 0; r < 16; ++r) { const float fr_ = wsf[crow(r, hi)]; o[0][r] *= fr_; o[1][r] *= fr_; }
            }
            float sacc = 0.f;
#pragma unroll
            for (int r = 0; r < 16; ++r) { p0[r] = __builtin_amdgcn_exp2f(p0[r]); p1[r] = __builtin_amdgcn_exp2f(p1[r]); sacc += p0[r] + p1[r]; }
            l_run += sacc;
            u32x4 pw0, pw1, pw2, pw3;
            pw0 = (u32x4){cvtpk(p0[0], p0[1]), cvtpk(p0[2], p0[3]), cvtpk(p0[4], p0[5]), cvtpk(p0[6], p0[7])};
            pw1 = (u32x4){cvtpk(p0[8], p0[9]), cvtpk(p0[10], p0[11]), cvtpk(p0[12], p0[13]), cvtpk(p0[14], p0[15])};
            pw2 = (u32x4){cvtpk(p1[0], p1[1]), cvtpk(p1[2], p1[3]), cvtpk(p1[4], p1[5]), cvtpk(p1[6], p1[7])};
            pw3 = (u32x4){cvtpk(p1[8], p1[9]), cvtpk(p1[10], p1[11]), cvtpk(p1[12], p1[13]), cvtpk(p1[14], p1[15])};
            ATT_SBAR();
            pv(o, vb0 + cur, __builtin_bit_cast(bf16x8, pw0), __builtin_bit_cast(bf16x8, pw1), __builtin_bit_cast(bf16x8, pw2), __builtin_bit_cast(bf16x8, pw3));
        }
        { auto rr = __builtin_amdgcn_permlane32_swap(__float_as_uint(l_run), __float_as_uint(l_run), false, false); l_run = __uint_as_float(rr[0]) + __uint_as_float(rr[1]); }
        if (hi == 0) wsf[32 + r32] = l_run;
        LDS_WAIT();
        float rli[16];
#pragma unroll
        for (int r = 0; r < 16; ++r) rli[r] = __builtin_amdgcn_rcpf(wsf[32 + crow(r, hi)]);
        bf16_t* Ow = aout + (rowbase + qa) * D + qcol;
        { LAS bf16_t* stg = (LAS bf16_t*)(shm + L_OST) + wid * 2048;
#pragma unroll
            for (int r = 0; r < 16; ++r) { const int orow = crow(r, hi);
#pragma unroll
                for (int d0 = 0; d0 < 2; ++d0) stg[orow * 64 + d0 * 32 + r32] = (bf16_t)f2bf(o[d0][r] * rli[r]); }
            LDS_WAIT();
#pragma unroll
            for (int i = 0; i < 4; ++i) { const int row = i * 8 + (lane >> 3), ch = lane & 7; const u32x4 v = *(const LAS u32x4*)(stg + row * 64 + ch * 8); *(u32x4*)(Ow + (long)row * D + ch * 8) = v; } }
        ATT_WAIT_BAR0();
    }
#undef SW_DMA
}

constexpr int MK_K = 0, MK_V = 3 * SLOTB, MK_WS = 6 * SLOTB, MK_OST = MK_WS + 8 * 256, MK_KS = MK_OST + 8 * 4096, MK_END = MK_KS + 2048;
constexpr float NEGB = -1.0e30f;
__device__ __forceinline__ float max3f(float a, float b, float c) { float r; asm("v_max3_f32 %0, %1, %2, %3" : "=v"(r) : "v"(a), "v"(b), "v"(c)); return r; }
__device__ __forceinline__ float max2f(float a, float b) { float r; asm("v_max_f32_e32 %0, %1, %2" : "=v"(r) : "v"(a), "v"(b)); return r; }
__device__ __forceinline__ float fadd_s(float a, float b) { float r; asm("v_add_f32_e32 %0, %1, %2" : "=v"(r) : "v"(a), "v"(b)); return r; }
__device__ __forceinline__ float fsub_s(float a, float b) { float r; asm("v_sub_f32_e32 %0, %1, %2" : "=v"(r) : "v"(a), "v"(b)); return r; }
typedef short v4i16_t __attribute__((ext_vector_type(4)));
#define MK_WAIT_BAR(N) asm volatile("s_waitcnt vmcnt(" #N ") lgkmcnt(0)\n\ts_barrier" ::: "memory")
__device__ __forceinline__ void kload8(bf16x8* kf, lds_cptr kp) {
    kf[0] = *(const LAS bf16x8*)(kp);        kf[1] = *(const LAS bf16x8*)(kp + 512);
    kf[2] = *(const LAS bf16x8*)(kp + 2048); kf[3] = *(const LAS bf16x8*)(kp + 2560);
    kf[4] = *(const LAS bf16x8*)(kp + 4096); kf[5] = *(const LAS bf16x8*)(kp + 4608);
    kf[6] = *(const LAS bf16x8*)(kp + 6144); kf[7] = *(const LAS bf16x8*)(kp + 6656);
}
__device__ __forceinline__ void kload2(bf16x8* kf, lds_cptr kp, int j) { kf[2 * j] = *(const LAS bf16x8*)(kp + j * 2048); kf[2 * j + 1] = *(const LAS bf16x8*)(kp + j * 2048 + 512); }
__device__ __forceinline__ s16x4 vtr(lds_cptr p) { return __builtin_bit_cast(s16x4, __builtin_amdgcn_ds_read_tr16_b64_v4i16((LAS v4i16_t*)p)); }
__device__ __forceinline__ float rowmax_a(const f32x16& p0, const f32x16& p1) {
    float a = max3f(p0[0], p0[1], p1[0]), b = max3f(p0[2], p0[3], p1[1]); a = max3f(a, p1[2], p1[3]);
#pragma unroll
    for (int r = 4; r < 16; r += 4) { a = max3f(a, p0[r], p0[r + 1]); b = max3f(b, p0[r + 2], p0[r + 3]); a = max3f(a, p1[r], p1[r + 1]); b = max3f(b, p1[r + 2], p1[r + 3]); }
    const float m = max2f(a, b);
    auto rr = __builtin_amdgcn_permlane32_swap(__float_as_uint(m), __float_as_uint(m), false, false);
    return max2f(__uint_as_float(rr[0]), __uint_as_float(rr[1]));
}
__device__ __forceinline__ void cmask(f32x16& p0, f32x16& p1, int jb, int qrel, int hi) {
    const float NEGI = -INFINITY; const int kb = 64 * jb + 4 * hi;
#pragma unroll
    for (int r = 0; r < 16; ++r) { const int kv = kb + (r & 3) + 8 * (r >> 2); if (kv > qrel) p0[r] = NEGI; if (kv + 32 > qrel) p1[r] = NEGI; }
}

template <int THRL>
__device__ __forceinline__ void moba_unit(int b, int h, int qb, const bf16_t* __restrict__ qkv, bf16_t* __restrict__ aout, const float* __restrict__ ksum, LAS char* shm, const int wave_s) {
    int tid = tid_of(wave_s); asm volatile("" : "+v"(tid));
    const int lane = tid & 63, r32 = lane & 31, hi = lane >> 5; const int wid = __builtin_amdgcn_readfirstlane(tid >> 6);
    const long rowbase = (long)b * SEQ; const int q0 = qb * 256;
    const bf16_t* Qw = qkv + (rowbase + q0 + wid * 32) * PITCH + 768 + 64 * h;
    const bf16_t* Kh = qkv + rowbase * PITCH + 1280 + 64 * h; const bf16_t* Vh = qkv + rowbase * PITCH + 1792 + 64 * h;
    const unsigned lds0 = (unsigned)(uintptr_t)shm;
    LAS float* wsf = (LAS float*)(shm + MK_WS) + wid * 64;
    const unsigned koff = (unsigned)(lane * PITCH + wid * 8) * 2u;
    const unsigned voff = (unsigned)((16 * (wid & 3) + (lane >> 2)) * PITCH + (wid >> 2) * 32 + (lane & 3) * 8) * 2u;
    const unsigned kdst = lds0 + MK_K + wid * 1024, vdst = lds0 + MK_V + wid * 1024;
#define DMA_K(t, slot) glds16s(koff, Kh + (long)(t) * 64 * PITCH, (unsigned)__builtin_amdgcn_readfirstlane(kdst + (slot)))
#define DMA_V(t, slot) glds16s(voff, Vh + (long)(t) * 64 * PITCH, (unsigned)__builtin_amdgcn_readfirstlane(vdst + (slot)))
    bf16x8 kf[8];
    const lds_cptr shm3 = (lds_cptr)shm; const lds_cptr kp0 = shm3 + MK_K + hi * 1024 + r32 * 16; const lds_cptr vp0 = shm3 + MK_V + ((lane >> 4) & 1) * 32 + (lane & 3) * 8 + (4 * hi + ((lane & 15) >> 2)) * 64;
    const int NT = (q0 + 256) / 64;
    DMA_K(0, 0); DMA_V(0, 0); DMA_K(1, SLOTB);
    { LAS float* ksl = (LAS float*)(shm + MK_KS); ksl[tid] = ksum[((size_t)b * 8 + (tid >> 6)) * 512 + 64 * h + (tid & 63)]; }
    bf16x8 qr[4];
#pragma unroll
    for (int d0 = 0; d0 < 4; ++d0) qr[d0] = *reinterpret_cast<const bf16x8*>(&Qw[(long)r32 * PITCH + d0 * 16 + hi * 8]);
    float mhat = 0.f, l_reg = 0.f; f32x16 o[2], negm;
    { float zf = 0.f; asm volatile("" : "+v"(zf));
#pragma unroll
      for (int r = 0; r < 16; ++r) { o[0][r] = zf; o[1][r] = zf; negm[r] = zf; } }
    asm volatile("" : "+v"(negm));
    const int qrel = wid * 32 + r32;
#define CMASK(P0, P1, t) do { int jb_ = (t) - (NT - 4); if (jb_ >= 0) cmask(P0, P1, jb_, qrel, hi); } while (0)
    bool resc = false;
#define START(P0, P1) do { const float rm = rowmax_a(P0, P1); resc = false; \
    { const float dl = (rm > 0.1f * NEGB) ? rm : 0.f;      mhat = fadd_s(mhat, dl); \
      _Pragma("unroll") for (int r = 0; r < 16; ++r) { P0[r] = fsub_s(P0[r], dl); P1[r] = fsub_s(P1[r], dl); } \
      const float nm_ = ONB(1) ? -mhat : NEGB; \
      _Pragma("unroll") for (int r = 0; r < 16; ++r) negm[r] = nm_; asm volatile("" : "+v"(negm)); } \
    _Pragma("unroll") for (int r = 0; r < 16; ++r) P0[r] = __builtin_amdgcn_exp2f(P0[r]); } while (0)
#define RESC() do { if (resc) { asm volatile("s_waitcnt lgkmcnt(0)" ::: "memory"); \
      _Pragma("unroll") for (int d_ = 0; d_ < 2; ++d_) _Pragma("unroll") for (int r = 0; r < 16; ++r) o[d_][r] *= wsf[crow(r, hi)]; } } while (0)
    f32x16 pA0, pA1, pB0, pB1;
    int sl_prev = 0, sl_cur = 0, sl_next = SLOTB;
#define ROT() do { sl_prev = sl_cur; sl_cur = sl_next; sl_next = (sl_next == 2 * SLOTB) ? 0 : sl_next + SLOTB; } while (0)
    DMA_K(2, 2 * SLOTB);
    MK_WAIT_BAR(3);
    unsigned sel = 0u;
    if (qb <= 3) sel = (1u << qb) - 1u;
    else {
        const LAS float* ksl = (const LAS float*)(shm + MK_KS);
        float gv[7];
#pragma unroll
        for (int i = 0; i < 7; ++i) {
            float s = 0.f;
#pragma unroll
            for (int d0 = 0; d0 < 4; ++d0) {
                const f32x4 k0 = *(const LAS f32x4*)(ksl + i * 64 + 16 * d0 + 8 * hi), k1 = *(const LAS f32x4*)(ksl + i * 64 + 16 * d0 + 8 * hi + 4);
#pragma unroll
                for (int jj = 0; jj < 4; ++jj) { s += bf2f((unsigned short)qr[d0][jj]) * k0[jj]; s += bf2f((unsigned short)qr[d0][4 + jj]) * k1[jj]; }
            }
            auto rr = __builtin_amdgcn_permlane32_swap(__float_as_uint(s), __float_as_uint(s), false, false);
            s = __uint_as_float(rr[0]) + __uint_as_float(rr[1]);
            gv[i] = (i < qb) ? s : -INFINITY;
        }
#pragma unroll
        for (int rk = 0; rk < 3; ++rk) { float best = -INFINITY; int bi = 0;
#pragma unroll
            for (int i = 0; i < 7; ++i) { const bool c = (((sel >> i) & 1u) == 0u) && (gv[i] > best); best = c ? gv[i] : best; bi = c ? i : bi; }
            sel |= 1u << bi; }
    }
#define ONB(tt) (((tt) >= NT - 4) ? true : (((sel >> ((tt) >> 2)) & 1u) != 0u))
#define SETNEGM(tt) do { const float nm_ = ONB(tt) ? -mhat : NEGB; _Pragma("unroll") for (int r = 0; r < 16; ++r) negm[r] = nm_; asm volatile("" : "+v"(negm)); } while (0)
    SETNEGM(0);
    qkt(pA0, pA1, kp0, qr, negm); asm volatile("s_nop 15\n\ts_nop 7" : "+v"(pA0), "+v"(pA1)); CMASK(pA0, pA1, 0);
    START(pA0, pA1);
    _Pragma("unroll") for (int r = 0; r < 16; ++r) pA1[r] = __builtin_amdgcn_exp2f(pA1[r]);
    MK_WAIT_BAR(0);
    DMA_K(3, 0); DMA_V(1, SLOTB);
    ROT();
    kload8(kf, kp0 + sl_cur);
    MK_WAIT_BAR(2);
    s16x4 vlo[8], vhi[8]; u32x4 pw0, pw1, pw2, pw3;
#define PKW(P, B) cvtpk(P[B], P[B + 1])
#define PAF(k) __builtin_bit_cast(bf16x8, pw##k)
#define VFR(i) (bf16x8){vlo[i][0], vlo[i][1], vlo[i][2], vlo[i][3], vhi[i][0], vhi[i][1], vhi[i][2], vhi[i][3]}
#define PIN(x) asm volatile("" : "+v"(x))
#define MX3(a, b, c) __builtin_fmaxf(__builtin_fmaxf((a), (b)), (c))
#define GAPA(MF, A0, A1, A2, A3, W0, W1, PW) do { MF; sacc += A0; sacc += A1; sacc += A2; sacc += A3; PIN(sacc); W0; W1; PIN(PW); ATT_SBAR(); } while (0)
#define EX(v) __builtin_amdgcn_exp2f(v)
#define GAPB(MF, X, B) do { MF; X[B] = EX(X[B]); X[B + 1] = EX(X[B + 1]); X[B + 2] = EX(X[B + 2]); X[B + 3] = EX(X[B + 3]); PIN(X); ATT_SBAR(); } while (0)
#define VRD(i) do { vlo[i] = vtr(vp_ + (((i) >> 2) * 4096 + ((i) & 3) * 1024)); vhi[i] = vtr(vp_ + (((i) >> 2) * 4096 + ((i) & 3) * 1024 + 512)); } while (0)
#define KRD(G, j) do { if (G) { kload2(kf, kp0 + sl_next, j); ATT_SBAR(); } } while (0)
#define MF32(a, b, c) __builtin_amdgcn_mfma_f32_32x32x16_bf16(a, b, c, 0, 0, 0)
#define STEP(C0, C1, P0, P1, t, GK, GV, GL) do { ATT_SBAR(); \
    const lds_cptr vp_ = vp0 + sl_prev; \
    VRD(0); ATT_SBAR(); float sacc = (P0[0] + P0[1]); \
    GAPA(C0 = MF32(kf[0], qr[0], negm), P0[2], P0[3], P0[4], P0[5],     pw0[0] = PKW(P0, 0), pw0[1] = PKW(P0, 2), pw0); \
    VRD(4); ATT_SBAR(); GAPA(C1 = MF32(kf[1], qr[0], negm), P0[6], P0[7], P0[8], P0[9],     pw0[2] = PKW(P0, 4), pw0[3] = PKW(P0, 6), pw0); \
    VRD(1); ATT_SBAR(); GAPA(C0 = MF32(kf[2], qr[1], C0),   P0[10], P0[11], P0[12], P0[13], pw1[0] = PKW(P0, 8), pw1[1] = PKW(P0, 10), pw1); \
    VRD(5); ATT_SBAR(); GAPA(C1 = MF32(kf[3], qr[1], C1),   P0[14], P0[15], P1[0], P1[1],   pw1[2] = PKW(P0, 12), pw1[3] = PKW(P0, 14), pw1); \
    VRD(2); ATT_SBAR(); GAPA(C0 = MF32(kf[4], qr[2], C0),   P1[2], P1[3], P1[4], P1[5],     pw2[0] = PKW(P1, 0), pw2[1] = PKW(P1, 2), pw2); \
    VRD(6); ATT_SBAR(); GAPA(C1 = MF32(kf[5], qr[2], C1),   P1[6], P1[7], P1[8], P1[9],     pw2[2] = PKW(P1, 4), pw2[3] = PKW(P1, 6), pw2); \
    VRD(3); ATT_SBAR(); GAPA(C0 = MF32(kf[6], qr[3], C0),   P1[10], P1[11], P1[12], P1[13], pw3[0] = PKW(P1, 8), pw3[1] = PKW(P1, 10), pw3); \
    VRD(7); ATT_SBAR(); GAPA(C1 = MF32(kf[7], qr[3], C1),   P1[14], P1[15], 0.f, 0.f,       pw3[2] = PKW(P1, 12), pw3[3] = PKW(P1, 14), pw3); \
    l_reg += sacc; \
    if (GK) { DMA_K((t) + 3, sl_cur); } if (GV) { DMA_V((t) + 1, sl_next); } \
    CMASK(C0, C1, t); \
    { float a = MX3(C0[0], C0[1], C1[0]), b_ = MX3(C0[2], C0[3], C1[1]); a = MX3(a, C1[2], C1[3]); \
      _Pragma("unroll") for (int r = 4; r < 16; r += 4) { a = MX3(a, C0[r], C0[r + 1]); b_ = MX3(b_, C0[r + 2], C0[r + 3]); a = MX3(a, C1[r], C1[r + 1]); b_ = MX3(b_, C1[r + 2], C1[r + 3]); } \
      float rm = __builtin_fmaxf(a, b_); { auto rr = __builtin_amdgcn_permlane32_swap(__float_as_uint(rm), __float_as_uint(rm), false, false); rm = __builtin_fmaxf(__uint_as_float(rr[0]), __uint_as_float(rr[1])); } \
      resc = false; \
      const bool blk_ = (((t) + 1) & 3) == 0;                    \
      if (__builtin_expect(__any(rm > (float)THRL), 0)) { const float dl = __builtin_fmaxf(rm, 0.f); mhat += dl; \
        _Pragma("unroll") for (int r = 0; r < 16; ++r) { C0[r] -= dl; C1[r] -= dl; } \
        const float nm_ = ONB((t) + 1) ? -mhat : NEGB; \
        _Pragma("unroll") for (int r = 0; r < 16; ++r) negm[r] = nm_; asm volatile("" : "+v"(negm)); \
        const float f = __builtin_amdgcn_exp2f(-dl); l_reg *= f; if (hi == 0) wsf[r32] = f; resc = true; } \
      else if (blk_) { SETNEGM((t) + 1); } } \
    ATT_SBAR(); \
    GAPB(o[0] = MF32(PAF(0), VFR(0), o[0]), C0, 0); \
    GAPB(o[1] = MF32(PAF(0), VFR(4), o[1]), C0, 4); \
    KRD(GL, 0); GAPB(o[0] = MF32(PAF(1), VFR(1), o[0]), C0, 8); \
    KRD(GL, 1); GAPB(o[1] = MF32(PAF(1), VFR(5), o[1]), C0, 12); \
    KRD(GL, 2); GAPB(o[0] = MF32(PAF(2), VFR(2), o[0]), C1, 0); \
    KRD(GL, 3); GAPB(o[1] = MF32(PAF(2), VFR(6), o[1]), C1, 4); \
    GAPB(o[0] = MF32(PAF(3), VFR(3), o[0]), C1, 8); \
    GAPB(o[1] = MF32(PAF(3), VFR(7), o[1]), C1, 12); \
    } while (0)
    int t = 1;
#undef CMASK
#define CMASK(P0, P1, t) do { } while (0)
    for (; t + 5 < NT; t += 2) {
        STEP(pB0, pB1, pA0, pA1, t, true, true, true);       MK_WAIT_BAR(2); RESC(); ROT();
        STEP(pA0, pA1, pB0, pB1, t + 1, true, true, true);   MK_WAIT_BAR(2); RESC(); ROT();
    }
#undef CMASK
#define CMASK(P0, P1, t) do { int jb_ = (t) - (NT - 4); if (jb_ >= 0) cmask(P0, P1, jb_, qrel, hi); } while (0)
#define ENDW(tt) do { if ((tt) + 3 < NT) { MK_WAIT_BAR(2); } else if ((tt) + 2 < NT) { MK_WAIT_BAR(1); } else { MK_WAIT_BAR(0); } } while (0)
    for (; t + 1 < NT; t += 2) {
        STEP(pB0, pB1, pA0, pA1, t, (t + 3 < NT), (t + 1 < NT), (t + 1 < NT));           ENDW(t);     RESC(); ROT();
        STEP(pA0, pA1, pB0, pB1, t + 1, (t + 4 < NT), (t + 2 < NT), (t + 2 < NT));       ENDW(t + 1); RESC(); ROT();
    }
    STEP(pB0, pB1, pA0, pA1, NT - 1, false, false, false); RESC();
    { float sacc = pB0[0] + pB0[1]; _Pragma("unroll") for (int r = 2; r < 16; ++r) sacc += pB0[r]; _Pragma("unroll") for (int r = 0; r < 16; ++r) sacc += pB1[r]; l_reg += sacc;
      pw0 = (u32x4){PKW(pB0, 0), PKW(pB0, 2), PKW(pB0, 4), PKW(pB0, 6)}; pw1 = (u32x4){PKW(pB0, 8), PKW(pB0, 10), PKW(pB0, 12), PKW(pB0, 14)}; pw2 = (u32x4){PKW(pB1, 0), PKW(pB1, 2), PKW(pB1, 4), PKW(pB1, 6)}; pw3 = (u32x4){PKW(pB1, 8), PKW(pB1, 10), PKW(pB1, 12), PKW(pB1, 14)};
      ATT_SBAR(); const int vb0 = (int)(lds0 + MK_V) + ((lane >> 4) & 1) * 32 + (lane & 3) * 8 + (4 * hi + ((lane & 15) >> 2)) * 64; pv(o, vb0 + sl_cur, PAF(0), PAF(1), PAF(2), PAF(3)); }
#undef PKW
#undef PAF
#undef VFR
#undef PIN
#undef MX3
#undef GAPA
#undef GAPB
#undef EX
#undef VRD
#undef KRD
#undef MF32
#undef STEP
#undef ENDW
    { auto rr = __builtin_amdgcn_permlane32_swap(__float_as_uint(l_reg), __float_as_uint(l_reg), false, false); l_reg = __uint_as_float(rr[0]) + __uint_as_float(rr[1]); }
    if (hi == 0) wsf[32 + r32] = l_reg; asm volatile("s_waitcnt lgkmcnt(0)" ::: "memory");
    float rli[16];
#pragma unroll
    for (int r = 0; r < 16; ++r) rli[r] = __builtin_amdgcn_rcpf(wsf[32 + crow(r, hi)]);
    bf16_t* Ow = aout + (rowbase + q0 + wid * 32) * D + 512 + 64 * h;
    { LAS bf16_t* stg = (LAS bf16_t*)(shm + MK_OST) + wid * 2048;
#pragma unroll
      for (int r = 0; r < 16; ++r) { const int orow = crow(r, hi);
#pragma unroll
          for (int d0 = 0; d0 < 2; ++d0) stg[orow * 64 + d0 * 32 + r32] = (bf16_t)f2bf(o[d0][r] * rli[r]); }
      asm volatile("s_waitcnt lgkmcnt(0)" ::: "memory");
#pragma unroll
      for (int i = 0; i < 4; ++i) { const int row = i * 8 + (lane >> 3), ch = lane & 7; const u32x4 v = *(const LAS u32x4*)(stg + row * 64 + ch * 8); *(u32x4*)(Ow + (long)row * D + ch * 8) = v; } }
    asm volatile("s_waitcnt lgkmcnt(0)\n\ts_barrier" ::: "memory");
#undef DMA_K
#undef DMA_V
#undef CMASK
#undef START
#undef RESC
#undef ROT
#undef ONB
#undef SETNEGM
}
}

__device__ __forceinline__ void sincos_d(double a, double& s, double& c) {
    const double q = __builtin_rint(a * 0.63661977236758134308);
    double r = __builtin_fma(-q, 1.57079632679489655800e+00, a);
    r = __builtin_fma(-q, 6.12323399573676603587e-17, r);
    const double r2 = r * r;
    double sp = -1.0 / 1307674368000.0;
    sp = sp * r2 + 1.0 / 6227020800.0; sp = sp * r2 - 1.0 / 39916800.0; sp = sp * r2 + 1.0 / 362880.0; sp = sp * r2 - 1.0 / 5040.0; sp = sp * r2 + 1.0 / 120.0; sp = sp * r2 - 1.0 / 6.0;
    const double sr = r + r * r2 * sp;
    double cp = 1.0 / 20922789888000.0;
    cp = cp * r2 - 1.0 / 87178291200.0; cp = cp * r2 + 1.0 / 479001600.0; cp = cp * r2 - 1.0 / 3628800.0; cp = cp * r2 + 1.0 / 40320.0; cp = cp * r2 - 1.0 / 720.0; cp = cp * r2 + 1.0 / 24.0; cp = cp * r2 - 0.5;
    const double cr = 1.0 + r2 * cp;
    const int n = ((int)q) & 3;
    s = (n == 0) ? sr : (n == 1) ? cr : (n == 2) ? -sr : -cr;
    c = (n == 0) ? cr : (n == 1) ? -sr : (n == 2) ? -cr : sr;
}
__device__ __forceinline__ int sigma_col(int p, int mode) {
    if (mode == 0) return (p & ~255) + 64 * ((p >> 5) & 3) + 32 * ((p >> 7) & 1) + pg8::perm32(p & 31);
    if (mode == 1) return (p & ~31) + pg8::perm32(p & 31);
    const int pn = p >> 8, q = p & 255; return 2 * (128 * pn + 32 * ((q >> 5) & 3) + pg8::perm32(q & 31)) + (q >> 7);
}
__device__ __forceinline__ void p0_transpose_item(const float* __restrict__ W, int N, bf16_t* __restrict__ WT, int mode, LAS float* scr, int item, int lane) {
    const int nblk = N / 32, kb = item / nblk, nb = item % nblk, k0 = 64 * kb, p0 = 32 * nb;
    const int sc = sigma_col(p0 + (lane & 31), mode);
#pragma unroll 8
    for (int i = 0; i < 32; ++i) { const int kk = 2 * i + (lane >> 5); scr[kk * 33 + (lane & 31)] = W[(size_t)(k0 + kk) * N + sc]; }
    LDS_WAIT(); asm volatile("" ::: "memory");
    const int c = lane & 7;
#pragma unroll
    for (int j = 0; j < 4; ++j) { const int n = (lane >> 3) + 8 * j; const LAS float* s = scr + (8 * c) * 33 + n;
        u32x4 o; o.x = cvtpk(s[0 * 33], s[1 * 33]); o.y = cvtpk(s[2 * 33], s[3 * 33]); o.z = cvtpk(s[4 * 33], s[5 * 33]); o.w = cvtpk(s[6 * 33], s[7 * 33]);
        *(u32x4*)(WT + (size_t)(p0 + n) * 1024 + k0 + 8 * c) = o; }
    LDS_WAIT(); asm volatile("" ::: "memory");
}

__device__ __forceinline__ void p0_transpose_item_fp8(const float* __restrict__ W, int N, unsigned char* __restrict__ WT, int mode, float scale, LAS float* scr, int item, int lane) {
    const int nblk = N / 32, kb = item / nblk, nb = item % nblk, k0 = 64 * kb, p0 = 32 * nb;
    const int sc = sigma_col(p0 + (lane & 31), mode);
#pragma unroll 8
    for (int i = 0; i < 32; ++i) { const int kk = 2 * i + (lane >> 5); scr[kk * 33 + (lane & 31)] = W[(size_t)(k0 + kk) * N + sc] * scale; }
    LDS_WAIT(); asm volatile("" ::: "memory");
    const int c = lane & 7;
#pragma unroll
    for (int j = 0; j < 4; ++j) { const int n = (lane >> 3) + 8 * j; const LAS float* s = scr + (8 * c) * 33 + n;
        u32x2 o; o.x = pk4_fp8(s[0 * 33], s[1 * 33], s[2 * 33], s[3 * 33]); o.y = pk4_fp8(s[4 * 33], s[5 * 33], s[6 * 33], s[7 * 33]);
        *(u32x2*)(WT + (size_t)(p0 + n) * 1024 + k0 + 8 * c) = o; }
    LDS_WAIT(); asm volatile("" ::: "memory");
}


#define XB_TMO      128
#define XB_XCNT(j)  (256  + 64 * (j))
#define XB_XSUB(j)  (1280 + 64 * (j))
#define XB_XGEN(j)  (2304 + 64 * (j))
#define XB_TOP      3328
#define XB_TOPGEN   3392
#define XCD_BAR_WORDS 3456
#define XB_SPIN_CAP (1u << 18)
__device__ __forceinline__ unsigned xb_ld(unsigned* p)              { return __hip_atomic_load(p, __ATOMIC_RELAXED, __HIP_MEMORY_SCOPE_AGENT); }
__device__ __forceinline__ unsigned xb_add(unsigned* p, unsigned v) { return __hip_atomic_fetch_add(p, v, __ATOMIC_RELAXED, __HIP_MEMORY_SCOPE_AGENT); }
__device__ __forceinline__ unsigned xb_xcc_id() { return (unsigned)__builtin_amdgcn_s_getreg((3 << 11) | 20) & 0xFu; }
#define XB_SPIN(cond, bar) do { unsigned _sp = 0; while (cond) { __builtin_amdgcn_s_sleep(1); \
    if ((++_sp & 255u) == 0u) { if (xb_ld(&(bar)[XB_TMO])) break; if (_sp > XB_SPIN_CAP) { atomicAdd(&(bar)[XB_TMO], 1u); break; } } } } while (0)
struct XcdBarrier { unsigned* bar; unsigned x; volatile LAS unsigned* st; };
__device__ __forceinline__ XcdBarrier xcd_barrier_post(unsigned* bar, volatile LAS unsigned* st, const int wave_s) {
    XcdBarrier b; b.bar = bar; b.x = xb_xcc_id(); b.st = st;
    if (tid_of(wave_s) == 0) (void)xb_add(&bar[XB_XCNT(b.x)], 1u);
    return b;
}
__device__ __forceinline__ void xcd_barrier_complete(unsigned* bar, unsigned x, unsigned& nloc, unsigned& nx) {
    const unsigned G = gridDim.x * gridDim.y * gridDim.z;
    unsigned sum, cnt, mine, sp = 0u;
    for (;;) {
        sum = 0u; cnt = 0u; mine = 0u;
#pragma unroll
        for (unsigned j = 0; j < 16; ++j) { const unsigned c = xb_ld(&bar[XB_XCNT(j)]); sum += c; cnt += (c > 0u) ? 1u : 0u; mine = (j == x) ? c : mine; }
        if (sum == G) break;
        __builtin_amdgcn_s_sleep(1);
        if ((++sp & 255u) == 0u) { if (xb_ld(&bar[XB_TMO])) break; if (sp > XB_SPIN_CAP) { atomicAdd(&bar[XB_TMO], 1u); break; } }
    }
    nloc = mine > 0u ? mine : 1u; nx = cnt > 0u ? cnt : 1u;
}
__device__ __forceinline__ void xcd_barrier(const XcdBarrier& b, const int wave_s) {
    asm volatile("s_waitcnt vmcnt(0)" ::: "memory");
    __syncthreads();
    if (tid_of(wave_s) == 0) {
        unsigned* bar = b.bar;
        __builtin_amdgcn_s_waitcnt(0);
        unsigned nloc = b.st[0], nx = b.st[1];
        if (nloc == 0u) { xcd_barrier_complete(bar, b.x, nloc, nx); b.st[0] = nloc; b.st[1] = nx; }
        const unsigned old = xb_add(&bar[XB_XSUB(b.x)], 1u);
        const unsigned gen = old / nloc;
        if (old + 1u == (gen + 1u) * nloc) {
            __builtin_amdgcn_fence(__ATOMIC_RELEASE, "agent");
            asm volatile("s_waitcnt vmcnt(0)" ::: "memory");
            const unsigned og = xb_add(&bar[XB_TOP], 1u);
            const unsigned tg = og / nx;
            if (og + 1u == (tg + 1u) * nx) xb_add(&bar[XB_TOPGEN], 1u);
            else XB_SPIN(xb_ld(&bar[XB_TOPGEN]) == tg, bar);
            __builtin_amdgcn_fence(__ATOMIC_ACQUIRE, "agent");
            xb_add(&bar[XB_XGEN(b.x)], 1u);
            asm volatile("s_waitcnt vmcnt(0)" ::: "memory");
        } else {
            XB_SPIN(xb_ld(&bar[XB_XGEN(b.x)]) == gen, bar);
            __builtin_amdgcn_fence(__ATOMIC_ACQUIRE, "agent");
            asm volatile("s_waitcnt vmcnt(0)" ::: "memory");
        }
    }
    __syncthreads();
}

__global__ void __launch_bounds__(NTHREADS, 2) fwd_megakernel(Params p_arg) {
    extern __shared__ __attribute__((aligned(16))) unsigned char lds_raw[];
    LAS unsigned char* lds = (LAS unsigned char*)lds_raw;
#define PHASE_IDS() int tid = tid_of(wave_s); asm volatile("" : "+v"(tid)); const int lane = tid & 63, wave = wave_s; (void)lane; (void)wave
    const int G = gridDim.x, bx = blockIdx.x;
    const int wave_s = __builtin_amdgcn_readfirstlane((int)threadIdx.x >> 6);
    typedef const __attribute__((address_space(4))) Params* KParams;
    const KParams kp0 = (KParams)__builtin_amdgcn_kernarg_segment_ptr();
#define PHASE_PTRS() KParams _kp = kp0; asm volatile("" : "+s"(_kp)); Params p; p.x = _kp->x; p.w_in = _kp->w_in; p.b_in = _kp->b_in; p.sinks = _kp->sinks; p.w_out = _kp->w_out; p.b_out = _kp->b_out; p.ln1_g = _kp->ln1_g; p.ln1_b = _kp->ln1_b; \
    p.w_router = _kp->w_router; p.b_router = _kp->b_router; p.w1 = _kp->w1; p.b1 = _kp->b1; p.w2 = _kp->w2; p.b2 = _kp->b2; p.ln2_g = _kp->ln2_g; p.ln2_b = _kp->ln2_b; p.out = _kp->out; p.ws = _kp->ws; unsigned char* const ws = p.ws; \
    unsigned* const ctl = (unsigned*)(ws + WS_CTL); float* const ksum = (float*)(ws + WS_KSUM); float* const rope = (float*)(ws + WS_ROPE); \
    bf16_t* const w_in_t = (bf16_t*)(ws + WS_WIN_T); bf16_t* const w_out_t = (bf16_t*)(ws + WS_WOUT_T); \
    unsigned char* const w1_8 = ws + WS_W1_8; unsigned char* const w2_8 = ws + WS_W2_8; unsigned char* const x1_8 = ws + WS_X1_8; unsigned char* const act8 = ws + WS_ACT8; \
    int* const cnt_blk = (int*)(ws + WS_CNT); int* const tile_e = (int*)(ws + WS_TILE_E); bf16_t* const wr_hi = (bf16_t*)(ws + WS_WR_HI); bf16_t* const wr_lo = (bf16_t*)(ws + WS_WR_LO); \
    int* const tok = (int*)(ws + WS_TOK); int* const asg_e = (int*)(ws + WS_ASG_E); float* const asg_g = (float*)(ws + WS_ASG_G); int* const asg_d = (int*)(ws + WS_ASG_D); \
    bf16_t* const x1b = (bf16_t*)(ws + WS_X1B); bf16_t* const xb = (bf16_t*)(ws + WS_XB); bf16_t* const attn_o = xb; bf16_t* const qkv = (bf16_t*)(ws + WS_QKV); unsigned char* const yb = ws + WS_YB; \
    (void)ctl; (void)ksum; (void)rope; (void)w_in_t; (void)w_out_t; (void)w1_8; (void)w2_8; (void)x1_8; (void)act8; (void)cnt_blk; (void)tile_e; (void)wr_hi; (void)wr_lo; (void)tok; (void)asg_e; (void)asg_g; (void)asg_d; \
    (void)x1b; (void)xb; (void)attn_o; (void)qkv; (void)yb
    { const int t0 = tid_of(wave_s); if (t0 < 2) ((LAS unsigned*)(lds + LDS_BARST))[t0] = 0u; }
    __syncthreads();
    XcdBarrier xbar;
    { PHASE_PTRS(); xbar = xcd_barrier_post(ctl + CW_BAR, (volatile LAS unsigned*)(lds + LDS_BARST), wave_s); }

    REP(0) {
        PHASE_IDS(); PHASE_PTRS();
        const long gt = (long)bx * NTHREADS + tid, gsz = (long)G * NTHREADS;
        for (long i = gt; i < 2048 * 32; i += gsz) {
            const int pos = (int)(i >> 5), k = (int)(i & 31);
            double inv = 1.0; for (int q = 0; q < k; ++q) inv *= 0.7498942093324559;
            double s, c; sincos_d((double)pos * inv, s, c);
            rope[pos * 64 + k] = (float)c; rope[pos * 64 + 32 + k] = (float)s;
        }
        for (long i = gt; i < 32 * 1024; i += gsz) {
            const int e = (int)(i >> 10), k = (int)(i & 1023); const float w = p.w_router[k * 32 + e];
            const unsigned h = f2bf(w); wr_hi[i] = (bf16_t)h; wr_lo[i] = (bf16_t)f2bf(w - bf2f(h));
        }
        LAS float* scr = (LAS float*)(lds + wave * 16384);
        const int gw = bx * 8 + wave, NGW = G * 8;
        constexpr int I_IN = 16 * (INW / 32), I_OUT = 16 * 32, I_W1 = 16 * 64, I_W2 = 16 * 32;
        constexpr int NITEMS = I_IN + I_OUT + NE * I_W1 + NE * I_W2;
        for (int it = gw; it < NITEMS; it += NGW) {
            int r = it;
#if INPROJ_FP8
            if (r < I_IN) { p0_transpose_item_fp8(p.w_in, INW, (unsigned char*)w_in_t, 0, WIN_SCALE, scr, r, lane); continue; } r -= I_IN;
#else
            if (r < I_IN) { p0_transpose_item(p.w_in, INW, w_in_t, 0, scr, r, lane); continue; } r -= I_IN;
#endif
            if (r < I_OUT) { p0_transpose_item(p.w_out, 1024, w_out_t, 1, scr, r, lane); continue; } r -= I_OUT;
            if (r < NE * I_W1) { const int e = r / I_W1; p0_transpose_item_fp8(p.w1 + (size_t)e * 1024 * 2048, 2048, w1_8 + (size_t)e * 2048 * 1024, 2, W_SCALE, scr, r % I_W1, lane); continue; } r -= NE * I_W1;
            { const int e = r / I_W2; p0_transpose_item_fp8(p.w2 + (size_t)e * 1024 * 1024, 1024, w2_8 + (size_t)e * 1024 * 1024, 1, W_SCALE, scr, r % I_W2, lane); }
        }
        const f32x4* x4 = (const f32x4*)p.x;
#if INPROJ_FP8
        u32x2* x8 = (u32x2*)xb;
        for (long i = gt; i < (long)T * D / 8; i += gsz) { const f32x4 a = x4[2 * i], b = x4[2 * i + 1];
            u32x2 o; o.x = pk4_fp8(a[0], a[1], a[2], a[3]); o.y = pk4_fp8(b[0], b[1], b[2], b[3]); x8[i] = o; }
#else
        u32x4* xb4 = (u32x4*)xb;
        for (long i = gt; i < (long)T * D / 8; i += gsz) { const f32x4 a = x4[2 * i], b = x4[2 * i + 1];
            u32x4 o; o.x = cvtpk(a[0], a[1]); o.y = cvtpk(a[2], a[3]); o.z = cvtpk(b[0], b[1]); o.w = cvtpk(b[2], b[3]); xb4[i] = o; }
#endif
    }
    xcd_barrier(xbar, wave_s);

    REP(1) {
        PHASE_PTRS();
#if INPROJ_FP8
        pg8::SchedInProj<1024> S{(const char*)xb, (const char*)w_in_t, G, bx};
        pg8::EpiInProj E{qkv, p.b_in, rope, ksum, 1.0f / WIN_SCALE};
        pg8::gemm_phase<pg8::EpiInProj, pg8::SchedInProj<1024>, false, true, 512, true>(lds, S, E, wave_s);
#else
        pg8::SchedInProj<2048> S{(const char*)xb, (const char*)w_in_t, G, bx};
        pg8::EpiInProj E{qkv, p.b_in, rope, ksum, 1.0f};
        pg8::gemm_phase<pg8::EpiInProj, pg8::SchedInProj<2048>, false, true>(lds, S, E, wave_s);
#endif
    }
    xcd_barrier(xbar, wave_s);

    REP(2) for (int u = bx; u < 256; u += G) {
        PHASE_PTRS();
        { const int b = u >> 3, h = u & 7;
            for (int j = 0; j < 8; ++j) att::moba_unit<8>(b, h, j, qkv, attn_o, ksum, (LAS char*)lds, wave_s); }
        { const int b = u >> 3, kvh = (u >> 2) & 1, oct = u & 3;
            att::swa_stream((LAS char*)lds, qkv, attn_o, b, kvh, oct * 8, 8, p.sinks, wave_s); }
    }
    xcd_barrier(xbar, wave_s);

    REP(3) for (int pm = bx; pm < T / 256; pm += G) {
        PHASE_IDS(); PHASE_PTRS();
        {
            pg8::SchedPanel S{(const char*)attn_o, (const char*)w_out_t, pm};
            pg8::EpiOutProj E{(bf16_t*)p.out, p.b_out, p.x};
            pg8::gemm_phase<pg8::EpiOutProj, pg8::SchedPanel, false, true>(lds, S, E, wave_s);
        }
        __syncthreads();
        {
#pragma unroll
            for (int i = 0; i < 16; ++i) { const int idx = tid + 512 * i, mat = idx >> 12, rw = (idx >> 7) & 31, ch = idx & 127;
                const u32x4 v = *(const u32x4*)((mat ? wr_lo : wr_hi) + rw * 1024 + ch * 8);
                *(LAS u32x4*)(lds + mat * 66048 + rw * 2064 + ch * 16) = v; }
        }
        {
            const bf16_t* ytmp = (const bf16_t*)p.out;
            f32x4 gg[2][2], bb[2][2];
#pragma unroll
            for (int j = 0; j < 2; ++j)
#pragma unroll
                for (int h = 0; h < 2; ++h) { gg[j][h] = *(const f32x4*)(p.ln1_g + 512 * j + 8 * lane + 4 * h); bb[j][h] = *(const f32x4*)(p.ln1_b + 512 * j + 8 * lane + 4 * h); }
            for (int rr = 0; rr < 32; rr += 4) {
                const size_t row0 = (size_t)pm * 256 + wave * 32 + rr;
                u32x4 raw[4][2]; float v[4][2][8]; float sm[4], sq[4];
#pragma unroll
                for (int q = 0; q < 4; ++q)
#pragma unroll
                    for (int j = 0; j < 2; ++j) raw[q][j] = *(const u32x4*)(ytmp + (row0 + q) * D + 512 * j + 8 * lane);
#pragma unroll
                for (int q = 0; q < 4; ++q) { float s_ = 0.f;
#pragma unroll
                    for (int j = 0; j < 2; ++j)
#pragma unroll
                        for (int c = 0; c < 4; ++c) { const unsigned w = raw[q][j][c]; v[q][j][2 * c] = bf2f(w & 0xffffu); v[q][j][2 * c + 1] = bf2f(w >> 16); s_ += v[q][j][2 * c] + v[q][j][2 * c + 1]; }
                    sm[q] = s_; }
#pragma unroll
                for (int o = 1; o < 64; o <<= 1) {
#pragma unroll
                    for (int q = 0; q < 4; ++q) sm[q] += __shfl_xor(sm[q], o); }
#pragma unroll
                for (int q = 0; q < 4; ++q) { const float mean = sm[q] * (1.0f / D); float s2 = 0.f;
#pragma unroll
                    for (int j = 0; j < 2; ++j)
#pragma unroll
                        for (int c = 0; c < 8; ++c) { v[q][j][c] -= mean; s2 += v[q][j][c] * v[q][j][c]; }
                    sq[q] = s2; }
#pragma unroll
                for (int o = 1; o < 64; o <<= 1) {
#pragma unroll
                    for (int q = 0; q < 4; ++q) sq[q] += __shfl_xor(sq[q], o); }
#pragma unroll
                for (int q = 0; q < 4; ++q) {
                    const float rstd = 1.0f / sqrtf(sq[q] * (1.0f / D) + LN_EPS);
#pragma unroll
                    for (int j = 0; j < 2; ++j) {
                        float xv[8];
#pragma unroll
                        for (int c = 0; c < 8; ++c) xv[c] = v[q][j][c] * rstd * gg[j][c >> 2][c & 3] + bb[j][c >> 2][c & 3];
                        u32x4 hv; hv.x = cvtpk(xv[0], xv[1]); hv.y = cvtpk(xv[2], xv[3]); hv.z = cvtpk(xv[4], xv[5]); hv.w = cvtpk(xv[6], xv[7]);
                        u32x2 fv; fv.x = pk4_fp8(xv[0], xv[1], xv[2], xv[3]); fv.y = pk4_fp8(xv[4], xv[5], xv[6], xv[7]);
                        *(u32x4*)(x1b + (row0 + q) * D + 512 * j + 8 * lane) = hv;
                        *(u32x2*)(x1_8 + (row0 + q) * D + 512 * j + 8 * lane) = fv;
                    }
                }
            }
        }
        __syncthreads();
        {
            const int fr = lane & 15, fq = lane >> 4;
            f32x4 lacc[2][2];
#pragma unroll
            for (int m = 0; m < 2; ++m)
#pragma unroll
                for (int n = 0; n < 2; ++n) lacc[m][n] = (f32x4){0.f, 0.f, 0.f, 0.f};
            const size_t r0 = (size_t)pm * 256 + wave * 32;
            const bf16_t* ah = x1b + (r0 + fr) * D + 8 * fq;
            const LAS unsigned char* bh = lds + fr * 2064 + 16 * fq; const LAS unsigned char* bl = bh + 66048;
#pragma unroll 4
            for (int k0 = 0; k0 < 1024; k0 += 32) {
                bf16x8 a_hi[2], b_hi[2], b_lo[2];
#pragma unroll
                for (int m = 0; m < 2; ++m) a_hi[m] = *(const bf16x8*)(ah + (size_t)m * 16 * D + k0);
#pragma unroll
                for (int n = 0; n < 2; ++n) { b_hi[n] = *(const LAS bf16x8*)(bh + n * 16 * 2064 + k0 * 2); b_lo[n] = *(const LAS bf16x8*)(bl + n * 16 * 2064 + k0 * 2); }
#pragma unroll
                for (int m = 0; m < 2; ++m)
#pragma unroll
                    for (int n = 0; n < 2; ++n) {
                        lacc[m][n] = __builtin_amdgcn_mfma_f32_16x16x32_bf16(a_hi[m], b_hi[n], lacc[m][n], 0, 0, 0);
                        lacc[m][n] = __builtin_amdgcn_mfma_f32_16x16x32_bf16(a_hi[m], b_lo[n], lacc[m][n], 0, 0, 0);
                    }
            }
            __syncthreads();
            LAS float* lg = (LAS float*)lds;
#pragma unroll
            for (int m = 0; m < 2; ++m)
#pragma unroll
                for (int n = 0; n < 2; ++n)
#pragma unroll
                    for (int rg = 0; rg < 4; ++rg) lg[(wave * 32 + 16 * m + 4 * fq + rg) * 33 + 16 * n + fr] = lacc[m][n][rg];
        }
        __syncthreads();
        {
            LAS float* lg = (LAS float*)lds;
            LAS int* wcnt = (LAS int*)(lds + 36864);
            float t0 = -INFINITY, t1 = -INFINITY, t2 = -INFINITY, t3 = -INFINITY; int i0 = 0, i1 = 0, i2 = 0, i3 = 0;
            int rk0 = 0, rk1 = 0, rk2 = 0, rk3 = 0;
            if (tid < 256) {
                for (int e = 0; e < NE; ++e) {
                    const float xv = lg[tid * 33 + e] + p.b_router[e];
                    if (xv > t3) {
                        if (xv > t2) { t3 = t2; i3 = i2;
                            if (xv > t1) { t2 = t1; i2 = i1;
                                if (xv > t0) { t1 = t0; i1 = i0; t0 = xv; i0 = e; } else { t1 = xv; i1 = e; }
                            } else { t2 = xv; i2 = e; }
                        } else { t3 = xv; i3 = e; }
                    }
                }
                const unsigned selm = (1u << i0) | (1u << i1) | (1u << i2) | (1u << i3);
                for (int e = 0; e < NE; ++e) {
                    const bool has = ((selm >> e) & 1u) != 0u;
                    const unsigned long long bal = __ballot(has);
                    const int pre = __popcll(bal & ((1ull << lane) - 1ull));
                    if (e == i0) rk0 = pre; if (e == i1) rk1 = pre; if (e == i2) rk2 = pre; if (e == i3) rk3 = pre;
                    if (lane == 0) wcnt[wave * 32 + e] = __popcll(bal);
                }
            }
            __syncthreads();
            if (tid < 256) {
                const float e1 = __expf(t1 - t0), e2 = __expf(t2 - t0), e3 = __expf(t3 - t0);
                const float inv = 1.0f / (1.0f + e1 + e2 + e3);
                int b0 = 0, b1 = 0, b2 = 0, b3 = 0;
                for (int w = 0; w < wave; ++w) { b0 += wcnt[w * 32 + i0]; b1 += wcnt[w * 32 + i1]; b2 += wcnt[w * 32 + i2]; b3 += wcnt[w * 32 + i3]; }
                const size_t a = ((size_t)pm * 256 + tid) * 4;
                *(int4*)(asg_e + a) = make_int4(i0, i1, i2, i3);
                *(float4*)(asg_g + a) = make_float4(inv, e1 * inv, e2 * inv, e3 * inv);
                *(int4*)(asg_d + a) = make_int4(b0 + rk0, b1 + rk1, b2 + rk2, b3 + rk3);
            }
            if (tid < 32) cnt_blk[pm * 32 + tid] = wcnt[tid] + wcnt[32 + tid] + wcnt[64 + tid] + wcnt[96 + tid];
            __syncthreads();
        }
    }
    xcd_barrier(xbar, wave_s);

    for (int pm = bx; pm < T / 256; pm += G) {
        PHASE_IDS(); PHASE_PTRS();
        LAS int* part_all = (LAS int*)lds; LAS int* part_pre = part_all + 512; LAS int* tot = part_pre + 512; LAS int* pre = tot + 32; LAS int* poff = pre + 32;
        { const int e = tid & 31, seg = tid >> 5; int sa = 0, sp = 0;
            for (int bb = seg * 16; bb < seg * 16 + 16; ++bb) { const int c = cnt_blk[bb * 32 + e]; sa += c; sp += (bb < pm) ? c : 0; }
            part_all[tid] = sa; part_pre[tid] = sp; }
        __syncthreads();
        if (tid < 32) { int sa = 0, sp = 0; for (int s = 0; s < 16; ++s) { sa += part_all[s * 32 + tid]; sp += part_pre[s * 32 + tid]; } tot[tid] = sa; pre[tid] = sp; }
        __syncthreads();
        if (tid == 0) { int off = 0; for (int e = 0; e < NE; ++e) { poff[e] = off; off += ((tot[e] + 255) >> 8) << 8; } poff[32] = off; }
        __syncthreads();
        if (tid < 256) {
            const int token = pm * 256 + tid; const size_t a = (size_t)token * 4;
            const int4 ee = *(const int4*)(asg_e + a); const int4 rk = *(const int4*)(asg_d + a);
            const int d0 = poff[ee.x] + pre[ee.x] + rk.x, d1 = poff[ee.y] + pre[ee.y] + rk.y, d2 = poff[ee.z] + pre[ee.z] + rk.z, d3 = poff[ee.w] + pre[ee.w] + rk.w;
            *(int4*)(asg_d + a) = make_int4(d0, d1, d2, d3);
            tok[d0] = token; tok[d1] = token; tok[d2] = token; tok[d3] = token;
        }
        if (pm < NE) {
            const int e = pm, n = tot[e], np = ((n + 255) >> 8) << 8, o = poff[e];
            for (int i = n + tid; i < np; i += NTHREADS) tok[o + i] = 0;
            for (int i = tid; i < (np >> 8); i += NTHREADS) tile_e[(o >> 8) + i] = e;
        }
        if (pm == 0 && tid == 0) ctl[CW_NTILES] = (unsigned)(poff[32] >> 8);
        __syncthreads();
    }
    xcd_barrier(xbar, wave_s);

    REP(5) {
        PHASE_PTRS(); const int ntiles = (int)ctl[CW_NTILES];
        { LAS int* tl = (LAS int*)(lds + LDSX_TILE); for (int i = tid_of(wave_s); i < ntiles; i += NTHREADS) tl[i] = tile_e[i]; __syncthreads(); }
        pg8::SchedMoe<8, true> S{(const char*)x1_8, (const char*)w1_8, (const LAS int*)(lds + LDSX_TILE), tok, ntiles, G, bx};
        pg8::EpiSwiglu E{act8, p.b1};
        pg8::gemm_phase<pg8::EpiSwiglu, pg8::SchedMoe<8, true>, true, true, 512, true, true>(lds, S, E, wave_s);
    }
    xcd_barrier(xbar, wave_s);

    REP(6) {
        PHASE_PTRS(); const int ntiles = (int)ctl[CW_NTILES];
        { LAS int* tl = (LAS int*)(lds + LDSX_TILE); for (int i = tid_of(wave_s); i < ntiles; i += NTHREADS) tl[i] = tile_e[i]; __syncthreads(); }
        pg8::SchedMoe<4, false> S{(const char*)act8, (const char*)w2_8, (const LAS int*)(lds + LDSX_TILE), tok, ntiles, G, bx};
        pg8::EpiDown E{yb, p.b2};
        pg8::gemm_phase<pg8::EpiDown, pg8::SchedMoe<4, false>, false, true, 512, true, true>(lds, S, E, wave_s);
    }
    xcd_barrier(xbar, wave_s);

    REP(7) {
        PHASE_IDS(); PHASE_PTRS();
        const int gw = bx * 8 + wave, NGW = G * 8;
        f32x4 gg[2][2], bb[2][2];
#pragma unroll
        for (int j = 0; j < 2; ++j)
#pragma unroll
            for (int h = 0; h < 2; ++h) { gg[j][h] = *(const f32x4*)(p.ln2_g + 512 * j + 8 * lane + 4 * h); bb[j][h] = *(const f32x4*)(p.ln2_b + 512 * j + 8 * lane + 4 * h); }
        constexpr int R = 2;
        for (int row0 = gw; row0 < T; row0 += R * NGW) {
            int4 dd[R]; float4 gt[R];
#pragma unroll
            for (int q = 0; q < R; ++q) { const int row = row0 + q * NGW < T ? row0 + q * NGW : row0; dd[q] = *(const int4*)(asg_d + (size_t)row * 4); gt[q] = *(const float4*)(asg_g + (size_t)row * 4); }
            u32x4 xr[R][2]; u32x2 yk[R][4][2];
#pragma unroll
            for (int q = 0; q < R; ++q) { const int row = row0 + q * NGW < T ? row0 + q * NGW : row0;
#pragma unroll
                for (int j = 0; j < 2; ++j) {
                    xr[q][j] = *(const u32x4*)(x1b + (size_t)row * D + 512 * j + 8 * lane);
                    yk[q][0][j] = *(const u32x2*)(yb + (size_t)dd[q].x * D + 512 * j + 8 * lane);
                    yk[q][1][j] = *(const u32x2*)(yb + (size_t)dd[q].y * D + 512 * j + 8 * lane);
                    yk[q][2][j] = *(const u32x2*)(yb + (size_t)dd[q].z * D + 512 * j + 8 * lane);
                    yk[q][3][j] = *(const u32x2*)(yb + (size_t)dd[q].w * D + 512 * j + 8 * lane);
                } }
            float z[R][2][8]; float sm[R], sq[R];
#pragma unroll
            for (int q = 0; q < R; ++q) {
                const float g0 = gt[q].x * (1.0f / Y_SCALE), g1 = gt[q].y * (1.0f / Y_SCALE), g2 = gt[q].z * (1.0f / Y_SCALE), g3 = gt[q].w * (1.0f / Y_SCALE);
                float s_ = 0.f;
#pragma unroll
                for (int j = 0; j < 2; ++j)
#pragma unroll
                    for (int d = 0; d < 2; ++d) {
#define P7_PAIR(HH, SEL) do { \
                            const f32x2 a0 = __builtin_amdgcn_cvt_pk_f32_fp8((int)yk[q][0][j][d], SEL), a1 = __builtin_amdgcn_cvt_pk_f32_fp8((int)yk[q][1][j][d], SEL); \
                            const f32x2 a2 = __builtin_amdgcn_cvt_pk_f32_fp8((int)yk[q][2][j][d], SEL), a3 = __builtin_amdgcn_cvt_pk_f32_fp8((int)yk[q][3][j][d], SEL); \
                            const unsigned xw = xr[q][j][2 * d + HH]; \
                            const float lo = DN_ALPHA * bf2f(xw & 0xffffu) + g0 * a0.x + g1 * a1.x + g2 * a2.x + g3 * a3.x; \
                            const float hi = DN_ALPHA * bf2f(xw >> 16) + g0 * a0.y + g1 * a1.y + g2 * a2.y + g3 * a3.y; \
                            z[q][j][4 * d + 2 * HH] = lo; z[q][j][4 * d + 2 * HH + 1] = hi; s_ += lo + hi; } while (0)
                        P7_PAIR(0, false); P7_PAIR(1, true);
#undef P7_PAIR
                    }
                sm[q] = s_;
            }
#pragma unroll
            for (int o = 1; o < 64; o <<= 1) {
#pragma unroll
                for (int q = 0; q < R; ++q) sm[q] += __shfl_xor(sm[q], o); }
#pragma unroll
            for (int q = 0; q < R; ++q) { const float mean = sm[q] * (1.0f / D); float s2 = 0.f;
#pragma unroll
                for (int j = 0; j < 2; ++j)
#pragma unroll
                    for (int c = 0; c < 8; ++c) { z[q][j][c] -= mean; s2 += z[q][j][c] * z[q][j][c]; }
                sq[q] = s2; }
#pragma unroll
            for (int o = 1; o < 64; o <<= 1) {
#pragma unroll
                for (int q = 0; q < R; ++q) sq[q] += __shfl_xor(sq[q], o); }
#pragma unroll
            for (int q = 0; q < R; ++q) {
                const int row = row0 + q * NGW;
                if (row < T) {
                    const float rstd = 1.0f / sqrtf(sq[q] * (1.0f / D) + LN_EPS);
#pragma unroll
                    for (int j = 0; j < 2; ++j)
#pragma unroll
                        for (int h = 0; h < 2; ++h) {
                            f32x4 o;
#pragma unroll
                            for (int c = 0; c < 4; ++c) o[c] = z[q][j][4 * h + c] * rstd * gg[j][h][c] + bb[j][h][c];
                            *(f32x4*)(p.out + (size_t)row * D + 512 * j + 8 * lane + 4 * h) = o;
                        }
                }
            }
        }
    }
}

extern "C" void kernel_launch(void* const* d_in, const int* in_sizes, int n_in, void* d_out, int out_size, void* d_ws, size_t ws_size, hipStream_t stream) {
    static int grid_blocks = 0;
    if (grid_blocks == 0) {
        if (n_in != 16 || in_sizes[0] != T * D || out_size != T * D || ws_size < WS_END) {
            fprintf(stderr, "kernel_launch: unexpected shapes: n_in %d in0 %d out %d ws %zu (need %zu)\n", n_in, n_in > 0 ? in_sizes[0] : -1, out_size, ws_size, (size_t)WS_END); grid_blocks = -1; return; }
        int dev = 0, cus = 0, per_cu = 0;
        (void)hipGetDevice(&dev);
        (void)hipDeviceGetAttribute(&cus, hipDeviceAttributeMultiprocessorCount, dev);
        (void)hipFuncSetAttribute((const void*)fwd_megakernel, hipFuncAttributeMaxDynamicSharedMemorySize, LDS_BYTES);
        (void)hipOccupancyMaxActiveBlocksPerMultiprocessor(&per_cu, (const void*)fwd_megakernel, NTHREADS, LDS_BYTES);
        if (per_cu < 1) { fprintf(stderr, "kernel_launch: occupancy query reports %d blocks per CU\n", per_cu); per_cu = 1; }
        grid_blocks = cus;
        fprintf(stderr, "kernel_launch: cus=%d per_cu=%d grid=%d ws=%zu\n", cus, per_cu, grid_blocks, ws_size);
    }
    if (grid_blocks < 0) return;
    (void)hipMemsetAsync((char*)d_ws + WS_CTL, 0, CTL_ZERO_BYTES, stream);
    Params p{};
    p.x = (const float*)d_in[0]; p.w_in = (const float*)d_in[1]; p.b_in = (const float*)d_in[2]; p.sinks = (const float*)d_in[3]; p.w_out = (const float*)d_in[4]; p.b_out = (const float*)d_in[5];
    p.ln1_g = (const float*)d_in[6]; p.ln1_b = (const float*)d_in[7]; p.w_router = (const float*)d_in[8]; p.b_router = (const float*)d_in[9];
    p.w1 = (const float*)d_in[10]; p.b1 = (const float*)d_in[11]; p.w2 = (const float*)d_in[12]; p.b2 = (const float*)d_in[13]; p.ln2_g = (const float*)d_in[14]; p.ln2_b = (const float*)d_in[15];
    p.out = (float*)d_out; p.ws = (unsigned char*)d_ws;
    hipLaunchKernelGGL(fwd_megakernel, dim3(grid_blocks), dim3(NTHREADS), LDS_BYTES, stream, p);
    hipError_t e = hipPeekAtLastError();
    if (e != hipSuccess) fprintf(stderr, "launch failed: %s (grid %d)\n", hipGetErrorString(e), grid_blocks);
}
```

```cpp
#include <hip/hip_runtime.h>
#include <cstdio>
#include <cstdint>

#define LAS __attribute__((address_space(3)))
typedef unsigned short bf16_t;
typedef short bf16x8 __attribute__((ext_vector_type(8)));
typedef short s16x4 __attribute__((ext_vector_type(4)));
typedef float f32x2 __attribute__((ext_vector_type(2)));
typedef float f32x4 __attribute__((ext_vector_type(4)));
typedef float f32x16 __attribute__((ext_vector_type(16)));
typedef unsigned u32x2 __attribute__((ext_vector_type(2)));
typedef unsigned u32x4 __attribute__((ext_vector_type(4)));
typedef __bf16 bf16x2_t __attribute__((ext_vector_type(2)));

constexpr int D = 1024, BATCH = 32, SEQ = 2048, T = BATCH * SEQ;
constexpr int INW = 2304, NE = 32;
constexpr float LN_EPS = 1e-5f;
constexpr float DN_ALPHA = 1.189207115002721f;
constexpr float LOG2E = 1.4426950408889634f;
constexpr float C2 = 0.18033688011112042f;
constexpr int NTHREADS = 512;
constexpr int LDS_BYTES = 147456;
constexpr int MAX_TILES = 1056;
#ifndef INPROJ_FP8
#define INPROJ_FP8 1
#endif
#ifndef EPI_DUP
#define EPI_DUP 0
#endif
#ifndef DUP_MASK
#define DUP_MASK 0
#endif
#define REP(k) for (int _rep = 0; _rep < (((DUP_MASK >> (k)) & 1) ? 2 : 1); ++_rep)

constexpr size_t MiB = 1u << 20;
constexpr size_t WS_CTL = 0, CTL_ZERO_BYTES = 2 * MiB;
constexpr size_t WS_KSUM = 1 * MiB;
constexpr size_t WS_ROPE = 2 * MiB;
constexpr size_t WS_WIN_T = 4 * MiB;
constexpr size_t WS_WOUT_T = 9 * MiB;
constexpr size_t WS_SMALL = 11 * MiB;
constexpr size_t WS_CNT = WS_SMALL, WS_TILE_E = WS_SMALL + 65536, WS_WR_HI = WS_SMALL + 131072, WS_WR_LO = WS_WR_HI + 65536;
constexpr size_t WS_TOK = 12 * MiB;
constexpr size_t WS_ASG_E = 14 * MiB, WS_ASG_G = 15 * MiB, WS_ASG_D = 16 * MiB;
constexpr size_t WS_W2_8 = 24 * MiB;
constexpr size_t WS_X1B = 56 * MiB;
constexpr size_t WS_ACT8 = 184 * MiB;
constexpr size_t WS_XB = 184 * MiB;
constexpr size_t WS_X1LO = 312 * MiB;
constexpr size_t WS_YB = 488 * MiB;
constexpr size_t WS_W1_8 = 488 * MiB;
constexpr size_t WS_X1_8 = 552 * MiB;
constexpr size_t WS_QKV = 616 * MiB;
constexpr size_t WS_END = 1016 * MiB;
constexpr float W_SCALE = 64.0f, ACT_SCALE = 4.0f, WIN_SCALE = 32.0f, Y_SCALE = 16.0f, AO_SCALE = 64.0f;
constexpr int CW_NTILES = 16, CW_BAR = 4096;
constexpr int LDSX_TILE = 131072, LDSX_IDX = 135424, LDSX_BIAS = 136448;
constexpr int LDS_BARST = LDS_BYTES - 256;

struct Params {
    const float *x, *w_in, *b_in, *sinks, *w_out, *b_out, *ln1_g, *ln1_b, *w_router, *b_router, *w1, *b1, *w2, *b2, *ln2_g, *ln2_b;
    float* out; unsigned char* ws;
};

__device__ __forceinline__ unsigned f2bf(float f) { unsigned u = __builtin_bit_cast(unsigned, f); return (u + 0x7fffu + ((u >> 16) & 1u)) >> 16; }
__device__ __forceinline__ float bf2f(unsigned h) { return __builtin_bit_cast(float, h << 16); }
__device__ __forceinline__ unsigned cvtpk(float lo, float hi) { f32x2 v = {lo, hi}; bf16x2_t b = __builtin_convertvector(v, bf16x2_t); return __builtin_bit_cast(unsigned, b); }
__device__ __forceinline__ unsigned pk4_fp8(float a, float b, float c, float d) { int w = 0; w = __builtin_amdgcn_cvt_pk_fp8_f32(a, b, w, false); w = __builtin_amdgcn_cvt_pk_fp8_f32(c, d, w, true); return (unsigned)w; }
__device__ __forceinline__ float wave_sum(float v) {
#pragma unroll
    for (int o = 1; o < 64; o <<= 1) v += __shfl_xor(v, o);
    return v;
}
#define LDS_WAIT() asm volatile("s_waitcnt lgkmcnt(0)" ::: "memory")
__device__ __forceinline__ int tid_of(int wave_s) { unsigned z = 0u; asm volatile("" : "+v"(z));
    return wave_s * 64 + (int)__builtin_amdgcn_mbcnt_hi(~0u, __builtin_amdgcn_mbcnt_lo(~0u, z)); }
template <int X> __device__ __forceinline__ float swz_xor(float v) { return __builtin_bit_cast(float, __builtin_amdgcn_ds_swizzle(__builtin_bit_cast(int, v), (X << 10) | 0x1f)); }

namespace pg8 {
constexpr int BM = 256, BK = 64, HALF = 128, HTB = HALF * BK * 2, STAGE_BYTES = 8 * HTB, NXCD = 8, WGM = 8;
constexpr int KD = 1024;
__host__ __device__ __forceinline__ int lds_byte(int r, int c) { const int st = (r >> 4) * 2 + (c >> 5), rr = r & 15, cc = c & 31, ob = rr * 64 + cc * 2; return st * 1024 + (ob ^ (((ob >> 9) & 1) << 5)); }
__host__ __device__ __forceinline__ void stage_rc(int b, int& R, int& C) { const int st = b / 1024, sb = b % 1024, swz = sb ^ (((sb >> 9) & 1) << 5); R = (st >> 1) * 16 + swz / 64; C = (st & 1) * 32 + (swz % 64) / 2; }
__host__ __device__ __forceinline__ int perm32(int rho) { const int n = rho >> 4, i = rho & 15; return 8 * (i >> 2) + 4 * n + (i & 3); }

struct Unit { int pm, pn, e; unsigned ao, bo; const int* rows; };

typedef int v8i32_t __attribute__((ext_vector_type(8)));
typedef int v4i32_t __attribute__((ext_vector_type(4)));
__device__ __forceinline__ v8i32_t cat8(bf16x8 a, bf16x8 b) { const v4i32_t x = __builtin_bit_cast(v4i32_t, a), y = __builtin_bit_cast(v4i32_t, b); return __builtin_shufflevector(x, y, 0, 1, 2, 3, 4, 5, 6, 7); }
template <class Epi, class Sched, bool GATHER, bool ALIGN_EPI, int KP = 1024, bool FP8 = false, bool MOE = false>
__device__ __forceinline__ void gemm_phase(LAS unsigned char* lds, const Sched& S, const Epi& E, const int wave_s) {
    int tid = tid_of(wave_s); asm volatile("" : "+v"(tid));
    const int wid = __builtin_amdgcn_readfirstlane(tid >> 6), lane = tid & 63, wr = wid >> 2, wc = wid & 3, fr = lane & 15, fq = lane >> 4;
    constexpr int K = KP, nt = K / BK;
    unsigned voffB[2], Vc[2][2]; int stR0, stC0;
    { int R, C; stage_rc(tid * 16, R, C); stR0 = R; stC0 = C; }
#pragma unroll
    for (int i = 0; i < 2; ++i) { voffB[i] = (unsigned)((stR0 + 64 * i) * K + stC0) * 2u; Vc[0][i] = voffB[i]; Vc[1][i] = voffB[i]; }
#define PG8_GATHER_LOAD(VV) do { int _t = tid_of(wave_s); asm volatile("" : "+v"(_t)); int _R, _C; stage_rc(_t * 16, _R, _C);     \
        const LAS int* _rp = (const LAS int*)(lds + LDSX_IDX) + _R; _Pragma("unroll") for (int _h = 0; _h < 2; ++_h) _Pragma("unroll") for (int _i = 0; _i < 2; ++_i) \
        VV[_h][_i] = ((unsigned)_rp[128 * _h + 64 * _i] * (unsigned)K + (unsigned)_C) * 2u; } while (0)
#define PG8_DMA4(gsrc, ldsoff) __builtin_amdgcn_global_load_lds((const unsigned*)(gsrc), (LAS unsigned*)(lds + (ldsoff)), 4, 0, 0)
    constexpr unsigned kstep = (unsigned)(BK * 2);
    constexpr unsigned hstep = (unsigned)HALF * K * 2;
    const char* const Abase = S.A; const char* const Bbase = S.B;
    const unsigned ldsw = (unsigned)wid * 1024u;
    const int aoff = lds_byte(wr * 64 + fr, fq * 8), boff = lds_byte(wc * 32 + fr, fq * 8);
#define PG8_SA(b, h) (((b) * 2 + (h)) * HTB)
#define PG8_SB(b, h) ((4 + (b) * 2 + (h)) * HTB)
#define PG8_STAGE(bufoff, gbase, soff, voff) do { _Pragma("unroll") for (int _i = 0; _i < 2; ++_i) \
        __builtin_amdgcn_global_load_lds((const unsigned*)((gbase) + (unsigned)((voff)[_i] + (soff))), (LAS unsigned*)(lds + (bufoff) + ldsw + _i * 8192), 16, 0, 0); } while (0)
#define PG8_STAGE_B(bufoff, soff) PG8_STAGE(bufoff, Bbase, soff, voffB)
#define PG8_STAGE_A(bufoff, soff, h, VV) do { if constexpr (GATHER) { PG8_STAGE(bufoff, Abase, soff, VV[h]); } else { PG8_STAGE(bufoff, Abase, (soff) + (h) * hstep, voffB); } } while (0)
#define PG8_LDA(dst, b, h) do { _Pragma("unroll") for (int m = 0; m < 4; ++m) dst[m] = cat8(*(const LAS bf16x8*)(lds + PG8_SA(b, h) + aoff + m * 2048), *(const LAS bf16x8*)(lds + PG8_SA(b, h) + aoff + m * 2048 + 1024)); } while (0)
#define PG8_LDB(dst, b, h) do { _Pragma("unroll") for (int n = 0; n < 2; ++n) dst[n] = cat8(*(const LAS bf16x8*)(lds + PG8_SB(b, h) + boff + n * 2048), *(const LAS bf16x8*)(lds + PG8_SB(b, h) + boff + n * 2048 + 1024)); } while (0)
#define PG8_LO(v) __builtin_bit_cast(bf16x8, __builtin_shufflevector(v, v, 0, 1, 2, 3))
#define PG8_HI(v) __builtin_bit_cast(bf16x8, __builtin_shufflevector(v, v, 4, 5, 6, 7))
#define PG8_MMA(ai, bj, At, Bt) do { __builtin_amdgcn_s_setprio(1); _Pragma("unroll") for (int m = 0; m < 4; ++m) _Pragma("unroll") for (int n = 0; n < 2; ++n) { \
        if constexpr (FP8) { acc[ai][bj][m][n] = __builtin_amdgcn_mfma_scale_f32_16x16x128_f8f6f4(Bt[n], At[m], acc[ai][bj][m][n], 0, 0, 0, 0x7f7f7f7f, 0, 0x7f7f7f7f); } \
        else { acc[ai][bj][m][n] = __builtin_amdgcn_mfma_f32_16x16x32_bf16(PG8_LO(Bt[n]), PG8_LO(At[m]), acc[ai][bj][m][n], 0, 0, 0); \
               acc[ai][bj][m][n] = __builtin_amdgcn_mfma_f32_16x16x32_bf16(PG8_HI(Bt[n]), PG8_HI(At[m]), acc[ai][bj][m][n], 0, 0, 0); } } \
        __builtin_amdgcn_s_setprio(0); } while (0)
#define PG8_WAIT_V(n) asm volatile("s_waitcnt vmcnt(" #n ")" ::: "memory")
#define PG8_WAIT_L(n) asm volatile("s_waitcnt lgkmcnt(" #n ")" ::: "memory")
#define PG8_BAR __builtin_amdgcn_s_barrier()
#define PG8_SCHED __builtin_amdgcn_sched_barrier(0)
    Unit cur, nxt; int ui = 0;
    if (!S.next(0, cur)) return;
    if constexpr (MOE) {
        if (wid < 4) { PG8_DMA4(E.bias_src(cur) + wid * 64 + lane, LDSX_BIAS + wid * 256); if constexpr (GATHER) PG8_DMA4(cur.rows + wid * 64 + lane, LDSX_IDX + wid * 256); }
        asm volatile("s_waitcnt vmcnt(0)" ::: "memory"); __builtin_amdgcn_s_barrier(); asm volatile("" ::: "memory");
    }
    if constexpr (GATHER) { PG8_GATHER_LOAD(Vc); }
    f32x4 acc[2][2][4][2];
#pragma unroll
    for (int a = 0; a < 2; ++a)
#pragma unroll
        for (int b = 0; b < 2; ++b)
#pragma unroll
            for (int m = 0; m < 4; ++m)
#pragma unroll
                for (int n = 0; n < 2; ++n) acc[a][b][m][n] = (f32x4){0.f, 0.f, 0.f, 0.f};
    v8i32_t At[4], B0[2], B1[2];
    unsigned cA = cur.ao, cB = cur.bo;
    PG8_STAGE_B(PG8_SB(0, 0), cB); PG8_STAGE_B(PG8_SB(0, 1), cB + hstep); PG8_STAGE_A(PG8_SA(0, 0), cA, 0, Vc); PG8_STAGE_A(PG8_SA(0, 1), cA, 1, Vc);
    if (wr == 1) PG8_BAR;
    PG8_WAIT_V(2); PG8_BAR;
    PG8_STAGE_B(PG8_SB(1, 0), cB + kstep); PG8_STAGE_A(PG8_SA(1, 0), cA + kstep, 0, Vc); PG8_STAGE_B(PG8_SB(1, 1), cB + hstep + kstep);
    PG8_WAIT_V(6); PG8_BAR;
    for (;;) {
        const bool has_next = S.next(ui + 1, nxt);
        const unsigned nA = has_next ? nxt.ao : cA; const unsigned nB = has_next ? nxt.bo : cB;
        if constexpr (MOE) {
            if (has_next && wid < 4) { PG8_DMA4(E.bias_src(nxt) + wid * 64 + lane, LDSX_BIAS + ((ui + 1) % 3) * 1024 + wid * 256); if constexpr (GATHER) PG8_DMA4(nxt.rows + wid * 64 + lane, LDSX_IDX + wid * 256); }
        }
#pragma unroll 1
        for (int t = 0; t < nt; t += 2) {
            const bool last = (t == nt - 2);
            const unsigned a1 = cA + (unsigned)(t + 1) * kstep;
            const unsigned a2 = last ? nA : cA + (unsigned)(t + 2) * kstep; const unsigned b2 = last ? nB : cB + (unsigned)(t + 2) * kstep;
            const unsigned a3 = a2 + kstep; const unsigned b3 = b2 + kstep;
            PG8_LDB(B0, 0, 0); PG8_LDB(B1, 0, 1); PG8_SCHED; PG8_LDA(At, 0, 0); PG8_STAGE_A(PG8_SA(1, 1), a1, 1, Vc);
            if constexpr (GATHER) { if (last && has_next) { PG8_GATHER_LOAD(Vc); } }
            PG8_WAIT_V(8); PG8_WAIT_L(0); PG8_BAR; PG8_MMA(0, 0, At, B0); PG8_MMA(0, 1, At, B1); PG8_BAR; PG8_SCHED;
            PG8_LDA(At, 0, 1); PG8_STAGE_B(PG8_SB(0, 0), b2); PG8_STAGE_B(PG8_SB(0, 1), b2 + hstep); PG8_STAGE_A(PG8_SA(0, 0), a2, 0, Vc);
            PG8_WAIT_V(8); PG8_WAIT_L(0); PG8_BAR; PG8_MMA(1, 0, At, B0); PG8_MMA(1, 1, At, B1); PG8_BAR; PG8_SCHED;
            PG8_LDB(B0, 1, 0); PG8_LDB(B1, 1, 1); PG8_SCHED; PG8_LDA(At, 1, 0); PG8_STAGE_A(PG8_SA(0, 1), a2, 1, Vc);
            PG8_WAIT_V(8); PG8_WAIT_L(0); PG8_BAR; PG8_MMA(0, 0, At, B0); PG8_MMA(0, 1, At, B1); PG8_BAR; PG8_SCHED;
            PG8_LDA(At, 1, 1); PG8_STAGE_B(PG8_SB(1, 0), b3); PG8_STAGE_B(PG8_SB(1, 1), b3 + hstep); PG8_STAGE_A(PG8_SA(1, 0), a3, 0, Vc);
            PG8_WAIT_V(8); PG8_WAIT_L(0); PG8_BAR; PG8_MMA(1, 0, At, B0); PG8_MMA(1, 1, At, B1); PG8_BAR; PG8_SCHED;
        }
        if constexpr (ALIGN_EPI) { if (wr == 0) PG8_BAR; }
        { int t2 = tid_of(wave_s); asm volatile("" : "+v"(t2));
          if constexpr (MOE) { E(acc, cur, wr, wc, t2 & 15, (t2 & 63) >> 4, (const LAS float*)(lds + LDSX_BIAS + (ui % 3) * 1024));
              if (EPI_DUP) { asm volatile("" : "+v"(t2)); E(acc, cur, wr, wc, t2 & 15, (t2 & 63) >> 4, (const LAS float*)(lds + LDSX_BIAS + (ui % 3) * 1024)); } }
          else E(acc, cur, wr, wc, t2 & 15, (t2 & 63) >> 4); }
        if (!has_next) break;
#pragma unroll
        for (int a = 0; a < 2; ++a)
#pragma unroll
            for (int b = 0; b < 2; ++b)
#pragma unroll
                for (int m = 0; m < 4; ++m)
#pragma unroll
                    for (int n = 0; n < 2; ++n) acc[a][b][m][n] = (f32x4){0.f, 0.f, 0.f, 0.f};
        cur = nxt; cA = nA; cB = nB; ++ui;
        if constexpr (ALIGN_EPI) { if (wr == 1) PG8_BAR; }
    }
    PG8_WAIT_V(0);
    if constexpr (!ALIGN_EPI) { if (wr == 0) PG8_BAR; }
    PG8_BAR;
#undef PG8_SA
#undef PG8_SB
#undef PG8_STAGE
#undef PG8_STAGE_A
#undef PG8_STAGE_B
#undef PG8_GATHER_LOAD
#undef PG8_DMA4
#undef PG8_LDA
#undef PG8_LDB
#undef PG8_LO
#undef PG8_HI
#undef PG8_MMA
#undef PG8_WAIT_V
#undef PG8_WAIT_L
#undef PG8_BAR
#undef PG8_SCHED
}

template <int ROWB>
struct SchedInProj {
    const char* A; const char* B; int G, c;
    __device__ __forceinline__ bool next(int i, Unit& u) const {
        constexpr int nM = T / BM, nN = INW / BM, nwg = nM * nN;
        const long L = (long)i * G + c; if (L >= nwg) return false;
        int wgid = (int)L; { const int q = nwg / NXCD, r = nwg % NXCD, xcd = wgid % NXCD, off = wgid / NXCD; wgid = (xcd < r ? xcd * (q + 1) : r * (q + 1) + (xcd - r) * q) + off; }
        const int nig = WGM * nN, gid = wgid / nig, fm = gid * WGM, gsz = (nM - fm) < WGM ? (nM - fm) : WGM;
        u.pm = fm + ((wgid % nig) % gsz); u.pn = (wgid % nig) / gsz; u.e = 0; u.rows = nullptr;
        u.ao = (unsigned)u.pm * (unsigned)(256 * ROWB); u.bo = (unsigned)u.pn * (unsigned)(256 * ROWB); return true;
    }
};
struct SchedPanel {
    const char* A; const char* B; int pm;
    __device__ __forceinline__ bool next(int i, Unit& u) const {
        if (i >= 4) return false;
        u.pm = pm; u.pn = i; u.e = 0; u.rows = nullptr; u.ao = (unsigned)pm * (unsigned)(256 * 1024); u.bo = (unsigned)i * (unsigned)(256 * 1024); return true;
    }
};
template <int NPN, bool G1>
struct SchedMoe {
    const char* A; const char* B; const LAS int* tile_e; const int* tok; int ntiles, G, c;
    __device__ __forceinline__ bool next(int i, Unit& u) const {
        const long L = (long)i * G + c; int t, pn;
        if ((G & 7) == 0) { const int x = (int)(L & 7); const long j = L >> 3; t = (int)(j / NPN) * 8 + x; pn = (int)(j % NPN); }
        else { t = (int)(L / NPN); pn = (int)(L % NPN); }
        if (t >= ntiles) return false;
        const int e = __builtin_amdgcn_readfirstlane(tile_e[t]);
        u.pm = t; u.pn = pn; u.e = e;
        if (G1) { u.ao = 0u; u.rows = tok + (size_t)t * 256; u.bo = ((unsigned)e * 2048u + (unsigned)pn * 256u) * 1024u; }
        else { u.ao = (unsigned)t * (256u * 1024u); u.rows = nullptr; u.bo = ((unsigned)e * 1024u + (unsigned)pn * 256u) * 1024u; }
        return true;
    }
};

struct EpiInProj {
    bf16_t* qkv; const float* b_in; const float* rope; float* ksum; float descale;
    __device__ __forceinline__ void operator()(const f32x4 (&acc)[2][2][4][2], const Unit& u, int wr, int wc, int fr, int fq) const {
        const int pn = u.pn;
        const int colb = 256 * pn + 64 * wc + 8 * fq;
        const bool do_rope = !(pn >= 7 || (pn == 2 && wc >= 2));
        const bool is_q = (pn < 2) || (pn == 3) || (pn == 4);
        const bool is_kb = (pn == 5) || (pn == 6);
        const float sc = is_q ? C2 : 1.0f;
        f32x4 bv[2][2];
#pragma unroll
        for (int bj = 0; bj < 2; ++bj)
#pragma unroll
            for (int n = 0; n < 2; ++n) bv[bj][n] = *(const f32x4*)(b_in + colb + 32 * bj + 4 * n);
        f32x4 ks[2][2];
#pragma unroll
        for (int bj = 0; bj < 2; ++bj)
#pragma unroll
            for (int n = 0; n < 2; ++n) ks[bj][n] = (f32x4){0.f, 0.f, 0.f, 0.f};
#pragma unroll
        for (int ai = 0; ai < 2; ++ai)
#pragma unroll
            for (int m = 0; m < 4; ++m) {
                const int row = u.pm * 256 + ai * 128 + wr * 64 + m * 16 + fr;
                const int pos = row & (SEQ - 1);
                f32x4 o1[2], o2[2];
#pragma unroll
                for (int n = 0; n < 2; ++n) { o1[n] = acc[ai][0][m][n] * descale + bv[0][n]; o2[n] = acc[ai][1][m][n] * descale + bv[1][n]; }
                if (do_rope) {
                    const float* rp = rope + pos * 64 + 8 * fq;
#pragma unroll
                    for (int n = 0; n < 2; ++n) { const f32x4 c = *(const f32x4*)(rp + 4 * n), s = *(const f32x4*)(rp + 32 + 4 * n);
                        const f32x4 a = o1[n], b = o2[n]; o1[n] = a * c - b * s; o2[n] = b * c + a * s; }
                }
                if (is_kb) {
#pragma unroll
                    for (int n = 0; n < 2; ++n) { ks[0][n] += o1[n]; ks[1][n] += o2[n]; }
                }
                bf16_t* rowp = qkv + (size_t)row * INW + colb;
                u32x4 w1, w2;
                w1.x = cvtpk(o1[0][0] * sc, o1[0][1] * sc); w1.y = cvtpk(o1[0][2] * sc, o1[0][3] * sc); w1.z = cvtpk(o1[1][0] * sc, o1[1][1] * sc); w1.w = cvtpk(o1[1][2] * sc, o1[1][3] * sc);
                w2.x = cvtpk(o2[0][0] * sc, o2[0][1] * sc); w2.y = cvtpk(o2[0][2] * sc, o2[0][3] * sc); w2.z = cvtpk(o2[1][0] * sc, o2[1][1] * sc); w2.w = cvtpk(o2[1][2] * sc, o2[1][3] * sc);
                *(u32x4*)(rowp) = w1; *(u32x4*)(rowp + 32) = w2;
            }
        if (is_kb) {
            float* kd = ksum + (size_t)u.pm * 512 + 256 * (pn - 5) + 64 * wc + 8 * fq;
#pragma unroll
            for (int bj = 0; bj < 2; ++bj)
#pragma unroll
                for (int n = 0; n < 2; ++n)
#pragma unroll
                    for (int j = 0; j < 4; ++j) {
                        float v = ks[bj][n][j];
                        v += swz_xor<1>(v); v += swz_xor<2>(v); v += swz_xor<4>(v); v += swz_xor<8>(v);
                        if (fr == 0) atomicAdd(kd + 32 * bj + 4 * n + j, v);
                    }
        }
    }
};
struct EpiOutProj {
    bf16_t* y; const float* b_out; const float* x;
    __device__ __forceinline__ void operator()(const f32x4 (&acc)[2][2][4][2], const Unit& u, int wr, int wc, int fr, int fq) const {
        const int col0 = u.pn * 256 + wc * 32 + 8 * fq;
        f32x4 bv[2][2];
#pragma unroll
        for (int bj = 0; bj < 2; ++bj)
#pragma unroll
            for (int n = 0; n < 2; ++n) bv[bj][n] = *(const f32x4*)(b_out + col0 + 128 * bj + 4 * n);
#pragma unroll
        for (int ai = 0; ai < 2; ++ai)
#pragma unroll
            for (int m = 0; m < 4; ++m) {
                const size_t off = (size_t)(u.pm * 256 + ai * 128 + wr * 64 + m * 16 + fr) * D + col0;
#pragma unroll
                for (int bj = 0; bj < 2; ++bj) {
                    const f32x4 x0 = *(const f32x4*)(x + off + 128 * bj), x1 = *(const f32x4*)(x + off + 128 * bj + 4);
                    const f32x4 v0 = acc[ai][bj][m][0] * (1.0f / (W_SCALE * AO_SCALE)) + bv[bj][0] + x0 * DN_ALPHA, v1 = acc[ai][bj][m][1] * (1.0f / (W_SCALE * AO_SCALE)) + bv[bj][1] + x1 * DN_ALPHA;
                    u32x4 w; w.x = cvtpk(v0[0], v0[1]); w.y = cvtpk(v0[2], v0[3]); w.z = cvtpk(v1[0], v1[1]); w.w = cvtpk(v1[2], v1[3]);
                    *(u32x4*)(y + off + 128 * bj) = w; }
                if (m & 1) asm volatile("" ::: "memory");
            }
    }
};
struct EpiSwiglu {
    unsigned char* act8; const float* b1;
    __device__ __forceinline__ const float* bias_src(const Unit& u) const { return b1 + (size_t)u.e * 2048 + 256 * u.pn; }
    __device__ __forceinline__ void operator()(const f32x4 (&acc)[2][2][4][2], const Unit& u, int wr, int wc, int fr, int fq, const LAS float* bias) const {
        const int a0 = 128 * u.pn + 32 * wc + 8 * fq;
        const LAS float* bp = bias + 2 * (32 * wc + 8 * fq);
        f32x4 bb[4];
#pragma unroll
        for (int q = 0; q < 4; ++q) bb[q] = *(const LAS f32x4*)(bp + 4 * q);
        f32x2 bg[2][2], bl[2][2];
#pragma unroll
        for (int n = 0; n < 2; ++n)
#pragma unroll
            for (int jp = 0; jp < 2; ++jp) { bg[n][jp] = (f32x2){bb[2 * n + jp][0], bb[2 * n + jp][2]}; bl[n][jp] = (f32x2){bb[2 * n + jp][1], bb[2 * n + jp][3]}; }
        unsigned char* tile = act8 + (size_t)u.pm * (256 * 1024);
#pragma unroll
        for (int ai = 0; ai < 2; ++ai)
#pragma unroll
            for (int m = 0; m < 4; ++m) {
                const int row = ai * 128 + wr * 64 + m * 16 + fr;
                f32x2 r[2][2];
#pragma unroll
                for (int n = 0; n < 2; ++n)
#pragma unroll
                    for (int jp = 0; jp < 2; ++jp) {
                        const f32x2 ag = {acc[ai][0][m][n][2 * jp], acc[ai][0][m][n][2 * jp + 1]}, al = {acc[ai][1][m][n][2 * jp], acc[ai][1][m][n][2 * jp + 1]};
                        f32x2 g = ag * (1.0f / W_SCALE) + bg[n][jp], l = al * (1.0f / W_SCALE) + bl[n][jp];
                        g.x = fminf(g.x, 7.0f); g.y = fminf(g.y, 7.0f);
                        l.x = __builtin_amdgcn_fmed3f(l.x, -7.0f, 7.0f); l.y = __builtin_amdgcn_fmed3f(l.y, -7.0f, 7.0f);
                        const f32x2 uarg = g * (-1.702f * LOG2E);
                        f32x2 t; t.x = __builtin_amdgcn_exp2f(uarg.x); t.y = __builtin_amdgcn_exp2f(uarg.y);
                        const f32x2 d = t + 1.0f;
                        f32x2 sg; sg.x = __builtin_amdgcn_rcpf(d.x); sg.y = __builtin_amdgcn_rcpf(d.y);
                        const f32x2 lf = l * ACT_SCALE + ACT_SCALE;
                        r[n][jp] = (g * sg) * lf;
                    }
                u32x2 w; w.x = pk4_fp8(r[0][0].x, r[0][0].y, r[0][1].x, r[0][1].y); w.y = pk4_fp8(r[1][0].x, r[1][0].y, r[1][1].x, r[1][1].y);
                *(u32x2*)(tile + (size_t)row * 1024 + (size_t)a0) = w;
            }
    }
};
struct EpiDown {
    unsigned char* yb; const float* b2;
    __device__ __forceinline__ const float* bias_src(const Unit& u) const { return b2 + (size_t)u.e * 1024 + 256 * u.pn; }
    __device__ __forceinline__ void operator()(const f32x4 (&acc)[2][2][4][2], const Unit& u, int wr, int wc, int fr, int fq, const LAS float* bias) const {
        const int col0 = u.pn * 256 + wc * 32 + 8 * fq;
        const LAS float* bp = bias + wc * 32 + 8 * fq;
#pragma unroll
        for (int bj = 0; bj < 2; ++bj) {
            const f32x4 bv0 = *(const LAS f32x4*)(bp + 128 * bj) * Y_SCALE, bv1 = *(const LAS f32x4*)(bp + 128 * bj + 4) * Y_SCALE;
#pragma unroll
            for (int ai = 0; ai < 2; ++ai)
#pragma unroll
                for (int m = 0; m < 4; ++m) {
                    unsigned char* rowp = yb + (size_t)(u.pm * 256 + ai * 128 + wr * 64 + m * 16 + fr) * 1024 + col0;
                    const f32x4 v0 = acc[ai][bj][m][0] * (Y_SCALE / (W_SCALE * ACT_SCALE)) + bv0, v1 = acc[ai][bj][m][1] * (Y_SCALE / (W_SCALE * ACT_SCALE)) + bv1;
                    u32x2 w; w.x = pk4_fp8(v0[0], v0[1], v0[2], v0[3]); w.y = pk4_fp8(v1[0], v1[1], v1[2], v1[3]);
                    *(u32x2*)(rowp + 128 * bj) = w;
                }
        }
    }
};
}

namespace att {
constexpr int PITCH = INW, SLOTB = 8192;
constexpr int NSLOT = 4;
constexpr int L_K = 0, L_V = NSLOT * SLOTB, L_WS = 2 * NSLOT * SLOTB, L_KS = L_WS + 2048, L_OST = L_KS + 2048, L_END = L_OST + 8 * 4096;
static_assert(NSLOT == 4 && L_END <= 131072, "attention LDS map");
constexpr float NEG = -1.0e30f, M0 = -1.0e20f, THR = 8.0f;
typedef LAS const char* lds_cptr;
__device__ __forceinline__ int crow(int r, int hi) { return (r & 3) + 8 * (r >> 2) + 4 * hi; }
__device__ __forceinline__ void glds16(const void* gsrc, unsigned lds_dst) { unsigned keep;
    asm volatile("s_mov_b32 %0, m0\n\ts_mov_b32 m0, %2\n\ts_nop 0\n\tglobal_load_lds_dwordx4 %1, off\n\ts_mov_b32 m0, %0" : "=&s"(keep) : "v"(gsrc), "s"(lds_dst) : "memory"); }
__device__ __forceinline__ void glds16s(unsigned voff, const void* sbase, unsigned lds_dst) { unsigned keep;
    asm volatile("s_mov_b32 %0, m0\n\ts_mov_b32 m0, %3\n\ts_nop 0\n\tglobal_load_lds_dwordx4 %1, %2\n\ts_mov_b32 m0, %0" : "=&s"(keep) : "v"(voff), "s"(sbase), "s"(lds_dst) : "memory"); }
#define ATT_WAIT_BAR0() asm volatile("s_waitcnt vmcnt(0) lgkmcnt(0)\n\ts_barrier" ::: "memory")
#define ATT_WAIT_BARN(N) asm volatile("s_waitcnt vmcnt(" #N ") lgkmcnt(0)\n\ts_barrier" ::: "memory")
#define ATT_SBAR() __builtin_amdgcn_sched_barrier(0)

__device__ __forceinline__ void qkt(f32x16& p0, f32x16& p1, lds_cptr kb, const bf16x8* qr, const f32x16& negm) {
#pragma unroll
    for (int d0 = 0; d0 < 4; ++d0) {
        const bf16x8 b0 = *(const LAS bf16x8*)(kb + d0 * 2048);
        const bf16x8 b1 = *(const LAS bf16x8*)(kb + d0 * 2048 + 512);
        if (d0 == 0) { p0 = __builtin_amdgcn_mfma_f32_32x32x16_bf16(b0, qr[0], negm, 0, 0, 0); p1 = __builtin_amdgcn_mfma_f32_32x32x16_bf16(b1, qr[0], negm, 0, 0, 0); }
        else { p0 = __builtin_amdgcn_mfma_f32_32x32x16_bf16(b0, qr[d0], p0, 0, 0, 0); p1 = __builtin_amdgcn_mfma_f32_32x32x16_bf16(b1, qr[d0], p1, 0, 0, 0); }
    }
}
__device__ __forceinline__ float rowmax32(const f32x16& p0, const f32x16& p1) {
    float a = fmaxf(p0[0], p1[0]);
#pragma unroll
    for (int r = 1; r < 16; ++r) a = fmaxf(a, fmaxf(p0[r], p1[r]));
    auto rr = __builtin_amdgcn_permlane32_swap(__float_as_uint(a), __float_as_uint(a), false, false);
    return fmaxf(__uint_as_float(rr[0]), __uint_as_float(rr[1]));
}
__device__ __forceinline__ void pv(f32x16* o, int vb, bf16x8 pa0, bf16x8 pa1, bf16x8 pa2, bf16x8 pa3) {
#pragma unroll
    for (int d0 = 0; d0 < 2; ++d0) { s16x4 lo[4], hi[4];
#pragma unroll
        for (int ks = 0; ks < 4; ++ks) {
            asm volatile("ds_read_b64_tr_b16 %0,%1 offset:%c2" : "=&v"(lo[ks]) : "v"(vb), "i"(d0 * 4096 + ks * 1024) : "memory");
            asm volatile("ds_read_b64_tr_b16 %0,%1 offset:%c2" : "=&v"(hi[ks]) : "v"(vb), "i"(d0 * 4096 + ks * 1024 + 512) : "memory"); }
        asm volatile("s_waitcnt lgkmcnt(0)" ::: "memory"); ATT_SBAR();
#define ATT_PK(k) (bf16x8){lo[k][0], lo[k][1], lo[k][2], lo[k][3], hi[k][0], hi[k][1], hi[k][2], hi[k][3]}
        o[d0] = __builtin_amdgcn_mfma_f32_32x32x16_bf16(pa0, ATT_PK(0), o[d0], 0, 0, 0);
        o[d0] = __builtin_amdgcn_mfma_f32_32x32x16_bf16(pa1, ATT_PK(1), o[d0], 0, 0, 0);
        o[d0] = __builtin_amdgcn_mfma_f32_32x32x16_bf16(pa2, ATT_PK(2), o[d0], 0, 0, 0);
        o[d0] = __builtin_amdgcn_mfma_f32_32x32x16_bf16(pa3, ATT_PK(3), o[d0], 0, 0, 0);
#undef ATT_PK
    }
}

__device__ __forceinline__ void swa_stream(LAS char* shm, const bf16_t* __restrict__ qkv, unsigned char* __restrict__ aout, int b, int hh, int qb0, int nqb, const float* __restrict__ sinks, const int wave_s) {
    int tid = tid_of(wave_s); asm volatile("" : "+v"(tid));
    const int lane = tid & 63, r32 = lane & 31, hi = lane >> 5; const int wid = wave_s;
    const long rowbase = (long)b * SEQ;
    const int g = wid >> 1, qcol = (4 * hh + g) * 64, kcol = 512 + 64 * hh, vcol = 640 + 64 * hh;
    const bf16_t* Kh = qkv + rowbase * PITCH + kcol; const bf16_t* Vh = qkv + rowbase * PITCH + vcol;
    const unsigned lds0 = (unsigned)(uintptr_t)shm;
    LAS float* wsf = (LAS float*)(shm + L_WS) + wid * 64;
    const unsigned koff = (unsigned)(lane * PITCH + wid * 8) * 2u;
    const unsigned voff = (unsigned)((16 * (wid & 3) + (lane >> 2)) * PITCH + (wid >> 2) * 32 + (lane & 3) * 8) * 2u;
    const unsigned kdst = lds0 + L_K + wid * 1024, vdst = lds0 + L_V + wid * 1024;
#define SW_DMA(t) do { const unsigned sl_ = (unsigned)(((t) & (NSLOT - 1)) * SLOTB); \
        glds16s(koff, Kh + (long)(t) * 64 * PITCH, (unsigned)__builtin_amdgcn_readfirstlane(kdst + sl_)); glds16s(voff, Vh + (long)(t) * 64 * PITCH, (unsigned)__builtin_amdgcn_readfirstlane(vdst + sl_)); } while (0)
    const int vb0 = (int)(lds0 + L_V) + ((lane >> 4) & 1) * 32 + (lane & 3) * 8 + (4 * hi + ((lane & 15) >> 2)) * 64;
    const lds_cptr kp0 = (lds_cptr)shm + L_K + hi * 1024 + r32 * 16;
    const float sink2 = sinks[4 * hh + g] * LOG2E;
    const int qend = qb0 + nqb;
    for (int kt = (qb0 - 2 < 0 ? 0 : qb0 - 2); kt <= qb0; ++kt) SW_DMA(kt);
    const bf16_t* Qb = qkv + (rowbase + 32 * (wid & 1) + r32) * PITCH + qcol + hi * 8;
    bf16x8 qn[4];
#pragma unroll
    for (int d0 = 0; d0 < 4; ++d0) qn[d0] = *reinterpret_cast<const bf16x8*>(Qb + (long)qb0 * 64 * PITCH + d0 * 16);
    ATT_WAIT_BAR0();
    for (int qb = qb0; qb < qend; ++qb) {
        const int qa = 64 * qb + 32 * (wid & 1);
        if (qb + 1 < qend) SW_DMA(qb + 1);
        bf16x8 qr[4];
#pragma unroll
        for (int d0 = 0; d0 < 4; ++d0) qr[d0] = qn[d0];
        if (qb + 1 < qend) {
#pragma unroll
            for (int d0 = 0; d0 < 4; ++d0) qn[d0] = *reinterpret_cast<const bf16x8*>(Qb + (long)(qb + 1) * 64 * PITCH + d0 * 16);
        }
        float m_run = sink2, l_run = (hi == 0) ? 1.0f : 0.0f;
        f32x16 negm, o[2];
        { float zf = 0.f; asm volatile("" : "+v"(zf));
#pragma unroll
          for (int r = 0; r < 16; ++r) { o[0][r] = zf; o[1][r] = zf; negm[r] = -m_run; } }
        for (int kt = (qb - 2 < 0 ? 0 : qb - 2); kt <= qb; ++kt) {
            const int cur = (kt & (NSLOT - 1)) * SLOTB;
            f32x16 p0, p1; qkt(p0, p1, kp0 + cur, qr, negm);
            const bool edge = !((64 * kt + 63 <= qa) && (qa + 31 - 64 * kt <= 127));
            if (edge) {
                const int dq = qa + r32 - 64 * kt - 4 * hi;
#pragma unroll
                for (int r = 0; r < 16; ++r) { const int d0_ = dq - ((r & 3) + 8 * (r >> 2)), d1_ = d0_ - 32;
                    p0[r] = ((unsigned)d0_ < 128u) ? p0[r] : NEG; p1[r] = ((unsigned)d1_ < 128u) ? p1[r] : NEG; }
            }
            const float rm = rowmax32(p0, p1);
            if (__any(rm > THR)) {
                const float dl = fmaxf(rm, 0.f);
                const float f = __builtin_amdgcn_exp2f(-dl);
                m_run += dl;
#pragma unroll
                for (int r = 0; r < 16; ++r) { p0[r] -= dl; p1[r] -= dl; negm[r] = -m_run; }
                l_run *= f;
                if (hi == 0) wsf[r32] = f;
                LDS_WAIT();
#pragma unroll
                for (int r = 0; r < 16; ++r) { const float fr_ = wsf[crow(r, hi)]; o[0][r] *= fr_; o[1][r] *= fr_; }
            }
            float sacc = 0.f;
#pragma unroll
            for (int r = 0; r < 16; ++r) { p0[r] = __builtin_amdgcn_exp2f(p0[r]); p1[r] = __builtin_amdgcn_exp2f(p1[r]); sacc += p0[r] + p1[r]; }
            l_run += sacc;
            u32x4 pw0, pw1, pw2, pw3;
            pw0 = (u32x4){cvtpk(p0[0], p0[1]), cvtpk(p0[2], p0[3]), cvtpk(p0[4], p0[5]), cvtpk(p0[6], p0[7])};
            pw1 = (u32x4){cvtpk(p0[8], p0[9]), cvtpk(p0[10], p0[11]), cvtpk(p0[12], p0[13]), cvtpk(p0[14], p0[15])};
            pw2 = (u32x4){cvtpk(p1[0], p1[1]), cvtpk(p1[2], p1[3]), cvtpk(p1[4], p1[5]), cvtpk(p1[6], p1[7])};
            pw3 = (u32x4){cvtpk(p1[8], p1[9]), cvtpk(p1[10], p1[11]), cvtpk(p1[12], p1[13]), cvtpk(p1[14], p1[15])};
            ATT_SBAR();
            pv(o, vb0 + cur, __builtin_bit_cast(bf16x8, pw0), __builtin_bit_cast(bf16x8, pw1), __builtin_bit_cast(bf16x8, pw2), __builtin_bit_cast(bf16x8, pw3));
        }
        { auto rr = __builtin_amdgcn_permlane32_swap(__float_as_uint(l_run), __float_as_uint(l_run), false, false); l_run = __uint_as_float(rr[0]) + __uint_as_float(rr[1]); }
        if (hi == 0) wsf[32 + r32] = l_run;
        LDS_WAIT();
        float rli[16];
#pragma unroll
        for (int r = 0; r < 16; ++r) rli[r] = __builtin_amdgcn_rcpf(wsf[32 + crow(r, hi)]);
        unsigned char* Ow = aout + (rowbase + qa) * D + qcol;
        { LAS unsigned char* stg = (LAS unsigned char*)(shm + L_OST) + wid * 2048;
#pragma unroll
            for (int r = 0; r < 16; ++r) { const int orow = crow(r, hi);
#pragma unroll
                for (int d0 = 0; d0 < 2; ++d0) { const float v = o[d0][r] * rli[r] * AO_SCALE; stg[orow * 64 + d0 * 32 + r32] = (unsigned char)__builtin_amdgcn_cvt_pk_fp8_f32(v, v, 0, false); } }
            LDS_WAIT();
#pragma unroll
            for (int i = 0; i < 2; ++i) { const int row = i * 16 + (lane >> 2), ch = lane & 3; const u32x4 v = *(const LAS u32x4*)(stg + row * 64 + ch * 16); *(u32x4*)(Ow + (long)row * D + ch * 16) = v; } }
        ATT_WAIT_BAR0();
    }
#undef SW_DMA
}

constexpr int MK_K = 0, MK_V = 3 * SLOTB, MK_WS = 6 * SLOTB, MK_OST = MK_WS + 8 * 256, MK_KS = MK_OST + 8 * 4096, MK_END = MK_KS + 2048;
constexpr float NEGB = -1.0e30f;
__device__ __forceinline__ float max3f(float a, float b, float c) { float r; asm("v_max3_f32 %0, %1, %2, %3" : "=v"(r) : "v"(a), "v"(b), "v"(c)); return r; }
__device__ __forceinline__ float max2f(float a, float b) { float r; asm("v_max_f32_e32 %0, %1, %2" : "=v"(r) : "v"(a), "v"(b)); return r; }
__device__ __forceinline__ float fadd_s(float a, float b) { float r; asm("v_add_f32_e32 %0, %1, %2" : "=v"(r) : "v"(a), "v"(b)); return r; }
__device__ __forceinline__ float fsub_s(float a, float b) { float r; asm("v_sub_f32_e32 %0, %1, %2" : "=v"(r) : "v"(a), "v"(b)); return r; }
typedef short v4i16_t __attribute__((ext_vector_type(4)));
#define MK_WAIT_BAR(N) asm volatile("s_waitcnt vmcnt(" #N ") lgkmcnt(0)\n\ts_barrier" ::: "memory")
__device__ __forceinline__ void kload8(bf16x8* kf, lds_cptr kp) {
    kf[0] = *(const LAS bf16x8*)(kp);        kf[1] = *(const LAS bf16x8*)(kp + 512);
    kf[2] = *(const LAS bf16x8*)(kp + 2048); kf[3] = *(const LAS bf16x8*)(kp + 2560);
    kf[4] = *(const LAS bf16x8*)(kp + 4096); kf[5] = *(const LAS bf16x8*)(kp + 4608);
    kf[6] = *(const LAS bf16x8*)(kp + 6144); kf[7] = *(const LAS bf16x8*)(kp + 6656);
}
__device__ __forceinline__ void kload2(bf16x8* kf, lds_cptr kp, int j) { kf[2 * j] = *(const LAS bf16x8*)(kp + j * 2048); kf[2 * j + 1] = *(const LAS bf16x8*)(kp + j * 2048 + 512); }
__device__ __forceinline__ s16x4 vtr(lds_cptr p) { return __builtin_bit_cast(s16x4, __builtin_amdgcn_ds_read_tr16_b64_v4i16((LAS v4i16_t*)p)); }
__device__ __forceinline__ float rowmax_a(const f32x16& p0, const f32x16& p1) {
    float a = max3f(p0[0], p0[1], p1[0]), b = max3f(p0[2], p0[3], p1[1]); a = max3f(a, p1[2], p1[3]);
#pragma unroll
    for (int r = 4; r < 16; r += 4) { a = max3f(a, p0[r], p0[r + 1]); b = max3f(b, p0[r + 2], p0[r + 3]); a = max3f(a, p1[r], p1[r + 1]); b = max3f(b, p1[r + 2], p1[r + 3]); }
    const float m = max2f(a, b);
    auto rr = __builtin_amdgcn_permlane32_swap(__float_as_uint(m), __float_as_uint(m), false, false);
    return max2f(__uint_as_float(rr[0]), __uint_as_float(rr[1]));
}
__device__ __forceinline__ void cmask(f32x16& p0, f32x16& p1, int jb, int qrel, int hi) {
    const float NEGI = -INFINITY; const int kb = 64 * jb + 4 * hi;
#pragma unroll
    for (int r = 0; r < 16; ++r) { const int kv = kb + (r & 3) + 8 * (r >> 2); if (kv > qrel) p0[r] = NEGI; if (kv + 32 > qrel) p1[r] = NEGI; }
}

template <int THRL>
__device__ __forceinline__ void moba_unit(int b, int h, int qb, const bf16_t* __restrict__ qkv, unsigned char* __restrict__ aout, const float* __restrict__ ksum, LAS char* shm, const int wave_s) {
    int tid = tid_of(wave_s); asm volatile("" : "+v"(tid));
    const int lane = tid & 63, r32 = lane & 31, hi = lane >> 5; const int wid = __builtin_amdgcn_readfirstlane(tid >> 6);
    const long rowbase = (long)b * SEQ; const int q0 = qb * 256;
    const bf16_t* Qw = qkv + (rowbase + q0 + wid * 32) * PITCH + 768 + 64 * h;
    const bf16_t* Kh = qkv + rowbase * PITCH + 1280 + 64 * h; const bf16_t* Vh = qkv + rowbase * PITCH + 1792 + 64 * h;
    const unsigned lds0 = (unsigned)(uintptr_t)shm;
    LAS float* wsf = (LAS float*)(shm + MK_WS) + wid * 64;
    const unsigned koff = (unsigned)(lane * PITCH + wid * 8) * 2u;
    const unsigned voff = (unsigned)((16 * (wid & 3) + (lane >> 2)) * PITCH + (wid >> 2) * 32 + (lane & 3) * 8) * 2u;
    const unsigned kdst = lds0 + MK_K + wid * 1024, vdst = lds0 + MK_V + wid * 1024;
#define DMA_K(t, slot) glds16s(koff, Kh + (long)(t) * 64 * PITCH, (unsigned)__builtin_amdgcn_readfirstlane(kdst + (slot)))
#define DMA_V(t, slot) glds16s(voff, Vh + (long)(t) * 64 * PITCH, (unsigned)__builtin_amdgcn_readfirstlane(vdst + (slot)))
    bf16x8 kf[8];
    const lds_cptr shm3 = (lds_cptr)shm; const lds_cptr kp0 = shm3 + MK_K + hi * 1024 + r32 * 16; const lds_cptr vp0 = shm3 + MK_V + ((lane >> 4) & 1) * 32 + (lane & 3) * 8 + (4 * hi + ((lane & 15) >> 2)) * 64;
    const int NT = (q0 + 256) / 64;
    DMA_K(0, 0); DMA_V(0, 0); DMA_K(1, SLOTB);
    { LAS float* ksl = (LAS float*)(shm + MK_KS); ksl[tid] = ksum[((size_t)b * 8 + (tid >> 6)) * 512 + 64 * h + (tid & 63)]; }
    bf16x8 qr[4];
#pragma unroll
    for (int d0 = 0; d0 < 4; ++d0) qr[d0] = *reinterpret_cast<const bf16x8*>(&Qw[(long)r32 * PITCH + d0 * 16 + hi * 8]);
    float mhat = 0.f, l_reg = 0.f; f32x16 o[2], negm;
    { float zf = 0.f; asm volatile("" : "+v"(zf));
#pragma unroll
      for (int r = 0; r < 16; ++r) { o[0][r] = zf; o[1][r] = zf; negm[r] = zf; } }
    asm volatile("" : "+v"(negm));
    const int qrel = wid * 32 + r32;
#define CMASK(P0, P1, t) do { int jb_ = (t) - (NT - 4); if (jb_ >= 0) cmask(P0, P1, jb_, qrel, hi); } while (0)
    bool resc = false;
#define START(P0, P1) do { const float rm = rowmax_a(P0, P1); resc = false; \
    { const float dl = (rm > 0.1f * NEGB) ? rm : 0.f;      mhat = fadd_s(mhat, dl); \
      _Pragma("unroll") for (int r = 0; r < 16; ++r) { P0[r] = fsub_s(P0[r], dl); P1[r] = fsub_s(P1[r], dl); } \
      const float nm_ = ONB(1) ? -mhat : NEGB; \
      _Pragma("unroll") for (int r = 0; r < 16; ++r) negm[r] = nm_; asm volatile("" : "+v"(negm)); } \
    _Pragma("unroll") for (int r = 0; r < 16; ++r) P0[r] = __builtin_amdgcn_exp2f(P0[r]); } while (0)
#define RESC() do { if (resc) { asm volatile("s_waitcnt lgkmcnt(0)" ::: "memory"); \
      _Pragma("unroll") for (int d_ = 0; d_ < 2; ++d_) _Pragma("unroll") for (int r = 0; r < 16; ++r) o[d_][r] *= wsf[crow(r, hi)]; } } while (0)
    f32x16 pA0, pA1, pB0, pB1;
    int sl_prev = 0, sl_cur = 0, sl_next = SLOTB;
#define ROT() do { sl_prev = sl_cur; sl_cur = sl_next; sl_next = (sl_next == 2 * SLOTB) ? 0 : sl_next + SLOTB; } while (0)
    DMA_K(2, 2 * SLOTB);
    MK_WAIT_BAR(3);
    unsigned sel = 0u;
    if (qb <= 3) sel = (1u << qb) - 1u;
    else {
        const LAS float* ksl = (const LAS float*)(shm + MK_KS);
        float gv[7];
#pragma unroll
        for (int i = 0; i < 7; ++i) {
            float s = 0.f;
#pragma unroll
            for (int d0 = 0; d0 < 4; ++d0) {
                const f32x4 k0 = *(const LAS f32x4*)(ksl + i * 64 + 16 * d0 + 8 * hi), k1 = *(const LAS f32x4*)(ksl + i * 64 + 16 * d0 + 8 * hi + 4);
#pragma unroll
                for (int jj = 0; jj < 4; ++jj) { s += bf2f((unsigned short)qr[d0][jj]) * k0[jj]; s += bf2f((unsigned short)qr[d0][4 + jj]) * k1[jj]; }
            }
            auto rr = __builtin_amdgcn_permlane32_swap(__float_as_uint(s), __float_as_uint(s), false, false);
            s = __uint_as_float(rr[0]) + __uint_as_float(rr[1]);
            gv[i] = (i < qb) ? s : -INFINITY;
        }
#pragma unroll
        for (int rk = 0; rk < 3; ++rk) { float best = -INFINITY; int bi = 0;
#pragma unroll
            for (int i = 0; i < 7; ++i) { const bool c = (((sel >> i) & 1u) == 0u) && (gv[i] > best); best = c ? gv[i] : best; bi = c ? i : bi; }
            sel |= 1u << bi; }
    }
#define ONB(tt) (((tt) >= NT - 4) ? true : (((sel >> ((tt) >> 2)) & 1u) != 0u))
#define SETNEGM(tt) do { const float nm_ = ONB(tt) ? -mhat : NEGB; _Pragma("unroll") for (int r = 0; r < 16; ++r) negm[r] = nm_; asm volatile("" : "+v"(negm)); } while (0)
    SETNEGM(0);
    qkt(pA0, pA1, kp0, qr, negm); asm volatile("s_nop 15\n\ts_nop 7" : "+v"(pA0), "+v"(pA1)); CMASK(pA0, pA1, 0);
    START(pA0, pA1);
    _Pragma("unroll") for (int r = 0; r < 16; ++r) pA1[r] = __builtin_amdgcn_exp2f(pA1[r]);
    MK_WAIT_BAR(0);
    DMA_K(3, 0); DMA_V(1, SLOTB);
    ROT();
    kload8(kf, kp0 + sl_cur);
    MK_WAIT_BAR(2);
    s16x4 vlo[8], vhi[8]; u32x4 pw0, pw1, pw2, pw3;
#define PKW(P, B) cvtpk(P[B], P[B + 1])
#define PAF(k) __builtin_bit_cast(bf16x8, pw##k)
#define VFR(i) (bf16x8){vlo[i][0], vlo[i][1], vlo[i][2], vlo[i][3], vhi[i][0], vhi[i][1], vhi[i][2], vhi[i][3]}
#define PIN(x) asm volatile("" : "+v"(x))
#define MX3(a, b, c) __builtin_fmaxf(__builtin_fmaxf((a), (b)), (c))
#define GAPA(MF, A0, A1, A2, A3, W0, W1, PW) do { MF; sacc += A0; sacc += A1; sacc += A2; sacc += A3; PIN(sacc); W0; W1; PIN(PW); ATT_SBAR(); } while (0)
#define EX(v) __builtin_amdgcn_exp2f(v)
#define GAPB(MF, X, B) do { MF; X[B] = EX(X[B]); X[B + 1] = EX(X[B + 1]); X[B + 2] = EX(X[B + 2]); X[B + 3] = EX(X[B + 3]); PIN(X); ATT_SBAR(); } while (0)
#define VRD(i) do { vlo[i] = vtr(vp_ + (((i) >> 2) * 4096 + ((i) & 3) * 1024)); vhi[i] = vtr(vp_ + (((i) >> 2) * 4096 + ((i) & 3) * 1024 + 512)); } while (0)
#define KRD(G, j) do { if (G) { kload2(kf, kp0 + sl_next, j); ATT_SBAR(); } } while (0)
#define MF32(a, b, c) __builtin_amdgcn_mfma_f32_32x32x16_bf16(a, b, c, 0, 0, 0)
#define STEP(C0, C1, P0, P1, t, GK, GV, GL) do { ATT_SBAR(); \
    const lds_cptr vp_ = vp0 + sl_prev; \
    VRD(0); ATT_SBAR(); float sacc = (P0[0] + P0[1]); \
    GAPA(C0 = MF32(kf[0], qr[0], negm), P0[2], P0[3], P0[4], P0[5],     pw0[0] = PKW(P0, 0), pw0[1] = PKW(P0, 2), pw0); \
    VRD(4); ATT_SBAR(); GAPA(C1 = MF32(kf[1], qr[0], negm), P0[6], P0[7], P0[8], P0[9],     pw0[2] = PKW(P0, 4), pw0[3] = PKW(P0, 6), pw0); \
    VRD(1); ATT_SBAR(); GAPA(C0 = MF32(kf[2], qr[1], C0),   P0[10], P0[11], P0[12], P0[13], pw1[0] = PKW(P0, 8), pw1[1] = PKW(P0, 10), pw1); \
    VRD(5); ATT_SBAR(); GAPA(C1 = MF32(kf[3], qr[1], C1),   P0[14], P0[15], P1[0], P1[1],   pw1[2] = PKW(P0, 12), pw1[3] = PKW(P0, 14), pw1); \
    VRD(2); ATT_SBAR(); GAPA(C0 = MF32(kf[4], qr[2], C0),   P1[2], P1[3], P1[4], P1[5],     pw2[0] = PKW(P1, 0), pw2[1] = PKW(P1, 2), pw2); \
    VRD(6); ATT_SBAR(); GAPA(C1 = MF32(kf[5], qr[2], C1),   P1[6], P1[7], P1[8], P1[9],     pw2[2] = PKW(P1, 4), pw2[3] = PKW(P1, 6), pw2); \
    VRD(3); ATT_SBAR(); GAPA(C0 = MF32(kf[6], qr[3], C0),   P1[10], P1[11], P1[12], P1[13], pw3[0] = PKW(P1, 8), pw3[1] = PKW(P1, 10), pw3); \
    VRD(7); ATT_SBAR(); GAPA(C1 = MF32(kf[7], qr[3], C1),   P1[14], P1[15], 0.f, 0.f,       pw3[2] = PKW(P1, 12), pw3[3] = PKW(P1, 14), pw3); \
    l_reg += sacc; \
    if (GK) { DMA_K((t) + 3, sl_cur); } if (GV) { DMA_V((t) + 1, sl_next); } \
    CMASK(C0, C1, t); \
    { float a = MX3(C0[0], C0[1], C1[0]), b_ = MX3(C0[2], C0[3], C1[1]); a = MX3(a, C1[2], C1[3]); \
      _Pragma("unroll") for (int r = 4; r < 16; r += 4) { a = MX3(a, C0[r], C0[r + 1]); b_ = MX3(b_, C0[r + 2], C0[r + 3]); a = MX3(a, C1[r], C1[r + 1]); b_ = MX3(b_, C1[r + 2], C1[r + 3]); } \
      float rm = __builtin_fmaxf(a, b_); { auto rr = __builtin_amdgcn_permlane32_swap(__float_as_uint(rm), __float_as_uint(rm), false, false); rm = __builtin_fmaxf(__uint_as_float(rr[0]), __uint_as_float(rr[1])); } \
      resc = false; \
      const bool blk_ = (((t) + 1) & 3) == 0;                    \
      if (__builtin_expect(__any(rm > (float)THRL), 0)) { const float dl = __builtin_fmaxf(rm, 0.f); mhat += dl; \
        _Pragma("unroll") for (int r = 0; r < 16; ++r) { C0[r] -= dl; C1[r] -= dl; } \
        const float nm_ = ONB((t) + 1) ? -mhat : NEGB; \
        _Pragma("unroll") for (int r = 0; r < 16; ++r) negm[r] = nm_; asm volatile("" : "+v"(negm)); \
        const float f = __builtin_amdgcn_exp2f(-dl); l_reg *= f; if (hi == 0) wsf[r32] = f; resc = true; } \
      else if (blk_) { SETNEGM((t) + 1); } } \
    ATT_SBAR(); \
    GAPB(o[0] = MF32(PAF(0), VFR(0), o[0]), C0, 0); \
    GAPB(o[1] = MF32(PAF(0), VFR(4), o[1]), C0, 4); \
    KRD(GL, 0); GAPB(o[0] = MF32(PAF(1), VFR(1), o[0]), C0, 8); \
    KRD(GL, 1); GAPB(o[1] = MF32(PAF(1), VFR(5), o[1]), C0, 12); \
    KRD(GL, 2); GAPB(o[0] = MF32(PAF(2), VFR(2), o[0]), C1, 0); \
    KRD(GL, 3); GAPB(o[1] = MF32(PAF(2), VFR(6), o[1]), C1, 4); \
    GAPB(o[0] = MF32(PAF(3), VFR(3), o[0]), C1, 8); \
    GAPB(o[1] = MF32(PAF(3), VFR(7), o[1]), C1, 12); \
    } while (0)
    int t = 1;
#undef CMASK
#define CMASK(P0, P1, t) do { } while (0)
    for (; t + 5 < NT; t += 2) {
        STEP(pB0, pB1, pA0, pA1, t, true, true, true);       MK_WAIT_BAR(2); RESC(); ROT();
        STEP(pA0, pA1, pB0, pB1, t + 1, true, true, true);   MK_WAIT_BAR(2); RESC(); ROT();
    }
#undef CMASK
#define CMASK(P0, P1, t) do { int jb_ = (t) - (NT - 4); if (jb_ >= 0) cmask(P0, P1, jb_, qrel, hi); } while (0)
#define ENDW(tt) do { if ((tt) + 3 < NT) { MK_WAIT_BAR(2); } else if ((tt) + 2 < NT) { MK_WAIT_BAR(1); } else { MK_WAIT_BAR(0); } } while (0)
    for (; t + 1 < NT; t += 2) {
        STEP(pB0, pB1, pA0, pA1, t, (t + 3 < NT), (t + 1 < NT), (t + 1 < NT));           ENDW(t);     RESC(); ROT();
        STEP(pA0, pA1, pB0, pB1, t + 1, (t + 4 < NT), (t + 2 < NT), (t + 2 < NT));       ENDW(t + 1); RESC(); ROT();
    }
    STEP(pB0, pB1, pA0, pA1, NT - 1, false, false, false); RESC();
    { float sacc = pB0[0] + pB0[1]; _Pragma("unroll") for (int r = 2; r < 16; ++r) sacc += pB0[r]; _Pragma("unroll") for (int r = 0; r < 16; ++r) sacc += pB1[r]; l_reg += sacc;
      pw0 = (u32x4){PKW(pB0, 0), PKW(pB0, 2), PKW(pB0, 4), PKW(pB0, 6)}; pw1 = (u32x4){PKW(pB0, 8), PKW(pB0, 10), PKW(pB0, 12), PKW(pB0, 14)}; pw2 = (u32x4){PKW(pB1, 0), PKW(pB1, 2), PKW(pB1, 4), PKW(pB1, 6)}; pw3 = (u32x4){PKW(pB1, 8), PKW(pB1, 10), PKW(pB1, 12), PKW(pB1, 14)};
      ATT_SBAR(); const int vb0 = (int)(lds0 + MK_V) + ((lane >> 4) & 1) * 32 + (lane & 3) * 8 + (4 * hi + ((lane & 15) >> 2)) * 64; pv(o, vb0 + sl_cur, PAF(0), PAF(1), PAF(2), PAF(3)); }
#undef PKW
#undef PAF
#undef VFR
#undef PIN
#undef MX3
#undef GAPA
#undef GAPB
#undef EX
#undef VRD
#undef KRD
#undef MF32
#undef STEP
#undef ENDW
    { auto rr = __builtin_amdgcn_permlane32_swap(__float_as_uint(l_reg), __float_as_uint(l_reg), false, false); l_reg = __uint_as_float(rr[0]) + __uint_as_float(rr[1]); }
    if (hi == 0) wsf[32 + r32] = l_reg; asm volatile("s_waitcnt lgkmcnt(0)" ::: "memory");
    float rli[16];
#pragma unroll
    for (int r = 0; r < 16; ++r) rli[r] = __builtin_amdgcn_rcpf(wsf[32 + crow(r, hi)]);
    unsigned char* Ow = aout + (rowbase + q0 + wid * 32) * D + 512 + 64 * h;
    { LAS unsigned char* stg = (LAS unsigned char*)(shm + MK_OST) + wid * 2048;
#pragma unroll
      for (int r = 0; r < 16; ++r) { const int orow = crow(r, hi);
#pragma unroll
          for (int d0 = 0; d0 < 2; ++d0) { const float v = o[d0][r] * rli[r] * AO_SCALE; stg[orow * 64 + d0 * 32 + r32] = (unsigned char)__builtin_amdgcn_cvt_pk_fp8_f32(v, v, 0, false); } }
      asm volatile("s_waitcnt lgkmcnt(0)" ::: "memory");
#pragma unroll
      for (int i = 0; i < 2; ++i) { const int row = i * 16 + (lane >> 2), ch = lane & 3; const u32x4 v = *(const LAS u32x4*)(stg + row * 64 + ch * 16); *(u32x4*)(Ow + (long)row * D + ch * 16) = v; } }
    asm volatile("s_waitcnt lgkmcnt(0)\n\ts_barrier" ::: "memory");
#undef DMA_K
#undef DMA_V
#undef CMASK
#undef START
#undef RESC
#undef ROT
#undef ONB
#undef SETNEGM
}
}

__device__ __forceinline__ void sincos_d(double a, double& s, double& c) {
    const double q = __builtin_rint(a * 0.63661977236758134308);
    double r = __builtin_fma(-q, 1.57079632679489655800e+00, a);
    r = __builtin_fma(-q, 6.12323399573676603587e-17, r);
    const double r2 = r * r;
    double sp = -1.0 / 1307674368000.0;
    sp = sp * r2 + 1.0 / 6227020800.0; sp = sp * r2 - 1.0 / 39916800.0; sp = sp * r2 + 1.0 / 362880.0; sp = sp * r2 - 1.0 / 5040.0; sp = sp * r2 + 1.0 / 120.0; sp = sp * r2 - 1.0 / 6.0;
    const double sr = r + r * r2 * sp;
    double cp = 1.0 / 20922789888000.0;
    cp = cp * r2 - 1.0 / 87178291200.0; cp = cp * r2 + 1.0 / 479001600.0; cp = cp * r2 - 1.0 / 3628800.0; cp = cp * r2 + 1.0 / 40320.0; cp = cp * r2 - 1.0 / 720.0; cp = cp * r2 + 1.0 / 24.0; cp = cp * r2 - 0.5;
    const double cr = 1.0 + r2 * cp;
    const int n = ((int)q) & 3;
    s = (n == 0) ? sr : (n == 1) ? cr : (n == 2) ? -sr : -cr;
    c = (n == 0) ? cr : (n == 1) ? -sr : (n == 2) ? -cr : sr;
}
__device__ __forceinline__ int sigma_col(int p, int mode) {
    if (mode == 0) return (p & ~255) + 64 * ((p >> 5) & 3) + 32 * ((p >> 7) & 1) + pg8::perm32(p & 31);
    if (mode == 1) return (p & ~31) + pg8::perm32(p & 31);
    const int pn = p >> 8, q = p & 255; return 2 * (128 * pn + 32 * ((q >> 5) & 3) + pg8::perm32(q & 31)) + (q >> 7);
}
__device__ __forceinline__ void p0_transpose_item(const float* __restrict__ W, int N, bf16_t* __restrict__ WT, int mode, LAS float* scr, int item, int lane) {
    const int nblk = N / 32, kb = item / nblk, nb = item % nblk, k0 = 64 * kb, p0 = 32 * nb;
    const int sc = sigma_col(p0 + (lane & 31), mode);
#pragma unroll 8
    for (int i = 0; i < 32; ++i) { const int kk = 2 * i + (lane >> 5); scr[kk * 33 + (lane & 31)] = W[(size_t)(k0 + kk) * N + sc]; }
    LDS_WAIT(); asm volatile("" ::: "memory");
    const int c = lane & 7;
#pragma unroll
    for (int j = 0; j < 4; ++j) { const int n = (lane >> 3) + 8 * j; const LAS float* s = scr + (8 * c) * 33 + n;
        u32x4 o; o.x = cvtpk(s[0 * 33], s[1 * 33]); o.y = cvtpk(s[2 * 33], s[3 * 33]); o.z = cvtpk(s[4 * 33], s[5 * 33]); o.w = cvtpk(s[6 * 33], s[7 * 33]);
        *(u32x4*)(WT + (size_t)(p0 + n) * 1024 + k0 + 8 * c) = o; }
    LDS_WAIT(); asm volatile("" ::: "memory");
}

__device__ __forceinline__ void p0_transpose_item_fp8(const float* __restrict__ W, int N, unsigned char* __restrict__ WT, int mode, float scale, LAS float* scr, int item, int lane) {
    const int nblk = N / 32, kb = item / nblk, nb = item % nblk, k0 = 64 * kb, p0 = 32 * nb;
    const int sc = sigma_col(p0 + (lane & 31), mode);
#pragma unroll 8
    for (int i = 0; i < 32; ++i) { const int kk = 2 * i + (lane >> 5); scr[kk * 33 + (lane & 31)] = W[(size_t)(k0 + kk) * N + sc] * scale; }
    LDS_WAIT(); asm volatile("" ::: "memory");
    const int c = lane & 7;
#pragma unroll
    for (int j = 0; j < 4; ++j) { const int n = (lane >> 3) + 8 * j; const LAS float* s = scr + (8 * c) * 33 + n;
        u32x2 o; o.x = pk4_fp8(s[0 * 33], s[1 * 33], s[2 * 33], s[3 * 33]); o.y = pk4_fp8(s[4 * 33], s[5 * 33], s[6 * 33], s[7 * 33]);
        *(u32x2*)(WT + (size_t)(p0 + n) * 1024 + k0 + 8 * c) = o; }
    LDS_WAIT(); asm volatile("" ::: "memory");
}


#define XB_TMO      128
#define XB_XCNT(j)  (256  + 64 * (j))
#define XB_XSUB(j)  (1280 + 64 * (j))
#define XB_XGEN(j)  (2304 + 64 * (j))
#define XB_TOP      3328
#define XB_TOPGEN   3392
#define XCD_BAR_WORDS 3456
#define XB_SPIN_CAP (1u << 18)
__device__ __forceinline__ unsigned xb_ld(unsigned* p)              { return __hip_atomic_load(p, __ATOMIC_RELAXED, __HIP_MEMORY_SCOPE_AGENT); }
__device__ __forceinline__ unsigned xb_add(unsigned* p, unsigned v) { return __hip_atomic_fetch_add(p, v, __ATOMIC_RELAXED, __HIP_MEMORY_SCOPE_AGENT); }
__device__ __forceinline__ unsigned xb_xcc_id() { return (unsigned)__builtin_amdgcn_s_getreg((3 << 11) | 20) & 0xFu; }
#define XB_SPIN(cond, bar) do { unsigned _sp = 0; while (cond) { __builtin_amdgcn_s_sleep(1); \
    if ((++_sp & 255u) == 0u) { if (xb_ld(&(bar)[XB_TMO])) break; if (_sp > XB_SPIN_CAP) { atomicAdd(&(bar)[XB_TMO], 1u); break; } } } } while (0)
struct XcdBarrier { unsigned* bar; unsigned x; volatile LAS unsigned* st; };
__device__ __forceinline__ XcdBarrier xcd_barrier_post(unsigned* bar, volatile LAS unsigned* st, const int wave_s) {
    XcdBarrier b; b.bar = bar; b.x = xb_xcc_id(); b.st = st;
    if (tid_of(wave_s) == 0) (void)xb_add(&bar[XB_XCNT(b.x)], 1u);
    return b;
}
__device__ __forceinline__ void xcd_barrier_complete(unsigned* bar, unsigned x, unsigned& nloc, unsigned& nx) {
    const unsigned G = gridDim.x * gridDim.y * gridDim.z;
    unsigned sum, cnt, mine, sp = 0u;
    for (;;) {
        sum = 0u; cnt = 0u; mine = 0u;
#pragma unroll
        for (unsigned j = 0; j < 16; ++j) { const unsigned c = xb_ld(&bar[XB_XCNT(j)]); sum += c; cnt += (c > 0u) ? 1u : 0u; mine = (j == x) ? c : mine; }
        if (sum == G) break;
        __builtin_amdgcn_s_sleep(1);
        if ((++sp & 255u) == 0u) { if (xb_ld(&bar[XB_TMO])) break; if (sp > XB_SPIN_CAP) { atomicAdd(&bar[XB_TMO], 1u); break; } }
    }
    nloc = mine > 0u ? mine : 1u; nx = cnt > 0u ? cnt : 1u;
}
__device__ __forceinline__ void xcd_barrier(const XcdBarrier& b, const int wave_s) {
    asm volatile("s_waitcnt vmcnt(0)" ::: "memory");
    __syncthreads();
    if (tid_of(wave_s) == 0) {
        unsigned* bar = b.bar;
        __builtin_amdgcn_s_waitcnt(0);
        unsigned nloc = b.st[0], nx = b.st[1];
        if (nloc == 0u) { xcd_barrier_complete(bar, b.x, nloc, nx); b.st[0] = nloc; b.st[1] = nx; }
        const unsigned old = xb_add(&bar[XB_XSUB(b.x)], 1u);
        const unsigned gen = old / nloc;
        if (old + 1u == (gen + 1u) * nloc) {
            __builtin_amdgcn_fence(__ATOMIC_RELEASE, "agent");
            asm volatile("s_waitcnt vmcnt(0)" ::: "memory");
            const unsigned og = xb_add(&bar[XB_TOP], 1u);
            const unsigned tg = og / nx;
            if (og + 1u == (tg + 1u) * nx) xb_add(&bar[XB_TOPGEN], 1u);
            else XB_SPIN(xb_ld(&bar[XB_TOPGEN]) == tg, bar);
            __builtin_amdgcn_fence(__ATOMIC_ACQUIRE, "agent");
            xb_add(&bar[XB_XGEN(b.x)], 1u);
            asm volatile("s_waitcnt vmcnt(0)" ::: "memory");
        } else {
            XB_SPIN(xb_ld(&bar[XB_XGEN(b.x)]) == gen, bar);
            __builtin_amdgcn_fence(__ATOMIC_ACQUIRE, "agent");
            asm volatile("s_waitcnt vmcnt(0)" ::: "memory");
        }
    }
    __syncthreads();
}

__global__ void __launch_bounds__(NTHREADS, 2) fwd_megakernel(Params p_arg) {
    extern __shared__ __attribute__((aligned(16))) unsigned char lds_raw[];
    LAS unsigned char* lds = (LAS unsigned char*)lds_raw;
#define PHASE_IDS() int tid = tid_of(wave_s); asm volatile("" : "+v"(tid)); const int lane = tid & 63, wave = wave_s; (void)lane; (void)wave
    const int G = gridDim.x, bx = blockIdx.x;
    const int wave_s = __builtin_amdgcn_readfirstlane((int)threadIdx.x >> 6);
    typedef const __attribute__((address_space(4))) Params* KParams;
    const KParams kp0 = (KParams)__builtin_amdgcn_kernarg_segment_ptr();
#define PHASE_PTRS() KParams _kp = kp0; asm volatile("" : "+s"(_kp)); Params p; p.x = _kp->x; p.w_in = _kp->w_in; p.b_in = _kp->b_in; p.sinks = _kp->sinks; p.w_out = _kp->w_out; p.b_out = _kp->b_out; p.ln1_g = _kp->ln1_g; p.ln1_b = _kp->ln1_b; \
    p.w_router = _kp->w_router; p.b_router = _kp->b_router; p.w1 = _kp->w1; p.b1 = _kp->b1; p.w2 = _kp->w2; p.b2 = _kp->b2; p.ln2_g = _kp->ln2_g; p.ln2_b = _kp->ln2_b; p.out = _kp->out; p.ws = _kp->ws; unsigned char* const ws = p.ws; \
    unsigned* const ctl = (unsigned*)(ws + WS_CTL); float* const ksum = (float*)(ws + WS_KSUM); float* const rope = (float*)(ws + WS_ROPE); \
    bf16_t* const w_in_t = (bf16_t*)(ws + WS_WIN_T); bf16_t* const w_out_t = (bf16_t*)(ws + WS_WOUT_T); \
    unsigned char* const w1_8 = ws + WS_W1_8; unsigned char* const w2_8 = ws + WS_W2_8; unsigned char* const x1_8 = ws + WS_X1_8; unsigned char* const act8 = ws + WS_ACT8; \
    int* const cnt_blk = (int*)(ws + WS_CNT); int* const tile_e = (int*)(ws + WS_TILE_E); bf16_t* const wr_hi = (bf16_t*)(ws + WS_WR_HI); bf16_t* const wr_lo = (bf16_t*)(ws + WS_WR_LO); \
    int* const tok = (int*)(ws + WS_TOK); int* const asg_e = (int*)(ws + WS_ASG_E); float* const asg_g = (float*)(ws + WS_ASG_G); int* const asg_d = (int*)(ws + WS_ASG_D); \
    bf16_t* const x1b = (bf16_t*)(ws + WS_X1B); bf16_t* const xb = (bf16_t*)(ws + WS_XB); bf16_t* const attn_o = xb; bf16_t* const qkv = (bf16_t*)(ws + WS_QKV); unsigned char* const yb = ws + WS_YB; \
    (void)ctl; (void)ksum; (void)rope; (void)w_in_t; (void)w_out_t; (void)w1_8; (void)w2_8; (void)x1_8; (void)act8; (void)cnt_blk; (void)tile_e; (void)wr_hi; (void)wr_lo; (void)tok; (void)asg_e; (void)asg_g; (void)asg_d; \
    (void)x1b; (void)xb; (void)attn_o; (void)qkv; (void)yb
    { const int t0 = tid_of(wave_s); if (t0 < 2) ((LAS unsigned*)(lds + LDS_BARST))[t0] = 0u; }
    __syncthreads();
    XcdBarrier xbar;
    { PHASE_PTRS(); xbar = xcd_barrier_post(ctl + CW_BAR, (volatile LAS unsigned*)(lds + LDS_BARST), wave_s); }

    REP(0) {
        PHASE_IDS(); PHASE_PTRS();
        const long gt = (long)bx * NTHREADS + tid, gsz = (long)G * NTHREADS;
        for (long i = gt; i < 2048 * 32; i += gsz) {
            const int pos = (int)(i >> 5), k = (int)(i & 31);
            double inv = 1.0; for (int q = 0; q < k; ++q) inv *= 0.7498942093324559;
            double s, c; sincos_d((double)pos * inv, s, c);
            rope[pos * 64 + k] = (float)c; rope[pos * 64 + 32 + k] = (float)s;
        }
        for (long i = gt; i < 32 * 1024; i += gsz) {
            const int e = (int)(i >> 10), k = (int)(i & 1023); const float w = p.w_router[k * 32 + e];
            const unsigned h = f2bf(w); wr_hi[i] = (bf16_t)h; wr_lo[i] = (bf16_t)f2bf(w - bf2f(h));
        }
        LAS float* scr = (LAS float*)(lds + wave * 16384);
        const int gw = bx * 8 + wave, NGW = G * 8;
        constexpr int I_IN = 16 * (INW / 32), I_OUT = 16 * 32, I_W1 = 16 * 64, I_W2 = 16 * 32;
        constexpr int NITEMS = I_IN + I_OUT + NE * I_W1 + NE * I_W2;
        for (int it = gw; it < NITEMS; it += NGW) {
            int r = it;
#if INPROJ_FP8
            if (r < I_IN) { p0_transpose_item_fp8(p.w_in, INW, (unsigned char*)w_in_t, 0, WIN_SCALE, scr, r, lane); continue; } r -= I_IN;
#else
            if (r < I_IN) { p0_transpose_item(p.w_in, INW, w_in_t, 0, scr, r, lane); continue; } r -= I_IN;
#endif
            if (r < I_OUT) { p0_transpose_item_fp8(p.w_out, 1024, (unsigned char*)w_out_t, 1, W_SCALE, scr, r, lane); continue; } r -= I_OUT;
            if (r < NE * I_W1) { const int e = r / I_W1; p0_transpose_item_fp8(p.w1 + (size_t)e * 1024 * 2048, 2048, w1_8 + (size_t)e * 2048 * 1024, 2, W_SCALE, scr, r % I_W1, lane); continue; } r -= NE * I_W1;
            { const int e = r / I_W2; p0_transpose_item_fp8(p.w2 + (size_t)e * 1024 * 1024, 1024, w2_8 + (size_t)e * 1024 * 1024, 1, W_SCALE, scr, r % I_W2, lane); }
        }
        const f32x4* x4 = (const f32x4*)p.x;
#if INPROJ_FP8
        u32x2* x8 = (u32x2*)xb;
        for (long i = gt; i < (long)T * D / 8; i += gsz) { const f32x4 a = x4[2 * i], b = x4[2 * i + 1];
            u32x2 o; o.x = pk4_fp8(a[0], a[1], a[2], a[3]); o.y = pk4_fp8(b[0], b[1], b[2], b[3]); x8[i] = o; }
#else
        u32x4* xb4 = (u32x4*)xb;
        for (long i = gt; i < (long)T * D / 8; i += gsz) { const f32x4 a = x4[2 * i], b = x4[2 * i + 1];
            u32x4 o; o.x = cvtpk(a[0], a[1]); o.y = cvtpk(a[2], a[3]); o.z = cvtpk(b[0], b[1]); o.w = cvtpk(b[2], b[3]); xb4[i] = o; }
#endif
    }
    xcd_barrier(xbar, wave_s);

    REP(1) {
        PHASE_PTRS();
#if INPROJ_FP8
        pg8::SchedInProj<1024> S{(const char*)xb, (const char*)w_in_t, G, bx};
        pg8::EpiInProj E{qkv, p.b_in, rope, ksum, 1.0f / WIN_SCALE};
        pg8::gemm_phase<pg8::EpiInProj, pg8::SchedInProj<1024>, false, true, 512, true>(lds, S, E, wave_s);
#else
        pg8::SchedInProj<2048> S{(const char*)xb, (const char*)w_in_t, G, bx};
        pg8::EpiInProj E{qkv, p.b_in, rope, ksum, 1.0f};
        pg8::gemm_phase<pg8::EpiInProj, pg8::SchedInProj<2048>, false, true>(lds, S, E, wave_s);
#endif
    }
    xcd_barrier(xbar, wave_s);

    REP(2) for (int u = bx; u < 256; u += G) {
        PHASE_PTRS();
        { const int b = u >> 3, h = u & 7;
            for (int j = 0; j < 8; ++j) att::moba_unit<8>(b, h, j, qkv, (unsigned char*)attn_o, ksum, (LAS char*)lds, wave_s); }
        { const int b = u >> 3, kvh = (u >> 2) & 1, oct = u & 3;
            att::swa_stream((LAS char*)lds, qkv, (unsigned char*)attn_o, b, kvh, oct * 8, 8, p.sinks, wave_s); }
    }
    xcd_barrier(xbar, wave_s);

    REP(3) for (int pm = bx; pm < T / 256; pm += G) {
        {
            PHASE_PTRS();
            pg8::SchedPanel S{(const char*)attn_o, (const char*)w_out_t, pm};
            pg8::EpiOutProj E{(bf16_t*)p.out, p.b_out, p.x};
            pg8::gemm_phase<pg8::EpiOutProj, pg8::SchedPanel, false, true, 512, true>(lds, S, E, wave_s);
        }
        __syncthreads();
        PHASE_IDS(); PHASE_PTRS();
        {
#pragma unroll
            for (int i = 0; i < 16; ++i) { const int idx = tid + 512 * i, mat = idx >> 12, rw = (idx >> 7) & 31, ch = idx & 127;
                const u32x4 v = *(const u32x4*)((mat ? wr_lo : wr_hi) + rw * 1024 + ch * 8);
                *(LAS u32x4*)(lds + mat * 66048 + rw * 2064 + ch * 16) = v; }
        }
        {
            const bf16_t* ytmp = (const bf16_t*)p.out;
            f32x4 gg[2][2], bb[2][2];
#pragma unroll
            for (int j = 0; j < 2; ++j)
#pragma unroll
                for (int h = 0; h < 2; ++h) { gg[j][h] = *(const f32x4*)(p.ln1_g + 512 * j + 8 * lane + 4 * h); bb[j][h] = *(const f32x4*)(p.ln1_b + 512 * j + 8 * lane + 4 * h); }
            for (int rr = 0; rr < 32; rr += 4) {
                const size_t row0 = (size_t)pm * 256 + wave * 32 + rr;
                u32x4 raw[4][2]; float v[4][2][8]; float sm[4], sq[4];
#pragma unroll
                for (int q = 0; q < 4; ++q)
#pragma unroll
                    for (int j = 0; j < 2; ++j) raw[q][j] = *(const u32x4*)(ytmp + (row0 + q) * D + 512 * j + 8 * lane);
#pragma unroll
                for (int q = 0; q < 4; ++q) { float s_ = 0.f;
#pragma unroll
                    for (int j = 0; j < 2; ++j)
#pragma unroll
                        for (int c = 0; c < 4; ++c) { const unsigned w = raw[q][j][c]; v[q][j][2 * c] = bf2f(w & 0xffffu); v[q][j][2 * c + 1] = bf2f(w >> 16); s_ += v[q][j][2 * c] + v[q][j][2 * c + 1]; }
                    sm[q] = s_; }
#pragma unroll
                for (int o = 1; o < 64; o <<= 1) {
#pragma unroll
                    for (int q = 0; q < 4; ++q) sm[q] += __shfl_xor(sm[q], o); }
#pragma unroll
                for (int q = 0; q < 4; ++q) { const float mean = sm[q] * (1.0f / D); float s2 = 0.f;
#pragma unroll
                    for (int j = 0; j < 2; ++j)
#pragma unroll
                        for (int c = 0; c < 8; ++c) { v[q][j][c] -= mean; s2 += v[q][j][c] * v[q][j][c]; }
                    sq[q] = s2; }
#pragma unroll
                for (int o = 1; o < 64; o <<= 1) {
#pragma unroll
                    for (int q = 0; q < 4; ++q) sq[q] += __shfl_xor(sq[q], o); }
#pragma unroll
                for (int q = 0; q < 4; ++q) {
                    const float rstd = 1.0f / sqrtf(sq[q] * (1.0f / D) + LN_EPS);
#pragma unroll
                    for (int j = 0; j < 2; ++j) {
                        float xv[8];
#pragma unroll
                        for (int c = 0; c < 8; ++c) xv[c] = v[q][j][c] * rstd * gg[j][c >> 2][c & 3] + bb[j][c >> 2][c & 3];
                        u32x4 hv; hv.x = cvtpk(xv[0], xv[1]); hv.y = cvtpk(xv[2], xv[3]); hv.z = cvtpk(xv[4], xv[5]); hv.w = cvtpk(xv[6], xv[7]);
                        u32x2 fv; fv.x = pk4_fp8(xv[0], xv[1], xv[2], xv[3]); fv.y = pk4_fp8(xv[4], xv[5], xv[6], xv[7]);
                        *(u32x4*)(x1b + (row0 + q) * D + 512 * j + 8 * lane) = hv;
                        *(u32x2*)(x1_8 + (row0 + q) * D + 512 * j + 8 * lane) = fv;
                    }
                }
            }
        }
        __syncthreads();
        {
            const int fr = lane & 15, fq = lane >> 4;
            f32x4 lacc[2][2];
#pragma unroll
            for (int m = 0; m < 2; ++m)
#pragma unroll
                for (int n = 0; n < 2; ++n) lacc[m][n] = (f32x4){0.f, 0.f, 0.f, 0.f};
            const size_t r0 = (size_t)pm * 256 + wave * 32;
            const bf16_t* ah = x1b + (r0 + fr) * D + 8 * fq;
            const LAS unsigned char* bh = lds + fr * 2064 + 16 * fq; const LAS unsigned char* bl = bh + 66048;
#pragma unroll 4
            for (int k0 = 0; k0 < 1024; k0 += 32) {
                bf16x8 a_hi[2], b_hi[2], b_lo[2];
#pragma unroll
                for (int m = 0; m < 2; ++m) a_hi[m] = *(const bf16x8*)(ah + (size_t)m * 16 * D + k0);
#pragma unroll
                for (int n = 0; n < 2; ++n) { b_hi[n] = *(const LAS bf16x8*)(bh + n * 16 * 2064 + k0 * 2); b_lo[n] = *(const LAS bf16x8*)(bl + n * 16 * 2064 + k0 * 2); }
#pragma unroll
                for (int m = 0; m < 2; ++m)
#pragma unroll
                    for (int n = 0; n < 2; ++n) {
                        lacc[m][n] = __builtin_amdgcn_mfma_f32_16x16x32_bf16(a_hi[m], b_hi[n], lacc[m][n], 0, 0, 0);
                        lacc[m][n] = __builtin_amdgcn_mfma_f32_16x16x32_bf16(a_hi[m], b_lo[n], lacc[m][n], 0, 0, 0);
                    }
            }
            __syncthreads();
            LAS float* lg = (LAS float*)lds;
#pragma unroll
            for (int m = 0; m < 2; ++m)
#pragma unroll
                for (int n = 0; n < 2; ++n)
#pragma unroll
                    for (int rg = 0; rg < 4; ++rg) lg[(wave * 32 + 16 * m + 4 * fq + rg) * 33 + 16 * n + fr] = lacc[m][n][rg];
        }
        __syncthreads();
        {
            LAS float* lg = (LAS float*)lds;
            LAS int* wcnt = (LAS int*)(lds + 36864);
            float t0 = -INFINITY, t1 = -INFINITY, t2 = -INFINITY, t3 = -INFINITY; int i0 = 0, i1 = 0, i2 = 0, i3 = 0;
            int rk0 = 0, rk1 = 0, rk2 = 0, rk3 = 0;
            if (tid < 256) {
                for (int e = 0; e < NE; ++e) {
                    const float xv = lg[tid * 33 + e] + p.b_router[e];
                    if (xv > t3) {
                        if (xv > t2) { t3 = t2; i3 = i2;
                            if (xv > t1) { t2 = t1; i2 = i1;
                                if (xv > t0) { t1 = t0; i1 = i0; t0 = xv; i0 = e; } else { t1 = xv; i1 = e; }
                            } else { t2 = xv; i2 = e; }
                        } else { t3 = xv; i3 = e; }
                    }
                }
                const unsigned selm = (1u << i0) | (1u << i1) | (1u << i2) | (1u << i3);
                for (int e = 0; e < NE; ++e) {
                    const bool has = ((selm >> e) & 1u) != 0u;
                    const unsigned long long bal = __ballot(has);
                    const int pre = __popcll(bal & ((1ull << lane) - 1ull));
                    if (e == i0) rk0 = pre; if (e == i1) rk1 = pre; if (e == i2) rk2 = pre; if (e == i3) rk3 = pre;
                    if (lane == 0) wcnt[wave * 32 + e] = __popcll(bal);
                }
            }
            __syncthreads();
            if (tid < 256) {
                const float e1 = __expf(t1 - t0), e2 = __expf(t2 - t0), e3 = __expf(t3 - t0);
                const float inv = 1.0f / (1.0f + e1 + e2 + e3);
                int b0 = 0, b1 = 0, b2 = 0, b3 = 0;
                for (int w = 0; w < wave; ++w) { b0 += wcnt[w * 32 + i0]; b1 += wcnt[w * 32 + i1]; b2 += wcnt[w * 32 + i2]; b3 += wcnt[w * 32 + i3]; }
                const size_t a = ((size_t)pm * 256 + tid) * 4;
                *(int4*)(asg_e + a) = make_int4(i0, i1, i2, i3);
                *(float4*)(asg_g + a) = make_float4(inv, e1 * inv, e2 * inv, e3 * inv);
                *(int4*)(asg_d + a) = make_int4(b0 + rk0, b1 + rk1, b2 + rk2, b3 + rk3);
            }
            if (tid < 32) cnt_blk[pm * 32 + tid] = wcnt[tid] + wcnt[32 + tid] + wcnt[64 + tid] + wcnt[96 + tid];
            __syncthreads();
        }
    }
    xcd_barrier(xbar, wave_s);

    for (int pm = bx; pm < T / 256; pm += G) {
        PHASE_IDS(); PHASE_PTRS();
        LAS int* part_all = (LAS int*)lds; LAS int* part_pre = part_all + 512; LAS int* tot = part_pre + 512; LAS int* pre = tot + 32; LAS int* poff = pre + 32;
        { const int e = tid & 31, seg = tid >> 5; int sa = 0, sp = 0;
            for (int bb = seg * 16; bb < seg * 16 + 16; ++bb) { const int c = cnt_blk[bb * 32 + e]; sa += c; sp += (bb < pm) ? c : 0; }
            part_all[tid] = sa; part_pre[tid] = sp; }
        __syncthreads();
        if (tid < 32) { int sa = 0, sp = 0; for (int s = 0; s < 16; ++s) { sa += part_all[s * 32 + tid]; sp += part_pre[s * 32 + tid]; } tot[tid] = sa; pre[tid] = sp; }
        __syncthreads();
        if (tid == 0) { int off = 0; for (int e = 0; e < NE; ++e) { poff[e] = off; off += ((tot[e] + 255) >> 8) << 8; } poff[32] = off; }
        __syncthreads();
        if (tid < 256) {
            const int token = pm * 256 + tid; const size_t a = (size_t)token * 4;
            const int4 ee = *(const int4*)(asg_e + a); const int4 rk = *(const int4*)(asg_d + a);
            const int d0 = poff[ee.x] + pre[ee.x] + rk.x, d1 = poff[ee.y] + pre[ee.y] + rk.y, d2 = poff[ee.z] + pre[ee.z] + rk.z, d3 = poff[ee.w] + pre[ee.w] + rk.w;
            *(int4*)(asg_d + a) = make_int4(d0, d1, d2, d3);
            tok[d0] = token; tok[d1] = token; tok[d2] = token; tok[d3] = token;
        }
        if (pm < NE) {
            const int e = pm, n = tot[e], np = ((n + 255) >> 8) << 8, o = poff[e];
            for (int i = n + tid; i < np; i += NTHREADS) tok[o + i] = 0;
            for (int i = tid; i < (np >> 8); i += NTHREADS) tile_e[(o >> 8) + i] = e;
        }
        if (pm == 0 && tid == 0) ctl[CW_NTILES] = (unsigned)(poff[32] >> 8);
        __syncthreads();
    }
    xcd_barrier(xbar, wave_s);

    REP(5) {
        PHASE_PTRS(); const int ntiles = (int)ctl[CW_NTILES];
        { LAS int* tl = (LAS int*)(lds + LDSX_TILE); for (int i = tid_of(wave_s); i < ntiles; i += NTHREADS) tl[i] = tile_e[i]; __syncthreads(); }
        pg8::SchedMoe<8, true> S{(const char*)x1_8, (const char*)w1_8, (const LAS int*)(lds + LDSX_TILE), tok, ntiles, G, bx};
        pg8::EpiSwiglu E{act8, p.b1};
        pg8::gemm_phase<pg8::EpiSwiglu, pg8::SchedMoe<8, true>, true, true, 512, true, true>(lds, S, E, wave_s);
    }
    xcd_barrier(xbar, wave_s);

    REP(6) {
        PHASE_PTRS(); const int ntiles = (int)ctl[CW_NTILES];
        { LAS int* tl = (LAS int*)(lds + LDSX_TILE); for (int i = tid_of(wave_s); i < ntiles; i += NTHREADS) tl[i] = tile_e[i]; __syncthreads(); }
        pg8::SchedMoe<4, false> S{(const char*)act8, (const char*)w2_8, (const LAS int*)(lds + LDSX_TILE), tok, ntiles, G, bx};
        pg8::EpiDown E{yb, p.b2};
        pg8::gemm_phase<pg8::EpiDown, pg8::SchedMoe<4, false>, false, true, 512, true, true>(lds, S, E, wave_s);
    }
    xcd_barrier(xbar, wave_s);

    REP(7) {
        PHASE_IDS(); PHASE_PTRS();
        const int gw = bx * 8 + wave, NGW = G * 8;
        f32x4 gg[2][2], bb[2][2];
#pragma unroll
        for (int j = 0; j < 2; ++j)
#pragma unroll
            for (int h = 0; h < 2; ++h) { gg[j][h] = *(const f32x4*)(p.ln2_g + 512 * j + 8 * lane + 4 * h); bb[j][h] = *(const f32x4*)(p.ln2_b + 512 * j + 8 * lane + 4 * h); }
        constexpr int R = 2;
        for (int row0 = gw; row0 < T; row0 += R * NGW) {
            int4 dd[R]; float4 gt[R];
#pragma unroll
            for (int q = 0; q < R; ++q) { const int row = row0 + q * NGW < T ? row0 + q * NGW : row0; dd[q] = *(const int4*)(asg_d + (size_t)row * 4); gt[q] = *(const float4*)(asg_g + (size_t)row * 4); }
            u32x4 xr[R][2]; u32x2 yk[R][4][2];
#pragma unroll
            for (int q = 0; q < R; ++q) { const int row = row0 + q * NGW < T ? row0 + q * NGW : row0;
#pragma unroll
                for (int j = 0; j < 2; ++j) {
                    xr[q][j] = *(const u32x4*)(x1b + (size_t)row * D + 512 * j + 8 * lane);
                    yk[q][0][j] = *(const u32x2*)(yb + (size_t)dd[q].x * D + 512 * j + 8 * lane);
                    yk[q][1][j] = *(const u32x2*)(yb + (size_t)dd[q].y * D + 512 * j + 8 * lane);
                    yk[q][2][j] = *(const u32x2*)(yb + (size_t)dd[q].z * D + 512 * j + 8 * lane);
                    yk[q][3][j] = *(const u32x2*)(yb + (size_t)dd[q].w * D + 512 * j + 8 * lane);
                } }
            float z[R][2][8]; float sm[R], sq[R];
#pragma unroll
            for (int q = 0; q < R; ++q) {
                const float g0 = gt[q].x * (1.0f / Y_SCALE), g1 = gt[q].y * (1.0f / Y_SCALE), g2 = gt[q].z * (1.0f / Y_SCALE), g3 = gt[q].w * (1.0f / Y_SCALE);
                float s_ = 0.f;
#pragma unroll
                for (int j = 0; j < 2; ++j)
#pragma unroll
                    for (int d = 0; d < 2; ++d) {
#define P7_PAIR(HH, SEL) do { \
                            const f32x2 a0 = __builtin_amdgcn_cvt_pk_f32_fp8((int)yk[q][0][j][d], SEL), a1 = __builtin_amdgcn_cvt_pk_f32_fp8((int)yk[q][1][j][d], SEL); \
                            const f32x2 a2 = __builtin_amdgcn_cvt_pk_f32_fp8((int)yk[q][2][j][d], SEL), a3 = __builtin_amdgcn_cvt_pk_f32_fp8((int)yk[q][3][j][d], SEL); \
                            const unsigned xw = xr[q][j][2 * d + HH]; \
                            const float lo = DN_ALPHA * bf2f(xw & 0xffffu) + g0 * a0.x + g1 * a1.x + g2 * a2.x + g3 * a3.x; \
                            const float hi = DN_ALPHA * bf2f(xw >> 16) + g0 * a0.y + g1 * a1.y + g2 * a2.y + g3 * a3.y; \
                            z[q][j][4 * d + 2 * HH] = lo; z[q][j][4 * d + 2 * HH + 1] = hi; s_ += lo + hi; } while (0)
                        P7_PAIR(0, false); P7_PAIR(1, true);
#undef P7_PAIR
                    }
                sm[q] = s_;
            }
#pragma unroll
            for (int o = 1; o < 64; o <<= 1) {
#pragma unroll
                for (int q = 0; q < R; ++q) sm[q] += __shfl_xor(sm[q], o); }
#pragma unroll
            for (int q = 0; q < R; ++q) { const float mean = sm[q] * (1.0f / D); float s2 = 0.f;
#pragma unroll
                for (int j = 0; j < 2; ++j)
#pragma unroll
                    for (int c = 0; c < 8; ++c) { z[q][j][c] -= mean; s2 += z[q][j][c] * z[q][j][c]; }
                sq[q] = s2; }
#pragma unroll
            for (int o = 1; o < 64; o <<= 1) {
#pragma unroll
                for (int q = 0; q < R; ++q) sq[q] += __shfl_xor(sq[q], o); }
#pragma unroll
            for (int q = 0; q < R; ++q) {
                const int row = row0 + q * NGW;
                if (row < T) {
                    const float rstd = 1.0f / sqrtf(sq[q] * (1.0f / D) + LN_EPS);
#pragma unroll
                    for (int j = 0; j < 2; ++j)
#pragma unroll
                        for (int h = 0; h < 2; ++h) {
                            f32x4 o;
#pragma unroll
                            for (int c = 0; c < 4; ++c) o[c] = z[q][j][4 * h + c] * rstd * gg[j][h][c] + bb[j][h][c];
                            *(f32x4*)(p.out + (size_t)row * D + 512 * j + 8 * lane + 4 * h) = o;
                        }
                }
            }
        }
    }
}

extern "C" void kernel_launch(void* const* d_in, const int* in_sizes, int n_in, void* d_out, int out_size, void* d_ws, size_t ws_size, hipStream_t stream) {
    static int grid_blocks = 0;
    if (grid_blocks == 0) {
        if (n_in != 16 || in_sizes[0] != T * D || out_size != T * D || ws_size < WS_END) {
            fprintf(stderr, "kernel_launch: unexpected shapes: n_in %d in0 %d out %d ws %zu (need %zu)\n", n_in, n_in > 0 ? in_sizes[0] : -1, out_size, ws_size, (size_t)WS_END); grid_blocks = -1; return; }
        int dev = 0, cus = 0, per_cu = 0;
        (void)hipGetDevice(&dev);
        (void)hipDeviceGetAttribute(&cus, hipDeviceAttributeMultiprocessorCount, dev);
        (void)hipFuncSetAttribute((const void*)fwd_megakernel, hipFuncAttributeMaxDynamicSharedMemorySize, LDS_BYTES);
        (void)hipOccupancyMaxActiveBlocksPerMultiprocessor(&per_cu, (const void*)fwd_megakernel, NTHREADS, LDS_BYTES);
        if (per_cu < 1) { fprintf(stderr, "kernel_launch: occupancy query reports %d blocks per CU\n", per_cu); per_cu = 1; }
        grid_blocks = cus;
        fprintf(stderr, "kernel_launch: cus=%d per_cu=%d grid=%d ws=%zu\n", cus, per_cu, grid_blocks, ws_size);
    }
    if (grid_blocks < 0) return;
    (void)hipMemsetAsync((char*)d_ws + WS_CTL, 0, CTL_ZERO_BYTES, stream);
    Params p{};
    p.x = (const float*)d_in[0]; p.w_in = (const float*)d_in[1]; p.b_in = (const float*)d_in[2]; p.sinks = (const float*)d_in[3]; p.w_out = (const float*)d_in[4]; p.b_out = (const float*)d_in[5];
    p.ln1_g = (const float*)d_in[6]; p.ln1_b = (const float*)d_in[7]; p.w_router = (const float*)d_in[8]; p.b_router = (const float*)d_in[9];
    p.w1 = (const float*)d_in[10]; p.b1 = (const float*)d_in[11]; p.w2 = (const float*)d_in[12]; p.b2 = (const float*)d_in[13]; p.ln2_g = (const float*)d_in[14]; p.ln2_b = (const float*)d_in[15];
    p.out = (float*)d_out; p.ws = (unsigned char*)d_ws;
    hipLaunchKernelGGL(fwd_megakernel, dim3(grid_blocks), dim3(NTHREADS), LDS_BYTES, stream, p);
    hipError_t e = hipPeekAtLastError();
    if (e != hipSuccess) fprintf(stderr, "launch failed: %s (grid %d)\n", hipGetErrorString(e), grid_blocks);
}
```

```cpp
#include <hip/hip_runtime.h>
#include <cstdio>
#include <cstdint>

#define LAS __attribute__((address_space(3)))
typedef unsigned short bf16_t;
typedef short bf16x8 __attribute__((ext_vector_type(8)));
typedef short s16x4 __attribute__((ext_vector_type(4)));
typedef float f32x2 __attribute__((ext_vector_type(2)));
typedef float f32x4 __attribute__((ext_vector_type(4)));
typedef float f32x16 __attribute__((ext_vector_type(16)));
typedef unsigned u32x2 __attribute__((ext_vector_type(2)));
typedef unsigned u32x4 __attribute__((ext_vector_type(4)));
typedef __bf16 bf16x2_t __attribute__((ext_vector_type(2)));

constexpr int D = 1024, BATCH = 32, SEQ = 2048, T = BATCH * SEQ;
constexpr int INW = 2304, NE = 32;
constexpr float LN_EPS = 1e-5f;
constexpr float DN_ALPHA = 1.189207115002721f;
constexpr float LOG2E = 1.4426950408889634f;
constexpr float C2 = 0.18033688011112042f;
constexpr int NTHREADS = 512;
constexpr int LDS_BYTES = 147456;
constexpr int MAX_TILES = 1056;
#ifndef INPROJ_FP8
#define INPROJ_FP8 1
#endif
#ifndef EPI_DUP
#define EPI_DUP 0
#endif
#ifndef DUP_MASK
#define DUP_MASK 0
#endif
#ifndef KPROBE
#define KPROBE 0
#endif
#define REP(k) for (int _rep = 0; _rep < (((DUP_MASK >> (k)) & 1) ? 2 : 1); ++_rep)

constexpr size_t MiB = 1u << 20;
constexpr size_t WS_CTL = 0, CTL_ZERO_BYTES = 2 * MiB;
constexpr size_t WS_KSUM = 1 * MiB;
constexpr size_t WS_ROPE = 2 * MiB;
constexpr size_t WS_WIN_T = 4 * MiB;
constexpr size_t WS_WOUT_T = 9 * MiB;
constexpr size_t WS_SMALL = 11 * MiB;
constexpr size_t WS_CNT = WS_SMALL, WS_TILE_E = WS_SMALL + 65536, WS_WR_HI = WS_SMALL + 131072, WS_WR_LO = WS_WR_HI + 65536;
constexpr size_t WS_TOK = 12 * MiB;
constexpr size_t WS_ASG_E = 14 * MiB, WS_ASG_G = 15 * MiB, WS_ASG_D = 16 * MiB;
constexpr size_t WS_W2_8 = 24 * MiB;
constexpr size_t WS_X1B = 56 * MiB;
constexpr size_t WS_ACT8 = 184 * MiB;
constexpr size_t WS_XB = 184 * MiB;
constexpr size_t WS_X1LO = 312 * MiB;
constexpr size_t WS_YB = 488 * MiB;
constexpr size_t WS_W1_8 = 488 * MiB;
constexpr size_t WS_X1_8 = 552 * MiB;
constexpr size_t WS_QKV = 616 * MiB;
constexpr size_t WS_END = 1016 * MiB;
constexpr float KPF = (KPROBE == 1) ? 0.5f : 1.0f;
constexpr float W_SCALE = 64.0f, ACT_SCALE = 4.0f, WIN_SCALE = 32.0f, Y_SCALE = 16.0f, AO_SCALE = 64.0f;
constexpr int CW_NTILES = 16, CW_BAR = 4096;
constexpr int LDSX_TILE = 131072, LDSX_IDX = 135424, LDSX_BIAS = 136448;
constexpr int LDS_BARST = LDS_BYTES - 256;

struct Params {
    const float *x, *w_in, *b_in, *sinks, *w_out, *b_out, *ln1_g, *ln1_b, *w_router, *b_router, *w1, *b1, *w2, *b2, *ln2_g, *ln2_b;
    float* out; unsigned char* ws;
};

__device__ __forceinline__ unsigned f2bf(float f) { unsigned u = __builtin_bit_cast(unsigned, f); return (u + 0x7fffu + ((u >> 16) & 1u)) >> 16; }
__device__ __forceinline__ float bf2f(unsigned h) { return __builtin_bit_cast(float, h << 16); }
__device__ __forceinline__ unsigned cvtpk(float lo, float hi) { f32x2 v = {lo, hi}; bf16x2_t b = __builtin_convertvector(v, bf16x2_t); return __builtin_bit_cast(unsigned, b); }
__device__ __forceinline__ unsigned pk4_fp8(float a, float b, float c, float d) { int w = 0; w = __builtin_amdgcn_cvt_pk_fp8_f32(a, b, w, false); w = __builtin_amdgcn_cvt_pk_fp8_f32(c, d, w, true); return (unsigned)w; }
template <int X> __device__ __forceinline__ float swz_xor(float v) { return __builtin_bit_cast(float, __builtin_amdgcn_ds_swizzle(__builtin_bit_cast(int, v), (X << 10) | 0x1f)); }
__device__ __forceinline__ float wave_sum(float v) {
    v += swz_xor<1>(v); v += swz_xor<2>(v); v += swz_xor<4>(v); v += swz_xor<8>(v); v += swz_xor<16>(v);
    auto rr = __builtin_amdgcn_permlane32_swap(__float_as_uint(v), __float_as_uint(v), false, false);
    return __uint_as_float(rr[0]) + __uint_as_float(rr[1]);
}
#define LDS_WAIT() asm volatile("s_waitcnt lgkmcnt(0)" ::: "memory")
__device__ __forceinline__ int tid_of(int wave_s) { unsigned z = 0u; asm volatile("" : "+v"(z));
    return wave_s * 64 + (int)__builtin_amdgcn_mbcnt_hi(~0u, __builtin_amdgcn_mbcnt_lo(~0u, z)); }

namespace pg8 {
constexpr int BM = 256, BK = 64, HALF = 128, HTB = HALF * BK * 2, STAGE_BYTES = 8 * HTB, NXCD = 8, WGM = 8;
constexpr int KD = 1024;
__host__ __device__ __forceinline__ int lds_byte(int r, int c) { const int st = (r >> 4) * 2 + (c >> 5), rr = r & 15, cc = c & 31, ob = rr * 64 + cc * 2; return st * 1024 + (ob ^ (((ob >> 9) & 1) << 5)); }
__host__ __device__ __forceinline__ void stage_rc(int b, int& R, int& C) { const int st = b / 1024, sb = b % 1024, swz = sb ^ (((sb >> 9) & 1) << 5); R = (st >> 1) * 16 + swz / 64; C = (st & 1) * 32 + (swz % 64) / 2; }
__host__ __device__ __forceinline__ int perm32(int rho) { const int n = rho >> 4, i = rho & 15; return 8 * (i >> 2) + 4 * n + (i & 3); }

struct Unit { int pm, pn, e; unsigned ao, bo; const int* rows; };

typedef int v8i32_t __attribute__((ext_vector_type(8)));
typedef int v4i32_t __attribute__((ext_vector_type(4)));
typedef unsigned long long u64x2_t __attribute__((ext_vector_type(2)));
__device__ __forceinline__ f32x4 zero4() { unsigned long long lo, hi; asm volatile("v_mov_b64 %0, 0\n\tv_mov_b64 %1, 0" : "=v"(lo), "=v"(hi)); u64x2_t v = {lo, hi}; return __builtin_bit_cast(f32x4, v); }
__device__ __forceinline__ v8i32_t cat8(bf16x8 a, bf16x8 b) { const v4i32_t x = __builtin_bit_cast(v4i32_t, a), y = __builtin_bit_cast(v4i32_t, b); return __builtin_shufflevector(x, y, 0, 1, 2, 3, 4, 5, 6, 7); }
__device__ __forceinline__ void pg8_glds16(unsigned voff, const void* sbase, unsigned lds_dst) { unsigned keep;
    asm volatile("s_mov_b32 %0, m0\n\ts_mov_b32 m0, %3\n\ts_nop 0\n\tglobal_load_lds_dwordx4 %1, %2\n\ts_mov_b32 m0, %0" : "=&s"(keep) : "v"(voff), "s"(sbase), "s"(lds_dst) : "memory"); }
struct NoHook { struct State {}; __device__ __forceinline__ void pre(int, int, State&) const {} __device__ __forceinline__ void operator()(int, int, State&) const {} };
template <class Epi, class Sched, bool GATHER, bool ALIGN_EPI, int KP = 1024, bool FP8 = false, bool MOE = false, class Hook = NoHook>
__device__ __forceinline__ void gemm_phase(LAS unsigned char* lds, const Sched& S, const Epi& E, const int wave_s, Hook H = Hook()) {
    int tid = tid_of(wave_s); asm volatile("" : "+v"(tid));
    const int wid = __builtin_amdgcn_readfirstlane(tid >> 6), lane = tid & 63, wr = wid >> 2, wc = wid & 3, fr = lane & 15, fq = lane >> 4;
    constexpr int K = KP, nt = K / BK;
    unsigned voffB[2], Vc[2][2]; int stR0, stC0;
    { int R, C; stage_rc(tid * 16, R, C); stR0 = R; stC0 = C; }
#pragma unroll
    for (int i = 0; i < 2; ++i) { voffB[i] = (unsigned)((stR0 + 64 * i) * K + stC0) * 2u; Vc[0][i] = voffB[i]; Vc[1][i] = voffB[i]; }
#define PG8_GATHER_LOAD(VV) do { int _t = tid_of(wave_s); asm volatile("" : "+v"(_t)); int _R, _C; stage_rc(_t * 16, _R, _C);     \
        const LAS int* _rp = (const LAS int*)(lds + LDSX_IDX) + _R; _Pragma("unroll") for (int _h = 0; _h < 2; ++_h) _Pragma("unroll") for (int _i = 0; _i < 2; ++_i) \
        VV[_h][_i] = ((unsigned)_rp[128 * _h + 64 * _i] * (unsigned)K + (unsigned)_C) * 2u; } while (0)
#define PG8_DMA4(gsrc, ldsoff) __builtin_amdgcn_global_load_lds((const unsigned*)(gsrc), (LAS unsigned*)(lds + (ldsoff)), 4, 0, 0)
    constexpr unsigned kstep = (unsigned)(BK * 2);
    constexpr unsigned hstep = (unsigned)HALF * K * 2;
    const char* const Abase = S.A; const char* const Bbase = S.B;
    const unsigned ldsw = (unsigned)wid * 1024u; const unsigned lds0 = (unsigned)(uintptr_t)lds;
    const int aoff = lds_byte(wr * 64 + fr, fq * 8), boff = lds_byte(wc * 32 + fr, fq * 8) + 4 * HTB;
#define PG8_SA(b, h) (((b) * 2 + (h)) * HTB)
#define PG8_SB(b, h) ((4 + (b) * 2 + (h)) * HTB)
#define PG8_SBR(b, h) (((b) * 2 + (h)) * HTB)
#define PG8_STAGE(bufoff, gbase, soff, voff) do { _Pragma("unroll") for (int _r = 0; _r < (KPROBE == 3 ? 2 : 1); ++_r) _Pragma("unroll") for (int _i = 0; _i < 2; ++_i) \
        pg8_glds16((voff)[_i], (gbase) + (size_t)(unsigned)(soff), (unsigned)__builtin_amdgcn_readfirstlane((int)(lds0 + (unsigned)(bufoff) + ldsw + _i * 8192))); } while (0)
#define PG8_STAGE_B(bufoff, soff) PG8_STAGE(bufoff, Bbase, soff, voffB)
#define PG8_STAGE_A(bufoff, soff, h, VV) do { if constexpr (GATHER) { PG8_STAGE(bufoff, Abase, soff, VV[h]); } else { PG8_STAGE(bufoff, Abase, (soff) + (h) * hstep, voffB); } } while (0)
#if KPROBE == 2
#define PG8_LDA(dst, b, h) do { _Pragma("unroll") for (int m = 0; m < 4; ++m) { dst[m] = cat8(*(volatile const LAS bf16x8*)(lds + PG8_SA(b, h) + aoff + m * 2048), *(volatile const LAS bf16x8*)(lds + PG8_SA(b, h) + aoff + m * 2048 + 1024)); \
        dst[m] = cat8(*(volatile const LAS bf16x8*)(lds + PG8_SA(b, h) + aoff + m * 2048), *(volatile const LAS bf16x8*)(lds + PG8_SA(b, h) + aoff + m * 2048 + 1024)); } } while (0)
#define PG8_LDB(dst, b, h) do { _Pragma("unroll") for (int n = 0; n < 2; ++n) { dst[n] = cat8(*(volatile const LAS bf16x8*)(lds + PG8_SBR(b, h) + boff + n * 2048), *(volatile const LAS bf16x8*)(lds + PG8_SBR(b, h) + boff + n * 2048 + 1024)); \
        dst[n] = cat8(*(volatile const LAS bf16x8*)(lds + PG8_SBR(b, h) + boff + n * 2048), *(volatile const LAS bf16x8*)(lds + PG8_SBR(b, h) + boff + n * 2048 + 1024)); } } while (0)
#else
#define PG8_LDA(dst, b, h) do { _Pragma("unroll") for (int m = 0; m < 4; ++m) dst[m] = cat8(*(const LAS bf16x8*)(lds + PG8_SA(b, h) + aoff + m * 2048), *(const LAS bf16x8*)(lds + PG8_SA(b, h) + aoff + m * 2048 + 1024)); } while (0)
#define PG8_LDB(dst, b, h) do { _Pragma("unroll") for (int n = 0; n < 2; ++n) dst[n] = cat8(*(const LAS bf16x8*)(lds + PG8_SBR(b, h) + boff + n * 2048), *(const LAS bf16x8*)(lds + PG8_SBR(b, h) + boff + n * 2048 + 1024)); } while (0)
#endif
#define PG8_LO(v) __builtin_bit_cast(bf16x8, __builtin_shufflevector(v, v, 0, 1, 2, 3))
#define PG8_HI(v) __builtin_bit_cast(bf16x8, __builtin_shufflevector(v, v, 4, 5, 6, 7))
#define PG8_MMA(ai, bj, At, Bt) do { __builtin_amdgcn_s_setprio(1); _Pragma("unroll") for (int m = 0; m < 4; ++m) _Pragma("unroll") for (int n = 0; n < 2; ++n) { \
        if constexpr (FP8) { acc[ai][bj][m][n] = __builtin_amdgcn_mfma_scale_f32_16x16x128_f8f6f4(Bt[n], At[m], acc[ai][bj][m][n], 0, 0, 0, 0, 0, 0); \
            if (KPROBE == 1) acc[ai][bj][m][n] = __builtin_amdgcn_mfma_scale_f32_16x16x128_f8f6f4(Bt[n], At[m], acc[ai][bj][m][n], 0, 0, 0, 0, 0, 0); } \
        else { acc[ai][bj][m][n] = __builtin_amdgcn_mfma_f32_16x16x32_bf16(PG8_LO(Bt[n]), PG8_LO(At[m]), acc[ai][bj][m][n], 0, 0, 0); \
               acc[ai][bj][m][n] = __builtin_amdgcn_mfma_f32_16x16x32_bf16(PG8_HI(Bt[n]), PG8_HI(At[m]), acc[ai][bj][m][n], 0, 0, 0); } } \
        __builtin_amdgcn_s_setprio(0); } while (0)
#define PG8_WAIT_V(n) asm volatile("s_waitcnt vmcnt(" #n ")" ::: "memory")
#define PG8_WAIT_L(n) asm volatile("s_waitcnt lgkmcnt(" #n ")" ::: "memory")
#define PG8_BAR __builtin_amdgcn_s_barrier()
#define PG8_SCHED __builtin_amdgcn_sched_barrier(0)
    Unit cur, nxt; int ui = 0;
    if (!S.next(0, cur)) return;
    if constexpr (MOE) {
        if (wid < 4) { const int ln_ = tid_of(wave_s) & 63; PG8_DMA4(E.bias_src(cur) + wid * 64 + ln_, LDSX_BIAS + wid * 256); if constexpr (GATHER) PG8_DMA4(cur.rows + wid * 64 + ln_, LDSX_IDX + wid * 256); }
        asm volatile("s_waitcnt vmcnt(0)" ::: "memory"); __builtin_amdgcn_s_barrier(); asm volatile("" ::: "memory");
    }
    if constexpr (GATHER) { PG8_GATHER_LOAD(Vc); }
    f32x4 acc[2][2][4][2];
#pragma unroll
    for (int a = 0; a < 2; ++a)
#pragma unroll
        for (int b = 0; b < 2; ++b)
#pragma unroll
            for (int m = 0; m < 4; ++m)
#pragma unroll
                for (int n = 0; n < 2; ++n) acc[a][b][m][n] = zero4();
    v8i32_t At[4], B0[2], B1[2];
    unsigned cA = cur.ao, cB = cur.bo;
    PG8_STAGE_B(PG8_SB(0, 0), cB); PG8_STAGE_B(PG8_SB(0, 1), cB + hstep); PG8_STAGE_A(PG8_SA(0, 0), cA, 0, Vc); PG8_STAGE_A(PG8_SA(0, 1), cA, 1, Vc);
    if (wr == 1) PG8_BAR;
    PG8_WAIT_V(2); PG8_BAR;
    PG8_STAGE_B(PG8_SB(1, 0), cB + kstep); PG8_STAGE_A(PG8_SA(1, 0), cA + kstep, 0, Vc); PG8_STAGE_B(PG8_SB(1, 1), cB + hstep + kstep);
    PG8_WAIT_V(6); PG8_BAR;
    for (;;) {
        { int _t = tid_of(wave_s); asm volatile("" : "+v"(_t)); int _R, _C; stage_rc(_t * 16, _R, _C);
#pragma unroll
          for (int i = 0; i < 2; ++i) voffB[i] = (unsigned)((_R + 64 * i) * K + _C) * 2u; }
        const bool has_next = S.next(ui + 1, nxt);
        const unsigned nA = has_next ? nxt.ao : cA; const unsigned nB = has_next ? nxt.bo : cB;
        if constexpr (MOE) {
            if (has_next && wid < 4) { const int ln_ = tid_of(wave_s) & 63;
                PG8_DMA4(E.bias_src(nxt) + wid * 64 + ln_, LDSX_BIAS + ((ui + 1) % 3) * 1024 + wid * 256); if constexpr (GATHER) PG8_DMA4(nxt.rows + wid * 64 + ln_, LDSX_IDX + wid * 256); }
        }
        PG8_LDB(B0, 0, 0);
#pragma unroll 1
        for (int t = 0; t < nt; t += 2) {
            const bool last = (t == nt - 2);
            const unsigned a1 = cA + (unsigned)(t + 1) * kstep;
            const unsigned a2 = last ? nA : cA + (unsigned)(t + 2) * kstep; const unsigned b2 = last ? nB : cB + (unsigned)(t + 2) * kstep;
            const unsigned a3 = a2 + kstep; const unsigned b3 = b2 + kstep;
            PG8_LDB(B1, 0, 1); PG8_SCHED; PG8_LDA(At, 0, 0); PG8_STAGE_A(PG8_SA(1, 1), a1, 1, Vc);
            if constexpr (GATHER) { if (last && has_next) { PG8_GATHER_LOAD(Vc); } }
            PG8_WAIT_V(6); PG8_WAIT_L(0); PG8_BAR; PG8_MMA(0, 0, At, B0); PG8_MMA(0, 1, At, B1); PG8_BAR; PG8_SCHED;
            PG8_LDA(At, 0, 1); PG8_STAGE_B(PG8_SB(0, 0), b2); PG8_STAGE_B(PG8_SB(0, 1), b2 + hstep); PG8_STAGE_A(PG8_SA(0, 0), a2, 0, Vc);
            PG8_WAIT_V(8); PG8_WAIT_L(0); PG8_BAR; PG8_MMA(1, 0, At, B0); PG8_SCHED; PG8_LDB(B0, 1, 0); PG8_SCHED; PG8_MMA(1, 1, At, B1); PG8_BAR; PG8_SCHED;
            PG8_LDB(B1, 1, 1); PG8_SCHED; PG8_LDA(At, 1, 0); PG8_STAGE_A(PG8_SA(0, 1), a2, 1, Vc);
            PG8_WAIT_V(6); PG8_WAIT_L(0); PG8_BAR; PG8_MMA(0, 0, At, B0); PG8_MMA(0, 1, At, B1); PG8_BAR; PG8_SCHED;
            PG8_LDA(At, 1, 1); PG8_STAGE_B(PG8_SB(1, 0), b3); PG8_STAGE_B(PG8_SB(1, 1), b3 + hstep); PG8_STAGE_A(PG8_SA(1, 0), a3, 0, Vc);
            PG8_WAIT_V(8); PG8_WAIT_L(0); PG8_BAR; PG8_MMA(1, 0, At, B0); PG8_SCHED; if (!last) { PG8_LDB(B0, 0, 0); } PG8_SCHED; PG8_MMA(1, 1, At, B1); PG8_BAR; PG8_SCHED;
        }
        typename Hook::State hst; H.pre(ui, wave_s, hst);
        if constexpr (ALIGN_EPI) { if (wr == 0) PG8_BAR; }
        { int t2 = tid_of(wave_s); asm volatile("" : "+v"(t2));
          if constexpr (MOE) { E(acc, cur, wr, wc, t2 & 15, (t2 & 63) >> 4, (const LAS float*)(lds + LDSX_BIAS + (ui % 3) * 1024));
              if (EPI_DUP) { asm volatile("" : "+v"(t2)); E(acc, cur, wr, wc, t2 & 15, (t2 & 63) >> 4, (const LAS float*)(lds + LDSX_BIAS + (ui % 3) * 1024)); } }
          else E(acc, cur, wr, wc, t2 & 15, (t2 & 63) >> 4); }
        H(ui, wave_s, hst);
        if (!has_next) break;
#pragma unroll
        for (int a = 0; a < 2; ++a)
#pragma unroll
            for (int b = 0; b < 2; ++b)
#pragma unroll
                for (int m = 0; m < 4; ++m)
#pragma unroll
                    for (int n = 0; n < 2; ++n) acc[a][b][m][n] = zero4();
        cur = nxt; cA = nA; cB = nB; ++ui;
        if constexpr (ALIGN_EPI) { if (wr == 1) PG8_BAR; }
    }
    PG8_WAIT_V(0);
    if constexpr (!ALIGN_EPI) { if (wr == 0) PG8_BAR; }
    PG8_BAR;
#undef PG8_SA
#undef PG8_SB
#undef PG8_SBR
#undef PG8_STAGE
#undef PG8_STAGE_A
#undef PG8_STAGE_B
#undef PG8_GATHER_LOAD
#undef PG8_DMA4
#undef PG8_LDA
#undef PG8_LDB
#undef PG8_LO
#undef PG8_HI
#undef PG8_MMA
#undef PG8_WAIT_V
#undef PG8_WAIT_L
#undef PG8_BAR
#undef PG8_SCHED
}

template <int ROWB>
struct SchedInProj {
    const char* A; const char* B; int G, c;
    __device__ __forceinline__ bool next(int i, Unit& u) const {
        constexpr int nM = T / BM, nN = INW / BM, nwg = nM * nN;
        const long L = (long)i * G + c; if (L >= nwg) return false;
        int wgid = (int)L; { const int q = nwg / NXCD, r = nwg % NXCD, xcd = wgid % NXCD, off = wgid / NXCD; wgid = (xcd < r ? xcd * (q + 1) : r * (q + 1) + (xcd - r) * q) + off; }
        const int nig = WGM * nN, gid = wgid / nig, fm = gid * WGM, gsz = (nM - fm) < WGM ? (nM - fm) : WGM;
        u.pm = fm + ((wgid % nig) % gsz); u.pn = (wgid % nig) / gsz; u.e = 0; u.rows = nullptr;
        u.ao = (unsigned)u.pm * (unsigned)(256 * ROWB); u.bo = (unsigned)u.pn * (unsigned)(256 * ROWB); return true;
    }
};
struct SchedPanel {
    const char* A; const char* B; int pm;
    __device__ __forceinline__ bool next(int i, Unit& u) const {
        if (i >= 4) return false;
        u.pm = pm; u.pn = i; u.e = 0; u.rows = nullptr; u.ao = (unsigned)pm * (unsigned)(256 * 1024); u.bo = (unsigned)i * (unsigned)(256 * 1024); return true;
    }
};
template <int NPN, bool G1>
struct SchedMoe {
    const char* A; const char* B; const LAS int* tile_e; const int* tok; int ntiles, G, c;
    __device__ __forceinline__ bool next(int i, Unit& u) const {
        const long L = (long)i * G + c; int t, pn;
        if ((G & 7) == 0) { const int x = (int)(L & 7); const long j = L >> 3; t = (int)(j / NPN) * 8 + x; pn = (int)(j % NPN); }
        else { t = (int)(L / NPN); pn = (int)(L % NPN); }
        if (t >= ntiles) return false;
        if (!G1) t = ntiles - 1 - t;
        const int e = __builtin_amdgcn_readfirstlane(tile_e[t]);
        u.pm = t; u.pn = pn; u.e = e;
        if (G1) { u.ao = 0u; u.rows = tok + (size_t)t * 256; u.bo = ((unsigned)e * 2048u + (unsigned)pn * 256u) * 1024u; }
        else { u.ao = (unsigned)t * (256u * 1024u); u.rows = nullptr; u.bo = ((unsigned)e * 1024u + (unsigned)pn * 256u) * 1024u; }
        return true;
    }
};

struct EpiInProj {
    bf16_t* qkv; const float* b_in; const float* rope; float descale;
    __device__ __forceinline__ void operator()(const f32x4 (&acc)[2][2][4][2], const Unit& u, int wr, int wc, int fr, int fq) const {
        const int pn = u.pn;
        const int colb = 256 * pn + 64 * wc + 8 * fq;
        const bool do_rope = !(pn >= 7 || (pn == 2 && wc >= 2));
        const bool is_q = (pn < 2) || (pn == 3) || (pn == 4);
        const float sc = is_q ? C2 : 1.0f;
        f32x4 bv[2][2];
#pragma unroll
        for (int bj = 0; bj < 2; ++bj)
#pragma unroll
            for (int n = 0; n < 2; ++n) bv[bj][n] = *(const f32x4*)(b_in + colb + 32 * bj + 4 * n);
        const int row0 = u.pm * 256 + wr * 64 + fr;
        f32x4 cb[2], sb[2], c16[2], s16[2], c128[2], s128[2];
        if (do_rope) {
            const float* rp = rope + (row0 & (SEQ - 1)) * 64 + 8 * fq; const float* r16 = rope + 16 * 64 + 8 * fq; const float* r128 = rope + 128 * 64 + 8 * fq;
#pragma unroll
            for (int n = 0; n < 2; ++n) { cb[n] = *(const f32x4*)(rp + 4 * n); sb[n] = *(const f32x4*)(rp + 32 + 4 * n); c16[n] = *(const f32x4*)(r16 + 4 * n); s16[n] = *(const f32x4*)(r16 + 32 + 4 * n);
                c128[n] = *(const f32x4*)(r128 + 4 * n); s128[n] = *(const f32x4*)(r128 + 32 + 4 * n); }
        } else {
#pragma unroll
            for (int n = 0; n < 2; ++n) { cb[n] = sb[n] = c16[n] = s16[n] = c128[n] = s128[n] = (f32x4){0.f, 0.f, 0.f, 0.f}; }
        }
        f32x4 cn[2], sn[2];
#pragma unroll
        for (int n = 0; n < 2; ++n) { cn[n] = cb[n] * c128[n] - sb[n] * s128[n]; sn[n] = sb[n] * c128[n] + cb[n] * s128[n]; }
#pragma unroll
        for (int ai = 0; ai < 2; ++ai) {
            f32x4 cc[2], ss[2];
#pragma unroll
            for (int n = 0; n < 2; ++n) { if (ai == 0) { cc[n] = cb[n]; ss[n] = sb[n]; } else { cc[n] = cn[n]; ss[n] = sn[n]; } }
#pragma unroll
            for (int m = 0; m < 4; ++m) {
                const int row = row0 + ai * 128 + m * 16;
                f32x4 o1[2], o2[2];
#pragma unroll
                for (int n = 0; n < 2; ++n) { o1[n] = acc[ai][0][m][n] * descale + bv[0][n]; o2[n] = acc[ai][1][m][n] * descale + bv[1][n]; }
                if (do_rope) {
#pragma unroll
                    for (int n = 0; n < 2; ++n) { const f32x4 a = o1[n], b = o2[n]; o1[n] = a * cc[n] - b * ss[n]; o2[n] = b * cc[n] + a * ss[n]; }
                    if (m < 3) {
#pragma unroll
                        for (int n = 0; n < 2; ++n) { const f32x4 c_ = cc[n], s_ = ss[n]; cc[n] = c_ * c16[n] - s_ * s16[n]; ss[n] = s_ * c16[n] + c_ * s16[n]; }
                    }
                }
                unsigned char* rowp = (unsigned char*)qkv + ((size_t)(row >> 4) * 36 + (size_t)(4 * pn + wc)) * 2048 + (size_t)(row & 15) * 16 + (size_t)fq * 256;
                u32x4 w1, w2;
                w1.x = cvtpk(o1[0][0] * sc, o1[0][1] * sc); w1.y = cvtpk(o1[0][2] * sc, o1[0][3] * sc); w1.z = cvtpk(o1[1][0] * sc, o1[1][1] * sc); w1.w = cvtpk(o1[1][2] * sc, o1[1][3] * sc);
                w2.x = cvtpk(o2[0][0] * sc, o2[0][1] * sc); w2.y = cvtpk(o2[0][2] * sc, o2[0][3] * sc); w2.z = cvtpk(o2[1][0] * sc, o2[1][1] * sc); w2.w = cvtpk(o2[1][2] * sc, o2[1][3] * sc);
                *(u32x4*)(rowp) = w1; *(u32x4*)(rowp + 1024) = w2;
            }
        }
    }
};
template <int BANK> __device__ __forceinline__ u32x4 ror8sel(u32x4 old, u32x4 src) { u32x4 r;
#pragma unroll
    for (int c = 0; c < 4; ++c) r[c] = (unsigned)__builtin_amdgcn_update_dpp((int)old[c], (int)src[c], 0x128  , 0xF, BANK, false);
    return r; }
template <int BANK> __device__ __forceinline__ f32x4 ror8sel(f32x4 old, f32x4 src) { return __builtin_bit_cast(f32x4, ror8sel<BANK>(__builtin_bit_cast(u32x4, old), __builtin_bit_cast(u32x4, src))); }
struct EpiOutProj {
    bf16_t* y;
    __device__ __forceinline__ void operator()(const f32x4 (&acc)[2][2][4][2], const Unit& u, int wr, int wc, int fr, int fq) const {
        const int colw = u.pn * 256 + wc * 64 + 8 * fq;
        const int fr8 = fr & 7, hs = fr >> 3;
        bf16_t* yl = y + (size_t)(u.pm * 256 + wr * 64 + fr8) * D + colw + 32 * hs;
#pragma unroll
        for (int ai = 0; ai < 2; ++ai) {
            u32x4 YA[4], YB[4];
#pragma unroll
            for (int m = 0; m < 4; ++m) { const size_t ro = (size_t)(ai * 128 + m * 16) * D; YA[m] = *(const u32x4*)(yl + ro); YB[m] = *(const u32x4*)(yl + ro + 8 * D); }
            asm volatile("" ::: "memory");
#pragma unroll
            for (int m = 0; m < 4; ++m) {
                const size_t ro = (size_t)(ai * 128 + m * 16) * D;
                u32x4 y0[2]; y0[0] = ror8sel<0xC>(YA[m], YB[m]); y0[1] = ror8sel<0x3>(YB[m], YA[m]);
                u32x4 w[2];
#pragma unroll
                for (int bj = 0; bj < 2; ++bj) {
                    const f32x4 r0 = {bf2f(y0[bj].x & 0xffffu), bf2f(y0[bj].x >> 16), bf2f(y0[bj].y & 0xffffu), bf2f(y0[bj].y >> 16)}, r1 = {bf2f(y0[bj].z & 0xffffu), bf2f(y0[bj].z >> 16), bf2f(y0[bj].w & 0xffffu), bf2f(y0[bj].w >> 16)};
                    const f32x4 v0 = acc[ai][bj][m][0] * (KPF / (W_SCALE * AO_SCALE)) + r0, v1 = acc[ai][bj][m][1] * (KPF / (W_SCALE * AO_SCALE)) + r1;
                    w[bj].x = cvtpk(v0[0], v0[1]); w[bj].y = cvtpk(v0[2], v0[3]); w[bj].z = cvtpk(v1[0], v1[1]); w[bj].w = cvtpk(v1[2], v1[3]); }
                *(u32x4*)(yl + ro) = ror8sel<0xC>(w[0], w[1]); *(u32x4*)(yl + ro + 8 * D) = ror8sel<0x3>(w[1], w[0]);
            }
            asm volatile("" ::: "memory");
        }
    }
};
struct EpiSwiglu {
    unsigned char* act8; const float* b1;
    __device__ __forceinline__ const float* bias_src(const Unit& u) const { return b1 + (size_t)u.e * 2048 + 256 * u.pn; }
    __device__ __forceinline__ void operator()(const f32x4 (&acc)[2][2][4][2], const Unit& u, int wr, int wc, int fr, int fq, const LAS float* bias) const {
        const int a0 = 128 * u.pn + 32 * wc + 8 * fq;
        const LAS float* bp = bias + 2 * (32 * wc + 8 * fq);
        f32x4 bb[4];
#pragma unroll
        for (int q = 0; q < 4; ++q) bb[q] = *(const LAS f32x4*)(bp + 4 * q);
        f32x2 bg[2][2], bl[2][2];
#pragma unroll
        for (int n = 0; n < 2; ++n)
#pragma unroll
            for (int jp = 0; jp < 2; ++jp) { bg[n][jp] = (f32x2){bb[2 * n + jp][0], bb[2 * n + jp][2]}; bl[n][jp] = (f32x2){bb[2 * n + jp][1], bb[2 * n + jp][3]}; }
        unsigned char* tile = act8 + (size_t)u.pm * (256 * 1024);
#pragma unroll
        for (int ai = 0; ai < 2; ++ai)
#pragma unroll
            for (int m = 0; m < 4; ++m) {
                const int row = ai * 128 + wr * 64 + m * 16 + fr;
                f32x2 r[2][2];
#pragma unroll
                for (int n = 0; n < 2; ++n)
#pragma unroll
                    for (int jp = 0; jp < 2; ++jp) {
                        const f32x2 ag = {acc[ai][0][m][n][2 * jp], acc[ai][0][m][n][2 * jp + 1]}, al = {acc[ai][1][m][n][2 * jp], acc[ai][1][m][n][2 * jp + 1]};
                        f32x2 g = ag * (KPF / W_SCALE) + bg[n][jp], l = al * (KPF / W_SCALE) + bl[n][jp];
                        g.x = fminf(g.x, 7.0f); g.y = fminf(g.y, 7.0f);
                        l.x = __builtin_amdgcn_fmed3f(l.x, -7.0f, 7.0f); l.y = __builtin_amdgcn_fmed3f(l.y, -7.0f, 7.0f);
                        const f32x2 uarg = g * (-1.702f * LOG2E);
                        f32x2 t; t.x = __builtin_amdgcn_exp2f(uarg.x); t.y = __builtin_amdgcn_exp2f(uarg.y);
                        const f32x2 d = t + 1.0f;
                        f32x2 sg; sg.x = __builtin_amdgcn_rcpf(d.x); sg.y = __builtin_amdgcn_rcpf(d.y);
                        const f32x2 lf = l * ACT_SCALE + ACT_SCALE;
                        r[n][jp] = (g * sg) * lf;
                    }
                u32x2 w; w.x = pk4_fp8(r[0][0].x, r[0][0].y, r[0][1].x, r[0][1].y); w.y = pk4_fp8(r[1][0].x, r[1][0].y, r[1][1].x, r[1][1].y);
                *(u32x2*)(tile + (size_t)row * 1024 + (size_t)a0) = w;
            }
    }
};
struct EpiDown {
    unsigned char* yb; const float* b2;
    __device__ __forceinline__ const float* bias_src(const Unit& u) const { return b2 + (size_t)u.e * 1024 + 256 * u.pn; }
    __device__ __forceinline__ void operator()(const f32x4 (&acc)[2][2][4][2], const Unit& u, int wr, int wc, int fr, int fq, const LAS float* bias) const {
        const int col0 = u.pn * 256 + wc * 64 + 16 * fq;
        const LAS float* bp = bias + wc * 64 + 16 * fq;
        f32x4 bv[2][2];
#pragma unroll
        for (int bj = 0; bj < 2; ++bj)
#pragma unroll
            for (int n = 0; n < 2; ++n) bv[bj][n] = *(const LAS f32x4*)(bp + 8 * bj + 4 * n) * Y_SCALE;
#pragma unroll
        for (int ai = 0; ai < 2; ++ai)
#pragma unroll
            for (int m = 0; m < 4; ++m) {
                unsigned char* rowp = yb + (size_t)(u.pm * 256 + ai * 128 + wr * 64 + m * 16 + fr) * 1024 + col0;
                u32x4 w;
#pragma unroll
                for (int bj = 0; bj < 2; ++bj)
#pragma unroll
                    for (int n = 0; n < 2; ++n) { const f32x4 v = acc[ai][bj][m][n] * (KPF * Y_SCALE / (W_SCALE * ACT_SCALE)) + bv[bj][n]; w[2 * bj + n] = pk4_fp8(v[0], v[1], v[2], v[3]); }
                *(u32x4*)rowp = w;
            }
    }
};
}

__device__ __forceinline__ void y0_load(const float* __restrict__ x, long xi, int lane, f32x4 (&xv)[16]) {
    const f32x4* src = (const f32x4*)(x + (size_t)xi * 4096) + lane;
#pragma unroll
    for (int q = 0; q < 16; ++q) xv[q] = __builtin_nontemporal_load(src + q * 64);
}
__device__ __forceinline__ void y0_store(bf16_t* __restrict__ y, const float* __restrict__ b_out, long xi, int lane, const f32x4 (&xv)[16]) {
    f32x4 b4[4];
#pragma unroll
    for (int c = 0; c < 4; ++c) b4[c] = *(const f32x4*)(b_out + 256 * c + 4 * lane);
#pragma unroll
    for (int q = 0; q < 16; ++q) { const f32x4 v = xv[q] * DN_ALPHA + b4[q & 3];
        u32x2 w; w.x = cvtpk(v[0], v[1]); w.y = cvtpk(v[2], v[3]);
        *(u32x2*)(y + ((size_t)xi * 4 + (q >> 2)) * 1024 + 256 * (q & 3) + 4 * lane) = w; }
}
template <int CW> __device__ __forceinline__ void cvt_load(const float* __restrict__ W, int N, int item, int lane, f32x4 (&v)[16]);
template <int CW> __device__ __forceinline__ void cvt_store(unsigned char* __restrict__ WT, int N, int mode, float scale, int item, int lane, const f32x4 (&v)[16]);
namespace att {
constexpr int PITCH = INW, SLOTB = 8192;
constexpr size_t QKV_RB = 36 * 2048;
__device__ __forceinline__ size_t qkv_tile(long rb16, int u) { return (size_t)rb16 * QKV_RB + (size_t)u * 2048; }
constexpr int NSLOT = 4;
constexpr int L_K = 0, L_V = NSLOT * SLOTB, L_WS = 2 * NSLOT * SLOTB, L_KS = L_WS + 2048, L_OST = L_KS + 2048, L_END = L_OST + 8 * 4096;
static_assert(NSLOT == 4 && L_END <= 131072, "attention LDS map");
constexpr float NEG = -1.0e30f, M0 = -1.0e20f, THR = 8.0f;
typedef LAS const char* lds_cptr;
__device__ __forceinline__ int crow(int r, int hi) { return (r & 3) + 8 * (r >> 2) + 4 * hi; }
__device__ __forceinline__ void glds16(const void* gsrc, unsigned lds_dst) { unsigned keep;
    asm volatile("s_mov_b32 %0, m0\n\ts_mov_b32 m0, %2\n\ts_nop 0\n\tglobal_load_lds_dwordx4 %1, off\n\ts_mov_b32 m0, %0" : "=&s"(keep) : "v"(gsrc), "s"(lds_dst) : "memory"); }
__device__ __forceinline__ void glds16s(unsigned voff, const void* sbase, unsigned lds_dst) { unsigned keep;
    asm volatile("s_mov_b32 %0, m0\n\ts_mov_b32 m0, %3\n\ts_nop 0\n\tglobal_load_lds_dwordx4 %1, %2\n\ts_mov_b32 m0, %0" : "=&s"(keep) : "v"(voff), "s"(sbase), "s"(lds_dst) : "memory"); }
#define ATT_WAIT_BAR0() asm volatile("s_waitcnt vmcnt(0) lgkmcnt(0)\n\ts_barrier" ::: "memory")
#define ATT_WAIT_BARN(N) asm volatile("s_waitcnt vmcnt(" #N ") lgkmcnt(0)\n\ts_barrier" ::: "memory")
#define ATT_SBAR() __builtin_amdgcn_sched_barrier(0)

__device__ __forceinline__ void qkt(f32x16& p0, f32x16& p1, lds_cptr kb, const bf16x8* qr, const f32x16& negm) {
#pragma unroll
    for (int d0 = 0; d0 < 4; ++d0) {
        const bf16x8 b0 = *(const LAS bf16x8*)(kb + d0 * 2048);
        const bf16x8 b1 = *(const LAS bf16x8*)(kb + d0 * 2048 + 512);
        if (d0 == 0) { p0 = __builtin_amdgcn_mfma_f32_32x32x16_bf16(b0, qr[0], negm, 0, 0, 0); p1 = __builtin_amdgcn_mfma_f32_32x32x16_bf16(b1, qr[0], negm, 0, 0, 0); }
        else { p0 = __builtin_amdgcn_mfma_f32_32x32x16_bf16(b0, qr[d0], p0, 0, 0, 0); p1 = __builtin_amdgcn_mfma_f32_32x32x16_bf16(b1, qr[d0], p1, 0, 0, 0); }
    }
}
__device__ __forceinline__ float rowmax32(const f32x16& p0, const f32x16& p1) {
    float a = fmaxf(p0[0], p1[0]);
#pragma unroll
    for (int r = 1; r < 16; ++r) a = fmaxf(a, fmaxf(p0[r], p1[r]));
    auto rr = __builtin_amdgcn_permlane32_swap(__float_as_uint(a), __float_as_uint(a), false, false);
    return fmaxf(__uint_as_float(rr[0]), __uint_as_float(rr[1]));
}
__device__ __forceinline__ void pv(f32x16* o, int vb, bf16x8 pa0, bf16x8 pa1, bf16x8 pa2, bf16x8 pa3) {
#pragma unroll
    for (int d0 = 0; d0 < 2; ++d0) { s16x4 lo[4], hi[4];
#pragma unroll
        for (int ks = 0; ks < 4; ++ks) {
            asm volatile("ds_read_b64_tr_b16 %0,%1 offset:%c2" : "=&v"(lo[ks]) : "v"(vb), "i"(d0 * 4096 + ks * 1024) : "memory");
            asm volatile("ds_read_b64_tr_b16 %0,%1 offset:%c2" : "=&v"(hi[ks]) : "v"(vb), "i"(d0 * 4096 + ks * 1024 + 512) : "memory"); }
        asm volatile("s_waitcnt lgkmcnt(0)" ::: "memory"); ATT_SBAR();
#define ATT_PK(k) (bf16x8){lo[k][0], lo[k][1], lo[k][2], lo[k][3], hi[k][0], hi[k][1], hi[k][2], hi[k][3]}
        o[d0] = __builtin_amdgcn_mfma_f32_32x32x16_bf16(pa0, ATT_PK(0), o[d0], 0, 0, 0);
        o[d0] = __builtin_amdgcn_mfma_f32_32x32x16_bf16(pa1, ATT_PK(1), o[d0], 0, 0, 0);
        o[d0] = __builtin_amdgcn_mfma_f32_32x32x16_bf16(pa2, ATT_PK(2), o[d0], 0, 0, 0);
        o[d0] = __builtin_amdgcn_mfma_f32_32x32x16_bf16(pa3, ATT_PK(3), o[d0], 0, 0, 0);
#undef ATT_PK
    }
}

__device__ __forceinline__ void swa_stream(LAS char* shm, const bf16_t* __restrict__ qkv, unsigned char* __restrict__ aout, int b, int hh, int qb0, int nqb, const float* __restrict__ sinks, const int wave_s, const float* __restrict__ rx, const float* __restrict__ rb, bf16_t* __restrict__ ry, const long xi0) {
    int tid = tid_of(wave_s); asm volatile("" : "+v"(tid));
    const int lane = tid & 63, r32 = lane & 31, hi = lane >> 5; const int wid = wave_s;
    const long rowbase = (long)b * SEQ;
    const bool xon = xi0 >= 0;
    const int g = wid >> 1, qcol = (4 * hh + g) * 64, kcol = 512 + 64 * hh, vcol = 640 + 64 * hh;
    const unsigned char* const qkv8 = (const unsigned char*)qkv; const long rb0 = rowbase >> 4; (void)kcol; (void)vcol;
    const unsigned lds0 = (unsigned)(uintptr_t)shm;
    LAS float* wsf = (LAS float*)(shm + L_WS) + wid * 64;
    const unsigned koff = (unsigned)((lane >> 4) * (int)QKV_RB + (lane & 15) * 16);
    const unsigned voff = (unsigned)((lane & 3) * 256 + (lane >> 2) * 16);
    const unsigned kdst = lds0 + L_K + wid * 1024, vdst = lds0 + L_V + wid * 1024;
#define SW_DMA(t) do { const unsigned sl_ = (unsigned)(((t) & (NSLOT - 1)) * SLOTB); \
        glds16s(koff, qkv8 + qkv_tile(rb0 + 4 * (long)(t), 8 + hh) + wid * 256, (unsigned)__builtin_amdgcn_readfirstlane(kdst + sl_)); \
        glds16s(voff, qkv8 + qkv_tile(rb0 + 4 * (long)(t) + (wid & 3), 10 + hh) + (wid >> 2) * 1024, (unsigned)__builtin_amdgcn_readfirstlane(vdst + sl_)); } while (0)
    const int vb0 = (int)(lds0 + L_V) + ((lane >> 4) & 1) * 32 + (lane & 3) * 8 + (4 * hi + ((lane & 15) >> 2)) * 64;
    const lds_cptr kp0 = (lds_cptr)shm + L_K + hi * 1024 + r32 * 16;
    const float sink2 = sinks[4 * hh + g] * LOG2E;
    const int qend = qb0 + nqb;
    for (int kt = (qb0 - 2 < 0 ? 0 : qb0 - 2); kt <= qb0; ++kt) SW_DMA(kt);
    const unsigned char* Qb = qkv8 + qkv_tile(rb0 + 2 * (wid & 1) + (r32 >> 4), 4 * hh + g) + hi * 256 + (r32 & 15) * 16; (void)qcol;
    bf16x8 qn[4];
#pragma unroll
    for (int d0 = 0; d0 < 4; ++d0) qn[d0] = *reinterpret_cast<const bf16x8*>(Qb + (size_t)qb0 * 4 * QKV_RB + d0 * 512);
    ATT_WAIT_BAR0();
    for (int qb = qb0; qb < qend; ++qb) {
        const int qa = 64 * qb + 32 * (wid & 1);
        if (qb + 1 < qend) SW_DMA(qb + 1);
        bf16x8 qr[4];
#pragma unroll
        for (int d0 = 0; d0 < 4; ++d0) qr[d0] = qn[d0];
        if (qb + 1 < qend) {
#pragma unroll
            for (int d0 = 0; d0 < 4; ++d0) qn[d0] = *reinterpret_cast<const bf16x8*>(Qb + (size_t)(qb + 1) * 4 * QKV_RB + d0 * 512);
        }
        float m_run = sink2, l_run = (hi == 0) ? 1.0f : 0.0f;
        f32x16 negm, o[2];
        { float zf = 0.f; asm volatile("" : "+v"(zf));
#pragma unroll
          for (int r = 0; r < 16; ++r) { o[0][r] = zf; o[1][r] = zf; negm[r] = -m_run; } }
        f32x4 xv[16];
        if (xon) { int t_ = tid_of(wave_s); asm volatile("" : "+v"(t_)); y0_load(rx, xi0 + (qb - qb0), t_ & 63, xv); }
        for (int kt = (qb - 2 < 0 ? 0 : qb - 2); kt <= qb; ++kt) {
            const int cur = (kt & (NSLOT - 1)) * SLOTB;
            f32x16 p0, p1; qkt(p0, p1, kp0 + cur, qr, negm);
            const bool edge = !((64 * kt + 63 <= qa) && (qa + 31 - 64 * kt <= 127));
            if (edge) {
                const int dq = qa + r32 - 64 * kt - 4 * hi;
#pragma unroll
                for (int r = 0; r < 16; ++r) { const int d0_ = dq - ((r & 3) + 8 * (r >> 2)), d1_ = d0_ - 32;
                    p0[r] = ((unsigned)d0_ < 128u) ? p0[r] : NEG; p1[r] = ((unsigned)d1_ < 128u) ? p1[r] : NEG; }
            }
            const float rm = rowmax32(p0, p1);
            if (__any(rm > THR)) {
                const float dl = fmaxf(rm, 0.f);
                const float f = __builtin_amdgcn_exp2f(-dl);
                m_run += dl;
#pragma unroll
                for (int r = 0; r < 16; ++r) { p0[r] -= dl; p1[r] -= dl; negm[r] = -m_run; }
                l_run *= f;
                if (hi == 0) wsf[r32] = f;
                LDS_WAIT();
#pragma unroll
                for (int r = 0; r < 16; ++r) { const float fr_ = wsf[crow(r, hi)]; o[0][r] *= fr_; o[1][r] *= fr_; }
            }
            float sacc = 0.f;
#pragma unroll
            for (int r = 0; r < 16; ++r) { p0[r] = __builtin_amdgcn_exp2f(p0[r]); p1[r] = __builtin_amdgcn_exp2f(p1[r]); sacc += p0[r] + p1[r]; }
            l_run += sacc;
            u32x4 pw0, pw1, pw2, pw3;
            pw0 = (u32x4){cvtpk(p0[0], p0[1]), cvtpk(p0[2], p0[3]), cvtpk(p0[4], p0[5]), cvtpk(p0[6], p0[7])};
            pw1 = (u32x4){cvtpk(p0[8], p0[9]), cvtpk(p0[10], p0[11]), cvtpk(p0[12], p0[13]), cvtpk(p0[14], p0[15])};
            pw2 = (u32x4){cvtpk(p1[0], p1[1]), cvtpk(p1[2], p1[3]), cvtpk(p1[4], p1[5]), cvtpk(p1[6], p1[7])};
            pw3 = (u32x4){cvtpk(p1[8], p1[9]), cvtpk(p1[10], p1[11]), cvtpk(p1[12], p1[13]), cvtpk(p1[14], p1[15])};
            ATT_SBAR();
            pv(o, vb0 + cur, __builtin_bit_cast(bf16x8, pw0), __builtin_bit_cast(bf16x8, pw1), __builtin_bit_cast(bf16x8, pw2), __builtin_bit_cast(bf16x8, pw3));
        }
        { auto rr = __builtin_amdgcn_permlane32_swap(__float_as_uint(l_run), __float_as_uint(l_run), false, false); l_run = __uint_as_float(rr[0]) + __uint_as_float(rr[1]); }
        if (hi == 0) wsf[32 + r32] = l_run;
        LDS_WAIT();
        float rli[16];
#pragma unroll
        for (int r = 0; r < 16; ++r) rli[r] = __builtin_amdgcn_rcpf(wsf[32 + crow(r, hi)]);
        unsigned char* Ow = aout + (rowbase + qa) * D + qcol;
        { LAS unsigned char* stg = (LAS unsigned char*)(shm + L_OST) + wid * 2048;
#pragma unroll
            for (int r = 0; r < 16; ++r) { const int orow = crow(r, hi);
#pragma unroll
                for (int d0 = 0; d0 < 2; ++d0) { const float v = o[d0][r] * rli[r] * AO_SCALE; stg[orow * 64 + d0 * 32 + r32] = (unsigned char)__builtin_amdgcn_cvt_pk_fp8_f32(v, v, 0, false); } }
            LDS_WAIT();
#pragma unroll
            for (int i = 0; i < 2; ++i) { const int row = i * 16 + (lane >> 2), ch = lane & 3; const u32x4 v = *(const LAS u32x4*)(stg + row * 64 + ch * 16); *(u32x4*)(Ow + (long)row * D + ch * 16) = v; } }
        if (xon) { int t_ = tid_of(wave_s); asm volatile("" : "+v"(t_)); y0_store(ry, rb, xi0 + (qb - qb0), t_ & 63, xv);
            ATT_WAIT_BARN(42); }
        else { ATT_WAIT_BAR0(); }
    }
#undef SW_DMA
}

constexpr int MK_K = 0, MK_V = 3 * SLOTB, MK_WS = 6 * SLOTB, MK_OST = MK_WS + 8 * 256, MK_KS = MK_OST + 8 * 4096, MK_END = MK_KS + 2048;
constexpr float NEGB = -1.0e30f;
__device__ __forceinline__ float max3f(float a, float b, float c) { float r; asm("v_max3_f32 %0, %1, %2, %3" : "=v"(r) : "v"(a), "v"(b), "v"(c)); return r; }
__device__ __forceinline__ float max2f(float a, float b) { float r; asm("v_max_f32_e32 %0, %1, %2" : "=v"(r) : "v"(a), "v"(b)); return r; }
__device__ __forceinline__ float fadd_s(float a, float b) { float r; asm("v_add_f32_e32 %0, %1, %2" : "=v"(r) : "v"(a), "v"(b)); return r; }
__device__ __forceinline__ float fsub_s(float a, float b) { float r; asm("v_sub_f32_e32 %0, %1, %2" : "=v"(r) : "v"(a), "v"(b)); return r; }
typedef short v4i16_t __attribute__((ext_vector_type(4)));
#define MK_WAIT_BAR(N) asm volatile("s_waitcnt vmcnt(" #N ") lgkmcnt(0)\n\ts_barrier" ::: "memory")
__device__ __forceinline__ void kload8(bf16x8* kf, lds_cptr kp) {
    kf[0] = *(const LAS bf16x8*)(kp);        kf[1] = *(const LAS bf16x8*)(kp + 512);
    kf[2] = *(const LAS bf16x8*)(kp + 2048); kf[3] = *(const LAS bf16x8*)(kp + 2560);
    kf[4] = *(const LAS bf16x8*)(kp + 4096); kf[5] = *(const LAS bf16x8*)(kp + 4608);
    kf[6] = *(const LAS bf16x8*)(kp + 6144); kf[7] = *(const LAS bf16x8*)(kp + 6656);
}
__device__ __forceinline__ void kload2(bf16x8* kf, lds_cptr kp, int j) { kf[2 * j] = *(const LAS bf16x8*)(kp + j * 2048); kf[2 * j + 1] = *(const LAS bf16x8*)(kp + j * 2048 + 512); }
__device__ __forceinline__ s16x4 vtr(lds_cptr p) { return __builtin_bit_cast(s16x4, __builtin_amdgcn_ds_read_tr16_b64_v4i16((LAS v4i16_t*)p)); }
__device__ __forceinline__ float rowmax_a(const f32x16& p0, const f32x16& p1) {
    float a = max3f(p0[0], p0[1], p1[0]), b = max3f(p0[2], p0[3], p1[1]); a = max3f(a, p1[2], p1[3]);
#pragma unroll
    for (int r = 4; r < 16; r += 4) { a = max3f(a, p0[r], p0[r + 1]); b = max3f(b, p0[r + 2], p0[r + 3]); a = max3f(a, p1[r], p1[r + 1]); b = max3f(b, p1[r + 2], p1[r + 3]); }
    const float m = max2f(a, b);
    auto rr = __builtin_amdgcn_permlane32_swap(__float_as_uint(m), __float_as_uint(m), false, false);
    return max2f(__uint_as_float(rr[0]), __uint_as_float(rr[1]));
}
__device__ __forceinline__ void cmask(f32x16& p0, f32x16& p1, int jb, int qrel, int hi) {
    const float NEGI = -INFINITY; const int kb = 64 * jb + 4 * hi;
#pragma unroll
    for (int r = 0; r < 16; ++r) { const int kv = kb + (r & 3) + 8 * (r >> 2); if (kv > qrel) p0[r] = NEGI; if (kv + 32 > qrel) p1[r] = NEGI; }
}


__device__ __forceinline__ void moba_ksums(const bf16_t* __restrict__ qkv, int b, int h, LAS char* shm, const int wave_s) {
    int tid = tid_of(wave_s); asm volatile("" : "+v"(tid));
    const int lane = tid & 63;
    if (wave_s < 7) {
        const unsigned char* base = (const unsigned char*)qkv + qkv_tile((((long)b * SEQ + 256 * wave_s) >> 4), 20 + h) + (lane & 7) * 256 + (lane >> 3) * 16;
        float a[8];
#pragma unroll
        for (int j = 0; j < 8; ++j) a[j] = 0.f;
#pragma unroll 8
        for (int i = 0; i < 32; ++i) { const u32x4 v = *(const u32x4*)(base + (size_t)(i >> 1) * QKV_RB + (i & 1) * 128);
#pragma unroll
            for (int q = 0; q < 4; ++q) { a[2 * q] += bf2f(v[q] & 0xffffu); a[2 * q + 1] += bf2f(v[q] >> 16); } }
#pragma unroll
        for (int j = 0; j < 8; ++j) { a[j] += swz_xor<8>(a[j]); a[j] += swz_xor<16>(a[j]);
            auto rr = __builtin_amdgcn_permlane32_swap(__float_as_uint(a[j]), __float_as_uint(a[j]), false, false); a[j] = __uint_as_float(rr[0]) + __uint_as_float(rr[1]); }
        if (lane < 8) { LAS float* ksl = (LAS float*)(shm + MK_KS) + wave_s * 64 + 8 * lane;
            *(LAS f32x4*)(ksl) = (f32x4){a[0], a[1], a[2], a[3]}; *(LAS f32x4*)(ksl + 4) = (f32x4){a[4], a[5], a[6], a[7]}; }
    }
    asm volatile("s_waitcnt lgkmcnt(0)" ::: "memory"); __builtin_amdgcn_s_barrier(); asm volatile("" ::: "memory");
}
template <int THRL>
__device__ __forceinline__ void moba_unit(int b, int h, int qb, const bf16_t* __restrict__ qkv, unsigned char* __restrict__ aout, LAS char* shm, const int wave_s, const bool pre, const bool nxt, bf16x8 (&qpre)[4], const float* cw1, unsigned char* cw1_8, const int cit) {
    int tid = tid_of(wave_s); asm volatile("" : "+v"(tid));
    const int lane = tid & 63, r32 = lane & 31, hi = lane >> 5; const int wid = __builtin_amdgcn_readfirstlane(tid >> 6);
    const long rowbase = (long)b * SEQ; const int q0 = qb * 256;
    const unsigned char* const qkv8 = (const unsigned char*)qkv; const long rb0 = rowbase >> 4;
    const unsigned char* Qw = qkv8 + qkv_tile(rb0 + (q0 >> 4) + 2 * wid + (r32 >> 4), 12 + h) + hi * 256 + (r32 & 15) * 16;
    const unsigned lds0 = (unsigned)(uintptr_t)shm;
    LAS float* wsf = (LAS float*)(shm + MK_WS) + wid * 64;
    const unsigned koff = (unsigned)((lane >> 4) * (int)QKV_RB + (lane & 15) * 16);
    const unsigned voff = (unsigned)((lane & 3) * 256 + (lane >> 2) * 16);
    const unsigned kdst = lds0 + MK_K + wid * 1024, vdst = lds0 + MK_V + wid * 1024;
#define DMA_K(t, slot) glds16s(koff, qkv8 + qkv_tile(rb0 + 4 * (long)(t), 20 + h) + wid * 256, (unsigned)__builtin_amdgcn_readfirstlane(kdst + (slot)))
#define DMA_V(t, slot) glds16s(voff, qkv8 + qkv_tile(rb0 + 4 * (long)(t) + (wid & 3), 28 + h) + (wid >> 2) * 1024, (unsigned)__builtin_amdgcn_readfirstlane(vdst + (slot)))
    bf16x8 kf[8];
    const lds_cptr shm3 = (lds_cptr)shm; const lds_cptr kp0 = shm3 + MK_K + hi * 1024 + r32 * 16; const lds_cptr vp0 = shm3 + MK_V + ((lane >> 4) & 1) * 32 + (lane & 3) * 8 + (4 * hi + ((lane & 15) >> 2)) * 64;
    const int NT = (q0 + 256) / 64;
    if (!pre) { DMA_K(0, 0); DMA_K(1, SLOTB); DMA_K(2, 2 * SLOTB); }
    bf16x8 qr[4];
    if (!pre) {
#pragma unroll
        for (int d0 = 0; d0 < 4; ++d0) qr[d0] = *reinterpret_cast<const bf16x8*>(Qw + d0 * 512);
    } else {
#pragma unroll
        for (int d0 = 0; d0 < 4; ++d0) qr[d0] = qpre[d0];
    }
    DMA_V(0, 0);
    float mhat = 0.f, l_reg = 0.f; f32x16 o[2], negm;
    { float zf = 0.f; asm volatile("" : "+v"(zf));
#pragma unroll
      for (int r = 0; r < 16; ++r) { o[0][r] = zf; o[1][r] = zf; negm[r] = zf; } }
    asm volatile("" : "+v"(negm));
    const int qrel = wid * 32 + r32;
#define CMASK(P0, P1, t) do { int jb_ = (t) - (NT - 4); if (jb_ >= 0) cmask(P0, P1, jb_, qrel, hi); } while (0)
    bool resc = false;
#define START(P0, P1) do { const float rm = rowmax_a(P0, P1); resc = false; \
    { const float dl = (rm > 0.1f * NEGB) ? rm : 0.f;      mhat = fadd_s(mhat, dl); \
      _Pragma("unroll") for (int r = 0; r < 16; ++r) { P0[r] = fsub_s(P0[r], dl); P1[r] = fsub_s(P1[r], dl); } \
      const float nm_ = ONB(1) ? -mhat : NEGB; \
      _Pragma("unroll") for (int r = 0; r < 16; ++r) negm[r] = nm_; asm volatile("" : "+v"(negm)); } \
    _Pragma("unroll") for (int r = 0; r < 16; ++r) P0[r] = __builtin_amdgcn_exp2f(P0[r]); } while (0)
#define RESC() do { if (resc) { asm volatile("s_waitcnt lgkmcnt(0)" ::: "memory"); \
      _Pragma("unroll") for (int d_ = 0; d_ < 2; ++d_) _Pragma("unroll") for (int r = 0; r < 16; ++r) o[d_][r] *= wsf[crow(r, hi)]; } } while (0)
    f32x16 pA0, pA1, pB0, pB1;
    int sl_prev = 0, sl_cur = 0, sl_next = SLOTB;
#define ROT() do { sl_prev = sl_cur; sl_cur = sl_next; sl_next = (sl_next == 2 * SLOTB) ? 0 : sl_next + SLOTB; } while (0)
    MK_WAIT_BAR(1);
    unsigned sel = 0u;
    if (qb <= 3) sel = (1u << qb) - 1u;
    else {
        const LAS float* ksl = (const LAS float*)(shm + MK_KS);
        float gv[7];
#pragma unroll
        for (int i = 0; i < 7; ++i) {
            float s = 0.f;
#pragma unroll
            for (int d0 = 0; d0 < 4; ++d0) {
                const f32x4 k0 = *(const LAS f32x4*)(ksl + i * 64 + 16 * d0 + 8 * hi), k1 = *(const LAS f32x4*)(ksl + i * 64 + 16 * d0 + 8 * hi + 4);
#pragma unroll
                for (int jj = 0; jj < 4; ++jj) { s += bf2f((unsigned short)qr[d0][jj]) * k0[jj]; s += bf2f((unsigned short)qr[d0][4 + jj]) * k1[jj]; }
            }
            auto rr = __builtin_amdgcn_permlane32_swap(__float_as_uint(s), __float_as_uint(s), false, false);
            s = __uint_as_float(rr[0]) + __uint_as_float(rr[1]);
            gv[i] = (i < qb) ? s : -INFINITY;
        }
#pragma unroll
        for (int rk = 0; rk < 3; ++rk) { float best = -INFINITY; int bi = 0;
#pragma unroll
            for (int i = 0; i < 7; ++i) { const bool c = (((sel >> i) & 1u) == 0u) && (gv[i] > best); best = c ? gv[i] : best; bi = c ? i : bi; }
            sel |= 1u << bi; }
    }
#define ONB(tt) (((tt) >= NT - 4) ? true : (((sel >> ((tt) >> 2)) & 1u) != 0u))
#define SETNEGM(tt) do { const float nm_ = ONB(tt) ? -mhat : NEGB; _Pragma("unroll") for (int r = 0; r < 16; ++r) negm[r] = nm_; asm volatile("" : "+v"(negm)); } while (0)
    SETNEGM(0);
    qkt(pA0, pA1, kp0, qr, negm); asm volatile("s_nop 15\n\ts_nop 7" : "+v"(pA0), "+v"(pA1)); CMASK(pA0, pA1, 0);
    START(pA0, pA1);
    _Pragma("unroll") for (int r = 0; r < 16; ++r) pA1[r] = __builtin_amdgcn_exp2f(pA1[r]);
    MK_WAIT_BAR(0);
    DMA_K(3, 0); DMA_V(1, SLOTB);
    ROT();
    kload8(kf, kp0 + sl_cur);
    MK_WAIT_BAR(2);
    s16x4 vlo[8], vhi[8]; u32x4 pw0, pw1, pw2, pw3;
#define PKW(P, B) cvtpk(P[B], P[B + 1])
#define PAF(k) __builtin_bit_cast(bf16x8, pw##k)
#define VFR(i) (bf16x8){vlo[i][0], vlo[i][1], vlo[i][2], vlo[i][3], vhi[i][0], vhi[i][1], vhi[i][2], vhi[i][3]}
#define PIN(x) asm volatile("" : "+v"(x))
#define MX3(a, b, c) __builtin_fmaxf(__builtin_fmaxf((a), (b)), (c))
#define GAPA(MF, A0, A1, A2, A3, W0, W1, PW) do { MF; sacc += A0; sacc += A1; sacc += A2; sacc += A3; PIN(sacc); W0; W1; PIN(PW); ATT_SBAR(); } while (0)
#define EX(v) __builtin_amdgcn_exp2f(v)
#define GAPB(MF, X, B) do { MF; X[B] = EX(X[B]); X[B + 1] = EX(X[B + 1]); X[B + 2] = EX(X[B + 2]); X[B + 3] = EX(X[B + 3]); PIN(X); ATT_SBAR(); } while (0)
#define VRD(i) do { vlo[i] = vtr(vp_ + (((i) >> 2) * 4096 + ((i) & 3) * 1024)); vhi[i] = vtr(vp_ + (((i) >> 2) * 4096 + ((i) & 3) * 1024 + 512)); } while (0)
#define KRD(G, j) do { if (G) { kload2(kf, kp0 + sl_next, j); ATT_SBAR(); } } while (0)
#define MF32(a, b, c) __builtin_amdgcn_mfma_f32_32x32x16_bf16(a, b, c, 0, 0, 0)
#define STEP(C0, C1, P0, P1, t, GK, GV, GL) do { ATT_SBAR(); \
    const lds_cptr vp_ = vp0 + sl_prev; \
    VRD(0); ATT_SBAR(); float sacc = (P0[0] + P0[1]); \
    GAPA(C0 = MF32(kf[0], qr[0], negm), P0[2], P0[3], P0[4], P0[5],     pw0[0] = PKW(P0, 0), pw0[1] = PKW(P0, 2), pw0); \
    VRD(4); ATT_SBAR(); GAPA(C1 = MF32(kf[1], qr[0], negm), P0[6], P0[7], P0[8], P0[9],     pw0[2] = PKW(P0, 4), pw0[3] = PKW(P0, 6), pw0); \
    VRD(1); ATT_SBAR(); GAPA(C0 = MF32(kf[2], qr[1], C0),   P0[10], P0[11], P0[12], P0[13], pw1[0] = PKW(P0, 8), pw1[1] = PKW(P0, 10), pw1); \
    VRD(5); ATT_SBAR(); GAPA(C1 = MF32(kf[3], qr[1], C1),   P0[14], P0[15], P1[0], P1[1],   pw1[2] = PKW(P0, 12), pw1[3] = PKW(P0, 14), pw1); \
    VRD(2); ATT_SBAR(); GAPA(C0 = MF32(kf[4], qr[2], C0),   P1[2], P1[3], P1[4], P1[5],     pw2[0] = PKW(P1, 0), pw2[1] = PKW(P1, 2), pw2); \
    VRD(6); ATT_SBAR(); GAPA(C1 = MF32(kf[5], qr[2], C1),   P1[6], P1[7], P1[8], P1[9],     pw2[2] = PKW(P1, 4), pw2[3] = PKW(P1, 6), pw2); \
    VRD(3); ATT_SBAR(); GAPA(C0 = MF32(kf[6], qr[3], C0),   P1[10], P1[11], P1[12], P1[13], pw3[0] = PKW(P1, 8), pw3[1] = PKW(P1, 10), pw3); \
    VRD(7); ATT_SBAR(); GAPA(C1 = MF32(kf[7], qr[3], C1),   P1[14], P1[15], 0.f, 0.f,       pw3[2] = PKW(P1, 12), pw3[3] = PKW(P1, 14), pw3); \
    l_reg += sacc; \
    if (GK) { DMA_K((t) + 3, sl_cur); } if (GV) { DMA_V((t) + 1, sl_next); } \
    CMASK(C0, C1, t); \
    { float a = MX3(C0[0], C0[1], C1[0]), b_ = MX3(C0[2], C0[3], C1[1]); a = MX3(a, C1[2], C1[3]); \
      _Pragma("unroll") for (int r = 4; r < 16; r += 4) { a = MX3(a, C0[r], C0[r + 1]); b_ = MX3(b_, C0[r + 2], C0[r + 3]); a = MX3(a, C1[r], C1[r + 1]); b_ = MX3(b_, C1[r + 2], C1[r + 3]); } \
      float rm = __builtin_fmaxf(a, b_); { auto rr = __builtin_amdgcn_permlane32_swap(__float_as_uint(rm), __float_as_uint(rm), false, false); rm = __builtin_fmaxf(__uint_as_float(rr[0]), __uint_as_float(rr[1])); } \
      resc = false; \
      const bool blk_ = (((t) + 1) & 3) == 0;                    \
      if (__builtin_expect(__any(rm > (float)THRL), 0)) { const float dl = __builtin_fmaxf(rm, 0.f); mhat += dl; \
        _Pragma("unroll") for (int r = 0; r < 16; ++r) { C0[r] -= dl; C1[r] -= dl; } \
        const float nm_ = ONB((t) + 1) ? -mhat : NEGB; \
        _Pragma("unroll") for (int r = 0; r < 16; ++r) negm[r] = nm_; asm volatile("" : "+v"(negm)); \
        const float f = __builtin_amdgcn_exp2f(-dl); l_reg *= f; if (hi == 0) wsf[r32] = f; resc = true; } \
      else if (blk_) { SETNEGM((t) + 1); } } \
    ATT_SBAR(); \
    GAPB(o[0] = MF32(PAF(0), VFR(0), o[0]), C0, 0); \
    GAPB(o[1] = MF32(PAF(0), VFR(4), o[1]), C0, 4); \
    KRD(GL, 0); GAPB(o[0] = MF32(PAF(1), VFR(1), o[0]), C0, 8); \
    KRD(GL, 1); GAPB(o[1] = MF32(PAF(1), VFR(5), o[1]), C0, 12); \
    KRD(GL, 2); GAPB(o[0] = MF32(PAF(2), VFR(2), o[0]), C1, 0); \
    KRD(GL, 3); GAPB(o[1] = MF32(PAF(2), VFR(6), o[1]), C1, 4); \
    GAPB(o[0] = MF32(PAF(3), VFR(3), o[0]), C1, 8); \
    GAPB(o[1] = MF32(PAF(3), VFR(7), o[1]), C1, 12); \
    } while (0)
    int t = 1;
#undef CMASK
#define CMASK(P0, P1, t) do { } while (0)
    for (; t + 5 < NT; t += 2) {
        STEP(pB0, pB1, pA0, pA1, t, true, true, true);       MK_WAIT_BAR(2); RESC(); ROT();
        STEP(pA0, pA1, pB0, pB1, t + 1, true, true, true);   MK_WAIT_BAR(2); RESC(); ROT();
    }
#undef CMASK
#define CMASK(P0, P1, t) do { int jb_ = (t) - (NT - 4); if (jb_ >= 0) cmask(P0, P1, jb_, qrel, hi); } while (0)
#define ENDW(tt) do { if ((tt) + 3 < NT) { MK_WAIT_BAR(2); } else if ((tt) + 2 < NT) { MK_WAIT_BAR(1); } else { MK_WAIT_BAR(0); } } while (0)
    for (; t + 1 < NT; t += 2) {
        STEP(pB0, pB1, pA0, pA1, t, (t + 3 < NT), (t + 1 < NT), (t + 1 < NT));           ENDW(t);     RESC(); ROT();
        STEP(pA0, pA1, pB0, pB1, t + 1, (t + 4 < NT), (t + 2 < NT), (t + 2 < NT));       ENDW(t + 1); RESC(); ROT();
    }
    if (nxt) { DMA_K(0, 0); DMA_K(1, SLOTB); DMA_K(2, 2 * SLOTB); }
    f32x4 cv[16];
    if (cit < NE * 512) { int t_ = tid_of(wave_s); asm volatile("" : "+v"(t_)); cvt_load<64>(cw1 + (size_t)(cit >> 9) * 1024 * 2048, 2048, cit & 511, t_ & 63, cv); }
    STEP(pB0, pB1, pA0, pA1, NT - 1, false, false, false); RESC();
    { float sacc = pB0[0] + pB0[1]; _Pragma("unroll") for (int r = 2; r < 16; ++r) sacc += pB0[r]; _Pragma("unroll") for (int r = 0; r < 16; ++r) sacc += pB1[r]; l_reg += sacc;
      pw0 = (u32x4){PKW(pB0, 0), PKW(pB0, 2), PKW(pB0, 4), PKW(pB0, 6)}; pw1 = (u32x4){PKW(pB0, 8), PKW(pB0, 10), PKW(pB0, 12), PKW(pB0, 14)}; pw2 = (u32x4){PKW(pB1, 0), PKW(pB1, 2), PKW(pB1, 4), PKW(pB1, 6)}; pw3 = (u32x4){PKW(pB1, 8), PKW(pB1, 10), PKW(pB1, 12), PKW(pB1, 14)};
      ATT_SBAR(); const int vb0 = (int)(lds0 + MK_V) + ((lane >> 4) & 1) * 32 + (lane & 3) * 8 + (4 * hi + ((lane & 15) >> 2)) * 64; pv(o, vb0 + sl_cur, PAF(0), PAF(1), PAF(2), PAF(3)); }
#undef PKW
#undef PAF
#undef VFR
#undef PIN
#undef MX3
#undef GAPA
#undef GAPB
#undef EX
#undef VRD
#undef KRD
#undef MF32
#undef STEP
#undef ENDW
    {
        int t_ = tid_of(wave_s); asm volatile("" : "+v"(t_)); const int r_ = t_ & 31, h_ = (t_ >> 5) & 1;
        const unsigned char* Qn = qkv8 + qkv_tile(rb0 + ((q0 + (nxt ? 256 : 0)) >> 4) + 2 * wid + (r_ >> 4), 12 + h) + h_ * 256 + (r_ & 15) * 16;
#pragma unroll
        for (int d0 = 0; d0 < 4; ++d0) qpre[d0] = *reinterpret_cast<const bf16x8*>(Qn + d0 * 512);
    }
    { auto rr = __builtin_amdgcn_permlane32_swap(__float_as_uint(l_reg), __float_as_uint(l_reg), false, false); l_reg = __uint_as_float(rr[0]) + __uint_as_float(rr[1]); }
    if (hi == 0) wsf[32 + r32] = l_reg; asm volatile("s_waitcnt lgkmcnt(0)" ::: "memory");
    float rli[16];
#pragma unroll
    for (int r = 0; r < 16; ++r) rli[r] = __builtin_amdgcn_rcpf(wsf[32 + crow(r, hi)]);
    unsigned char* Ow = aout + (rowbase + q0 + wid * 32) * D + 512 + 64 * h;
    { LAS unsigned char* stg = (LAS unsigned char*)(shm + MK_OST) + wid * 2048;
#pragma unroll
      for (int r = 0; r < 16; ++r) { const int orow = crow(r, hi);
#pragma unroll
          for (int d0 = 0; d0 < 2; ++d0) { const float v = o[d0][r] * rli[r] * AO_SCALE; stg[orow * 64 + d0 * 32 + r32] = (unsigned char)__builtin_amdgcn_cvt_pk_fp8_f32(v, v, 0, false); } }
      asm volatile("s_waitcnt lgkmcnt(0)" ::: "memory");
#pragma unroll
      for (int i = 0; i < 2; ++i) { const int row = i * 16 + (lane >> 2), ch = lane & 3; const u32x4 v = *(const LAS u32x4*)(stg + row * 64 + ch * 16); *(u32x4*)(Ow + (long)row * D + ch * 16) = v; } }
    if (cit < NE * 512) { int t_ = tid_of(wave_s); asm volatile("" : "+v"(t_)); cvt_store<64>(cw1_8 + (size_t)(cit >> 9) * 2048 * 1024, 2048, 2, W_SCALE, cit & 511, t_ & 63, cv); }
    asm volatile("s_waitcnt lgkmcnt(0)\n\ts_barrier" ::: "memory");
#undef DMA_K
#undef DMA_V
#undef CMASK
#undef START
#undef RESC
#undef ROT
#undef ONB
#undef SETNEGM
}
}

__device__ __forceinline__ void sincos_d(double a, double& s, double& c) {
    const double q = __builtin_rint(a * 0.63661977236758134308);
    double r = __builtin_fma(-q, 1.57079632679489655800e+00, a);
    r = __builtin_fma(-q, 6.12323399573676603587e-17, r);
    const double r2 = r * r;
    double sp = -1.0 / 1307674368000.0;
    sp = sp * r2 + 1.0 / 6227020800.0; sp = sp * r2 - 1.0 / 39916800.0; sp = sp * r2 + 1.0 / 362880.0; sp = sp * r2 - 1.0 / 5040.0; sp = sp * r2 + 1.0 / 120.0; sp = sp * r2 - 1.0 / 6.0;
    const double sr = r + r * r2 * sp;
    double cp = 1.0 / 20922789888000.0;
    cp = cp * r2 - 1.0 / 87178291200.0; cp = cp * r2 + 1.0 / 479001600.0; cp = cp * r2 - 1.0 / 3628800.0; cp = cp * r2 + 1.0 / 40320.0; cp = cp * r2 - 1.0 / 720.0; cp = cp * r2 + 1.0 / 24.0; cp = cp * r2 - 0.5;
    const double cr = 1.0 + r2 * cp;
    const int n = ((int)q) & 3;
    s = (n == 0) ? sr : (n == 1) ? cr : (n == 2) ? -sr : -cr;
    c = (n == 0) ? cr : (n == 1) ? -sr : (n == 2) ? -cr : sr;
}
__device__ __forceinline__ int sigma_col(int p, int mode) {
    if (mode == 0) return (p & ~255) + 64 * ((p >> 5) & 3) + 32 * ((p >> 7) & 1) + pg8::perm32(p & 31);
    if (mode == 1) return (p & ~31) + pg8::perm32(p & 31);
    if (mode == 3) return (p & ~255) + 64 * ((p >> 5) & 3) + 16 * ((p >> 2) & 3) + 8 * ((p >> 7) & 1) + 4 * ((p >> 4) & 1) + (p & 3);
    const int pn = p >> 8, q = p & 255; return 2 * (128 * pn + 32 * ((q >> 5) & 3) + pg8::perm32(q & 31)) + (q >> 7);
}
__device__ __forceinline__ void p0_transpose_item(const float* __restrict__ W, int N, bf16_t* __restrict__ WT, int mode, LAS float* scr, int item, int lane) {
    const int nblk = N / 32, kb = item / nblk, nb = item % nblk, k0 = 64 * kb, p0 = 32 * nb;
    const int sc = sigma_col(p0 + (lane & 31), mode);
#pragma unroll 8
    for (int i = 0; i < 32; ++i) { const int kk = 2 * i + (lane >> 5); scr[kk * 33 + (lane & 31)] = W[(size_t)(k0 + kk) * N + sc]; }
    LDS_WAIT(); asm volatile("" ::: "memory");
    const int c = lane & 7;
#pragma unroll
    for (int j = 0; j < 4; ++j) { const int n = (lane >> 3) + 8 * j; const LAS float* s = scr + (8 * c) * 33 + n;
        u32x4 o; o.x = cvtpk(s[0 * 33], s[1 * 33]); o.y = cvtpk(s[2 * 33], s[3 * 33]); o.z = cvtpk(s[4 * 33], s[5 * 33]); o.w = cvtpk(s[6 * 33], s[7 * 33]);
        *(u32x4*)(WT + (size_t)(p0 + n) * 1024 + k0 + 8 * c) = o; }
    LDS_WAIT(); asm volatile("" ::: "memory");
}

__device__ __forceinline__ void p0_transpose_item_fp8(const float* __restrict__ W, int N, unsigned char* __restrict__ WT, int mode, float scale, LAS float* scr, int item, int lane) {
    const int nblk = N / 32, kb = item / nblk, nb = item % nblk, k0 = 64 * kb, p0 = 32 * nb;
    const int sc = sigma_col(p0 + (lane & 31), mode);
#pragma unroll 8
    for (int i = 0; i < 32; ++i) { const int kk = 2 * i + (lane >> 5); scr[kk * 33 + (lane & 31)] = W[(size_t)(k0 + kk) * N + sc] * scale; }
    LDS_WAIT(); asm volatile("" ::: "memory");
    const int c = lane & 7;
#pragma unroll
    for (int j = 0; j < 4; ++j) { const int n = (lane >> 3) + 8 * j; const LAS float* s = scr + (8 * c) * 33 + n;
        u32x2 o; o.x = pk4_fp8(s[0 * 33], s[1 * 33], s[2 * 33], s[3 * 33]); o.y = pk4_fp8(s[4 * 33], s[5 * 33], s[6 * 33], s[7 * 33]);
        *(u32x2*)(WT + (size_t)(p0 + n) * 1024 + k0 + 8 * c) = o; }
    LDS_WAIT(); asm volatile("" ::: "memory");
}


__device__ __forceinline__ int inv32(int c) { return 16 * ((c >> 2) & 1) + 4 * (c >> 3) + (c & 3); }
__device__ __forceinline__ int pos_of(int c, int mode) {
    if (mode == 0) return (c & ~255) + (((c >> 6) & 3) << 5) + (((c >> 5) & 1) << 7) + inv32(c & 31);
    if (mode == 1) return (c & ~31) + inv32(c & 31);
    if (mode == 3) return (c & ~255) + 128 * ((c >> 3) & 1) + 32 * ((c >> 6) & 3) + 16 * ((c >> 2) & 1) + 4 * ((c >> 4) & 3) + (c & 3);
    const int par = c & 1, h = c >> 1; return 256 * (h >> 7) + 128 * par + 32 * ((h >> 5) & 3) + inv32(h & 31);
}
template <int CW>
__device__ __forceinline__ void cvt_load(const float* __restrict__ W, int N, int item, int lane, f32x4 (&v)[16]) {
    constexpr int LPR = CW / 4, KR = 16 * (64 / LPR);
    const int ncb = N / CW, kb = item / ncb, cb = item % ncb;
    const int cl = lane % LPR, g = lane / LPR;
    const int c0 = CW * cb + 4 * cl, k0 = KR * kb + 16 * g;
    const float* src = W + (size_t)k0 * N + c0;
#pragma unroll
    for (int i = 0; i < 16; ++i) v[i] = __builtin_nontemporal_load((const f32x4*)(src + (size_t)i * N));
}
template <int CW>
__device__ __forceinline__ void cvt_store(unsigned char* __restrict__ WT, int N, int mode, float scale, int item, int lane, const f32x4 (&v)[16]) {
    constexpr int LPR = CW / 4, KR = 16 * (64 / LPR);
    const int ncb = N / CW, kb = item / ncb, cb = item % ncb;
    const int cl = lane % LPR, g = lane / LPR;
    const int c0 = CW * cb + 4 * cl, k0 = KR * kb + 16 * g;
#pragma unroll
    for (int j = 0; j < 4; ++j) {
        u32x4 o;
        o.x = pk4_fp8(v[0][j] * scale, v[1][j] * scale, v[2][j] * scale, v[3][j] * scale);     o.y = pk4_fp8(v[4][j] * scale, v[5][j] * scale, v[6][j] * scale, v[7][j] * scale);
        o.z = pk4_fp8(v[8][j] * scale, v[9][j] * scale, v[10][j] * scale, v[11][j] * scale);   o.w = pk4_fp8(v[12][j] * scale, v[13][j] * scale, v[14][j] * scale, v[15][j] * scale);
        *(u32x4*)(WT + (size_t)pos_of(c0 + j, mode) * 1024 + k0) = o;
    }
}
__device__ __forceinline__ void cvt_load8(const float* __restrict__ W, int item, int lane, f32x4 (&v)[8]) {
    const int kb = item >> 5, cb = item & 31, cl = lane & 7, g = lane >> 3;
    const float* src = W + (size_t)(64 * kb + 8 * g) * 1024 + 32 * cb + 4 * cl;
#pragma unroll
    for (int i = 0; i < 8; ++i) v[i] = __builtin_nontemporal_load((const f32x4*)(src + (size_t)i * 1024));
}
__device__ __forceinline__ void cvt_store8(unsigned char* __restrict__ WT, int mode, float scale, int item, int lane, const f32x4 (&v)[8]) {
    const int kb = item >> 5, cb = item & 31, cl = lane & 7, g = lane >> 3;
    const int c0 = 32 * cb + 4 * cl, k0 = 64 * kb + 8 * g;
#pragma unroll
    for (int j = 0; j < 4; ++j) {
        u32x2 o; o.x = pk4_fp8(v[0][j] * scale, v[1][j] * scale, v[2][j] * scale, v[3][j] * scale); o.y = pk4_fp8(v[4][j] * scale, v[5][j] * scale, v[6][j] * scale, v[7][j] * scale);
        *(u32x2*)(WT + (size_t)pos_of(c0 + j, mode) * 1024 + k0) = o;
    }
}
template <int CW>
__device__ __forceinline__ void cvt_item(const float* __restrict__ W, int N, unsigned char* __restrict__ WT, int mode, float scale, int item, int lane) {
    f32x4 v[16]; cvt_load<CW>(W, N, item, lane, v); cvt_store<CW>(WT, N, mode, scale, item, lane, v);
}

struct CvtHook {
    const float* w1; unsigned char* w1_8; int gw, NGW, kbase;
    __device__ __forceinline__ void one(int k, int lane) const {
        constexpr int NIT1 = NE * 512;
        const int it = gw + NGW * k; if (it >= NIT1) return;
        const int e = it >> 9; cvt_item<64>(w1 + (size_t)e * 1024 * 2048, 2048, w1_8 + (size_t)e * 2048 * 1024, 2, W_SCALE, it & 511, lane);
    }
    struct State {};
    __device__ __forceinline__ void pre(int, int, State&) const {}
    __device__ __forceinline__ void operator()(int ui, int wave_s, State&) const { int t_ = tid_of(wave_s); asm volatile("" : "+v"(t_)); one(kbase + ui, t_ & 63); }
};
struct W2Hook {
    const float* w2; unsigned char* w2_8; int gw, NGW, step;
    struct State { f32x4 v[8]; int item; bool armed; };
    __device__ __forceinline__ void pre(int ui, int wave_s, State& st) const {
        constexpr int NIT2 = NE * 512;
        const int k = ui / step; st.item = gw + NGW * k; st.armed = (ui % step == 0) && (st.item < NIT2);
        if (st.armed) { int t_ = tid_of(wave_s); asm volatile("" : "+v"(t_)); cvt_load8(w2 + (size_t)(st.item >> 9) * 1024 * 1024, st.item & 511, t_ & 63, st.v); }
    }
    __device__ __forceinline__ void operator()(int, int wave_s, State& st) const {
        if (st.armed) { int t_ = tid_of(wave_s); asm volatile("" : "+v"(t_)); cvt_store8(w2_8 + (size_t)(st.item >> 9) * 1024 * 1024, 3, W_SCALE, st.item & 511, t_ & 63, st.v); }
    }
};

#define XB_TMO      128
#define XB_XCNT(j)  (256  + 64 * (j))
#define XB_XSUB(j)  (1280 + 64 * (j))
#define XB_XGEN(j)  (2304 + 64 * (j))
#define XB_TOP      3328
#define XB_TOPGEN   3392
#define XCD_BAR_WORDS 3456
#define XB_SPIN_CAP (1u << 18)
__device__ __forceinline__ unsigned xb_ld(unsigned* p)              { return __hip_atomic_load(p, __ATOMIC_RELAXED, __HIP_MEMORY_SCOPE_AGENT); }
__device__ __forceinline__ unsigned xb_add(unsigned* p, unsigned v) { return __hip_atomic_fetch_add(p, v, __ATOMIC_RELAXED, __HIP_MEMORY_SCOPE_AGENT); }
__device__ __forceinline__ unsigned xb_xcc_id() { return (unsigned)__builtin_amdgcn_s_getreg((3 << 11) | 20) & 0xFu; }
#define XB_SPIN(cond, bar) do { unsigned _sp = 0; while (cond) { __builtin_amdgcn_s_sleep(1); \
    if ((++_sp & 255u) == 0u) { if (xb_ld(&(bar)[XB_TMO])) break; if (_sp > XB_SPIN_CAP) { atomicAdd(&(bar)[XB_TMO], 1u); break; } } } } while (0)
struct XcdBarrier { unsigned* bar; unsigned x; volatile LAS unsigned* st; };
__device__ __forceinline__ XcdBarrier xcd_barrier_post(unsigned* bar, volatile LAS unsigned* st, const int wave_s) {
    XcdBarrier b; b.bar = bar; b.x = xb_xcc_id(); b.st = st;
    if (tid_of(wave_s) == 0) (void)xb_add(&bar[XB_XCNT(b.x)], 1u);
    return b;
}
__device__ __forceinline__ void xcd_barrier_complete(unsigned* bar, unsigned x, unsigned& nloc, unsigned& nx, unsigned& xmask) {
    const unsigned G = gridDim.x * gridDim.y * gridDim.z;
    unsigned sum, cnt, mine, sp = 0u;
    for (;;) {
        sum = 0u; cnt = 0u; mine = 0u; xmask = 0u;
#pragma unroll
        for (unsigned j = 0; j < 16; ++j) { const unsigned c = xb_ld(&bar[XB_XCNT(j)]); sum += c; cnt += (c > 0u) ? 1u : 0u; xmask |= (c > 0u) ? (1u << j) : 0u; mine = (j == x) ? c : mine; }
        if (sum == G) break;
        __builtin_amdgcn_s_sleep(1);
        if ((++sp & 255u) == 0u) { if (xb_ld(&bar[XB_TMO])) break; if (sp > XB_SPIN_CAP) { atomicAdd(&bar[XB_TMO], 1u); break; } }
    }
    nloc = mine > 0u ? mine : 1u; nx = cnt > 0u ? cnt : 1u;
}
__device__ __forceinline__ void xcd_barrier(const XcdBarrier& b, const int wave_s) {
    asm volatile("s_waitcnt vmcnt(0)" ::: "memory");
    __syncthreads();
    if (tid_of(wave_s) == 0) {
        unsigned* bar = b.bar;
        __builtin_amdgcn_s_waitcnt(0);
        unsigned nloc = b.st[0], nx = b.st[1], xmask = b.st[2];
        if (nloc == 0u) { xcd_barrier_complete(bar, b.x, nloc, nx, xmask); b.st[0] = nloc; b.st[1] = nx; b.st[2] = xmask; }
        const unsigned old = xb_add(&bar[XB_XSUB(b.x)], 1u);
        const unsigned gen = old / nloc;
        if (old + 1u == (gen + 1u) * nloc) {
            __builtin_amdgcn_fence(__ATOMIC_RELEASE, "agent");
            asm volatile("s_waitcnt vmcnt(0)" ::: "memory");
            const unsigned og = xb_add(&bar[XB_TOP], 1u);
            const unsigned tg = og / nx;
            if (og + 1u == (tg + 1u) * nx) {
#pragma unroll
                for (unsigned j = 0; j < 16; ++j) if ((xmask >> j) & 1u) (void)xb_add(&bar[XB_XGEN(j)], 1u);
            }
        }
        XB_SPIN(xb_ld(&bar[XB_XGEN(b.x)]) == gen, bar);
        __builtin_amdgcn_fence(__ATOMIC_ACQUIRE, "agent");
        asm volatile("s_waitcnt vmcnt(0)" ::: "memory");
    }
    __syncthreads();
}

__global__ void __launch_bounds__(NTHREADS, 2) fwd_megakernel(Params p_arg) {
    extern __shared__ __attribute__((aligned(16))) unsigned char lds_raw[];
    LAS unsigned char* lds = (LAS unsigned char*)lds_raw;
#define PHASE_IDS() int tid = tid_of(wave_s); asm volatile("" : "+v"(tid)); const int lane = tid & 63, wave = wave_s; (void)lane; (void)wave
    const int G = gridDim.x, bx = blockIdx.x;
    const int wave_s = __builtin_amdgcn_readfirstlane((int)threadIdx.x >> 6);
    typedef const __attribute__((address_space(4))) Params* KParams;
    const KParams kp0 = (KParams)__builtin_amdgcn_kernarg_segment_ptr();
#define PHASE_PTRS() KParams _kp = kp0; asm volatile("" : "+s"(_kp)); Params p; p.x = _kp->x; p.w_in = _kp->w_in; p.b_in = _kp->b_in; p.sinks = _kp->sinks; p.w_out = _kp->w_out; p.b_out = _kp->b_out; p.ln1_g = _kp->ln1_g; p.ln1_b = _kp->ln1_b; \
    p.w_router = _kp->w_router; p.b_router = _kp->b_router; p.w1 = _kp->w1; p.b1 = _kp->b1; p.w2 = _kp->w2; p.b2 = _kp->b2; p.ln2_g = _kp->ln2_g; p.ln2_b = _kp->ln2_b; p.out = _kp->out; p.ws = _kp->ws; unsigned char* const ws = p.ws; \
    unsigned* const ctl = (unsigned*)(ws + WS_CTL); float* const ksum = (float*)(ws + WS_KSUM); float* const rope = (float*)(ws + WS_ROPE); \
    bf16_t* const w_in_t = (bf16_t*)(ws + WS_WIN_T); bf16_t* const w_out_t = (bf16_t*)(ws + WS_WOUT_T); \
    unsigned char* const w1_8 = ws + WS_W1_8; unsigned char* const w2_8 = ws + WS_W2_8; unsigned char* const x1_8 = ws + WS_X1_8; unsigned char* const act8 = ws + WS_ACT8; \
    int* const cnt_blk = (int*)(ws + WS_CNT); int* const tile_e = (int*)(ws + WS_TILE_E); bf16_t* const wr_hi = (bf16_t*)(ws + WS_WR_HI); bf16_t* const wr_lo = (bf16_t*)(ws + WS_WR_LO); \
    int* const tok = (int*)(ws + WS_TOK); int* const asg_e = (int*)(ws + WS_ASG_E); float* const asg_g = (float*)(ws + WS_ASG_G); int* const asg_d = (int*)(ws + WS_ASG_D); \
    bf16_t* const x1b = (bf16_t*)(ws + WS_X1B); bf16_t* const xb = (bf16_t*)(ws + WS_XB); bf16_t* const attn_o = xb; bf16_t* const qkv = (bf16_t*)(ws + WS_QKV); unsigned char* const yb = ws + WS_YB; \
    (void)ctl; (void)ksum; (void)rope; (void)w_in_t; (void)w_out_t; (void)w1_8; (void)w2_8; (void)x1_8; (void)act8; (void)cnt_blk; (void)tile_e; (void)wr_hi; (void)wr_lo; (void)tok; (void)asg_e; (void)asg_g; (void)asg_d; \
    (void)x1b; (void)xb; (void)attn_o; (void)qkv; (void)yb
    { const int t0 = tid_of(wave_s); if (t0 < 3) ((LAS unsigned*)(lds + LDS_BARST))[t0] = 0u; }
    __syncthreads();
    XcdBarrier xbar;
    { PHASE_PTRS(); xbar = xcd_barrier_post(ctl + CW_BAR, (volatile LAS unsigned*)(lds + LDS_BARST), wave_s); }

    REP(0) {
        PHASE_IDS(); PHASE_PTRS();
        const long gt = (long)bx * NTHREADS + tid, gsz = (long)G * NTHREADS;
        for (long i = gt; i < 2048 * 32; i += gsz) {
            const int pos = (int)(i >> 5), k = (int)(i & 31);
            double inv = 1.0; for (int q = 0; q < k; ++q) inv *= 0.7498942093324559;
            double s, c; sincos_d((double)pos * inv, s, c);
            rope[pos * 64 + k] = (float)c; rope[pos * 64 + 32 + k] = (float)s;
        }
        for (long i = gt; i < 32 * 1024; i += gsz) {
            const int e = (int)(i >> 10), k = (int)(i & 1023); const float w = p.w_router[k * 32 + e];
            const unsigned h = f2bf(w); wr_hi[i] = (bf16_t)h; wr_lo[i] = (bf16_t)f2bf(w - bf2f(h));
        }
        const int gw = bx * 8 + wave, NGW = G * 8;
        constexpr int I_IN = 8 * (INW / 32), I_OUT = 8 * 32, I_W1 = 16 * 32, I_W2 = 8 * 32;
        if (G * 64 < T / 4) { for (long xi = gw; xi < T / 4; xi += NGW) { f32x4 xv_[16]; y0_load(p.x, xi, lane, xv_); y0_store((bf16_t*)p.out, p.b_out, xi, lane, xv_); } }
        if (G * 8 * 8 < NE * 512) { for (int it = gw; it < NE * I_W2; it += NGW) { const int e = it / I_W2; cvt_item<32>(p.w2 + (size_t)e * 1024 * 1024, 1024, w2_8 + (size_t)e * 1024 * 1024, 3, W_SCALE, it % I_W2, lane); } }
        if (G * 8 * 8 < NE * 512) { for (int it = gw; it < NE * I_W1; it += NGW) { const int e = it / I_W1; cvt_item<64>(p.w1 + (size_t)e * 1024 * 2048, 2048, w1_8 + (size_t)e * 2048 * 1024, 2, W_SCALE, it % I_W1, lane); } }
        for (int it = gw; it < I_IN + I_OUT; it += NGW) {
            if (it < I_IN) cvt_item<32>(p.w_in, INW, (unsigned char*)w_in_t, 0, WIN_SCALE, it, lane);
            else cvt_item<32>(p.w_out, 1024, (unsigned char*)w_out_t, 0, W_SCALE, it - I_IN, lane);
        }
        const f32x4* x4 = (const f32x4*)p.x;
#if INPROJ_FP8
        unsigned* x8 = (unsigned*)xb;
        constexpr long NV = (long)T * D / 4;
        for (long i0 = gt; i0 < NV; i0 += 8 * gsz) {
            f32x4 a[8];
#pragma unroll
            for (int q = 0; q < 8; ++q) { const long i = i0 + q * gsz; a[q] = __builtin_nontemporal_load(x4 + (i < NV ? i : i0)); }
#pragma unroll
            for (int q = 0; q < 8; ++q) { const long i = i0 + q * gsz; if (i < NV) x8[i] = pk4_fp8(a[q][0], a[q][1], a[q][2], a[q][3]); }
        }
#else
        u32x4* xb4 = (u32x4*)xb;
        for (long i = gt; i < (long)T * D / 8; i += gsz) { const f32x4 a = x4[2 * i], b = x4[2 * i + 1];
            u32x4 o; o.x = cvtpk(a[0], a[1]); o.y = cvtpk(a[2], a[3]); o.z = cvtpk(b[0], b[1]); o.w = cvtpk(b[2], b[3]); xb4[i] = o; }
#endif
    }
    xcd_barrier(xbar, wave_s);

    REP(1) {
        PHASE_PTRS();
        pg8::SchedInProj<1024> S{(const char*)xb, (const char*)w_in_t, G, bx};
        pg8::EpiInProj E{qkv, p.b_in, rope, KPF / WIN_SCALE};
        pg8::gemm_phase<pg8::EpiInProj, pg8::SchedInProj<1024>, false, true, 512, true>(lds, S, E, wave_s);
    }
    xcd_barrier(xbar, wave_s);

    REP(2) for (int u = bx; u < 256; u += G) {
        PHASE_PTRS();
        { const int b = u >> 3, h = u & 7;
            att::moba_ksums(qkv, b, h, (LAS char*)lds, wave_s);
            bf16x8 qpre[4];
#pragma unroll
            for (int d0 = 0; d0 < 4; ++d0) qpre[d0] = (bf16x8){0, 0, 0, 0, 0, 0, 0, 0};
            for (int j = 0; j < 8; ++j) att::moba_unit<8>(b, h, j, qkv, (unsigned char*)attn_o, (LAS char*)lds, wave_s, j > 0, j < 7, qpre, p.w1, w1_8, (u == bx && G * 8 * 8 >= NE * 512) ? (bx * 8 + wave_s) + G * 8 * j : 0x7fffffff); }
        { const int b = u >> 3, kvh = (u >> 2) & 1, oct = u & 3;
            for (int rp_ = 0; rp_ < (((DUP_MASK >> 8) & 1) ? 2 : 1); ++rp_) att::swa_stream((LAS char*)lds, qkv, (unsigned char*)attn_o, b, kvh, oct * 8, 8, p.sinks, wave_s, p.x, p.b_out, (bf16_t*)p.out, (u == bx && G * 64 >= T / 4) ? (long)(bx * 8 + wave_s) * 8 : -1L); }
    }
    xcd_barrier(xbar, wave_s);

    REP(3) for (int pm = bx; pm < T / 256; pm += G) {
        {
            PHASE_PTRS();
            pg8::SchedPanel S{(const char*)attn_o, (const char*)w_out_t, pm};
            pg8::EpiOutProj E{(bf16_t*)p.out};
            pg8::gemm_phase<pg8::EpiOutProj, pg8::SchedPanel, false, true, 512, true>(lds, S, E, wave_s);
        }
        __syncthreads();
        for (int rp3_ = 0; rp3_ < (((DUP_MASK >> 9) & 1) ? 2 : 1); ++rp3_) {
        {
            PHASE_IDS(); PHASE_PTRS();
#pragma unroll
            for (int i = 0; i < 16; ++i) { const int idx = tid + 512 * i, mat = idx >> 12, rw = (idx >> 7) & 31, ch = idx & 127;
                const u32x4 v = *(const u32x4*)((mat ? wr_lo : wr_hi) + rw * 1024 + ch * 8);
                *(LAS u32x4*)(lds + mat * 66048 + rw * 2064 + ch * 16) = v; }
        }
        {
            PHASE_IDS(); PHASE_PTRS();
            const bf16_t* ytmp = (const bf16_t*)p.out;
            f32x4 gg[2][2], bb[2][2];
#pragma unroll
            for (int j = 0; j < 2; ++j)
#pragma unroll
                for (int h = 0; h < 2; ++h) { gg[j][h] = *(const f32x4*)(p.ln1_g + 512 * j + 8 * lane + 4 * h); bb[j][h] = *(const f32x4*)(p.ln1_b + 512 * j + 8 * lane + 4 * h); }
            constexpr int LNR = 2;
            for (int rr = 0; rr < 32; rr += LNR) {
                const size_t row0 = (size_t)pm * 256 + wave * 32 + rr;
                u32x4 raw[LNR][2]; float v[LNR][2][8]; float sm[LNR], sq[LNR];
#pragma unroll
                for (int q = 0; q < LNR; ++q)
#pragma unroll
                    for (int j = 0; j < 2; ++j) raw[q][j] = *(const u32x4*)(ytmp + (row0 + q) * D + 512 * j + 8 * lane);
#pragma unroll
                for (int q = 0; q < LNR; ++q) { float s_ = 0.f;
#pragma unroll
                    for (int j = 0; j < 2; ++j)
#pragma unroll
                        for (int c = 0; c < 4; ++c) { const unsigned w = raw[q][j][c]; v[q][j][2 * c] = bf2f(w & 0xffffu); v[q][j][2 * c + 1] = bf2f(w >> 16); s_ += v[q][j][2 * c] + v[q][j][2 * c + 1]; }
                    sm[q] = s_; }
#pragma unroll
                for (int q = 0; q < LNR; ++q) sm[q] = wave_sum(sm[q]);
#pragma unroll
                for (int q = 0; q < LNR; ++q) { const float mean = sm[q] * (1.0f / D); float s2 = 0.f;
#pragma unroll
                    for (int j = 0; j < 2; ++j)
#pragma unroll
                        for (int c = 0; c < 8; ++c) { v[q][j][c] -= mean; s2 += v[q][j][c] * v[q][j][c]; }
                    sq[q] = s2; }
#pragma unroll
                for (int q = 0; q < LNR; ++q) sq[q] = wave_sum(sq[q]);
#pragma unroll
                for (int q = 0; q < LNR; ++q) {
                    const float rstd = 1.0f / sqrtf(sq[q] * (1.0f / D) + LN_EPS);
#pragma unroll
                    for (int j = 0; j < 2; ++j) {
                        float xv[8];
#pragma unroll
                        for (int c = 0; c < 8; ++c) xv[c] = v[q][j][c] * rstd * gg[j][c >> 2][c & 3] + bb[j][c >> 2][c & 3];
                        u32x4 hv; hv.x = cvtpk(xv[0], xv[1]); hv.y = cvtpk(xv[2], xv[3]); hv.z = cvtpk(xv[4], xv[5]); hv.w = cvtpk(xv[6], xv[7]);
                        u32x2 fv; fv.x = pk4_fp8(xv[0], xv[1], xv[2], xv[3]); fv.y = pk4_fp8(xv[4], xv[5], xv[6], xv[7]);
                        *(u32x4*)(x1b + (row0 + q) * D + 512 * j + 8 * lane) = hv;
                        *(u32x2*)(x1_8 + (row0 + q) * D + 512 * j + 8 * lane) = fv;
                    }
                }
            }
        }
        __syncthreads();
        {
            PHASE_IDS(); PHASE_PTRS();
            const int fr = lane & 15, fq = lane >> 4;
            f32x4 lacc[2][2];
#pragma unroll
            for (int m = 0; m < 2; ++m)
#pragma unroll
                for (int n = 0; n < 2; ++n) lacc[m][n] = (f32x4){0.f, 0.f, 0.f, 0.f};
            const size_t r0 = (size_t)pm * 256 + wave * 32;
            const int fr8 = fr & 7, hs = fr >> 3;
            const bf16_t* al = x1b + (r0 + fr8) * D + 8 * fq + 32 * hs;
            const LAS unsigned char* bh = lds + fr * 2064 + 16 * fq; const LAS unsigned char* bl = bh + 66048;
#pragma unroll 2
            for (int k0 = 0; k0 < 1024; k0 += 64) {
                bf16x8 a0[2], a1[2], b_hi[2][2], b_lo[2][2];
#pragma unroll
                for (int m = 0; m < 2; ++m) {
                    const u32x4 A = *(const u32x4*)(al + (size_t)m * 16 * D + k0), B = *(const u32x4*)(al + (size_t)(m * 16 + 8) * D + k0);
                    a0[m] = __builtin_bit_cast(bf16x8, pg8::ror8sel<0xC>(A, B)); a1[m] = __builtin_bit_cast(bf16x8, pg8::ror8sel<0x3>(B, A)); }
#pragma unroll
                for (int st = 0; st < 2; ++st)
#pragma unroll
                    for (int n = 0; n < 2; ++n) { b_hi[st][n] = *(const LAS bf16x8*)(bh + n * 16 * 2064 + (k0 + 32 * st) * 2); b_lo[st][n] = *(const LAS bf16x8*)(bl + n * 16 * 2064 + (k0 + 32 * st) * 2); }
#pragma unroll
                for (int m = 0; m < 2; ++m)
#pragma unroll
                    for (int n = 0; n < 2; ++n) {
                        lacc[m][n] = __builtin_amdgcn_mfma_f32_16x16x32_bf16(a0[m], b_hi[0][n], lacc[m][n], 0, 0, 0);
                        lacc[m][n] = __builtin_amdgcn_mfma_f32_16x16x32_bf16(a0[m], b_lo[0][n], lacc[m][n], 0, 0, 0);
                        lacc[m][n] = __builtin_amdgcn_mfma_f32_16x16x32_bf16(a1[m], b_hi[1][n], lacc[m][n], 0, 0, 0);
                        lacc[m][n] = __builtin_amdgcn_mfma_f32_16x16x32_bf16(a1[m], b_lo[1][n], lacc[m][n], 0, 0, 0);
                    }
            }
            __syncthreads();
            LAS float* lg = (LAS float*)lds;
#pragma unroll
            for (int m = 0; m < 2; ++m)
#pragma unroll
                for (int n = 0; n < 2; ++n)
#pragma unroll
                    for (int rg = 0; rg < 4; ++rg) lg[(wave * 32 + 16 * m + 4 * fq + rg) * 33 + 16 * n + fr] = lacc[m][n][rg];
        }
        __syncthreads();
        {
            PHASE_IDS(); PHASE_PTRS();
            LAS float* lg = (LAS float*)lds;
            LAS int* wcnt = (LAS int*)(lds + 36864);
            float t0 = -INFINITY, t1 = -INFINITY, t2 = -INFINITY, t3 = -INFINITY; int i0 = 0, i1 = 0, i2 = 0, i3 = 0;
            int rk0 = 0, rk1 = 0, rk2 = 0, rk3 = 0;
            if (tid < 256) {
                for (int e = 0; e < NE; ++e) {
                    const float xv = lg[tid * 33 + e] + p.b_router[e];
                    if (xv > t3) {
                        if (xv > t2) { t3 = t2; i3 = i2;
                            if (xv > t1) { t2 = t1; i2 = i1;
                                if (xv > t0) { t1 = t0; i1 = i0; t0 = xv; i0 = e; } else { t1 = xv; i1 = e; }
                            } else { t2 = xv; i2 = e; }
                        } else { t3 = xv; i3 = e; }
                    }
                }
                const unsigned selm = (1u << i0) | (1u << i1) | (1u << i2) | (1u << i3);
                for (int e = 0; e < NE; ++e) {
                    const bool has = ((selm >> e) & 1u) != 0u;
                    const unsigned long long bal = __ballot(has);
                    const int pre = __popcll(bal & ((1ull << lane) - 1ull));
                    if (e == i0) rk0 = pre; if (e == i1) rk1 = pre; if (e == i2) rk2 = pre; if (e == i3) rk3 = pre;
                    if (lane == 0) wcnt[wave * 32 + e] = __popcll(bal);
                }
            }
            __syncthreads();
            if (tid < 256) {
                const float e1 = __expf(t1 - t0), e2 = __expf(t2 - t0), e3 = __expf(t3 - t0);
                const float inv = 1.0f / (1.0f + e1 + e2 + e3);
                int b0 = 0, b1 = 0, b2 = 0, b3 = 0;
                for (int w = 0; w < wave; ++w) { b0 += wcnt[w * 32 + i0]; b1 += wcnt[w * 32 + i1]; b2 += wcnt[w * 32 + i2]; b3 += wcnt[w * 32 + i3]; }
                const size_t a = ((size_t)pm * 256 + tid) * 4;
                *(int4*)(asg_e + a) = make_int4(i0, i1, i2, i3);
                *(float4*)(asg_g + a) = make_float4(inv, e1 * inv, e2 * inv, e3 * inv);
                *(int4*)(asg_d + a) = make_int4(b0 + rk0, b1 + rk1, b2 + rk2, b3 + rk3);
            }
            if (tid < 32) cnt_blk[pm * 32 + tid] = wcnt[tid] + wcnt[32 + tid] + wcnt[64 + tid] + wcnt[96 + tid];
            __syncthreads();
        }
        }
    }
    xcd_barrier(xbar, wave_s);

    for (int pm = bx; pm < T / 256; pm += G) {
        PHASE_IDS(); PHASE_PTRS();
        LAS int* part_all = (LAS int*)lds; LAS int* part_pre = part_all + 512; LAS int* tot = part_pre + 512; LAS int* pre = tot + 32; LAS int* poff = pre + 32;
        { const int e = tid & 31, seg = tid >> 5; int sa = 0, sp = 0;
            for (int bb = seg * 16; bb < seg * 16 + 16; ++bb) { const int c = cnt_blk[bb * 32 + e]; sa += c; sp += (bb < pm) ? c : 0; }
            part_all[tid] = sa; part_pre[tid] = sp; }
        __syncthreads();
        if (tid < 32) { int sa = 0, sp = 0; for (int s = 0; s < 16; ++s) { sa += part_all[s * 32 + tid]; sp += part_pre[s * 32 + tid]; } tot[tid] = sa; pre[tid] = sp; }
        __syncthreads();
        if (tid == 0) { int off = 0; for (int e = 0; e < NE; ++e) { poff[e] = off; off += ((tot[e] + 255) >> 8) << 8; } poff[32] = off; }
        __syncthreads();
        if (tid < 256) {
            const int token = pm * 256 + tid; const size_t a = (size_t)token * 4;
            const int4 ee = *(const int4*)(asg_e + a); const int4 rk = *(const int4*)(asg_d + a);
            const int d0 = poff[ee.x] + pre[ee.x] + rk.x, d1 = poff[ee.y] + pre[ee.y] + rk.y, d2 = poff[ee.z] + pre[ee.z] + rk.z, d3 = poff[ee.w] + pre[ee.w] + rk.w;
            *(int4*)(asg_d + a) = make_int4(d0, d1, d2, d3);
            tok[d0] = token; tok[d1] = token; tok[d2] = token; tok[d3] = token;
        }
        if (pm < NE) {
            const int e = pm, n = tot[e], np = ((n + 255) >> 8) << 8, o = poff[e];
            for (int i = n + tid; i < np; i += NTHREADS) tok[o + i] = 0;
            for (int i = tid; i < (np >> 8); i += NTHREADS) tile_e[(o >> 8) + i] = e;
        }
        if (pm == 0 && tid == 0) ctl[CW_NTILES] = (unsigned)(poff[32] >> 8);
        __syncthreads();
    }
    xcd_barrier(xbar, wave_s);

    REP(5) {
        PHASE_PTRS(); const int ntiles = (int)ctl[CW_NTILES];
        { LAS int* tl = (LAS int*)(lds + LDSX_TILE); for (int i = tid_of(wave_s); i < ntiles; i += NTHREADS) tl[i] = tile_e[i]; __syncthreads(); }
        pg8::SchedMoe<8, true> S{(const char*)x1_8, (const char*)w1_8, (const LAS int*)(lds + LDSX_TILE), tok, ntiles, G, bx};
        pg8::EpiSwiglu E{act8, p.b1};
        W2Hook H2; H2.w2 = p.w2; H2.w2_8 = w2_8; H2.gw = bx * 8 + wave_s; H2.NGW = G * 8; H2.step = (G * 8 * 8 >= NE * 512) ? 4 : (1 << 20);
        pg8::gemm_phase<pg8::EpiSwiglu, pg8::SchedMoe<8, true>, true, true, 512, true, true, W2Hook>(lds, S, E, wave_s, H2);
    }
    xcd_barrier(xbar, wave_s);

    REP(6) {
        PHASE_PTRS(); const int ntiles = (int)ctl[CW_NTILES];
        { LAS int* tl = (LAS int*)(lds + LDSX_TILE); for (int i = tid_of(wave_s); i < ntiles; i += NTHREADS) tl[i] = tile_e[i]; __syncthreads(); }
        pg8::SchedMoe<4, false> S{(const char*)act8, (const char*)w2_8, (const LAS int*)(lds + LDSX_TILE), tok, ntiles, G, bx};
        pg8::EpiDown E{yb, p.b2};
        pg8::gemm_phase<pg8::EpiDown, pg8::SchedMoe<4, false>, false, true, 512, true, true>(lds, S, E, wave_s);
    }
    xcd_barrier(xbar, wave_s);

    REP(7) {
        PHASE_IDS(); PHASE_PTRS();
        const int gw = bx * 8 + wave, NGW = G * 8;
        f32x4 gg[2][2], bb[2][2];
#pragma unroll
        for (int j = 0; j < 2; ++j)
#pragma unroll
            for (int h = 0; h < 2; ++h) { gg[j][h] = *(const f32x4*)(p.ln2_g + 512 * j + 8 * lane + 4 * h); bb[j][h] = *(const f32x4*)(p.ln2_b + 512 * j + 8 * lane + 4 * h); }
        constexpr int R = 2;
        for (int row0 = gw; row0 < T; row0 += R * NGW) {
            int4 dd[R]; float4 gt[R];
#pragma unroll
            for (int q = 0; q < R; ++q) { const int row = row0 + q * NGW < T ? row0 + q * NGW : row0; dd[q] = *(const int4*)(asg_d + (size_t)row * 4); gt[q] = *(const float4*)(asg_g + (size_t)row * 4); }
            u32x4 xr[R][2]; u32x2 yk[R][4][2];
#pragma unroll
            for (int q = 0; q < R; ++q) { const int row = row0 + q * NGW < T ? row0 + q * NGW : row0;
#pragma unroll
                for (int j = 0; j < 2; ++j) {
                    xr[q][j] = *(const u32x4*)(x1b + (size_t)row * D + 512 * j + 8 * lane);
                    yk[q][0][j] = __builtin_nontemporal_load((const u32x2*)(yb + (size_t)dd[q].x * D + 512 * j + 8 * lane));
                    yk[q][1][j] = __builtin_nontemporal_load((const u32x2*)(yb + (size_t)dd[q].y * D + 512 * j + 8 * lane));
                    yk[q][2][j] = __builtin_nontemporal_load((const u32x2*)(yb + (size_t)dd[q].z * D + 512 * j + 8 * lane));
                    yk[q][3][j] = __builtin_nontemporal_load((const u32x2*)(yb + (size_t)dd[q].w * D + 512 * j + 8 * lane));
                } }
            float z[R][2][8]; float sm[R], sq[R];
#pragma unroll
            for (int q = 0; q < R; ++q) {
                const float g0 = gt[q].x * (1.0f / Y_SCALE), g1 = gt[q].y * (1.0f / Y_SCALE), g2 = gt[q].z * (1.0f / Y_SCALE), g3 = gt[q].w * (1.0f / Y_SCALE);
                float s_ = 0.f;
#pragma unroll
                for (int j = 0; j < 2; ++j)
#pragma unroll
                    for (int d = 0; d < 2; ++d) {
#define P7_PAIR(HH, SEL) do { \
                            const f32x2 a0 = __builtin_amdgcn_cvt_pk_f32_fp8((int)yk[q][0][j][d], SEL), a1 = __builtin_amdgcn_cvt_pk_f32_fp8((int)yk[q][1][j][d], SEL); \
                            const f32x2 a2 = __builtin_amdgcn_cvt_pk_f32_fp8((int)yk[q][2][j][d], SEL), a3 = __builtin_amdgcn_cvt_pk_f32_fp8((int)yk[q][3][j][d], SEL); \
                            const unsigned xw = xr[q][j][2 * d + HH]; \
                            const float lo = DN_ALPHA * bf2f(xw & 0xffffu) + g0 * a0.x + g1 * a1.x + g2 * a2.x + g3 * a3.x; \
                            const float hi = DN_ALPHA * bf2f(xw >> 16) + g0 * a0.y + g1 * a1.y + g2 * a2.y + g3 * a3.y; \
                            z[q][j][4 * d + 2 * HH] = lo; z[q][j][4 * d + 2 * HH + 1] = hi; s_ += lo + hi; } while (0)
                        P7_PAIR(0, false); P7_PAIR(1, true);
#undef P7_PAIR
                    }
                sm[q] = s_;
            }
#pragma unroll
            for (int q = 0; q < R; ++q) sm[q] = wave_sum(sm[q]);
#pragma unroll
            for (int q = 0; q < R; ++q) { const float mean = sm[q] * (1.0f / D); float s2 = 0.f;
#pragma unroll
                for (int j = 0; j < 2; ++j)
#pragma unroll
                    for (int c = 0; c < 8; ++c) { z[q][j][c] -= mean; s2 += z[q][j][c] * z[q][j][c]; }
                sq[q] = s2; }
#pragma unroll
            for (int q = 0; q < R; ++q) sq[q] = wave_sum(sq[q]);
#pragma unroll
            for (int q = 0; q < R; ++q) {
                const int row = row0 + q * NGW;
                if (row < T) {
                    const float rstd = 1.0f / sqrtf(sq[q] * (1.0f / D) + LN_EPS);
#pragma unroll
                    for (int j = 0; j < 2; ++j)
#pragma unroll
                        for (int h = 0; h < 2; ++h) {
                            f32x4 o;
#pragma unroll
                            for (int c = 0; c < 4; ++c) o[c] = z[q][j][4 * h + c] * rstd * gg[j][h][c] + bb[j][h][c];
                            *(f32x4*)(p.out + (size_t)row * D + 512 * j + 8 * lane + 4 * h) = o;
                        }
                }
            }
        }
    }
}

extern "C" void kernel_launch(void* const* d_in, const int* in_sizes, int n_in, void* d_out, int out_size, void* d_ws, size_t ws_size, hipStream_t stream) {
    static int grid_blocks = 0;
    if (grid_blocks == 0) {
        if (n_in != 16 || in_sizes[0] != T * D || out_size != T * D || ws_size < WS_END) {
            fprintf(stderr, "kernel_launch: unexpected shapes: n_in %d in0 %d out %d ws %zu (need %zu)\n", n_in, n_in > 0 ? in_sizes[0] : -1, out_size, ws_size, (size_t)WS_END); grid_blocks = -1; return; }
        int dev = 0, cus = 0, per_cu = 0;
        (void)hipGetDevice(&dev);
        (void)hipDeviceGetAttribute(&cus, hipDeviceAttributeMultiprocessorCount, dev);
        (void)hipFuncSetAttribute((const void*)fwd_megakernel, hipFuncAttributeMaxDynamicSharedMemorySize, LDS_BYTES);
        (void)hipOccupancyMaxActiveBlocksPerMultiprocessor(&per_cu, (const void*)fwd_megakernel, NTHREADS, LDS_BYTES);
        if (per_cu < 1) { fprintf(stderr, "kernel_launch: occupancy query reports %d blocks per CU\n", per_cu); per_cu = 1; }
        grid_blocks = cus;
        fprintf(stderr, "kernel_launch: cus=%d per_cu=%d grid=%d ws=%zu\n", cus, per_cu, grid_blocks, ws_size);
    }
    if (grid_blocks < 0) return;
    (void)hipMemsetAsync((char*)d_ws + WS_CTL, 0, CTL_ZERO_BYTES, stream);
    Params p{};
    p.x = (const float*)d_in[0]; p.w_in = (const float*)d_in[1]; p.b_in = (const float*)d_in[2]; p.sinks = (const float*)d_in[3]; p.w_out = (const float*)d_in[4]; p.b_out = (const float*)d_in[5];
    p.ln1_g = (const float*)d_in[6]; p.ln1_b = (const float*)d_in[7]; p.w_router = (const float*)d_in[8]; p.b_router = (const float*)d_in[9];
    p.w1 = (const float*)d_in[10]; p.b1 = (const float*)d_in[11]; p.w2 = (const float*)d_in[12]; p.b2 = (const float*)d_in[13]; p.ln2_g = (const float*)d_in[14]; p.ln2_b = (const float*)d_in[15];
    p.out = (float*)d_out; p.ws = (unsigned char*)d_ws;
    hipLaunchKernelGGL(fwd_megakernel, dim3(grid_blocks), dim3(NTHREADS), LDS_BYTES, stream, p);
    hipError_t e = hipPeekAtLastError();
    if (e != hipSuccess) fprintf(stderr, "launch failed: %s (grid %d)\n", hipGetErrorString(e), grid_blocks);
}
```

```cpp
#include <hip/hip_runtime.h>
#include <cstdio>
#include <cstdint>

#define LAS __attribute__((address_space(3)))
typedef unsigned short bf16_t;
typedef short bf16x8 __attribute__((ext_vector_type(8)));
typedef short s16x4 __attribute__((ext_vector_type(4)));
typedef float f32x2 __attribute__((ext_vector_type(2)));
typedef float f32x4 __attribute__((ext_vector_type(4)));
typedef float f32x16 __attribute__((ext_vector_type(16)));
typedef unsigned u32x2 __attribute__((ext_vector_type(2)));
typedef unsigned u32x4 __attribute__((ext_vector_type(4)));
typedef __bf16 bf16x2_t __attribute__((ext_vector_type(2)));

constexpr int D = 1024, BATCH = 32, SEQ = 2048, T = BATCH * SEQ;
constexpr int INW = 2304, NE = 32;
constexpr float LN_EPS = 1e-5f;
constexpr float DN_ALPHA = 1.189207115002721f;
constexpr float LOG2E = 1.4426950408889634f;
constexpr float C2 = 0.18033688011112042f;
constexpr int NTHREADS = 512;
constexpr int LDS_BYTES = 147456;
constexpr int MAX_TILES = 1056;
#ifndef INPROJ_FP8
#define INPROJ_FP8 1
#endif
#ifndef EPI_DUP
#define EPI_DUP 0
#endif
#ifndef DUP_MASK
#define DUP_MASK 0
#endif
#ifndef KPROBE
#define KPROBE 0
#endif
#define REP(k) for (int _rep = 0; _rep < (((DUP_MASK >> (k)) & 1) ? 2 : 1); ++_rep)

constexpr size_t MiB = 1u << 20;
constexpr size_t WS_CTL = 0, CTL_ZERO_BYTES = 2 * MiB;
constexpr size_t WS_KSUM = 1 * MiB;
constexpr size_t WS_ROPE = 2 * MiB;
constexpr size_t WS_WIN_T = 4 * MiB;
constexpr size_t WS_WOUT_T = 9 * MiB;
constexpr size_t WS_SMALL = 11 * MiB;
constexpr size_t WS_CNT = WS_SMALL, WS_TILE_E = WS_SMALL + 65536, WS_WR_HI = WS_SMALL + 131072, WS_WR_LO = WS_WR_HI + 65536;
constexpr size_t WS_STATS = WS_SMALL + 262144, WS_RC = WS_SMALL + 786432;
constexpr size_t WS_TOK = 12 * MiB;
constexpr size_t WS_ASG_E = 14 * MiB, WS_ASG_G = 15 * MiB, WS_ASG_D = 16 * MiB;
constexpr size_t WS_W2_8 = 24 * MiB;
constexpr size_t WS_X1B = 56 * MiB;
constexpr size_t WS_ACT8 = 184 * MiB;
constexpr size_t WS_XB = 184 * MiB;
constexpr size_t WS_X1LO = 312 * MiB;
constexpr size_t WS_YB = 488 * MiB;
constexpr size_t WS_W1_8 = 488 * MiB;
constexpr size_t WS_X1_8 = 552 * MiB;
constexpr size_t WS_QKV = 616 * MiB;
constexpr size_t WS_END = 1016 * MiB;
constexpr float KPF = (KPROBE == 1) ? 0.5f : 1.0f;
constexpr float W_SCALE = 64.0f, ACT_SCALE = 4.0f, WIN_SCALE = 32.0f, Y_SCALE = 16.0f, AO_SCALE = 64.0f;
constexpr int CW_NTILES = 16, CW_BAR = 4096;
constexpr int LDSX_TILE = 131072, LDSX_IDX = 135424, LDSX_BIAS = 136448;
constexpr int LDS_BARST = LDS_BYTES - 256;

struct Params {
    const float *x, *w_in, *b_in, *sinks, *w_out, *b_out, *ln1_g, *ln1_b, *w_router, *b_router, *w1, *b1, *w2, *b2, *ln2_g, *ln2_b;
    float* out; unsigned char* ws;
};

__device__ __forceinline__ unsigned f2bf(float f) { unsigned u = __builtin_bit_cast(unsigned, f); return (u + 0x7fffu + ((u >> 16) & 1u)) >> 16; }
__device__ __forceinline__ float bf2f(unsigned h) { return __builtin_bit_cast(float, h << 16); }
__device__ __forceinline__ unsigned cvtpk(float lo, float hi) { f32x2 v = {lo, hi}; bf16x2_t b = __builtin_convertvector(v, bf16x2_t); return __builtin_bit_cast(unsigned, b); }
__device__ __forceinline__ unsigned pk4_fp8(float a, float b, float c, float d) { int w = 0; w = __builtin_amdgcn_cvt_pk_fp8_f32(a, b, w, false); w = __builtin_amdgcn_cvt_pk_fp8_f32(c, d, w, true); return (unsigned)w; }
template <int X> __device__ __forceinline__ float swz_xor(float v) { return __builtin_bit_cast(float, __builtin_amdgcn_ds_swizzle(__builtin_bit_cast(int, v), (X << 10) | 0x1f)); }
__device__ __forceinline__ float wave_sum(float v) {
    v += swz_xor<1>(v); v += swz_xor<2>(v); v += swz_xor<4>(v); v += swz_xor<8>(v); v += swz_xor<16>(v);
    auto rr = __builtin_amdgcn_permlane32_swap(__float_as_uint(v), __float_as_uint(v), false, false);
    return __uint_as_float(rr[0]) + __uint_as_float(rr[1]);
}
#define LDS_WAIT() asm volatile("s_waitcnt lgkmcnt(0)" ::: "memory")
__device__ __forceinline__ int tid_of(int wave_s) { unsigned z = 0u; asm volatile("" : "+v"(z));
    return wave_s * 64 + (int)__builtin_amdgcn_mbcnt_hi(~0u, __builtin_amdgcn_mbcnt_lo(~0u, z)); }

namespace pg8 {
constexpr int BM = 256, BK = 64, HALF = 128, HTB = HALF * BK * 2, STAGE_BYTES = 8 * HTB, NXCD = 8, WGM = 8;
constexpr int KD = 1024;
__host__ __device__ __forceinline__ int lds_byte(int r, int c) { const int st = (r >> 4) * 2 + (c >> 5), rr = r & 15, cc = c & 31, ob = rr * 64 + cc * 2; return st * 1024 + (ob ^ (((ob >> 9) & 1) << 5)); }
__host__ __device__ __forceinline__ void stage_rc(int b, int& R, int& C) { const int st = b / 1024, sb = b % 1024, swz = sb ^ (((sb >> 9) & 1) << 5); R = (st >> 1) * 16 + swz / 64; C = (st & 1) * 32 + (swz % 64) / 2; }
__host__ __device__ __forceinline__ int perm32(int rho) { const int n = rho >> 4, i = rho & 15; return 8 * (i >> 2) + 4 * n + (i & 3); }

struct Unit { int pm, pn, e; unsigned ao, bo; const int* rows; };

typedef int v8i32_t __attribute__((ext_vector_type(8)));
typedef int v4i32_t __attribute__((ext_vector_type(4)));
typedef unsigned long long u64x2_t __attribute__((ext_vector_type(2)));
__device__ __forceinline__ f32x4 zero4() { unsigned long long lo, hi; asm volatile("v_mov_b64 %0, 0\n\tv_mov_b64 %1, 0" : "=v"(lo), "=v"(hi)); u64x2_t v = {lo, hi}; return __builtin_bit_cast(f32x4, v); }
__device__ __forceinline__ v8i32_t cat8(bf16x8 a, bf16x8 b) { const v4i32_t x = __builtin_bit_cast(v4i32_t, a), y = __builtin_bit_cast(v4i32_t, b); return __builtin_shufflevector(x, y, 0, 1, 2, 3, 4, 5, 6, 7); }
__device__ __forceinline__ void pg8_glds16(unsigned voff, const void* sbase, unsigned lds_dst) { unsigned keep;
    asm volatile("s_mov_b32 %0, m0\n\ts_mov_b32 m0, %3\n\ts_nop 0\n\tglobal_load_lds_dwordx4 %1, %2\n\ts_mov_b32 m0, %0" : "=&s"(keep) : "v"(voff), "s"(sbase), "s"(lds_dst) : "memory"); }
struct NoHook { struct State {}; __device__ __forceinline__ void pre(int, int, State&) const {} __device__ __forceinline__ void operator()(int, int, State&) const {} };
template <class Epi, class Sched, bool GATHER, bool ALIGN_EPI, int KP = 1024, bool FP8 = false, bool MOE = false, class Hook = NoHook>
__device__ __forceinline__ void gemm_phase(LAS unsigned char* lds, const Sched& S, const Epi& E, const int wave_s, Hook H = Hook()) {
    int tid = tid_of(wave_s); asm volatile("" : "+v"(tid));
    const int wid = __builtin_amdgcn_readfirstlane(tid >> 6), lane = tid & 63, wr = wid >> 2, wc = wid & 3, fr = lane & 15, fq = lane >> 4;
    constexpr int K = KP, nt = K / BK;
    unsigned voffB[2], Vc[2][2]; int stR0, stC0;
    { int R, C; stage_rc(tid * 16, R, C); stR0 = R; stC0 = C; }
#pragma unroll
    for (int i = 0; i < 2; ++i) { voffB[i] = (unsigned)((stR0 + 64 * i) * K + stC0) * 2u; Vc[0][i] = voffB[i]; Vc[1][i] = voffB[i]; }
#define PG8_GATHER_LOAD(VV) do { int _t = tid_of(wave_s); asm volatile("" : "+v"(_t)); int _R, _C; stage_rc(_t * 16, _R, _C);     \
        const LAS int* _rp = (const LAS int*)(lds + LDSX_IDX) + _R; _Pragma("unroll") for (int _h = 0; _h < 2; ++_h) _Pragma("unroll") for (int _i = 0; _i < 2; ++_i) \
        VV[_h][_i] = ((unsigned)_rp[128 * _h + 64 * _i] * (unsigned)K + (unsigned)_C) * 2u; } while (0)
#define PG8_DMA4(gsrc, ldsoff) __builtin_amdgcn_global_load_lds((const unsigned*)(gsrc), (LAS unsigned*)(lds + (ldsoff)), 4, 0, 0)
    constexpr unsigned kstep = (unsigned)(BK * 2);
    constexpr unsigned hstep = (unsigned)HALF * K * 2;
    const char* const Abase = S.A; const char* const Bbase = S.B;
    const unsigned ldsw = (unsigned)wid * 1024u; const unsigned lds0 = (unsigned)(uintptr_t)lds;
    const int aoff = lds_byte(wr * 64 + fr, fq * 8), boff = lds_byte(wc * 32 + fr, fq * 8) + 4 * HTB;
#define PG8_SA(b, h) (((b) * 2 + (h)) * HTB)
#define PG8_SB(b, h) ((4 + (b) * 2 + (h)) * HTB)
#define PG8_SBR(b, h) (((b) * 2 + (h)) * HTB)
#define PG8_STAGE(bufoff, gbase, soff, voff) do { _Pragma("unroll") for (int _r = 0; _r < (KPROBE == 3 ? 2 : 1); ++_r) _Pragma("unroll") for (int _i = 0; _i < 2; ++_i) \
        pg8_glds16((voff)[_i], (gbase) + (size_t)(unsigned)(soff), (unsigned)__builtin_amdgcn_readfirstlane((int)(lds0 + (unsigned)(bufoff) + ldsw + _i * 8192))); } while (0)
#define PG8_STAGE_B(bufoff, soff) PG8_STAGE(bufoff, Bbase, soff, voffB)
#define PG8_STAGE_A(bufoff, soff, h, VV) do { if constexpr (GATHER) { PG8_STAGE(bufoff, Abase, soff, VV[h]); } else { PG8_STAGE(bufoff, Abase, (soff) + (h) * hstep, voffB); } } while (0)
#if KPROBE == 2
#define PG8_LDA(dst, b, h) do { _Pragma("unroll") for (int m = 0; m < 4; ++m) { dst[m] = cat8(*(volatile const LAS bf16x8*)(lds + PG8_SA(b, h) + aoff + m * 2048), *(volatile const LAS bf16x8*)(lds + PG8_SA(b, h) + aoff + m * 2048 + 1024)); \
        dst[m] = cat8(*(volatile const LAS bf16x8*)(lds + PG8_SA(b, h) + aoff + m * 2048), *(volatile const LAS bf16x8*)(lds + PG8_SA(b, h) + aoff + m * 2048 + 1024)); } } while (0)
#define PG8_LDB(dst, b, h) do { _Pragma("unroll") for (int n = 0; n < 2; ++n) { dst[n] = cat8(*(volatile const LAS bf16x8*)(lds + PG8_SBR(b, h) + boff + n * 2048), *(volatile const LAS bf16x8*)(lds + PG8_SBR(b, h) + boff + n * 2048 + 1024)); \
        dst[n] = cat8(*(volatile const LAS bf16x8*)(lds + PG8_SBR(b, h) + boff + n * 2048), *(volatile const LAS bf16x8*)(lds + PG8_SBR(b, h) + boff + n * 2048 + 1024)); } } while (0)
#else
#define PG8_LDA(dst, b, h) do { _Pragma("unroll") for (int m = 0; m < 4; ++m) dst[m] = cat8(*(const LAS bf16x8*)(lds + PG8_SA(b, h) + aoff + m * 2048), *(const LAS bf16x8*)(lds + PG8_SA(b, h) + aoff + m * 2048 + 1024)); } while (0)
#define PG8_LDB(dst, b, h) do { _Pragma("unroll") for (int n = 0; n < 2; ++n) dst[n] = cat8(*(const LAS bf16x8*)(lds + PG8_SBR(b, h) + boff + n * 2048), *(const LAS bf16x8*)(lds + PG8_SBR(b, h) + boff + n * 2048 + 1024)); } while (0)
#endif
#define PG8_LO(v) __builtin_bit_cast(bf16x8, __builtin_shufflevector(v, v, 0, 1, 2, 3))
#define PG8_HI(v) __builtin_bit_cast(bf16x8, __builtin_shufflevector(v, v, 4, 5, 6, 7))
#define PG8_MMA(ai, bj, At, Bt) do { __builtin_amdgcn_s_setprio(1); _Pragma("unroll") for (int m = 0; m < 4; ++m) _Pragma("unroll") for (int n = 0; n < 2; ++n) { \
        if constexpr (FP8) { acc[ai][bj][m][n] = __builtin_amdgcn_mfma_scale_f32_16x16x128_f8f6f4(Bt[n], At[m], acc[ai][bj][m][n], 0, 0, 0, 0, 0, 0); \
            if (KPROBE == 1) acc[ai][bj][m][n] = __builtin_amdgcn_mfma_scale_f32_16x16x128_f8f6f4(Bt[n], At[m], acc[ai][bj][m][n], 0, 0, 0, 0, 0, 0); } \
        else { acc[ai][bj][m][n] = __builtin_amdgcn_mfma_f32_16x16x32_bf16(PG8_LO(Bt[n]), PG8_LO(At[m]), acc[ai][bj][m][n], 0, 0, 0); \
               acc[ai][bj][m][n] = __builtin_amdgcn_mfma_f32_16x16x32_bf16(PG8_HI(Bt[n]), PG8_HI(At[m]), acc[ai][bj][m][n], 0, 0, 0); } } \
        __builtin_amdgcn_s_setprio(0); } while (0)
#define PG8_WAIT_V(n) asm volatile("s_waitcnt vmcnt(" #n ")" ::: "memory")
#define PG8_WAIT_L(n) asm volatile("s_waitcnt lgkmcnt(" #n ")" ::: "memory")
#define PG8_BAR __builtin_amdgcn_s_barrier()
#define PG8_SCHED __builtin_amdgcn_sched_barrier(0)
    Unit cur, nxt; int ui = 0;
    if (!S.next(0, cur)) return;
    if constexpr (MOE) {
        if (wid < 4) { const int ln_ = tid_of(wave_s) & 63; PG8_DMA4(E.bias_src(cur) + wid * 64 + ln_, LDSX_BIAS + wid * 256); if constexpr (GATHER) PG8_DMA4(cur.rows + wid * 64 + ln_, LDSX_IDX + wid * 256); }
        asm volatile("s_waitcnt vmcnt(0)" ::: "memory"); __builtin_amdgcn_s_barrier(); asm volatile("" ::: "memory");
    }
    if constexpr (GATHER) { PG8_GATHER_LOAD(Vc); }
    f32x4 acc[2][2][4][2];
#pragma unroll
    for (int a = 0; a < 2; ++a)
#pragma unroll
        for (int b = 0; b < 2; ++b)
#pragma unroll
            for (int m = 0; m < 4; ++m)
#pragma unroll
                for (int n = 0; n < 2; ++n) acc[a][b][m][n] = zero4();
    v8i32_t At[4], B0[2], B1[2];
    unsigned cA = cur.ao, cB = cur.bo;
    PG8_STAGE_B(PG8_SB(0, 0), cB); PG8_STAGE_B(PG8_SB(0, 1), cB + hstep); PG8_STAGE_A(PG8_SA(0, 0), cA, 0, Vc); PG8_STAGE_A(PG8_SA(0, 1), cA, 1, Vc);
    if (wr == 1) PG8_BAR;
    PG8_WAIT_V(2); PG8_BAR;
    PG8_STAGE_B(PG8_SB(1, 0), cB + kstep); PG8_STAGE_A(PG8_SA(1, 0), cA + kstep, 0, Vc); PG8_STAGE_B(PG8_SB(1, 1), cB + hstep + kstep);
    PG8_WAIT_V(6); PG8_BAR;
    for (;;) {
        { int _t = tid_of(wave_s); asm volatile("" : "+v"(_t)); int _R, _C; stage_rc(_t * 16, _R, _C);
#pragma unroll
          for (int i = 0; i < 2; ++i) voffB[i] = (unsigned)((_R + 64 * i) * K + _C) * 2u; }
        const bool has_next = S.next(ui + 1, nxt);
        const unsigned nA = has_next ? nxt.ao : cA; const unsigned nB = has_next ? nxt.bo : cB;
        if constexpr (MOE) {
            if (has_next && wid < 4) { const int ln_ = tid_of(wave_s) & 63;
                PG8_DMA4(E.bias_src(nxt) + wid * 64 + ln_, LDSX_BIAS + ((ui + 1) % 3) * 1024 + wid * 256); if constexpr (GATHER) PG8_DMA4(nxt.rows + wid * 64 + ln_, LDSX_IDX + wid * 256); }
        }
        PG8_LDB(B0, 0, 0);
#pragma unroll 1
        for (int t = 0; t < nt; t += 2) {
            const bool last = (t == nt - 2);
            const unsigned a1 = cA + (unsigned)(t + 1) * kstep;
            const unsigned a2 = last ? nA : cA + (unsigned)(t + 2) * kstep; const unsigned b2 = last ? nB : cB + (unsigned)(t + 2) * kstep;
            const unsigned a3 = a2 + kstep; const unsigned b3 = b2 + kstep;
            PG8_LDB(B1, 0, 1); PG8_SCHED; PG8_LDA(At, 0, 0); PG8_STAGE_A(PG8_SA(1, 1), a1, 1, Vc);
            if constexpr (GATHER) { if (last && has_next) { PG8_GATHER_LOAD(Vc); } }
            PG8_WAIT_V(6); PG8_WAIT_L(0); PG8_BAR; PG8_MMA(0, 0, At, B0); PG8_MMA(0, 1, At, B1); PG8_BAR; PG8_SCHED;
            PG8_LDA(At, 0, 1); PG8_STAGE_B(PG8_SB(0, 0), b2); PG8_STAGE_B(PG8_SB(0, 1), b2 + hstep); PG8_STAGE_A(PG8_SA(0, 0), a2, 0, Vc);
            PG8_WAIT_V(8); PG8_WAIT_L(0); PG8_BAR; PG8_MMA(1, 0, At, B0); PG8_SCHED; PG8_LDB(B0, 1, 0); PG8_SCHED; PG8_MMA(1, 1, At, B1); PG8_BAR; PG8_SCHED;
            PG8_LDB(B1, 1, 1); PG8_SCHED; PG8_LDA(At, 1, 0); PG8_STAGE_A(PG8_SA(0, 1), a2, 1, Vc);
            PG8_WAIT_V(6); PG8_WAIT_L(0); PG8_BAR; PG8_MMA(0, 0, At, B0); PG8_MMA(0, 1, At, B1); PG8_BAR; PG8_SCHED;
            PG8_LDA(At, 1, 1); PG8_STAGE_B(PG8_SB(1, 0), b3); PG8_STAGE_B(PG8_SB(1, 1), b3 + hstep); PG8_STAGE_A(PG8_SA(1, 0), a3, 0, Vc);
            PG8_WAIT_V(8); PG8_WAIT_L(0); PG8_BAR; PG8_MMA(1, 0, At, B0); PG8_SCHED; if (!last) { PG8_LDB(B0, 0, 0); } PG8_SCHED; PG8_MMA(1, 1, At, B1); PG8_BAR; PG8_SCHED;
        }
        typename Hook::State hst; H.pre(ui, wave_s, hst);
        if constexpr (ALIGN_EPI) { if (wr == 0) PG8_BAR; }
        { int t2 = tid_of(wave_s); asm volatile("" : "+v"(t2));
          if constexpr (MOE) { E(acc, cur, wr, wc, t2 & 15, (t2 & 63) >> 4, (const LAS float*)(lds + LDSX_BIAS + (ui % 3) * 1024));
              if (EPI_DUP) { asm volatile("" : "+v"(t2)); E(acc, cur, wr, wc, t2 & 15, (t2 & 63) >> 4, (const LAS float*)(lds + LDSX_BIAS + (ui % 3) * 1024)); } }
          else E(acc, cur, wr, wc, t2 & 15, (t2 & 63) >> 4); }
        H(ui, wave_s, hst);
        if (!has_next) break;
#pragma unroll
        for (int a = 0; a < 2; ++a)
#pragma unroll
            for (int b = 0; b < 2; ++b)
#pragma unroll
                for (int m = 0; m < 4; ++m)
#pragma unroll
                    for (int n = 0; n < 2; ++n) acc[a][b][m][n] = zero4();
        cur = nxt; cA = nA; cB = nB; ++ui;
        if constexpr (ALIGN_EPI) { if (wr == 1) PG8_BAR; }
    }
    PG8_WAIT_V(0);
    if constexpr (!ALIGN_EPI) { if (wr == 0) PG8_BAR; }
    PG8_BAR;
#undef PG8_SA
#undef PG8_SB
#undef PG8_SBR
#undef PG8_STAGE
#undef PG8_STAGE_A
#undef PG8_STAGE_B
#undef PG8_GATHER_LOAD
#undef PG8_DMA4
#undef PG8_LDA
#undef PG8_LDB
#undef PG8_LO
#undef PG8_HI
#undef PG8_MMA
#undef PG8_WAIT_V
#undef PG8_WAIT_L
#undef PG8_BAR
#undef PG8_SCHED
}

template <int ROWB>
struct SchedInProj {
    const char* A; const char* B; int G, c;
    __device__ __forceinline__ bool next(int i, Unit& u) const {
        constexpr int nM = T / BM, nN = INW / BM, nwg = nM * nN;
        const long L = (long)i * G + c; if (L >= nwg) return false;
        int wgid = (int)L; { const int q = nwg / NXCD, r = nwg % NXCD, xcd = wgid % NXCD, off = wgid / NXCD; wgid = (xcd < r ? xcd * (q + 1) : r * (q + 1) + (xcd - r) * q) + off; }
        const int nig = WGM * nN, gid = wgid / nig, fm = gid * WGM, gsz = (nM - fm) < WGM ? (nM - fm) : WGM;
        u.pm = fm + ((wgid % nig) % gsz); u.pn = (wgid % nig) / gsz; u.e = 0; u.rows = nullptr;
        u.ao = (unsigned)u.pm * (unsigned)(256 * ROWB); u.bo = (unsigned)u.pn * (unsigned)(256 * ROWB); return true;
    }
};
struct SchedPanel {
    const char* A; const char* B; int pm;
    __device__ __forceinline__ bool next(int i, Unit& u) const {
        if (i >= 4) return false;
        u.pm = pm; u.pn = i; u.e = 0; u.rows = nullptr; u.ao = (unsigned)pm * (unsigned)(256 * 1024); u.bo = (unsigned)i * (unsigned)(256 * 1024); return true;
    }
};
template <int NPN, bool G1>
struct SchedMoe {
    const char* A; const char* B; const LAS int* tile_e; const int* tok; int ntiles, G, c;
    __device__ __forceinline__ bool next(int i, Unit& u) const {
        const long L = (long)i * G + c; int t, pn;
        if ((G & 7) == 0) { const int x = (int)(L & 7); const long j = L >> 3; t = (int)(j / NPN) * 8 + x; pn = (int)(j % NPN); }
        else { t = (int)(L / NPN); pn = (int)(L % NPN); }
        if (t >= ntiles) return false;
        if (!G1) t = ntiles - 1 - t;
        const int e = __builtin_amdgcn_readfirstlane(tile_e[t]);
        u.pm = t; u.pn = pn; u.e = e;
        if (G1) { u.ao = 0u; u.rows = tok + (size_t)t * 256; u.bo = ((unsigned)e * 2048u + (unsigned)pn * 256u) * 1024u; }
        else { u.ao = (unsigned)t * (256u * 1024u); u.rows = nullptr; u.bo = ((unsigned)e * 1024u + (unsigned)pn * 256u) * 1024u; }
        return true;
    }
};

struct EpiInProj {
    bf16_t* qkv; const float* b_in; const float* rope; float descale;
    __device__ __forceinline__ void operator()(const f32x4 (&acc)[2][2][4][2], const Unit& u, int wr, int wc, int fr, int fq) const {
        const int pn = u.pn;
        const int colb = 256 * pn + 64 * wc + 8 * fq;
        const bool do_rope = !(pn >= 7 || (pn == 2 && wc >= 2));
        const bool is_q = (pn < 2) || (pn == 3) || (pn == 4);
        const float sc = is_q ? C2 : 1.0f;
        f32x4 bv[2][2];
#pragma unroll
        for (int bj = 0; bj < 2; ++bj)
#pragma unroll
            for (int n = 0; n < 2; ++n) bv[bj][n] = *(const f32x4*)(b_in + colb + 32 * bj + 4 * n);
        const int row0 = u.pm * 256 + wr * 64 + fr;
        f32x4 cb[2], sb[2], c16[2], s16[2], c128[2], s128[2];
        if (do_rope) {
            const float* rp = rope + (row0 & (SEQ - 1)) * 64 + 8 * fq; const float* r16 = rope + 16 * 64 + 8 * fq; const float* r128 = rope + 128 * 64 + 8 * fq;
#pragma unroll
            for (int n = 0; n < 2; ++n) { cb[n] = *(const f32x4*)(rp + 4 * n); sb[n] = *(const f32x4*)(rp + 32 + 4 * n); c16[n] = *(const f32x4*)(r16 + 4 * n); s16[n] = *(const f32x4*)(r16 + 32 + 4 * n);
                c128[n] = *(const f32x4*)(r128 + 4 * n); s128[n] = *(const f32x4*)(r128 + 32 + 4 * n); }
        } else {
#pragma unroll
            for (int n = 0; n < 2; ++n) { cb[n] = sb[n] = c16[n] = s16[n] = c128[n] = s128[n] = (f32x4){0.f, 0.f, 0.f, 0.f}; }
        }
        f32x4 cn[2], sn[2];
#pragma unroll
        for (int n = 0; n < 2; ++n) { cn[n] = cb[n] * c128[n] - sb[n] * s128[n]; sn[n] = sb[n] * c128[n] + cb[n] * s128[n]; }
#pragma unroll
        for (int ai = 0; ai < 2; ++ai) {
            f32x4 cc[2], ss[2];
#pragma unroll
            for (int n = 0; n < 2; ++n) { if (ai == 0) { cc[n] = cb[n]; ss[n] = sb[n]; } else { cc[n] = cn[n]; ss[n] = sn[n]; } }
#pragma unroll
            for (int m = 0; m < 4; ++m) {
                const int row = row0 + ai * 128 + m * 16;
                f32x4 o1[2], o2[2];
#pragma unroll
                for (int n = 0; n < 2; ++n) { o1[n] = acc[ai][0][m][n] * descale + bv[0][n]; o2[n] = acc[ai][1][m][n] * descale + bv[1][n]; }
                if (do_rope) {
#pragma unroll
                    for (int n = 0; n < 2; ++n) { const f32x4 a = o1[n], b = o2[n]; o1[n] = a * cc[n] - b * ss[n]; o2[n] = b * cc[n] + a * ss[n]; }
                    if (m < 3) {
#pragma unroll
                        for (int n = 0; n < 2; ++n) { const f32x4 c_ = cc[n], s_ = ss[n]; cc[n] = c_ * c16[n] - s_ * s16[n]; ss[n] = s_ * c16[n] + c_ * s16[n]; }
                    }
                }
                unsigned char* rowp = (unsigned char*)qkv + ((size_t)(row >> 4) * 36 + (size_t)(4 * pn + wc)) * 2048 + (size_t)(row & 15) * 16 + (size_t)fq * 256;
                u32x4 w1, w2;
                w1.x = cvtpk(o1[0][0] * sc, o1[0][1] * sc); w1.y = cvtpk(o1[0][2] * sc, o1[0][3] * sc); w1.z = cvtpk(o1[1][0] * sc, o1[1][1] * sc); w1.w = cvtpk(o1[1][2] * sc, o1[1][3] * sc);
                w2.x = cvtpk(o2[0][0] * sc, o2[0][1] * sc); w2.y = cvtpk(o2[0][2] * sc, o2[0][3] * sc); w2.z = cvtpk(o2[1][0] * sc, o2[1][1] * sc); w2.w = cvtpk(o2[1][2] * sc, o2[1][3] * sc);
                *(u32x4*)(rowp) = w1; *(u32x4*)(rowp + 1024) = w2;
            }
        }
    }
};
template <int BANK> __device__ __forceinline__ u32x4 ror8sel(u32x4 old, u32x4 src) { u32x4 r;
#pragma unroll
    for (int c = 0; c < 4; ++c) r[c] = (unsigned)__builtin_amdgcn_update_dpp((int)old[c], (int)src[c], 0x128  , 0xF, BANK, false);
    return r; }
template <int BANK> __device__ __forceinline__ f32x4 ror8sel(f32x4 old, f32x4 src) { return __builtin_bit_cast(f32x4, ror8sel<BANK>(__builtin_bit_cast(u32x4, old), __builtin_bit_cast(u32x4, src))); }
struct EpiOutProj {
    bf16_t* y; const float* b_out; const float* x;
    __device__ __forceinline__ void operator()(const f32x4 (&acc)[2][2][4][2], const Unit& u, int wr, int wc, int fr, int fq) const {
        const int colw = u.pn * 256 + wc * 64 + 8 * fq;
        const int fr8 = fr & 7, hs = fr >> 3;
        f32x4 bv[2][2];
#pragma unroll
        for (int bj = 0; bj < 2; ++bj)
#pragma unroll
            for (int n = 0; n < 2; ++n) bv[bj][n] = *(const f32x4*)(b_out + colw + 32 * bj + 4 * n);
        const size_t lrow = (size_t)(u.pm * 256 + wr * 64 + fr8) * D + colw;
        const float* xl = x + lrow + 4 * hs;
        bf16_t* yl = y + lrow + 32 * hs;
#pragma unroll
        for (int ai = 0; ai < 2; ++ai) {
            f32x4 XA[4][2], XB[4][2];
#pragma unroll
            for (int m = 0; m < 4; ++m)
#pragma unroll
                for (int bj = 0; bj < 2; ++bj) { const size_t ro = (size_t)(ai * 128 + m * 16) * D; XA[m][bj] = __builtin_nontemporal_load((const f32x4*)(xl + ro + 32 * bj)); XB[m][bj] = __builtin_nontemporal_load((const f32x4*)(xl + ro + 8 * D + 32 * bj)); }
            asm volatile("" ::: "memory");
#pragma unroll
            for (int m = 0; m < 4; ++m) {
                const size_t ro = (size_t)(ai * 128 + m * 16) * D;
                u32x4 w[2];
#pragma unroll
                for (int bj = 0; bj < 2; ++bj) {
                    const f32x4 x0 = ror8sel<0xC>(XA[m][bj], XB[m][bj]), x1 = ror8sel<0x3>(XB[m][bj], XA[m][bj]);
                    const f32x4 v0 = acc[ai][bj][m][0] * (KPF / (W_SCALE * AO_SCALE)) + bv[bj][0] + x0 * DN_ALPHA, v1 = acc[ai][bj][m][1] * (KPF / (W_SCALE * AO_SCALE)) + bv[bj][1] + x1 * DN_ALPHA;
                    w[bj].x = cvtpk(v0[0], v0[1]); w[bj].y = cvtpk(v0[2], v0[3]); w[bj].z = cvtpk(v1[0], v1[1]); w[bj].w = cvtpk(v1[2], v1[3]); }
                *(u32x4*)(yl + ro) = ror8sel<0xC>(w[0], w[1]); *(u32x4*)(yl + ro + 8 * D) = ror8sel<0x3>(w[1], w[0]);
            }
            asm volatile("" ::: "memory");
        }
    }
};
struct EpiSwiglu {
    unsigned char* act8; const float* b1;
    __device__ __forceinline__ const float* bias_src(const Unit& u) const { return b1 + (size_t)u.e * 2048 + 256 * u.pn; }
    __device__ __forceinline__ void operator()(const f32x4 (&acc)[2][2][4][2], const Unit& u, int wr, int wc, int fr, int fq, const LAS float* bias) const {
        const int a0 = 128 * u.pn + 32 * wc + 8 * fq;
        const LAS float* bp = bias + 2 * (32 * wc + 8 * fq);
        f32x4 bb[4];
#pragma unroll
        for (int q = 0; q < 4; ++q) bb[q] = *(const LAS f32x4*)(bp + 4 * q);
        f32x2 bg[2][2], bl[2][2];
#pragma unroll
        for (int n = 0; n < 2; ++n)
#pragma unroll
            for (int jp = 0; jp < 2; ++jp) { bg[n][jp] = (f32x2){bb[2 * n + jp][0], bb[2 * n + jp][2]}; bl[n][jp] = (f32x2){bb[2 * n + jp][1], bb[2 * n + jp][3]}; }
        unsigned char* tile = act8 + (size_t)u.pm * (256 * 1024);
#pragma unroll
        for (int ai = 0; ai < 2; ++ai)
#pragma unroll
            for (int m = 0; m < 4; ++m) {
                const int row = ai * 128 + wr * 64 + m * 16 + fr;
                f32x2 r[2][2];
#pragma unroll
                for (int n = 0; n < 2; ++n)
#pragma unroll
                    for (int jp = 0; jp < 2; ++jp) {
                        const f32x2 ag = {acc[ai][0][m][n][2 * jp], acc[ai][0][m][n][2 * jp + 1]}, al = {acc[ai][1][m][n][2 * jp], acc[ai][1][m][n][2 * jp + 1]};
                        f32x2 g = ag * (KPF / W_SCALE) + bg[n][jp], l = al * (KPF / W_SCALE) + bl[n][jp];
                        g.x = fminf(g.x, 7.0f); g.y = fminf(g.y, 7.0f);
                        l.x = __builtin_amdgcn_fmed3f(l.x, -7.0f, 7.0f); l.y = __builtin_amdgcn_fmed3f(l.y, -7.0f, 7.0f);
                        const f32x2 uarg = g * (-1.702f * LOG2E);
                        f32x2 t; t.x = __builtin_amdgcn_exp2f(uarg.x); t.y = __builtin_amdgcn_exp2f(uarg.y);
                        const f32x2 d = t + 1.0f;
                        f32x2 sg; sg.x = __builtin_amdgcn_rcpf(d.x); sg.y = __builtin_amdgcn_rcpf(d.y);
                        const f32x2 lf = l * ACT_SCALE + ACT_SCALE;
                        r[n][jp] = (g * sg) * lf;
                    }
                u32x2 w; w.x = pk4_fp8(r[0][0].x, r[0][0].y, r[0][1].x, r[0][1].y); w.y = pk4_fp8(r[1][0].x, r[1][0].y, r[1][1].x, r[1][1].y);
                *(u32x2*)(tile + (size_t)row * 1024 + (size_t)a0) = w;
            }
    }
};
struct EpiDown {
    unsigned char* yb; const float* b2;
    __device__ __forceinline__ const float* bias_src(const Unit& u) const { return b2 + (size_t)u.e * 1024 + 256 * u.pn; }
    __device__ __forceinline__ void operator()(const f32x4 (&acc)[2][2][4][2], const Unit& u, int wr, int wc, int fr, int fq, const LAS float* bias) const {
        const int col0 = u.pn * 256 + wc * 64 + 16 * fq;
        const LAS float* bp = bias + wc * 64 + 16 * fq;
        f32x4 bv[2][2];
#pragma unroll
        for (int bj = 0; bj < 2; ++bj)
#pragma unroll
            for (int n = 0; n < 2; ++n) bv[bj][n] = *(const LAS f32x4*)(bp + 8 * bj + 4 * n) * Y_SCALE;
#pragma unroll
        for (int ai = 0; ai < 2; ++ai)
#pragma unroll
            for (int m = 0; m < 4; ++m) {
                unsigned char* rowp = yb + (size_t)(u.pm * 256 + ai * 128 + wr * 64 + m * 16 + fr) * 1024 + col0;
                u32x4 w;
#pragma unroll
                for (int bj = 0; bj < 2; ++bj)
#pragma unroll
                    for (int n = 0; n < 2; ++n) { const f32x4 v = acc[ai][bj][m][n] * (KPF * Y_SCALE / (W_SCALE * ACT_SCALE)) + bv[bj][n]; w[2 * bj + n] = pk4_fp8(v[0], v[1], v[2], v[3]); }
                *(u32x4*)rowp = w;
            }
    }
};
}

template <int CW> __device__ __forceinline__ void cvt_load(const float* __restrict__ W, int N, int item, int lane, f32x4 (&v)[16]);
template <int CW> __device__ __forceinline__ void cvt_store(unsigned char* __restrict__ WT, int N, int mode, float scale, int item, int lane, const f32x4 (&v)[16]);
namespace att {
constexpr int PITCH = INW, SLOTB = 8192;
constexpr size_t QKV_RB = 36 * 2048;
__device__ __forceinline__ size_t qkv_tile(long rb16, int u) { return (size_t)rb16 * QKV_RB + (size_t)u * 2048; }
constexpr int NSLOT = 4;
constexpr int L_K = 0, L_V = NSLOT * SLOTB, L_WS = 2 * NSLOT * SLOTB, L_KS = L_WS + 2048, L_OST = L_KS + 2048, L_END = L_OST + 8 * 4096;
static_assert(NSLOT == 4 && L_END <= 131072, "attention LDS map");
constexpr float NEG = -1.0e30f, M0 = -1.0e20f, THR = 8.0f;
typedef LAS const char* lds_cptr;
__device__ __forceinline__ int crow(int r, int hi) { return (r & 3) + 8 * (r >> 2) + 4 * hi; }
__device__ __forceinline__ void glds16(const void* gsrc, unsigned lds_dst) { unsigned keep;
    asm volatile("s_mov_b32 %0, m0\n\ts_mov_b32 m0, %2\n\ts_nop 0\n\tglobal_load_lds_dwordx4 %1, off\n\ts_mov_b32 m0, %0" : "=&s"(keep) : "v"(gsrc), "s"(lds_dst) : "memory"); }
__device__ __forceinline__ void glds16s(unsigned voff, const void* sbase, unsigned lds_dst) { unsigned keep;
    asm volatile("s_mov_b32 %0, m0\n\ts_mov_b32 m0, %3\n\ts_nop 0\n\tglobal_load_lds_dwordx4 %1, %2\n\ts_mov_b32 m0, %0" : "=&s"(keep) : "v"(voff), "s"(sbase), "s"(lds_dst) : "memory"); }
#define ATT_WAIT_BAR0() asm volatile("s_waitcnt vmcnt(0) lgkmcnt(0)\n\ts_barrier" ::: "memory")
#define ATT_WAIT_BARN(N) asm volatile("s_waitcnt vmcnt(" #N ") lgkmcnt(0)\n\ts_barrier" ::: "memory")
#define ATT_SBAR() __builtin_amdgcn_sched_barrier(0)

__device__ __forceinline__ void qkt(f32x16& p0, f32x16& p1, lds_cptr kb, const bf16x8* qr, const f32x16& negm) {
#pragma unroll
    for (int d0 = 0; d0 < 4; ++d0) {
        const bf16x8 b0 = *(const LAS bf16x8*)(kb + d0 * 2048);
        const bf16x8 b1 = *(const LAS bf16x8*)(kb + d0 * 2048 + 512);
        if (d0 == 0) { p0 = __builtin_amdgcn_mfma_f32_32x32x16_bf16(b0, qr[0], negm, 0, 0, 0); p1 = __builtin_amdgcn_mfma_f32_32x32x16_bf16(b1, qr[0], negm, 0, 0, 0); }
        else { p0 = __builtin_amdgcn_mfma_f32_32x32x16_bf16(b0, qr[d0], p0, 0, 0, 0); p1 = __builtin_amdgcn_mfma_f32_32x32x16_bf16(b1, qr[d0], p1, 0, 0, 0); }
    }
}
__device__ __forceinline__ float rowmax32(const f32x16& p0, const f32x16& p1) {
    float a = fmaxf(p0[0], p1[0]);
#pragma unroll
    for (int r = 1; r < 16; ++r) a = fmaxf(a, fmaxf(p0[r], p1[r]));
    auto rr = __builtin_amdgcn_permlane32_swap(__float_as_uint(a), __float_as_uint(a), false, false);
    return fmaxf(__uint_as_float(rr[0]), __uint_as_float(rr[1]));
}
__device__ __forceinline__ void pv(f32x16* o, int vb, bf16x8 pa0, bf16x8 pa1, bf16x8 pa2, bf16x8 pa3) {
#pragma unroll
    for (int d0 = 0; d0 < 2; ++d0) { s16x4 lo[4], hi[4];
#pragma unroll
        for (int ks = 0; ks < 4; ++ks) {
            asm volatile("ds_read_b64_tr_b16 %0,%1 offset:%c2" : "=&v"(lo[ks]) : "v"(vb), "i"(d0 * 4096 + ks * 1024) : "memory");
            asm volatile("ds_read_b64_tr_b16 %0,%1 offset:%c2" : "=&v"(hi[ks]) : "v"(vb), "i"(d0 * 4096 + ks * 1024 + 512) : "memory"); }
        asm volatile("s_waitcnt lgkmcnt(0)" ::: "memory"); ATT_SBAR();
#define ATT_PK(k) (bf16x8){lo[k][0], lo[k][1], lo[k][2], lo[k][3], hi[k][0], hi[k][1], hi[k][2], hi[k][3]}
        o[d0] = __builtin_amdgcn_mfma_f32_32x32x16_bf16(pa0, ATT_PK(0), o[d0], 0, 0, 0);
        o[d0] = __builtin_amdgcn_mfma_f32_32x32x16_bf16(pa1, ATT_PK(1), o[d0], 0, 0, 0);
        o[d0] = __builtin_amdgcn_mfma_f32_32x32x16_bf16(pa2, ATT_PK(2), o[d0], 0, 0, 0);
        o[d0] = __builtin_amdgcn_mfma_f32_32x32x16_bf16(pa3, ATT_PK(3), o[d0], 0, 0, 0);
#undef ATT_PK
    }
}

__device__ __forceinline__ void swa_stream(LAS char* shm, const bf16_t* __restrict__ qkv, unsigned char* __restrict__ aout, int b, int hh, int qb0, int nqb, const float* __restrict__ sinks, const int wave_s) {
    int tid = tid_of(wave_s); asm volatile("" : "+v"(tid));
    const int lane = tid & 63, r32 = lane & 31, hi = lane >> 5; const int wid = wave_s;
    const long rowbase = (long)b * SEQ;
    const int g = wid >> 1, qcol = (4 * hh + g) * 64, kcol = 512 + 64 * hh, vcol = 640 + 64 * hh;
    const unsigned char* const qkv8 = (const unsigned char*)qkv; const long rb0 = rowbase >> 4; (void)kcol; (void)vcol;
    const unsigned lds0 = (unsigned)(uintptr_t)shm;
    LAS float* wsf = (LAS float*)(shm + L_WS) + wid * 64;
    const unsigned koff = (unsigned)((lane >> 4) * (int)QKV_RB + (lane & 15) * 16);
    const unsigned voff = (unsigned)((lane & 3) * 256 + (lane >> 2) * 16);
    const unsigned kdst = lds0 + L_K + wid * 1024, vdst = lds0 + L_V + wid * 1024;
#define SW_DMA(t) do { const unsigned sl_ = (unsigned)(((t) & (NSLOT - 1)) * SLOTB); \
        glds16s(koff, qkv8 + qkv_tile(rb0 + 4 * (long)(t), 8 + hh) + wid * 256, (unsigned)__builtin_amdgcn_readfirstlane(kdst + sl_)); \
        glds16s(voff, qkv8 + qkv_tile(rb0 + 4 * (long)(t) + (wid & 3), 10 + hh) + (wid >> 2) * 1024, (unsigned)__builtin_amdgcn_readfirstlane(vdst + sl_)); } while (0)
    const int vb0 = (int)(lds0 + L_V) + ((lane >> 4) & 1) * 32 + (lane & 3) * 8 + (4 * hi + ((lane & 15) >> 2)) * 64;
    const lds_cptr kp0 = (lds_cptr)shm + L_K + hi * 1024 + r32 * 16;
    const float sink2 = sinks[4 * hh + g] * LOG2E;
    const int qend = qb0 + nqb;
    for (int kt = (qb0 - 2 < 0 ? 0 : qb0 - 2); kt <= qb0; ++kt) SW_DMA(kt);
    const unsigned char* Qb = qkv8 + qkv_tile(rb0 + 2 * (wid & 1) + (r32 >> 4), 4 * hh + g) + hi * 256 + (r32 & 15) * 16; (void)qcol;
    bf16x8 qn[4];
#pragma unroll
    for (int d0 = 0; d0 < 4; ++d0) qn[d0] = *reinterpret_cast<const bf16x8*>(Qb + (size_t)qb0 * 4 * QKV_RB + d0 * 512);
    ATT_WAIT_BAR0();
    for (int qb = qb0; qb < qend; ++qb) {
        const int qa = 64 * qb + 32 * (wid & 1);
        if (qb + 1 < qend) SW_DMA(qb + 1);
        bf16x8 qr[4];
#pragma unroll
        for (int d0 = 0; d0 < 4; ++d0) qr[d0] = qn[d0];
        if (qb + 1 < qend) {
#pragma unroll
            for (int d0 = 0; d0 < 4; ++d0) qn[d0] = *reinterpret_cast<const bf16x8*>(Qb + (size_t)(qb + 1) * 4 * QKV_RB + d0 * 512);
        }
        float m_run = sink2, l_run = (hi == 0) ? 1.0f : 0.0f;
        f32x16 negm, o[2];
        { float zf = 0.f; asm volatile("" : "+v"(zf));
#pragma unroll
          for (int r = 0; r < 16; ++r) { o[0][r] = zf; o[1][r] = zf; negm[r] = -m_run; } }
        for (int kt = (qb - 2 < 0 ? 0 : qb - 2); kt <= qb; ++kt) {
            const int cur = (kt & (NSLOT - 1)) * SLOTB;
            f32x16 p0, p1; qkt(p0, p1, kp0 + cur, qr, negm);
            const bool edge = !((64 * kt + 63 <= qa) && (qa + 31 - 64 * kt <= 127));
            if (edge) {
                const int dq = qa + r32 - 64 * kt - 4 * hi;
#pragma unroll
                for (int r = 0; r < 16; ++r) { const int d0_ = dq - ((r & 3) + 8 * (r >> 2)), d1_ = d0_ - 32;
                    p0[r] = ((unsigned)d0_ < 128u) ? p0[r] : NEG; p1[r] = ((unsigned)d1_ < 128u) ? p1[r] : NEG; }
            }
            const float rm = rowmax32(p0, p1);
            if (__any(rm > THR)) {
                const float dl = fmaxf(rm, 0.f);
                const float f = __builtin_amdgcn_exp2f(-dl);
                m_run += dl;
#pragma unroll
                for (int r = 0; r < 16; ++r) { p0[r] -= dl; p1[r] -= dl; negm[r] = -m_run; }
                l_run *= f;
                if (hi == 0) wsf[r32] = f;
                LDS_WAIT();
#pragma unroll
                for (int r = 0; r < 16; ++r) { const float fr_ = wsf[crow(r, hi)]; o[0][r] *= fr_; o[1][r] *= fr_; }
            }
            float sacc = 0.f;
#pragma unroll
            for (int r = 0; r < 16; ++r) { p0[r] = __builtin_amdgcn_exp2f(p0[r]); p1[r] = __builtin_amdgcn_exp2f(p1[r]); sacc += p0[r] + p1[r]; }
            l_run += sacc;
            u32x4 pw0, pw1, pw2, pw3;
            pw0 = (u32x4){cvtpk(p0[0], p0[1]), cvtpk(p0[2], p0[3]), cvtpk(p0[4], p0[5]), cvtpk(p0[6], p0[7])};
            pw1 = (u32x4){cvtpk(p0[8], p0[9]), cvtpk(p0[10], p0[11]), cvtpk(p0[12], p0[13]), cvtpk(p0[14], p0[15])};
            pw2 = (u32x4){cvtpk(p1[0], p1[1]), cvtpk(p1[2], p1[3]), cvtpk(p1[4], p1[5]), cvtpk(p1[6], p1[7])};
            pw3 = (u32x4){cvtpk(p1[8], p1[9]), cvtpk(p1[10], p1[11]), cvtpk(p1[12], p1[13]), cvtpk(p1[14], p1[15])};
            ATT_SBAR();
            pv(o, vb0 + cur, __builtin_bit_cast(bf16x8, pw0), __builtin_bit_cast(bf16x8, pw1), __builtin_bit_cast(bf16x8, pw2), __builtin_bit_cast(bf16x8, pw3));
        }
        { auto rr = __builtin_amdgcn_permlane32_swap(__float_as_uint(l_run), __float_as_uint(l_run), false, false); l_run = __uint_as_float(rr[0]) + __uint_as_float(rr[1]); }
        if (hi == 0) wsf[32 + r32] = l_run;
        LDS_WAIT();
        float rli[16];
#pragma unroll
        for (int r = 0; r < 16; ++r) rli[r] = __builtin_amdgcn_rcpf(wsf[32 + crow(r, hi)]);
        unsigned char* Ow = aout + (rowbase + qa) * D + qcol;
        { LAS unsigned char* stg = (LAS unsigned char*)(shm + L_OST) + wid * 2048;
#pragma unroll
            for (int r = 0; r < 16; ++r) { const int orow = crow(r, hi);
#pragma unroll
                for (int d0 = 0; d0 < 2; ++d0) { const float v = o[d0][r] * rli[r] * AO_SCALE; stg[orow * 64 + d0 * 32 + r32] = (unsigned char)__builtin_amdgcn_cvt_pk_fp8_f32(v, v, 0, false); } }
            LDS_WAIT();
#pragma unroll
            for (int i = 0; i < 2; ++i) { const int row = i * 16 + (lane >> 2), ch = lane & 3; const u32x4 v = *(const LAS u32x4*)(stg + row * 64 + ch * 16); *(u32x4*)(Ow + (long)row * D + ch * 16) = v; } }
        ATT_WAIT_BAR0();
    }
#undef SW_DMA
}

constexpr int MK_K = 0, MK_V = 3 * SLOTB, MK_WS = 6 * SLOTB, MK_OST = MK_WS + 8 * 256, MK_KS = MK_OST + 8 * 4096, MK_END = MK_KS + 2048;
constexpr float NEGB = -1.0e30f;
__device__ __forceinline__ float max3f(float a, float b, float c) { float r; asm("v_max3_f32 %0, %1, %2, %3" : "=v"(r) : "v"(a), "v"(b), "v"(c)); return r; }
__device__ __forceinline__ float max2f(float a, float b) { float r; asm("v_max_f32_e32 %0, %1, %2" : "=v"(r) : "v"(a), "v"(b)); return r; }
__device__ __forceinline__ float fadd_s(float a, float b) { float r; asm("v_add_f32_e32 %0, %1, %2" : "=v"(r) : "v"(a), "v"(b)); return r; }
__device__ __forceinline__ float fsub_s(float a, float b) { float r; asm("v_sub_f32_e32 %0, %1, %2" : "=v"(r) : "v"(a), "v"(b)); return r; }
typedef short v4i16_t __attribute__((ext_vector_type(4)));
#define MK_WAIT_BAR(N) asm volatile("s_waitcnt vmcnt(" #N ") lgkmcnt(0)\n\ts_barrier" ::: "memory")
__device__ __forceinline__ void kload8(bf16x8* kf, lds_cptr kp) {
    kf[0] = *(const LAS bf16x8*)(kp);        kf[1] = *(const LAS bf16x8*)(kp + 512);
    kf[2] = *(const LAS bf16x8*)(kp + 2048); kf[3] = *(const LAS bf16x8*)(kp + 2560);
    kf[4] = *(const LAS bf16x8*)(kp + 4096); kf[5] = *(const LAS bf16x8*)(kp + 4608);
    kf[6] = *(const LAS bf16x8*)(kp + 6144); kf[7] = *(const LAS bf16x8*)(kp + 6656);
}
__device__ __forceinline__ void kload2(bf16x8* kf, lds_cptr kp, int j) { kf[2 * j] = *(const LAS bf16x8*)(kp + j * 2048); kf[2 * j + 1] = *(const LAS bf16x8*)(kp + j * 2048 + 512); }
__device__ __forceinline__ s16x4 vtr(lds_cptr p) { return __builtin_bit_cast(s16x4, __builtin_amdgcn_ds_read_tr16_b64_v4i16((LAS v4i16_t*)p)); }
__device__ __forceinline__ float rowmax_a(const f32x16& p0, const f32x16& p1) {
    float a = max3f(p0[0], p0[1], p1[0]), b = max3f(p0[2], p0[3], p1[1]); a = max3f(a, p1[2], p1[3]);
#pragma unroll
    for (int r = 4; r < 16; r += 4) { a = max3f(a, p0[r], p0[r + 1]); b = max3f(b, p0[r + 2], p0[r + 3]); a = max3f(a, p1[r], p1[r + 1]); b = max3f(b, p1[r + 2], p1[r + 3]); }
    const float m = max2f(a, b);
    auto rr = __builtin_amdgcn_permlane32_swap(__float_as_uint(m), __float_as_uint(m), false, false);
    return max2f(__uint_as_float(rr[0]), __uint_as_float(rr[1]));
}
__device__ __forceinline__ void cmask(f32x16& p0, f32x16& p1, int jb, int qrel, int hi) {
    const float NEGI = -INFINITY; const int kb = 64 * jb + 4 * hi;
#pragma unroll
    for (int r = 0; r < 16; ++r) { const int kv = kb + (r & 3) + 8 * (r >> 2); if (kv > qrel) p0[r] = NEGI; if (kv + 32 > qrel) p1[r] = NEGI; }
}


__device__ __forceinline__ void moba_ksums(const bf16_t* __restrict__ qkv, int b, int h, LAS char* shm, const int wave_s) {
    int tid = tid_of(wave_s); asm volatile("" : "+v"(tid));
    const int lane = tid & 63;
    if (wave_s < 7) {
        const unsigned char* base = (const unsigned char*)qkv + qkv_tile((((long)b * SEQ + 256 * wave_s) >> 4), 20 + h) + (lane & 7) * 256 + (lane >> 3) * 16;
        float a[8];
#pragma unroll
        for (int j = 0; j < 8; ++j) a[j] = 0.f;
#pragma unroll 8
        for (int i = 0; i < 32; ++i) { const u32x4 v = *(const u32x4*)(base + (size_t)(i >> 1) * QKV_RB + (i & 1) * 128);
#pragma unroll
            for (int q = 0; q < 4; ++q) { a[2 * q] += bf2f(v[q] & 0xffffu); a[2 * q + 1] += bf2f(v[q] >> 16); } }
#pragma unroll
        for (int j = 0; j < 8; ++j) { a[j] += swz_xor<8>(a[j]); a[j] += swz_xor<16>(a[j]);
            auto rr = __builtin_amdgcn_permlane32_swap(__float_as_uint(a[j]), __float_as_uint(a[j]), false, false); a[j] = __uint_as_float(rr[0]) + __uint_as_float(rr[1]); }
        if (lane < 8) { LAS float* ksl = (LAS float*)(shm + MK_KS) + wave_s * 64 + 8 * lane;
            *(LAS f32x4*)(ksl) = (f32x4){a[0], a[1], a[2], a[3]}; *(LAS f32x4*)(ksl + 4) = (f32x4){a[4], a[5], a[6], a[7]}; }
    }
    asm volatile("s_waitcnt lgkmcnt(0)" ::: "memory"); __builtin_amdgcn_s_barrier(); asm volatile("" ::: "memory");
}
template <int THRL>
__device__ __forceinline__ void moba_unit(int b, int h, int qb, const bf16_t* __restrict__ qkv, unsigned char* __restrict__ aout, LAS char* shm, const int wave_s, const bool pre, const bool nxt, bf16x8 (&qpre)[4], const float* cw1, unsigned char* cw1_8, const int cit) {
    int tid = tid_of(wave_s); asm volatile("" : "+v"(tid));
    const int lane = tid & 63, r32 = lane & 31, hi = lane >> 5; const int wid = __builtin_amdgcn_readfirstlane(tid >> 6);
    const long rowbase = (long)b * SEQ; const int q0 = qb * 256;
    const unsigned char* const qkv8 = (const unsigned char*)qkv; const long rb0 = rowbase >> 4;
    const unsigned char* Qw = qkv8 + qkv_tile(rb0 + (q0 >> 4) + 2 * wid + (r32 >> 4), 12 + h) + hi * 256 + (r32 & 15) * 16;
    const unsigned lds0 = (unsigned)(uintptr_t)shm;
    LAS float* wsf = (LAS float*)(shm + MK_WS) + wid * 64;
    const unsigned koff = (unsigned)((lane >> 4) * (int)QKV_RB + (lane & 15) * 16);
    const unsigned voff = (unsigned)((lane & 3) * 256 + (lane >> 2) * 16);
    const unsigned kdst = lds0 + MK_K + wid * 1024, vdst = lds0 + MK_V + wid * 1024;
#define DMA_K(t, slot) glds16s(koff, qkv8 + qkv_tile(rb0 + 4 * (long)(t), 20 + h) + wid * 256, (unsigned)__builtin_amdgcn_readfirstlane(kdst + (slot)))
#define DMA_V(t, slot) glds16s(voff, qkv8 + qkv_tile(rb0 + 4 * (long)(t) + (wid & 3), 28 + h) + (wid >> 2) * 1024, (unsigned)__builtin_amdgcn_readfirstlane(vdst + (slot)))
    bf16x8 kf[8];
    const lds_cptr shm3 = (lds_cptr)shm; const lds_cptr kp0 = shm3 + MK_K + hi * 1024 + r32 * 16; const lds_cptr vp0 = shm3 + MK_V + ((lane >> 4) & 1) * 32 + (lane & 3) * 8 + (4 * hi + ((lane & 15) >> 2)) * 64;
    const int NT = (q0 + 256) / 64;
    if (!pre) { DMA_K(0, 0); DMA_K(1, SLOTB); DMA_K(2, 2 * SLOTB); }
    bf16x8 qr[4];
    if (!pre) {
#pragma unroll
        for (int d0 = 0; d0 < 4; ++d0) qr[d0] = *reinterpret_cast<const bf16x8*>(Qw + d0 * 512);
    } else {
#pragma unroll
        for (int d0 = 0; d0 < 4; ++d0) qr[d0] = qpre[d0];
    }
    DMA_V(0, 0);
    float mhat = 0.f, l_reg = 0.f; f32x16 o[2], negm;
    { float zf = 0.f; asm volatile("" : "+v"(zf));
#pragma unroll
      for (int r = 0; r < 16; ++r) { o[0][r] = zf; o[1][r] = zf; negm[r] = zf; } }
    asm volatile("" : "+v"(negm));
    const int qrel = wid * 32 + r32;
#define CMASK(P0, P1, t) do { int jb_ = (t) - (NT - 4); if (jb_ >= 0) cmask(P0, P1, jb_, qrel, hi); } while (0)
    bool resc = false;
#define START(P0, P1) do { const float rm = rowmax_a(P0, P1); resc = false; \
    { const float dl = (rm > 0.1f * NEGB) ? rm : 0.f;      mhat = fadd_s(mhat, dl); \
      _Pragma("unroll") for (int r = 0; r < 16; ++r) { P0[r] = fsub_s(P0[r], dl); P1[r] = fsub_s(P1[r], dl); } \
      const float nm_ = ONB(1) ? -mhat : NEGB; \
      _Pragma("unroll") for (int r = 0; r < 16; ++r) negm[r] = nm_; asm volatile("" : "+v"(negm)); } \
    _Pragma("unroll") for (int r = 0; r < 16; ++r) P0[r] = __builtin_amdgcn_exp2f(P0[r]); } while (0)
#define RESC() do { if (resc) { asm volatile("s_waitcnt lgkmcnt(0)" ::: "memory"); \
      _Pragma("unroll") for (int d_ = 0; d_ < 2; ++d_) _Pragma("unroll") for (int r = 0; r < 16; ++r) o[d_][r] *= wsf[crow(r, hi)]; } } while (0)
    f32x16 pA0, pA1, pB0, pB1;
    int sl_prev = 0, sl_cur = 0, sl_next = SLOTB;
#define ROT() do { sl_prev = sl_cur; sl_cur = sl_next; sl_next = (sl_next == 2 * SLOTB) ? 0 : sl_next + SLOTB; } while (0)
    MK_WAIT_BAR(1);
    unsigned sel = 0u;
    if (qb <= 3) sel = (1u << qb) - 1u;
    else {
        const LAS float* ksl = (const LAS float*)(shm + MK_KS);
        float gv[7];
#pragma unroll
        for (int i = 0; i < 7; ++i) {
            float s = 0.f;
#pragma unroll
            for (int d0 = 0; d0 < 4; ++d0) {
                const f32x4 k0 = *(const LAS f32x4*)(ksl + i * 64 + 16 * d0 + 8 * hi), k1 = *(const LAS f32x4*)(ksl + i * 64 + 16 * d0 + 8 * hi + 4);
#pragma unroll
                for (int jj = 0; jj < 4; ++jj) { s += bf2f((unsigned short)qr[d0][jj]) * k0[jj]; s += bf2f((unsigned short)qr[d0][4 + jj]) * k1[jj]; }
            }
            auto rr = __builtin_amdgcn_permlane32_swap(__float_as_uint(s), __float_as_uint(s), false, false);
            s = __uint_as_float(rr[0]) + __uint_as_float(rr[1]);
            gv[i] = (i < qb) ? s : -INFINITY;
        }
#pragma unroll
        for (int rk = 0; rk < 3; ++rk) { float best = -INFINITY; int bi = 0;
#pragma unroll
            for (int i = 0; i < 7; ++i) { const bool c = (((sel >> i) & 1u) == 0u) && (gv[i] > best); best = c ? gv[i] : best; bi = c ? i : bi; }
            sel |= 1u << bi; }
    }
#define ONB(tt) (((tt) >= NT - 4) ? true : (((sel >> ((tt) >> 2)) & 1u) != 0u))
#define SETNEGM(tt) do { const float nm_ = ONB(tt) ? -mhat : NEGB; _Pragma("unroll") for (int r = 0; r < 16; ++r) negm[r] = nm_; asm volatile("" : "+v"(negm)); } while (0)
    SETNEGM(0);
    qkt(pA0, pA1, kp0, qr, negm); asm volatile("s_nop 15\n\ts_nop 7" : "+v"(pA0), "+v"(pA1)); CMASK(pA0, pA1, 0);
    START(pA0, pA1);
    _Pragma("unroll") for (int r = 0; r < 16; ++r) pA1[r] = __builtin_amdgcn_exp2f(pA1[r]);
    MK_WAIT_BAR(0);
    DMA_K(3, 0); DMA_V(1, SLOTB);
    ROT();
    kload8(kf, kp0 + sl_cur);
    MK_WAIT_BAR(2);
    s16x4 vlo[8], vhi[8]; u32x4 pw0, pw1, pw2, pw3;
#define PKW(P, B) cvtpk(P[B], P[B + 1])
#define PAF(k) __builtin_bit_cast(bf16x8, pw##k)
#define VFR(i) (bf16x8){vlo[i][0], vlo[i][1], vlo[i][2], vlo[i][3], vhi[i][0], vhi[i][1], vhi[i][2], vhi[i][3]}
#define PIN(x) asm volatile("" : "+v"(x))
#define MX3(a, b, c) __builtin_fmaxf(__builtin_fmaxf((a), (b)), (c))
#define GAPA(MF, A0, A1, A2, A3, W0, W1, PW) do { MF; sacc += A0; sacc += A1; sacc += A2; sacc += A3; PIN(sacc); W0; W1; PIN(PW); ATT_SBAR(); } while (0)
#define EX(v) __builtin_amdgcn_exp2f(v)
#define GAPB(MF, X, B) do { MF; X[B] = EX(X[B]); X[B + 1] = EX(X[B + 1]); X[B + 2] = EX(X[B + 2]); X[B + 3] = EX(X[B + 3]); PIN(X); ATT_SBAR(); } while (0)
#define VRD(i) do { vlo[i] = vtr(vp_ + (((i) >> 2) * 4096 + ((i) & 3) * 1024)); vhi[i] = vtr(vp_ + (((i) >> 2) * 4096 + ((i) & 3) * 1024 + 512)); } while (0)
#define KRD(G, j) do { if (G) { kload2(kf, kp0 + sl_next, j); ATT_SBAR(); } } while (0)
#define MF32(a, b, c) __builtin_amdgcn_mfma_f32_32x32x16_bf16(a, b, c, 0, 0, 0)
#define STEP(C0, C1, P0, P1, t, GK, GV, GL) do { ATT_SBAR(); \
    const lds_cptr vp_ = vp0 + sl_prev; \
    VRD(0); ATT_SBAR(); float sacc = (P0[0] + P0[1]); \
    GAPA(C0 = MF32(kf[0], qr[0], negm), P0[2], P0[3], P0[4], P0[5],     pw0[0] = PKW(P0, 0), pw0[1] = PKW(P0, 2), pw0); \
    VRD(4); ATT_SBAR(); GAPA(C1 = MF32(kf[1], qr[0], negm), P0[6], P0[7], P0[8], P0[9],     pw0[2] = PKW(P0, 4), pw0[3] = PKW(P0, 6), pw0); \
    VRD(1); ATT_SBAR(); GAPA(C0 = MF32(kf[2], qr[1], C0),   P0[10], P0[11], P0[12], P0[13], pw1[0] = PKW(P0, 8), pw1[1] = PKW(P0, 10), pw1); \
    VRD(5); ATT_SBAR(); GAPA(C1 = MF32(kf[3], qr[1], C1),   P0[14], P0[15], P1[0], P1[1],   pw1[2] = PKW(P0, 12), pw1[3] = PKW(P0, 14), pw1); \
    VRD(2); ATT_SBAR(); GAPA(C0 = MF32(kf[4], qr[2], C0),   P1[2], P1[3], P1[4], P1[5],     pw2[0] = PKW(P1, 0), pw2[1] = PKW(P1, 2), pw2); \
    VRD(6); ATT_SBAR(); GAPA(C1 = MF32(kf[5], qr[2], C1),   P1[6], P1[7], P1[8], P1[9],     pw2[2] = PKW(P1, 4), pw2[3] = PKW(P1, 6), pw2); \
    VRD(3); ATT_SBAR(); GAPA(C0 = MF32(kf[6], qr[3], C0),   P1[10], P1[11], P1[12], P1[13], pw3[0] = PKW(P1, 8), pw3[1] = PKW(P1, 10), pw3); \
    VRD(7); ATT_SBAR(); GAPA(C1 = MF32(kf[7], qr[3], C1),   P1[14], P1[15], 0.f, 0.f,       pw3[2] = PKW(P1, 12), pw3[3] = PKW(P1, 14), pw3); \
    l_reg += sacc; \
    if (GK) { DMA_K((t) + 3, sl_cur); } if (GV) { DMA_V((t) + 1, sl_next); } \
    CMASK(C0, C1, t); \
    { float a = MX3(C0[0], C0[1], C1[0]), b_ = MX3(C0[2], C0[3], C1[1]); a = MX3(a, C1[2], C1[3]); \
      _Pragma("unroll") for (int r = 4; r < 16; r += 4) { a = MX3(a, C0[r], C0[r + 1]); b_ = MX3(b_, C0[r + 2], C0[r + 3]); a = MX3(a, C1[r], C1[r + 1]); b_ = MX3(b_, C1[r + 2], C1[r + 3]); } \
      float rm = __builtin_fmaxf(a, b_); { auto rr = __builtin_amdgcn_permlane32_swap(__float_as_uint(rm), __float_as_uint(rm), false, false); rm = __builtin_fmaxf(__uint_as_float(rr[0]), __uint_as_float(rr[1])); } \
      resc = false; \
      const bool blk_ = (((t) + 1) & 3) == 0;                    \
      if (__builtin_expect(__any(rm > (float)THRL), 0)) { const float dl = __builtin_fmaxf(rm, 0.f); mhat += dl; \
        _Pragma("unroll") for (int r = 0; r < 16; ++r) { C0[r] -= dl; C1[r] -= dl; } \
        const float nm_ = ONB((t) + 1) ? -mhat : NEGB; \
        _Pragma("unroll") for (int r = 0; r < 16; ++r) negm[r] = nm_; asm volatile("" : "+v"(negm)); \
        const float f = __builtin_amdgcn_exp2f(-dl); l_reg *= f; if (hi == 0) wsf[r32] = f; resc = true; } \
      else if (blk_) { SETNEGM((t) + 1); } } \
    ATT_SBAR(); \
    GAPB(o[0] = MF32(PAF(0), VFR(0), o[0]), C0, 0); \
    GAPB(o[1] = MF32(PAF(0), VFR(4), o[1]), C0, 4); \
    KRD(GL, 0); GAPB(o[0] = MF32(PAF(1), VFR(1), o[0]), C0, 8); \
    KRD(GL, 1); GAPB(o[1] = MF32(PAF(1), VFR(5), o[1]), C0, 12); \
    KRD(GL, 2); GAPB(o[0] = MF32(PAF(2), VFR(2), o[0]), C1, 0); \
    KRD(GL, 3); GAPB(o[1] = MF32(PAF(2), VFR(6), o[1]), C1, 4); \
    GAPB(o[0] = MF32(PAF(3), VFR(3), o[0]), C1, 8); \
    GAPB(o[1] = MF32(PAF(3), VFR(7), o[1]), C1, 12); \
    } while (0)
    int t = 1;
#undef CMASK
#define CMASK(P0, P1, t) do { } while (0)
    for (; t + 5 < NT; t += 2) {
        STEP(pB0, pB1, pA0, pA1, t, true, true, true);       MK_WAIT_BAR(2); RESC(); ROT();
        STEP(pA0, pA1, pB0, pB1, t + 1, true, true, true);   MK_WAIT_BAR(2); RESC(); ROT();
    }
#undef CMASK
#define CMASK(P0, P1, t) do { int jb_ = (t) - (NT - 4); if (jb_ >= 0) cmask(P0, P1, jb_, qrel, hi); } while (0)
#define ENDW(tt) do { if ((tt) + 3 < NT) { MK_WAIT_BAR(2); } else if ((tt) + 2 < NT) { MK_WAIT_BAR(1); } else { MK_WAIT_BAR(0); } } while (0)
    for (; t + 1 < NT; t += 2) {
        STEP(pB0, pB1, pA0, pA1, t, (t + 3 < NT), (t + 1 < NT), (t + 1 < NT));           ENDW(t);     RESC(); ROT();
        STEP(pA0, pA1, pB0, pB1, t + 1, (t + 4 < NT), (t + 2 < NT), (t + 2 < NT));       ENDW(t + 1); RESC(); ROT();
    }
    if (nxt) { DMA_K(0, 0); DMA_K(1, SLOTB); DMA_K(2, 2 * SLOTB); }
    f32x4 cv[16];
    if (cit < NE * 512) { int t_ = tid_of(wave_s); asm volatile("" : "+v"(t_)); cvt_load<64>(cw1 + (size_t)(cit >> 9) * 1024 * 2048, 2048, cit & 511, t_ & 63, cv); }
    STEP(pB0, pB1, pA0, pA1, NT - 1, false, false, false); RESC();
    { float sacc = pB0[0] + pB0[1]; _Pragma("unroll") for (int r = 2; r < 16; ++r) sacc += pB0[r]; _Pragma("unroll") for (int r = 0; r < 16; ++r) sacc += pB1[r]; l_reg += sacc;
      pw0 = (u32x4){PKW(pB0, 0), PKW(pB0, 2), PKW(pB0, 4), PKW(pB0, 6)}; pw1 = (u32x4){PKW(pB0, 8), PKW(pB0, 10), PKW(pB0, 12), PKW(pB0, 14)}; pw2 = (u32x4){PKW(pB1, 0), PKW(pB1, 2), PKW(pB1, 4), PKW(pB1, 6)}; pw3 = (u32x4){PKW(pB1, 8), PKW(pB1, 10), PKW(pB1, 12), PKW(pB1, 14)};
      ATT_SBAR(); const int vb0 = (int)(lds0 + MK_V) + ((lane >> 4) & 1) * 32 + (lane & 3) * 8 + (4 * hi + ((lane & 15) >> 2)) * 64; pv(o, vb0 + sl_cur, PAF(0), PAF(1), PAF(2), PAF(3)); }
#undef PKW
#undef PAF
#undef VFR
#undef PIN
#undef MX3
#undef GAPA
#undef GAPB
#undef EX
#undef VRD
#undef KRD
#undef MF32
#undef STEP
#undef ENDW
    {
        int t_ = tid_of(wave_s); asm volatile("" : "+v"(t_)); const int r_ = t_ & 31, h_ = (t_ >> 5) & 1;
        const unsigned char* Qn = qkv8 + qkv_tile(rb0 + ((q0 + (nxt ? 256 : 0)) >> 4) + 2 * wid + (r_ >> 4), 12 + h) + h_ * 256 + (r_ & 15) * 16;
#pragma unroll
        for (int d0 = 0; d0 < 4; ++d0) qpre[d0] = *reinterpret_cast<const bf16x8*>(Qn + d0 * 512);
    }
    { auto rr = __builtin_amdgcn_permlane32_swap(__float_as_uint(l_reg), __float_as_uint(l_reg), false, false); l_reg = __uint_as_float(rr[0]) + __uint_as_float(rr[1]); }
    if (hi == 0) wsf[32 + r32] = l_reg; asm volatile("s_waitcnt lgkmcnt(0)" ::: "memory");
    float rli[16];
#pragma unroll
    for (int r = 0; r < 16; ++r) rli[r] = __builtin_amdgcn_rcpf(wsf[32 + crow(r, hi)]);
    unsigned char* Ow = aout + (rowbase + q0 + wid * 32) * D + 512 + 64 * h;
    { LAS unsigned char* stg = (LAS unsigned char*)(shm + MK_OST) + wid * 2048;
#pragma unroll
      for (int r = 0; r < 16; ++r) { const int orow = crow(r, hi);
#pragma unroll
          for (int d0 = 0; d0 < 2; ++d0) { const float v = o[d0][r] * rli[r] * AO_SCALE; stg[orow * 64 + d0 * 32 + r32] = (unsigned char)__builtin_amdgcn_cvt_pk_fp8_f32(v, v, 0, false); } }
      asm volatile("s_waitcnt lgkmcnt(0)" ::: "memory");
#pragma unroll
      for (int i = 0; i < 2; ++i) { const int row = i * 16 + (lane >> 2), ch = lane & 3; const u32x4 v = *(const LAS u32x4*)(stg + row * 64 + ch * 16); *(u32x4*)(Ow + (long)row * D + ch * 16) = v; } }
    if (cit < NE * 512) { int t_ = tid_of(wave_s); asm volatile("" : "+v"(t_)); cvt_store<64>(cw1_8 + (size_t)(cit >> 9) * 2048 * 1024, 2048, 2, W_SCALE, cit & 511, t_ & 63, cv); }
    asm volatile("s_waitcnt lgkmcnt(0)\n\ts_barrier" ::: "memory");
#undef DMA_K
#undef DMA_V
#undef CMASK
#undef START
#undef RESC
#undef ROT
#undef ONB
#undef SETNEGM
}
}

__device__ __forceinline__ void sincos_d(double a, double& s, double& c) {
    const double q = __builtin_rint(a * 0.63661977236758134308);
    double r = __builtin_fma(-q, 1.57079632679489655800e+00, a);
    r = __builtin_fma(-q, 6.12323399573676603587e-17, r);
    const double r2 = r * r;
    double sp = -1.0 / 1307674368000.0;
    sp = sp * r2 + 1.0 / 6227020800.0; sp = sp * r2 - 1.0 / 39916800.0; sp = sp * r2 + 1.0 / 362880.0; sp = sp * r2 - 1.0 / 5040.0; sp = sp * r2 + 1.0 / 120.0; sp = sp * r2 - 1.0 / 6.0;
    const double sr = r + r * r2 * sp;
    double cp = 1.0 / 20922789888000.0;
    cp = cp * r2 - 1.0 / 87178291200.0; cp = cp * r2 + 1.0 / 479001600.0; cp = cp * r2 - 1.0 / 3628800.0; cp = cp * r2 + 1.0 / 40320.0; cp = cp * r2 - 1.0 / 720.0; cp = cp * r2 + 1.0 / 24.0; cp = cp * r2 - 0.5;
    const double cr = 1.0 + r2 * cp;
    const int n = ((int)q) & 3;
    s = (n == 0) ? sr : (n == 1) ? cr : (n == 2) ? -sr : -cr;
    c = (n == 0) ? cr : (n == 1) ? -sr : (n == 2) ? -cr : sr;
}
__device__ __forceinline__ int sigma_col(int p, int mode) {
    if (mode == 0) return (p & ~255) + 64 * ((p >> 5) & 3) + 32 * ((p >> 7) & 1) + pg8::perm32(p & 31);
    if (mode == 1) return (p & ~31) + pg8::perm32(p & 31);
    if (mode == 3) return (p & ~255) + 64 * ((p >> 5) & 3) + 16 * ((p >> 2) & 3) + 8 * ((p >> 7) & 1) + 4 * ((p >> 4) & 1) + (p & 3);
    const int pn = p >> 8, q = p & 255; return 2 * (128 * pn + 32 * ((q >> 5) & 3) + pg8::perm32(q & 31)) + (q >> 7);
}
__device__ __forceinline__ void p0_transpose_item(const float* __restrict__ W, int N, bf16_t* __restrict__ WT, int mode, LAS float* scr, int item, int lane) {
    const int nblk = N / 32, kb = item / nblk, nb = item % nblk, k0 = 64 * kb, p0 = 32 * nb;
    const int sc = sigma_col(p0 + (lane & 31), mode);
#pragma unroll 8
    for (int i = 0; i < 32; ++i) { const int kk = 2 * i + (lane >> 5); scr[kk * 33 + (lane & 31)] = W[(size_t)(k0 + kk) * N + sc]; }
    LDS_WAIT(); asm volatile("" ::: "memory");
    const int c = lane & 7;
#pragma unroll
    for (int j = 0; j < 4; ++j) { const int n = (lane >> 3) + 8 * j; const LAS float* s = scr + (8 * c) * 33 + n;
        u32x4 o; o.x = cvtpk(s[0 * 33], s[1 * 33]); o.y = cvtpk(s[2 * 33], s[3 * 33]); o.z = cvtpk(s[4 * 33], s[5 * 33]); o.w = cvtpk(s[6 * 33], s[7 * 33]);
        *(u32x4*)(WT + (size_t)(p0 + n) * 1024 + k0 + 8 * c) = o; }
    LDS_WAIT(); asm volatile("" ::: "memory");
}

__device__ __forceinline__ void p0_transpose_item_fp8(const float* __restrict__ W, int N, unsigned char* __restrict__ WT, int mode, float scale, LAS float* scr, int item, int lane) {
    const int nblk = N / 32, kb = item / nblk, nb = item % nblk, k0 = 64 * kb, p0 = 32 * nb;
    const int sc = sigma_col(p0 + (lane & 31), mode);
#pragma unroll 8
    for (int i = 0; i < 32; ++i) { const int kk = 2 * i + (lane >> 5); scr[kk * 33 + (lane & 31)] = W[(size_t)(k0 + kk) * N + sc] * scale; }
    LDS_WAIT(); asm volatile("" ::: "memory");
    const int c = lane & 7;
#pragma unroll
    for (int j = 0; j < 4; ++j) { const int n = (lane >> 3) + 8 * j; const LAS float* s = scr + (8 * c) * 33 + n;
        u32x2 o; o.x = pk4_fp8(s[0 * 33], s[1 * 33], s[2 * 33], s[3 * 33]); o.y = pk4_fp8(s[4 * 33], s[5 * 33], s[6 * 33], s[7 * 33]);
        *(u32x2*)(WT + (size_t)(p0 + n) * 1024 + k0 + 8 * c) = o; }
    LDS_WAIT(); asm volatile("" ::: "memory");
}


__device__ __forceinline__ int inv32(int c) { return 16 * ((c >> 2) & 1) + 4 * (c >> 3) + (c & 3); }
__device__ __forceinline__ int pos_of(int c, int mode) {
    if (mode == 0) return (c & ~255) + (((c >> 6) & 3) << 5) + (((c >> 5) & 1) << 7) + inv32(c & 31);
    if (mode == 1) return (c & ~31) + inv32(c & 31);
    if (mode == 3) return (c & ~255) + 128 * ((c >> 3) & 1) + 32 * ((c >> 6) & 3) + 16 * ((c >> 2) & 1) + 4 * ((c >> 4) & 3) + (c & 3);
    const int par = c & 1, h = c >> 1; return 256 * (h >> 7) + 128 * par + 32 * ((h >> 5) & 3) + inv32(h & 31);
}
template <int CW>
__device__ __forceinline__ void cvt_load(const float* __restrict__ W, int N, int item, int lane, f32x4 (&v)[16]) {
    constexpr int LPR = CW / 4, KR = 16 * (64 / LPR);
    const int ncb = N / CW, kb = item / ncb, cb = item % ncb;
    const int cl = lane % LPR, g = lane / LPR;
    const int c0 = CW * cb + 4 * cl, k0 = KR * kb + 16 * g;
    const float* src = W + (size_t)k0 * N + c0;
#pragma unroll
    for (int i = 0; i < 16; ++i) v[i] = __builtin_nontemporal_load((const f32x4*)(src + (size_t)i * N));
}
template <int CW>
__device__ __forceinline__ void cvt_store(unsigned char* __restrict__ WT, int N, int mode, float scale, int item, int lane, const f32x4 (&v)[16]) {
    constexpr int LPR = CW / 4, KR = 16 * (64 / LPR);
    const int ncb = N / CW, kb = item / ncb, cb = item % ncb;
    const int cl = lane % LPR, g = lane / LPR;
    const int c0 = CW * cb + 4 * cl, k0 = KR * kb + 16 * g;
#pragma unroll
    for (int j = 0; j < 4; ++j) {
        u32x4 o;
        o.x = pk4_fp8(v[0][j] * scale, v[1][j] * scale, v[2][j] * scale, v[3][j] * scale);     o.y = pk4_fp8(v[4][j] * scale, v[5][j] * scale, v[6][j] * scale, v[7][j] * scale);
        o.z = pk4_fp8(v[8][j] * scale, v[9][j] * scale, v[10][j] * scale, v[11][j] * scale);   o.w = pk4_fp8(v[12][j] * scale, v[13][j] * scale, v[14][j] * scale, v[15][j] * scale);
        *(u32x4*)(WT + (size_t)pos_of(c0 + j, mode) * 1024 + k0) = o;
    }
}
__device__ __forceinline__ void cvt_load8(const float* __restrict__ W, int item, int lane, f32x4 (&v)[8]) {
    const int kb = item >> 5, cb = item & 31, cl = lane & 7, g = lane >> 3;
    const float* src = W + (size_t)(64 * kb + 8 * g) * 1024 + 32 * cb + 4 * cl;
#pragma unroll
    for (int i = 0; i < 8; ++i) v[i] = __builtin_nontemporal_load((const f32x4*)(src + (size_t)i * 1024));
}
__device__ __forceinline__ void cvt_store8(unsigned char* __restrict__ WT, int mode, float scale, int item, int lane, const f32x4 (&v)[8]) {
    const int kb = item >> 5, cb = item & 31, cl = lane & 7, g = lane >> 3;
    const int c0 = 32 * cb + 4 * cl, k0 = 64 * kb + 8 * g;
#pragma unroll
    for (int j = 0; j < 4; ++j) {
        u32x2 o; o.x = pk4_fp8(v[0][j] * scale, v[1][j] * scale, v[2][j] * scale, v[3][j] * scale); o.y = pk4_fp8(v[4][j] * scale, v[5][j] * scale, v[6][j] * scale, v[7][j] * scale);
        *(u32x2*)(WT + (size_t)pos_of(c0 + j, mode) * 1024 + k0) = o;
    }
}
template <int CW>
__device__ __forceinline__ void cvt_item(const float* __restrict__ W, int N, unsigned char* __restrict__ WT, int mode, float scale, int item, int lane) {
    f32x4 v[16]; cvt_load<CW>(W, N, item, lane, v); cvt_store<CW>(WT, N, mode, scale, item, lane, v);
}

struct CvtHook {
    const float* w1; unsigned char* w1_8; int gw, NGW, kbase;
    __device__ __forceinline__ void one(int k, int lane) const {
        constexpr int NIT1 = NE * 512;
        const int it = gw + NGW * k; if (it >= NIT1) return;
        const int e = it >> 9; cvt_item<64>(w1 + (size_t)e * 1024 * 2048, 2048, w1_8 + (size_t)e * 2048 * 1024, 2, W_SCALE, it & 511, lane);
    }
    struct State {};
    __device__ __forceinline__ void pre(int, int, State&) const {}
    __device__ __forceinline__ void operator()(int ui, int wave_s, State&) const { int t_ = tid_of(wave_s); asm volatile("" : "+v"(t_)); one(kbase + ui, t_ & 63); }
};
struct W2Hook {
    const float* w2; unsigned char* w2_8; int gw, NGW, step;
    struct State { f32x4 v[8]; int item; bool armed; };
    __device__ __forceinline__ void pre(int ui, int wave_s, State& st) const {
        constexpr int NIT2 = NE * 512;
        const int k = ui / step; st.item = gw + NGW * k; st.armed = (ui % step == 0) && (st.item < NIT2);
        if (st.armed) { int t_ = tid_of(wave_s); asm volatile("" : "+v"(t_)); cvt_load8(w2 + (size_t)(st.item >> 9) * 1024 * 1024, st.item & 511, t_ & 63, st.v); }
    }
    __device__ __forceinline__ void operator()(int, int wave_s, State& st) const {
        if (st.armed) { int t_ = tid_of(wave_s); asm volatile("" : "+v"(t_)); cvt_store8(w2_8 + (size_t)(st.item >> 9) * 1024 * 1024, 3, W_SCALE, st.item & 511, t_ & 63, st.v); }
    }
};

#define XB_TMO      128
#define XB_XCNT(j)  (256  + 64 * (j))
#define XB_XSUB(j)  (1280 + 64 * (j))
#define XB_XGEN(j)  (2304 + 64 * (j))
#define XB_TOP      3328
#define XB_TOPGEN   3392
#define XCD_BAR_WORDS 3456
#define XB_SPIN_CAP (1u << 18)
__device__ __forceinline__ unsigned xb_ld(unsigned* p)              { return __hip_atomic_load(p, __ATOMIC_RELAXED, __HIP_MEMORY_SCOPE_AGENT); }
__device__ __forceinline__ unsigned xb_add(unsigned* p, unsigned v) { return __hip_atomic_fetch_add(p, v, __ATOMIC_RELAXED, __HIP_MEMORY_SCOPE_AGENT); }
__device__ __forceinline__ unsigned xb_xcc_id() { return (unsigned)__builtin_amdgcn_s_getreg((3 << 11) | 20) & 0xFu; }
#define XB_SPIN(cond, bar) do { unsigned _sp = 0; while (cond) { __builtin_amdgcn_s_sleep(1); \
    if ((++_sp & 255u) == 0u) { if (xb_ld(&(bar)[XB_TMO])) break; if (_sp > XB_SPIN_CAP) { atomicAdd(&(bar)[XB_TMO], 1u); break; } } } } while (0)
struct XcdBarrier { unsigned* bar; unsigned x; volatile LAS unsigned* st; };
__device__ __forceinline__ XcdBarrier xcd_barrier_post(unsigned* bar, volatile LAS unsigned* st, const int wave_s) {
    XcdBarrier b; b.bar = bar; b.x = xb_xcc_id(); b.st = st;
    if (tid_of(wave_s) == 0) (void)xb_add(&bar[XB_XCNT(b.x)], 1u);
    return b;
}
__device__ __forceinline__ void xcd_barrier_complete(unsigned* bar, unsigned x, unsigned& nloc, unsigned& nx, unsigned& xmask) {
    const unsigned G = gridDim.x * gridDim.y * gridDim.z;
    unsigned sum, cnt, mine, sp = 0u;
    for (;;) {
        sum = 0u; cnt = 0u; mine = 0u; xmask = 0u;
#pragma unroll
        for (unsigned j = 0; j < 16; ++j) { const unsigned c = xb_ld(&bar[XB_XCNT(j)]); sum += c; cnt += (c > 0u) ? 1u : 0u; xmask |= (c > 0u) ? (1u << j) : 0u; mine = (j == x) ? c : mine; }
        if (sum == G) break;
        __builtin_amdgcn_s_sleep(1);
        if ((++sp & 255u) == 0u) { if (xb_ld(&bar[XB_TMO])) break; if (sp > XB_SPIN_CAP) { atomicAdd(&bar[XB_TMO], 1u); break; } }
    }
    nloc = mine > 0u ? mine : 1u; nx = cnt > 0u ? cnt : 1u;
}
__device__ __forceinline__ void xcd_barrier(const XcdBarrier& b, const int wave_s) {
    asm volatile("s_waitcnt vmcnt(0)" ::: "memory");
    __syncthreads();
    if (tid_of(wave_s) == 0) {
        unsigned* bar = b.bar;
        __builtin_amdgcn_s_waitcnt(0);
        unsigned nloc = b.st[0], nx = b.st[1], xmask = b.st[2];
        if (nloc == 0u) { xcd_barrier_complete(bar, b.x, nloc, nx, xmask); b.st[0] = nloc; b.st[1] = nx; b.st[2] = xmask; }
        const unsigned old = xb_add(&bar[XB_XSUB(b.x)], 1u);
        const unsigned gen = old / nloc;
        if (old + 1u == (gen + 1u) * nloc) {
            __builtin_amdgcn_fence(__ATOMIC_RELEASE, "agent");
            asm volatile("s_waitcnt vmcnt(0)" ::: "memory");
            const unsigned og = xb_add(&bar[XB_TOP], 1u);
            const unsigned tg = og / nx;
            if (og + 1u == (tg + 1u) * nx) {
#pragma unroll
                for (unsigned j = 0; j < 16; ++j) if ((xmask >> j) & 1u) (void)xb_add(&bar[XB_XGEN(j)], 1u);
            }
        }
        XB_SPIN(xb_ld(&bar[XB_XGEN(b.x)]) == gen, bar);
        __builtin_amdgcn_fence(__ATOMIC_ACQUIRE, "agent");
        asm volatile("s_waitcnt vmcnt(0)" ::: "memory");
    }
    __syncthreads();
}

__global__ void __launch_bounds__(NTHREADS, 2) fwd_megakernel(Params p_arg) {
    extern __shared__ __attribute__((aligned(16))) unsigned char lds_raw[];
    LAS unsigned char* lds = (LAS unsigned char*)lds_raw;
#define PHASE_IDS() int tid = tid_of(wave_s); asm volatile("" : "+v"(tid)); const int lane = tid & 63, wave = wave_s; (void)lane; (void)wave
    const int G = gridDim.x, bx = blockIdx.x;
    const int wave_s = __builtin_amdgcn_readfirstlane((int)threadIdx.x >> 6);
    typedef const __attribute__((address_space(4))) Params* KParams;
    const KParams kp0 = (KParams)__builtin_amdgcn_kernarg_segment_ptr();
#define PHASE_PTRS() KParams _kp = kp0; asm volatile("" : "+s"(_kp)); Params p; p.x = _kp->x; p.w_in = _kp->w_in; p.b_in = _kp->b_in; p.sinks = _kp->sinks; p.w_out = _kp->w_out; p.b_out = _kp->b_out; p.ln1_g = _kp->ln1_g; p.ln1_b = _kp->ln1_b; \
    p.w_router = _kp->w_router; p.b_router = _kp->b_router; p.w1 = _kp->w1; p.b1 = _kp->b1; p.w2 = _kp->w2; p.b2 = _kp->b2; p.ln2_g = _kp->ln2_g; p.ln2_b = _kp->ln2_b; p.out = _kp->out; p.ws = _kp->ws; unsigned char* const ws = p.ws; \
    unsigned* const ctl = (unsigned*)(ws + WS_CTL); float* const ksum = (float*)(ws + WS_KSUM); float* const rope = (float*)(ws + WS_ROPE); \
    bf16_t* const w_in_t = (bf16_t*)(ws + WS_WIN_T); bf16_t* const w_out_t = (bf16_t*)(ws + WS_WOUT_T); \
    unsigned char* const w1_8 = ws + WS_W1_8; unsigned char* const w2_8 = ws + WS_W2_8; unsigned char* const x1_8 = ws + WS_X1_8; unsigned char* const act8 = ws + WS_ACT8; \
    int* const cnt_blk = (int*)(ws + WS_CNT); int* const tile_e = (int*)(ws + WS_TILE_E); bf16_t* const wr_hi = (bf16_t*)(ws + WS_WR_HI); bf16_t* const wr_lo = (bf16_t*)(ws + WS_WR_LO); \
    int* const tok = (int*)(ws + WS_TOK); int* const asg_e = (int*)(ws + WS_ASG_E); float* const asg_g = (float*)(ws + WS_ASG_G); int* const asg_d = (int*)(ws + WS_ASG_D); \
    bf16_t* const x1b = (bf16_t*)(ws + WS_X1B); bf16_t* const xb = (bf16_t*)(ws + WS_XB); bf16_t* const attn_o = xb; bf16_t* const qkv = (bf16_t*)(ws + WS_QKV); unsigned char* const yb = ws + WS_YB; \
    (void)ctl; (void)ksum; (void)rope; (void)w_in_t; (void)w_out_t; (void)w1_8; (void)w2_8; (void)x1_8; (void)act8; (void)cnt_blk; (void)tile_e; (void)wr_hi; (void)wr_lo; (void)tok; (void)asg_e; (void)asg_g; (void)asg_d; \
    float* const stats = (float*)(ws + WS_STATS); float* const rc = (float*)(ws + WS_RC); (void)stats; (void)rc; \
    (void)x1b; (void)xb; (void)attn_o; (void)qkv; (void)yb
    { const int t0 = tid_of(wave_s); if (t0 < 3) ((LAS unsigned*)(lds + LDS_BARST))[t0] = 0u; }
    __syncthreads();
    XcdBarrier xbar;
    { PHASE_PTRS(); xbar = xcd_barrier_post(ctl + CW_BAR, (volatile LAS unsigned*)(lds + LDS_BARST), wave_s); }

    REP(0) {
        PHASE_IDS(); PHASE_PTRS();
        const long gt = (long)bx * NTHREADS + tid, gsz = (long)G * NTHREADS;
        for (long i = gt; i < 2048 * 32; i += gsz) {
            const int pos = (int)(i >> 5), k = (int)(i & 31);
            double inv = 1.0; for (int q = 0; q < k; ++q) inv *= 0.7498942093324559;
            double s, c; sincos_d((double)pos * inv, s, c);
            rope[pos * 64 + k] = (float)c; rope[pos * 64 + 32 + k] = (float)s;
        }
        for (long i = gt; i < 32 * 1024; i += gsz) {
            const int e = (int)(i >> 10), k = (int)(i & 1023); const float w = p.ln1_g[k] * p.w_router[k * 32 + e];
            const unsigned h = f2bf(w); wr_hi[i] = (bf16_t)h; wr_lo[i] = (bf16_t)f2bf(w - bf2f(h));
        }
        for (int e = bx * 8 + wave; e < NE; e += G * 8) {
            float s1 = 0.f, s2 = 0.f;
            for (int k = lane; k < 1024; k += 64) { const float wr = p.w_router[k * 32 + e], w = p.ln1_g[k] * wr; const unsigned h = f2bf(w);
                s1 += bf2f(h) + bf2f(f2bf(w - bf2f(h))); s2 += p.ln1_b[k] * wr; }
            s1 = wave_sum(s1); s2 = wave_sum(s2);
            if (lane == 0) { rc[e] = s1; rc[32 + e] = s2 + p.b_router[e]; }
        }
        const int gw = bx * 8 + wave, NGW = G * 8;
        constexpr int I_IN = 8 * (INW / 32), I_OUT = 8 * 32, I_W1 = 16 * 32, I_W2 = 8 * 32;
        if (G * 8 * 8 < NE * 512) { for (int it = gw; it < NE * I_W2; it += NGW) { const int e = it / I_W2; cvt_item<32>(p.w2 + (size_t)e * 1024 * 1024, 1024, w2_8 + (size_t)e * 1024 * 1024, 3, W_SCALE, it % I_W2, lane); } }
        if (G * 8 * 8 < NE * 512) { for (int it = gw; it < NE * I_W1; it += NGW) { const int e = it / I_W1; cvt_item<64>(p.w1 + (size_t)e * 1024 * 2048, 2048, w1_8 + (size_t)e * 2048 * 1024, 2, W_SCALE, it % I_W1, lane); } }
        for (int it = gw; it < I_IN + I_OUT; it += NGW) {
            if (it < I_IN) cvt_item<32>(p.w_in, INW, (unsigned char*)w_in_t, 0, WIN_SCALE, it, lane);
            else cvt_item<32>(p.w_out, 1024, (unsigned char*)w_out_t, 0, W_SCALE, it - I_IN, lane);
        }
        const f32x4* x4 = (const f32x4*)p.x;
#if INPROJ_FP8
        unsigned* x8 = (unsigned*)xb;
        constexpr long NV = (long)T * D / 4;
        for (long i0 = gt; i0 < NV; i0 += 8 * gsz) {
            f32x4 a[8];
#pragma unroll
            for (int q = 0; q < 8; ++q) { const long i = i0 + q * gsz; a[q] = __builtin_nontemporal_load(x4 + (i < NV ? i : i0)); }
#pragma unroll
            for (int q = 0; q < 8; ++q) { const long i = i0 + q * gsz; if (i < NV) x8[i] = pk4_fp8(a[q][0], a[q][1], a[q][2], a[q][3]); }
        }
#else
        u32x4* xb4 = (u32x4*)xb;
        for (long i = gt; i < (long)T * D / 8; i += gsz) { const f32x4 a = x4[2 * i], b = x4[2 * i + 1];
            u32x4 o; o.x = cvtpk(a[0], a[1]); o.y = cvtpk(a[2], a[3]); o.z = cvtpk(b[0], b[1]); o.w = cvtpk(b[2], b[3]); xb4[i] = o; }
#endif
    }
    xcd_barrier(xbar, wave_s);

    REP(1) {
        PHASE_PTRS();
        pg8::SchedInProj<1024> S{(const char*)xb, (const char*)w_in_t, G, bx};
        pg8::EpiInProj E{qkv, p.b_in, rope, KPF / WIN_SCALE};
        pg8::gemm_phase<pg8::EpiInProj, pg8::SchedInProj<1024>, false, true, 512, true>(lds, S, E, wave_s);
    }
    xcd_barrier(xbar, wave_s);

    REP(2) for (int u = bx; u < 256; u += G) {
        PHASE_PTRS();
        { const int b = u >> 3, h = u & 7;
            att::moba_ksums(qkv, b, h, (LAS char*)lds, wave_s);
            bf16x8 qpre[4];
#pragma unroll
            for (int d0 = 0; d0 < 4; ++d0) qpre[d0] = (bf16x8){0, 0, 0, 0, 0, 0, 0, 0};
            for (int j = 0; j < 8; ++j) att::moba_unit<8>(b, h, j, qkv, (unsigned char*)attn_o, (LAS char*)lds, wave_s, j > 0, j < 7, qpre, p.w1, w1_8, (u == bx && G * 8 * 8 >= NE * 512) ? (bx * 8 + wave_s) + G * 8 * j : 0x7fffffff); }
        { const int b = u >> 3, kvh = (u >> 2) & 1, oct = u & 3;
            for (int rp_ = 0; rp_ < (((DUP_MASK >> 8) & 1) ? 2 : 1); ++rp_) att::swa_stream((LAS char*)lds, qkv, (unsigned char*)attn_o, b, kvh, oct * 8, 8, p.sinks, wave_s); }
    }
    xcd_barrier(xbar, wave_s);

    REP(3) for (int pm = bx; pm < T / 256; pm += G) {
        {
            PHASE_PTRS();
            pg8::SchedPanel S{(const char*)attn_o, (const char*)w_out_t, pm};
            pg8::EpiOutProj E{x1b, p.b_out, p.x};
            pg8::gemm_phase<pg8::EpiOutProj, pg8::SchedPanel, false, true, 512, true>(lds, S, E, wave_s);
        }
        __syncthreads();
        for (int rp3_ = 0; rp3_ < (((DUP_MASK >> 9) & 1) ? 2 : 1); ++rp3_) {
        {
            PHASE_IDS(); PHASE_PTRS();
#pragma unroll
            for (int i = 0; i < 16; ++i) { const int idx = tid + 512 * i, mat = idx >> 12, rw = (idx >> 7) & 31, ch = idx & 127;
                const u32x4 v = *(const u32x4*)((mat ? wr_lo : wr_hi) + rw * 1024 + ch * 8);
                *(LAS u32x4*)(lds + mat * 66048 + rw * 2064 + ch * 16) = v; }
        }
        {
            PHASE_IDS(); PHASE_PTRS();
            const bf16_t* ytmp = x1b;
            f32x4 gg[2][2], bb[2][2];
#pragma unroll
            for (int j = 0; j < 2; ++j)
#pragma unroll
                for (int h = 0; h < 2; ++h) { gg[j][h] = *(const f32x4*)(p.ln1_g + 512 * j + 8 * lane + 4 * h); bb[j][h] = *(const f32x4*)(p.ln1_b + 512 * j + 8 * lane + 4 * h); }
            constexpr int LNR = 2;
            for (int rr = 0; rr < 32; rr += LNR) {
                const size_t row0 = (size_t)pm * 256 + wave * 32 + rr;
                u32x4 raw[LNR][2]; float v[LNR][2][8]; float sm[LNR], sq[LNR];
#pragma unroll
                for (int q = 0; q < LNR; ++q)
#pragma unroll
                    for (int j = 0; j < 2; ++j) raw[q][j] = *(const u32x4*)(ytmp + (row0 + q) * D + 512 * j + 8 * lane);
#pragma unroll
                for (int q = 0; q < LNR; ++q) { float s_ = 0.f;
#pragma unroll
                    for (int j = 0; j < 2; ++j)
#pragma unroll
                        for (int c = 0; c < 4; ++c) { const unsigned w = raw[q][j][c]; v[q][j][2 * c] = bf2f(w & 0xffffu); v[q][j][2 * c + 1] = bf2f(w >> 16); s_ += v[q][j][2 * c] + v[q][j][2 * c + 1]; }
                    sm[q] = s_; }
#pragma unroll
                for (int q = 0; q < LNR; ++q) sm[q] = wave_sum(sm[q]);
#pragma unroll
                for (int q = 0; q < LNR; ++q) { const float mean = sm[q] * (1.0f / D); float s2 = 0.f;
#pragma unroll
                    for (int j = 0; j < 2; ++j)
#pragma unroll
                        for (int c = 0; c < 8; ++c) { v[q][j][c] -= mean; s2 += v[q][j][c] * v[q][j][c]; }
                    sq[q] = s2; }
#pragma unroll
                for (int q = 0; q < LNR; ++q) sq[q] = wave_sum(sq[q]);
#pragma unroll
                for (int q = 0; q < LNR; ++q) {
                    const float rstd = 1.0f / sqrtf(sq[q] * (1.0f / D) + LN_EPS);
                    if (lane == 0) *(float2*)(stats + 2 * (row0 + q)) = make_float2(sm[q] * (1.0f / D), rstd);
#pragma unroll
                    for (int j = 0; j < 2; ++j) {
                        float xv[8];
#pragma unroll
                        for (int c = 0; c < 8; ++c) xv[c] = v[q][j][c] * rstd * gg[j][c >> 2][c & 3] + bb[j][c >> 2][c & 3];
                        u32x2 fv; fv.x = pk4_fp8(xv[0], xv[1], xv[2], xv[3]); fv.y = pk4_fp8(xv[4], xv[5], xv[6], xv[7]);
                        *(u32x2*)(x1_8 + (row0 + q) * D + 512 * j + 8 * lane) = fv;
                    }
                }
            }
        }
        __syncthreads();
        {
            PHASE_IDS(); PHASE_PTRS();
            const int fr = lane & 15, fq = lane >> 4;
            f32x4 lacc[2][2];
#pragma unroll
            for (int m = 0; m < 2; ++m)
#pragma unroll
                for (int n = 0; n < 2; ++n) lacc[m][n] = (f32x4){0.f, 0.f, 0.f, 0.f};
            const size_t r0 = (size_t)pm * 256 + wave * 32;
            const int fr8 = fr & 7, hs = fr >> 3;
            const bf16_t* al = x1b + (r0 + fr8) * D + 8 * fq + 32 * hs;
            const LAS unsigned char* bh = lds + fr * 2064 + 16 * fq; const LAS unsigned char* bl = bh + 66048;
#pragma unroll 2
            for (int k0 = 0; k0 < 1024; k0 += 64) {
                bf16x8 a0[2], a1[2], b_hi[2][2], b_lo[2][2];
#pragma unroll
                for (int m = 0; m < 2; ++m) {
                    const u32x4 A = *(const u32x4*)(al + (size_t)m * 16 * D + k0), B = *(const u32x4*)(al + (size_t)(m * 16 + 8) * D + k0);
                    a0[m] = __builtin_bit_cast(bf16x8, pg8::ror8sel<0xC>(A, B)); a1[m] = __builtin_bit_cast(bf16x8, pg8::ror8sel<0x3>(B, A)); }
#pragma unroll
                for (int st = 0; st < 2; ++st)
#pragma unroll
                    for (int n = 0; n < 2; ++n) { b_hi[st][n] = *(const LAS bf16x8*)(bh + n * 16 * 2064 + (k0 + 32 * st) * 2); b_lo[st][n] = *(const LAS bf16x8*)(bl + n * 16 * 2064 + (k0 + 32 * st) * 2); }
#pragma unroll
                for (int m = 0; m < 2; ++m)
#pragma unroll
                    for (int n = 0; n < 2; ++n) {
                        lacc[m][n] = __builtin_amdgcn_mfma_f32_16x16x32_bf16(a0[m], b_hi[0][n], lacc[m][n], 0, 0, 0);
                        lacc[m][n] = __builtin_amdgcn_mfma_f32_16x16x32_bf16(a0[m], b_lo[0][n], lacc[m][n], 0, 0, 0);
                        lacc[m][n] = __builtin_amdgcn_mfma_f32_16x16x32_bf16(a1[m], b_hi[1][n], lacc[m][n], 0, 0, 0);
                        lacc[m][n] = __builtin_amdgcn_mfma_f32_16x16x32_bf16(a1[m], b_lo[1][n], lacc[m][n], 0, 0, 0);
                    }
            }
            __syncthreads();
            LAS float* lg = (LAS float*)lds;
#pragma unroll
            for (int m = 0; m < 2; ++m)
#pragma unroll
                for (int n = 0; n < 2; ++n)
#pragma unroll
                    for (int rg = 0; rg < 4; ++rg) lg[(wave * 32 + 16 * m + 4 * fq + rg) * 33 + 16 * n + fr] = lacc[m][n][rg];
        }
        __syncthreads();
        {
            PHASE_IDS(); PHASE_PTRS();
            LAS float* lg = (LAS float*)lds;
            LAS int* wcnt = (LAS int*)(lds + 36864);
            float t0 = -INFINITY, t1 = -INFINITY, t2 = -INFINITY, t3 = -INFINITY; int i0 = 0, i1 = 0, i2 = 0, i3 = 0;
            int rk0 = 0, rk1 = 0, rk2 = 0, rk3 = 0;
            if (tid < 256) {
                const float2 st = *(const float2*)(stats + 2 * ((size_t)pm * 256 + tid));
                const float nmr = -st.x * st.y;
                for (int e = 0; e < NE; ++e) {
                    const float xv = st.y * lg[tid * 33 + e] + (nmr * rc[e] + rc[32 + e]);
                    if (xv > t3) {
                        if (xv > t2) { t3 = t2; i3 = i2;
                            if (xv > t1) { t2 = t1; i2 = i1;
                                if (xv > t0) { t1 = t0; i1 = i0; t0 = xv; i0 = e; } else { t1 = xv; i1 = e; }
                            } else { t2 = xv; i2 = e; }
                        } else { t3 = xv; i3 = e; }
                    }
                }
                const unsigned selm = (1u << i0) | (1u << i1) | (1u << i2) | (1u << i3);
                for (int e = 0; e < NE; ++e) {
                    const bool has = ((selm >> e) & 1u) != 0u;
                    const unsigned long long bal = __ballot(has);
                    const int pre = __popcll(bal & ((1ull << lane) - 1ull));
                    if (e == i0) rk0 = pre; if (e == i1) rk1 = pre; if (e == i2) rk2 = pre; if (e == i3) rk3 = pre;
                    if (lane == 0) wcnt[wave * 32 + e] = __popcll(bal);
                }
            }
            __syncthreads();
            if (tid < 256) {
                const float e1 = __expf(t1 - t0), e2 = __expf(t2 - t0), e3 = __expf(t3 - t0);
                const float inv = 1.0f / (1.0f + e1 + e2 + e3);
                int b0 = 0, b1 = 0, b2 = 0, b3 = 0;
                for (int w = 0; w < wave; ++w) { b0 += wcnt[w * 32 + i0]; b1 += wcnt[w * 32 + i1]; b2 += wcnt[w * 32 + i2]; b3 += wcnt[w * 32 + i3]; }
                const size_t a = ((size_t)pm * 256 + tid) * 4;
                *(int4*)(asg_e + a) = make_int4(i0, i1, i2, i3);
                *(float4*)(asg_g + a) = make_float4(inv, e1 * inv, e2 * inv, e3 * inv);
                *(int4*)(asg_d + a) = make_int4(b0 + rk0, b1 + rk1, b2 + rk2, b3 + rk3);
            }
            if (tid < 32) cnt_blk[pm * 32 + tid] = wcnt[tid] + wcnt[32 + tid] + wcnt[64 + tid] + wcnt[96 + tid];
            __syncthreads();
        }
        }
    }
    xcd_barrier(xbar, wave_s);

    for (int pm = bx; pm < T / 256; pm += G) {
        PHASE_IDS(); PHASE_PTRS();
        LAS int* part_all = (LAS int*)lds; LAS int* part_pre = part_all + 512; LAS int* tot = part_pre + 512; LAS int* pre = tot + 32; LAS int* poff = pre + 32;
        { const int e = tid & 31, seg = tid >> 5; int sa = 0, sp = 0;
            for (int bb = seg * 16; bb < seg * 16 + 16; ++bb) { const int c = cnt_blk[bb * 32 + e]; sa += c; sp += (bb < pm) ? c : 0; }
            part_all[tid] = sa; part_pre[tid] = sp; }
        __syncthreads();
        if (tid < 32) { int sa = 0, sp = 0; for (int s = 0; s < 16; ++s) { sa += part_all[s * 32 + tid]; sp += part_pre[s * 32 + tid]; } tot[tid] = sa; pre[tid] = sp; }
        __syncthreads();
        if (tid == 0) { int off = 0; for (int e = 0; e < NE; ++e) { poff[e] = off; off += ((tot[e] + 255) >> 8) << 8; } poff[32] = off; }
        __syncthreads();
        if (tid < 256) {
            const int token = pm * 256 + tid; const size_t a = (size_t)token * 4;
            const int4 ee = *(const int4*)(asg_e + a); const int4 rk = *(const int4*)(asg_d + a);
            const int d0 = poff[ee.x] + pre[ee.x] + rk.x, d1 = poff[ee.y] + pre[ee.y] + rk.y, d2 = poff[ee.z] + pre[ee.z] + rk.z, d3 = poff[ee.w] + pre[ee.w] + rk.w;
            *(int4*)(asg_d + a) = make_int4(d0, d1, d2, d3);
            tok[d0] = token; tok[d1] = token; tok[d2] = token; tok[d3] = token;
        }
        if (pm < NE) {
            const int e = pm, n = tot[e], np = ((n + 255) >> 8) << 8, o = poff[e];
            for (int i = n + tid; i < np; i += NTHREADS) tok[o + i] = 0;
            for (int i = tid; i < (np >> 8); i += NTHREADS) tile_e[(o >> 8) + i] = e;
        }
        if (pm == 0 && tid == 0) ctl[CW_NTILES] = (unsigned)(poff[32] >> 8);
        __syncthreads();
    }
    xcd_barrier(xbar, wave_s);

    REP(5) {
        PHASE_PTRS(); const int ntiles = (int)ctl[CW_NTILES];
        { LAS int* tl = (LAS int*)(lds + LDSX_TILE); for (int i = tid_of(wave_s); i < ntiles; i += NTHREADS) tl[i] = tile_e[i]; __syncthreads(); }
        pg8::SchedMoe<8, true> S{(const char*)x1_8, (const char*)w1_8, (const LAS int*)(lds + LDSX_TILE), tok, ntiles, G, bx};
        pg8::EpiSwiglu E{act8, p.b1};
        W2Hook H2; H2.w2 = p.w2; H2.w2_8 = w2_8; H2.gw = bx * 8 + wave_s; H2.NGW = G * 8; H2.step = (G * 8 * 8 >= NE * 512) ? 4 : (1 << 20);
        pg8::gemm_phase<pg8::EpiSwiglu, pg8::SchedMoe<8, true>, true, true, 512, true, true, W2Hook>(lds, S, E, wave_s, H2);
    }
    xcd_barrier(xbar, wave_s);

    REP(6) {
        PHASE_PTRS(); const int ntiles = (int)ctl[CW_NTILES];
        { LAS int* tl = (LAS int*)(lds + LDSX_TILE); for (int i = tid_of(wave_s); i < ntiles; i += NTHREADS) tl[i] = tile_e[i]; __syncthreads(); }
        pg8::SchedMoe<4, false> S{(const char*)act8, (const char*)w2_8, (const LAS int*)(lds + LDSX_TILE), tok, ntiles, G, bx};
        pg8::EpiDown E{yb, p.b2};
        pg8::gemm_phase<pg8::EpiDown, pg8::SchedMoe<4, false>, false, true, 512, true, true>(lds, S, E, wave_s);
    }
    xcd_barrier(xbar, wave_s);

    REP(7) {
        PHASE_IDS(); PHASE_PTRS();
        const int gw = bx * 8 + wave, NGW = G * 8;
        f32x4 gg[2][2], bb[2][2];
#pragma unroll
        for (int j = 0; j < 2; ++j)
#pragma unroll
            for (int h = 0; h < 2; ++h) { gg[j][h] = *(const f32x4*)(p.ln2_g + 512 * j + 8 * lane + 4 * h); bb[j][h] = *(const f32x4*)(p.ln2_b + 512 * j + 8 * lane + 4 * h); }
        f32x4 ag[2][2], ab[2][2];
#pragma unroll
        for (int j = 0; j < 2; ++j)
#pragma unroll
            for (int h = 0; h < 2; ++h) { ag[j][h] = DN_ALPHA * *(const f32x4*)(p.ln1_g + 512 * j + 8 * lane + 4 * h); ab[j][h] = DN_ALPHA * *(const f32x4*)(p.ln1_b + 512 * j + 8 * lane + 4 * h); }
        constexpr int R = 2;
        for (int row0 = gw; row0 < T; row0 += R * NGW) {
            int4 dd[R]; float4 gt[R]; float2 st[R];
#pragma unroll
            for (int q = 0; q < R; ++q) { const int row = row0 + q * NGW < T ? row0 + q * NGW : row0; dd[q] = *(const int4*)(asg_d + (size_t)row * 4); gt[q] = *(const float4*)(asg_g + (size_t)row * 4); st[q] = *(const float2*)(stats + 2 * (size_t)row); }
            u32x4 xr[R][2]; u32x2 yk[R][4][2];
#pragma unroll
            for (int q = 0; q < R; ++q) { const int row = row0 + q * NGW < T ? row0 + q * NGW : row0;
#pragma unroll
                for (int j = 0; j < 2; ++j) {
                    xr[q][j] = *(const u32x4*)(x1b + (size_t)row * D + 512 * j + 8 * lane);
                    yk[q][0][j] = __builtin_nontemporal_load((const u32x2*)(yb + (size_t)dd[q].x * D + 512 * j + 8 * lane));
                    yk[q][1][j] = __builtin_nontemporal_load((const u32x2*)(yb + (size_t)dd[q].y * D + 512 * j + 8 * lane));
                    yk[q][2][j] = __builtin_nontemporal_load((const u32x2*)(yb + (size_t)dd[q].z * D + 512 * j + 8 * lane));
                    yk[q][3][j] = __builtin_nontemporal_load((const u32x2*)(yb + (size_t)dd[q].w * D + 512 * j + 8 * lane));
                } }
            float z[R][2][8]; float sm[R], sq[R];
#pragma unroll
            for (int q = 0; q < R; ++q) {
                const float g0 = gt[q].x * (1.0f / Y_SCALE), g1 = gt[q].y * (1.0f / Y_SCALE), g2 = gt[q].z * (1.0f / Y_SCALE), g3 = gt[q].w * (1.0f / Y_SCALE);
                const float rs = st[q].y, nmr = -st[q].x * st[q].y;
                float s_ = 0.f;
#pragma unroll
                for (int j = 0; j < 2; ++j)
#pragma unroll
                    for (int d = 0; d < 2; ++d) {
#define P7_PAIR(HH, SEL) do { \
                            const f32x2 a0 = __builtin_amdgcn_cvt_pk_f32_fp8((int)yk[q][0][j][d], SEL), a1 = __builtin_amdgcn_cvt_pk_f32_fp8((int)yk[q][1][j][d], SEL); \
                            const f32x2 a2 = __builtin_amdgcn_cvt_pk_f32_fp8((int)yk[q][2][j][d], SEL), a3 = __builtin_amdgcn_cvt_pk_f32_fp8((int)yk[q][3][j][d], SEL); \
                            const unsigned xw = xr[q][j][2 * d + HH]; \
                            const float lo = (bf2f(xw & 0xffffu) * rs + nmr) * ag[j][d][2 * HH] + ab[j][d][2 * HH] + g0 * a0.x + g1 * a1.x + g2 * a2.x + g3 * a3.x; \
                            const float hi = (bf2f(xw >> 16) * rs + nmr) * ag[j][d][2 * HH + 1] + ab[j][d][2 * HH + 1] + g0 * a0.y + g1 * a1.y + g2 * a2.y + g3 * a3.y; \
                            z[q][j][4 * d + 2 * HH] = lo; z[q][j][4 * d + 2 * HH + 1] = hi; s_ += lo + hi; } while (0)
                        P7_PAIR(0, false); P7_PAIR(1, true);
#undef P7_PAIR
                    }
                sm[q] = s_;
            }
#pragma unroll
            for (int q = 0; q < R; ++q) sm[q] = wave_sum(sm[q]);
#pragma unroll
            for (int q = 0; q < R; ++q) { const float mean = sm[q] * (1.0f / D); float s2 = 0.f;
#pragma unroll
                for (int j = 0; j < 2; ++j)
#pragma unroll
                    for (int c = 0; c < 8; ++c) { z[q][j][c] -= mean; s2 += z[q][j][c] * z[q][j][c]; }
                sq[q] = s2; }
#pragma unroll
            for (int q = 0; q < R; ++q) sq[q] = wave_sum(sq[q]);
#pragma unroll
            for (int q = 0; q < R; ++q) {
                const int row = row0 + q * NGW;
                if (row < T) {
                    const float rstd = 1.0f / sqrtf(sq[q] * (1.0f / D) + LN_EPS);
#pragma unroll
                    for (int j = 0; j < 2; ++j)
#pragma unroll
                        for (int h = 0; h < 2; ++h) {
                            f32x4 o;
#pragma unroll
                            for (int c = 0; c < 4; ++c) o[c] = z[q][j][4 * h + c] * rstd * gg[j][h][c] + bb[j][h][c];
                            *(f32x4*)(p.out + (size_t)row * D + 512 * j + 8 * lane + 4 * h) = o;
                        }
                }
            }
        }
    }
}

extern "C" void kernel_launch(void* const* d_in, const int* in_sizes, int n_in, void* d_out, int out_size, void* d_ws, size_t ws_size, hipStream_t stream) {
    static int grid_blocks = 0;
    if (grid_blocks == 0) {
        if (n_in != 16 || in_sizes[0] != T * D || out_size != T * D || ws_size < WS_END) {
            fprintf(stderr, "kernel_launch: unexpected shapes: n_in %d in0 %d out %d ws %zu (need %zu)\n", n_in, n_in > 0 ? in_sizes[0] : -1, out_size, ws_size, (size_t)WS_END); grid_blocks = -1; return; }
        int dev = 0, cus = 0, per_cu = 0;
        (void)hipGetDevice(&dev);
        (void)hipDeviceGetAttribute(&cus, hipDeviceAttributeMultiprocessorCount, dev);
        (void)hipFuncSetAttribute((const void*)fwd_megakernel, hipFuncAttributeMaxDynamicSharedMemorySize, LDS_BYTES);
        (void)hipOccupancyMaxActiveBlocksPerMultiprocessor(&per_cu, (const void*)fwd_megakernel, NTHREADS, LDS_BYTES);
        if (per_cu < 1) { fprintf(stderr, "kernel_launch: occupancy query reports %d blocks per CU\n", per_cu); per_cu = 1; }
        grid_blocks = cus;
        fprintf(stderr, "kernel_launch: cus=%d per_cu=%d grid=%d ws=%zu\n", cus, per_cu, grid_blocks, ws_size);
    }
    if (grid_blocks < 0) return;
    (void)hipMemsetAsync((char*)d_ws + WS_CTL, 0, CTL_ZERO_BYTES, stream);
    Params p{};
    p.x = (const float*)d_in[0]; p.w_in = (const float*)d_in[1]; p.b_in = (const float*)d_in[2]; p.sinks = (const float*)d_in[3]; p.w_out = (const float*)d_in[4]; p.b_out = (const float*)d_in[5];
    p.ln1_g = (const float*)d_in[6]; p.ln1_b = (const float*)d_in[7]; p.w_router = (const float*)d_in[8]; p.b_router = (const float*)d_in[9];
    p.w1 = (const float*)d_in[10]; p.b1 = (const float*)d_in[11]; p.w2 = (const float*)d_in[12]; p.b2 = (const float*)d_in[13]; p.ln2_g = (const float*)d_in[14]; p.ln2_b = (const float*)d_in[15];
    p.out = (float*)d_out; p.ws = (unsigned char*)d_ws;
    hipLaunchKernelGGL(fwd_megakernel, dim3(grid_blocks), dim3(NTHREADS), LDS_BYTES, stream, p);
    hipError_t e = hipPeekAtLastError();
    if (e != hipSuccess) fprintf(stderr, "launch failed: %s (grid %d)\n", hipGetErrorString(e), grid_blocks);
}
```

```cpp
#include <hip/hip_runtime.h>
#include <cstdio>
#include <cstdint>

#define LAS __attribute__((address_space(3)))
typedef unsigned short bf16_t;
typedef short bf16x8 __attribute__((ext_vector_type(8)));
typedef short s16x4 __attribute__((ext_vector_type(4)));
typedef float f32x2 __attribute__((ext_vector_type(2)));
typedef float f32x4 __attribute__((ext_vector_type(4)));
typedef float f32x16 __attribute__((ext_vector_type(16)));
typedef unsigned u32x2 __attribute__((ext_vector_type(2)));
typedef unsigned u32x4 __attribute__((ext_vector_type(4)));
typedef __bf16 bf16x2_t __attribute__((ext_vector_type(2)));

constexpr int D = 1024, BATCH = 32, SEQ = 2048, T = BATCH * SEQ;
constexpr int INW = 2304, NE = 32;
constexpr float LN_EPS = 1e-5f;
constexpr float DN_ALPHA = 1.189207115002721f;
constexpr float LOG2E = 1.4426950408889634f;
constexpr float C2 = 0.18033688011112042f;
constexpr int NTHREADS = 512;
constexpr int LDS_BYTES = 147456;
constexpr int MAX_TILES = 1056;
#ifndef INPROJ_FP8
#define INPROJ_FP8 1
#endif
#ifndef EPI_DUP
#define EPI_DUP 0
#endif
#ifndef DUP_MASK
#define DUP_MASK 0
#endif
#ifndef KPROBE
#define KPROBE 0
#endif
#define REP(k) for (int _rep = 0; _rep < (((DUP_MASK >> (k)) & 1) ? 2 : 1); ++_rep)

constexpr size_t MiB = 1u << 20;
constexpr size_t WS_CTL = 0, CTL_ZERO_BYTES = 2 * MiB;
constexpr size_t WS_KSUM = 1 * MiB;
constexpr size_t WS_ROPE = 2 * MiB;
constexpr size_t WS_WIN_T = 4 * MiB;
constexpr size_t WS_WOUT_T = 9 * MiB;
constexpr size_t WS_SMALL = 11 * MiB;
constexpr size_t WS_CNT = WS_SMALL, WS_TILE_E = WS_SMALL + 65536, WS_WR_HI = WS_SMALL + 131072, WS_WR_LO = WS_WR_HI + 65536;
constexpr size_t WS_STATS = WS_SMALL + 262144, WS_RC = WS_SMALL + 786432;
constexpr size_t WS_TOK = 12 * MiB;
constexpr size_t WS_ASG_E = 14 * MiB, WS_ASG_G = 15 * MiB, WS_ASG_D = 16 * MiB;
constexpr size_t WS_W2_8 = 24 * MiB;
constexpr size_t WS_X1B = 56 * MiB;
constexpr size_t WS_ACT8 = 184 * MiB;
constexpr size_t WS_XB = 184 * MiB;
constexpr size_t WS_X1LO = 312 * MiB;
constexpr size_t WS_YB = 488 * MiB;
constexpr size_t WS_W1_8 = 488 * MiB;
constexpr size_t WS_X1_8 = 552 * MiB;
constexpr size_t WS_QKV = 616 * MiB;
constexpr size_t WS_END = 1016 * MiB;
constexpr float KPF = (KPROBE == 1) ? 0.5f : 1.0f;
constexpr float W_SCALE = 64.0f, ACT_SCALE = 4.0f, WIN_SCALE = 32.0f, Y_SCALE = 16.0f, AO_SCALE = 64.0f;
constexpr int CW_NTILES = 16, CW_BAR = 4096;
constexpr int LDSX_TILE = 131072, LDSX_IDX = 135424, LDSX_BIAS = 136448;
constexpr int LDS_BARST = LDS_BYTES - 256;

struct Params {
    const float *x, *w_in, *b_in, *sinks, *w_out, *b_out, *ln1_g, *ln1_b, *w_router, *b_router, *w1, *b1, *w2, *b2, *ln2_g, *ln2_b;
    float* out; unsigned char* ws;
};

__device__ __forceinline__ unsigned f2bf(float f) { unsigned u = __builtin_bit_cast(unsigned, f); return (u + 0x7fffu + ((u >> 16) & 1u)) >> 16; }
__device__ __forceinline__ float bf2f(unsigned h) { return __builtin_bit_cast(float, h << 16); }
__device__ __forceinline__ unsigned cvtpk(float lo, float hi) { f32x2 v = {lo, hi}; bf16x2_t b = __builtin_convertvector(v, bf16x2_t); return __builtin_bit_cast(unsigned, b); }
__device__ __forceinline__ unsigned pk4_fp8(float a, float b, float c, float d) { int w = 0; w = __builtin_amdgcn_cvt_pk_fp8_f32(a, b, w, false); w = __builtin_amdgcn_cvt_pk_fp8_f32(c, d, w, true); return (unsigned)w; }
template <int X> __device__ __forceinline__ float swz_xor(float v) { return __builtin_bit_cast(float, __builtin_amdgcn_ds_swizzle(__builtin_bit_cast(int, v), (X << 10) | 0x1f)); }
__device__ __forceinline__ float wave_sum(float v) {
    v += swz_xor<1>(v); v += swz_xor<2>(v); v += swz_xor<4>(v); v += swz_xor<8>(v); v += swz_xor<16>(v);
    auto rr = __builtin_amdgcn_permlane32_swap(__float_as_uint(v), __float_as_uint(v), false, false);
    return __uint_as_float(rr[0]) + __uint_as_float(rr[1]);
}
#define LDS_WAIT() asm volatile("s_waitcnt lgkmcnt(0)" ::: "memory")
__device__ __forceinline__ int tid_of(int wave_s) { unsigned z = 0u; asm volatile("" : "+v"(z));
    return wave_s * 64 + (int)__builtin_amdgcn_mbcnt_hi(~0u, __builtin_amdgcn_mbcnt_lo(~0u, z)); }

namespace pg8 {
constexpr int BM = 256, BK = 64, HALF = 128, HTB = HALF * BK * 2, STAGE_BYTES = 8 * HTB, NXCD = 8, WGM = 8;
constexpr int KD = 1024;
__host__ __device__ __forceinline__ int lds_byte(int r, int c) { const int st = (r >> 4) * 2 + (c >> 5), rr = r & 15, cc = c & 31, ob = rr * 64 + cc * 2; return st * 1024 + (ob ^ (((ob >> 9) & 1) << 5)); }
__host__ __device__ __forceinline__ void stage_rc(int b, int& R, int& C) { const int st = b / 1024, sb = b % 1024, swz = sb ^ (((sb >> 9) & 1) << 5); R = (st >> 1) * 16 + swz / 64; C = (st & 1) * 32 + (swz % 64) / 2; }
__host__ __device__ __forceinline__ int perm32(int rho) { const int n = rho >> 4, i = rho & 15; return 8 * (i >> 2) + 4 * n + (i & 3); }

struct Unit { int pm, pn, e; unsigned ao, bo; const int* rows; };

typedef int v8i32_t __attribute__((ext_vector_type(8)));
typedef int v4i32_t __attribute__((ext_vector_type(4)));
typedef unsigned long long u64x2_t __attribute__((ext_vector_type(2)));
__device__ __forceinline__ f32x4 zero4() { unsigned long long lo, hi; asm volatile("v_mov_b64 %0, 0\n\tv_mov_b64 %1, 0" : "=v"(lo), "=v"(hi)); u64x2_t v = {lo, hi}; return __builtin_bit_cast(f32x4, v); }
__device__ __forceinline__ v8i32_t cat8(bf16x8 a, bf16x8 b) { const v4i32_t x = __builtin_bit_cast(v4i32_t, a), y = __builtin_bit_cast(v4i32_t, b); return __builtin_shufflevector(x, y, 0, 1, 2, 3, 4, 5, 6, 7); }
__device__ __forceinline__ void pg8_glds16(unsigned voff, const void* sbase, unsigned lds_dst) { unsigned keep;
    asm volatile("s_mov_b32 %0, m0\n\ts_mov_b32 m0, %3\n\ts_nop 0\n\tglobal_load_lds_dwordx4 %1, %2\n\ts_mov_b32 m0, %0" : "=&s"(keep) : "v"(voff), "s"(sbase), "s"(lds_dst) : "memory"); }
struct NoHook { struct State {}; __device__ __forceinline__ void pre(int, int, State&) const {} __device__ __forceinline__ void operator()(int, int, State&) const {} };
template <class Epi, class Sched, bool GATHER, bool ALIGN_EPI, int KP = 1024, bool FP8 = false, bool MOE = false, class Hook = NoHook>
__device__ __forceinline__ void gemm_phase(LAS unsigned char* lds, const Sched& S, const Epi& E, const int wave_s, Hook H = Hook()) {
    int tid = tid_of(wave_s); asm volatile("" : "+v"(tid));
    const int wid = __builtin_amdgcn_readfirstlane(tid >> 6), lane = tid & 63, wr = wid >> 2, wc = wid & 3, fr = lane & 15, fq = lane >> 4;
    constexpr int K = KP, nt = K / BK;
    unsigned voffB[2], Vc[2][2]; int stR0, stC0;
    { int R, C; stage_rc(tid * 16, R, C); stR0 = R; stC0 = C; }
#pragma unroll
    for (int i = 0; i < 2; ++i) { voffB[i] = (unsigned)((stR0 + 64 * i) * K + stC0) * 2u; Vc[0][i] = voffB[i]; Vc[1][i] = voffB[i]; }
#define PG8_GATHER_LOAD(VV) do { int _t = tid_of(wave_s); asm volatile("" : "+v"(_t)); int _R, _C; stage_rc(_t * 16, _R, _C);     \
        const LAS int* _rp = (const LAS int*)(lds + LDSX_IDX) + _R; _Pragma("unroll") for (int _h = 0; _h < 2; ++_h) _Pragma("unroll") for (int _i = 0; _i < 2; ++_i) \
        VV[_h][_i] = ((unsigned)_rp[128 * _h + 64 * _i] * (unsigned)K + (unsigned)_C) * 2u; } while (0)
#define PG8_DMA4(gsrc, ldsoff) __builtin_amdgcn_global_load_lds((const unsigned*)(gsrc), (LAS unsigned*)(lds + (ldsoff)), 4, 0, 0)
    constexpr unsigned kstep = (unsigned)(BK * 2);
    constexpr unsigned hstep = (unsigned)HALF * K * 2;
    const char* const Abase = S.A; const char* const Bbase = S.B;
    const unsigned ldsw = (unsigned)wid * 1024u; const unsigned lds0 = (unsigned)(uintptr_t)lds;
    const int aoff = lds_byte(wr * 64 + fr, fq * 8), boff = lds_byte(wc * 32 + fr, fq * 8) + 4 * HTB;
#define PG8_SA(b, h) (((b) * 2 + (h)) * HTB)
#define PG8_SB(b, h) ((4 + (b) * 2 + (h)) * HTB)
#define PG8_SBR(b, h) (((b) * 2 + (h)) * HTB)
#define PG8_STAGE(bufoff, gbase, soff, voff) do { _Pragma("unroll") for (int _r = 0; _r < (KPROBE == 3 ? 2 : 1); ++_r) _Pragma("unroll") for (int _i = 0; _i < 2; ++_i) \
        pg8_glds16((voff)[_i], (gbase) + (size_t)(unsigned)(soff), (unsigned)__builtin_amdgcn_readfirstlane((int)(lds0 + (unsigned)(bufoff) + ldsw + _i * 8192))); } while (0)
#define PG8_STAGE_B(bufoff, soff) PG8_STAGE(bufoff, Bbase, soff, voffB)
#define PG8_STAGE_A(bufoff, soff, h, VV) do { if constexpr (GATHER) { PG8_STAGE(bufoff, Abase, soff, VV[h]); } else { PG8_STAGE(bufoff, Abase, (soff) + (h) * hstep, voffB); } } while (0)
#if KPROBE == 2
#define PG8_LDA(dst, b, h) do { _Pragma("unroll") for (int m = 0; m < 4; ++m) { dst[m] = cat8(*(volatile const LAS bf16x8*)(lds + PG8_SA(b, h) + aoff + m * 2048), *(volatile const LAS bf16x8*)(lds + PG8_SA(b, h) + aoff + m * 2048 + 1024)); \
        dst[m] = cat8(*(volatile const LAS bf16x8*)(lds + PG8_SA(b, h) + aoff + m * 2048), *(volatile const LAS bf16x8*)(lds + PG8_SA(b, h) + aoff + m * 2048 + 1024)); } } while (0)
#define PG8_LDB(dst, b, h) do { _Pragma("unroll") for (int n = 0; n < 2; ++n) { dst[n] = cat8(*(volatile const LAS bf16x8*)(lds + PG8_SBR(b, h) + boff + n * 2048), *(volatile const LAS bf16x8*)(lds + PG8_SBR(b, h) + boff + n * 2048 + 1024)); \
        dst[n] = cat8(*(volatile const LAS bf16x8*)(lds + PG8_SBR(b, h) + boff + n * 2048), *(volatile const LAS bf16x8*)(lds + PG8_SBR(b, h) + boff + n * 2048 + 1024)); } } while (0)
#else
#define PG8_LDA(dst, b, h) do { _Pragma("unroll") for (int m = 0; m < 4; ++m) dst[m] = cat8(*(const LAS bf16x8*)(lds + PG8_SA(b, h) + aoff + m * 2048), *(const LAS bf16x8*)(lds + PG8_SA(b, h) + aoff + m * 2048 + 1024)); } while (0)
#define PG8_LDB(dst, b, h) do { _Pragma("unroll") for (int n = 0; n < 2; ++n) dst[n] = cat8(*(const LAS bf16x8*)(lds + PG8_SBR(b, h) + boff + n * 2048), *(const LAS bf16x8*)(lds + PG8_SBR(b, h) + boff + n * 2048 + 1024)); } while (0)
#endif
#define PG8_LO(v) __builtin_bit_cast(bf16x8, __builtin_shufflevector(v, v, 0, 1, 2, 3))
#define PG8_HI(v) __builtin_bit_cast(bf16x8, __builtin_shufflevector(v, v, 4, 5, 6, 7))
#define PG8_MMA(ai, bj, At, Bt) do { __builtin_amdgcn_s_setprio(1); _Pragma("unroll") for (int m = 0; m < 4; ++m) _Pragma("unroll") for (int n = 0; n < 2; ++n) { \
        if constexpr (FP8) { acc[ai][bj][m][n] = __builtin_amdgcn_mfma_scale_f32_16x16x128_f8f6f4(Bt[n], At[m], acc[ai][bj][m][n], 0, 0, 0, 0, 0, 0); \
            if (KPROBE == 1) acc[ai][bj][m][n] = __builtin_amdgcn_mfma_scale_f32_16x16x128_f8f6f4(Bt[n], At[m], acc[ai][bj][m][n], 0, 0, 0, 0, 0, 0); } \
        else { acc[ai][bj][m][n] = __builtin_amdgcn_mfma_f32_16x16x32_bf16(PG8_LO(Bt[n]), PG8_LO(At[m]), acc[ai][bj][m][n], 0, 0, 0); \
               acc[ai][bj][m][n] = __builtin_amdgcn_mfma_f32_16x16x32_bf16(PG8_HI(Bt[n]), PG8_HI(At[m]), acc[ai][bj][m][n], 0, 0, 0); } } \
        __builtin_amdgcn_s_setprio(0); } while (0)
#define PG8_WAIT_V(n) asm volatile("s_waitcnt vmcnt(" #n ")" ::: "memory")
#define PG8_WAIT_L(n) asm volatile("s_waitcnt lgkmcnt(" #n ")" ::: "memory")
#define PG8_BAR __builtin_amdgcn_s_barrier()
#define PG8_SCHED __builtin_amdgcn_sched_barrier(0)
    Unit cur, nxt; int ui = 0;
    if (!S.next(0, cur)) return;
    if constexpr (MOE) {
        if (wid < 4) { const int ln_ = tid_of(wave_s) & 63; PG8_DMA4(E.bias_src(cur) + wid * 64 + ln_, LDSX_BIAS + wid * 256); if constexpr (GATHER) PG8_DMA4(cur.rows + wid * 64 + ln_, LDSX_IDX + wid * 256); }
        asm volatile("s_waitcnt vmcnt(0)" ::: "memory"); __builtin_amdgcn_s_barrier(); asm volatile("" ::: "memory");
    }
    if constexpr (GATHER) { PG8_GATHER_LOAD(Vc); }
    f32x4 acc[2][2][4][2];
#pragma unroll
    for (int a = 0; a < 2; ++a)
#pragma unroll
        for (int b = 0; b < 2; ++b)
#pragma unroll
            for (int m = 0; m < 4; ++m)
#pragma unroll
                for (int n = 0; n < 2; ++n) acc[a][b][m][n] = zero4();
    v8i32_t At[4], B0[2], B1[2];
    unsigned cA = cur.ao, cB = cur.bo;
    PG8_STAGE_B(PG8_SB(0, 0), cB); PG8_STAGE_B(PG8_SB(0, 1), cB + hstep); PG8_STAGE_A(PG8_SA(0, 0), cA, 0, Vc); PG8_STAGE_A(PG8_SA(0, 1), cA, 1, Vc);
    if (wr == 1) PG8_BAR;
    PG8_WAIT_V(2); PG8_BAR;
    PG8_STAGE_B(PG8_SB(1, 0), cB + kstep); PG8_STAGE_A(PG8_SA(1, 0), cA + kstep, 0, Vc); PG8_STAGE_B(PG8_SB(1, 1), cB + hstep + kstep);
    PG8_WAIT_V(6); PG8_BAR;
    for (;;) {
        { int _t = tid_of(wave_s); asm volatile("" : "+v"(_t)); int _R, _C; stage_rc(_t * 16, _R, _C);
#pragma unroll
          for (int i = 0; i < 2; ++i) voffB[i] = (unsigned)((_R + 64 * i) * K + _C) * 2u; }
        const bool has_next = S.next(ui + 1, nxt);
        const unsigned nA = has_next ? nxt.ao : cA; const unsigned nB = has_next ? nxt.bo : cB;
        if constexpr (MOE) {
            if (has_next && wid < 4) { const int ln_ = tid_of(wave_s) & 63;
                PG8_DMA4(E.bias_src(nxt) + wid * 64 + ln_, LDSX_BIAS + ((ui + 1) % 3) * 1024 + wid * 256); if constexpr (GATHER) PG8_DMA4(nxt.rows + wid * 64 + ln_, LDSX_IDX + wid * 256); }
        }
        PG8_LDB(B0, 0, 0);
#pragma unroll 1
        for (int t = 0; t < nt; t += 2) {
            const bool last = (t == nt - 2);
            const unsigned a1 = cA + (unsigned)(t + 1) * kstep;
            const unsigned a2 = last ? nA : cA + (unsigned)(t + 2) * kstep; const unsigned b2 = last ? nB : cB + (unsigned)(t + 2) * kstep;
            const unsigned a3 = a2 + kstep; const unsigned b3 = b2 + kstep;
            PG8_LDB(B1, 0, 1); PG8_SCHED; PG8_LDA(At, 0, 0); PG8_STAGE_A(PG8_SA(1, 1), a1, 1, Vc);
            if constexpr (GATHER) { if (last && has_next) { PG8_GATHER_LOAD(Vc); } }
            PG8_WAIT_V(6); PG8_WAIT_L(0); PG8_BAR; PG8_MMA(0, 0, At, B0); PG8_MMA(0, 1, At, B1); PG8_BAR; PG8_SCHED;
            PG8_LDA(At, 0, 1); PG8_STAGE_B(PG8_SB(0, 0), b2); PG8_STAGE_B(PG8_SB(0, 1), b2 + hstep); PG8_STAGE_A(PG8_SA(0, 0), a2, 0, Vc);
            PG8_WAIT_V(8); PG8_WAIT_L(0); PG8_BAR; PG8_MMA(1, 0, At, B0); PG8_SCHED; PG8_LDB(B0, 1, 0); PG8_SCHED; PG8_MMA(1, 1, At, B1); PG8_BAR; PG8_SCHED;
            PG8_LDB(B1, 1, 1); PG8_SCHED; PG8_LDA(At, 1, 0); PG8_STAGE_A(PG8_SA(0, 1), a2, 1, Vc);
            PG8_WAIT_V(6); PG8_WAIT_L(0); PG8_BAR; PG8_MMA(0, 0, At, B0); PG8_MMA(0, 1, At, B1); PG8_BAR; PG8_SCHED;
            PG8_LDA(At, 1, 1); PG8_STAGE_B(PG8_SB(1, 0), b3); PG8_STAGE_B(PG8_SB(1, 1), b3 + hstep); PG8_STAGE_A(PG8_SA(1, 0), a3, 0, Vc);
            PG8_WAIT_V(8); PG8_WAIT_L(0); PG8_BAR; PG8_MMA(1, 0, At, B0); PG8_SCHED; if (!last) { PG8_LDB(B0, 0, 0); } PG8_SCHED; PG8_MMA(1, 1, At, B1); PG8_BAR; PG8_SCHED;
        }
        typename Hook::State hst; H.pre(ui, wave_s, hst);
        if constexpr (ALIGN_EPI) { if (wr == 0) PG8_BAR; }
        { int t2 = tid_of(wave_s); asm volatile("" : "+v"(t2));
          if constexpr (MOE) { E(acc, cur, wr, wc, t2 & 15, (t2 & 63) >> 4, (const LAS float*)(lds + LDSX_BIAS + (ui % 3) * 1024));
              if (EPI_DUP) { asm volatile("" : "+v"(t2)); E(acc, cur, wr, wc, t2 & 15, (t2 & 63) >> 4, (const LAS float*)(lds + LDSX_BIAS + (ui % 3) * 1024)); } }
          else E(acc, cur, wr, wc, t2 & 15, (t2 & 63) >> 4); }
        H(ui, wave_s, hst);
        if (!has_next) break;
#pragma unroll
        for (int a = 0; a < 2; ++a)
#pragma unroll
            for (int b = 0; b < 2; ++b)
#pragma unroll
                for (int m = 0; m < 4; ++m)
#pragma unroll
                    for (int n = 0; n < 2; ++n) acc[a][b][m][n] = zero4();
        cur = nxt; cA = nA; cB = nB; ++ui;
        if constexpr (ALIGN_EPI) { if (wr == 1) PG8_BAR; }
    }
    PG8_WAIT_V(0);
    if constexpr (!ALIGN_EPI) { if (wr == 0) PG8_BAR; }
    PG8_BAR;
#undef PG8_SA
#undef PG8_SB
#undef PG8_SBR
#undef PG8_STAGE
#undef PG8_STAGE_A
#undef PG8_STAGE_B
#undef PG8_GATHER_LOAD
#undef PG8_DMA4
#undef PG8_LDA
#undef PG8_LDB
#undef PG8_LO
#undef PG8_HI
#undef PG8_MMA
#undef PG8_WAIT_V
#undef PG8_WAIT_L
#undef PG8_BAR
#undef PG8_SCHED
}

template <int ROWB>
struct SchedInProj {
    const char* A; const char* B; int G, c;
    __device__ __forceinline__ bool next(int i, Unit& u) const {
        constexpr int nM = T / BM, nN = INW / BM, nwg = nM * nN;
        const long L = (long)i * G + c; if (L >= nwg) return false;
        int wgid = (int)L; { const int q = nwg / NXCD, r = nwg % NXCD, xcd = wgid % NXCD, off = wgid / NXCD; wgid = (xcd < r ? xcd * (q + 1) : r * (q + 1) + (xcd - r) * q) + off; }
        const int nig = WGM * nN, gid = wgid / nig, fm = gid * WGM, gsz = (nM - fm) < WGM ? (nM - fm) : WGM;
        u.pm = fm + ((wgid % nig) % gsz); u.pn = (wgid % nig) / gsz; u.e = 0; u.rows = nullptr;
        u.ao = (unsigned)u.pm * (unsigned)(256 * ROWB); u.bo = (unsigned)u.pn * (unsigned)(256 * ROWB); return true;
    }
};
struct SchedPanel {
    const char* A; const char* B; int pm;
    __device__ __forceinline__ bool next(int i, Unit& u) const {
        if (i >= 4) return false;
        u.pm = pm; u.pn = i; u.e = 0; u.rows = nullptr; u.ao = (unsigned)pm * (unsigned)(256 * 1024); u.bo = (unsigned)i * (unsigned)(256 * 1024); return true;
    }
};
template <int NPN, bool G1>
struct SchedMoe {
    const char* A; const char* B; const LAS int* tile_e; const int* tok; int ntiles, G, c;
    __device__ __forceinline__ bool next(int i, Unit& u) const {
        const long L = (long)i * G + c; int t, pn;
        if ((G & 7) == 0) { const int x = (int)(L & 7); const long j = L >> 3; t = (int)(j / NPN) * 8 + x; pn = (int)(j % NPN); }
        else { t = (int)(L / NPN); pn = (int)(L % NPN); }
        if (t >= ntiles) return false;
        if (!G1) t = ntiles - 1 - t;
        const int e = __builtin_amdgcn_readfirstlane(tile_e[t]);
        u.pm = t; u.pn = pn; u.e = e;
        if (G1) { u.ao = 0u; u.rows = tok + (size_t)t * 256; u.bo = ((unsigned)e * 2048u + (unsigned)pn * 256u) * 1024u; }
        else { u.ao = (unsigned)t * (256u * 1024u); u.rows = nullptr; u.bo = ((unsigned)e * 1024u + (unsigned)pn * 256u) * 1024u; }
        return true;
    }
};

struct EpiInProj {
    bf16_t* qkv; const float* b_in; const float* rope; float descale;
    __device__ __forceinline__ void operator()(const f32x4 (&acc)[2][2][4][2], const Unit& u, int wr, int wc, int fr, int fq) const {
        const int pn = u.pn;
        const int colb = 256 * pn + 64 * wc + 8 * fq;
        const bool do_rope = !(pn >= 7 || (pn == 2 && wc >= 2));
        const bool is_q = (pn < 2) || (pn == 3) || (pn == 4);
        const float sc = is_q ? C2 : 1.0f;
        f32x4 bv[2][2];
#pragma unroll
        for (int bj = 0; bj < 2; ++bj)
#pragma unroll
            for (int n = 0; n < 2; ++n) bv[bj][n] = *(const f32x4*)(b_in + colb + 32 * bj + 4 * n) * sc;
        const float dsc = descale * sc;
        const int row0 = u.pm * 256 + wr * 64 + fr;
        f32x4 cb[2], sb[2], c16[2], s16[2], c128[2], s128[2];
        if (do_rope) {
            const float* rp = rope + (row0 & (SEQ - 1)) * 64 + 8 * fq; const float* r16 = rope + 16 * 64 + 8 * fq; const float* r128 = rope + 128 * 64 + 8 * fq;
#pragma unroll
            for (int n = 0; n < 2; ++n) { cb[n] = *(const f32x4*)(rp + 4 * n); sb[n] = *(const f32x4*)(rp + 32 + 4 * n); c16[n] = *(const f32x4*)(r16 + 4 * n); s16[n] = *(const f32x4*)(r16 + 32 + 4 * n);
                c128[n] = *(const f32x4*)(r128 + 4 * n); s128[n] = *(const f32x4*)(r128 + 32 + 4 * n); }
        } else {
#pragma unroll
            for (int n = 0; n < 2; ++n) { cb[n] = sb[n] = c16[n] = s16[n] = c128[n] = s128[n] = (f32x4){0.f, 0.f, 0.f, 0.f}; }
        }
        f32x4 cn[2], sn[2];
#pragma unroll
        for (int n = 0; n < 2; ++n) { cn[n] = cb[n] * c128[n] - sb[n] * s128[n]; sn[n] = sb[n] * c128[n] + cb[n] * s128[n]; }
#pragma unroll
        for (int ai = 0; ai < 2; ++ai) {
            f32x4 cc[2], ss[2];
#pragma unroll
            for (int n = 0; n < 2; ++n) { if (ai == 0) { cc[n] = cb[n]; ss[n] = sb[n]; } else { cc[n] = cn[n]; ss[n] = sn[n]; } }
#pragma unroll
            for (int m = 0; m < 4; ++m) {
                const int row = row0 + ai * 128 + m * 16;
                f32x4 o1[2], o2[2];
#pragma unroll
                for (int n = 0; n < 2; ++n) { o1[n] = acc[ai][0][m][n] * dsc + bv[0][n]; o2[n] = acc[ai][1][m][n] * dsc + bv[1][n]; }
                if (do_rope) {
#pragma unroll
                    for (int n = 0; n < 2; ++n) { const f32x4 a = o1[n], b = o2[n]; o1[n] = a * cc[n] - b * ss[n]; o2[n] = b * cc[n] + a * ss[n]; }
                    if (m < 3) {
#pragma unroll
                        for (int n = 0; n < 2; ++n) { const f32x4 c_ = cc[n], s_ = ss[n]; cc[n] = c_ * c16[n] - s_ * s16[n]; ss[n] = s_ * c16[n] + c_ * s16[n]; }
                    }
                }
                unsigned char* rowp = (unsigned char*)qkv + ((size_t)(row >> 4) * 36 + (size_t)(4 * pn + wc)) * 2048 + (size_t)(row & 15) * 16 + (size_t)fq * 256;
                u32x4 w1, w2;
                w1.x = cvtpk(o1[0][0], o1[0][1]); w1.y = cvtpk(o1[0][2], o1[0][3]); w1.z = cvtpk(o1[1][0], o1[1][1]); w1.w = cvtpk(o1[1][2], o1[1][3]);
                w2.x = cvtpk(o2[0][0], o2[0][1]); w2.y = cvtpk(o2[0][2], o2[0][3]); w2.z = cvtpk(o2[1][0], o2[1][1]); w2.w = cvtpk(o2[1][2], o2[1][3]);
                *(u32x4*)(rowp) = w1; *(u32x4*)(rowp + 1024) = w2;
            }
        }
    }
};
template <int BANK> __device__ __forceinline__ u32x4 ror8sel(u32x4 old, u32x4 src) { u32x4 r;
#pragma unroll
    for (int c = 0; c < 4; ++c) r[c] = (unsigned)__builtin_amdgcn_update_dpp((int)old[c], (int)src[c], 0x128  , 0xF, BANK, false);
    return r; }
template <int BANK> __device__ __forceinline__ f32x4 ror8sel(f32x4 old, f32x4 src) { return __builtin_bit_cast(f32x4, ror8sel<BANK>(__builtin_bit_cast(u32x4, old), __builtin_bit_cast(u32x4, src))); }
struct EpiOutProj {
    bf16_t* y; const float* b_out; const float* x;
    __device__ __forceinline__ void operator()(const f32x4 (&acc)[2][2][4][2], const Unit& u, int wr, int wc, int fr, int fq) const {
        const int colw = u.pn * 256 + wc * 64 + 8 * fq;
        const int fr8 = fr & 7, hs = fr >> 3;
        f32x4 bv[2][2];
#pragma unroll
        for (int bj = 0; bj < 2; ++bj)
#pragma unroll
            for (int n = 0; n < 2; ++n) bv[bj][n] = *(const f32x4*)(b_out + colw + 32 * bj + 4 * n);
        const size_t lrow = (size_t)(u.pm * 256 + wr * 64 + fr8) * D + colw;
        const float* xl = x + lrow + 4 * hs;
        bf16_t* yl = y + lrow + 32 * hs;
#pragma unroll
        for (int ai = 0; ai < 2; ++ai) {
            f32x4 XA[4][2], XB[4][2];
#pragma unroll
            for (int m = 0; m < 4; ++m)
#pragma unroll
                for (int bj = 0; bj < 2; ++bj) { const size_t ro = (size_t)(ai * 128 + m * 16) * D; XA[m][bj] = __builtin_nontemporal_load((const f32x4*)(xl + ro + 32 * bj)); XB[m][bj] = __builtin_nontemporal_load((const f32x4*)(xl + ro + 8 * D + 32 * bj)); }
            asm volatile("" ::: "memory");
#pragma unroll
            for (int m = 0; m < 4; ++m) {
                const size_t ro = (size_t)(ai * 128 + m * 16) * D;
                u32x4 w[2];
#pragma unroll
                for (int bj = 0; bj < 2; ++bj) {
                    const f32x4 x0 = ror8sel<0xC>(XA[m][bj], XB[m][bj]), x1 = ror8sel<0x3>(XB[m][bj], XA[m][bj]);
                    const f32x4 v0 = acc[ai][bj][m][0] * (KPF / (W_SCALE * AO_SCALE)) + bv[bj][0] + x0 * DN_ALPHA, v1 = acc[ai][bj][m][1] * (KPF / (W_SCALE * AO_SCALE)) + bv[bj][1] + x1 * DN_ALPHA;
                    w[bj].x = cvtpk(v0[0], v0[1]); w[bj].y = cvtpk(v0[2], v0[3]); w[bj].z = cvtpk(v1[0], v1[1]); w[bj].w = cvtpk(v1[2], v1[3]); }
                *(u32x4*)(yl + ro) = ror8sel<0xC>(w[0], w[1]); *(u32x4*)(yl + ro + 8 * D) = ror8sel<0x3>(w[1], w[0]);
            }
            asm volatile("" ::: "memory");
        }
    }
};
struct EpiSwiglu {
    unsigned char* act8; const float* b1;
    __device__ __forceinline__ const float* bias_src(const Unit& u) const { return b1 + (size_t)u.e * 2048 + 256 * u.pn; }
    __device__ __forceinline__ void operator()(const f32x4 (&acc)[2][2][4][2], const Unit& u, int wr, int wc, int fr, int fq, const LAS float* bias) const {
        const int a0 = 128 * u.pn + 32 * wc + 8 * fq;
        const LAS float* bp = bias + 2 * (32 * wc + 8 * fq);
        f32x4 bb[4];
#pragma unroll
        for (int q = 0; q < 4; ++q) bb[q] = *(const LAS f32x4*)(bp + 4 * q);
        constexpr float KS = -1.702f * LOG2E;
        f32x2 bg[2][2], bl[2][2];
#pragma unroll
        for (int n = 0; n < 2; ++n)
#pragma unroll
            for (int jp = 0; jp < 2; ++jp) { bg[n][jp] = (f32x2){bb[2 * n + jp][0], bb[2 * n + jp][2]} * KS; bl[n][jp] = (f32x2){bb[2 * n + jp][1], bb[2 * n + jp][3]} * (ACT_SCALE / KS) + (ACT_SCALE / KS); }
        unsigned char* tile = act8 + (size_t)u.pm * (256 * 1024);
#pragma unroll
        for (int ai = 0; ai < 2; ++ai)
#pragma unroll
            for (int m = 0; m < 4; ++m) {
                const int row = ai * 128 + wr * 64 + m * 16 + fr;
                f32x2 r[2][2];
#pragma unroll
                for (int n = 0; n < 2; ++n)
#pragma unroll
                    for (int jp = 0; jp < 2; ++jp) {
                        const f32x2 ag = {acc[ai][0][m][n][2 * jp], acc[ai][0][m][n][2 * jp + 1]}, al = {acc[ai][1][m][n][2 * jp], acc[ai][1][m][n][2 * jp + 1]};
                        f32x2 g = ag * (KPF / W_SCALE * KS) + bg[n][jp], l = al * (KPF / W_SCALE * ACT_SCALE / KS) + bl[n][jp];
                        g.x = fmaxf(g.x, 7.0f * KS); g.y = fmaxf(g.y, 7.0f * KS);
                        l.x = __builtin_amdgcn_fmed3f(l.x, -6.0f * ACT_SCALE / KS, 8.0f * ACT_SCALE / KS); l.y = __builtin_amdgcn_fmed3f(l.y, -6.0f * ACT_SCALE / KS, 8.0f * ACT_SCALE / KS);
                        f32x2 t; t.x = __builtin_amdgcn_exp2f(g.x); t.y = __builtin_amdgcn_exp2f(g.y);
                        const f32x2 d = t + 1.0f;
                        f32x2 sg; sg.x = __builtin_amdgcn_rcpf(d.x); sg.y = __builtin_amdgcn_rcpf(d.y);
                        r[n][jp] = (g * sg) * l;
                    }
                u32x2 w; w.x = pk4_fp8(r[0][0].x, r[0][0].y, r[0][1].x, r[0][1].y); w.y = pk4_fp8(r[1][0].x, r[1][0].y, r[1][1].x, r[1][1].y);
                *(u32x2*)(tile + (size_t)row * 1024 + (size_t)a0) = w;
            }
    }
};
struct EpiDown {
    unsigned char* yb; const float* b2;
    __device__ __forceinline__ const float* bias_src(const Unit& u) const { return b2 + (size_t)u.e * 1024 + 256 * u.pn; }
    __device__ __forceinline__ void operator()(const f32x4 (&acc)[2][2][4][2], const Unit& u, int wr, int wc, int fr, int fq, const LAS float* bias) const {
        const int col0 = u.pn * 256 + wc * 64 + 16 * fq;
        const LAS float* bp = bias + wc * 64 + 16 * fq;
        f32x4 bv[2][2];
#pragma unroll
        for (int bj = 0; bj < 2; ++bj)
#pragma unroll
            for (int n = 0; n < 2; ++n) bv[bj][n] = *(const LAS f32x4*)(bp + 8 * bj + 4 * n) * Y_SCALE;
#pragma unroll
        for (int ai = 0; ai < 2; ++ai)
#pragma unroll
            for (int m = 0; m < 4; ++m) {
                unsigned char* rowp = yb + (size_t)(u.pm * 256 + ai * 128 + wr * 64 + m * 16 + fr) * 1024 + col0;
                u32x4 w;
#pragma unroll
                for (int bj = 0; bj < 2; ++bj)
#pragma unroll
                    for (int n = 0; n < 2; ++n) { const f32x4 v = acc[ai][bj][m][n] * (KPF * Y_SCALE / (W_SCALE * ACT_SCALE)) + bv[bj][n]; w[2 * bj + n] = pk4_fp8(v[0], v[1], v[2], v[3]); }
                *(u32x4*)rowp = w;
            }
    }
};
}

template <int CW> __device__ __forceinline__ void cvt_load(const float* __restrict__ W, int N, int item, int lane, f32x4 (&v)[16]);
template <int CW> __device__ __forceinline__ void cvt_store(unsigned char* __restrict__ WT, int N, int mode, float scale, int item, int lane, const f32x4 (&v)[16]);
namespace att {
constexpr int PITCH = INW, SLOTB = 8192;
constexpr size_t QKV_RB = 36 * 2048;
__device__ __forceinline__ size_t qkv_tile(long rb16, int u) { return (size_t)rb16 * QKV_RB + (size_t)u * 2048; }
constexpr int NSLOT = 4;
constexpr int L_K = 0, L_V = NSLOT * SLOTB, L_WS = 2 * NSLOT * SLOTB, L_KS = L_WS + 2048, L_OST = L_KS + 2048, L_END = L_OST + 8 * 4096;
static_assert(NSLOT == 4 && L_END <= 131072, "attention LDS map");
constexpr float NEG = -1.0e30f, M0 = -1.0e20f, THR = 8.0f;
typedef LAS const char* lds_cptr;
__device__ __forceinline__ int crow(int r, int hi) { return (r & 3) + 8 * (r >> 2) + 4 * hi; }
__device__ __forceinline__ void glds16(const void* gsrc, unsigned lds_dst) { unsigned keep;
    asm volatile("s_mov_b32 %0, m0\n\ts_mov_b32 m0, %2\n\ts_nop 0\n\tglobal_load_lds_dwordx4 %1, off\n\ts_mov_b32 m0, %0" : "=&s"(keep) : "v"(gsrc), "s"(lds_dst) : "memory"); }
__device__ __forceinline__ void glds16s(unsigned voff, const void* sbase, unsigned lds_dst) { unsigned keep;
    asm volatile("s_mov_b32 %0, m0\n\ts_mov_b32 m0, %3\n\ts_nop 0\n\tglobal_load_lds_dwordx4 %1, %2\n\ts_mov_b32 m0, %0" : "=&s"(keep) : "v"(voff), "s"(sbase), "s"(lds_dst) : "memory"); }
#define ATT_WAIT_BAR0() asm volatile("s_waitcnt vmcnt(0) lgkmcnt(0)\n\ts_barrier" ::: "memory")
#define ATT_WAIT_BARN(N) asm volatile("s_waitcnt vmcnt(" #N ") lgkmcnt(0)\n\ts_barrier" ::: "memory")
#define ATT_SBAR() __builtin_amdgcn_sched_barrier(0)

__device__ __forceinline__ void qkt(f32x16& p0, f32x16& p1, lds_cptr kb, const bf16x8* qr, const f32x16& negm) {
#pragma unroll
    for (int d0 = 0; d0 < 4; ++d0) {
        const bf16x8 b0 = *(const LAS bf16x8*)(kb + d0 * 2048);
        const bf16x8 b1 = *(const LAS bf16x8*)(kb + d0 * 2048 + 512);
        if (d0 == 0) { p0 = __builtin_amdgcn_mfma_f32_32x32x16_bf16(b0, qr[0], negm, 0, 0, 0); p1 = __builtin_amdgcn_mfma_f32_32x32x16_bf16(b1, qr[0], negm, 0, 0, 0); }
        else { p0 = __builtin_amdgcn_mfma_f32_32x32x16_bf16(b0, qr[d0], p0, 0, 0, 0); p1 = __builtin_amdgcn_mfma_f32_32x32x16_bf16(b1, qr[d0], p1, 0, 0, 0); }
    }
}
__device__ __forceinline__ float rowmax32(const f32x16& p0, const f32x16& p1) {
    float a = fmaxf(p0[0], p1[0]);
#pragma unroll
    for (int r = 1; r < 16; ++r) a = fmaxf(a, fmaxf(p0[r], p1[r]));
    auto rr = __builtin_amdgcn_permlane32_swap(__float_as_uint(a), __float_as_uint(a), false, false);
    return fmaxf(__uint_as_float(rr[0]), __uint_as_float(rr[1]));
}
__device__ __forceinline__ void pv(f32x16* o, int vb, bf16x8 pa0, bf16x8 pa1, bf16x8 pa2, bf16x8 pa3) {
#pragma unroll
    for (int d0 = 0; d0 < 2; ++d0) { s16x4 lo[4], hi[4];
#pragma unroll
        for (int ks = 0; ks < 4; ++ks) {
            asm volatile("ds_read_b64_tr_b16 %0,%1 offset:%c2" : "=&v"(lo[ks]) : "v"(vb), "i"(d0 * 4096 + ks * 1024) : "memory");
            asm volatile("ds_read_b64_tr_b16 %0,%1 offset:%c2" : "=&v"(hi[ks]) : "v"(vb), "i"(d0 * 4096 + ks * 1024 + 512) : "memory"); }
        asm volatile("s_waitcnt lgkmcnt(0)" ::: "memory"); ATT_SBAR();
#define ATT_PK(k) (bf16x8){lo[k][0], lo[k][1], lo[k][2], lo[k][3], hi[k][0], hi[k][1], hi[k][2], hi[k][3]}
        o[d0] = __builtin_amdgcn_mfma_f32_32x32x16_bf16(pa0, ATT_PK(0), o[d0], 0, 0, 0);
        o[d0] = __builtin_amdgcn_mfma_f32_32x32x16_bf16(pa1, ATT_PK(1), o[d0], 0, 0, 0);
        o[d0] = __builtin_amdgcn_mfma_f32_32x32x16_bf16(pa2, ATT_PK(2), o[d0], 0, 0, 0);
        o[d0] = __builtin_amdgcn_mfma_f32_32x32x16_bf16(pa3, ATT_PK(3), o[d0], 0, 0, 0);
#undef ATT_PK
    }
}

__device__ __forceinline__ void swa_stream(LAS char* shm, const bf16_t* __restrict__ qkv, unsigned char* __restrict__ aout, int b, int hh, int qb0, int nqb, const float* __restrict__ sinks, const int wave_s) {
    int tid = tid_of(wave_s); asm volatile("" : "+v"(tid));
    const int lane = tid & 63, r32 = lane & 31, hi = lane >> 5; const int wid = wave_s;
    const long rowbase = (long)b * SEQ;
    const int g = wid >> 1, qcol = (4 * hh + g) * 64, kcol = 512 + 64 * hh, vcol = 640 + 64 * hh;
    const unsigned char* const qkv8 = (const unsigned char*)qkv; const long rb0 = rowbase >> 4; (void)kcol; (void)vcol;
    const unsigned lds0 = (unsigned)(uintptr_t)shm;
    LAS float* wsf = (LAS float*)(shm + L_WS) + wid * 64;
    const unsigned koff = (unsigned)((lane >> 4) * (int)QKV_RB + (lane & 15) * 16);
    const unsigned voff = (unsigned)((lane & 3) * 256 + (lane >> 2) * 16);
    const unsigned kdst = lds0 + L_K + wid * 1024, vdst = lds0 + L_V + wid * 1024;
#define SW_DMA(t) do { const unsigned sl_ = (unsigned)(((t) & (NSLOT - 1)) * SLOTB); \
        glds16s(koff, qkv8 + qkv_tile(rb0 + 4 * (long)(t), 8 + hh) + wid * 256, (unsigned)__builtin_amdgcn_readfirstlane(kdst + sl_)); \
        glds16s(voff, qkv8 + qkv_tile(rb0 + 4 * (long)(t) + (wid & 3), 10 + hh) + (wid >> 2) * 1024, (unsigned)__builtin_amdgcn_readfirstlane(vdst + sl_)); } while (0)
    const int vb0 = (int)(lds0 + L_V) + ((lane >> 4) & 1) * 32 + (lane & 3) * 8 + (4 * hi + ((lane & 15) >> 2)) * 64;
    const lds_cptr kp0 = (lds_cptr)shm + L_K + hi * 1024 + r32 * 16;
    const float sink2 = sinks[4 * hh + g] * LOG2E;
    const int qend = qb0 + nqb;
    for (int kt = (qb0 - 2 < 0 ? 0 : qb0 - 2); kt <= qb0; ++kt) SW_DMA(kt);
    const unsigned char* Qb = qkv8 + qkv_tile(rb0 + 2 * (wid & 1) + (r32 >> 4), 4 * hh + g) + hi * 256 + (r32 & 15) * 16; (void)qcol;
    bf16x8 qn[4];
#pragma unroll
    for (int d0 = 0; d0 < 4; ++d0) qn[d0] = *reinterpret_cast<const bf16x8*>(Qb + (size_t)qb0 * 4 * QKV_RB + d0 * 512);
    ATT_WAIT_BAR0();
    for (int qb = qb0; qb < qend; ++qb) {
        const int qa = 64 * qb + 32 * (wid & 1);
        if (qb + 1 < qend) SW_DMA(qb + 1);
        bf16x8 qr[4];
#pragma unroll
        for (int d0 = 0; d0 < 4; ++d0) qr[d0] = qn[d0];
        if (qb + 1 < qend) {
#pragma unroll
            for (int d0 = 0; d0 < 4; ++d0) qn[d0] = *reinterpret_cast<const bf16x8*>(Qb + (size_t)(qb + 1) * 4 * QKV_RB + d0 * 512);
        }
        float m_run = sink2, l_run = (hi == 0) ? 1.0f : 0.0f;
        f32x16 negm, o[2];
        { float zf = 0.f; asm volatile("" : "+v"(zf));
#pragma unroll
          for (int r = 0; r < 16; ++r) { o[0][r] = zf; o[1][r] = zf; negm[r] = -m_run; } }
        auto tile_step = [&](f32x16& p0, f32x16& p1, const int kt, f32x16& x0, f32x16& x1, const bool has_x) {
            const int cur = (kt & (NSLOT - 1)) * SLOTB;
            const bool edge = !((64 * kt + 63 <= qa) && (qa + 31 - 64 * kt <= 127));
            if (edge) {
                const int dq = qa + r32 - 64 * kt - 4 * hi;
#pragma unroll
                for (int r = 0; r < 16; ++r) { const int d0_ = dq - ((r & 3) + 8 * (r >> 2)), d1_ = d0_ - 32;
                    p0[r] = ((unsigned)d0_ < 128u) ? p0[r] : NEG; p1[r] = ((unsigned)d1_ < 128u) ? p1[r] : NEG; }
            }
            const float rm = rowmax32(p0, p1);
            if (__any(rm > THR)) {
                const float dl = fmaxf(rm, 0.f);
                const float f = __builtin_amdgcn_exp2f(-dl);
                m_run += dl;
#pragma unroll
                for (int r = 0; r < 16; ++r) { p0[r] -= dl; p1[r] -= dl; negm[r] = -m_run; }
                if (has_x) {
#pragma unroll
                    for (int r = 0; r < 16; ++r) { x0[r] -= dl; x1[r] -= dl; }
                }
                l_run *= f;
                if (hi == 0) wsf[r32] = f;
                LDS_WAIT();
#pragma unroll
                for (int r = 0; r < 16; ++r) { const float fr_ = wsf[crow(r, hi)]; o[0][r] *= fr_; o[1][r] *= fr_; }
            }
            float sacc = 0.f;
#pragma unroll
            for (int r = 0; r < 16; ++r) { p0[r] = __builtin_amdgcn_exp2f(p0[r]); p1[r] = __builtin_amdgcn_exp2f(p1[r]); sacc += p0[r] + p1[r]; }
            l_run += sacc;
            u32x4 pw0, pw1, pw2, pw3;
            pw0 = (u32x4){cvtpk(p0[0], p0[1]), cvtpk(p0[2], p0[3]), cvtpk(p0[4], p0[5]), cvtpk(p0[6], p0[7])};
            pw1 = (u32x4){cvtpk(p0[8], p0[9]), cvtpk(p0[10], p0[11]), cvtpk(p0[12], p0[13]), cvtpk(p0[14], p0[15])};
            pw2 = (u32x4){cvtpk(p1[0], p1[1]), cvtpk(p1[2], p1[3]), cvtpk(p1[4], p1[5]), cvtpk(p1[6], p1[7])};
            pw3 = (u32x4){cvtpk(p1[8], p1[9]), cvtpk(p1[10], p1[11]), cvtpk(p1[12], p1[13]), cvtpk(p1[14], p1[15])};
            ATT_SBAR();
            pv(o, vb0 + cur, __builtin_bit_cast(bf16x8, pw0), __builtin_bit_cast(bf16x8, pw1), __builtin_bit_cast(bf16x8, pw2), __builtin_bit_cast(bf16x8, pw3));
        };
        {
            f32x16 a0, a1, b0, b1;
            const bool v0 = qb >= 2, v1 = qb >= 1;
            if (v0) qkt(a0, a1, kp0 + (((qb - 2) & (NSLOT - 1)) * SLOTB), qr, negm);
            if (v1) qkt(b0, b1, kp0 + (((qb - 1) & (NSLOT - 1)) * SLOTB), qr, negm);
            if (v0) tile_step(a0, a1, qb - 2, b0, b1, true);
            qkt(a0, a1, kp0 + ((qb & (NSLOT - 1)) * SLOTB), qr, negm);
            if (v1) tile_step(b0, b1, qb - 1, a0, a1, true);
            tile_step(a0, a1, qb, b0, b1, false);
        }
        { auto rr = __builtin_amdgcn_permlane32_swap(__float_as_uint(l_run), __float_as_uint(l_run), false, false); l_run = __uint_as_float(rr[0]) + __uint_as_float(rr[1]); }
        if (hi == 0) wsf[32 + r32] = l_run;
        LDS_WAIT();
        float rli[16];
#pragma unroll
        for (int r = 0; r < 16; ++r) rli[r] = __builtin_amdgcn_rcpf(wsf[32 + crow(r, hi)]);
        unsigned char* Ow = aout + (rowbase + qa) * D + qcol;
        { LAS unsigned char* stg = (LAS unsigned char*)(shm + L_OST) + wid * 2048;
#pragma unroll
            for (int r = 0; r < 16; ++r) { const int orow = crow(r, hi);
#pragma unroll
                for (int d0 = 0; d0 < 2; ++d0) { const float v = o[d0][r] * rli[r] * AO_SCALE; stg[orow * 64 + d0 * 32 + r32] = (unsigned char)__builtin_amdgcn_cvt_pk_fp8_f32(v, v, 0, false); } }
            LDS_WAIT();
#pragma unroll
            for (int i = 0; i < 2; ++i) { const int row = i * 16 + (lane >> 2), ch = lane & 3; const u32x4 v = *(const LAS u32x4*)(stg + row * 64 + ch * 16); *(u32x4*)(Ow + (long)row * D + ch * 16) = v; } }
        ATT_WAIT_BARN(2);
    }
#undef SW_DMA
}

constexpr int MK_K = 0, MK_V = 3 * SLOTB, MK_WS = 6 * SLOTB, MK_OST = MK_WS + 8 * 256, MK_KS = MK_OST + 8 * 4096, MK_END = MK_KS + 2048, MK_GATE = 131072;
constexpr float NEGB = -1.0e30f;
__device__ __forceinline__ float max3f(float a, float b, float c) { float r; asm("v_max3_f32 %0, %1, %2, %3" : "=v"(r) : "v"(a), "v"(b), "v"(c)); return r; }
__device__ __forceinline__ float max2f(float a, float b) { float r; asm("v_max_f32_e32 %0, %1, %2" : "=v"(r) : "v"(a), "v"(b)); return r; }
__device__ __forceinline__ float fadd_s(float a, float b) { float r; asm("v_add_f32_e32 %0, %1, %2" : "=v"(r) : "v"(a), "v"(b)); return r; }
__device__ __forceinline__ float fsub_s(float a, float b) { float r; asm("v_sub_f32_e32 %0, %1, %2" : "=v"(r) : "v"(a), "v"(b)); return r; }
typedef short v4i16_t __attribute__((ext_vector_type(4)));
#define MK_WAIT_BAR(N) asm volatile("s_waitcnt vmcnt(" #N ") lgkmcnt(0)\n\ts_barrier" ::: "memory")
__device__ __forceinline__ void kload8(bf16x8* kf, lds_cptr kp) {
    kf[0] = *(const LAS bf16x8*)(kp);        kf[1] = *(const LAS bf16x8*)(kp + 512);
    kf[2] = *(const LAS bf16x8*)(kp + 2048); kf[3] = *(const LAS bf16x8*)(kp + 2560);
    kf[4] = *(const LAS bf16x8*)(kp + 4096); kf[5] = *(const LAS bf16x8*)(kp + 4608);
    kf[6] = *(const LAS bf16x8*)(kp + 6144); kf[7] = *(const LAS bf16x8*)(kp + 6656);
}
__device__ __forceinline__ void kload2(bf16x8* kf, lds_cptr kp, int j) { kf[2 * j] = *(const LAS bf16x8*)(kp + j * 2048); kf[2 * j + 1] = *(const LAS bf16x8*)(kp + j * 2048 + 512); }
__device__ __forceinline__ s16x4 vtr(lds_cptr p) { return __builtin_bit_cast(s16x4, __builtin_amdgcn_ds_read_tr16_b64_v4i16((LAS v4i16_t*)p)); }
__device__ __forceinline__ float rowmax_a(const f32x16& p0, const f32x16& p1) {
    float a = max3f(p0[0], p0[1], p1[0]), b = max3f(p0[2], p0[3], p1[1]); a = max3f(a, p1[2], p1[3]);
#pragma unroll
    for (int r = 4; r < 16; r += 4) { a = max3f(a, p0[r], p0[r + 1]); b = max3f(b, p0[r + 2], p0[r + 3]); a = max3f(a, p1[r], p1[r + 1]); b = max3f(b, p1[r + 2], p1[r + 3]); }
    const float m = max2f(a, b);
    auto rr = __builtin_amdgcn_permlane32_swap(__float_as_uint(m), __float_as_uint(m), false, false);
    return max2f(__uint_as_float(rr[0]), __uint_as_float(rr[1]));
}
__device__ __forceinline__ void cmask(f32x16& p0, f32x16& p1, int jb, int qrel, int hi) {
    const float NEGI = -INFINITY; const int kb = 64 * jb + 4 * hi;
#pragma unroll
    for (int r = 0; r < 16; ++r) { const int kv = kb + (r & 3) + 8 * (r >> 2); if (kv > qrel) p0[r] = NEGI; if (kv + 32 > qrel) p1[r] = NEGI; }
}


__device__ __forceinline__ void moba_ksums(const bf16_t* __restrict__ qkv, int b, int h, LAS char* shm, const int wave_s) {
    int tid = tid_of(wave_s); asm volatile("" : "+v"(tid));
    const int lane = tid & 63;
    if (wave_s < 7) {
        const unsigned char* base = (const unsigned char*)qkv + qkv_tile((((long)b * SEQ + 256 * wave_s) >> 4), 20 + h) + (lane & 7) * 256 + (lane >> 3) * 16;
        float a[8];
#pragma unroll
        for (int j = 0; j < 8; ++j) a[j] = 0.f;
#pragma unroll 8
        for (int i = 0; i < 32; ++i) { const u32x4 v = *(const u32x4*)(base + (size_t)(i >> 1) * QKV_RB + (i & 1) * 128);
#pragma unroll
            for (int q = 0; q < 4; ++q) { a[2 * q] += bf2f(v[q] & 0xffffu); a[2 * q + 1] += bf2f(v[q] >> 16); } }
#pragma unroll
        for (int j = 0; j < 8; ++j) { a[j] += swz_xor<8>(a[j]); a[j] += swz_xor<16>(a[j]);
            auto rr = __builtin_amdgcn_permlane32_swap(__float_as_uint(a[j]), __float_as_uint(a[j]), false, false); a[j] = __uint_as_float(rr[0]) + __uint_as_float(rr[1]); }
        if (lane < 8) { LAS float* ksl = (LAS float*)(shm + MK_KS) + wave_s * 64 + 8 * lane;
            *(LAS f32x4*)(ksl) = (f32x4){a[0], a[1], a[2], a[3]}; *(LAS f32x4*)(ksl + 4) = (f32x4){a[4], a[5], a[6], a[7]};
            u32x4 hv, lv;
#pragma unroll
            for (int q = 0; q < 4; ++q) { const unsigned h0 = f2bf(a[2 * q]), h1 = f2bf(a[2 * q + 1]); hv[q] = h0 | (h1 << 16); lv[q] = f2bf(a[2 * q] - bf2f(h0)) | (f2bf(a[2 * q + 1] - bf2f(h1)) << 16); }
            *(LAS u32x4*)(shm + MK_GATE + lane * 1024 + wave_s * 16) = hv; *(LAS u32x4*)(shm + MK_GATE + lane * 1024 + (32 + wave_s) * 16) = lv; }
    }
    asm volatile("s_waitcnt lgkmcnt(0)" ::: "memory"); __builtin_amdgcn_s_barrier(); asm volatile("" ::: "memory");
}
template <int THRL>
__device__ __forceinline__ void moba_unit(int b, int h, int qb, const bf16_t* __restrict__ qkv, unsigned char* __restrict__ aout, LAS char* shm, const int wave_s, const bool pre, const bool nxt, bf16x8 (&qpre)[4], const float* cw1, unsigned char* cw1_8, const int cit) {
    int tid = tid_of(wave_s); asm volatile("" : "+v"(tid));
    const int lane = tid & 63, r32 = lane & 31, hi = lane >> 5; const int wid = __builtin_amdgcn_readfirstlane(tid >> 6);
    const long rowbase = (long)b * SEQ; const int q0 = qb * 256;
    const unsigned char* const qkv8 = (const unsigned char*)qkv; const long rb0 = rowbase >> 4;
    const unsigned char* Qw = qkv8 + qkv_tile(rb0 + (q0 >> 4) + 2 * wid + (r32 >> 4), 12 + h) + hi * 256 + (r32 & 15) * 16;
    const unsigned lds0 = (unsigned)(uintptr_t)shm;
    LAS float* wsf = (LAS float*)(shm + MK_WS) + wid * 64;
    const unsigned koff = (unsigned)((lane >> 4) * (int)QKV_RB + (lane & 15) * 16);
    const unsigned voff = (unsigned)((lane & 3) * 256 + (lane >> 2) * 16);
    const unsigned kdst = lds0 + MK_K + wid * 1024, vdst = lds0 + MK_V + wid * 1024;
#define DMA_K(t, slot) glds16s(koff, qkv8 + qkv_tile(rb0 + 4 * (long)(t), 20 + h) + wid * 256, (unsigned)__builtin_amdgcn_readfirstlane(kdst + (slot)))
#define DMA_V(t, slot) glds16s(voff, qkv8 + qkv_tile(rb0 + 4 * (long)(t) + (wid & 3), 28 + h) + (wid >> 2) * 1024, (unsigned)__builtin_amdgcn_readfirstlane(vdst + (slot)))
    bf16x8 kf[8];
    const lds_cptr shm3 = (lds_cptr)shm; const lds_cptr kp0 = shm3 + MK_K + hi * 1024 + r32 * 16; const lds_cptr vp0 = shm3 + MK_V + ((lane >> 4) & 1) * 32 + (lane & 3) * 8 + (4 * hi + ((lane & 15) >> 2)) * 64;
    const int NT = (q0 + 256) / 64;
    if (!pre) { DMA_K(0, 0); DMA_K(1, SLOTB); DMA_K(2, 2 * SLOTB); }
    bf16x8 qr[4];
    if (!pre) {
#pragma unroll
        for (int d0 = 0; d0 < 4; ++d0) qr[d0] = *reinterpret_cast<const bf16x8*>(Qw + d0 * 512);
    } else {
#pragma unroll
        for (int d0 = 0; d0 < 4; ++d0) qr[d0] = qpre[d0];
    }
    DMA_V(0, 0);
    float mhat = 0.f, l_reg = 0.f; f32x16 o[2], negm;
    { float zf = 0.f; asm volatile("" : "+v"(zf));
#pragma unroll
      for (int r = 0; r < 16; ++r) { o[0][r] = zf; o[1][r] = zf; negm[r] = zf; } }
    asm volatile("" : "+v"(negm));
    const int qrel = wid * 32 + r32;
#define CMASK(P0, P1, t) do { int jb_ = (t) - (NT - 4); if (jb_ >= 0) cmask(P0, P1, jb_, qrel, hi); } while (0)
    bool resc = false;
#define START(P0, P1) do { const float rm = rowmax_a(P0, P1); resc = false; \
    { const float dl = (rm > 0.1f * NEGB) ? rm : 0.f;      mhat = fadd_s(mhat, dl); \
      _Pragma("unroll") for (int r = 0; r < 16; ++r) { P0[r] = fsub_s(P0[r], dl); P1[r] = fsub_s(P1[r], dl); } \
      const float nm_ = ONB(1) ? -mhat : NEGB; \
      _Pragma("unroll") for (int r = 0; r < 16; ++r) negm[r] = nm_; asm volatile("" : "+v"(negm)); } \
    _Pragma("unroll") for (int r = 0; r < 16; ++r) P0[r] = __builtin_amdgcn_exp2f(P0[r]); } while (0)
#define RESC() do { if (resc) { asm volatile("s_waitcnt lgkmcnt(0)" ::: "memory"); \
      _Pragma("unroll") for (int d_ = 0; d_ < 2; ++d_) _Pragma("unroll") for (int r = 0; r < 16; ++r) o[d_][r] *= wsf[crow(r, hi)]; } } while (0)
    f32x16 pA0, pA1, pB0, pB1;
    int sl_prev = 0, sl_cur = 0, sl_next = SLOTB;
#define ROT() do { sl_prev = sl_cur; sl_cur = sl_next; sl_next = (sl_next == 2 * SLOTB) ? 0 : sl_next + SLOTB; } while (0)
    if (pre) { MK_WAIT_BAR(7); } else { MK_WAIT_BAR(1); }
    unsigned sel = 0u;
    if (qb <= 3) sel = (1u << qb) - 1u;
    else {
        f32x16 g0, g1, z16;
#pragma unroll
        for (int r = 0; r < 16; ++r) z16[r] = 0.f;
        qkt(g0, g1, shm3 + MK_GATE + hi * 1024 + r32 * 16, qr, z16);
        float gv[8];
#pragma unroll
        for (int i = 0; i < 4; ++i) { const float t_ = g0[i] + g1[i];
            auto rr = __builtin_amdgcn_permlane32_swap(__float_as_uint(t_), __float_as_uint(t_), false, false);
            gv[i] = __uint_as_float(rr[0]); gv[4 + i] = __uint_as_float(rr[1]); }
#pragma unroll
        for (int i = 0; i < 7; ++i) gv[i] = (i < qb) ? gv[i] : -INFINITY;
#pragma unroll
        for (int rk = 0; rk < 3; ++rk) { float best = -INFINITY; int bi = 0;
#pragma unroll
            for (int i = 0; i < 7; ++i) { const bool c = (((sel >> i) & 1u) == 0u) && (gv[i] > best); best = c ? gv[i] : best; bi = c ? i : bi; }
            sel |= 1u << bi; }
    }
#define ONB(tt) (((tt) >= NT - 4) ? true : (((sel >> ((tt) >> 2)) & 1u) != 0u))
#define SETNEGM(tt) do { const float nm_ = ONB(tt) ? -mhat : NEGB; _Pragma("unroll") for (int r = 0; r < 16; ++r) negm[r] = nm_; asm volatile("" : "+v"(negm)); } while (0)
    SETNEGM(0);
    qkt(pA0, pA1, kp0, qr, negm); asm volatile("s_nop 15\n\ts_nop 7" : "+v"(pA0), "+v"(pA1)); CMASK(pA0, pA1, 0);
    START(pA0, pA1);
    _Pragma("unroll") for (int r = 0; r < 16; ++r) pA1[r] = __builtin_amdgcn_exp2f(pA1[r]);
    MK_WAIT_BAR(0);
    DMA_K(3, 0); DMA_V(1, SLOTB);
    ROT();
    kload8(kf, kp0 + sl_cur);
    MK_WAIT_BAR(2);
    s16x4 vlo[8], vhi[8]; u32x4 pw0, pw1, pw2, pw3;
#define PKW(P, B) cvtpk(P[B], P[B + 1])
#define PAF(k) __builtin_bit_cast(bf16x8, pw##k)
#define VFR(i) (bf16x8){vlo[i][0], vlo[i][1], vlo[i][2], vlo[i][3], vhi[i][0], vhi[i][1], vhi[i][2], vhi[i][3]}
#define PIN(x) asm volatile("" : "+v"(x))
#define MX3(a, b, c) __builtin_fmaxf(__builtin_fmaxf((a), (b)), (c))
#define GAPA(MF, A0, A1, A2, A3, W0, W1, PW) do { MF; sacc += A0; sacc += A1; sacc += A2; sacc += A3; PIN(sacc); W0; W1; PIN(PW); ATT_SBAR(); } while (0)
#define EX(v) __builtin_amdgcn_exp2f(v)
#define GAPB(MF, X, B) do { MF; X[B] = EX(X[B]); X[B + 1] = EX(X[B + 1]); X[B + 2] = EX(X[B + 2]); X[B + 3] = EX(X[B + 3]); PIN(X); ATT_SBAR(); } while (0)
#define VRD(i) do { vlo[i] = vtr(vp_ + (((i) >> 2) * 4096 + ((i) & 3) * 1024)); vhi[i] = vtr(vp_ + (((i) >> 2) * 4096 + ((i) & 3) * 1024 + 512)); } while (0)
#define KRD(G, j) do { if (G) { kload2(kf, kp0 + sl_next, j); ATT_SBAR(); } } while (0)
#define MF32(a, b, c) __builtin_amdgcn_mfma_f32_32x32x16_bf16(a, b, c, 0, 0, 0)
#define STEP(C0, C1, P0, P1, t, GK, GV, GL) do { ATT_SBAR(); \
    const lds_cptr vp_ = vp0 + sl_prev; \
    VRD(0); ATT_SBAR(); float sacc = (P0[0] + P0[1]); \
    GAPA(C0 = MF32(kf[0], qr[0], negm), P0[2], P0[3], P0[4], P0[5],     pw0[0] = PKW(P0, 0), pw0[1] = PKW(P0, 2), pw0); \
    VRD(4); ATT_SBAR(); GAPA(C1 = MF32(kf[1], qr[0], negm), P0[6], P0[7], P0[8], P0[9],     pw0[2] = PKW(P0, 4), pw0[3] = PKW(P0, 6), pw0); \
    VRD(1); ATT_SBAR(); GAPA(C0 = MF32(kf[2], qr[1], C0),   P0[10], P0[11], P0[12], P0[13], pw1[0] = PKW(P0, 8), pw1[1] = PKW(P0, 10), pw1); \
    VRD(5); ATT_SBAR(); GAPA(C1 = MF32(kf[3], qr[1], C1),   P0[14], P0[15], P1[0], P1[1],   pw1[2] = PKW(P0, 12), pw1[3] = PKW(P0, 14), pw1); \
    VRD(2); ATT_SBAR(); GAPA(C0 = MF32(kf[4], qr[2], C0),   P1[2], P1[3], P1[4], P1[5],     pw2[0] = PKW(P1, 0), pw2[1] = PKW(P1, 2), pw2); \
    VRD(6); ATT_SBAR(); GAPA(C1 = MF32(kf[5], qr[2], C1),   P1[6], P1[7], P1[8], P1[9],     pw2[2] = PKW(P1, 4), pw2[3] = PKW(P1, 6), pw2); \
    VRD(3); ATT_SBAR(); GAPA(C0 = MF32(kf[6], qr[3], C0),   P1[10], P1[11], P1[12], P1[13], pw3[0] = PKW(P1, 8), pw3[1] = PKW(P1, 10), pw3); \
    VRD(7); ATT_SBAR(); GAPA(C1 = MF32(kf[7], qr[3], C1),   P1[14], P1[15], 0.f, 0.f,       pw3[2] = PKW(P1, 12), pw3[3] = PKW(P1, 14), pw3); \
    l_reg += sacc; \
    if (GK) { DMA_K((t) + 3, sl_cur); } if (GV) { DMA_V((t) + 1, sl_next); } \
    CMASK(C0, C1, t); \
    { float a = MX3(C0[0], C0[1], C1[0]), b_ = MX3(C0[2], C0[3], C1[1]); a = MX3(a, C1[2], C1[3]); \
      _Pragma("unroll") for (int r = 4; r < 16; r += 4) { a = MX3(a, C0[r], C0[r + 1]); b_ = MX3(b_, C0[r + 2], C0[r + 3]); a = MX3(a, C1[r], C1[r + 1]); b_ = MX3(b_, C1[r + 2], C1[r + 3]); } \
      float rm = __builtin_fmaxf(a, b_); { auto rr = __builtin_amdgcn_permlane32_swap(__float_as_uint(rm), __float_as_uint(rm), false, false); rm = __builtin_fmaxf(__uint_as_float(rr[0]), __uint_as_float(rr[1])); } \
      resc = false; \
      const bool blk_ = (((t) + 1) & 3) == 0;                    \
      if (__builtin_expect(__any(rm > (float)THRL), 0)) { const float dl = __builtin_fmaxf(rm, 0.f); mhat += dl; \
        _Pragma("unroll") for (int r = 0; r < 16; ++r) { C0[r] -= dl; C1[r] -= dl; } \
        const float nm_ = ONB((t) + 1) ? -mhat : NEGB; \
        _Pragma("unroll") for (int r = 0; r < 16; ++r) negm[r] = nm_; asm volatile("" : "+v"(negm)); \
        const float f = __builtin_amdgcn_exp2f(-dl); l_reg *= f; if (hi == 0) wsf[r32] = f; resc = true; } \
      else if (blk_) { SETNEGM((t) + 1); } } \
    ATT_SBAR(); \
    GAPB(o[0] = MF32(PAF(0), VFR(0), o[0]), C0, 0); \
    GAPB(o[1] = MF32(PAF(0), VFR(4), o[1]), C0, 4); \
    KRD(GL, 0); GAPB(o[0] = MF32(PAF(1), VFR(1), o[0]), C0, 8); \
    KRD(GL, 1); GAPB(o[1] = MF32(PAF(1), VFR(5), o[1]), C0, 12); \
    KRD(GL, 2); GAPB(o[0] = MF32(PAF(2), VFR(2), o[0]), C1, 0); \
    KRD(GL, 3); GAPB(o[1] = MF32(PAF(2), VFR(6), o[1]), C1, 4); \
    GAPB(o[0] = MF32(PAF(3), VFR(3), o[0]), C1, 8); \
    GAPB(o[1] = MF32(PAF(3), VFR(7), o[1]), C1, 12); \
    } while (0)
    int t = 1;
#undef CMASK
#define CMASK(P0, P1, t) do { } while (0)
    for (; t + 5 < NT; t += 2) {
        STEP(pB0, pB1, pA0, pA1, t, true, true, true);       MK_WAIT_BAR(2); RESC(); ROT();
        STEP(pA0, pA1, pB0, pB1, t + 1, true, true, true);   MK_WAIT_BAR(2); RESC(); ROT();
    }
#undef CMASK
#define CMASK(P0, P1, t) do { int jb_ = (t) - (NT - 4); if (jb_ >= 0) cmask(P0, P1, jb_, qrel, hi); } while (0)
#define ENDW(tt) do { if ((tt) + 3 < NT) { MK_WAIT_BAR(2); } else if ((tt) + 2 < NT) { MK_WAIT_BAR(1); } else { MK_WAIT_BAR(0); } } while (0)
    for (; t + 1 < NT; t += 2) {
        STEP(pB0, pB1, pA0, pA1, t, (t + 3 < NT), (t + 1 < NT), (t + 1 < NT));           ENDW(t);     RESC(); ROT();
        STEP(pA0, pA1, pB0, pB1, t + 1, (t + 4 < NT), (t + 2 < NT), (t + 2 < NT));       ENDW(t + 1); RESC(); ROT();
    }
    if (nxt) { DMA_K(0, 0); DMA_K(1, SLOTB); DMA_K(2, 2 * SLOTB); }
    f32x4 cv[16];
    if (cit < NE * 512) { int t_ = tid_of(wave_s); asm volatile("" : "+v"(t_)); cvt_load<64>(cw1 + (size_t)(cit >> 9) * 1024 * 2048, 2048, cit & 511, t_ & 63, cv); }
    STEP(pB0, pB1, pA0, pA1, NT - 1, false, false, false); RESC();
    { float sacc = pB0[0] + pB0[1]; _Pragma("unroll") for (int r = 2; r < 16; ++r) sacc += pB0[r]; _Pragma("unroll") for (int r = 0; r < 16; ++r) sacc += pB1[r]; l_reg += sacc;
      pw0 = (u32x4){PKW(pB0, 0), PKW(pB0, 2), PKW(pB0, 4), PKW(pB0, 6)}; pw1 = (u32x4){PKW(pB0, 8), PKW(pB0, 10), PKW(pB0, 12), PKW(pB0, 14)}; pw2 = (u32x4){PKW(pB1, 0), PKW(pB1, 2), PKW(pB1, 4), PKW(pB1, 6)}; pw3 = (u32x4){PKW(pB1, 8), PKW(pB1, 10), PKW(pB1, 12), PKW(pB1, 14)};
      ATT_SBAR(); const int vb0 = (int)(lds0 + MK_V) + ((lane >> 4) & 1) * 32 + (lane & 3) * 8 + (4 * hi + ((lane & 15) >> 2)) * 64; pv(o, vb0 + sl_cur, PAF(0), PAF(1), PAF(2), PAF(3)); }
#undef PKW
#undef PAF
#undef VFR
#undef PIN
#undef MX3
#undef GAPA
#undef GAPB
#undef EX
#undef VRD
#undef KRD
#undef MF32
#undef STEP
#undef ENDW
    {
        int t_ = tid_of(wave_s); asm volatile("" : "+v"(t_)); const int r_ = t_ & 31, h_ = (t_ >> 5) & 1;
        const unsigned char* Qn = qkv8 + qkv_tile(rb0 + ((q0 + (nxt ? 256 : 0)) >> 4) + 2 * wid + (r_ >> 4), 12 + h) + h_ * 256 + (r_ & 15) * 16;
#pragma unroll
        for (int d0 = 0; d0 < 4; ++d0) qpre[d0] = *reinterpret_cast<const bf16x8*>(Qn + d0 * 512);
    }
    { auto rr = __builtin_amdgcn_permlane32_swap(__float_as_uint(l_reg), __float_as_uint(l_reg), false, false); l_reg = __uint_as_float(rr[0]) + __uint_as_float(rr[1]); }
    if (hi == 0) wsf[32 + r32] = l_reg; asm volatile("s_waitcnt lgkmcnt(0)" ::: "memory");
    float rli[16];
#pragma unroll
    for (int r = 0; r < 16; ++r) rli[r] = __builtin_amdgcn_rcpf(wsf[32 + crow(r, hi)]);
    unsigned char* Ow = aout + (rowbase + q0 + wid * 32) * D + 512 + 64 * h;
    { LAS unsigned char* stg = (LAS unsigned char*)(shm + MK_OST) + wid * 2048;
#pragma unroll
      for (int r = 0; r < 16; ++r) { const int orow = crow(r, hi);
#pragma unroll
          for (int d0 = 0; d0 < 2; ++d0) { const float v = o[d0][r] * rli[r] * AO_SCALE; stg[orow * 64 + d0 * 32 + r32] = (unsigned char)__builtin_amdgcn_cvt_pk_fp8_f32(v, v, 0, false); } }
      asm volatile("s_waitcnt lgkmcnt(0)" ::: "memory");
#pragma unroll
      for (int i = 0; i < 2; ++i) { const int row = i * 16 + (lane >> 2), ch = lane & 3; const u32x4 v = *(const LAS u32x4*)(stg + row * 64 + ch * 16); *(u32x4*)(Ow + (long)row * D + ch * 16) = v; } }
    if (cit < NE * 512) { int t_ = tid_of(wave_s); asm volatile("" : "+v"(t_)); cvt_store<64>(cw1_8 + (size_t)(cit >> 9) * 2048 * 1024, 2048, 2, W_SCALE, cit & 511, t_ & 63, cv); }
    asm volatile("s_waitcnt lgkmcnt(0)\n\ts_barrier" ::: "memory");
#undef DMA_K
#undef DMA_V
#undef CMASK
#undef START
#undef RESC
#undef ROT
#undef ONB
#undef SETNEGM
}
}

__device__ __forceinline__ void sincos_d(double a, double& s, double& c) {
    const double q = __builtin_rint(a * 0.63661977236758134308);
    double r = __builtin_fma(-q, 1.57079632679489655800e+00, a);
    r = __builtin_fma(-q, 6.12323399573676603587e-17, r);
    const double r2 = r * r;
    double sp = -1.0 / 1307674368000.0;
    sp = sp * r2 + 1.0 / 6227020800.0; sp = sp * r2 - 1.0 / 39916800.0; sp = sp * r2 + 1.0 / 362880.0; sp = sp * r2 - 1.0 / 5040.0; sp = sp * r2 + 1.0 / 120.0; sp = sp * r2 - 1.0 / 6.0;
    const double sr = r + r * r2 * sp;
    double cp = 1.0 / 20922789888000.0;
    cp = cp * r2 - 1.0 / 87178291200.0; cp = cp * r2 + 1.0 / 479001600.0; cp = cp * r2 - 1.0 / 3628800.0; cp = cp * r2 + 1.0 / 40320.0; cp = cp * r2 - 1.0 / 720.0; cp = cp * r2 + 1.0 / 24.0; cp = cp * r2 - 0.5;
    const double cr = 1.0 + r2 * cp;
    const int n = ((int)q) & 3;
    s = (n == 0) ? sr : (n == 1) ? cr : (n == 2) ? -sr : -cr;
    c = (n == 0) ? cr : (n == 1) ? -sr : (n == 2) ? -cr : sr;
}
__device__ __forceinline__ int sigma_col(int p, int mode) {
    if (mode == 0) return (p & ~255) + 64 * ((p >> 5) & 3) + 32 * ((p >> 7) & 1) + pg8::perm32(p & 31);
    if (mode == 1) return (p & ~31) + pg8::perm32(p & 31);
    if (mode == 3) return (p & ~255) + 64 * ((p >> 5) & 3) + 16 * ((p >> 2) & 3) + 8 * ((p >> 7) & 1) + 4 * ((p >> 4) & 1) + (p & 3);
    const int pn = p >> 8, q = p & 255; return 2 * (128 * pn + 32 * ((q >> 5) & 3) + pg8::perm32(q & 31)) + (q >> 7);
}
__device__ __forceinline__ void p0_transpose_item(const float* __restrict__ W, int N, bf16_t* __restrict__ WT, int mode, LAS float* scr, int item, int lane) {
    const int nblk = N / 32, kb = item / nblk, nb = item % nblk, k0 = 64 * kb, p0 = 32 * nb;
    const int sc = sigma_col(p0 + (lane & 31), mode);
#pragma unroll 8
    for (int i = 0; i < 32; ++i) { const int kk = 2 * i + (lane >> 5); scr[kk * 33 + (lane & 31)] = W[(size_t)(k0 + kk) * N + sc]; }
    LDS_WAIT(); asm volatile("" ::: "memory");
    const int c = lane & 7;
#pragma unroll
    for (int j = 0; j < 4; ++j) { const int n = (lane >> 3) + 8 * j; const LAS float* s = scr + (8 * c) * 33 + n;
        u32x4 o; o.x = cvtpk(s[0 * 33], s[1 * 33]); o.y = cvtpk(s[2 * 33], s[3 * 33]); o.z = cvtpk(s[4 * 33], s[5 * 33]); o.w = cvtpk(s[6 * 33], s[7 * 33]);
        *(u32x4*)(WT + (size_t)(p0 + n) * 1024 + k0 + 8 * c) = o; }
    LDS_WAIT(); asm volatile("" ::: "memory");
}

__device__ __forceinline__ void p0_transpose_item_fp8(const float* __restrict__ W, int N, unsigned char* __restrict__ WT, int mode, float scale, LAS float* scr, int item, int lane) {
    const int nblk = N / 32, kb = item / nblk, nb = item % nblk, k0 = 64 * kb, p0 = 32 * nb;
    const int sc = sigma_col(p0 + (lane & 31), mode);
#pragma unroll 8
    for (int i = 0; i < 32; ++i) { const int kk = 2 * i + (lane >> 5); scr[kk * 33 + (lane & 31)] = W[(size_t)(k0 + kk) * N + sc] * scale; }
    LDS_WAIT(); asm volatile("" ::: "memory");
    const int c = lane & 7;
#pragma unroll
    for (int j = 0; j < 4; ++j) { const int n = (lane >> 3) + 8 * j; const LAS float* s = scr + (8 * c) * 33 + n;
        u32x2 o; o.x = pk4_fp8(s[0 * 33], s[1 * 33], s[2 * 33], s[3 * 33]); o.y = pk4_fp8(s[4 * 33], s[5 * 33], s[6 * 33], s[7 * 33]);
        *(u32x2*)(WT + (size_t)(p0 + n) * 1024 + k0 + 8 * c) = o; }
    LDS_WAIT(); asm volatile("" ::: "memory");
}


__device__ __forceinline__ int inv32(int c) { return 16 * ((c >> 2) & 1) + 4 * (c >> 3) + (c & 3); }
__device__ __forceinline__ int pos_of(int c, int mode) {
    if (mode == 0) return (c & ~255) + (((c >> 6) & 3) << 5) + (((c >> 5) & 1) << 7) + inv32(c & 31);
    if (mode == 1) return (c & ~31) + inv32(c & 31);
    if (mode == 3) return (c & ~255) + 128 * ((c >> 3) & 1) + 32 * ((c >> 6) & 3) + 16 * ((c >> 2) & 1) + 4 * ((c >> 4) & 3) + (c & 3);
    const int par = c & 1, h = c >> 1; return 256 * (h >> 7) + 128 * par + 32 * ((h >> 5) & 3) + inv32(h & 31);
}
template <int CW>
__device__ __forceinline__ void cvt_load(const float* __restrict__ W, int N, int item, int lane, f32x4 (&v)[16]) {
    constexpr int LPR = CW / 4, KR = 16 * (64 / LPR);
    const int ncb = N / CW, kb = item / ncb, cb = item % ncb;
    const int cl = lane % LPR, g = lane / LPR;
    const int c0 = CW * cb + 4 * cl, k0 = KR * kb + 16 * g;
    const float* src = W + (size_t)k0 * N + c0;
#pragma unroll
    for (int i = 0; i < 16; ++i) v[i] = __builtin_nontemporal_load((const f32x4*)(src + (size_t)i * N));
}
template <int CW>
__device__ __forceinline__ void cvt_store(unsigned char* __restrict__ WT, int N, int mode, float scale, int item, int lane, const f32x4 (&v)[16]) {
    constexpr int LPR = CW / 4, KR = 16 * (64 / LPR);
    const int ncb = N / CW, kb = item / ncb, cb = item % ncb;
    const int cl = lane % LPR, g = lane / LPR;
    const int c0 = CW * cb + 4 * cl, k0 = KR * kb + 16 * g;
#pragma unroll
    for (int j = 0; j < 4; ++j) {
        u32x4 o;
        o.x = pk4_fp8(v[0][j] * scale, v[1][j] * scale, v[2][j] * scale, v[3][j] * scale);     o.y = pk4_fp8(v[4][j] * scale, v[5][j] * scale, v[6][j] * scale, v[7][j] * scale);
        o.z = pk4_fp8(v[8][j] * scale, v[9][j] * scale, v[10][j] * scale, v[11][j] * scale);   o.w = pk4_fp8(v[12][j] * scale, v[13][j] * scale, v[14][j] * scale, v[15][j] * scale);
        *(u32x4*)(WT + (size_t)pos_of(c0 + j, mode) * 1024 + k0) = o;
    }
}
__device__ __forceinline__ void cvt_load8(const float* __restrict__ W, int item, int lane, f32x4 (&v)[8]) {
    const int kb = item >> 5, cb = item & 31, cl = lane & 7, g = lane >> 3;
    const float* src = W + (size_t)(64 * kb + 8 * g) * 1024 + 32 * cb + 4 * cl;
#pragma unroll
    for (int i = 0; i < 8; ++i) v[i] = __builtin_nontemporal_load((const f32x4*)(src + (size_t)i * 1024));
}
__device__ __forceinline__ void cvt_store8(unsigned char* __restrict__ WT, int mode, float scale, int item, int lane, const f32x4 (&v)[8]) {
    const int kb = item >> 5, cb = item & 31, cl = lane & 7, g = lane >> 3;
    const int c0 = 32 * cb + 4 * cl, k0 = 64 * kb + 8 * g;
#pragma unroll
    for (int j = 0; j < 4; ++j) {
        u32x2 o; o.x = pk4_fp8(v[0][j] * scale, v[1][j] * scale, v[2][j] * scale, v[3][j] * scale); o.y = pk4_fp8(v[4][j] * scale, v[5][j] * scale, v[6][j] * scale, v[7][j] * scale);
        *(u32x2*)(WT + (size_t)pos_of(c0 + j, mode) * 1024 + k0) = o;
    }
}
template <int CW>
__device__ __forceinline__ void cvt_item(const float* __restrict__ W, int N, unsigned char* __restrict__ WT, int mode, float scale, int item, int lane) {
    f32x4 v[16]; cvt_load<CW>(W, N, item, lane, v); cvt_store<CW>(WT, N, mode, scale, item, lane, v);
}

struct CvtHook {
    const float* w1; unsigned char* w1_8; int gw, NGW, kbase;
    __device__ __forceinline__ void one(int k, int lane) const {
        constexpr int NIT1 = NE * 512;
        const int it = gw + NGW * k; if (it >= NIT1) return;
        const int e = it >> 9; cvt_item<64>(w1 + (size_t)e * 1024 * 2048, 2048, w1_8 + (size_t)e * 2048 * 1024, 2, W_SCALE, it & 511, lane);
    }
    struct State {};
    __device__ __forceinline__ void pre(int, int, State&) const {}
    __device__ __forceinline__ void operator()(int ui, int wave_s, State&) const { int t_ = tid_of(wave_s); asm volatile("" : "+v"(t_)); one(kbase + ui, t_ & 63); }
};
struct W2Hook {
    const float* w2; unsigned char* w2_8; int gw, NGW, step;
    struct State { f32x4 v[8]; int item; bool armed; };
    __device__ __forceinline__ void pre(int ui, int wave_s, State& st) const {
        constexpr int NIT2 = NE * 512;
        const int k = ui / step; st.item = gw + NGW * k; st.armed = (ui % step == 0) && (st.item < NIT2);
        if (st.armed) { int t_ = tid_of(wave_s); asm volatile("" : "+v"(t_)); cvt_load8(w2 + (size_t)(st.item >> 9) * 1024 * 1024, st.item & 511, t_ & 63, st.v); }
    }
    __device__ __forceinline__ void operator()(int, int wave_s, State& st) const {
        if (st.armed) { int t_ = tid_of(wave_s); asm volatile("" : "+v"(t_)); cvt_store8(w2_8 + (size_t)(st.item >> 9) * 1024 * 1024, 3, W_SCALE, st.item & 511, t_ & 63, st.v); }
    }
};

#define XB_TMO      128
#define XB_XCNT(j)  (256  + 64 * (j))
#define XB_XSUB(j)  (1280 + 64 * (j))
#define XB_XGEN(j)  (2304 + 64 * (j))
#define XB_TOP      3328
#define XB_TOPGEN   3392
#define XB_DONE     3456
#define XCD_BAR_WORDS 3520
#define XB_SPIN_CAP (1u << 18)
__device__ __forceinline__ unsigned xb_ld(unsigned* p)              { return __hip_atomic_load(p, __ATOMIC_RELAXED, __HIP_MEMORY_SCOPE_AGENT); }
__device__ __forceinline__ unsigned xb_add(unsigned* p, unsigned v) { return __hip_atomic_fetch_add(p, v, __ATOMIC_RELAXED, __HIP_MEMORY_SCOPE_AGENT); }
__device__ __forceinline__ unsigned xb_xcc_id() { return (unsigned)__builtin_amdgcn_s_getreg((3 << 11) | 20) & 0xFu; }
#define XB_SPIN(cond, bar) do { unsigned _sp = 0; while (cond) { __builtin_amdgcn_s_sleep(1); \
    if ((++_sp & 255u) == 0u) { if (xb_ld(&(bar)[XB_TMO])) break; if (_sp > XB_SPIN_CAP) { atomicAdd(&(bar)[XB_TMO], 1u); break; } } } } while (0)
struct XcdBarrier { unsigned* bar; unsigned x; volatile LAS unsigned* st; };
__device__ __forceinline__ XcdBarrier xcd_barrier_post(unsigned* bar, volatile LAS unsigned* st, const int wave_s) {
    XcdBarrier b; b.bar = bar; b.x = xb_xcc_id(); b.st = st;
    if (tid_of(wave_s) == 0) (void)xb_add(&bar[XB_XCNT(b.x)], 1u);
    return b;
}
__device__ __forceinline__ void xcd_barrier_complete(unsigned* bar, unsigned x, unsigned& nloc, unsigned& nx, unsigned& xmask) {
    const unsigned G = gridDim.x * gridDim.y * gridDim.z;
    unsigned sum, cnt, mine, sp = 0u;
    for (;;) {
        sum = 0u; cnt = 0u; mine = 0u; xmask = 0u;
#pragma unroll
        for (unsigned j = 0; j < 16; ++j) { const unsigned c = xb_ld(&bar[XB_XCNT(j)]); sum += c; cnt += (c > 0u) ? 1u : 0u; xmask |= (c > 0u) ? (1u << j) : 0u; mine = (j == x) ? c : mine; }
        if (sum == G) break;
        __builtin_amdgcn_s_sleep(1);
        if ((++sp & 255u) == 0u) { if (xb_ld(&bar[XB_TMO])) break; if (sp > XB_SPIN_CAP) { atomicAdd(&bar[XB_TMO], 1u); break; } }
    }
    nloc = mine > 0u ? mine : 1u; nx = cnt > 0u ? cnt : 1u;
}
__device__ __forceinline__ void xcd_barrier(const XcdBarrier& b, const int wave_s) {
    asm volatile("s_waitcnt vmcnt(0)" ::: "memory");
    __syncthreads();
    if (tid_of(wave_s) == 0) {
        unsigned* bar = b.bar;
        __builtin_amdgcn_s_waitcnt(0);
        unsigned nloc = b.st[0], nx = b.st[1], xmask = b.st[2];
        if (nloc == 0u) { xcd_barrier_complete(bar, b.x, nloc, nx, xmask); b.st[0] = nloc; b.st[1] = nx; b.st[2] = xmask; }
        const unsigned old = xb_add(&bar[XB_XSUB(b.x)], 1u);
        const unsigned gen = old / nloc;
        if (old + 1u == (gen + 1u) * nloc) {
            __builtin_amdgcn_fence(__ATOMIC_RELEASE, "agent");
            asm volatile("s_waitcnt vmcnt(0)" ::: "memory");
            const unsigned og = xb_add(&bar[XB_TOP], 1u);
            const unsigned tg = og / nx;
            if (og + 1u == (tg + 1u) * nx) {
#pragma unroll
                for (unsigned j = 0; j < 16; ++j) if ((xmask >> j) & 1u) (void)xb_add(&bar[XB_XGEN(j)], 1u);
            }
        }
        XB_SPIN(xb_ld(&bar[XB_XGEN(b.x)]) == gen, bar);
        __builtin_amdgcn_fence(__ATOMIC_ACQUIRE, "agent");
        asm volatile("s_waitcnt vmcnt(0)" ::: "memory");
    }
    __syncthreads();
}

__device__ unsigned g_xbar[XCD_BAR_WORDS];
__global__ void __launch_bounds__(NTHREADS, 2) fwd_megakernel(Params p_arg) {
    extern __shared__ __attribute__((aligned(16))) unsigned char lds_raw[];
    LAS unsigned char* lds = (LAS unsigned char*)lds_raw;
#define PHASE_IDS() int tid = tid_of(wave_s); asm volatile("" : "+v"(tid)); const int lane = tid & 63, wave = wave_s; (void)lane; (void)wave
    const int G = gridDim.x, bx = blockIdx.x;
    const int wave_s = __builtin_amdgcn_readfirstlane((int)threadIdx.x >> 6);
    typedef const __attribute__((address_space(4))) Params* KParams;
    const KParams kp0 = (KParams)__builtin_amdgcn_kernarg_segment_ptr();
#define PHASE_PTRS() KParams _kp = kp0; asm volatile("" : "+s"(_kp)); Params p; p.x = _kp->x; p.w_in = _kp->w_in; p.b_in = _kp->b_in; p.sinks = _kp->sinks; p.w_out = _kp->w_out; p.b_out = _kp->b_out; p.ln1_g = _kp->ln1_g; p.ln1_b = _kp->ln1_b; \
    p.w_router = _kp->w_router; p.b_router = _kp->b_router; p.w1 = _kp->w1; p.b1 = _kp->b1; p.w2 = _kp->w2; p.b2 = _kp->b2; p.ln2_g = _kp->ln2_g; p.ln2_b = _kp->ln2_b; p.out = _kp->out; p.ws = _kp->ws; unsigned char* const ws = p.ws; \
    unsigned* const ctl = (unsigned*)(ws + WS_CTL); float* const ksum = (float*)(ws + WS_KSUM); float* const rope = (float*)(ws + WS_ROPE); \
    bf16_t* const w_in_t = (bf16_t*)(ws + WS_WIN_T); bf16_t* const w_out_t = (bf16_t*)(ws + WS_WOUT_T); \
    unsigned char* const w1_8 = ws + WS_W1_8; unsigned char* const w2_8 = ws + WS_W2_8; unsigned char* const x1_8 = ws + WS_X1_8; unsigned char* const act8 = ws + WS_ACT8; \
    int* const cnt_blk = (int*)(ws + WS_CNT); int* const tile_e = (int*)(ws + WS_TILE_E); bf16_t* const wr_hi = (bf16_t*)(ws + WS_WR_HI); bf16_t* const wr_lo = (bf16_t*)(ws + WS_WR_LO); \
    int* const tok = (int*)(ws + WS_TOK); int* const asg_e = (int*)(ws + WS_ASG_E); float* const asg_g = (float*)(ws + WS_ASG_G); int* const asg_d = (int*)(ws + WS_ASG_D); \
    bf16_t* const x1b = (bf16_t*)(ws + WS_X1B); bf16_t* const xb = (bf16_t*)(ws + WS_XB); bf16_t* const attn_o = xb; bf16_t* const qkv = (bf16_t*)(ws + WS_QKV); unsigned char* const yb = ws + WS_YB; \
    (void)ctl; (void)ksum; (void)rope; (void)w_in_t; (void)w_out_t; (void)w1_8; (void)w2_8; (void)x1_8; (void)act8; (void)cnt_blk; (void)tile_e; (void)wr_hi; (void)wr_lo; (void)tok; (void)asg_e; (void)asg_g; (void)asg_d; \
    float* const stats = (float*)(ws + WS_STATS); float* const rc = (float*)(ws + WS_RC); (void)stats; (void)rc; \
    (void)x1b; (void)xb; (void)attn_o; (void)qkv; (void)yb
    { const int t0 = tid_of(wave_s); if (t0 < 3) ((LAS unsigned*)(lds + LDS_BARST))[t0] = 0u; }
    __syncthreads();
    XcdBarrier xbar;
    { PHASE_PTRS(); xbar = xcd_barrier_post(g_xbar, (volatile LAS unsigned*)(lds + LDS_BARST), wave_s); }

    REP(0) {
        PHASE_IDS(); PHASE_PTRS();
        const long gt = (long)bx * NTHREADS + tid, gsz = (long)G * NTHREADS;
        for (long i = gt; i < 2048 * 32; i += gsz) {
            const int pos = (int)(i >> 5), k = (int)(i & 31);
            double inv = 1.0; for (int q = 0; q < k; ++q) inv *= 0.7498942093324559;
            double s, c; sincos_d((double)pos * inv, s, c);
            rope[pos * 64 + k] = (float)c; rope[pos * 64 + 32 + k] = (float)s;
        }
        for (long i = gt; i < 32 * 1024; i += gsz) {
            const int e = (int)(i >> 10), k = (int)(i & 1023); const float w = p.ln1_g[k] * p.w_router[k * 32 + e];
            const unsigned h = f2bf(w); wr_hi[i] = (bf16_t)h; wr_lo[i] = (bf16_t)f2bf(w - bf2f(h));
        }
        for (int e = bx * 8 + wave; e < NE; e += G * 8) {
            float s1 = 0.f, s2 = 0.f;
            for (int k = lane; k < 1024; k += 64) { const float wr = p.w_router[k * 32 + e], w = p.ln1_g[k] * wr; const unsigned h = f2bf(w);
                s1 += bf2f(h) + bf2f(f2bf(w - bf2f(h))); s2 += p.ln1_b[k] * wr; }
            s1 = wave_sum(s1); s2 = wave_sum(s2);
            if (lane == 0) { rc[e] = s1; rc[32 + e] = s2 + p.b_router[e]; }
        }
        const int gw = bx * 8 + wave, NGW = G * 8;
        constexpr int I_IN = 8 * (INW / 32), I_OUT = 8 * 32, I_W1 = 16 * 32, I_W2 = 8 * 32;
        if (G * 8 * 8 < NE * 512) { for (int it = gw; it < NE * I_W2; it += NGW) { const int e = it / I_W2; cvt_item<32>(p.w2 + (size_t)e * 1024 * 1024, 1024, w2_8 + (size_t)e * 1024 * 1024, 3, W_SCALE, it % I_W2, lane); } }
        if (G * 8 * 8 < NE * 512) { for (int it = gw; it < NE * I_W1; it += NGW) { const int e = it / I_W1; cvt_item<64>(p.w1 + (size_t)e * 1024 * 2048, 2048, w1_8 + (size_t)e * 2048 * 1024, 2, W_SCALE, it % I_W1, lane); } }
        for (int it = gw; it < I_IN + I_OUT; it += NGW) {
            if (it < I_IN) cvt_item<32>(p.w_in, INW, (unsigned char*)w_in_t, 0, WIN_SCALE, it, lane);
            else cvt_item<32>(p.w_out, 1024, (unsigned char*)w_out_t, 0, W_SCALE, it - I_IN, lane);
        }
        const f32x4* x4 = (const f32x4*)p.x;
#if INPROJ_FP8
        unsigned* x8 = (unsigned*)xb;
        constexpr long NV = (long)T * D / 4;
        for (long i0 = gt; i0 < NV; i0 += 8 * gsz) {
            f32x4 a[8];
#pragma unroll
            for (int q = 0; q < 8; ++q) { const long i = i0 + q * gsz; a[q] = __builtin_nontemporal_load(x4 + (i < NV ? i : i0)); }
#pragma unroll
            for (int q = 0; q < 8; ++q) { const long i = i0 + q * gsz; if (i < NV) x8[i] = pk4_fp8(a[q][0], a[q][1], a[q][2], a[q][3]); }
        }
#else
        u32x4* xb4 = (u32x4*)xb;
        for (long i = gt; i < (long)T * D / 8; i += gsz) { const f32x4 a = x4[2 * i], b = x4[2 * i + 1];
            u32x4 o; o.x = cvtpk(a[0], a[1]); o.y = cvtpk(a[2], a[3]); o.z = cvtpk(b[0], b[1]); o.w = cvtpk(b[2], b[3]); xb4[i] = o; }
#endif
    }
    xcd_barrier(xbar, wave_s);

    REP(1) {
        PHASE_PTRS();
        pg8::SchedInProj<1024> S{(const char*)xb, (const char*)w_in_t, G, bx};
        pg8::EpiInProj E{qkv, p.b_in, rope, KPF / WIN_SCALE};
        pg8::gemm_phase<pg8::EpiInProj, pg8::SchedInProj<1024>, false, true, 512, true>(lds, S, E, wave_s);
    }
    xcd_barrier(xbar, wave_s);

    REP(2) for (int u = bx; u < 256; u += G) {
        PHASE_PTRS();
        { const int b = u >> 3, h = u & 7;
            att::moba_ksums(qkv, b, h, (LAS char*)lds, wave_s);
            bf16x8 qpre[4];
#pragma unroll
            for (int d0 = 0; d0 < 4; ++d0) qpre[d0] = (bf16x8){0, 0, 0, 0, 0, 0, 0, 0};
            for (int j = 0; j < 8; ++j) att::moba_unit<8>(b, h, j, qkv, (unsigned char*)attn_o, (LAS char*)lds, wave_s, j > 0, j < 7, qpre, p.w1, w1_8, (u == bx && G * 8 * 8 >= NE * 512) ? (bx * 8 + wave_s) + G * 8 * j : 0x7fffffff); }
        { const int b = u >> 3, kvh = (u >> 2) & 1, oct = u & 3;
            for (int rp_ = 0; rp_ < (((DUP_MASK >> 8) & 1) ? 2 : 1); ++rp_) att::swa_stream((LAS char*)lds, qkv, (unsigned char*)attn_o, b, kvh, oct * 8, 8, p.sinks, wave_s); }
    }
    xcd_barrier(xbar, wave_s);

    REP(3) for (int pm = bx; pm < T / 256; pm += G) {
        {
            PHASE_PTRS();
            pg8::SchedPanel S{(const char*)attn_o, (const char*)w_out_t, pm};
            pg8::EpiOutProj E{x1b, p.b_out, p.x};
            pg8::gemm_phase<pg8::EpiOutProj, pg8::SchedPanel, false, true, 512, true>(lds, S, E, wave_s);
        }
        __syncthreads();
        for (int rp3_ = 0; rp3_ < (((DUP_MASK >> 9) & 1) ? 2 : 1); ++rp3_) {
        {
            PHASE_IDS(); PHASE_PTRS();
#pragma unroll
            for (int i = 0; i < 16; ++i) { const int idx = tid + 512 * i, mat = idx >> 12, rw = (idx >> 7) & 31, ch = idx & 127;
                const u32x4 v = *(const u32x4*)((mat ? wr_lo : wr_hi) + rw * 1024 + ch * 8);
                *(LAS u32x4*)(lds + mat * 66048 + rw * 2064 + ch * 16) = v; }
        }
        __syncthreads();
        {
            PHASE_IDS(); PHASE_PTRS();
            const bf16_t* ytmp = x1b;
            f32x4 gg[2][2], bb[2][2];
#pragma unroll
            for (int j = 0; j < 2; ++j)
#pragma unroll
                for (int h = 0; h < 2; ++h) { gg[j][h] = *(const f32x4*)(p.ln1_g + 512 * j + 8 * lane + 4 * h); bb[j][h] = *(const f32x4*)(p.ln1_b + 512 * j + 8 * lane + 4 * h); }
            constexpr int LNR = 2;
            for (int rr = 0; rr < 32; rr += LNR) {
                const size_t row0 = (size_t)pm * 256 + wave * 32 + rr;
                u32x4 raw[LNR][2]; float v[LNR][2][8]; float sm[LNR], sq[LNR];
#pragma unroll
                for (int q = 0; q < LNR; ++q)
#pragma unroll
                    for (int j = 0; j < 2; ++j) raw[q][j] = *(const u32x4*)(ytmp + (row0 + q) * D + 512 * j + 8 * lane);
#pragma unroll
                for (int q = 0; q < LNR; ++q) { float s_ = 0.f;
#pragma unroll
                    for (int j = 0; j < 2; ++j)
#pragma unroll
                        for (int c = 0; c < 4; ++c) { const unsigned w = raw[q][j][c]; v[q][j][2 * c] = bf2f(w & 0xffffu); v[q][j][2 * c + 1] = bf2f(w >> 16); s_ += v[q][j][2 * c] + v[q][j][2 * c + 1]; }
                    sm[q] = s_; }
#pragma unroll
                for (int q = 0; q < LNR; ++q) sm[q] = wave_sum(sm[q]);
#pragma unroll
                for (int q = 0; q < LNR; ++q) { const float mean = sm[q] * (1.0f / D); float s2 = 0.f;
#pragma unroll
                    for (int j = 0; j < 2; ++j)
#pragma unroll
                        for (int c = 0; c < 8; ++c) { v[q][j][c] -= mean; s2 += v[q][j][c] * v[q][j][c]; }
                    sq[q] = s2; }
#pragma unroll
                for (int q = 0; q < LNR; ++q) sq[q] = wave_sum(sq[q]);
#pragma unroll
                for (int q = 0; q < LNR; ++q) {
                    const float rstd = 1.0f / sqrtf(sq[q] * (1.0f / D) + LN_EPS);
                    if (lane == 0) *(float2*)(stats + 2 * (row0 + q)) = make_float2(sm[q] * (1.0f / D), rstd);
#pragma unroll
                    for (int j = 0; j < 2; ++j) {
                        float xv[8];
#pragma unroll
                        for (int c = 0; c < 8; ++c) xv[c] = v[q][j][c] * rstd * gg[j][c >> 2][c & 3] + bb[j][c >> 2][c & 3];
                        u32x2 fv; fv.x = pk4_fp8(xv[0], xv[1], xv[2], xv[3]); fv.y = pk4_fp8(xv[4], xv[5], xv[6], xv[7]);
                        *(u32x2*)(x1_8 + (row0 + q) * D + 512 * j + 8 * lane) = fv;
                    }
                }
            }
        }
        {
            PHASE_IDS(); PHASE_PTRS();
            const int fr = lane & 15, fq = lane >> 4;
            f32x4 lacc[2][2];
#pragma unroll
            for (int m = 0; m < 2; ++m)
#pragma unroll
                for (int n = 0; n < 2; ++n) lacc[m][n] = (f32x4){0.f, 0.f, 0.f, 0.f};
            const size_t r0 = (size_t)pm * 256 + wave * 32;
            const int fr8 = fr & 7, hs = fr >> 3;
            const bf16_t* al = x1b + (r0 + fr8) * D + 8 * fq + 32 * hs;
            const LAS unsigned char* bh = lds + fr * 2064 + 16 * fq; const LAS unsigned char* bl = bh + 66048;
#pragma unroll 2
            for (int k0 = 0; k0 < 1024; k0 += 64) {
                bf16x8 a0[2], a1[2], b_hi[2][2], b_lo[2][2];
#pragma unroll
                for (int m = 0; m < 2; ++m) {
                    const u32x4 A = *(const u32x4*)(al + (size_t)m * 16 * D + k0), B = *(const u32x4*)(al + (size_t)(m * 16 + 8) * D + k0);
                    a0[m] = __builtin_bit_cast(bf16x8, pg8::ror8sel<0xC>(A, B)); a1[m] = __builtin_bit_cast(bf16x8, pg8::ror8sel<0x3>(B, A)); }
#pragma unroll
                for (int st = 0; st < 2; ++st)
#pragma unroll
                    for (int n = 0; n < 2; ++n) { b_hi[st][n] = *(const LAS bf16x8*)(bh + n * 16 * 2064 + (k0 + 32 * st) * 2); b_lo[st][n] = *(const LAS bf16x8*)(bl + n * 16 * 2064 + (k0 + 32 * st) * 2); }
#pragma unroll
                for (int m = 0; m < 2; ++m)
#pragma unroll
                    for (int n = 0; n < 2; ++n) {
                        lacc[m][n] = __builtin_amdgcn_mfma_f32_16x16x32_bf16(a0[m], b_hi[0][n], lacc[m][n], 0, 0, 0);
                        lacc[m][n] = __builtin_amdgcn_mfma_f32_16x16x32_bf16(a0[m], b_lo[0][n], lacc[m][n], 0, 0, 0);
                        lacc[m][n] = __builtin_amdgcn_mfma_f32_16x16x32_bf16(a1[m], b_hi[1][n], lacc[m][n], 0, 0, 0);
                        lacc[m][n] = __builtin_amdgcn_mfma_f32_16x16x32_bf16(a1[m], b_lo[1][n], lacc[m][n], 0, 0, 0);
                    }
            }
            __syncthreads();
            LAS float* lg = (LAS float*)lds;
#pragma unroll
            for (int m = 0; m < 2; ++m)
#pragma unroll
                for (int n = 0; n < 2; ++n)
#pragma unroll
                    for (int rg = 0; rg < 4; ++rg) lg[(wave * 32 + 16 * m + 4 * fq + rg) * 33 + 16 * n + fr] = lacc[m][n][rg];
        }
        __syncthreads();
        {
            PHASE_IDS(); PHASE_PTRS();
            LAS float* lg = (LAS float*)lds;
            LAS int* wcnt = (LAS int*)(lds + 36864);
            float t0 = -INFINITY, t1 = -INFINITY, t2 = -INFINITY, t3 = -INFINITY; int i0 = 0, i1 = 0, i2 = 0, i3 = 0;
            int rk0 = 0, rk1 = 0, rk2 = 0, rk3 = 0;
            if (tid < 256) {
                const float2 st = *(const float2*)(stats + 2 * ((size_t)pm * 256 + tid));
                const float nmr = -st.x * st.y;
                for (int e = 0; e < NE; ++e) {
                    const float xv = st.y * lg[tid * 33 + e] + (nmr * rc[e] + rc[32 + e]);
                    if (xv > t3) {
                        if (xv > t2) { t3 = t2; i3 = i2;
                            if (xv > t1) { t2 = t1; i2 = i1;
                                if (xv > t0) { t1 = t0; i1 = i0; t0 = xv; i0 = e; } else { t1 = xv; i1 = e; }
                            } else { t2 = xv; i2 = e; }
                        } else { t3 = xv; i3 = e; }
                    }
                }
                const unsigned selm = (1u << i0) | (1u << i1) | (1u << i2) | (1u << i3);
                for (int e = 0; e < NE; ++e) {
                    const bool has = ((selm >> e) & 1u) != 0u;
                    const unsigned long long bal = __ballot(has);
                    const int pre = __popcll(bal & ((1ull << lane) - 1ull));
                    if (e == i0) rk0 = pre; if (e == i1) rk1 = pre; if (e == i2) rk2 = pre; if (e == i3) rk3 = pre;
                    if (lane == 0) wcnt[wave * 32 + e] = __popcll(bal);
                }
            }
            __syncthreads();
            if (tid < 256) {
                const float e1 = __expf(t1 - t0), e2 = __expf(t2 - t0), e3 = __expf(t3 - t0);
                const float inv = 1.0f / (1.0f + e1 + e2 + e3);
                int b0 = 0, b1 = 0, b2 = 0, b3 = 0;
                for (int w = 0; w < wave; ++w) { b0 += wcnt[w * 32 + i0]; b1 += wcnt[w * 32 + i1]; b2 += wcnt[w * 32 + i2]; b3 += wcnt[w * 32 + i3]; }
                const size_t a = ((size_t)pm * 256 + tid) * 4;
                *(int4*)(asg_e + a) = make_int4(i0, i1, i2, i3);
                *(float4*)(asg_g + a) = make_float4(inv, e1 * inv, e2 * inv, e3 * inv);
                *(int4*)(asg_d + a) = make_int4(b0 + rk0, b1 + rk1, b2 + rk2, b3 + rk3);
            }
            if (tid < 32) cnt_blk[pm * 32 + tid] = wcnt[tid] + wcnt[32 + tid] + wcnt[64 + tid] + wcnt[96 + tid];
            __syncthreads();
        }
        }
    }
    xcd_barrier(xbar, wave_s);

    for (int pm = bx; pm < T / 256; pm += G) {
        PHASE_IDS(); PHASE_PTRS();
        LAS int* part_all = (LAS int*)lds; LAS int* part_pre = part_all + 512; LAS int* tot = part_pre + 512; LAS int* pre = tot + 32; LAS int* poff = pre + 32;
        { const int e = tid & 31, seg = tid >> 5; int sa = 0, sp = 0;
            for (int bb = seg * 16; bb < seg * 16 + 16; ++bb) { const int c = cnt_blk[bb * 32 + e]; sa += c; sp += (bb < pm) ? c : 0; }
            part_all[tid] = sa; part_pre[tid] = sp; }
        __syncthreads();
        if (tid < 32) { int sa = 0, sp = 0; for (int s = 0; s < 16; ++s) { sa += part_all[s * 32 + tid]; sp += part_pre[s * 32 + tid]; } tot[tid] = sa; pre[tid] = sp; }
        __syncthreads();
        if (tid == 0) { int off = 0; for (int e = 0; e < NE; ++e) { poff[e] = off; off += ((tot[e] + 255) >> 8) << 8; } poff[32] = off; }
        __syncthreads();
        if (tid < 256) {
            const int token = pm * 256 + tid; const size_t a = (size_t)token * 4;
            const int4 ee = *(const int4*)(asg_e + a); const int4 rk = *(const int4*)(asg_d + a);
            const int d0 = poff[ee.x] + pre[ee.x] + rk.x, d1 = poff[ee.y] + pre[ee.y] + rk.y, d2 = poff[ee.z] + pre[ee.z] + rk.z, d3 = poff[ee.w] + pre[ee.w] + rk.w;
            *(int4*)(asg_d + a) = make_int4(d0, d1, d2, d3);
            tok[d0] = token; tok[d1] = token; tok[d2] = token; tok[d3] = token;
        }
        if (pm < NE) {
            const int e = pm, n = tot[e], np = ((n + 255) >> 8) << 8, o = poff[e];
            for (int i = n + tid; i < np; i += NTHREADS) tok[o + i] = 0;
            for (int i = tid; i < (np >> 8); i += NTHREADS) tile_e[(o >> 8) + i] = e;
        }
        if (pm == 0 && tid == 0) ctl[CW_NTILES] = (unsigned)(poff[32] >> 8);
        __syncthreads();
    }
    xcd_barrier(xbar, wave_s);

    REP(5) {
        PHASE_PTRS(); const int ntiles = (int)ctl[CW_NTILES];
        { LAS int* tl = (LAS int*)(lds + LDSX_TILE); for (int i = tid_of(wave_s); i < ntiles; i += NTHREADS) tl[i] = tile_e[i]; __syncthreads(); }
        pg8::SchedMoe<8, true> S{(const char*)x1_8, (const char*)w1_8, (const LAS int*)(lds + LDSX_TILE), tok, ntiles, G, bx};
        pg8::EpiSwiglu E{act8, p.b1};
        W2Hook H2; H2.w2 = p.w2; H2.w2_8 = w2_8; H2.gw = bx * 8 + wave_s; H2.NGW = G * 8; H2.step = (G * 8 * 8 >= NE * 512) ? 4 : (1 << 20);
        pg8::gemm_phase<pg8::EpiSwiglu, pg8::SchedMoe<8, true>, true, true, 512, true, true, W2Hook>(lds, S, E, wave_s, H2);
    }
    xcd_barrier(xbar, wave_s);

    REP(6) {
        PHASE_PTRS(); const int ntiles = (int)ctl[CW_NTILES];
        { LAS int* tl = (LAS int*)(lds + LDSX_TILE); for (int i = tid_of(wave_s); i < ntiles; i += NTHREADS) tl[i] = tile_e[i]; __syncthreads(); }
        pg8::SchedMoe<4, false> S{(const char*)act8, (const char*)w2_8, (const LAS int*)(lds + LDSX_TILE), tok, ntiles, G, bx};
        pg8::EpiDown E{yb, p.b2};
        pg8::gemm_phase<pg8::EpiDown, pg8::SchedMoe<4, false>, false, true, 512, true, true>(lds, S, E, wave_s);
    }
    xcd_barrier(xbar, wave_s);

    REP(7) {
        PHASE_IDS(); PHASE_PTRS();
        const int gw = bx * 8 + wave, NGW = G * 8;
        f32x4 gg[2][2], bb[2][2];
#pragma unroll
        for (int j = 0; j < 2; ++j)
#pragma unroll
            for (int h = 0; h < 2; ++h) { gg[j][h] = *(const f32x4*)(p.ln2_g + 512 * j + 8 * lane + 4 * h); bb[j][h] = *(const f32x4*)(p.ln2_b + 512 * j + 8 * lane + 4 * h); }
        f32x4 ag[2][2], ab[2][2];
#pragma unroll
        for (int j = 0; j < 2; ++j)
#pragma unroll
            for (int h = 0; h < 2; ++h) { ag[j][h] = DN_ALPHA * *(const f32x4*)(p.ln1_g + 512 * j + 8 * lane + 4 * h); ab[j][h] = DN_ALPHA * *(const f32x4*)(p.ln1_b + 512 * j + 8 * lane + 4 * h); }
        constexpr int R = 2;
        int4 dd[R]; float4 gt[R]; float2 st[R];
#pragma unroll
        for (int q = 0; q < R; ++q) { const int row = gw + q * NGW < T ? gw + q * NGW : gw; dd[q] = *(const int4*)(asg_d + (size_t)row * 4); gt[q] = *(const float4*)(asg_g + (size_t)row * 4); st[q] = *(const float2*)(stats + 2 * (size_t)row); }
        for (int row0 = gw; row0 < T; row0 += R * NGW) {
            u32x4 xr[R][2]; u32x2 yk[R][4][2];
#pragma unroll
            for (int q = 0; q < R; ++q) { const int row = row0 + q * NGW < T ? row0 + q * NGW : row0;
#pragma unroll
                for (int j = 0; j < 2; ++j) {
                    xr[q][j] = *(const u32x4*)(x1b + (size_t)row * D + 512 * j + 8 * lane);
                    yk[q][0][j] = __builtin_nontemporal_load((const u32x2*)(yb + (size_t)dd[q].x * D + 512 * j + 8 * lane));
                    yk[q][1][j] = __builtin_nontemporal_load((const u32x2*)(yb + (size_t)dd[q].y * D + 512 * j + 8 * lane));
                    yk[q][2][j] = __builtin_nontemporal_load((const u32x2*)(yb + (size_t)dd[q].z * D + 512 * j + 8 * lane));
                    yk[q][3][j] = __builtin_nontemporal_load((const u32x2*)(yb + (size_t)dd[q].w * D + 512 * j + 8 * lane));
                } }
            int4 ddn[R]; float4 gtn[R]; float2 stn[R];
            { const int nr0 = row0 + R * NGW < T ? row0 + R * NGW : row0;
#pragma unroll
              for (int q = 0; q < R; ++q) { const int row = nr0 + q * NGW < T ? nr0 + q * NGW : nr0; ddn[q] = *(const int4*)(asg_d + (size_t)row * 4); gtn[q] = *(const float4*)(asg_g + (size_t)row * 4); stn[q] = *(const float2*)(stats + 2 * (size_t)row); } }
            float z[R][2][8]; float sm[R], sq[R];
#pragma unroll
            for (int q = 0; q < R; ++q) {
                const float g0 = gt[q].x * (1.0f / Y_SCALE), g1 = gt[q].y * (1.0f / Y_SCALE), g2 = gt[q].z * (1.0f / Y_SCALE), g3 = gt[q].w * (1.0f / Y_SCALE);
                const float rs = st[q].y, nmr = -st[q].x * st[q].y;
                float s_ = 0.f;
#pragma unroll
                for (int j = 0; j < 2; ++j)
#pragma unroll
                    for (int d = 0; d < 2; ++d) {
#define P7_PAIR(HH, SEL) do { \
                            const f32x2 a0 = __builtin_amdgcn_cvt_pk_f32_fp8((int)yk[q][0][j][d], SEL), a1 = __builtin_amdgcn_cvt_pk_f32_fp8((int)yk[q][1][j][d], SEL); \
                            const f32x2 a2 = __builtin_amdgcn_cvt_pk_f32_fp8((int)yk[q][2][j][d], SEL), a3 = __builtin_amdgcn_cvt_pk_f32_fp8((int)yk[q][3][j][d], SEL); \
                            const unsigned xw = xr[q][j][2 * d + HH]; \
                            const float lo = (bf2f(xw & 0xffffu) * rs + nmr) * ag[j][d][2 * HH] + ab[j][d][2 * HH] + g0 * a0.x + g1 * a1.x + g2 * a2.x + g3 * a3.x; \
                            const float hi = (bf2f(xw >> 16) * rs + nmr) * ag[j][d][2 * HH + 1] + ab[j][d][2 * HH + 1] + g0 * a0.y + g1 * a1.y + g2 * a2.y + g3 * a3.y; \
                            z[q][j][4 * d + 2 * HH] = lo; z[q][j][4 * d + 2 * HH + 1] = hi; s_ += lo + hi; } while (0)
                        P7_PAIR(0, false); P7_PAIR(1, true);
#undef P7_PAIR
                    }
                sm[q] = s_;
            }
#pragma unroll
            for (int q = 0; q < R; ++q) sm[q] = wave_sum(sm[q]);
#pragma unroll
            for (int q = 0; q < R; ++q) { const float mean = sm[q] * (1.0f / D); float s2 = 0.f;
#pragma unroll
                for (int j = 0; j < 2; ++j)
#pragma unroll
                    for (int c = 0; c < 8; ++c) { z[q][j][c] -= mean; s2 += z[q][j][c] * z[q][j][c]; }
                sq[q] = s2; }
#pragma unroll
            for (int q = 0; q < R; ++q) sq[q] = wave_sum(sq[q]);
#pragma unroll
            for (int q = 0; q < R; ++q) {
                const int row = row0 + q * NGW;
                if (row < T) {
                    const float rstd = 1.0f / sqrtf(sq[q] * (1.0f / D) + LN_EPS);
#pragma unroll
                    for (int j = 0; j < 2; ++j)
#pragma unroll
                        for (int h = 0; h < 2; ++h) {
                            f32x4 o;
#pragma unroll
                            for (int c = 0; c < 4; ++c) o[c] = z[q][j][4 * h + c] * rstd * gg[j][h][c] + bb[j][h][c];
                            *(f32x4*)(p.out + (size_t)row * D + 512 * j + 8 * lane + 4 * h) = o;
                        }
                }
            }
#pragma unroll
            for (int q = 0; q < R; ++q) { dd[q] = ddn[q]; gt[q] = gtn[q]; st[q] = stn[q]; }
        }
    }
    if (tid_of(wave_s) == 0) {
        const unsigned old = xb_add(&g_xbar[XB_DONE], 1u);
        if (old + 1u == (unsigned)G) {
#pragma unroll 1
            for (unsigned j = 0; j < 16; ++j) { __hip_atomic_store(&g_xbar[XB_XCNT(j)], 0u, __ATOMIC_RELAXED, __HIP_MEMORY_SCOPE_AGENT); __hip_atomic_store(&g_xbar[XB_XSUB(j)], 0u, __ATOMIC_RELAXED, __HIP_MEMORY_SCOPE_AGENT);
                __hip_atomic_store(&g_xbar[XB_XGEN(j)], 0u, __ATOMIC_RELAXED, __HIP_MEMORY_SCOPE_AGENT); }
            __hip_atomic_store(&g_xbar[XB_TOP], 0u, __ATOMIC_RELAXED, __HIP_MEMORY_SCOPE_AGENT); __hip_atomic_store(&g_xbar[XB_TOPGEN], 0u, __ATOMIC_RELAXED, __HIP_MEMORY_SCOPE_AGENT);
            __hip_atomic_store(&g_xbar[XB_TMO], 0u, __ATOMIC_RELAXED, __HIP_MEMORY_SCOPE_AGENT); __hip_atomic_store(&g_xbar[XB_DONE], 0u, __ATOMIC_RELAXED, __HIP_MEMORY_SCOPE_AGENT);
        }
    }
}

extern "C" void kernel_launch(void* const* d_in, const int* in_sizes, int n_in, void* d_out, int out_size, void* d_ws, size_t ws_size, hipStream_t stream) {
    static int grid_blocks = 0;
    if (grid_blocks == 0) {
        if (n_in != 16 || in_sizes[0] != T * D || out_size != T * D || ws_size < WS_END) {
            fprintf(stderr, "kernel_launch: unexpected shapes: n_in %d in0 %d out %d ws %zu (need %zu)\n", n_in, n_in > 0 ? in_sizes[0] : -1, out_size, ws_size, (size_t)WS_END); grid_blocks = -1; return; }
        int dev = 0, cus = 0, per_cu = 0;
        (void)hipGetDevice(&dev);
        (void)hipDeviceGetAttribute(&cus, hipDeviceAttributeMultiprocessorCount, dev);
        (void)hipFuncSetAttribute((const void*)fwd_megakernel, hipFuncAttributeMaxDynamicSharedMemorySize, LDS_BYTES);
        (void)hipOccupancyMaxActiveBlocksPerMultiprocessor(&per_cu, (const void*)fwd_megakernel, NTHREADS, LDS_BYTES);
        if (per_cu < 1) { fprintf(stderr, "kernel_launch: occupancy query reports %d blocks per CU\n", per_cu); per_cu = 1; }
        grid_blocks = cus;
        fprintf(stderr, "kernel_launch: cus=%d per_cu=%d grid=%d ws=%zu\n", cus, per_cu, grid_blocks, ws_size);
    }
    if (grid_blocks < 0) return;
    Params p{};
    p.x = (const float*)d_in[0]; p.w_in = (const float*)d_in[1]; p.b_in = (const float*)d_in[2]; p.sinks = (const float*)d_in[3]; p.w_out = (const float*)d_in[4]; p.b_out = (const float*)d_in[5];
    p.ln1_g = (const float*)d_in[6]; p.ln1_b = (const float*)d_in[7]; p.w_router = (const float*)d_in[8]; p.b_router = (const float*)d_in[9];
    p.w1 = (const float*)d_in[10]; p.b1 = (const float*)d_in[11]; p.w2 = (const float*)d_in[12]; p.b2 = (const float*)d_in[13]; p.ln2_g = (const float*)d_in[14]; p.ln2_b = (const float*)d_in[15];
    p.out = (float*)d_out; p.ws = (unsigned char*)d_ws;
    hipLaunchKernelGGL(fwd_megakernel, dim3(grid_blocks), dim3(NTHREADS), LDS_BYTES, stream, p);
    hipError_t e = hipPeekAtLastError();
    if (e != hipSuccess) fprintf(stderr, "launch failed: %s (grid %d)\n", hipGetErrorString(e), grid_blocks);
}
```
